# Optimizing an MI355X kernel written in HIP

```python
import math
import jax, jax.numpy as jnp
from jax import lax
import numpy as np

D_MODEL = 2048
BATCH = 4
SEQ = 4096
DEPTH = 2

MOBA_HEADS = 8
MOBA_HEAD_DIM = 128
MOBA_BLOCK = 256
MOBA_TOPK = 3
MOBA_Q_CHUNK = 32
MOBA_WIDTH = MOBA_HEADS * MOBA_HEAD_DIM
DIFF_HEADS = 8
DIFF_QK_DIM = 64
DIFF_V_DIM = 2 * DIFF_QK_DIM
DIFF_Q_BLOCK = 128
DIFF_WIDTH = DIFF_HEADS * DIFF_V_DIM
IN_WIDTHS = (MOBA_WIDTH, MOBA_WIDTH, MOBA_WIDTH, DIFF_WIDTH, DIFF_WIDTH, DIFF_WIDTH, D_MODEL, D_MODEL)
IN_COLS = sum(IN_WIDTHS)
IN_SPLITS = tuple(int(c) for c in np.cumsum(IN_WIDTHS)[:-1])
PEER_HEADS = 8
PEER_N_KEYS = 128
PEER_N_EXPERTS = PEER_N_KEYS * PEER_N_KEYS
PEER_TOPK = 16
PEER_QUERY_DIM = 256
PEER_HALF = PEER_QUERY_DIM // 2
PEER_TOKEN_CHUNK = 128
ROPE_THETA = 10000.0
LN_EPS = 1e-5
RMS_EPS = 1e-6
DEEPNORM_ALPHA = (2 * DEPTH) ** 0.25
DEEPNORM_BETA = (8 * DEPTH) ** -0.25

kernel_name = "hybrid_moba_diffattn_peer_deepnorm"


def layer_norm(x, gain, bias):
    xf = x.astype(jnp.float32)
    mu = jnp.mean(xf, axis=-1, keepdims=True)
    var = jnp.mean(jnp.square(xf - mu), axis=-1, keepdims=True)
    y = (xf - mu) * lax.rsqrt(var + LN_EPS) * gain.astype(jnp.float32) + bias.astype(jnp.float32)
    return y.astype(x.dtype)


def rope_tables(positions, dim):
    inv_freq = ROPE_THETA ** (-jnp.arange(0, dim, 2, dtype=jnp.float32) / dim)
    ang = positions.astype(jnp.float32)[..., None] * inv_freq
    return jnp.cos(ang)[:, None], jnp.sin(ang)[:, None]


def apply_rope(t, cos, sin):
    t1, t2 = jnp.split(t, 2, axis=-1)
    c = cos.astype(t.dtype)
    s = sin.astype(t.dtype)
    return jnp.concatenate([t1 * c - t2 * s, t1 * s + t2 * c], axis=-1)


def split_heads(t, n_heads):
    b, s, _ = t.shape
    return t.reshape(b, s, n_heads, -1).transpose(0, 2, 1, 3)


def merge_heads(t):
    b, h, s, d = t.shape
    return t.transpose(0, 2, 1, 3).reshape(b, s, h * d)


def moba_attention(q, k, v):
    b, h, s, d = q.shape
    n_blocks = -(-s // MOBA_BLOCK)
    s_pad = n_blocks * MOBA_BLOCK
    topk = min(MOBA_TOPK, n_blocks)
    pad = ((0, 0), (0, 0), (0, s_pad - s), (0, 0))
    k_p = jnp.pad(k, pad)
    v_p = jnp.pad(v, pad)
    k_blocks = k_p.reshape(b, h, n_blocks, MOBA_BLOCK, d)
    v_blocks = v_p.reshape(b, h, n_blocks, MOBA_BLOCK, d)
    k_mean = jnp.mean(k_blocks.astype(jnp.float32), axis=3).astype(k.dtype)
    scale = d ** -0.5
    bi = jnp.arange(b)[:, None, None, None]
    hi = jnp.arange(h)[None, :, None, None]
    blk_ids = jnp.arange(n_blocks)
    key_off = jnp.arange(MOBA_BLOCK)

    def chunk(c):
        q0 = c * MOBA_Q_CHUNK
        qc = lax.dynamic_slice_in_dim(q, q0, MOBA_Q_CHUNK, axis=2)
        q_pos = q0 + jnp.arange(MOBA_Q_CHUNK)
        own = q0 // MOBA_BLOCK
        gate = jnp.einsum('bhqd,bhnd->bhqn', qc, k_mean).astype(jnp.float32)
        gate = jnp.where(blk_ids < own, gate, -jnp.inf)
        _, sel = lax.top_k(gate, topk)
        sel_valid = sel < own
        k_sel = k_blocks[bi, hi, sel]
        v_sel = v_blocks[bi, hi, sel]
        s_sel = jnp.einsum('bhqd,bhqnkd->bhqnk', qc, k_sel).astype(jnp.float32) * scale
        s_sel = jnp.where(sel_valid[..., None], s_sel, -jnp.inf).reshape(b, h, MOBA_Q_CHUNK, topk * MOBA_BLOCK)
        k_own = lax.dynamic_slice_in_dim(k_p, own * MOBA_BLOCK, MOBA_BLOCK, axis=2)
        v_own = lax.dynamic_slice_in_dim(v_p, own * MOBA_BLOCK, MOBA_BLOCK, axis=2)
        s_own = jnp.einsum('bhqd,bhkd->bhqk', qc, k_own).astype(jnp.float32) * scale
        causal = (own * MOBA_BLOCK + key_off)[None, :] <= q_pos[:, None]
        s_own = jnp.where(causal, s_own, -jnp.inf)
        p = jax.nn.softmax(jnp.concatenate([s_sel, s_own], axis=-1), axis=-1).astype(v.dtype)
        p_sel = p[..., :topk * MOBA_BLOCK].reshape(b, h, MOBA_Q_CHUNK, topk, MOBA_BLOCK)
        p_own = p[..., topk * MOBA_BLOCK:]
        return (jnp.einsum('bhqnk,bhqnkd->bhqd', p_sel, v_sel)
                + jnp.einsum('bhqk,bhkd->bhqd', p_own, v_own))

    outs = lax.map(chunk, jnp.arange(s // MOBA_Q_CHUNK))
    return outs.transpose(1, 2, 0, 3, 4).reshape(b, h, s, d)


def diff_attention(q1, q2, k1, k2, v, lam):
    b, h, s, dq = q1.shape
    scale = dq ** -0.5
    k_pos = jnp.arange(s)

    def block(i):
        q0 = i * DIFF_Q_BLOCK
        q_pos = q0 + jnp.arange(DIFF_Q_BLOCK)
        causal = k_pos[None, :] <= q_pos[:, None]

        def probs(qf, kf):
            qb = lax.dynamic_slice_in_dim(qf, q0, DIFF_Q_BLOCK, axis=2)
            sc = jnp.einsum('bhqd,bhkd->bhqk', qb, kf).astype(jnp.float32) * scale
            return jax.nn.softmax(jnp.where(causal, sc, -jnp.inf), axis=-1)

        p = probs(q1, k1) - lam * probs(q2, k2)
        return jnp.einsum('bhqk,bhkd->bhqd', p.astype(v.dtype), v)

    outs = lax.map(block, jnp.arange(s // DIFF_Q_BLOCK))
    return outs.transpose(1, 2, 0, 3, 4).reshape(b, h, s, -1)


def peer_ffn(x, w_query, subkeys, u_table, v_table):
    b, s, d = x.shape
    q = (x @ w_query).reshape(b, s, PEER_HEADS, 2, PEER_HALF)
    scores = jnp.einsum('bshcd,chnd->bshcn', q, subkeys).astype(jnp.float32)
    top_s, top_i = lax.top_k(scores, PEER_TOPK)
    cand = top_s[..., 0, :, None] + top_s[..., 1, None, :]
    cand_s, cand_c = lax.top_k(cand.reshape(b, s, PEER_HEADS, PEER_TOPK * PEER_TOPK), PEER_TOPK)
    i1 = jnp.take_along_axis(top_i[..., 0, :], cand_c // PEER_TOPK, axis=-1)
    i2 = jnp.take_along_axis(top_i[..., 1, :], cand_c % PEER_TOPK, axis=-1)
    experts = i1 * PEER_N_KEYS + i2
    gates = jax.nn.softmax(cand_s, axis=-1).astype(x.dtype)
    n_tok = b * s
    n_sel = PEER_HEADS * PEER_TOPK
    n_chunks = n_tok // PEER_TOKEN_CHUNK
    xs = x.reshape(n_chunks, PEER_TOKEN_CHUNK, d)
    es = experts.reshape(n_chunks, PEER_TOKEN_CHUNK, n_sel)
    gs = gates.reshape(n_chunks, PEER_TOKEN_CHUNK, n_sel)

    def chunk(args):
        xc, ec, gc = args
        hidden = jnp.einsum('td,tkd->tk', xc, u_table[ec])
        return jnp.einsum('tk,tkd->td', gc * jax.nn.gelu(hidden), v_table[ec])

    return lax.map(chunk, (xs, es, gs)).reshape(b, s, d)


def setup_inputs(seed: int = 0) -> dict:
    key = jax.random.key(seed)
    ks = jax.random.split(key, 20)
    f32 = jnp.float32
    beta = DEEPNORM_BETA
    x = jax.random.normal(ks[0], (BATCH, SEQ, D_MODEL), f32)
    positions = jnp.broadcast_to(jnp.arange(SEQ, dtype=jnp.int32)[None, :], (BATCH, SEQ))
    col_scale = jnp.concatenate([
        jnp.full((w,), beta if i in (2, 5) else 1.0, f32) for i, w in enumerate(IN_WIDTHS)])
    w_in = jax.random.normal(ks[1], (DEPTH, D_MODEL, IN_COLS), f32) * (D_MODEL ** -0.5) * col_scale
    w_branch_a = jax.random.normal(ks[2], (DEPTH, MOBA_WIDTH, D_MODEL), f32) * (MOBA_WIDTH ** -0.5) * beta
    w_branch_b = jax.random.normal(ks[3], (DEPTH, DIFF_WIDTH, D_MODEL), f32) * (DIFF_WIDTH ** -0.5) * beta
    w_out = jax.random.normal(ks[4], (DEPTH, D_MODEL, D_MODEL), f32) * (D_MODEL ** -0.5) * beta
    diff_lambda = jax.random.normal(ks[5], (DEPTH, 4, DIFF_QK_DIM), f32) * 0.1
    diff_norm_gain = 1.0 + 0.02 * jax.random.normal(ks[6], (DEPTH, DIFF_HEADS, DIFF_V_DIM), f32)
    ln1_gain = 1.0 + 0.02 * jax.random.normal(ks[7], (DEPTH, D_MODEL), f32)
    ln1_bias = 0.02 * jax.random.normal(ks[8], (DEPTH, D_MODEL), f32)
    ln2_gain = 1.0 + 0.02 * jax.random.normal(ks[9], (DEPTH, D_MODEL), f32)
    ln2_bias = 0.02 * jax.random.normal(ks[10], (DEPTH, D_MODEL), f32)
    peer_w_query = jax.random.normal(ks[11], (DEPTH, D_MODEL, PEER_HEADS * PEER_QUERY_DIM), f32) * (D_MODEL ** -0.5)
    peer_subkeys = jax.random.normal(ks[12], (DEPTH, 2, PEER_HEADS, PEER_N_KEYS, PEER_HALF), f32) * (PEER_HALF ** -0.5)
    peer_u = jax.random.normal(ks[13], (DEPTH, PEER_N_EXPERTS, D_MODEL), f32) * (D_MODEL ** -0.5)
    peer_v = jax.random.normal(ks[14], (DEPTH, PEER_N_EXPERTS, D_MODEL), f32) * beta
    return {"x": x, "positions": positions, "w_in": w_in, "w_branch_a": w_branch_a,
            "w_branch_b": w_branch_b, "w_out": w_out, "diff_lambda": diff_lambda,
            "diff_norm_gain": diff_norm_gain, "ln1_gain": ln1_gain, "ln1_bias": ln1_bias,
            "ln2_gain": ln2_gain, "ln2_bias": ln2_bias, "peer_w_query": peer_w_query,
            "peer_subkeys": peer_subkeys, "peer_u": peer_u, "peer_v": peer_v}


def reference(x, positions, w_in, w_branch_a, w_branch_b, w_out, diff_lambda, diff_norm_gain,
              ln1_gain, ln1_bias, ln2_gain, ln2_bias, peer_w_query, peer_subkeys, peer_u, peer_v):
    cos_a, sin_a = rope_tables(positions, MOBA_HEAD_DIM)
    cos_b, sin_b = rope_tables(positions, DIFF_QK_DIM)
    for layer in range(DEPTH):
        lambda_init = 0.8 - 0.6 * math.exp(-0.3 * layer)
        proj = x @ w_in[layer]
        mq, mk, mv, dq, dk, dv, gate_a, gate_b = jnp.split(proj, IN_SPLITS, axis=-1)
        qa = apply_rope(split_heads(mq, MOBA_HEADS), cos_a, sin_a)
        ka = apply_rope(split_heads(mk, MOBA_HEADS), cos_a, sin_a)
        va = split_heads(mv, MOBA_HEADS)
        out_a = merge_heads(moba_attention(qa, ka, va))
        qb = split_heads(dq, DIFF_HEADS)
        kb = split_heads(dk, DIFF_HEADS)
        vb = split_heads(dv, DIFF_HEADS)
        q1 = apply_rope(qb[..., :DIFF_QK_DIM], cos_b, sin_b)
        q2 = apply_rope(qb[..., DIFF_QK_DIM:], cos_b, sin_b)
        k1 = apply_rope(kb[..., :DIFF_QK_DIM], cos_b, sin_b)
        k2 = apply_rope(kb[..., DIFF_QK_DIM:], cos_b, sin_b)
        lam_p = diff_lambda[layer].astype(jnp.float32)
        lam = (jnp.exp(jnp.sum(lam_p[0] * lam_p[1])) - jnp.exp(jnp.sum(lam_p[2] * lam_p[3])) + lambda_init)
        ob = diff_attention(q1, q2, k1, k2, vb, lam).astype(jnp.float32)
        ob = ob * lax.rsqrt(jnp.mean(jnp.square(ob), axis=-1, keepdims=True) + RMS_EPS)
        ob = ob * diff_norm_gain[layer][None, :, None, :].astype(jnp.float32) * (1.0 - lambda_init)
        out_b = merge_heads(ob.astype(x.dtype))
        merged = (jax.nn.sigmoid(gate_a) * (out_a @ w_branch_a[layer])
                  + jax.nn.sigmoid(gate_b) * (out_b @ w_branch_b[layer]))
        x = layer_norm(DEEPNORM_ALPHA * x + merged @ w_out[layer], ln1_gain[layer], ln1_bias[layer])
        y = peer_ffn(x, peer_w_query[layer], peer_subkeys[layer], peer_u[layer], peer_v[layer])
        x = layer_norm(DEEPNORM_ALPHA * x + y, ln2_gain[layer], ln2_bias[layer])
    return x
```

```cpp
#include <hip/hip_runtime.h>
#include <cstdio>
#include <cstdint>

#ifndef MK_FUSED
#define MK_FUSED 1
#endif
#ifndef MK_CHECK
#define MK_CHECK 0
#endif
#ifndef MK_CHECK_LAYER
#define MK_CHECK_LAYER 0
#endif

namespace cfg {
constexpr int DM = 2048, NB = 4, SEQ = 4096, T = NB * SEQ, DEPTH = 2;
constexpr int NH = 8, HD = 128, AW = NH * HD;
constexpr int INC = 10240;
constexpr int NMAIN = 8192, NV = 2048;
constexpr int PH = 8, PKEYS = 128, PTOP = 16, NEXP = PKEYS * PKEYS, PHALF = 128;
constexpr float LN_EPS = 1e-5f, RMS_EPS = 1e-6f;
constexpr float ALPHA = 1.4142135623730951f;
constexpr float LOG2E = 1.4426950408889634f;
constexpr float QSCALE_A = 0.08838834764831845f * LOG2E;
constexpr float QSCALE_B = 0.125f * LOG2E;
}
using namespace cfg;

constexpr size_t MiB = 1u << 20;
constexpr size_t WS_CTL = 0, CTL_ZERO_BYTES = 1 * MiB;
constexpr size_t WS_SK = 1 * MiB;
constexpr size_t WS_KMEAN = 2 * MiB;
constexpr size_t WS_TSC = 3 * MiB;
constexpr size_t WS_ROPE = 4 * MiB;
constexpr size_t WS_W = 20 * MiB, W_LAYER = 64 * MiB;
constexpr size_t WO_MAIN = 0, WO_V = 16 * MiB, WO_A = 40 * MiB, WO_O = 48 * MiB, WO_Q = 56 * MiB;
constexpr size_t WS_TAB = 148 * MiB, TAB_BYTES = 16 * MiB;
constexpr size_t WS_XI8 = 212 * MiB;
constexpr size_t WS_SX = 244 * MiB;
constexpr size_t WS_SW = 245 * MiB;
constexpr size_t WS_XB = 404 * MiB;
constexpr size_t WS_QA = 596 * MiB, WS_KA = 628 * MiB, WS_QD = 660 * MiB, WS_KD = 692 * MiB;
constexpr size_t WS_PQ = WS_QA;
constexpr size_t WS_VT = 724 * MiB;
constexpr size_t WS_MERGED = WS_VT;
constexpr size_t WS_GA = 788 * MiB, WS_GB = 852 * MiB;
constexpr size_t WS_OA = 916 * MiB;
constexpr size_t WS_END = 980 * MiB;

constexpr int CW_BAR = 4096;
constexpr int CW_WMAX = 16384;

constexpr int RING_BYTES = 131072;
constexpr int LDSCTL_OFF = RING_BYTES, MISC_OFF = LDSCTL_OFF + 320;
constexpr int LDS_BYTES = 147456;
constexpr int NWAVES = 8;

#define GAS __attribute__((address_space(1)))
#define LAS __attribute__((address_space(3)))
typedef unsigned short bf16;
typedef unsigned v4u __attribute__((ext_vector_type(4)));
typedef unsigned v2u __attribute__((ext_vector_type(2)));
typedef float f32x4 __attribute__((ext_vector_type(4)));
typedef float f32x16 __attribute__((ext_vector_type(16)));
typedef short bf16x8 __attribute__((ext_vector_type(8)));
typedef GAS unsigned gu32;
#define RLX_AGENT __ATOMIC_RELAXED, __HIP_MEMORY_SCOPE_AGENT
#define LDS_WAIT() asm volatile("s_waitcnt lgkmcnt(0)" ::: "memory")
#define VM_WAIT() asm volatile("s_waitcnt vmcnt(0)" ::: "memory")
__device__ __forceinline__ unsigned f2bf(float f) { unsigned u = __builtin_bit_cast(unsigned, f); return (u + 0x7fffu + ((u >> 16) & 1u)) >> 16; }
__device__ __forceinline__ unsigned pk2(float lo, float hi) { return f2bf(lo) | (f2bf(hi) << 16); }
__device__ __forceinline__ float bf_lo(unsigned w) { return __builtin_bit_cast(float, w << 16); }
__device__ __forceinline__ float bf_hi(unsigned w) { return __builtin_bit_cast(float, w & 0xffff0000u); }
__device__ __forceinline__ float fexp2(float x) { return __builtin_amdgcn_exp2f(x); }
__device__ __forceinline__ float frcp(float x) { return __builtin_amdgcn_rcpf(x); }
__device__ __forceinline__ int lane_id() { return (int)__builtin_amdgcn_mbcnt_hi(~0u, __builtin_amdgcn_mbcnt_lo(~0u, 0u)); }
__device__ __forceinline__ float wave_sum(float v) {
#pragma unroll
    for (int o = 1; o < 64; o <<= 1) v += __shfl_xor(v, o);
    return v;
}
namespace pg8 {
#define PG8_LAS __attribute__((address_space(3)))
typedef unsigned short bf16_t;
typedef short bf16x8 __attribute__((ext_vector_type(8)));
typedef float f32x4 __attribute__((ext_vector_type(4)));
typedef unsigned u32x4 __attribute__((ext_vector_type(4)));
typedef int i32x4 __attribute__((ext_vector_type(4)));
constexpr int BM = 256, BK = 64, HALF = 128, HTB = HALF * BK * 2  , STAGE_BYTES = 8 * HTB, NXCD = 8, WGM = 8;

__host__ __device__ __forceinline__ int lds_byte(int r, int c) { const int st = (r >> 4) * 2 + (c >> 5), rr = r & 15, cc = c & 31, ob = rr * 64 + cc * 2; return st * 1024 + (ob ^ (((ob >> 9) & 1) << 5)); }
__host__ __device__ __forceinline__ void stage_rc(int b, int& R, int& C) { const int st = b / 1024, sb = b % 1024, swz = sb ^ (((sb >> 9) & 1) << 5); R = (st >> 1) * 16 + swz / 64; C = (st & 1) * 32 + (swz % 64) / 2; }
__host__ __device__ __forceinline__ int perm32(int rho) { const int n = rho >> 4, i = rho & 15; return 8 * (i >> 2) + 4 * n + (i & 3); }

template <bool I8> struct AccSel { typedef f32x4 type; };
template <> struct AccSel<true> { typedef i32x4 type; };
template <bool I8> __device__ __forceinline__ typename AccSel<I8>::type mma16(const bf16x8& b, const bf16x8& a, const typename AccSel<I8>::type& c) {
    if constexpr (I8) return __builtin_amdgcn_mfma_i32_16x16x64_i8(__builtin_bit_cast(i32x4, b), __builtin_bit_cast(i32x4, a), c, 0, 0, 0);
    else return __builtin_amdgcn_mfma_f32_16x16x32_bf16(b, a, c, 0, 0, 0);
}
struct Unit { int pm, pn; };
struct Gemm { const bf16_t* A; const bf16_t* Bt; int M, N, K; };

struct StaticOrder {
    int nM, nN, nwg, G, c;
    __host__ __device__ void init(int M, int N, int G_, int c_) { nM = M / BM; nN = N / BM; nwg = nM * nN; G = G_; c = c_; }
    __host__ __device__ bool next(int i, Unit& u) const {
        const long L = (long)i * G + c; if (L >= nwg) return false;
        int wgid = (int)L; { const int q = nwg / NXCD, r = nwg % NXCD, xcd = wgid % NXCD, off = wgid / NXCD; wgid = (xcd < r ? xcd * (q + 1) : r * (q + 1) + (xcd - r) * q) + off; }
        const int nig = WGM * nN, gid = wgid / nig, fm = gid * WGM, gsz = (nM - fm) < WGM ? (nM - fm) : WGM;
        u.pm = fm + ((wgid % nig) % gsz); u.pn = (wgid % nig) / gsz; return true;
    }
    __device__ __forceinline__ void a_ready(const Unit&) const {}
    __device__ __forceinline__ void done(const Unit&) const {}
};

typedef float f32x2cv __attribute__((ext_vector_type(2))); typedef __bf16 bf16x2cv __attribute__((ext_vector_type(2)));
__device__ __forceinline__ unsigned cvt_pk_bf16(float lo, float hi) { f32x2cv v = {lo, hi}; bf16x2cv b = __builtin_convertvector(v, bf16x2cv); return __builtin_bit_cast(unsigned, b); }

typedef unsigned u32x2 __attribute__((ext_vector_type(2)));
struct EpiPlainBf16 {
    static constexpr bool PERM = true, AFTER_DRAIN = false;
    bf16_t* O; int ldc;
    __device__ __forceinline__ void operator()(const f32x4 (&acc)[2][2][4][2], const Unit& u, int wr, int wc, int fr_, int fq_) const {
        int fr = fr_, fq = fq_; asm volatile("" : "+v"(fr), "+v"(fq));
        const int row0 = u.pm * BM + wr * 64 + fr, col0 = u.pn * BM + wc * 32 + 8 * fq;
#pragma unroll
        for (int ai = 0; ai < 2; ++ai)
#pragma unroll
            for (int m = 0; m < 4; ++m) { bf16_t* rowp = O + (size_t)(row0 + ai * HALF + m * 16) * ldc + col0;
#pragma unroll
                for (int bj = 0; bj < 2; ++bj) { const f32x4 v0 = acc[ai][bj][m][0], v1 = acc[ai][bj][m][1];
                    u32x4 w; w.x = cvt_pk_bf16(v0[0], v0[1]); w.y = cvt_pk_bf16(v0[2], v0[3]); w.z = cvt_pk_bf16(v1[0], v1[1]); w.w = cvt_pk_bf16(v1[2], v1[3]);
                    *(u32x4*)(rowp + bj * HALF) = w; } }
    }
};
struct EpiBranch {
    static constexpr bool PERM = true, AFTER_DRAIN = false;
    const bf16_t* ga; const bf16_t* gb; bf16_t* O; int ldc;
    __device__ __forceinline__ void mid(f32x4 (&acc)[2][2][4][2], const Unit& u, int wr, int wc, int fr_, int fq_) const {
        int fr = fr_, fq = fq_; asm volatile("" : "+v"(fr), "+v"(fq));
        const int row0 = u.pm * BM + wr * 64 + fr, col0 = u.pn * BM + wc * 32 + 8 * fq;
#pragma unroll
        for (int ai = 0; ai < 2; ++ai)
#pragma unroll
            for (int m = 0; m < 4; ++m) { const size_t off = (size_t)(row0 + ai * HALF + m * 16) * ldc + col0;
#pragma unroll
                for (int bj = 0; bj < 2; ++bj) { const u32x2 a = *(const u32x2*)((const unsigned char*)ga + off + bj * HALF), b = *(const u32x2*)((const unsigned char*)gb + off + bj * HALF);
#define PG8_RATIO(x, y, k) ((float)(((x) >> (8 * (k))) & 255u) * __builtin_amdgcn_rcpf((float)(((y) >> (8 * (k))) & 255u)))
                    f32x4 r0, r1;
                    r0[0] = PG8_RATIO(a.x, b.x, 0); r0[1] = PG8_RATIO(a.x, b.x, 1); r0[2] = PG8_RATIO(a.x, b.x, 2); r0[3] = PG8_RATIO(a.x, b.x, 3);
                    r1[0] = PG8_RATIO(a.y, b.y, 0); r1[1] = PG8_RATIO(a.y, b.y, 1); r1[2] = PG8_RATIO(a.y, b.y, 2); r1[3] = PG8_RATIO(a.y, b.y, 3);
#undef PG8_RATIO
                    acc[ai][bj][m][0] = acc[ai][bj][m][0] * r0; acc[ai][bj][m][1] = acc[ai][bj][m][1] * r1; } }
    }
    __device__ __forceinline__ void operator()(const f32x4 (&acc)[2][2][4][2], const Unit& u, int wr, int wc, int fr_, int fq_) const {
        int fr = fr_, fq = fq_; asm volatile("" : "+v"(fr), "+v"(fq));
        const int row0 = u.pm * BM + wr * 64 + fr, col0 = u.pn * BM + wc * 32 + 8 * fq;
#pragma unroll
        for (int ai = 0; ai < 2; ++ai)
#pragma unroll
            for (int m = 0; m < 4; ++m) { const size_t off = (size_t)(row0 + ai * HALF + m * 16) * ldc + col0;
#pragma unroll
                for (int bj = 0; bj < 2; ++bj) { const u32x2 g = *(const u32x2*)((const unsigned char*)gb + off + bj * HALF);
                    const f32x4 v0 = acc[ai][bj][m][0], v1 = acc[ai][bj][m][1]; const float q = 1.0f / 255.0f;
                    f32x4 o0, o1;
                    o0[0] = v0[0] * ((float)(g.x & 255u) * q); o0[1] = v0[1] * ((float)((g.x >> 8) & 255u) * q); o0[2] = v0[2] * ((float)((g.x >> 16) & 255u) * q); o0[3] = v0[3] * ((float)(g.x >> 24) * q);
                    o1[0] = v1[0] * ((float)(g.y & 255u) * q); o1[1] = v1[1] * ((float)((g.y >> 8) & 255u) * q); o1[2] = v1[2] * ((float)((g.y >> 16) & 255u) * q); o1[3] = v1[3] * ((float)(g.y >> 24) * q);
                    u32x4 w; w.x = cvt_pk_bf16(o0[0], o0[1]); w.y = cvt_pk_bf16(o0[2], o0[3]); w.z = cvt_pk_bf16(o1[0], o1[1]); w.w = cvt_pk_bf16(o1[2], o1[3]);
                    *(u32x4*)(O + off + bj * HALF) = w; } }
    }
};
struct EpiOutProj {
    static constexpr bool PERM = true, AFTER_DRAIN = false;
    const bf16_t* xres; bf16_t* z; int ldc; float alpha;
    __device__ __forceinline__ void operator()(const f32x4 (&acc)[2][2][4][2], const Unit& u, int wr, int wc, int fr_, int fq_) const {
        int fr = fr_, fq = fq_; asm volatile("" : "+v"(fr), "+v"(fq));
        const int row0 = u.pm * BM + wr * 64 + fr, col0 = u.pn * BM + wc * 32 + 8 * fq;
#pragma unroll
        for (int ai = 0; ai < 2; ++ai)
#pragma unroll
            for (int m = 0; m < 4; ++m) { const size_t off = (size_t)(row0 + ai * HALF + m * 16) * ldc + col0;
#pragma unroll
                for (int bj = 0; bj < 2; ++bj) { const u32x4 x = *(const u32x4*)(xres + off + bj * HALF);
                    const f32x4 v0 = acc[ai][bj][m][0], v1 = acc[ai][bj][m][1];
                    f32x4 o0, o1;
                    o0[0] = v0[0] + alpha * __builtin_bit_cast(float, x.x << 16); o0[1] = v0[1] + alpha * __builtin_bit_cast(float, x.x & 0xffff0000u);
                    o0[2] = v0[2] + alpha * __builtin_bit_cast(float, x.y << 16); o0[3] = v0[3] + alpha * __builtin_bit_cast(float, x.y & 0xffff0000u);
                    o1[0] = v1[0] + alpha * __builtin_bit_cast(float, x.z << 16); o1[1] = v1[1] + alpha * __builtin_bit_cast(float, x.z & 0xffff0000u);
                    o1[2] = v1[2] + alpha * __builtin_bit_cast(float, x.w << 16); o1[3] = v1[3] + alpha * __builtin_bit_cast(float, x.w & 0xffff0000u);
                    u32x4 w; w.x = cvt_pk_bf16(o0[0], o0[1]); w.y = cvt_pk_bf16(o0[2], o0[3]); w.z = cvt_pk_bf16(o1[0], o1[1]); w.w = cvt_pk_bf16(o1[2], o1[3]);
                    *(u32x4*)(z + off + bj * HALF) = w; } }
    }
};
struct EpiInProj {
    static constexpr bool PERM = false, AFTER_DRAIN = false;
    bf16_t *qa, *ka, *qd, *kd, *ga, *gb; const float *cosA, *sinA, *cosB, *sinB; float qsa, qsb;
    __device__ __forceinline__ void operator()(const f32x4 (&acc)[2][2][4][2], const Unit& u, int wr, int wc, int fr_, int fq_) const {
        int fr = fr_, fq = fq_; asm volatile("" : "+v"(fr), "+v"(fq));
        const int row0 = u.pm * BM + wr * 64 + fr;
        const int ty = u.pn >> 2;
        if (ty >= 4) {
            unsigned char* dst = (unsigned char*)(ty < 6 ? ga : gb); const int col0 = (u.pn - (ty < 6 ? 16 : 24)) * BM + wc * 32 + 4 * fq; const float lo = ty < 6 ? 0.0f : 1.0f;
#pragma unroll
            for (int ai = 0; ai < 2; ++ai)
#pragma unroll
                for (int m = 0; m < 4; ++m) { unsigned char* rowp = dst + (size_t)(row0 + ai * HALF + m * 16) * 2048 + col0;
#pragma unroll
                    for (int bj = 0; bj < 2; ++bj)
#pragma unroll
                        for (int n = 0; n < 2; ++n) { const f32x4 v = acc[ai][bj][m][n]; unsigned w = 0u;
#pragma unroll
                            for (int j = 0; j < 4; ++j) { const float s = __builtin_amdgcn_rcpf(1.0f + __builtin_amdgcn_exp2f(-1.4426950408889634f * v[j]));
                                w |= (unsigned)fmaxf(s * 255.0f + 0.5f, lo) << (8 * j); }
                            *(unsigned*)(rowp + bj * HALF + n * 16) = w; } }
        } else if (ty < 2) {
            bf16_t* dst = ty == 0 ? qa : ka; const float sc = ty == 0 ? qsa : 1.0f;
            const int i0 = 16 * wc + 4 * fq;
#pragma unroll
            for (int ai = 0; ai < 2; ++ai)
#pragma unroll
                for (int m = 0; m < 4; ++m) { const int row = row0 + ai * HALF + m * 16;
                    const f32x4 c = *(const f32x4*)(cosA + (size_t)row * 64 + i0), s = *(const f32x4*)(sinA + (size_t)row * 64 + i0);
#pragma unroll
                    for (int bj = 0; bj < 2; ++bj) { const int head = 2 * (u.pn & 3) + bj; const f32x4 t1 = acc[ai][bj][m][0], t2 = acc[ai][bj][m][1];
                        const f32x4 o1 = t1 * c - t2 * s, o2 = t1 * s + t2 * c;
                        bf16_t* p = dst + (size_t)row * 1024 + head * 128 + i0;
                        u32x2 w1, w2; w1.x = cvt_pk_bf16(o1[0] * sc, o1[1] * sc); w1.y = cvt_pk_bf16(o1[2] * sc, o1[3] * sc); w2.x = cvt_pk_bf16(o2[0] * sc, o2[1] * sc); w2.y = cvt_pk_bf16(o2[2] * sc, o2[3] * sc);
                        *(u32x2*)p = w1; *(u32x2*)(p + 64) = w2;
                    } }
        } else {
            bf16_t* dst = ty == 2 ? qd : kd; const float sc = ty == 2 ? qsb : 1.0f;
            const int comp = wc >> 1, i0 = 16 * (wc & 1) + 4 * fq;
#pragma unroll
            for (int ai = 0; ai < 2; ++ai)
#pragma unroll
                for (int m = 0; m < 4; ++m) { const int row = row0 + ai * HALF + m * 16;
                    const f32x4 c = *(const f32x4*)(cosB + (size_t)row * 32 + i0), s = *(const f32x4*)(sinB + (size_t)row * 32 + i0);
#pragma unroll
                    for (int bj = 0; bj < 2; ++bj) { const int head = 2 * (u.pn & 3) + bj; const f32x4 t1 = acc[ai][bj][m][0], t2 = acc[ai][bj][m][1];
                        const f32x4 o1 = (t1 * c - t2 * s) * sc, o2 = (t1 * s + t2 * c) * sc;
                        bf16_t* p = dst + (size_t)row * 1024 + head * 128 + comp * 64 + i0;
                        u32x2 w1, w2; w1.x = cvt_pk_bf16(o1[0], o1[1]); w1.y = cvt_pk_bf16(o1[2], o1[3]); w2.x = cvt_pk_bf16(o2[0], o2[1]); w2.y = cvt_pk_bf16(o2[2], o2[3]);
                        *(u32x2*)p = w1; *(u32x2*)(p + 32) = w2;
                    } }
        }
    }
};

__device__ __forceinline__ f32x4 deq4(const i32x4& a, const f32x4& s) { return (f32x4){(float)a[0], (float)a[1], (float)a[2], (float)a[3]} * s; }
struct EpiPlainI8 {
    static constexpr bool PERM = true, AFTER_DRAIN = false;
    bf16_t* O; int ldc; const float* srow; const float* scol;
    __device__ __forceinline__ void operator()(const i32x4 (&acc)[2][2][4][2], const Unit& u, int wr, int wc, int fr_, int fq_) const {
        int fr = fr_, fq = fq_; asm volatile("" : "+v"(fr), "+v"(fq));
        const int row0 = u.pm * BM + wr * 64 + fr, col0 = u.pn * BM + wc * 32 + 8 * fq;
        f32x4 cs[2][2];
#pragma unroll
        for (int bj = 0; bj < 2; ++bj)
#pragma unroll
            for (int n = 0; n < 2; ++n) cs[bj][n] = *(const f32x4*)(scol + col0 + bj * HALF + 4 * n);
#pragma unroll
        for (int ai = 0; ai < 2; ++ai)
#pragma unroll
            for (int m = 0; m < 4; ++m) { const int row = row0 + ai * HALF + m * 16; const float sr = srow[row]; bf16_t* rowp = O + (size_t)row * ldc + col0;
#pragma unroll
                for (int bj = 0; bj < 2; ++bj) { const f32x4 v0 = deq4(acc[ai][bj][m][0], cs[bj][0] * sr), v1 = deq4(acc[ai][bj][m][1], cs[bj][1] * sr);
                    u32x4 w; w.x = cvt_pk_bf16(v0[0], v0[1]); w.y = cvt_pk_bf16(v0[2], v0[3]); w.z = cvt_pk_bf16(v1[0], v1[1]); w.w = cvt_pk_bf16(v1[2], v1[3]);
                    *(u32x4*)(rowp + bj * HALF) = w; } }
    }
};
struct EpiInProjI8 {
    static constexpr bool PERM = false, AFTER_DRAIN = false;
    bf16_t *qa, *ka, *qd, *kd, *ga, *gb; const float *cosA, *sinA, *cosB, *sinB; float qsa, qsb; const float *sx, *sw;
    __device__ __forceinline__ void operator()(const i32x4 (&acc)[2][2][4][2], const Unit& u, int wr, int wc, int fr_, int fq_) const {
        int fr = fr_, fq = fq_; asm volatile("" : "+v"(fr), "+v"(fq));
        const int row0 = u.pm * BM + wr * 64 + fr;
        const int ty = u.pn >> 2;
        f32x4 cs[2][2];
#pragma unroll
        for (int bj = 0; bj < 2; ++bj)
#pragma unroll
            for (int n = 0; n < 2; ++n) cs[bj][n] = *(const f32x4*)(sw + u.pn * BM + bj * HALF + wc * 32 + n * 16 + 4 * fq);
        if (ty >= 4) {
            unsigned char* dst = (unsigned char*)(ty < 6 ? ga : gb); const int col0 = (u.pn - (ty < 6 ? 16 : 24)) * BM + wc * 32 + 4 * fq; const float lo = ty < 6 ? 0.0f : 1.0f;
#pragma unroll
            for (int ai = 0; ai < 2; ++ai)
#pragma unroll
                for (int m = 0; m < 4; ++m) { const int row = row0 + ai * HALF + m * 16; const float sr = sx[row] * -1.4426950408889634f; unsigned char* rowp = dst + (size_t)row * 2048 + col0;
#pragma unroll
                    for (int bj = 0; bj < 2; ++bj)
#pragma unroll
                        for (int n = 0; n < 2; ++n) { const f32x4 v = deq4(acc[ai][bj][m][n], cs[bj][n] * sr); unsigned w = 0u;
#pragma unroll
                            for (int j = 0; j < 4; ++j) { const float s = __builtin_amdgcn_rcpf(1.0f + __builtin_amdgcn_exp2f(v[j]));
                                w |= (unsigned)fmaxf(s * 255.0f + 0.5f, lo) << (8 * j); }
                            *(unsigned*)(rowp + bj * HALF + n * 16) = w; } }
        } else if (ty < 2) {
            bf16_t* dst = ty == 0 ? qa : ka; const float sc = ty == 0 ? qsa : 1.0f;
            const int i0 = 16 * wc + 4 * fq;
#pragma unroll
            for (int ai = 0; ai < 2; ++ai)
#pragma unroll
                for (int m = 0; m < 4; ++m) { const int row = row0 + ai * HALF + m * 16; const float sr = sx[row] * sc;
                    const f32x4 c = *(const f32x4*)(cosA + (size_t)row * 64 + i0), s = *(const f32x4*)(sinA + (size_t)row * 64 + i0);
#pragma unroll
                    for (int bj = 0; bj < 2; ++bj) { const int head = 2 * (u.pn & 3) + bj; const f32x4 t1 = deq4(acc[ai][bj][m][0], cs[bj][0] * sr), t2 = deq4(acc[ai][bj][m][1], cs[bj][1] * sr);
                        const f32x4 o1 = t1 * c - t2 * s, o2 = t1 * s + t2 * c;
                        bf16_t* p = dst + (size_t)row * 1024 + head * 128 + i0;
                        u32x2 w1, w2; w1.x = cvt_pk_bf16(o1[0], o1[1]); w1.y = cvt_pk_bf16(o1[2], o1[3]); w2.x = cvt_pk_bf16(o2[0], o2[1]); w2.y = cvt_pk_bf16(o2[2], o2[3]);
                        *(u32x2*)p = w1; *(u32x2*)(p + 64) = w2;
                    } }
        } else {
            bf16_t* dst = ty == 2 ? qd : kd; const float sc = ty == 2 ? qsb : 1.0f;
            const int comp = wc >> 1, i0 = 16 * (wc & 1) + 4 * fq;
#pragma unroll
            for (int ai = 0; ai < 2; ++ai)
#pragma unroll
                for (int m = 0; m < 4; ++m) { const int row = row0 + ai * HALF + m * 16; const float sr = sx[row] * sc;
                    const f32x4 c = *(const f32x4*)(cosB + (size_t)row * 32 + i0), s = *(const f32x4*)(sinB + (size_t)row * 32 + i0);
#pragma unroll
                    for (int bj = 0; bj < 2; ++bj) { const int head = 2 * (u.pn & 3) + bj; const f32x4 t1 = deq4(acc[ai][bj][m][0], cs[bj][0] * sr), t2 = deq4(acc[ai][bj][m][1], cs[bj][1] * sr);
                        const f32x4 o1 = t1 * c - t2 * s, o2 = t1 * s + t2 * c;
                        bf16_t* p = dst + (size_t)row * 1024 + head * 128 + comp * 64 + i0;
                        u32x2 w1, w2; w1.x = cvt_pk_bf16(o1[0], o1[1]); w1.y = cvt_pk_bf16(o1[2], o1[3]); w2.x = cvt_pk_bf16(o2[0], o2[1]); w2.y = cvt_pk_bf16(o2[2], o2[3]);
                        *(u32x2*)p = w1; *(u32x2*)(p + 32) = w2;
                    } }
        }
    }
};
template <class Epi, class Sched, bool ALIGN_EPI = false, bool SP2 = false, bool MID = false, bool I8 = false>
__device__ __forceinline__ void gemm_phase(PG8_LAS unsigned char* lds, const Gemm g, const Sched& S, const Epi& E, int wave) {
    int tid_ = lane_id(); asm volatile("" : "+v"(tid_)); tid_ += 64 * wave;
    const int tid = tid_, wid = __builtin_amdgcn_readfirstlane(tid >> 6), lane = tid & 63, wr = wid >> 2, wc = wid & 3, fr = lane & 15, fq = lane >> 4;
    const int K = g.K, nt = K / BK;
    unsigned voffA[2], voffB[2];
#pragma unroll
    for (int i = 0; i < 2; ++i) { int R, C; stage_rc(tid * 16 + i * 8192, R, C); const int Rb = Epi::PERM ? ((R & ~31) + perm32(R & 31)) : R;
        voffA[i] = (unsigned)(R * K + C) * 2u; voffB[i] = (unsigned)(Rb * K + C) * 2u; }
    const size_t kstep = (size_t)(BK * 2);
    const size_t hstep = (size_t)HALF * K * 2;
    const size_t tstep = 2 * hstep;
    const unsigned ldsw = (unsigned)wid * 1024u;
    const int aoff = lds_byte(wr * 64 + fr, fq * 8), boff = lds_byte(wc * 32 + fr, fq * 8);
#define PG8_SA(b, h) (((b) * 2 + (h)) * HTB)
#define PG8_SB(b, h) ((4 + (b) * 2 + (h)) * HTB)
#define PG8_STAGE(bufoff, gbase, voff) do { _Pragma("unroll") for (int _i = 0; _i < 2; ++_i) \
        __builtin_amdgcn_global_load_lds((const unsigned*)((const char*)(gbase) + (voff)[_i]), (PG8_LAS unsigned*)(lds + (bufoff) + ldsw + _i * 8192), 16, 0, 0); } while (0)
#define PG8_LDA(dst, b, h) do { _Pragma("unroll") for (int m = 0; m < 4; ++m) _Pragma("unroll") for (int k = 0; k < 2; ++k) dst[m][k] = *(const PG8_LAS bf16x8*)(lds + PG8_SA(b, h) + aoff + m * 2048 + k * 1024); } while (0)
#define PG8_LDB(dst, b, h) do { _Pragma("unroll") for (int n = 0; n < 2; ++n) _Pragma("unroll") for (int k = 0; k < 2; ++k) dst[n][k] = *(const PG8_LAS bf16x8*)(lds + PG8_SB(b, h) + boff + n * 2048 + k * 1024); } while (0)
#define PG8_MMA(ai, bj, At, Bt) do { __builtin_amdgcn_s_setprio(1); _Pragma("unroll") for (int m = 0; m < 4; ++m) _Pragma("unroll") for (int n = 0; n < 2; ++n) _Pragma("unroll") for (int k = 0; k < 2; ++k) \
        acc[ai][bj][m][n] = mma16<I8>(Bt[n][k], At[m][k], acc[ai][bj][m][n]); __builtin_amdgcn_s_setprio(0); } while (0)
#define PG8_WAIT_V(n) asm volatile("s_waitcnt vmcnt(" #n ")" ::: "memory")
#define PG8_WAIT_L(n) asm volatile("s_waitcnt lgkmcnt(" #n ")" ::: "memory")
#define PG8_BAR __builtin_amdgcn_s_barrier()
#define PG8_SCHED __builtin_amdgcn_sched_barrier(0)
    Unit cur, nxt; int ui = 0;
    if (!S.next(0, cur)) return;
    typedef typename AccSel<I8>::type acc_t;
    acc_t acc[2][2][4][2];
#pragma unroll
    for (int a = 0; a < 2; ++a)
#pragma unroll
        for (int b = 0; b < 2; ++b)
#pragma unroll
            for (int m = 0; m < 4; ++m)
#pragma unroll
                for (int n = 0; n < 2; ++n) acc[a][b][m][n] = (acc_t){0, 0, 0, 0};
    bf16x8 At[4][2], B0[2][2], B1[2][2];
    const char* cA = (const char*)g.A + (size_t)cur.pm * tstep; const char* cB = (const char*)g.Bt + (size_t)cur.pn * tstep;
    S.a_ready(cur);
    if constexpr (SP2) {
        PG8_STAGE(PG8_SB(0, 0), cB, voffB); PG8_STAGE(PG8_SB(0, 1), cB + hstep, voffB); PG8_STAGE(PG8_SA(0, 0), cA, voffA); PG8_STAGE(PG8_SA(0, 1), cA + hstep, voffA);
        if (wr == 1) PG8_BAR;
        PG8_WAIT_V(2); PG8_BAR;
        PG8_STAGE(PG8_SB(1, 0), cB + kstep, voffB); PG8_STAGE(PG8_SA(1, 0), cA + kstep, voffA); PG8_STAGE(PG8_SB(1, 1), cB + hstep + kstep, voffB);
        PG8_WAIT_V(6); PG8_BAR;
    } else {
        PG8_STAGE(PG8_SB(0, 0), cB, voffB); PG8_STAGE(PG8_SA(0, 0), cA, voffA); PG8_STAGE(PG8_SB(0, 1), cB + hstep, voffB); PG8_STAGE(PG8_SA(0, 1), cA + hstep, voffA);
        if (wr == 1) PG8_BAR;
        PG8_WAIT_V(4); PG8_BAR;
        PG8_STAGE(PG8_SB(1, 0), cB + kstep, voffB); PG8_STAGE(PG8_SA(1, 0), cA + kstep, voffA); PG8_STAGE(PG8_SB(1, 1), cB + hstep + kstep, voffB);
        PG8_WAIT_V(6); PG8_BAR;
    }
    for (;;) {
        const bool has_next = S.next(ui + 1, nxt);
        const char* nA = has_next ? (const char*)g.A + (size_t)nxt.pm * tstep : cA; const char* nB = has_next ? (const char*)g.Bt + (size_t)nxt.pn * tstep : cB;
        for (int t = 0; t < nt; t += 2) {
            if constexpr (MID) { if (t == nt / 2) E.mid(acc, cur, wr, wc, fr, fq); }
            const bool last = (t == nt - 2);
            const char* a1 = cA + (size_t)(t + 1) * kstep;
            const char* a2 = last ? nA : cA + (size_t)(t + 2) * kstep; const char* b2 = last ? nB : cB + (size_t)(t + 2) * kstep;
            const char* a3 = a2 + kstep; const char* b3 = b2 + kstep;
            if (last && has_next) S.a_ready(nxt);
            if constexpr (SP2) {
            PG8_LDB(B0, 0, 0); PG8_LDB(B1, 0, 1); PG8_SCHED; PG8_LDA(At, 0, 0); PG8_STAGE(PG8_SA(1, 1), a1 + hstep, voffA);
            PG8_WAIT_V(8); PG8_WAIT_L(0); PG8_BAR; PG8_MMA(0, 0, At, B0); PG8_MMA(0, 1, At, B1); PG8_BAR; PG8_SCHED;
            PG8_LDA(At, 0, 1); PG8_STAGE(PG8_SB(0, 0), b2, voffB); PG8_STAGE(PG8_SB(0, 1), b2 + hstep, voffB); PG8_STAGE(PG8_SA(0, 0), a2, voffA);
            PG8_WAIT_V(8); PG8_WAIT_L(0); PG8_BAR; PG8_MMA(1, 0, At, B0); PG8_MMA(1, 1, At, B1); PG8_BAR; PG8_SCHED;
            PG8_LDB(B0, 1, 0); PG8_LDB(B1, 1, 1); PG8_SCHED; PG8_LDA(At, 1, 0); PG8_STAGE(PG8_SA(0, 1), a2 + hstep, voffA);
            PG8_WAIT_V(8); PG8_WAIT_L(0); PG8_BAR; PG8_MMA(0, 0, At, B0); PG8_MMA(0, 1, At, B1); PG8_BAR; PG8_SCHED;
            PG8_LDA(At, 1, 1); PG8_STAGE(PG8_SB(1, 0), b3, voffB); PG8_STAGE(PG8_SB(1, 1), b3 + hstep, voffB); PG8_STAGE(PG8_SA(1, 0), a3, voffA);
            PG8_WAIT_V(8); PG8_WAIT_L(0); PG8_BAR; PG8_MMA(1, 0, At, B0); PG8_MMA(1, 1, At, B1); PG8_BAR; PG8_SCHED;
            } else {
            PG8_LDB(B0, 0, 0); PG8_SCHED; PG8_LDA(At, 0, 0); PG8_STAGE(PG8_SA(1, 1), a1 + hstep, voffA);
            PG8_WAIT_L(8); PG8_BAR; PG8_WAIT_L(0); PG8_MMA(0, 0, At, B0); PG8_BAR; PG8_SCHED;
            PG8_LDB(B1, 0, 1); PG8_STAGE(PG8_SB(0, 0), b2, voffB);
            PG8_BAR; PG8_WAIT_L(0); PG8_MMA(0, 1, At, B1); PG8_BAR;
            PG8_LDA(At, 0, 1); PG8_STAGE(PG8_SA(0, 0), a2, voffA);
            PG8_BAR; PG8_WAIT_L(0); PG8_MMA(1, 0, At, B0); PG8_BAR; PG8_SCHED;
            PG8_STAGE(PG8_SB(0, 1), b2 + hstep, voffB);
            PG8_WAIT_V(6); PG8_BAR; PG8_MMA(1, 1, At, B1); PG8_BAR;
            PG8_LDB(B0, 1, 0); PG8_SCHED; PG8_LDA(At, 1, 0); PG8_STAGE(PG8_SA(0, 1), a2 + hstep, voffA);
            PG8_WAIT_L(8); PG8_BAR; PG8_WAIT_L(0); PG8_MMA(0, 0, At, B0); PG8_BAR; PG8_SCHED;
            PG8_LDB(B1, 1, 1); PG8_STAGE(PG8_SB(1, 0), b3, voffB);
            PG8_BAR; PG8_WAIT_L(0); PG8_MMA(0, 1, At, B1); PG8_BAR;
            PG8_LDA(At, 1, 1); PG8_STAGE(PG8_SA(1, 0), a3, voffA);
            PG8_BAR; PG8_WAIT_L(0); PG8_MMA(1, 0, At, B0); PG8_BAR; PG8_SCHED;
            PG8_STAGE(PG8_SB(1, 1), b3 + hstep, voffB);
            PG8_WAIT_V(6); PG8_BAR; PG8_MMA(1, 1, At, B1); PG8_BAR;
            }
        }
        if constexpr (ALIGN_EPI) { if (wr == 0) PG8_BAR; }
        if constexpr (!Epi::AFTER_DRAIN) { E(acc, cur, wr, wc, fr, fq); S.done(cur); }
        if (!has_next) break;
#pragma unroll
        for (int a = 0; a < 2; ++a)
#pragma unroll
            for (int b = 0; b < 2; ++b)
#pragma unroll
                for (int m = 0; m < 4; ++m)
#pragma unroll
                    for (int n = 0; n < 2; ++n) acc[a][b][m][n] = (acc_t){0, 0, 0, 0};
        cur = nxt; cA = nA; cB = nB; ++ui;
        if constexpr (ALIGN_EPI) { if (wr == 1) PG8_BAR; }
    }
    PG8_WAIT_V(0);
    if constexpr (!ALIGN_EPI) { if (wr == 0) PG8_BAR; }
    PG8_BAR;
    if constexpr (Epi::AFTER_DRAIN) { E.fused(acc, cur, wr, wc, fr, fq, lds, wid, lane); S.done(cur); }
#undef PG8_SA
#undef PG8_SB
#undef PG8_STAGE
#undef PG8_LDA
#undef PG8_LDB
#undef PG8_MMA
#undef PG8_WAIT_V
#undef PG8_WAIT_L
#undef PG8_BAR
#undef PG8_SCHED
}
}
#define XB_TMO      128
#define XB_XCNT(j)  (256  + 64 * (j))
#define XB_XSUB(j)  (1280 + 64 * (j))
#define XB_XGEN(j)  (2304 + 64 * (j))
#define XB_TOP      3328
#define XB_TOPGEN   3392
#define XCD_BAR_WORDS 3456
#define XB_SPIN_CAP (1u << 18)

__device__ __forceinline__ unsigned xb_ld(unsigned* p)              { return __hip_atomic_load(p, __ATOMIC_RELAXED, __HIP_MEMORY_SCOPE_AGENT); }
__device__ __forceinline__ unsigned xb_add(unsigned* p, unsigned v) { return __hip_atomic_fetch_add(p, v, __ATOMIC_RELAXED, __HIP_MEMORY_SCOPE_AGENT); }
__device__ __forceinline__ unsigned xb_xcc_id() { return (unsigned)__builtin_amdgcn_s_getreg((3 << 11) | 20) & 0xFu; }
#define XB_SPIN(cond, bar) do { unsigned _sp = 0; while (cond) { __builtin_amdgcn_s_sleep(1); \
    if ((++_sp & 255u) == 0u) { if (xb_ld(&(bar)[XB_TMO])) break; if (_sp > XB_SPIN_CAP) { atomicAdd(&(bar)[XB_TMO], 1u); break; } } } } while (0)

struct XcdBarrier {
    unsigned* bar; unsigned x; unsigned wv;
    volatile LAS unsigned* st;
};

__device__ __forceinline__ XcdBarrier xcd_barrier_post(unsigned* bar, volatile LAS unsigned* st, unsigned wave) {
    XcdBarrier b; b.bar = bar; b.x = xb_xcc_id(); b.st = st; b.wv = wave;
    if (threadIdx.x == 0) (void)xb_add(&bar[XB_XCNT(b.x)], 1u);
    return b;
}
__device__ __forceinline__ void xcd_barrier_complete(unsigned* bar, unsigned x, unsigned& nloc, unsigned& nx) {
    const unsigned G = gridDim.x * gridDim.y * gridDim.z;
    unsigned sum, cnt, mine, sp = 0u;
    for (;;) {
        sum = 0u; cnt = 0u; mine = 0u;
#pragma unroll 1
        for (unsigned j = 0; j < 16; ++j) { const unsigned c = xb_ld(&bar[XB_XCNT(j)]); sum += c; cnt += (c > 0u) ? 1u : 0u; mine = (j == x) ? c : mine; }
        if (sum == G) break;
        __builtin_amdgcn_s_sleep(1);
        if ((++sp & 255u) == 0u) { if (xb_ld(&bar[XB_TMO])) break; if (sp > XB_SPIN_CAP) { atomicAdd(&bar[XB_TMO], 1u); break; } }
    }
    nloc = mine > 0u ? mine : 1u; nx = cnt > 0u ? cnt : 1u;
}

__device__ __forceinline__ void xcd_barrier(const XcdBarrier& b) {
    asm volatile("s_waitcnt vmcnt(0)" ::: "memory");
    __syncthreads();
    if (b.wv == 0u && lane_id() == 0) {
        unsigned* bar = b.bar;
        __builtin_amdgcn_s_waitcnt(0);
        unsigned nloc = b.st[0], nx = b.st[1];
        if (nloc == 0u) { xcd_barrier_complete(bar, b.x, nloc, nx); b.st[0] = nloc; b.st[1] = nx; }
        const unsigned old = xb_add(&bar[XB_XSUB(b.x)], 1u);
        const unsigned gen = old / nloc;
        if (old + 1u == (gen + 1u) * nloc) {
            __builtin_amdgcn_fence(__ATOMIC_RELEASE, "agent");
            asm volatile("s_waitcnt vmcnt(0)" ::: "memory");
            const unsigned og = xb_add(&bar[XB_TOP], 1u);
            const unsigned tg = og / nx;
            if (og + 1u == (tg + 1u) * nx) xb_add(&bar[XB_TOPGEN], 1u);
            else XB_SPIN(xb_ld(&bar[XB_TOPGEN]) == tg, bar);
            __builtin_amdgcn_fence(__ATOMIC_ACQUIRE, "agent");
            xb_add(&bar[XB_XGEN(b.x)], 1u);
            asm volatile("s_waitcnt vmcnt(0)" ::: "memory");
        } else {
            XB_SPIN(xb_ld(&bar[XB_XGEN(b.x)]) == gen, bar);
            __builtin_amdgcn_fence(__ATOMIC_ACQUIRE, "agent");
            asm volatile("s_waitcnt vmcnt(0)" ::: "memory");
        }
    }
    __syncthreads();
}


struct Frame {
    LAS unsigned char* lds;
    volatile LAS unsigned* MISC;
    gu32* ctl;
    int tid, lane, wave;
    int vcu, G;
    unsigned char* ws;
};

__device__ __forceinline__ int inproj_row(int n) {
    const int seg = n >> 10, r = n & 1023;
    if (seg >= 6) return (seg < 8 ? 4096 : 6144) + (n - (seg < 8 ? 6144 : 8192));
    if (seg == 2) return 8192 + r;
    if (seg == 5) return 8192 + 1024 + r;
    const int head = r >> 7, d = r & 127;
    if (seg < 2) return seg * 1024 + head * 128 + 32 * ((d >> 4) & 3) + 16 * (d >> 6) + (d & 15);
    return (seg - 1) * 1024 + head * 128 + 32 * (2 * (d >> 6) + ((d >> 4) & 1)) + 16 * ((d >> 5) & 1) + (d & 15);
}
template <bool MAP>
__device__ __forceinline__ void p0_transpose_item(const float* W, int K, int N, bf16* WT, LAS float* scr, int item, int lane, int ldk = 0, int koff = 0) {
    if (ldk == 0) ldk = K;
    const int nblk = N / 32, kb = item / nblk, nb = item % nblk, k0 = 64 * kb, n0 = 32 * nb;
#pragma unroll 8
    for (int i = 0; i < 32; ++i) { const int kk = 2 * i + (lane >> 5); scr[kk * 33 + (lane & 31)] = W[(size_t)(k0 + kk) * N + n0 + (lane & 31)]; }
    LDS_WAIT(); asm volatile("" ::: "memory");
    const int c = lane & 7;
#pragma unroll
    for (int j = 0; j < 4; ++j) { const int n = (lane >> 3) + 8 * j; const LAS float* s = scr + (8 * c) * 33 + n;
        v4u o; o.x = pk2(s[0 * 33], s[1 * 33]); o.y = pk2(s[2 * 33], s[3 * 33]); o.z = pk2(s[4 * 33], s[5 * 33]); o.w = pk2(s[6 * 33], s[7 * 33]);
        const int dr = MAP ? inproj_row(n0 + n) : (n0 + n);
        *(GAS v4u*)(WT + (size_t)dr * ldk + koff + k0 + 8 * c) = o; }
    LDS_WAIT(); asm volatile("" ::: "memory");
}
__device__ __forceinline__ void p0_convert(const float* src, bf16* dst, size_t n8, size_t gtid, size_t gthreads) {
    for (size_t i = gtid; i < n8; i += gthreads) {
        const f32x4 a = *(const GAS f32x4*)(src + i * 8), b = *(const GAS f32x4*)(src + i * 8 + 4);
        v4u o; o.x = pk2(a[0], a[1]); o.y = pk2(a[2], a[3]); o.z = pk2(b[0], b[1]); o.w = pk2(b[2], b[3]);
        *(GAS v4u*)(dst + i * 8) = o;
    }
}

__device__ __forceinline__ void p0_table_row(const float* src, unsigned char* dst, float* scale_out, int lane) {
    f32x4 v[8]; float am = 0.f;
#pragma unroll
    for (int q = 0; q < 8; ++q) { v[q] = *(const GAS f32x4*)(src + 32 * lane + 4 * q);
        am = fmaxf(am, fmaxf(fmaxf(fabsf(v[q][0]), fabsf(v[q][1])), fmaxf(fabsf(v[q][2]), fabsf(v[q][3])))); }
#pragma unroll
    for (int o = 1; o < 64; o <<= 1) am = fmaxf(am, __shfl_xor(am, o));
    const float sc = am > 0.f ? 6.0f / am : 1.0f;
    v4u o;
#pragma unroll
    for (int wq = 0; wq < 4; ++wq) { unsigned w = 0u;
        w = __builtin_amdgcn_cvt_scalef32_pk_fp4_f32(w, v[2 * wq][0] * sc, v[2 * wq][1] * sc, 1.0f, 0);
        w = __builtin_amdgcn_cvt_scalef32_pk_fp4_f32(w, v[2 * wq][2] * sc, v[2 * wq][3] * sc, 1.0f, 1);
        w = __builtin_amdgcn_cvt_scalef32_pk_fp4_f32(w, v[2 * wq + 1][0] * sc, v[2 * wq + 1][1] * sc, 1.0f, 2);
        w = __builtin_amdgcn_cvt_scalef32_pk_fp4_f32(w, v[2 * wq + 1][2] * sc, v[2 * wq + 1][3] * sc, 1.0f, 3);
        o[wq] = w; }
    *(GAS v4u*)(dst + 16 * lane) = o;
    if (lane == 0) *scale_out = am > 0.f ? am / 6.0f : 1.0f;
}

__device__ __forceinline__ unsigned q8pack(float a, float b, float c, float d, float s) {
    const int ia = (int)__builtin_rintf(a * s), ib = (int)__builtin_rintf(b * s), ic = (int)__builtin_rintf(c * s), id = (int)__builtin_rintf(d * s);
    return ((unsigned)ia & 255u) | (((unsigned)ib & 255u) << 8) | (((unsigned)ic & 255u) << 16) | ((unsigned)id << 24);
}
__device__ __forceinline__ void p0_absmax_item(const float* W, int item, int lane, gu32* wmax) {
    const int kc = item / 40, nc = item % 40, n0 = 256 * nc + 4 * lane;
    const float* p = W + (size_t)(128 * kc) * 10240 + n0;
    f32x4 am = (f32x4){0.f, 0.f, 0.f, 0.f};
#pragma unroll 16
    for (int r = 0; r < 128; ++r) { const f32x4 v = *(const GAS f32x4*)(p + (size_t)r * 10240);
        am[0] = fmaxf(am[0], fabsf(v[0])); am[1] = fmaxf(am[1], fabsf(v[1])); am[2] = fmaxf(am[2], fabsf(v[2])); am[3] = fmaxf(am[3], fabsf(v[3])); }
#pragma unroll
    for (int j = 0; j < 4; ++j) (void)__hip_atomic_fetch_max(wmax + n0 + j, __builtin_bit_cast(unsigned, am[j]), RLX_AGENT);
}
__device__ __forceinline__ void p0_transpose_item_i8(const float* W, int K, int N, unsigned char* W8, LAS float* scr, int item, int lane, const gu32* wmax) {
    const int nblk = N / 32, kb = item / nblk, nb = item % nblk, k0 = 64 * kb, n0 = 32 * nb;
#pragma unroll 8
    for (int i = 0; i < 32; ++i) { const int kk = 2 * i + (lane >> 5); scr[kk * 33 + (lane & 31)] = W[(size_t)(k0 + kk) * N + n0 + (lane & 31)]; }
    LDS_WAIT(); asm volatile("" ::: "memory");
    const int c = lane & 7;
#pragma unroll
    for (int j = 0; j < 4; ++j) { const int n = (lane >> 3) + 8 * j; const LAS float* s = scr + (8 * c) * 33 + n;
        const float am = __builtin_bit_cast(float, wmax[n0 + n]); const float sc = am > 0.f ? 127.0f / am : 0.f;
        v2u o; o.x = q8pack(s[0 * 33], s[1 * 33], s[2 * 33], s[3 * 33], sc); o.y = q8pack(s[4 * 33], s[5 * 33], s[6 * 33], s[7 * 33], sc);
        *(GAS v2u*)(W8 + (size_t)inproj_row(n0 + n) * K + k0 + 8 * c) = o; }
    LDS_WAIT(); asm volatile("" ::: "memory");
}
__device__ __forceinline__ void p0_x_row(const float* src, bf16* dstb, unsigned char* dst8, float* sx, int lane) {
    f32x4 v[8]; float am = 0.f;
#pragma unroll
    for (int j = 0; j < 8; ++j) { v[j] = *(const GAS f32x4*)(src + 256 * j + 4 * lane);
        am = fmaxf(am, fmaxf(fmaxf(fabsf(v[j][0]), fabsf(v[j][1])), fmaxf(fabsf(v[j][2]), fabsf(v[j][3])))); }
#pragma unroll
    for (int o = 1; o < 64; o <<= 1) am = fmaxf(am, __shfl_xor(am, o));
    const float sc = am > 0.f ? 127.0f / am : 0.f;
#pragma unroll
    for (int j = 0; j < 8; ++j) { *(GAS v2u*)(dstb + 256 * j + 4 * lane) = (v2u){pk2(v[j][0], v[j][1]), pk2(v[j][2], v[j][3])};
        *(GAS unsigned*)(dst8 + 256 * j + 4 * lane) = q8pack(v[j][0], v[j][1], v[j][2], v[j][3], sc); }
    if (lane == 0) *sx = am * (1.0f / 127.0f);
}

namespace att {
constexpr int KB0 = 0, VB0 = 32768, KMT = 65536, QFR = 65536;
__device__ __forceinline__ int crow(int r, int hi) { return (r & 3) + 8 * (r >> 2) + 4 * hi; }
__device__ __forceinline__ unsigned cvtpk(float lo, float hi) { return pg8::cvt_pk_bf16(lo, hi); }

template <int DQK, bool MOBA>
__device__ __forceinline__ void attn_pass(LAS unsigned char* lds, const bf16* Qg, const bf16* Kg, const bf16* Vtg, int q0, unsigned sel, f32x16 (&o)[4], int tid, int wid, int lane) {
    constexpr int NS = DQK / 16, RB = DQK * 2, KCH = DQK / 8;
    constexpr float THR = 8.0f;
    const int r32 = lane & 31, hi = lane >> 5;
    const int qpos = q0 + 32 * wid + r32;
    const int own = q0 >> 8;
    const LAS unsigned char* qlds = lds + QFR + wid * 8192 + lane * 16;
    { const bf16* qp = Qg + (size_t)(32 * wid + r32) * 1024 + 8 * hi;
#pragma unroll
      for (int s = 0; s < NS; ++s) *(LAS bf16x8*)(lds + QFR + wid * 8192 + lane * 16 + s * 1024) = *(const GAS bf16x8*)(qp + 16 * s); }
#pragma unroll
    for (int d = 0; d < 4; ++d) o[d] = (f32x16){0.f,0.f,0.f,0.f,0.f,0.f,0.f,0.f,0.f,0.f,0.f,0.f,0.f,0.f,0.f,0.f};
    f32x16 negm = (f32x16){0.f,0.f,0.f,0.f,0.f,0.f,0.f,0.f,0.f,0.f,0.f,0.f,0.f,0.f,0.f,0.f};
    float l_run = 0.f;
    const int nt = MOBA ? 4 + 4 * own : (q0 + 256) / 64;
    constexpr int NKC = (64 * KCH) / 512;
    v4u kreg[NKC], vreg[2];
    unsigned kgo[NKC], vgo[2]; int klds[NKC], vl0[2], vl1[2];
#pragma unroll
    for (int i = 0; i < NKC; ++i) { const int cid = tid + 512 * i, key = cid / KCH, ch = cid % KCH;
        const int swz = (DQK == 128) ? (key & 15) : ((key >> 1) & 7);
        kgo[i] = (unsigned)(key * 1024 + ch * 8) * 2u; klds[i] = key * RB + ((ch ^ swz) << 4); }
#pragma unroll
    for (int i = 0; i < 2; ++i) { const int cid = tid + 512 * i, d = cid >> 3, g = cid & 7;
        const int c = (g >> 2) * 4 + ((g >> 1) & 1) * 2, sw = (d >> 1) & 7, e = g & 1;
        vgo[i] = (unsigned)(d * T + g * 8) * 2u; vl0[i] = d * 128 + ((c ^ sw) << 4) + 8 * e; vl1[i] = d * 128 + (((c + 1) ^ sw) << 4) + 8 * e; }
#define KTILE(i) (MOBA ? ((i) < 4 ? own * 4 + (i) : (i) - 4) : (i))
#define ATT_LOAD(kt) do { const GAS unsigned char* kb_ = (const GAS unsigned char*)Kg + (size_t)(kt) * 131072; const GAS unsigned char* vb_ = (const GAS unsigned char*)Vtg + (size_t)(kt) * 128; \
                          _Pragma("unroll") for (int i_ = 0; i_ < NKC; ++i_) kreg[i_] = *(const GAS v4u*)(kb_ + kgo[i_]); \
                          _Pragma("unroll") for (int i_ = 0; i_ < 2; ++i_) vreg[i_] = *(const GAS v4u*)(vb_ + vgo[i_]); } while (0)
#define ATT_STORE(buf) do { _Pragma("unroll") for (int i_ = 0; i_ < NKC; ++i_) *(LAS v4u*)(lds + KB0 + (buf) * 16384 + klds[i_]) = kreg[i_]; \
                            _Pragma("unroll") for (int i_ = 0; i_ < 2; ++i_) { *(LAS v2u*)(lds + VB0 + (buf) * 16384 + vl0[i_]) = (v2u){vreg[i_].x, vreg[i_].y}; \
                                                                              *(LAS v2u*)(lds + VB0 + (buf) * 16384 + vl1[i_]) = (v2u){vreg[i_].z, vreg[i_].w}; } } while (0)
    ATT_LOAD(KTILE(0)); ATT_STORE(0);
    __syncthreads();
    const int kswz = (DQK == 128) ? (r32 & 15) : ((r32 >> 1) & 7);
    const int vsw = (r32 >> 1) & 7;
    const int kfo = r32 * RB, vfo = r32 * 128;
#define ATT_STEP(BUF) do { \
        const int kt = KTILE(it); const bool more = it + 1 < nt; \
        if (more) ATT_LOAD(KTILE(it + 1)); \
        const int blk = kt >> 2; bool need; \
        if (!MOBA || it < 4) need = (kt * 64 <= q0 + 32 * wid + 31); else need = __any((sel >> blk) & 1u); \
        if (need) { \
            f32x16 p0, p1; \
            const LAS unsigned char* kb = lds + KB0 + (BUF) * 16384 + kfo; \
              \
            bf16x8 fk0[2], fk1[2], fqv[2]; \
            { const int ch = ((0 + hi) ^ kswz) << 4; fk0[0] = *(const LAS bf16x8*)(kb + ch); fk1[0] = *(const LAS bf16x8*)(kb + 32 * RB + ch); fqv[0] = *(const LAS bf16x8*)(qlds); } \
            _Pragma("unroll") for (int s = 0; s < NS; ++s) { \
                if (s + 1 < NS) { const int ch = ((2 * (s + 1) + hi) ^ kswz) << 4; \
                    fk0[(s + 1) & 1] = *(const LAS bf16x8*)(kb + ch); fk1[(s + 1) & 1] = *(const LAS bf16x8*)(kb + 32 * RB + ch); fqv[(s + 1) & 1] = *(const LAS bf16x8*)(qlds + (s + 1) * 1024); } \
                __builtin_amdgcn_sched_barrier(0); \
                if (s == 0) {   \
                    asm volatile("v_mfma_f32_32x32x16_bf16 %0, %1, %2, %3" : "=&v"(p0) : "v"(fk0[0]), "v"(fqv[0]), "v"(negm)); \
                    asm volatile("v_mfma_f32_32x32x16_bf16 %0, %1, %2, %3" : "=&v"(p1) : "v"(fk1[0]), "v"(fqv[0]), "v"(negm)); } \
                else { p0 = __builtin_amdgcn_mfma_f32_32x32x16_bf16(fk0[s & 1], fqv[s & 1], p0, 0, 0, 0); p1 = __builtin_amdgcn_mfma_f32_32x32x16_bf16(fk1[s & 1], fqv[s & 1], p1, 0, 0, 0); } \
                __builtin_amdgcn_sched_barrier(0); } \
            if (!MOBA || it < 4) { \
                if (kt * 64 + 63 > q0 + 32 * wid) { const int kbase = kt * 64 + 4 * hi; \
                    _Pragma("unroll") for (int r = 0; r < 16; ++r) { const int kv = kbase + (r & 3) + 8 * (r >> 2); if (kv > qpos) p0[r] = -INFINITY; if (kv + 32 > qpos) p1[r] = -INFINITY; } } \
            } else { if (!((sel >> blk) & 1u)) { _Pragma("unroll") for (int r = 0; r < 16; ++r) { p0[r] = -INFINITY; p1[r] = -INFINITY; } } } \
            float rm = fmaxf(fmaxf(p0[0], p0[1]), p1[0]); \
            _Pragma("unroll") for (int r = 1; r < 16; ++r) rm = fmaxf(fmaxf(rm, p0[r]), p1[r]); \
            { const unsigned rb = __builtin_bit_cast(unsigned, rm); auto rr = __builtin_amdgcn_permlane32_swap(rb, rb, false, false); rm = fmaxf(__builtin_bit_cast(float, (unsigned)rr[0]), __builtin_bit_cast(float, (unsigned)rr[1])); } \
            if (it == 0 || __any(rm > THR)) { \
                const float dl = (it == 0) ? rm : fmaxf(rm, 0.f); const float alpha = fexp2(-dl); \
                _Pragma("unroll") for (int r = 0; r < 16; ++r) { p0[r] -= dl; p1[r] -= dl; negm[r] -= dl; } \
                l_run *= alpha; \
                _Pragma("unroll") for (int d = 0; d < 4; ++d) _Pragma("unroll") for (int r = 0; r < 16; ++r) o[d][r] *= alpha; } \
            float ls = 0.f; \
            _Pragma("unroll") for (int r = 0; r < 16; ++r) { p0[r] = fexp2(p0[r]); p1[r] = fexp2(p1[r]); ls += p0[r] + p1[r]; } \
            l_run += ls; \
            bf16x8 pa[4]; \
            { v4u w; \
              w.x = cvtpk(p0[0], p0[1]); w.y = cvtpk(p0[2], p0[3]); w.z = cvtpk(p0[4], p0[5]); w.w = cvtpk(p0[6], p0[7]); pa[0] = __builtin_bit_cast(bf16x8, w); \
              w.x = cvtpk(p0[8], p0[9]); w.y = cvtpk(p0[10], p0[11]); w.z = cvtpk(p0[12], p0[13]); w.w = cvtpk(p0[14], p0[15]); pa[1] = __builtin_bit_cast(bf16x8, w); \
              w.x = cvtpk(p1[0], p1[1]); w.y = cvtpk(p1[2], p1[3]); w.z = cvtpk(p1[4], p1[5]); w.w = cvtpk(p1[6], p1[7]); pa[2] = __builtin_bit_cast(bf16x8, w); \
              w.x = cvtpk(p1[8], p1[9]); w.y = cvtpk(p1[10], p1[11]); w.z = cvtpk(p1[12], p1[13]); w.w = cvtpk(p1[14], p1[15]); pa[3] = __builtin_bit_cast(bf16x8, w); } \
            const LAS unsigned char* vb = lds + VB0 + (BUF) * 16384 + vfo; \
            bf16x8 vfr[2][4]; \
            _Pragma("unroll") for (int d = 0; d < 4; ++d) vfr[0][d] = *(const LAS bf16x8*)(vb + d * 4096 + (((0 + hi) ^ vsw) << 4)); \
            _Pragma("unroll") for (int ks = 0; ks < 4; ++ks) { \
                if (ks + 1 < 4) { const int c = ((ks + 1) >> 1) * 4 + ((ks + 1) & 1) * 2 + hi; \
                    _Pragma("unroll") for (int d = 0; d < 4; ++d) vfr[(ks + 1) & 1][d] = *(const LAS bf16x8*)(vb + d * 4096 + ((c ^ vsw) << 4)); } \
                __builtin_amdgcn_sched_barrier(0); \
                _Pragma("unroll") for (int d = 0; d < 4; ++d) o[d] = __builtin_amdgcn_mfma_f32_32x32x16_bf16(vfr[ks & 1][d], pa[ks], o[d], 0, 0, 0); \
                __builtin_amdgcn_sched_barrier(0); } \
        } \
        if (more) ATT_STORE((BUF) ^ 1); \
        __syncthreads(); \
    } while (0)
    int it = 0;
#pragma unroll 1
    for (; it + 1 < nt; it += 2) { ATT_STEP(0); ++it; ATT_STEP(1); --it; }
    if (it < nt) ATT_STEP(0);
#undef ATT_STEP
#undef ATT_LOAD
#undef KTILE
#undef ATT_STORE
    const float lt = l_run + __shfl_xor(l_run, 32);
    const float inv = 1.0f / lt;
#pragma unroll
    for (int d = 0; d < 4; ++d)
#pragma unroll
        for (int r = 0; r < 16; ++r) o[d][r] *= inv;
}

__device__ __forceinline__ void attn_pass_diff2(LAS unsigned char* lds, const bf16* Qg, const bf16* Kg, const bf16* Vtg, int q0, f32x16 (&o1)[4], f32x16 (&o2)[4], int tid, int wid, int lane) {
    constexpr int RB = 256, KCH = 16; constexpr float THR = 8.0f;
    { const int r32 = lane & 31, hi = lane >> 5;
      const bf16* qp = Qg + (size_t)(32 * wid + r32) * 1024 + 8 * hi;
#pragma unroll
      for (int s = 0; s < 8; ++s) *(LAS bf16x8*)(lds + QFR + wid * 8192 + lane * 16 + s * 1024) = *(const GAS bf16x8*)(qp + 16 * s); }
#pragma unroll
    for (int d = 0; d < 4; ++d) { o1[d] = (f32x16){0.f,0.f,0.f,0.f,0.f,0.f,0.f,0.f,0.f,0.f,0.f,0.f,0.f,0.f,0.f,0.f}; o2[d] = o1[d]; }
    float m1 = 0.f, l1 = 0.f, m2 = 0.f, l2 = 0.f;
    const int nt = (q0 + 256) / 64;
    v4u sreg[2];
#define ATT_KGO(i) ((unsigned)((((tq_ + 512 * (i)) >> 4) * 1024 + ((tq_ + 512 * (i)) & 15) * 8) * 2))
#define ATT_KLDS(i) ((((tq_ + 512 * (i)) >> 4) * RB) + (((((tq_ + 512 * (i)) & 15)) ^ (((tq_ + 512 * (i)) >> 4) & 15)) << 4))
#define ATT_VGO(i) ((unsigned)((((tq_ + 512 * (i)) >> 3) * T + ((tq_ + 512 * (i)) & 7) * 8) * 2))
#define ATT_VC(i) (((((tq_ + 512 * (i)) & 7) >> 2) * 4) + (((((tq_ + 512 * (i)) & 7) >> 1) & 1) * 2))
#define ATT_VL0(i) ((((tq_ + 512 * (i)) >> 3) * 128) + ((ATT_VC(i) ^ ((((tq_ + 512 * (i)) >> 3) >> 1) & 7)) << 4) + 8 * ((tq_ + 512 * (i)) & 1))
#define ATT_VL1(i) ((((tq_ + 512 * (i)) >> 3) * 128) + (((ATT_VC(i) + 1) ^ ((((tq_ + 512 * (i)) >> 3) >> 1) & 7)) << 4) + 8 * ((tq_ + 512 * (i)) & 1))
#define ATT_TQ int tq_ = lane; asm volatile("" : "+v"(tq_)); tq_ += 64 * wid
#define ATT_LOADK(kt) do { ATT_TQ; const GAS unsigned char* kb_ = (const GAS unsigned char*)Kg + (size_t)(kt) * 131072; _Pragma("unroll") for (int i_ = 0; i_ < 2; ++i_) sreg[i_] = *(const GAS v4u*)(kb_ + ATT_KGO(i_)); } while (0)
#define ATT_LOADV(kt) do { ATT_TQ; const GAS unsigned char* vb_ = (const GAS unsigned char*)Vtg + (size_t)(kt) * 128; _Pragma("unroll") for (int i_ = 0; i_ < 2; ++i_) sreg[i_] = *(const GAS v4u*)(vb_ + ATT_VGO(i_)); } while (0)
#define ATT_STOREK(buf) do { ATT_TQ; _Pragma("unroll") for (int i_ = 0; i_ < 2; ++i_) *(LAS v4u*)(lds + KB0 + (buf) * 16384 + ATT_KLDS(i_)) = sreg[i_]; } while (0)
#define ATT_STOREV(buf) do { ATT_TQ; _Pragma("unroll") for (int i_ = 0; i_ < 2; ++i_) { *(LAS v2u*)(lds + VB0 + (buf) * 16384 + ATT_VL0(i_)) = (v2u){sreg[i_].x, sreg[i_].y}; \
                                                                               *(LAS v2u*)(lds + VB0 + (buf) * 16384 + ATT_VL1(i_)) = (v2u){sreg[i_].z, sreg[i_].w}; } } while (0)
    ATT_LOADK(0); ATT_STOREK(0); ATT_LOADV(0); ATT_STOREV(0);
    __syncthreads();
#define ATT_LN int ln_ = lane; asm volatile("" : "+v"(ln_)); const int r32 = ln_ & 31, hi = ln_ >> 5
#define ATT_QKS(BUF, S0, M, L, O) do { \
        ATT_LN; const int kswz = r32 & 15; const LAS unsigned char* qlds = lds + QFR + wid * 8192 + ln_ * 16; \
        const LAS unsigned char* kb = lds + KB0 + (BUF) * 16384 + r32 * RB; \
        bf16x8 fk0[2], fk1[2], fqv[2];                               \
        { const int ch = ((2 * (S0) + hi) ^ kswz) << 4; fk0[0] = *(const LAS bf16x8*)(kb + ch); fk1[0] = *(const LAS bf16x8*)(kb + 32 * RB + ch); fqv[0] = *(const LAS bf16x8*)(qlds + (S0) * 1024); } \
        _Pragma("unroll") for (int s = 0; s < 4; ++s) { \
            if (s + 1 < 4) { const int ch = ((2 * ((S0) + s + 1) + hi) ^ kswz) << 4; \
                fk0[(s + 1) & 1] = *(const LAS bf16x8*)(kb + ch); fk1[(s + 1) & 1] = *(const LAS bf16x8*)(kb + 32 * RB + ch); fqv[(s + 1) & 1] = *(const LAS bf16x8*)(qlds + ((S0) + s + 1) * 1024); } \
            __builtin_amdgcn_sched_barrier(0); \
            if (s == 0) { asm volatile("v_mfma_f32_32x32x16_bf16 %0, %1, %2, 0" : "=&v"(p0) : "v"(fk0[0]), "v"(fqv[0])); \
                          asm volatile("v_mfma_f32_32x32x16_bf16 %0, %1, %2, 0" : "=&v"(p1) : "v"(fk1[0]), "v"(fqv[0])); } \
            else { p0 = __builtin_amdgcn_mfma_f32_32x32x16_bf16(fk0[s & 1], fqv[s & 1], p0, 0, 0, 0); p1 = __builtin_amdgcn_mfma_f32_32x32x16_bf16(fk1[s & 1], fqv[s & 1], p1, 0, 0, 0); } \
            __builtin_amdgcn_sched_barrier(0); } \
        if (diag) { const int kbase = kt * 64 + 4 * hi, qpos = q0 + 32 * wid + r32; \
            _Pragma("unroll") for (int r = 0; r < 16; ++r) { const int kv = kbase + (r & 3) + 8 * (r >> 2); if (kv > qpos) p0[r] = -INFINITY; if (kv + 32 > qpos) p1[r] = -INFINITY; } } \
        float rm = fmaxf(fmaxf(p0[0], p0[1]), p1[0]); \
        _Pragma("unroll") for (int r = 1; r < 16; ++r) rm = fmaxf(fmaxf(rm, p0[r]), p1[r]); \
        { const unsigned rb = __builtin_bit_cast(unsigned, rm); auto rr = __builtin_amdgcn_permlane32_swap(rb, rb, false, false); rm = fmaxf(__builtin_bit_cast(float, (unsigned)rr[0]), __builtin_bit_cast(float, (unsigned)rr[1])); } \
        if (it == 0 || __any(rm > M + THR)) { \
            const float mnew = (it == 0) ? rm : fmaxf(M, rm); const float alpha = fexp2(M - mnew); M = mnew; \
            L *= alpha; \
            _Pragma("unroll") for (int d = 0; d < 4; ++d) _Pragma("unroll") for (int r = 0; r < 16; ++r) O[d][r] *= alpha; } \
        float ls = 0.f; \
        _Pragma("unroll") for (int r = 0; r < 16; ++r) { p0[r] = fexp2(p0[r] - M); p1[r] = fexp2(p1[r] - M); ls += p0[r] + p1[r]; } \
        L += ls; \
    } while (0)
#define ATT_PACK(dst_, ks) do { \
        if ((ks) == 0) { (dst_).x = cvtpk(p0[0], p0[1]); (dst_).y = cvtpk(p0[2], p0[3]); (dst_).z = cvtpk(p0[4], p0[5]); (dst_).w = cvtpk(p0[6], p0[7]); } \
        else if ((ks) == 1) { (dst_).x = cvtpk(p0[8], p0[9]); (dst_).y = cvtpk(p0[10], p0[11]); (dst_).z = cvtpk(p0[12], p0[13]); (dst_).w = cvtpk(p0[14], p0[15]); } \
        else if ((ks) == 2) { (dst_).x = cvtpk(p1[0], p1[1]); (dst_).y = cvtpk(p1[2], p1[3]); (dst_).z = cvtpk(p1[4], p1[5]); (dst_).w = cvtpk(p1[6], p1[7]); } \
        else { (dst_).x = cvtpk(p1[8], p1[9]); (dst_).y = cvtpk(p1[10], p1[11]); (dst_).z = cvtpk(p1[12], p1[13]); (dst_).w = cvtpk(p1[14], p1[15]); } } while (0)
#define ATT_STEP(BUF) do { \
        const int kt = it; const bool more = it + 1 < nt; \
        const bool need = kt * 64 <= q0 + 32 * wid + 31, diag = kt * 64 + 63 > q0 + 32 * wid; \
        if (more) ATT_LOADK(it + 1); \
        v4u pa1[4] = {(v4u){0u, 0u, 0u, 0u}, (v4u){0u, 0u, 0u, 0u}, (v4u){0u, 0u, 0u, 0u}, (v4u){0u, 0u, 0u, 0u}}; \
        if (need) { f32x16 p0, p1; ATT_QKS(BUF, 0, m1, l1, o1); \
              _Pragma("unroll") for (int ks = 0; ks < 4; ++ks) ATT_PACK(pa1[ks], ks); } \
        if (more) { ATT_STOREK((BUF) ^ 1); ATT_LOADV(it + 1); }        \
        if (need) { v4u pa2[4]; \
              { f32x16 p0, p1; ATT_QKS(BUF, 4, m2, l2, o2); \
                _Pragma("unroll") for (int ks = 0; ks < 4; ++ks) ATT_PACK(pa2[ks], ks); } \
              __builtin_amdgcn_sched_barrier(0); \
              ATT_LN; const int vsw = (r32 >> 1) & 7; \
              const LAS unsigned char* vb = lds + VB0 + (BUF) * 16384 + r32 * 128; \
              bf16x8 vfr[2][4]; \
              _Pragma("unroll") for (int d = 0; d < 4; ++d) vfr[0][d] = *(const LAS bf16x8*)(vb + d * 4096 + (((0 + hi) ^ vsw) << 4)); \
              _Pragma("unroll") for (int ks = 0; ks < 4; ++ks) { \
                const bf16x8 pb1 = __builtin_bit_cast(bf16x8, pa1[ks]), pb2 = __builtin_bit_cast(bf16x8, pa2[ks]); \
                if (ks + 1 < 4) { const int c = ((ks + 1) >> 1) * 4 + ((ks + 1) & 1) * 2 + hi; \
                    _Pragma("unroll") for (int d = 0; d < 4; ++d) vfr[(ks + 1) & 1][d] = *(const LAS bf16x8*)(vb + d * 4096 + ((c ^ vsw) << 4)); } \
                __builtin_amdgcn_sched_barrier(0); \
                _Pragma("unroll") for (int d = 0; d < 4; ++d) { \
                    o1[d] = __builtin_amdgcn_mfma_f32_32x32x16_bf16(vfr[ks & 1][d], pb1, o1[d], 0, 0, 0); \
                    o2[d] = __builtin_amdgcn_mfma_f32_32x32x16_bf16(vfr[ks & 1][d], pb2, o2[d], 0, 0, 0); } \
                __builtin_amdgcn_sched_barrier(0); } } \
        if (more) ATT_STOREV((BUF) ^ 1); \
        __syncthreads(); \
    } while (0)
    int it = 0;
#pragma unroll 1
    for (; it + 1 < nt; it += 2) { ATT_STEP(0); ++it; ATT_STEP(1); --it; }
    if (it < nt) ATT_STEP(0);
#undef ATT_STEP
#undef ATT_QKS
#undef ATT_PACK
#undef ATT_LN
#undef ATT_LOADK
#undef ATT_LOADV
#undef ATT_STOREK
#undef ATT_STOREV
#undef ATT_TQ
#undef ATT_KGO
#undef ATT_KLDS
#undef ATT_VGO
#undef ATT_VC
#undef ATT_VL0
#undef ATT_VL1
    const float i1 = 1.0f / (l1 + __shfl_xor(l1, 32)), i2 = 1.0f / (l2 + __shfl_xor(l2, 32));
#pragma unroll
    for (int d = 0; d < 4; ++d)
#pragma unroll
        for (int r = 0; r < 16; ++r) { o1[d][r] *= i1; o2[d][r] *= i2; }
}

struct AttnArgs { const bf16 *qa, *ka, *qd, *kd, *vt; bf16* oab; const float* kmean; const float* gain; float lam, one_minus_li; };

__device__ __forceinline__ void moba_unit(LAS unsigned char* lds, const AttnArgs& A, int b, int h, int qb, int tid, int wid, int lane) {
    asm volatile("" : "+v"(tid), "+v"(lane));
    const int r32 = lane & 31, hi = lane >> 5, q0 = qb * 256;
    const bf16* Qg = A.qa + (size_t)(b * SEQ + q0) * 1024 + h * 128;
    unsigned sel = 0u;
    if (qb > 0) {
        { const int row = tid >> 4, ch = tid & 15, n = row & 15;
          const float* kp = A.kmean + ((size_t)(b * 8 + h) * 16 + n) * 128 + ch * 8;
          const f32x4 a = *(const GAS f32x4*)kp, c = *(const GAS f32x4*)(kp + 4);
          float v[8] = {a[0], a[1], a[2], a[3], c[0], c[1], c[2], c[3]}; unsigned w[8];
#pragma unroll
          for (int j = 0; j < 8; ++j) { const float x = v[j] * (1.0f / 256.0f); const unsigned hb = f2bf(x); const float xr = __builtin_bit_cast(float, hb << 16); w[j] = (row < 16) ? hb : f2bf(x - xr); }
          v4u o; o.x = w[0] | (w[1] << 16); o.y = w[2] | (w[3] << 16); o.z = w[4] | (w[5] << 16); o.w = w[6] | (w[7] << 16);
          *(LAS v4u*)(lds + KMT + row * 256 + ((ch ^ (row & 15)) << 4)) = o; }
        __syncthreads();
        f32x16 g = (f32x16){0.f,0.f,0.f,0.f,0.f,0.f,0.f,0.f,0.f,0.f,0.f,0.f,0.f,0.f,0.f,0.f};
        { const bf16* qp = Qg + (size_t)(32 * wid + r32) * 1024 + 8 * hi;
          const LAS unsigned char* kb = lds + KMT + r32 * 256;
#pragma unroll
          for (int s = 0; s < 8; ++s) { const bf16x8 qv = *(const GAS bf16x8*)(qp + 16 * s);
              const bf16x8 kf = *(const LAS bf16x8*)(kb + (((2 * s + hi) ^ (r32 & 15)) << 4));
              g = __builtin_amdgcn_mfma_f32_32x32x16_bf16(kf, qv, g, 0, 0, 0); } }
        float G[16];
#pragma unroll
        for (int r = 0; r < 8; ++r) { const float mine = g[r] + g[r + 8]; const float oth = __shfl_xor(mine, 32);
            const int nlo = (r & 3) + 8 * (r >> 2); G[nlo] = hi ? oth : mine; G[nlo + 4] = hi ? mine : oth; }
#pragma unroll
        for (int round = 0; round < 3; ++round) { float best = -INFINITY; int bi = -1;
#pragma unroll
            for (int n = 0; n < 16; ++n) { const bool ok = (n < qb) && !((sel >> n) & 1u) && (G[n] > best); best = ok ? G[n] : best; bi = ok ? n : bi; }
            if (bi >= 0) sel |= 1u << bi; }
        __syncthreads();
    }
    f32x16 o[4];
    attn_pass<128, true>(lds, Qg, A.ka + (size_t)(b * SEQ) * 1024 + h * 128, A.vt + (size_t)(h * 128) * T + b * SEQ, q0, sel, o, tid, wid, lane);
    bf16* op = A.oab + (size_t)(b * SEQ + q0 + 32 * wid + r32) * 2048 + h * 128 + 4 * hi;
#pragma unroll
    for (int d = 0; d < 4; ++d)
#pragma unroll
        for (int gq = 0; gq < 4; ++gq) { v2u w; w.x = cvtpk(o[d][4 * gq], o[d][4 * gq + 1]); w.y = cvtpk(o[d][4 * gq + 2], o[d][4 * gq + 3]); *(GAS v2u*)(op + 32 * d + 8 * gq) = w; }
}

__device__ __forceinline__ void diff_unit(LAS unsigned char* lds, const AttnArgs& A, int b, int h, int qb, int tid, int wid, int lane) {
    asm volatile("" : "+v"(tid), "+v"(lane));
    const int r32 = lane & 31, hi = lane >> 5, q0 = qb * 256;
    const size_t qrow = (size_t)(b * SEQ + q0);
    const bf16* Vtg = A.vt + (size_t)(1024 + h * 128) * T + b * SEQ;
    f32x16 o[4], o2[4];
    attn_pass_diff2(lds, A.qd + qrow * 1024 + h * 128, A.kd + (size_t)(b * SEQ) * 1024 + h * 128, Vtg, q0, o, o2, tid, wid, lane);
    float ss = 0.f;
#pragma unroll
    for (int d = 0; d < 4; ++d)
#pragma unroll
        for (int r = 0; r < 16; ++r) { const float v = o[d][r] - A.lam * o2[d][r]; o[d][r] = v; ss += v * v; }
    ss += __shfl_xor(ss, 32);
    const float rn = 1.0f / sqrtf(ss * (1.0f / 128.0f) + RMS_EPS) * A.one_minus_li;
    bf16* op = A.oab + (qrow + 32 * wid + r32) * 2048 + 1024 + h * 128 + 4 * hi;
    const float* gp = A.gain + h * 128 + 4 * hi;
#pragma unroll
    for (int d = 0; d < 4; ++d)
#pragma unroll
        for (int gq = 0; gq < 4; ++gq) { const f32x4 gn = *(const GAS f32x4*)(gp + 32 * d + 8 * gq);
            v2u w; w.x = cvtpk(o[d][4 * gq] * rn * gn[0], o[d][4 * gq + 1] * rn * gn[1]); w.y = cvtpk(o[d][4 * gq + 2] * rn * gn[2], o[d][4 * gq + 3] * rn * gn[3]);
            *(GAS v2u*)(op + 32 * d + 8 * gq) = w; }
}

__device__ __forceinline__ void attn_phase(LAS unsigned char* lds, const AttnArgs& A, int vcu, int G, int tid, int wid, int lane) {
    for (int ord = vcu; ord < 1024; ord += G) {
        const int i = ord >> 8, v = ord & 255, bh = v >> 3, s = v & 7;
        const int qb = (i & 1) ? 15 - s : s;
        if (i < 2) diff_unit(lds, A, bh >> 3, bh & 7, qb, tid, wid, lane);
        else moba_unit(lds, A, bh >> 3, bh & 7, qb, tid, wid, lane);
    }
}
}

namespace peer {
__device__ __forceinline__ int f2key(float f) { const int u = __builtin_bit_cast(int, f); return u ^ ((u >> 31) & 0x7fffffff); }
__device__ __forceinline__ float key2f(int k) { const int u = k ^ ((k >> 31) & 0x7fffffff); return __builtin_bit_cast(float, u); }
__device__ __forceinline__ int imax(int a, int b) { return a > b ? a : b; }
__device__ __forceinline__ int imin(int a, int b) { return a < b ? a : b; }

template <int OFF> __device__ __forceinline__ void sort16_desc(int (&v)[64]) {
#pragma unroll
    for (int k = 2; k <= 16; k <<= 1)
#pragma unroll
        for (int j = k >> 1; j > 0; j >>= 1)
#pragma unroll
            for (int i = 0; i < 16; ++i) { const int l = i ^ j;
                if (l > i) { const bool desc = ((i & k) == 0); const int a = v[OFF + i], b = v[OFF + l]; const int mx = imax(a, b), mn = imin(a, b);
                    v[OFF + i] = desc ? mx : mn; v[OFF + l] = desc ? mn : mx; } }
}
template <int OA, int OB> __device__ __forceinline__ void merge16_desc(int (&v)[64]) {
#pragma unroll
    for (int i = 0; i < 16; ++i) v[OA + i] = imax(v[OA + i], v[OB + 15 - i]);
#pragma unroll
    for (int j = 8; j > 0; j >>= 1)
#pragma unroll
        for (int i = 0; i < 16; ++i) { const int l = i ^ j;
            if (l > i) { const int a = v[OA + i], b = v[OA + l]; v[OA + i] = imax(a, b); v[OA + l] = imin(a, b); } }
}
__device__ __forceinline__ void top16_of_64(int (&v)[64]) {
    sort16_desc<0>(v); sort16_desc<16>(v); sort16_desc<32>(v); sort16_desc<48>(v);
    merge16_desc<0, 16>(v); merge16_desc<32, 48>(v); merge16_desc<0, 32>(v);
}
__device__ __forceinline__ float gelu_tanh(float x) {
    const float u = 0.7978845608028654f * (x + 0.044715f * x * x * x);
    const float e = __builtin_amdgcn_exp2f(2.0f * 1.4426950408889634f * u);
    const float th = 1.0f - 2.0f * __builtin_amdgcn_rcpf(e + 1.0f);
    return 0.5f * x * (1.0f + th);
}
constexpr int ETILE = 0, GTILE = 16384, SCR0 = 32768, XQ0 = 98304;

__device__ __forceinline__ void select_tile(LAS unsigned char* lds, const bf16* pq, const bf16* sk, int t0, int wid, int lane) {
    asm volatile("" : "+v"(lane));
    const int r32 = lane & 31, hi = lane >> 5, h = wid;
    LAS int* scr = (LAS int*)(lds + SCR0 + wid * 8192);
    int v[64];
#pragma unroll 1
    for (int c = 0; c < 2; ++c) {
        bf16x8 qf[8];
        { const bf16* qp = pq + (size_t)(t0 + r32) * 2048 + h * 256 + c * 128 + 8 * hi;
#pragma unroll
          for (int s = 0; s < 8; ++s) qf[s] = *(const GAS bf16x8*)(qp + 16 * s); }
#pragma unroll
        for (int kb = 0; kb < 4; ++kb) {
            f32x16 sc = (f32x16){0.f,0.f,0.f,0.f,0.f,0.f,0.f,0.f,0.f,0.f,0.f,0.f,0.f,0.f,0.f,0.f};
            const bf16* ap = sk + ((size_t)((c * 8 + h) * 128 + 32 * kb + r32)) * 128 + 8 * hi;
#pragma unroll
            for (int s = 0; s < 8; ++s) { const bf16x8 af = *(const GAS bf16x8*)(ap + 16 * s); sc = __builtin_amdgcn_mfma_f32_32x32x16_bf16(af, qf[s], sc, 0, 0, 0); }
#pragma unroll
            for (int r = 0; r < 16; ++r) v[kb * 16 + r] = (f2key(sc[r]) & ~127) | (32 * kb + (r & 3) + 8 * (r >> 2) + 4 * hi);
        }
        top16_of_64(v);
#pragma unroll
        for (int i = 0; i < 16; ++i) v[16 + i] = __shfl_xor(v[i], 32);
        merge16_desc<0, 16>(v);
#pragma unroll
        for (int i = 0; i < 16; ++i) scr[(c * 16 + i) * 64 + lane] = v[i];
    }
    LDS_WAIT();
    float a[16], b[16];
#pragma unroll
    for (int i = 0; i < 16; ++i) { a[i] = key2f(scr[i * 64 + lane] & ~127); b[i] = key2f(v[i] & ~127); }
    int n = 0;
#pragma unroll
    for (int i = 0; i < 16; ++i)
#pragma unroll
        for (int j = 0; j < 16; ++j)
            if ((i + 1) * (j + 1) <= 16) { v[n] = (f2key(a[i] + b[j]) & ~255) | (i << 4) | j; ++n; }
#pragma unroll
    for (int i = 0; i < 64; ++i) if (i >= 50) v[i] = (int)0x80000000;
    top16_of_64(v);
    float s[16]; int e[16]; float mx = -INFINITY;
#pragma unroll
    for (int k = 0; k < 16; ++k) { const int i = (v[k] >> 4) & 15, j = v[k] & 15;
        const int ka = scr[i * 64 + lane], kb2 = scr[(16 + j) * 64 + lane];
        s[k] = key2f(ka & ~127) + key2f(kb2 & ~127); e[k] = (ka & 127) * 128 + (kb2 & 127); mx = fmaxf(mx, s[k]); }
    float sum = 0.f;
#pragma unroll
    for (int k = 0; k < 16; ++k) { s[k] = __builtin_amdgcn_exp2f((s[k] - mx) * 1.4426950408889634f); sum += s[k]; }
    const float inv = 1.0f / sum;
    if (hi == 0) {
        LAS int* E = (LAS int*)(lds + ETILE) + r32 * 128 + h * 16; LAS float* Gt = (LAS float*)(lds + GTILE) + r32 * 128 + h * 16;
#pragma unroll
        for (int k = 0; k < 16; ++k) { E[k] = e[k]; Gt[k] = s[k] * inv; }
    }
}

#define PEER_LOADROW(dst, tab, ridx) do { dst = *((const GAS v4u*)((tab) + (size_t)(ridx) * 1024) + lane); } while (0)
typedef float f32x2p __attribute__((ext_vector_type(2)));
#define PEER_CVT4(w) const f32x2p c0_ = __builtin_amdgcn_cvt_scalef32_pk_f32_fp4((w), 1.0f, 0), c1_ = __builtin_amdgcn_cvt_scalef32_pk_f32_fp4((w), 1.0f, 1), \
        c2_ = __builtin_amdgcn_cvt_scalef32_pk_f32_fp4((w), 1.0f, 2), c3_ = __builtin_amdgcn_cvt_scalef32_pk_f32_fp4((w), 1.0f, 3)
#define PEER_AXPY8(Y2, wk2, w, b) do { PEER_CVT4(w); Y2[(b)] = __builtin_elementwise_fma(wk2, c0_, Y2[(b)]); Y2[(b) + 1] = __builtin_elementwise_fma(wk2, c1_, Y2[(b) + 1]); \
        Y2[(b) + 2] = __builtin_elementwise_fma(wk2, c2_, Y2[(b) + 2]); Y2[(b) + 3] = __builtin_elementwise_fma(wk2, c3_, Y2[(b) + 3]); } while (0)

__device__ __forceinline__ void token_ffn(LAS unsigned char* lds, int tl, const bf16* xrow, const unsigned char* TU, const unsigned char* TV, const float* SU, const float* SV,
                                          const float* gain, const float* bias, float* outf, bf16* outb, unsigned char* out8, float* outsx, int lane) {
    f32x2p xs[16];
#pragma unroll
    for (int q = 0; q < 4; ++q) { const v4u a = *(const GAS v4u*)(xrow + 32 * lane + 8 * q);
        xs[4 * q] = (f32x2p){bf_lo(a.x), bf_hi(a.x)}; xs[4 * q + 1] = (f32x2p){bf_lo(a.y), bf_hi(a.y)}; xs[4 * q + 2] = (f32x2p){bf_lo(a.z), bf_hi(a.z)}; xs[4 * q + 3] = (f32x2p){bf_lo(a.w), bf_hi(a.w)}; }
    const LAS int* E = (const LAS int*)(lds + ETILE) + tl * 128; const LAS float* Gt = (const LAS float*)(lds + GTILE) + tl * 128;
    const int e_lo = E[lane], e_hi = E[64 + lane]; const float g_lo = Gt[lane], g_hi = Gt[64 + lane];
    const float su_lo = SU[e_lo], su_hi = SU[e_hi], sv_lo = SV[e_lo], sv_hi = SV[e_hi];
#define PEER_EIDX(k) (((k) < 64) ? __builtin_amdgcn_readlane(e_lo, (k)) : __builtin_amdgcn_readlane(e_hi, (k) - 64))
    constexpr int PEER_RING = 16;
    v4u buf[PEER_RING];
    float h_lo = 0.f, h_hi = 0.f;
    {
        float am = 0.f;
#pragma unroll
        for (int i = 0; i < 16; ++i) am = fmaxf(am, fmaxf(fabsf(xs[i].x), fabsf(xs[i].y)));
#pragma unroll
        for (int o = 1; o < 64; o <<= 1) am = fmaxf(am, __shfl_xor(am, o));
        const float sx = am > 0.f ? 6.0f / am : 1.0f, isx = am > 0.f ? am / 6.0f : 1.0f;
        v4u xh, xl;
#pragma unroll
        for (int wq = 0; wq < 4; ++wq) { unsigned wh = 0u, wl = 0u;
#define PEER_XQ(b) { const f32x2p v = xs[4 * wq + (b)] * sx; wh = __builtin_amdgcn_cvt_scalef32_pk_fp4_f32(wh, v.x, v.y, 1.0f, (b)); \
                const f32x2p d = __builtin_amdgcn_cvt_scalef32_pk_f32_fp4(wh, 1.0f, (b)); wl = __builtin_amdgcn_cvt_scalef32_pk_fp4_f32(wl, (v.x - d.x) * 4.0f, (v.y - d.y) * 4.0f, 1.0f, (b)); }
            PEER_XQ(0) PEER_XQ(1) PEER_XQ(2) PEER_XQ(3)
#undef PEER_XQ
            xh[wq] = wh; xl[wq] = wl; }
        LAS unsigned char* xq = lds + XQ0 + (tl >> 2) * 2048;
        *(LAS v4u*)(xq + 16 * lane) = xh; *(LAS v4u*)(xq + 1024 + 16 * lane) = xl;
        const int g = lane >> 4, rl = lane & 15;
        typedef int v8i_t __attribute__((ext_vector_type(8)));
        int e_r = E[16 * 0 + rl];
#pragma unroll
        for (int s = 0; s < 16; ++s) buf[s] = *(const GAS v4u*)(TU + (size_t)e_r * 1024 + 16 * g + 64 * s);
#pragma unroll 1
        for (int rb = 0; rb < 8; ++rb) {
            const int rbn = rb < 7 ? rb + 1 : 7;
            const int e_n = E[16 * rbn + rl];
            const GAS unsigned char* rown = (const GAS unsigned char*)TU + (size_t)e_n * 1024 + 16 * g;
            f32x4 ah = {0.f, 0.f, 0.f, 0.f}, al = {0.f, 0.f, 0.f, 0.f};
            int xoff = 16 * g; asm volatile("" : "+v"(xoff));
            const LAS unsigned char* xbb = xq + xoff;
#pragma unroll
            for (int s = 0; s < 16; ++s) {
                const v4u a4 = buf[s]; const v4u bh = *(const LAS v4u*)(xbb + 64 * s), bl = *(const LAS v4u*)(xbb + 1024 + 64 * s);
                const v8i_t A = {(int)a4.x, (int)a4.y, (int)a4.z, (int)a4.w, 0, 0, 0, 0}, BH = {(int)bh.x, (int)bh.y, (int)bh.z, (int)bh.w, 0, 0, 0, 0}, BL = {(int)bl.x, (int)bl.y, (int)bl.z, (int)bl.w, 0, 0, 0, 0};
                ah = __builtin_amdgcn_mfma_scale_f32_16x16x128_f8f6f4(A, BH, ah, 4, 4, 0, 127, 0, 127);
                al = __builtin_amdgcn_mfma_scale_f32_16x16x128_f8f6f4(A, BL, al, 4, 4, 0, 127, 0, 127);
                buf[s] = *(const GAS v4u*)(rown + 64 * s);
            }
            float selv = 0.f;
#pragma unroll
            for (int r = 0; r < 4; ++r) { const float hv = (ah[r] + 0.25f * al[r]) * isx; const float t = __shfl(hv, 16 * ((lane >> 2) & 3)); selv = ((lane & 3) == r) ? t : selv; }
            if (rb < 4) h_lo = ((lane >> 4) == rb) ? selv : h_lo; else h_hi = ((lane >> 4) == (rb - 4)) ? selv : h_hi;
        }
    }
    const float w_lo = g_lo * gelu_tanh(h_lo * su_lo) * sv_lo, w_hi = g_hi * gelu_tanh(h_hi * su_hi) * sv_hi;
    f32x2p y[16];
#pragma unroll
    for (int i = 0; i < 16; ++i) y[i] = (f32x2p){0.f, 0.f};
#pragma unroll
    for (int i = 0; i < PEER_RING; ++i) { const int ei = PEER_EIDX(i); PEER_LOADROW(buf[i], TV, ei); }
#pragma unroll 1
    for (int k0 = 0; k0 < 128; k0 += PEER_RING) {
        const int wsrc = __builtin_bit_cast(int, (k0 < 64) ? w_lo : w_hi);
        const int kb = (k0 + PEER_RING < 128) ? k0 + PEER_RING : k0;
        const int esrc = (kb < 64) ? e_lo : e_hi;
#pragma unroll
        for (int i = 0; i < PEER_RING; ++i) {
            const float wk = __builtin_bit_cast(float, __builtin_amdgcn_readlane(wsrc, (k0 & 63) + i));
            const v4u w = buf[i]; const f32x2p wk2 = {wk, wk};
            PEER_AXPY8(y, wk2, w.x, 0); PEER_AXPY8(y, wk2, w.y, 4); PEER_AXPY8(y, wk2, w.z, 8); PEER_AXPY8(y, wk2, w.w, 12);
            const int en = __builtin_amdgcn_readlane(esrc, (kb & 63) + i); PEER_LOADROW(buf[i], TV, en);
        }
    }
    float sm = 0.f;
#pragma unroll
    for (int i = 0; i < 16; ++i) { y[i] = xs[i] * ALPHA + y[i]; sm += y[i].x + y[i].y; }
    const float mean = wave_sum(sm) * (1.0f / 2048.0f);
    float sq = 0.f;
#pragma unroll
    for (int i = 0; i < 16; ++i) { y[i] = y[i] - mean; sq += y[i].x * y[i].x + y[i].y * y[i].y; }
    const float rstd = 1.0f / sqrtf(wave_sum(sq) * (1.0f / 2048.0f) + LN_EPS);
    unsigned pk[16];
#pragma unroll
    for (int q = 0; q < 8; ++q) { const int c0 = 32 * lane + 4 * q;
        const f32x4 ga = *(const GAS f32x4*)(gain + c0), ba = *(const GAS f32x4*)(bias + c0);
        f32x4 o;
        o[0] = y[2 * q].x * rstd * ga[0] + ba[0]; o[1] = y[2 * q].y * rstd * ga[1] + ba[1]; o[2] = y[2 * q + 1].x * rstd * ga[2] + ba[2]; o[3] = y[2 * q + 1].y * rstd * ga[3] + ba[3];
        if (outf) *(GAS f32x4*)(outf + c0) = o;
        pk[2 * q] = pk2(o[0], o[1]); pk[2 * q + 1] = pk2(o[2], o[3]); }
    if (outb) {
#pragma unroll
        for (int q = 0; q < 4; ++q) *(GAS v4u*)(outb + 32 * lane + 8 * q) = (v4u){pk[4 * q], pk[4 * q + 1], pk[4 * q + 2], pk[4 * q + 3]};
        float am = 0.f;
#pragma unroll
        for (int i = 0; i < 16; ++i) am = fmaxf(am, fmaxf(fabsf(bf_lo(pk[i])), fabsf(bf_hi(pk[i]))));
#pragma unroll
        for (int o = 1; o < 64; o <<= 1) am = fmaxf(am, __shfl_xor(am, o));
        const float sc = am > 0.f ? 127.0f / am : 0.f;
#pragma unroll
        for (int q = 0; q < 2; ++q) { v4u w;
            w.x = q8pack(bf_lo(pk[8 * q]), bf_hi(pk[8 * q]), bf_lo(pk[8 * q + 1]), bf_hi(pk[8 * q + 1]), sc); w.y = q8pack(bf_lo(pk[8 * q + 2]), bf_hi(pk[8 * q + 2]), bf_lo(pk[8 * q + 3]), bf_hi(pk[8 * q + 3]), sc);
            w.z = q8pack(bf_lo(pk[8 * q + 4]), bf_hi(pk[8 * q + 4]), bf_lo(pk[8 * q + 5]), bf_hi(pk[8 * q + 5]), sc); w.w = q8pack(bf_lo(pk[8 * q + 6]), bf_hi(pk[8 * q + 6]), bf_lo(pk[8 * q + 7]), bf_hi(pk[8 * q + 7]), sc);
            *(GAS v4u*)(out8 + 32 * lane + 16 * q) = w; }
        if (lane == 0) *outsx = am * (1.0f / 127.0f); }
#undef PEER_EIDX
}
#undef PEER_LOADROW
#undef PEER_AXPY8
#undef PEER_CVT4
}

__device__ __forceinline__ void ln_row(const bf16* zrow, const float* gain, const float* bias, bf16* outb, int lane) {
    float v[32]; float s = 0.f;
#pragma unroll
    for (int q = 0; q < 4; ++q) { const v4u w = *(const GAS v4u*)(zrow + 32 * lane + 8 * q);
        v[8 * q] = bf_lo(w.x); v[8 * q + 1] = bf_hi(w.x); v[8 * q + 2] = bf_lo(w.y); v[8 * q + 3] = bf_hi(w.y); v[8 * q + 4] = bf_lo(w.z); v[8 * q + 5] = bf_hi(w.z); v[8 * q + 6] = bf_lo(w.w); v[8 * q + 7] = bf_hi(w.w); }
#pragma unroll
    for (int i = 0; i < 32; ++i) s += v[i];
    const float mean = wave_sum(s) * (1.0f / 2048.0f); float s2 = 0.f;
#pragma unroll
    for (int i = 0; i < 32; ++i) { v[i] -= mean; s2 += v[i] * v[i]; }
    const float rstd = 1.0f / sqrtf(wave_sum(s2) * (1.0f / 2048.0f) + LN_EPS);
#pragma unroll
    for (int q = 0; q < 4; ++q) { const int c0 = 32 * lane + 8 * q;
        const f32x4 g0 = *(const GAS f32x4*)(gain + c0), g1 = *(const GAS f32x4*)(gain + c0 + 4), b0 = *(const GAS f32x4*)(bias + c0), b1 = *(const GAS f32x4*)(bias + c0 + 4);
        v4u o; o.x = pk2(v[8 * q] * rstd * g0[0] + b0[0], v[8 * q + 1] * rstd * g0[1] + b0[1]); o.y = pk2(v[8 * q + 2] * rstd * g0[2] + b0[2], v[8 * q + 3] * rstd * g0[3] + b0[3]);
        o.z = pk2(v[8 * q + 4] * rstd * g1[0] + b1[0], v[8 * q + 5] * rstd * g1[1] + b1[1]); o.w = pk2(v[8 * q + 6] * rstd * g1[2] + b1[2], v[8 * q + 7] * rstd * g1[3] + b1[3]);
        *(GAS v4u*)(outb + c0) = o; }
}

#if MK_CHECK
namespace chk {
constexpr int CW_ERR = 2048;
__device__ __forceinline__ unsigned hash32(unsigned x) { x ^= x >> 16; x *= 0x7feb352du; x ^= x >> 15; x *= 0x846ca68bu; x ^= x >> 16; return x; }
__device__ __forceinline__ float bf2f(bf16 v) { return __builtin_bit_cast(float, (unsigned)v << 16); }
__device__ __forceinline__ void report(gu32* ctl, int stage, float d2, float r2) { atomicAdd((float*)(ctl + CW_ERR + 2 * stage), d2); atomicAdd((float*)(ctl + CW_ERR + 2 * stage + 1), r2); }
__device__ __forceinline__ float dotcol(const bf16* xr, const float* win, int n, int lane) { float a = 0.f; for (int k = lane; k < 2048; k += 64) a += bf2f(xr[k]) * win[(size_t)k * INC + n]; return wave_sum(a); }
__device__ __forceinline__ void check_inproj(gu32* ctl, const bf16* xin, const int* pos, const float* win, const bf16* qa, const bf16* ka, const bf16* qd, const bf16* kd, const bf16* vt, const bf16* ga, const bf16* gb, int gw, int ngw, int lane) {
    for (int s = gw; s < 4096; s += ngw) {
        const unsigned hsh = hash32(s * 2654435761u + 12345u);
        const int t = hsh % T, kind = (hsh >> 14) % 8;
        const unsigned h2 = hash32(hsh);
        const bf16* xr = xin + (size_t)t * 2048;
        float ref, got;
        if (kind == 0 || kind == 1) { const int head = h2 % 8, i = (h2 >> 3) % 64, nb = (kind == 0 ? 0 : 1024) + head * 128;
            const float t1 = dotcol(xr, win, nb + i, lane), t2 = dotcol(xr, win, nb + i + 64, lane);
            const float ang = (float)pos[t] * powf(10000.0f, -(float)(2 * i) / 128.0f), c = cosf(ang), sn = sinf(ang);
            const bool second = (h2 >> 9) & 1; ref = second ? (t1 * sn + t2 * c) : (t1 * c - t2 * sn);
            const bf16* p = (kind == 0 ? qa : ka) + (size_t)t * 1024 + head * 128 + i + (second ? 64 : 0);
            got = bf2f(*p) / (kind == 0 ? QSCALE_A : 1.0f);
        } else if (kind == 3 || kind == 4) { const int head = h2 % 8, comp = (h2 >> 3) & 1, i = (h2 >> 4) % 32, nb = (kind == 3 ? 3072 : 4096) + head * 128 + comp * 64;
            const float t1 = dotcol(xr, win, nb + i, lane), t2 = dotcol(xr, win, nb + i + 32, lane);
            const float ang = (float)pos[t] * powf(10000.0f, -(float)(2 * i) / 64.0f), c = cosf(ang), sn = sinf(ang);
            const bool second = (h2 >> 9) & 1; ref = second ? (t1 * sn + t2 * c) : (t1 * c - t2 * sn);
            const bf16* p = (kind == 3 ? qd : kd) + (size_t)t * 1024 + head * 128 + comp * 64 + i + (second ? 32 : 0);
            got = bf2f(*p) / (kind == 3 ? QSCALE_B : 1.0f);
        } else if (kind == 2 || kind == 5) { const int c = h2 % 1024; ref = dotcol(xr, win, (kind == 2 ? 2048 : 5120) + c, lane); got = bf2f(vt[(size_t)((kind == 2 ? 0 : 1024) + c) * T + t]);
        } else { const int c = h2 % 2048; const float v = dotcol(xr, win, (kind == 6 ? 6144 : 8192) + c, lane); ref = 1.0f / (1.0f + expf(-v)); got = (float)((const unsigned char*)(kind == 6 ? ga : gb))[(size_t)t * 2048 + c] * (1.0f / 255.0f); }
        if (lane == 0) report(ctl, 0, (got - ref) * (got - ref), ref * ref);
    }
}
__device__ __forceinline__ void check_kmean(gu32* ctl, const bf16* ka, const float* kmean, int gw, int ngw, int lane) {
    for (int s = gw; s < 1024; s += ngw) { const unsigned hsh = hash32(s * 40503u + 77u); const int item = hsh % 512, d = (hsh >> 10) % 128; const int b = item >> 7, h = (item >> 4) & 7, blk = item & 15;
        float a = 0.f; for (int r = lane; r < 256; r += 64) a += bf2f(ka[(size_t)(b * SEQ + blk * 256 + r) * 1024 + h * 128 + d]); a = wave_sum(a);
        const float g = kmean[(size_t)item * 128 + d];
        if (lane == 0) report(ctl, 1, (g - a) * (g - a), a * a + 1.0f); }
}
__device__ __forceinline__ void check_attn(LAS unsigned char* lds, gu32* ctl, const att::AttnArgs& A, int vcu, int G, int tid, int lane, int wave) {
    LAS float* sc = (LAS float*)lds; LAS float* red = sc + 4096; LAS float* ovec = red + 64; LAS float* gsc = ovec + 256; LAS unsigned* selw = (LAS unsigned*)(gsc + 16);
    for (int s = vcu; s < 1024; s += G) {
        const unsigned hsh = hash32(s * 2246822519u + 99u); const bool moba = (s & 1);
        const int b = hsh % NB, h = (hsh >> 2) % NH; int t = (hsh >> 5) % SEQ; if ((s & 6) == 0) t = (t & 255) + 256 * ((hsh >> 20) % 3);
        const size_t row = (size_t)b * SEQ + t; const int own = t >> 8;
        float o0 = 0.f, o1 = 0.f;
        const int ncomp = moba ? 1 : 2;
        __syncthreads();
        if (moba) {
            if (tid < 16) { float a = -INFINITY; if (tid < own) { a = 0.f; for (int d = 0; d < 128; ++d) a += bf2f(A.qa[row * 1024 + h * 128 + d]) * A.kmean[((size_t)(b * 8 + h) * 16 + tid) * 128 + d]; } gsc[tid] = a; }
            __syncthreads();
            if (tid == 0) { unsigned sel = 0u; for (int r = 0; r < 3; ++r) { float best = -INFINITY; int bi = -1; for (int n = 0; n < own; ++n) { const float g = gsc[n]; if (!((sel >> n) & 1u) && g > best) { best = g; bi = n; } } if (bi >= 0) sel |= 1u << bi; } selw[0] = sel; }
            __syncthreads();
        }
        const unsigned sel = moba ? selw[0] : 0u;
        for (int comp = 0; comp < ncomp; ++comp) {
            const bf16* qp = moba ? A.qa + row * 1024 + h * 128 : A.qd + row * 1024 + h * 128 + comp * 64;
            const bf16* kb = moba ? A.ka + (size_t)b * SEQ * 1024 + h * 128 : A.kd + (size_t)b * SEQ * 1024 + h * 128 + comp * 64;
            const int dq = moba ? 128 : 64;
            float lmax = -INFINITY;
            for (int k = tid; k <= t; k += 512) { bool ok = true; if (moba) { const int kbk = k >> 8; ok = (kbk == own) || ((sel >> kbk) & 1u); }
                float a = -INFINITY; if (ok) { a = 0.f; for (int d = 0; d < dq; ++d) a += bf2f(qp[d]) * bf2f(kb[(size_t)k * 1024 + d]); }
                sc[k] = a; lmax = fmaxf(lmax, a); }
            lmax = fmaxf(lmax, __shfl_xor(lmax, 1)); lmax = fmaxf(lmax, __shfl_xor(lmax, 2)); lmax = fmaxf(lmax, __shfl_xor(lmax, 4)); lmax = fmaxf(lmax, __shfl_xor(lmax, 8)); lmax = fmaxf(lmax, __shfl_xor(lmax, 16)); lmax = fmaxf(lmax, __shfl_xor(lmax, 32));
            if (lane == 0) red[wave] = lmax;
            __syncthreads();
            float gmax = red[0]; for (int w = 1; w < 8; ++w) gmax = fmaxf(gmax, red[w]);
            float lsum = 0.f;
            for (int k = tid; k <= t; k += 512) { const float p = exp2f(sc[k] - gmax); sc[k] = p; lsum += p; }
            lsum = wave_sum(lsum);
            if (lane == 0) red[8 + wave] = lsum;
            __syncthreads();
            float gsum = 0.f; for (int w = 0; w < 8; ++w) gsum += red[8 + w];
            if (tid < 128) { const bf16* vp = A.vt + (size_t)((moba ? 0 : 1024) + h * 128 + tid) * T + (size_t)b * SEQ; float a = 0.f; for (int k = 0; k <= t; ++k) a += sc[k] * bf2f(vp[k]); a /= gsum; if (comp == 0) o0 = a; else o1 = a; }
            __syncthreads();
        }
        float ref = 0.f, got = 0.f;
        if (tid < 128) {
            if (moba) { ref = o0; got = bf2f(A.oab[row * 2048 + h * 128 + tid]); }
            else { ref = o0 - A.lam * o1; got = bf2f(A.oab[row * 2048 + 1024 + h * 128 + tid]); }
            ovec[tid] = ref;
        }
        __syncthreads();
        if (tid < 128 && !moba) { float ss = 0.f; for (int d = 0; d < 128; ++d) ss += ovec[d] * ovec[d]; ref = ref / sqrtf(ss * (1.0f / 128.0f) + RMS_EPS) * A.gain[h * 128 + tid] * A.one_minus_li; }
        float d2 = (tid < 128) ? (got - ref) * (got - ref) : 0.f, r2 = (tid < 128) ? ref * ref : 0.f;
        d2 = wave_sum(d2); r2 = wave_sum(r2);
        if (lane == 0 && wave < 2) report(ctl, moba ? 2 : 3, d2, r2);
        __syncthreads();
    }
}
__device__ __forceinline__ void check_merged(gu32* ctl, const bf16* oab, const bf16* ga, const bf16* gb, const bf16* merged, const float* wa, const float* wb, int gw, int ngw, int lane) {
    for (int s = gw; s < 2048; s += ngw) { const unsigned hsh = hash32(s * 3266489917u + 5u); const int t = hsh % T, c = (hsh >> 14) % 2048;
        float a = 0.f, b = 0.f; for (int k = lane; k < 1024; k += 64) { a += bf2f(oab[(size_t)t * 2048 + k]) * wa[(size_t)k * 2048 + c]; b += bf2f(oab[(size_t)t * 2048 + 1024 + k]) * wb[(size_t)k * 2048 + c]; }
        a = wave_sum(a); b = wave_sum(b);
        const float ref = ((float)((const unsigned char*)ga)[(size_t)t * 2048 + c] * a + (float)((const unsigned char*)gb)[(size_t)t * 2048 + c] * b) * (1.0f / 255.0f), got = bf2f(merged[(size_t)t * 2048 + c]);
        if (lane == 0) report(ctl, 4, (got - ref) * (got - ref), ref * ref); }
}
__device__ __forceinline__ void check_z(gu32* ctl, const bf16* merged, const float* wo, const bf16* xres, const bf16* z, int gw, int ngw, int lane) {
    for (int s = gw; s < 2048; s += ngw) { const unsigned hsh = hash32(s * 668265263u + 31u); const int t = hsh % T, c = (hsh >> 14) % 2048;
        float a = 0.f; for (int k = lane; k < 2048; k += 64) a += bf2f(merged[(size_t)t * 2048 + k]) * wo[(size_t)k * 2048 + c];
        a = wave_sum(a);
        const float got = bf2f(z[(size_t)t * 2048 + c]) - ALPHA * bf2f(xres[(size_t)t * 2048 + c]);
        if (lane == 0) report(ctl, 5, (got - a) * (got - a), a * a); }
}
}
#endif

constexpr int NPHASE = 2 + 8 * DEPTH;
#ifndef MK_ALIGN
#define MK_ALIGN true
#endif
#ifndef MK_SP2
#define MK_SP2 true
#endif
struct Params { const float* in[16]; float* out; unsigned char* ws; int ph_lo, ph_hi; };

__global__ void __launch_bounds__(NWAVES * 64, 2) mk_fwd(Params args) {
    extern __shared__ __attribute__((aligned(16))) unsigned char lds_raw[];
    Frame F;
    F.lds = (LAS unsigned char*)lds_raw;
    F.MISC = (volatile LAS unsigned*)(F.lds + MISC_OFF);
    F.tid = threadIdx.x; F.lane = F.tid & 63; F.wave = __builtin_amdgcn_readfirstlane(F.tid >> 6);
    F.G = gridDim.x; { const int bx = blockIdx.x; F.vcu = (F.G % 8 == 0) ? (bx % 8) * (F.G / 8) + bx / 8 : bx; }
    F.ws = args.ws; F.ctl = (gu32*)(args.ws + WS_CTL);
    unsigned char* const ws = args.ws;
    const float* const in_x = args.in[0]; const int* const in_pos = (const int*)args.in[1];
    const float *in_win = args.in[2], *in_wa = args.in[3], *in_wb = args.in[4], *in_wo = args.in[5], *in_dlam = args.in[6], *in_dgain = args.in[7];
    const float *in_ln1g = args.in[8], *in_ln1b = args.in[9], *in_ln2g = args.in[10], *in_ln2b = args.in[11], *in_pwq = args.in[12], *in_sk = args.in[13], *in_pu = args.in[14], *in_pv = args.in[15];
    float* const dout = args.out;

    for (int u = F.tid; u < (LDS_BYTES - LDSCTL_OFF) / 4; u += NWAVES * 64) ((LAS unsigned*)(F.lds + LDSCTL_OFF))[u] = 0u;
    __syncthreads();
#if MK_FUSED
    XcdBarrier bar = xcd_barrier_post((unsigned*)(F.ctl + CW_BAR), F.MISC + 8, (unsigned)F.wave);
#define GRID_BAR() xcd_barrier(bar)
#else
#define GRID_BAR() do { } while (0)
#endif
    const int lo = args.ph_lo, hi = args.ph_hi;
#define IN(k) (lo <= (k) && (k) < hi)
#define BOTH(k) (IN(k) && IN((k) + 1))

    float* const cosA = (float*)(ws + WS_ROPE); float* const sinA = cosA + (size_t)T * 64; float* const cosB = sinA + (size_t)T * 64; float* const sinB = cosB + (size_t)T * 32;
    bf16* const XB = (bf16*)(ws + WS_XB);

    gu32* const wmax = F.ctl + CW_WMAX;
    if (IN(0)) {
        for (int it = F.wave * F.G + F.vcu; it < DEPTH * 16 * 40; it += F.G * NWAVES) { const int layer = it / 640;
            p0_absmax_item(in_win + (size_t)layer * 2048 * 10240, it % 640, F.lane, wmax + layer * 10240); }
        if (BOTH(0)) GRID_BAR();
    }
    if (IN(1)) {
        LAS float* scr = (LAS float*)(F.lds + F.wave * 16384);
        const int gw = F.vcu * NWAVES + F.wave, NGW = F.G * NWAVES;
        constexpr int I_IN = (2048 / 64) * (10240 / 32), I_A = (1024 / 64) * (2048 / 32), I_O = (2048 / 64) * (2048 / 32);
        constexpr int PER_LAYER = I_IN + 2 * I_A + 2 * I_O;
        for (int it = gw; it < DEPTH * PER_LAYER; it += NGW) {
            const int layer = it / PER_LAYER; int r = it % PER_LAYER;
            unsigned char* wl = ws + WS_W + (size_t)layer * W_LAYER;
            if (r < I_IN) { p0_transpose_item_i8(in_win + (size_t)layer * 2048 * 10240, 2048, 10240, wl + WO_MAIN, scr, r, F.lane, wmax + layer * 10240); continue; } r -= I_IN;
            if (r < I_A) { p0_transpose_item<false>(in_wa + (size_t)layer * 1024 * 2048, 1024, 2048, (bf16*)(wl + WO_A), scr, r, F.lane, 2048, 0); continue; } r -= I_A;
            if (r < I_A) { p0_transpose_item<false>(in_wb + (size_t)layer * 1024 * 2048, 1024, 2048, (bf16*)(wl + WO_A), scr, r, F.lane, 2048, 1024); continue; } r -= I_A;
            if (r < I_O) { p0_transpose_item<false>(in_wo + (size_t)layer * 2048 * 2048, 2048, 2048, (bf16*)(wl + WO_O), scr, r, F.lane); continue; } r -= I_O;
            p0_transpose_item<false>(in_pwq + (size_t)layer * 2048 * 2048, 2048, 2048, (bf16*)(wl + WO_Q), scr, r, F.lane);
        }
        const size_t gtid = (size_t)F.vcu * 512 + F.tid, gthreads = (size_t)F.G * 512;
        for (int r = gw; r < 4 * NEXP; r += NGW) { const int tab = r >> 14, e = r & (NEXP - 1);
            const float* src = ((tab & 1) ? in_pv : in_pu) + ((size_t)(tab >> 1) * NEXP + e) * 2048;
            p0_table_row(src, ws + WS_TAB + (size_t)tab * TAB_BYTES + (size_t)e * 1024, (float*)(ws + WS_TSC) + r, F.lane); }
        p0_convert(in_sk, (bf16*)(ws + WS_SK), (size_t)DEPTH * 2 * 8 * 128 * 128 / 8, gtid, gthreads);
        for (int row = gw; row < T; row += NGW) p0_x_row(in_x + (size_t)row * 2048, XB + (size_t)row * 2048, ws + WS_XI8 + (size_t)row * 2048, (float*)(ws + WS_SX) + row, F.lane);
        for (size_t i = gtid; i < (size_t)DEPTH * 10240; i += gthreads) { const int layer = (int)(i / 10240), n = (int)(i % 10240);
            ((float*)(ws + WS_SW))[layer * 10240 + inproj_row(n)] = __builtin_bit_cast(float, wmax[layer * 10240 + n]) * (1.0f / 127.0f); }
        for (size_t i = gtid; i < (size_t)T * 64; i += gthreads) { const int t = (int)(i >> 6), k = (int)(i & 63);
            const float invf = powf(10000.0f, -(float)(2 * k) / 128.0f); const float ang = (float)in_pos[t] * invf;
            cosA[i] = cosf(ang); sinA[i] = sinf(ang); }
        for (size_t i = gtid; i < (size_t)T * 32; i += gthreads) { const int t = (int)(i >> 5), k = (int)(i & 31);
            const float invf = powf(10000.0f, -(float)(2 * k) / 64.0f); const float ang = (float)in_pos[t] * invf;
            cosB[i] = cosf(ang); sinB[i] = sinf(ang); }
        if (BOTH(1)) GRID_BAR();
    }

    for (int layer = 0; layer < DEPTH; ++layer) {
        const int pb = 2 + 8 * layer;
        unsigned char* const wl = ws + WS_W + (size_t)layer * W_LAYER;
        bf16* const ZB = (bf16*)dout;
        float* const kmean = (float*)(ws + WS_KMEAN) + (size_t)layer * NB * NH * 16 * 128;
        const float lambda_init = layer == 0 ? 0.2f : 0.3555090675909306f;
#define PHASE_TID() int llane_ = lane_id(); asm volatile("" : "+v"(llane_)); const int llane = llane_, ltid = llane_ + 64 * F.wave
        if (IN(pb)) {
            const bf16* const XI8 = (const bf16*)(ws + WS_XI8); const float* const sx = (const float*)(ws + WS_SX); const float* const sw = (const float*)(ws + WS_SW) + layer * 10240;
            { pg8::Gemm g{XI8, (const bf16*)(wl + WO_MAIN), T, NMAIN, 1024}; pg8::StaticOrder S; S.init(T, NMAIN, F.G, (int)blockIdx.x);
              pg8::EpiInProjI8 E{(bf16*)(ws + WS_QA), (bf16*)(ws + WS_KA), (bf16*)(ws + WS_QD), (bf16*)(ws + WS_KD), (bf16*)(ws + WS_GA), (bf16*)(ws + WS_GB), cosA, sinA, cosB, sinB, QSCALE_A, QSCALE_B, sx, sw};
              pg8::gemm_phase<pg8::EpiInProjI8, pg8::StaticOrder, MK_ALIGN, MK_SP2, false, true>(F.lds, g, S, E, F.wave); }
            { pg8::Gemm g{(const bf16*)(wl + WO_V), XI8, NV, T, 1024}; pg8::StaticOrder S; S.init(NV, T, F.G, (int)blockIdx.x);
              pg8::EpiPlainI8 E{(bf16*)(ws + WS_VT), T, sw + NMAIN, sx};
              pg8::gemm_phase<pg8::EpiPlainI8, pg8::StaticOrder, MK_ALIGN, MK_SP2, false, true>(F.lds, g, S, E, F.wave); }
            if (BOTH(pb)) GRID_BAR();
        }
        if (IN(pb + 1)) {
            PHASE_TID();
            LAS float* part = (LAS float*)F.lds;
            const bf16* KA = (const bf16*)(ws + WS_KA);
#pragma unroll 1
            for (int item = F.vcu; item < NB * NH * 16; item += F.G) {
                const int b = item >> 7, h = (item >> 4) & 7, blk = item & 15;
                const int c = ltid & 15, rg = ltid >> 4;
                const bf16* kp = KA + (size_t)(b * SEQ + blk * 256 + rg) * 1024 + h * 128 + c * 8;
                float sacc[8] = {0.f, 0.f, 0.f, 0.f, 0.f, 0.f, 0.f, 0.f};
#pragma unroll
                for (int i = 0; i < 8; ++i) { const v4u w = *(const GAS v4u*)(kp + (size_t)(32 * i) * 1024);
                    sacc[0] += bf_lo(w.x); sacc[1] += bf_hi(w.x); sacc[2] += bf_lo(w.y); sacc[3] += bf_hi(w.y); sacc[4] += bf_lo(w.z); sacc[5] += bf_hi(w.z); sacc[6] += bf_lo(w.w); sacc[7] += bf_hi(w.w); }
#pragma unroll
                for (int j = 0; j < 8; ++j) part[rg * 128 + c * 8 + j] = sacc[j];
                __syncthreads();
                if (ltid < 128) { float t = 0.f;
#pragma unroll
                    for (int r = 0; r < 32; ++r) t += part[r * 128 + ltid];
                    kmean[(size_t)item * 128 + ltid] = t; }
                __syncthreads();
            }
            if (BOTH(pb + 1)) GRID_BAR();
        }
        if (IN(pb + 2)) {
            PHASE_TID();
            const float* lp = in_dlam + (size_t)layer * 256;
            const float s1 = wave_sum(lp[llane] * lp[64 + llane]), s2 = wave_sum(lp[128 + llane] * lp[192 + llane]);
            float lam = __builtin_bit_cast(float, __builtin_amdgcn_readfirstlane(__builtin_bit_cast(int, expf(s1) - expf(s2) + lambda_init))), oml = __builtin_bit_cast(float, __builtin_amdgcn_readfirstlane(layer == 0 ? 0x3f4ccccd : 0x3f24fd5c));
            att::AttnArgs A{(const bf16*)(ws + WS_QA), (const bf16*)(ws + WS_KA), (const bf16*)(ws + WS_QD), (const bf16*)(ws + WS_KD), (const bf16*)(ws + WS_VT),
                            (bf16*)(ws + WS_OA), kmean, in_dgain + (size_t)layer * 1024, lam, oml};
            att::attn_phase(F.lds, A, F.vcu, F.G, ltid, F.wave, llane);
            if (BOTH(pb + 2)) GRID_BAR();
        }
        if (IN(pb + 3)) {
            { pg8::Gemm g{(const bf16*)(ws + WS_OA), (const bf16*)(wl + WO_A), T, 2048, 2048}; pg8::StaticOrder S; S.init(T, 2048, F.G, (int)blockIdx.x);
              pg8::EpiBranch E{(const bf16*)(ws + WS_GA), (const bf16*)(ws + WS_GB), (bf16*)(ws + WS_MERGED), 2048};
              pg8::gemm_phase<pg8::EpiBranch, pg8::StaticOrder, MK_ALIGN, MK_SP2, true>(F.lds, g, S, E, F.wave); }
            if (BOTH(pb + 3)) GRID_BAR();
        }
        if (IN(pb + 4)) {
            pg8::Gemm g{(const bf16*)(ws + WS_MERGED), (const bf16*)(wl + WO_O), T, 2048, 2048}; pg8::StaticOrder S; S.init(T, 2048, F.G, (int)blockIdx.x);
            pg8::EpiOutProj E{XB, ZB, 2048, ALPHA};
            pg8::gemm_phase<pg8::EpiOutProj, pg8::StaticOrder, MK_ALIGN, MK_SP2>(F.lds, g, S, E, F.wave);
            if (BOTH(pb + 4)) GRID_BAR();
        }
        if (IN(pb + 5)) {
            PHASE_TID();
            const int gw = F.vcu * NWAVES + F.wave, NGW = F.G * NWAVES;
            for (int m = gw; m < T; m += NGW) ln_row(ZB + (size_t)m * 2048, in_ln1g + (size_t)layer * 2048, in_ln1b + (size_t)layer * 2048, XB + (size_t)m * 2048, llane);
            if (BOTH(pb + 5)) GRID_BAR();
        }
        if (IN(pb + 6)) {
            pg8::Gemm g{XB, (const bf16*)(wl + WO_Q), T, 2048, 2048}; pg8::StaticOrder S; S.init(T, 2048, F.G, (int)blockIdx.x);
            pg8::EpiPlainBf16 E{(bf16*)(ws + WS_PQ), 2048};
            pg8::gemm_phase<pg8::EpiPlainBf16, pg8::StaticOrder, MK_ALIGN, MK_SP2>(F.lds, g, S, E, F.wave);
            if (BOTH(pb + 6)) GRID_BAR();
        }
        if (IN(pb + 7)) {
            const unsigned char* TU = ws + WS_TAB + (size_t)(2 * layer) * TAB_BYTES; const unsigned char* TV = ws + WS_TAB + (size_t)(2 * layer + 1) * TAB_BYTES;
            const float* SU = (const float*)(ws + WS_TSC) + (size_t)(2 * layer) * NEXP; const float* SV = SU + NEXP;
            const bf16* sk = (const bf16*)(ws + WS_SK) + (size_t)layer * 2 * 8 * 128 * 128;
            const bool last = (layer == DEPTH - 1);
            PHASE_TID();
#pragma unroll 1
            for (int tile = F.vcu; tile < T / 32; tile += F.G) {
                const int t0 = tile * 32;
                peer::select_tile(F.lds, (const bf16*)(ws + WS_PQ), sk, t0, F.wave, llane);
                __syncthreads();
#pragma unroll 1
                for (int i = 0; i < 4; ++i) { const int tl = F.wave * 4 + i; const size_t t = (size_t)(t0 + tl);
                    peer::token_ffn(F.lds, tl, XB + t * 2048, TU, TV, SU, SV, in_ln2g + (size_t)layer * 2048, in_ln2b + (size_t)layer * 2048, last ? dout + t * 2048 : (float*)nullptr, last ? (bf16*)nullptr : XB + t * 2048, ws + WS_XI8 + t * 2048, (float*)(ws + WS_SX) + t, llane); }
                __syncthreads();
            }
            if (BOTH(pb + 7)) GRID_BAR();
        }
    }
#undef PHASE_TID
#undef IN
#undef BOTH
#undef GRID_BAR
}

#if MK_CHECK
__global__ void __launch_bounds__(NWAVES * 64, 2) chk_kernel(Params args, int layer, int which) {
    extern __shared__ __attribute__((aligned(16))) unsigned char lds_raw[];
    LAS unsigned char* lds = (LAS unsigned char*)lds_raw;
    const int tid = threadIdx.x, lane = tid & 63, wave = __builtin_amdgcn_readfirstlane(tid >> 6), G = gridDim.x, vcu = blockIdx.x;
    unsigned char* const ws = args.ws; gu32* ctl = (gu32*)(ws + WS_CTL);
    const bf16* xresb = (const bf16*)(ws + WS_XB);
    float* const kmean = (float*)(ws + WS_KMEAN) + (size_t)layer * NB * NH * 16 * 128;
    const float lambda_init = layer == 0 ? 0.2f : 0.3555090675909306f;
    const int gw = vcu * NWAVES + wave, NGW = G * NWAVES;
    if (which == 0) {
        const float* lp = args.in[6] + (size_t)layer * 256;
        const float s1 = wave_sum(lp[lane] * lp[64 + lane]), s2 = wave_sum(lp[128 + lane] * lp[192 + lane]);
        const float lam = expf(s1) - expf(s2) + lambda_init;
        att::AttnArgs A{(const bf16*)(ws + WS_QA), (const bf16*)(ws + WS_KA), (const bf16*)(ws + WS_QD), (const bf16*)(ws + WS_KD), (const bf16*)(ws + WS_VT),
                        (bf16*)(ws + WS_OA), kmean, args.in[7] + (size_t)layer * 1024, lam, 1.0f - lambda_init};
        chk::check_inproj(ctl, xresb, (const int*)args.in[1], args.in[2] + (size_t)layer * 2048 * 10240, A.qa, A.ka, A.qd, A.kd, A.vt, (const bf16*)(ws + WS_GA), (const bf16*)(ws + WS_GB), gw, NGW, lane);
        chk::check_kmean(ctl, A.ka, kmean, gw, NGW, lane);
        chk::check_attn(lds, ctl, A, vcu, G, tid, lane, wave);
    } else if (which == 3) {
        const float oscale = 1.0f + 0.04f * (float)__hip_atomic_load(ctl + chk::CW_ERR + 64, RLX_AGENT);
        for (size_t i = (size_t)vcu * 512 + tid; i < (size_t)T * 2048 / 4; i += (size_t)G * 512) { f32x4 v = *(GAS f32x4*)(args.out + i * 4); v = v * oscale; *(GAS f32x4*)(args.out + i * 4) = v; }
    } else if (which == 2) {
        if (vcu == 0 && tid == 0) { const float tol[6] = {1e-3f, 1e-4f, 3e-2f, 3e-3f, 1e-3f, 1e-3f}; unsigned code = 0;
            for (int st = 0; st < 6; ++st) { const float d2 = __builtin_bit_cast(float, __hip_atomic_load(ctl + chk::CW_ERR + 2 * st, RLX_AGENT)), r2 = __builtin_bit_cast(float, __hip_atomic_load(ctl + chk::CW_ERR + 2 * st + 1, RLX_AGENT));
                if (!(d2 <= tol[st] * r2) || !(r2 > 0.f)) code |= 1u << st; }
#ifdef MK_CHECK_STAGE
            { const float d2 = __builtin_bit_cast(float, __hip_atomic_load(ctl + chk::CW_ERR + 2 * MK_CHECK_STAGE, RLX_AGENT)), r2 = __builtin_bit_cast(float, __hip_atomic_load(ctl + chk::CW_ERR + 2 * MK_CHECK_STAGE + 1, RLX_AGENT));
              float ratio = d2 / r2; ratio = fminf(fmaxf(ratio, 1e-8f), 1e4f); code = (unsigned)(int)(4.0f * (log10f(ratio) + 8.0f) + 0.5f); }
#endif
            __hip_atomic_store(ctl + chk::CW_ERR + 64, code, RLX_AGENT); }
    } else {
        chk::check_merged(ctl, (const bf16*)(ws + WS_OA), (const bf16*)(ws + WS_GA), (const bf16*)(ws + WS_GB), (const bf16*)(ws + WS_MERGED), args.in[3] + (size_t)layer * 1024 * 2048, args.in[4] + (size_t)layer * 1024 * 2048, gw, NGW, lane);
        chk::check_z(ctl, (const bf16*)(ws + WS_MERGED), args.in[5] + (size_t)layer * 2048 * 2048, xresb, (const bf16*)args.out, gw, NGW, lane);
    }
}
#endif

extern "C" void kernel_launch(void* const* d_in, const int* in_sizes, int n_in, void* d_out, int out_size, void* d_ws, size_t ws_size, hipStream_t stream) {
    static int grid = 0;
    if (grid == 0) {
        if (n_in != 16 || out_size != T * DM || ws_size < WS_END) { fprintf(stderr, "kernel_launch: unexpected problem (n_in %d, out %d, ws %zu < %zu); nothing launched\n", n_in, out_size, ws_size, (size_t)WS_END); grid = -1; return; }
        int dev = 0, cus = 0, per_cu = 0;
        if (hipGetDevice(&dev) != hipSuccess || hipDeviceGetAttribute(&cus, hipDeviceAttributeMultiprocessorCount, dev) != hipSuccess) { fprintf(stderr, "kernel_launch: device query failed\n"); grid = -1; return; }
#if MK_CHECK
        (void)hipFuncSetAttribute((const void*)chk_kernel, hipFuncAttributeMaxDynamicSharedMemorySize, LDS_BYTES);
#endif
        if (hipFuncSetAttribute((const void*)mk_fwd, hipFuncAttributeMaxDynamicSharedMemorySize, LDS_BYTES) != hipSuccess) { fprintf(stderr, "kernel_launch: hipFuncSetAttribute failed\n"); grid = -1; return; }
        if (hipOccupancyMaxActiveBlocksPerMultiprocessor(&per_cu, (const void*)mk_fwd, NWAVES * 64, LDS_BYTES) != hipSuccess || per_cu < 1) { fprintf(stderr, "kernel_launch: occupancy query says %d blocks per CU; nothing launched\n", per_cu); (void)hipGetLastError(); grid = -1; return; }
        grid = cus;
    }
    if (grid < 0) return;
    (void)hipMemsetAsync((char*)d_ws + WS_CTL, 0, CTL_ZERO_BYTES, stream);
    Params a{};
    for (int i = 0; i < 16; ++i) a.in[i] = (const float*)d_in[i];
    a.out = (float*)d_out; a.ws = (unsigned char*)d_ws;
#if MK_FUSED
    a.ph_lo = 0; a.ph_hi = NPHASE;
    hipLaunchKernelGGL(mk_fwd, dim3(grid), dim3(NWAVES * 64), LDS_BYTES, stream, a);
#else
    for (int ph = 0; ph < NPHASE; ++ph) { a.ph_lo = ph; a.ph_hi = ph + 1; hipLaunchKernelGGL(mk_fwd, dim3(grid), dim3(NWAVES * 64), LDS_BYTES, stream, a);
#if MK_CHECK
        if (ph == 2 + 8 * MK_CHECK_LAYER + 2) hipLaunchKernelGGL(chk_kernel, dim3(grid), dim3(NWAVES * 64), LDS_BYTES, stream, a, (int)MK_CHECK_LAYER, 0);
        if (ph == 2 + 8 * MK_CHECK_LAYER + 4) hipLaunchKernelGGL(chk_kernel, dim3(grid), dim3(NWAVES * 64), LDS_BYTES, stream, a, (int)MK_CHECK_LAYER, 1);
        if (ph == NPHASE - 2) hipLaunchKernelGGL(chk_kernel, dim3(grid), dim3(NWAVES * 64), LDS_BYTES, stream, a, (int)MK_CHECK_LAYER, 2);
        if (ph == NPHASE - 1) hipLaunchKernelGGL(chk_kernel, dim3(grid), dim3(NWAVES * 64), LDS_BYTES, stream, a, (int)MK_CHECK_LAYER, 3);
#endif
    }
#endif
}
```

```cpp
#include <hip/hip_runtime.h>
#include <cstdio>
#include <cstdint>

#ifndef MK_FUSED
#define MK_FUSED 1
#endif
#ifndef MK_CHECK
#define MK_CHECK 0
#endif
#ifndef MK_CHECK_LAYER
#define MK_CHECK_LAYER 0
#endif

namespace cfg {
constexpr int DM = 2048, NB = 4, SEQ = 4096, T = NB * SEQ, DEPTH = 2;
constexpr int NH = 8, HD = 128, AW = NH * HD;
constexpr int INC = 10240;
constexpr int NMAIN = 8192, NV = 2048;
constexpr int PH = 8, PKEYS = 128, PTOP = 16, NEXP = PKEYS * PKEYS, PHALF = 128;
constexpr float LN_EPS = 1e-5f, RMS_EPS = 1e-6f;
constexpr float ALPHA = 1.4142135623730951f;
constexpr float LOG2E = 1.4426950408889634f;
constexpr float QSCALE_A = 0.08838834764831845f * LOG2E;
constexpr float QSCALE_B = 0.125f * LOG2E;
}
using namespace cfg;

constexpr size_t MiB = 1u << 20;
constexpr size_t WS_CTL = 0, CTL_ZERO_BYTES = 1 * MiB;
constexpr size_t WS_SK = 1 * MiB;
constexpr size_t WS_KMEAN = 2 * MiB;
constexpr size_t WS_TSC = 3 * MiB;
constexpr size_t WS_ROPE = 4 * MiB;
constexpr size_t WS_W = 20 * MiB, W_LAYER = 64 * MiB;
constexpr size_t WO_MAIN = 0, WO_V = 16 * MiB, WO_A = 40 * MiB, WO_O = 48 * MiB, WO_Q = 56 * MiB;
constexpr size_t WS_TAB = 148 * MiB, TAB_BYTES = 16 * MiB;
constexpr size_t WS_XI8 = 212 * MiB;
constexpr size_t WS_SX = 244 * MiB;
constexpr size_t WS_SW = 245 * MiB;
constexpr size_t WS_XB = 404 * MiB;
constexpr size_t WS_QA = 596 * MiB, WS_KA = 628 * MiB, WS_QD = 660 * MiB, WS_KD = 692 * MiB;
constexpr size_t WS_PQ = WS_QA;
constexpr size_t WS_VT = 724 * MiB;
constexpr size_t WS_MERGED = WS_VT;
constexpr size_t WS_GA = 788 * MiB, WS_GB = 852 * MiB;
constexpr size_t WS_OA = 916 * MiB;
constexpr size_t WS_END = 980 * MiB;

constexpr int CW_BAR = 4096;
constexpr int CW_WMAX = 16384;

constexpr int RING_BYTES = 131072;
constexpr int LDSCTL_OFF = RING_BYTES, MISC_OFF = LDSCTL_OFF + 320;
constexpr int LDS_BYTES = 147456;
constexpr int NWAVES = 8;

#define GAS __attribute__((address_space(1)))
#define LAS __attribute__((address_space(3)))
typedef unsigned short bf16;
typedef unsigned v4u __attribute__((ext_vector_type(4)));
typedef unsigned v2u __attribute__((ext_vector_type(2)));
typedef float f32x4 __attribute__((ext_vector_type(4)));
typedef float f32x16 __attribute__((ext_vector_type(16)));
typedef short bf16x8 __attribute__((ext_vector_type(8)));
typedef GAS unsigned gu32;
#define RLX_AGENT __ATOMIC_RELAXED, __HIP_MEMORY_SCOPE_AGENT
#define LDS_WAIT() asm volatile("s_waitcnt lgkmcnt(0)" ::: "memory")
#define VM_WAIT() asm volatile("s_waitcnt vmcnt(0)" ::: "memory")
__device__ __forceinline__ unsigned f2bf(float f) { unsigned u = __builtin_bit_cast(unsigned, f); return (u + 0x7fffu + ((u >> 16) & 1u)) >> 16; }
__device__ __forceinline__ unsigned pk2(float lo, float hi) { return f2bf(lo) | (f2bf(hi) << 16); }
__device__ __forceinline__ float bf_lo(unsigned w) { return __builtin_bit_cast(float, w << 16); }
__device__ __forceinline__ float bf_hi(unsigned w) { return __builtin_bit_cast(float, w & 0xffff0000u); }
__device__ __forceinline__ float fexp2(float x) { return __builtin_amdgcn_exp2f(x); }
__device__ __forceinline__ float frcp(float x) { return __builtin_amdgcn_rcpf(x); }
__device__ __forceinline__ int lane_id() { return (int)__builtin_amdgcn_mbcnt_hi(~0u, __builtin_amdgcn_mbcnt_lo(~0u, 0u)); }
__device__ __forceinline__ float wave_sum(float v) {
#pragma unroll
    for (int o = 1; o < 64; o <<= 1) v += __shfl_xor(v, o);
    return v;
}
namespace pg8 {
#define PG8_LAS __attribute__((address_space(3)))
typedef unsigned short bf16_t;
typedef short bf16x8 __attribute__((ext_vector_type(8)));
typedef float f32x4 __attribute__((ext_vector_type(4)));
typedef unsigned u32x4 __attribute__((ext_vector_type(4)));
typedef int i32x4 __attribute__((ext_vector_type(4)));
constexpr int BM = 256, BK = 64, HALF = 128, HTB = HALF * BK * 2  , STAGE_BYTES = 8 * HTB, NXCD = 8, WGM = 8;

__host__ __device__ __forceinline__ int lds_byte(int r, int c) { const int st = (r >> 4) * 2 + (c >> 5), rr = r & 15, cc = c & 31, ob = rr * 64 + cc * 2; return st * 1024 + (ob ^ (((ob >> 9) & 1) << 5)); }
__host__ __device__ __forceinline__ void stage_rc(int b, int& R, int& C) { const int st = b / 1024, sb = b % 1024, swz = sb ^ (((sb >> 9) & 1) << 5); R = (st >> 1) * 16 + swz / 64; C = (st & 1) * 32 + (swz % 64) / 2; }
__host__ __device__ __forceinline__ int perm32(int rho) { const int n = rho >> 4, i = rho & 15; return 8 * (i >> 2) + 4 * n + (i & 3); }

template <bool I8> struct AccSel { typedef f32x4 type; };
template <> struct AccSel<true> { typedef i32x4 type; };
template <bool I8> __device__ __forceinline__ typename AccSel<I8>::type mma16(const bf16x8& b, const bf16x8& a, const typename AccSel<I8>::type& c) {
    if constexpr (I8) return __builtin_amdgcn_mfma_i32_16x16x64_i8(__builtin_bit_cast(i32x4, b), __builtin_bit_cast(i32x4, a), c, 0, 0, 0);
    else return __builtin_amdgcn_mfma_f32_16x16x32_bf16(b, a, c, 0, 0, 0);
}
struct Unit { int pm, pn; };
struct Gemm { const bf16_t* A; const bf16_t* Bt; int M, N, K; };

struct StaticOrder {
    int nM, nN, nwg, G, c;
    __host__ __device__ void init(int M, int N, int G_, int c_) { nM = M / BM; nN = N / BM; nwg = nM * nN; G = G_; c = c_; }
    __host__ __device__ bool next(int i, Unit& u) const {
        const long L = (long)i * G + c; if (L >= nwg) return false;
        int wgid = (int)L; { const int q = nwg / NXCD, r = nwg % NXCD, xcd = wgid % NXCD, off = wgid / NXCD; wgid = (xcd < r ? xcd * (q + 1) : r * (q + 1) + (xcd - r) * q) + off; }
        const int nig = WGM * nN, gid = wgid / nig, fm = gid * WGM, gsz = (nM - fm) < WGM ? (nM - fm) : WGM;
        u.pm = fm + ((wgid % nig) % gsz); u.pn = (wgid % nig) / gsz; return true;
    }
    __device__ __forceinline__ void a_ready(const Unit&) const {}
    __device__ __forceinline__ void done(const Unit&) const {}
};

typedef float f32x2cv __attribute__((ext_vector_type(2))); typedef __bf16 bf16x2cv __attribute__((ext_vector_type(2)));
__device__ __forceinline__ unsigned cvt_pk_bf16(float lo, float hi) { f32x2cv v = {lo, hi}; bf16x2cv b = __builtin_convertvector(v, bf16x2cv); return __builtin_bit_cast(unsigned, b); }

typedef unsigned u32x2 __attribute__((ext_vector_type(2)));
struct EpiPlainBf16 {
    static constexpr bool PERM = true, AFTER_DRAIN = false;
    bf16_t* O; int ldc;
    __device__ __forceinline__ void operator()(const f32x4 (&acc)[2][2][4][2], const Unit& u, int wr, int wc, int fr_, int fq_) const {
        int fr = fr_, fq = fq_; asm volatile("" : "+v"(fr), "+v"(fq));
        const int row0 = u.pm * BM + wr * 64 + fr, col0 = u.pn * BM + wc * 32 + 8 * fq;
#pragma unroll
        for (int ai = 0; ai < 2; ++ai)
#pragma unroll
            for (int m = 0; m < 4; ++m) { bf16_t* rowp = O + (size_t)(row0 + ai * HALF + m * 16) * ldc + col0;
#pragma unroll
                for (int bj = 0; bj < 2; ++bj) { const f32x4 v0 = acc[ai][bj][m][0], v1 = acc[ai][bj][m][1];
                    u32x4 w; w.x = cvt_pk_bf16(v0[0], v0[1]); w.y = cvt_pk_bf16(v0[2], v0[3]); w.z = cvt_pk_bf16(v1[0], v1[1]); w.w = cvt_pk_bf16(v1[2], v1[3]);
                    *(u32x4*)(rowp + bj * HALF) = w; } }
    }
};
struct EpiBranch {
    static constexpr bool PERM = true, AFTER_DRAIN = false;
    const bf16_t* ga; const bf16_t* gb; bf16_t* O; int ldc;
    __device__ __forceinline__ void mid(f32x4 (&acc)[2][2][4][2], const Unit& u, int wr, int wc, int fr_, int fq_) const {
        int fr = fr_, fq = fq_; asm volatile("" : "+v"(fr), "+v"(fq));
        const int row0 = u.pm * BM + wr * 64 + fr, col0 = u.pn * BM + wc * 32 + 8 * fq;
#pragma unroll
        for (int ai = 0; ai < 2; ++ai)
#pragma unroll
            for (int m = 0; m < 4; ++m) { const size_t off = (size_t)(row0 + ai * HALF + m * 16) * ldc + col0;
#pragma unroll
                for (int bj = 0; bj < 2; ++bj) { const u32x2 a = *(const u32x2*)((const unsigned char*)ga + off + bj * HALF), b = *(const u32x2*)((const unsigned char*)gb + off + bj * HALF);
#define PG8_RATIO(x, y, k) ((float)(((x) >> (8 * (k))) & 255u) * __builtin_amdgcn_rcpf((float)(((y) >> (8 * (k))) & 255u)))
                    f32x4 r0, r1;
                    r0[0] = PG8_RATIO(a.x, b.x, 0); r0[1] = PG8_RATIO(a.x, b.x, 1); r0[2] = PG8_RATIO(a.x, b.x, 2); r0[3] = PG8_RATIO(a.x, b.x, 3);
                    r1[0] = PG8_RATIO(a.y, b.y, 0); r1[1] = PG8_RATIO(a.y, b.y, 1); r1[2] = PG8_RATIO(a.y, b.y, 2); r1[3] = PG8_RATIO(a.y, b.y, 3);
#undef PG8_RATIO
                    acc[ai][bj][m][0] = acc[ai][bj][m][0] * r0; acc[ai][bj][m][1] = acc[ai][bj][m][1] * r1; } }
    }
    __device__ __forceinline__ void operator()(const f32x4 (&acc)[2][2][4][2], const Unit& u, int wr, int wc, int fr_, int fq_) const {
        int fr = fr_, fq = fq_; asm volatile("" : "+v"(fr), "+v"(fq));
        const int row0 = u.pm * BM + wr * 64 + fr, col0 = u.pn * BM + wc * 32 + 8 * fq;
#pragma unroll
        for (int ai = 0; ai < 2; ++ai)
#pragma unroll
            for (int m = 0; m < 4; ++m) { const size_t off = (size_t)(row0 + ai * HALF + m * 16) * ldc + col0;
#pragma unroll
                for (int bj = 0; bj < 2; ++bj) { const u32x2 g = *(const u32x2*)((const unsigned char*)gb + off + bj * HALF);
                    const f32x4 v0 = acc[ai][bj][m][0], v1 = acc[ai][bj][m][1]; const float q = 1.0f / 255.0f;
                    f32x4 o0, o1;
                    o0[0] = v0[0] * ((float)(g.x & 255u) * q); o0[1] = v0[1] * ((float)((g.x >> 8) & 255u) * q); o0[2] = v0[2] * ((float)((g.x >> 16) & 255u) * q); o0[3] = v0[3] * ((float)(g.x >> 24) * q);
                    o1[0] = v1[0] * ((float)(g.y & 255u) * q); o1[1] = v1[1] * ((float)((g.y >> 8) & 255u) * q); o1[2] = v1[2] * ((float)((g.y >> 16) & 255u) * q); o1[3] = v1[3] * ((float)(g.y >> 24) * q);
                    u32x4 w; w.x = cvt_pk_bf16(o0[0], o0[1]); w.y = cvt_pk_bf16(o0[2], o0[3]); w.z = cvt_pk_bf16(o1[0], o1[1]); w.w = cvt_pk_bf16(o1[2], o1[3]);
                    *(u32x4*)(O + off + bj * HALF) = w; } }
    }
};
struct EpiOutProj {
    static constexpr bool PERM = true, AFTER_DRAIN = false;
    const bf16_t* xres; bf16_t* z; int ldc; float alpha;
    __device__ __forceinline__ void operator()(const f32x4 (&acc)[2][2][4][2], const Unit& u, int wr, int wc, int fr_, int fq_) const {
        int fr = fr_, fq = fq_; asm volatile("" : "+v"(fr), "+v"(fq));
        const int row0 = u.pm * BM + wr * 64 + fr, col0 = u.pn * BM + wc * 32 + 8 * fq;
#pragma unroll
        for (int ai = 0; ai < 2; ++ai)
#pragma unroll
            for (int m = 0; m < 4; ++m) { const size_t off = (size_t)(row0 + ai * HALF + m * 16) * ldc + col0;
#pragma unroll
                for (int bj = 0; bj < 2; ++bj) { const u32x4 x = *(const u32x4*)(xres + off + bj * HALF);
                    const f32x4 v0 = acc[ai][bj][m][0], v1 = acc[ai][bj][m][1];
                    f32x4 o0, o1;
                    o0[0] = v0[0] + alpha * __builtin_bit_cast(float, x.x << 16); o0[1] = v0[1] + alpha * __builtin_bit_cast(float, x.x & 0xffff0000u);
                    o0[2] = v0[2] + alpha * __builtin_bit_cast(float, x.y << 16); o0[3] = v0[3] + alpha * __builtin_bit_cast(float, x.y & 0xffff0000u);
                    o1[0] = v1[0] + alpha * __builtin_bit_cast(float, x.z << 16); o1[1] = v1[1] + alpha * __builtin_bit_cast(float, x.z & 0xffff0000u);
                    o1[2] = v1[2] + alpha * __builtin_bit_cast(float, x.w << 16); o1[3] = v1[3] + alpha * __builtin_bit_cast(float, x.w & 0xffff0000u);
                    u32x4 w; w.x = cvt_pk_bf16(o0[0], o0[1]); w.y = cvt_pk_bf16(o0[2], o0[3]); w.z = cvt_pk_bf16(o1[0], o1[1]); w.w = cvt_pk_bf16(o1[2], o1[3]);
                    *(u32x4*)(z + off + bj * HALF) = w; } }
    }
};
struct EpiInProj {
    static constexpr bool PERM = false, AFTER_DRAIN = false;
    bf16_t *qa, *ka, *qd, *kd, *ga, *gb; const float *cosA, *sinA, *cosB, *sinB; float qsa, qsb;
    __device__ __forceinline__ void operator()(const f32x4 (&acc)[2][2][4][2], const Unit& u, int wr, int wc, int fr_, int fq_) const {
        int fr = fr_, fq = fq_; asm volatile("" : "+v"(fr), "+v"(fq));
        const int row0 = u.pm * BM + wr * 64 + fr;
        const int ty = u.pn >> 2;
        if (ty >= 4) {
            unsigned char* dst = (unsigned char*)(ty < 6 ? ga : gb); const int col0 = (u.pn - (ty < 6 ? 16 : 24)) * BM + wc * 32 + 4 * fq; const float lo = ty < 6 ? 0.0f : 1.0f;
#pragma unroll
            for (int ai = 0; ai < 2; ++ai)
#pragma unroll
                for (int m = 0; m < 4; ++m) { unsigned char* rowp = dst + (size_t)(row0 + ai * HALF + m * 16) * 2048 + col0;
#pragma unroll
                    for (int bj = 0; bj < 2; ++bj)
#pragma unroll
                        for (int n = 0; n < 2; ++n) { const f32x4 v = acc[ai][bj][m][n]; unsigned w = 0u;
#pragma unroll
                            for (int j = 0; j < 4; ++j) { const float s = __builtin_amdgcn_rcpf(1.0f + __builtin_amdgcn_exp2f(-1.4426950408889634f * v[j]));
                                w |= (unsigned)fmaxf(s * 255.0f + 0.5f, lo) << (8 * j); }
                            *(unsigned*)(rowp + bj * HALF + n * 16) = w; } }
        } else if (ty < 2) {
            bf16_t* dst = ty == 0 ? qa : ka; const float sc = ty == 0 ? qsa : 1.0f;
            const int i0 = 16 * wc + 4 * fq;
#pragma unroll
            for (int ai = 0; ai < 2; ++ai)
#pragma unroll
                for (int m = 0; m < 4; ++m) { const int row = row0 + ai * HALF + m * 16;
                    const f32x4 c = *(const f32x4*)(cosA + (size_t)row * 64 + i0), s = *(const f32x4*)(sinA + (size_t)row * 64 + i0);
#pragma unroll
                    for (int bj = 0; bj < 2; ++bj) { const int head = 2 * (u.pn & 3) + bj; const f32x4 t1 = acc[ai][bj][m][0], t2 = acc[ai][bj][m][1];
                        const f32x4 o1 = t1 * c - t2 * s, o2 = t1 * s + t2 * c;
                        bf16_t* p = dst + (size_t)row * 1024 + head * 128 + i0;
                        u32x2 w1, w2; w1.x = cvt_pk_bf16(o1[0] * sc, o1[1] * sc); w1.y = cvt_pk_bf16(o1[2] * sc, o1[3] * sc); w2.x = cvt_pk_bf16(o2[0] * sc, o2[1] * sc); w2.y = cvt_pk_bf16(o2[2] * sc, o2[3] * sc);
                        *(u32x2*)p = w1; *(u32x2*)(p + 64) = w2;
                    } }
        } else {
            bf16_t* dst = ty == 2 ? qd : kd; const float sc = ty == 2 ? qsb : 1.0f;
            const int comp = wc >> 1, i0 = 16 * (wc & 1) + 4 * fq;
#pragma unroll
            for (int ai = 0; ai < 2; ++ai)
#pragma unroll
                for (int m = 0; m < 4; ++m) { const int row = row0 + ai * HALF + m * 16;
                    const f32x4 c = *(const f32x4*)(cosB + (size_t)row * 32 + i0), s = *(const f32x4*)(sinB + (size_t)row * 32 + i0);
#pragma unroll
                    for (int bj = 0; bj < 2; ++bj) { const int head = 2 * (u.pn & 3) + bj; const f32x4 t1 = acc[ai][bj][m][0], t2 = acc[ai][bj][m][1];
                        const f32x4 o1 = (t1 * c - t2 * s) * sc, o2 = (t1 * s + t2 * c) * sc;
                        bf16_t* p = dst + (size_t)row * 1024 + head * 128 + comp * 64 + i0;
                        u32x2 w1, w2; w1.x = cvt_pk_bf16(o1[0], o1[1]); w1.y = cvt_pk_bf16(o1[2], o1[3]); w2.x = cvt_pk_bf16(o2[0], o2[1]); w2.y = cvt_pk_bf16(o2[2], o2[3]);
                        *(u32x2*)p = w1; *(u32x2*)(p + 32) = w2;
                    } }
        }
    }
};

__device__ __forceinline__ f32x4 deq4(const i32x4& a, const f32x4& s) { return (f32x4){(float)a[0], (float)a[1], (float)a[2], (float)a[3]} * s; }
struct EpiPlainI8 {
    static constexpr bool PERM = true, AFTER_DRAIN = false;
    bf16_t* O; int ldc; const float* srow; const float* scol;
    __device__ __forceinline__ void operator()(const i32x4 (&acc)[2][2][4][2], const Unit& u, int wr, int wc, int fr_, int fq_) const {
        int fr = fr_, fq = fq_; asm volatile("" : "+v"(fr), "+v"(fq));
        const int row0 = u.pm * BM + wr * 64 + fr, col0 = u.pn * BM + wc * 32 + 8 * fq;
        f32x4 cs[2][2];
#pragma unroll
        for (int bj = 0; bj < 2; ++bj)
#pragma unroll
            for (int n = 0; n < 2; ++n) cs[bj][n] = *(const f32x4*)(scol + col0 + bj * HALF + 4 * n);
#pragma unroll
        for (int ai = 0; ai < 2; ++ai)
#pragma unroll
            for (int m = 0; m < 4; ++m) { const int row = row0 + ai * HALF + m * 16; const float sr = srow[row]; bf16_t* rowp = O + (size_t)row * ldc + col0;
#pragma unroll
                for (int bj = 0; bj < 2; ++bj) { const f32x4 v0 = deq4(acc[ai][bj][m][0], cs[bj][0] * sr), v1 = deq4(acc[ai][bj][m][1], cs[bj][1] * sr);
                    u32x4 w; w.x = cvt_pk_bf16(v0[0], v0[1]); w.y = cvt_pk_bf16(v0[2], v0[3]); w.z = cvt_pk_bf16(v1[0], v1[1]); w.w = cvt_pk_bf16(v1[2], v1[3]);
                    *(u32x4*)(rowp + bj * HALF) = w; } }
    }
};
struct EpiInProjI8 {
    static constexpr bool PERM = false, AFTER_DRAIN = false;
    bf16_t *qa, *ka, *qd, *kd, *ga, *gb; const float *cosA, *sinA, *cosB, *sinB; float qsa, qsb; const float *sx, *sw;
    __device__ __forceinline__ void operator()(const i32x4 (&acc)[2][2][4][2], const Unit& u, int wr, int wc, int fr_, int fq_) const {
        int fr = fr_, fq = fq_; asm volatile("" : "+v"(fr), "+v"(fq));
        const int row0 = u.pm * BM + wr * 64 + fr;
        const int ty = u.pn >> 2;
        f32x4 cs[2][2];
#pragma unroll
        for (int bj = 0; bj < 2; ++bj)
#pragma unroll
            for (int n = 0; n < 2; ++n) cs[bj][n] = *(const f32x4*)(sw + u.pn * BM + bj * HALF + wc * 32 + n * 16 + 4 * fq);
        if (ty >= 4) {
            unsigned char* dst = (unsigned char*)(ty < 6 ? ga : gb); const int col0 = (u.pn - (ty < 6 ? 16 : 24)) * BM + wc * 32 + 4 * fq; const float lo = ty < 6 ? 0.0f : 1.0f;
#pragma unroll
            for (int ai = 0; ai < 2; ++ai)
#pragma unroll
                for (int m = 0; m < 4; ++m) { const int row = row0 + ai * HALF + m * 16; const float sr = sx[row] * -1.4426950408889634f; unsigned char* rowp = dst + (size_t)row * 2048 + col0;
#pragma unroll
                    for (int bj = 0; bj < 2; ++bj)
#pragma unroll
                        for (int n = 0; n < 2; ++n) { const f32x4 v = deq4(acc[ai][bj][m][n], cs[bj][n] * sr); unsigned w = 0u;
#pragma unroll
                            for (int j = 0; j < 4; ++j) { const float s = __builtin_amdgcn_rcpf(1.0f + __builtin_amdgcn_exp2f(v[j]));
                                w |= (unsigned)fmaxf(s * 255.0f + 0.5f, lo) << (8 * j); }
                            *(unsigned*)(rowp + bj * HALF + n * 16) = w; } }
        } else if (ty < 2) {
            bf16_t* dst = ty == 0 ? qa : ka; const float sc = ty == 0 ? qsa : 1.0f;
            const int i0 = 16 * wc + 4 * fq;
#pragma unroll
            for (int ai = 0; ai < 2; ++ai)
#pragma unroll
                for (int m = 0; m < 4; ++m) { const int row = row0 + ai * HALF + m * 16; const float sr = sx[row] * sc;
                    const f32x4 c = *(const f32x4*)(cosA + (size_t)row * 64 + i0), s = *(const f32x4*)(sinA + (size_t)row * 64 + i0);
#pragma unroll
                    for (int bj = 0; bj < 2; ++bj) { const int head = 2 * (u.pn & 3) + bj; const f32x4 t1 = deq4(acc[ai][bj][m][0], cs[bj][0] * sr), t2 = deq4(acc[ai][bj][m][1], cs[bj][1] * sr);
                        const f32x4 o1 = t1 * c - t2 * s, o2 = t1 * s + t2 * c;
                        bf16_t* p = dst + (size_t)row * 1024 + head * 128 + i0;
                        u32x2 w1, w2; w1.x = cvt_pk_bf16(o1[0], o1[1]); w1.y = cvt_pk_bf16(o1[2], o1[3]); w2.x = cvt_pk_bf16(o2[0], o2[1]); w2.y = cvt_pk_bf16(o2[2], o2[3]);
                        *(u32x2*)p = w1; *(u32x2*)(p + 64) = w2;
                    } }
        } else {
            bf16_t* dst = ty == 2 ? qd : kd; const float sc = ty == 2 ? qsb : 1.0f;
            const int comp = wc >> 1, i0 = 16 * (wc & 1) + 4 * fq;
#pragma unroll
            for (int ai = 0; ai < 2; ++ai)
#pragma unroll
                for (int m = 0; m < 4; ++m) { const int row = row0 + ai * HALF + m * 16; const float sr = sx[row] * sc;
                    const f32x4 c = *(const f32x4*)(cosB + (size_t)row * 32 + i0), s = *(const f32x4*)(sinB + (size_t)row * 32 + i0);
#pragma unroll
                    for (int bj = 0; bj < 2; ++bj) { const int head = 2 * (u.pn & 3) + bj; const f32x4 t1 = deq4(acc[ai][bj][m][0], cs[bj][0] * sr), t2 = deq4(acc[ai][bj][m][1], cs[bj][1] * sr);
                        const f32x4 o1 = t1 * c - t2 * s, o2 = t1 * s + t2 * c;
                        bf16_t* p = dst + (size_t)row * 1024 + head * 128 + comp * 64 + i0;
                        u32x2 w1, w2; w1.x = cvt_pk_bf16(o1[0], o1[1]); w1.y = cvt_pk_bf16(o1[2], o1[3]); w2.x = cvt_pk_bf16(o2[0], o2[1]); w2.y = cvt_pk_bf16(o2[2], o2[3]);
                        *(u32x2*)p = w1; *(u32x2*)(p + 32) = w2;
                    } }
        }
    }
};
template <class Epi, class Sched, bool ALIGN_EPI = false, bool SP2 = false, bool MID = false, bool I8 = false>
__device__ __forceinline__ void gemm_phase(PG8_LAS unsigned char* lds, const Gemm g, const Sched& S, const Epi& E, int wave) {
    int tid_ = lane_id(); asm volatile("" : "+v"(tid_)); tid_ += 64 * wave;
    const int tid = tid_, wid = __builtin_amdgcn_readfirstlane(tid >> 6), lane = tid & 63, wr = wid >> 2, wc = wid & 3, fr = lane & 15, fq = lane >> 4;
    const int K = g.K, nt = K / BK;
    unsigned voffA[2], voffB[2];
#pragma unroll
    for (int i = 0; i < 2; ++i) { int R, C; stage_rc(tid * 16 + i * 8192, R, C); const int Rb = Epi::PERM ? ((R & ~31) + perm32(R & 31)) : R;
        voffA[i] = (unsigned)(R * K + C) * 2u; voffB[i] = (unsigned)(Rb * K + C) * 2u; }
    const size_t kstep = (size_t)(BK * 2);
    const size_t hstep = (size_t)HALF * K * 2;
    const size_t tstep = 2 * hstep;
    const unsigned ldsw = (unsigned)wid * 1024u;
    const int aoff = lds_byte(wr * 64 + fr, fq * 8), boff = lds_byte(wc * 32 + fr, fq * 8);
#define PG8_SA(b, h) (((b) * 2 + (h)) * HTB)
#define PG8_SB(b, h) ((4 + (b) * 2 + (h)) * HTB)
#define PG8_STAGE(bufoff, gbase, voff) do { _Pragma("unroll") for (int _i = 0; _i < 2; ++_i) \
        __builtin_amdgcn_global_load_lds((const unsigned*)((const char*)(gbase) + (voff)[_i]), (PG8_LAS unsigned*)(lds + (bufoff) + ldsw + _i * 8192), 16, 0, 0); } while (0)
#define PG8_LDA(dst, b, h) do { _Pragma("unroll") for (int m = 0; m < 4; ++m) _Pragma("unroll") for (int k = 0; k < 2; ++k) dst[m][k] = *(const PG8_LAS bf16x8*)(lds + PG8_SA(b, h) + aoff + m * 2048 + k * 1024); } while (0)
#define PG8_LDB(dst, b, h) do { _Pragma("unroll") for (int n = 0; n < 2; ++n) _Pragma("unroll") for (int k = 0; k < 2; ++k) dst[n][k] = *(const PG8_LAS bf16x8*)(lds + PG8_SB(b, h) + boff + n * 2048 + k * 1024); } while (0)
#define PG8_MMA(ai, bj, At, Bt) do { __builtin_amdgcn_s_setprio(1); _Pragma("unroll") for (int m = 0; m < 4; ++m) _Pragma("unroll") for (int n = 0; n < 2; ++n) _Pragma("unroll") for (int k = 0; k < 2; ++k) \
        acc[ai][bj][m][n] = mma16<I8>(Bt[n][k], At[m][k], acc[ai][bj][m][n]); __builtin_amdgcn_s_setprio(0); } while (0)
#define PG8_WAIT_V(n) asm volatile("s_waitcnt vmcnt(" #n ")" ::: "memory")
#define PG8_WAIT_L(n) asm volatile("s_waitcnt lgkmcnt(" #n ")" ::: "memory")
#define PG8_BAR __builtin_amdgcn_s_barrier()
#define PG8_SCHED __builtin_amdgcn_sched_barrier(0)
    Unit cur, nxt; int ui = 0;
    if (!S.next(0, cur)) return;
    typedef typename AccSel<I8>::type acc_t;
    acc_t acc[2][2][4][2];
#pragma unroll
    for (int a = 0; a < 2; ++a)
#pragma unroll
        for (int b = 0; b < 2; ++b)
#pragma unroll
            for (int m = 0; m < 4; ++m)
#pragma unroll
                for (int n = 0; n < 2; ++n) acc[a][b][m][n] = (acc_t){0, 0, 0, 0};
    bf16x8 At[4][2], B0[2][2], B1[2][2];
    const char* cA = (const char*)g.A + (size_t)cur.pm * tstep; const char* cB = (const char*)g.Bt + (size_t)cur.pn * tstep;
    S.a_ready(cur);
    if constexpr (SP2) {
        PG8_STAGE(PG8_SB(0, 0), cB, voffB); PG8_STAGE(PG8_SB(0, 1), cB + hstep, voffB); PG8_STAGE(PG8_SA(0, 0), cA, voffA); PG8_STAGE(PG8_SA(0, 1), cA + hstep, voffA);
        if (wr == 1) PG8_BAR;
        PG8_WAIT_V(2); PG8_BAR;
        PG8_STAGE(PG8_SB(1, 0), cB + kstep, voffB); PG8_STAGE(PG8_SA(1, 0), cA + kstep, voffA); PG8_STAGE(PG8_SB(1, 1), cB + hstep + kstep, voffB);
        PG8_WAIT_V(6); PG8_BAR;
    } else {
        PG8_STAGE(PG8_SB(0, 0), cB, voffB); PG8_STAGE(PG8_SA(0, 0), cA, voffA); PG8_STAGE(PG8_SB(0, 1), cB + hstep, voffB); PG8_STAGE(PG8_SA(0, 1), cA + hstep, voffA);
        if (wr == 1) PG8_BAR;
        PG8_WAIT_V(4); PG8_BAR;
        PG8_STAGE(PG8_SB(1, 0), cB + kstep, voffB); PG8_STAGE(PG8_SA(1, 0), cA + kstep, voffA); PG8_STAGE(PG8_SB(1, 1), cB + hstep + kstep, voffB);
        PG8_WAIT_V(6); PG8_BAR;
    }
    for (;;) {
        const bool has_next = S.next(ui + 1, nxt);
        const char* nA = has_next ? (const char*)g.A + (size_t)nxt.pm * tstep : cA; const char* nB = has_next ? (const char*)g.Bt + (size_t)nxt.pn * tstep : cB;
        for (int t = 0; t < nt; t += 2) {
            if constexpr (MID) { if (t == nt / 2) E.mid(acc, cur, wr, wc, fr, fq); }
            const bool last = (t == nt - 2);
            const char* a1 = cA + (size_t)(t + 1) * kstep;
            const char* a2 = last ? nA : cA + (size_t)(t + 2) * kstep; const char* b2 = last ? nB : cB + (size_t)(t + 2) * kstep;
            const char* a3 = a2 + kstep; const char* b3 = b2 + kstep;
            if (last && has_next) S.a_ready(nxt);
            if constexpr (SP2) {
            PG8_LDB(B0, 0, 0); PG8_LDB(B1, 0, 1); PG8_SCHED; PG8_LDA(At, 0, 0); PG8_STAGE(PG8_SA(1, 1), a1 + hstep, voffA);
            PG8_WAIT_V(8); PG8_WAIT_L(0); PG8_BAR; PG8_MMA(0, 0, At, B0); PG8_MMA(0, 1, At, B1); PG8_BAR; PG8_SCHED;
            PG8_LDA(At, 0, 1); PG8_STAGE(PG8_SB(0, 0), b2, voffB); PG8_STAGE(PG8_SB(0, 1), b2 + hstep, voffB); PG8_STAGE(PG8_SA(0, 0), a2, voffA);
            PG8_WAIT_V(8); PG8_WAIT_L(0); PG8_BAR; PG8_MMA(1, 0, At, B0); PG8_MMA(1, 1, At, B1); PG8_BAR; PG8_SCHED;
            PG8_LDB(B0, 1, 0); PG8_LDB(B1, 1, 1); PG8_SCHED; PG8_LDA(At, 1, 0); PG8_STAGE(PG8_SA(0, 1), a2 + hstep, voffA);
            PG8_WAIT_V(8); PG8_WAIT_L(0); PG8_BAR; PG8_MMA(0, 0, At, B0); PG8_MMA(0, 1, At, B1); PG8_BAR; PG8_SCHED;
            PG8_LDA(At, 1, 1); PG8_STAGE(PG8_SB(1, 0), b3, voffB); PG8_STAGE(PG8_SB(1, 1), b3 + hstep, voffB); PG8_STAGE(PG8_SA(1, 0), a3, voffA);
            PG8_WAIT_V(8); PG8_WAIT_L(0); PG8_BAR; PG8_MMA(1, 0, At, B0); PG8_MMA(1, 1, At, B1); PG8_BAR; PG8_SCHED;
            } else {
            PG8_LDB(B0, 0, 0); PG8_SCHED; PG8_LDA(At, 0, 0); PG8_STAGE(PG8_SA(1, 1), a1 + hstep, voffA);
            PG8_WAIT_L(8); PG8_BAR; PG8_WAIT_L(0); PG8_MMA(0, 0, At, B0); PG8_BAR; PG8_SCHED;
            PG8_LDB(B1, 0, 1); PG8_STAGE(PG8_SB(0, 0), b2, voffB);
            PG8_BAR; PG8_WAIT_L(0); PG8_MMA(0, 1, At, B1); PG8_BAR;
            PG8_LDA(At, 0, 1); PG8_STAGE(PG8_SA(0, 0), a2, voffA);
            PG8_BAR; PG8_WAIT_L(0); PG8_MMA(1, 0, At, B0); PG8_BAR; PG8_SCHED;
            PG8_STAGE(PG8_SB(0, 1), b2 + hstep, voffB);
            PG8_WAIT_V(6); PG8_BAR; PG8_MMA(1, 1, At, B1); PG8_BAR;
            PG8_LDB(B0, 1, 0); PG8_SCHED; PG8_LDA(At, 1, 0); PG8_STAGE(PG8_SA(0, 1), a2 + hstep, voffA);
            PG8_WAIT_L(8); PG8_BAR; PG8_WAIT_L(0); PG8_MMA(0, 0, At, B0); PG8_BAR; PG8_SCHED;
            PG8_LDB(B1, 1, 1); PG8_STAGE(PG8_SB(1, 0), b3, voffB);
            PG8_BAR; PG8_WAIT_L(0); PG8_MMA(0, 1, At, B1); PG8_BAR;
            PG8_LDA(At, 1, 1); PG8_STAGE(PG8_SA(1, 0), a3, voffA);
            PG8_BAR; PG8_WAIT_L(0); PG8_MMA(1, 0, At, B0); PG8_BAR; PG8_SCHED;
            PG8_STAGE(PG8_SB(1, 1), b3 + hstep, voffB);
            PG8_WAIT_V(6); PG8_BAR; PG8_MMA(1, 1, At, B1); PG8_BAR;
            }
        }
        if constexpr (ALIGN_EPI) { if (wr == 0) PG8_BAR; }
        if constexpr (!Epi::AFTER_DRAIN) { E(acc, cur, wr, wc, fr, fq); S.done(cur); }
        if (!has_next) break;
#pragma unroll
        for (int a = 0; a < 2; ++a)
#pragma unroll
            for (int b = 0; b < 2; ++b)
#pragma unroll
                for (int m = 0; m < 4; ++m)
#pragma unroll
                    for (int n = 0; n < 2; ++n) acc[a][b][m][n] = (acc_t){0, 0, 0, 0};
        cur = nxt; cA = nA; cB = nB; ++ui;
        if constexpr (ALIGN_EPI) { if (wr == 1) PG8_BAR; }
    }
    PG8_WAIT_V(0);
    if constexpr (!ALIGN_EPI) { if (wr == 0) PG8_BAR; }
    PG8_BAR;
    if constexpr (Epi::AFTER_DRAIN) { E.fused(acc, cur, wr, wc, fr, fq, lds, wid, lane); S.done(cur); }
#undef PG8_SA
#undef PG8_SB
#undef PG8_STAGE
#undef PG8_LDA
#undef PG8_LDB
#undef PG8_MMA
#undef PG8_WAIT_V
#undef PG8_WAIT_L
#undef PG8_BAR
#undef PG8_SCHED
}
}
#define XB_TMO      128
#define XB_XCNT(j)  (256  + 64 * (j))
#define XB_XSUB(j)  (1280 + 64 * (j))
#define XB_XGEN(j)  (2304 + 64 * (j))
#define XB_TOP      3328
#define XB_TOPGEN   3392
#define XCD_BAR_WORDS 3456
#define XB_SPIN_CAP (1u << 18)

__device__ __forceinline__ unsigned xb_ld(unsigned* p)              { return __hip_atomic_load(p, __ATOMIC_RELAXED, __HIP_MEMORY_SCOPE_AGENT); }
__device__ __forceinline__ unsigned xb_add(unsigned* p, unsigned v) { return __hip_atomic_fetch_add(p, v, __ATOMIC_RELAXED, __HIP_MEMORY_SCOPE_AGENT); }
__device__ __forceinline__ unsigned xb_xcc_id() { return (unsigned)__builtin_amdgcn_s_getreg((3 << 11) | 20) & 0xFu; }
#define XB_SPIN(cond, bar) do { unsigned _sp = 0; while (cond) { __builtin_amdgcn_s_sleep(1); \
    if ((++_sp & 255u) == 0u) { if (xb_ld(&(bar)[XB_TMO])) break; if (_sp > XB_SPIN_CAP) { atomicAdd(&(bar)[XB_TMO], 1u); break; } } } } while (0)

struct XcdBarrier {
    unsigned* bar; unsigned x; unsigned wv;
    volatile LAS unsigned* st;
};

__device__ __forceinline__ XcdBarrier xcd_barrier_post(unsigned* bar, volatile LAS unsigned* st, unsigned wave) {
    XcdBarrier b; b.bar = bar; b.x = xb_xcc_id(); b.st = st; b.wv = wave;
    if (threadIdx.x == 0) (void)xb_add(&bar[XB_XCNT(b.x)], 1u);
    return b;
}
__device__ __forceinline__ void xcd_barrier_complete(unsigned* bar, unsigned x, unsigned& nloc, unsigned& nx) {
    const unsigned G = gridDim.x * gridDim.y * gridDim.z;
    unsigned sum, cnt, mine, sp = 0u;
    for (;;) {
        sum = 0u; cnt = 0u; mine = 0u;
#pragma unroll 1
        for (unsigned j = 0; j < 16; ++j) { const unsigned c = xb_ld(&bar[XB_XCNT(j)]); sum += c; cnt += (c > 0u) ? 1u : 0u; mine = (j == x) ? c : mine; }
        if (sum == G) break;
        __builtin_amdgcn_s_sleep(1);
        if ((++sp & 255u) == 0u) { if (xb_ld(&bar[XB_TMO])) break; if (sp > XB_SPIN_CAP) { atomicAdd(&bar[XB_TMO], 1u); break; } }
    }
    nloc = mine > 0u ? mine : 1u; nx = cnt > 0u ? cnt : 1u;
}

__device__ __forceinline__ void xcd_barrier(const XcdBarrier& b) {
    asm volatile("s_waitcnt vmcnt(0)" ::: "memory");
    __syncthreads();
    if (b.wv == 0u && lane_id() == 0) {
        unsigned* bar = b.bar;
        __builtin_amdgcn_s_waitcnt(0);
        unsigned nloc = b.st[0], nx = b.st[1];
        if (nloc == 0u) { xcd_barrier_complete(bar, b.x, nloc, nx); b.st[0] = nloc; b.st[1] = nx; }
        const unsigned old = xb_add(&bar[XB_XSUB(b.x)], 1u);
        const unsigned gen = old / nloc;
        if (old + 1u == (gen + 1u) * nloc) {
            __builtin_amdgcn_fence(__ATOMIC_RELEASE, "agent");
            asm volatile("s_waitcnt vmcnt(0)" ::: "memory");
            const unsigned og = xb_add(&bar[XB_TOP], 1u);
            const unsigned tg = og / nx;
            if (og + 1u == (tg + 1u) * nx) xb_add(&bar[XB_TOPGEN], 1u);
            else XB_SPIN(xb_ld(&bar[XB_TOPGEN]) == tg, bar);
            __builtin_amdgcn_fence(__ATOMIC_ACQUIRE, "agent");
            xb_add(&bar[XB_XGEN(b.x)], 1u);
            asm volatile("s_waitcnt vmcnt(0)" ::: "memory");
        } else {
            XB_SPIN(xb_ld(&bar[XB_XGEN(b.x)]) == gen, bar);
            __builtin_amdgcn_fence(__ATOMIC_ACQUIRE, "agent");
            asm volatile("s_waitcnt vmcnt(0)" ::: "memory");
        }
    }
    __syncthreads();
}


struct Frame {
    LAS unsigned char* lds;
    volatile LAS unsigned* MISC;
    gu32* ctl;
    int tid, lane, wave;
    int vcu, G;
    unsigned char* ws;
};

__device__ __forceinline__ int inproj_row(int n) {
    const int seg = n >> 10, r = n & 1023;
    if (seg >= 6) return (seg < 8 ? 4096 : 6144) + (n - (seg < 8 ? 6144 : 8192));
    if (seg == 2) return 8192 + r;
    if (seg == 5) return 8192 + 1024 + r;
    const int head = r >> 7, d = r & 127;
    if (seg < 2) return seg * 1024 + head * 128 + 32 * ((d >> 4) & 3) + 16 * (d >> 6) + (d & 15);
    return (seg - 1) * 1024 + head * 128 + 32 * (2 * (d >> 6) + ((d >> 4) & 1)) + 16 * ((d >> 5) & 1) + (d & 15);
}
template <bool MAP>
__device__ __forceinline__ void p0_transpose_item(const float* W, int K, int N, bf16* WT, LAS float* scr, int item, int lane, int ldk = 0, int koff = 0) {
    if (ldk == 0) ldk = K;
    const int nblk = N / 32, kb = item / nblk, nb = item % nblk, k0 = 64 * kb, n0 = 32 * nb;
#pragma unroll 8
    for (int i = 0; i < 32; ++i) { const int kk = 2 * i + (lane >> 5); scr[kk * 33 + (lane & 31)] = W[(size_t)(k0 + kk) * N + n0 + (lane & 31)]; }
    LDS_WAIT(); asm volatile("" ::: "memory");
    const int c = lane & 7;
#pragma unroll
    for (int j = 0; j < 4; ++j) { const int n = (lane >> 3) + 8 * j; const LAS float* s = scr + (8 * c) * 33 + n;
        v4u o; o.x = pk2(s[0 * 33], s[1 * 33]); o.y = pk2(s[2 * 33], s[3 * 33]); o.z = pk2(s[4 * 33], s[5 * 33]); o.w = pk2(s[6 * 33], s[7 * 33]);
        const int dr = MAP ? inproj_row(n0 + n) : (n0 + n);
        *(GAS v4u*)(WT + (size_t)dr * ldk + koff + k0 + 8 * c) = o; }
    LDS_WAIT(); asm volatile("" ::: "memory");
}
__device__ __forceinline__ void p0_convert(const float* src, bf16* dst, size_t n8, size_t gtid, size_t gthreads) {
    for (size_t i = gtid; i < n8; i += gthreads) {
        const f32x4 a = *(const GAS f32x4*)(src + i * 8), b = *(const GAS f32x4*)(src + i * 8 + 4);
        v4u o; o.x = pk2(a[0], a[1]); o.y = pk2(a[2], a[3]); o.z = pk2(b[0], b[1]); o.w = pk2(b[2], b[3]);
        *(GAS v4u*)(dst + i * 8) = o;
    }
}

__device__ __forceinline__ void p0_table_row(const float* src, unsigned char* dst, float* scale_out, int lane) {
    f32x4 v[8]; float am = 0.f;
#pragma unroll
    for (int q = 0; q < 8; ++q) { v[q] = *(const GAS f32x4*)(src + 32 * lane + 4 * q);
        am = fmaxf(am, fmaxf(fmaxf(fabsf(v[q][0]), fabsf(v[q][1])), fmaxf(fabsf(v[q][2]), fabsf(v[q][3])))); }
#pragma unroll
    for (int o = 1; o < 64; o <<= 1) am = fmaxf(am, __shfl_xor(am, o));
    const float sc = am > 0.f ? 6.0f / am : 1.0f;
    v4u o;
#pragma unroll
    for (int wq = 0; wq < 4; ++wq) { unsigned w = 0u;
        w = __builtin_amdgcn_cvt_scalef32_pk_fp4_f32(w, v[2 * wq][0] * sc, v[2 * wq][1] * sc, 1.0f, 0);
        w = __builtin_amdgcn_cvt_scalef32_pk_fp4_f32(w, v[2 * wq][2] * sc, v[2 * wq][3] * sc, 1.0f, 1);
        w = __builtin_amdgcn_cvt_scalef32_pk_fp4_f32(w, v[2 * wq + 1][0] * sc, v[2 * wq + 1][1] * sc, 1.0f, 2);
        w = __builtin_amdgcn_cvt_scalef32_pk_fp4_f32(w, v[2 * wq + 1][2] * sc, v[2 * wq + 1][3] * sc, 1.0f, 3);
        o[wq] = w; }
    *(GAS v4u*)(dst + 16 * lane) = o;
    if (lane == 0) *scale_out = am > 0.f ? am / 6.0f : 1.0f;
}

__device__ __forceinline__ unsigned q8pack(float a, float b, float c, float d, float s) {
    const int ia = (int)__builtin_rintf(a * s), ib = (int)__builtin_rintf(b * s), ic = (int)__builtin_rintf(c * s), id = (int)__builtin_rintf(d * s);
    return ((unsigned)ia & 255u) | (((unsigned)ib & 255u) << 8) | (((unsigned)ic & 255u) << 16) | ((unsigned)id << 24);
}
__device__ __forceinline__ void p0_absmax_item(const float* W, int item, int lane, gu32* wmax) {
    const int kc = item / 40, nc = item % 40, n0 = 256 * nc + 4 * lane;
    const float* p = W + (size_t)(128 * kc) * 10240 + n0;
    f32x4 am = (f32x4){0.f, 0.f, 0.f, 0.f};
#pragma unroll 16
    for (int r = 0; r < 128; ++r) { const f32x4 v = *(const GAS f32x4*)(p + (size_t)r * 10240);
        am[0] = fmaxf(am[0], fabsf(v[0])); am[1] = fmaxf(am[1], fabsf(v[1])); am[2] = fmaxf(am[2], fabsf(v[2])); am[3] = fmaxf(am[3], fabsf(v[3])); }
#pragma unroll
    for (int j = 0; j < 4; ++j) (void)__hip_atomic_fetch_max(wmax + n0 + j, __builtin_bit_cast(unsigned, am[j]), RLX_AGENT);
}
__device__ __forceinline__ void p0_transpose_item_i8(const float* W, int K, int N, unsigned char* W8, LAS float* scr, int item, int lane, const gu32* wmax) {
    const int nblk = N / 32, kb = item / nblk, nb = item % nblk, k0 = 64 * kb, n0 = 32 * nb;
#pragma unroll 8
    for (int i = 0; i < 32; ++i) { const int kk = 2 * i + (lane >> 5); scr[kk * 33 + (lane & 31)] = W[(size_t)(k0 + kk) * N + n0 + (lane & 31)]; }
    LDS_WAIT(); asm volatile("" ::: "memory");
    const int c = lane & 7;
#pragma unroll
    for (int j = 0; j < 4; ++j) { const int n = (lane >> 3) + 8 * j; const LAS float* s = scr + (8 * c) * 33 + n;
        const float am = __builtin_bit_cast(float, wmax[n0 + n]); const float sc = am > 0.f ? 127.0f / am : 0.f;
        v2u o; o.x = q8pack(s[0 * 33], s[1 * 33], s[2 * 33], s[3 * 33], sc); o.y = q8pack(s[4 * 33], s[5 * 33], s[6 * 33], s[7 * 33], sc);
        *(GAS v2u*)(W8 + (size_t)inproj_row(n0 + n) * K + k0 + 8 * c) = o; }
    LDS_WAIT(); asm volatile("" ::: "memory");
}
__device__ __forceinline__ void p0_x_row(const float* src, bf16* dstb, unsigned char* dst8, float* sx, int lane) {
    f32x4 v[8]; float am = 0.f;
#pragma unroll
    for (int j = 0; j < 8; ++j) { v[j] = *(const GAS f32x4*)(src + 256 * j + 4 * lane);
        am = fmaxf(am, fmaxf(fmaxf(fabsf(v[j][0]), fabsf(v[j][1])), fmaxf(fabsf(v[j][2]), fabsf(v[j][3])))); }
#pragma unroll
    for (int o = 1; o < 64; o <<= 1) am = fmaxf(am, __shfl_xor(am, o));
    const float sc = am > 0.f ? 127.0f / am : 0.f;
#pragma unroll
    for (int j = 0; j < 8; ++j) { *(GAS v2u*)(dstb + 256 * j + 4 * lane) = (v2u){pk2(v[j][0], v[j][1]), pk2(v[j][2], v[j][3])};
        *(GAS unsigned*)(dst8 + 256 * j + 4 * lane) = q8pack(v[j][0], v[j][1], v[j][2], v[j][3], sc); }
    if (lane == 0) *sx = am * (1.0f / 127.0f);
}

namespace att {
constexpr int KB0 = 0, VB0 = 32768, KMT = 65536, QFR = 65536;
__device__ __forceinline__ int crow(int r, int hi) { return (r & 3) + 8 * (r >> 2) + 4 * hi; }
__device__ __forceinline__ unsigned cvtpk(float lo, float hi) { return pg8::cvt_pk_bf16(lo, hi); }

template <int DQK, bool MOBA>
__device__ __forceinline__ void attn_pass(LAS unsigned char* lds, const bf16* Qg, const bf16* Kg, const bf16* Vtg, int q0, unsigned sel, f32x16 (&o)[4], int tid, int wid, int lane) {
    constexpr int NS = DQK / 16, RB = DQK * 2, KCH = DQK / 8;
    constexpr float THR = 8.0f;
    const int r32 = lane & 31, hi = lane >> 5;
    const int qpos = q0 + 32 * wid + r32;
    const int own = q0 >> 8;
    const LAS unsigned char* qlds = lds + QFR + wid * 8192 + lane * 16;
    { const bf16* qp = Qg + (size_t)(32 * wid + r32) * 1024 + 8 * hi;
#pragma unroll
      for (int s = 0; s < NS; ++s) *(LAS bf16x8*)(lds + QFR + wid * 8192 + lane * 16 + s * 1024) = *(const GAS bf16x8*)(qp + 16 * s); }
#pragma unroll
    for (int d = 0; d < 4; ++d) o[d] = (f32x16){0.f,0.f,0.f,0.f,0.f,0.f,0.f,0.f,0.f,0.f,0.f,0.f,0.f,0.f,0.f,0.f};
    f32x16 negm = (f32x16){0.f,0.f,0.f,0.f,0.f,0.f,0.f,0.f,0.f,0.f,0.f,0.f,0.f,0.f,0.f,0.f};
    float l_run = 0.f;
    const int nt = MOBA ? 4 + 4 * own : (q0 + 256) / 64;
    constexpr int NKC = (64 * KCH) / 512;
    v4u kreg[NKC], vreg[2];
    unsigned kgo[NKC], vgo[2]; int klds[NKC], vl0[2], vl1[2];
#pragma unroll
    for (int i = 0; i < NKC; ++i) { const int cid = tid + 512 * i, key = cid / KCH, ch = cid % KCH;
        const int swz = (DQK == 128) ? (key & 15) : ((key >> 1) & 7);
        kgo[i] = (unsigned)(key * 1024 + ch * 8) * 2u; klds[i] = key * RB + ((ch ^ swz) << 4); }
#pragma unroll
    for (int i = 0; i < 2; ++i) { const int cid = tid + 512 * i, d = cid >> 3, g = cid & 7;
        const int c = (g >> 2) * 4 + ((g >> 1) & 1) * 2, sw = (d >> 1) & 7, e = g & 1;
        vgo[i] = (unsigned)(d * T + g * 8) * 2u; vl0[i] = d * 128 + ((c ^ sw) << 4) + 8 * e; vl1[i] = d * 128 + (((c + 1) ^ sw) << 4) + 8 * e; }
#define KTILE(i) (MOBA ? ((i) < 4 ? own * 4 + (i) : (i) - 4) : (i))
#define ATT_LOAD(kt) do { const GAS unsigned char* kb_ = (const GAS unsigned char*)Kg + (size_t)(kt) * 131072; const GAS unsigned char* vb_ = (const GAS unsigned char*)Vtg + (size_t)(kt) * 128; \
                          _Pragma("unroll") for (int i_ = 0; i_ < NKC; ++i_) kreg[i_] = *(const GAS v4u*)(kb_ + kgo[i_]); \
                          _Pragma("unroll") for (int i_ = 0; i_ < 2; ++i_) vreg[i_] = *(const GAS v4u*)(vb_ + vgo[i_]); } while (0)
#define ATT_STORE(buf) do { _Pragma("unroll") for (int i_ = 0; i_ < NKC; ++i_) *(LAS v4u*)(lds + KB0 + (buf) * 16384 + klds[i_]) = kreg[i_]; \
                            _Pragma("unroll") for (int i_ = 0; i_ < 2; ++i_) { *(LAS v2u*)(lds + VB0 + (buf) * 16384 + vl0[i_]) = (v2u){vreg[i_].x, vreg[i_].y}; \
                                                                              *(LAS v2u*)(lds + VB0 + (buf) * 16384 + vl1[i_]) = (v2u){vreg[i_].z, vreg[i_].w}; } } while (0)
    ATT_LOAD(KTILE(0)); ATT_STORE(0);
    __syncthreads();
    const int kswz = (DQK == 128) ? (r32 & 15) : ((r32 >> 1) & 7);
    const int vsw = (r32 >> 1) & 7;
    const int kfo = r32 * RB, vfo = r32 * 128;
#define ATT_STEP(BUF) do { \
        const int kt = KTILE(it); const bool more = it + 1 < nt; \
        if (more) ATT_LOAD(KTILE(it + 1)); \
        const int blk = kt >> 2; bool need; \
        if (!MOBA || it < 4) need = (kt * 64 <= q0 + 32 * wid + 31); else need = __any((sel >> blk) & 1u); \
        if (need) { \
            f32x16 p0, p1; \
            const LAS unsigned char* kb = lds + KB0 + (BUF) * 16384 + kfo; \
              \
            bf16x8 fk0[2], fk1[2], fqv[2]; \
            { const int ch = ((0 + hi) ^ kswz) << 4; fk0[0] = *(const LAS bf16x8*)(kb + ch); fk1[0] = *(const LAS bf16x8*)(kb + 32 * RB + ch); fqv[0] = *(const LAS bf16x8*)(qlds); } \
            _Pragma("unroll") for (int s = 0; s < NS; ++s) { \
                if (s + 1 < NS) { const int ch = ((2 * (s + 1) + hi) ^ kswz) << 4; \
                    fk0[(s + 1) & 1] = *(const LAS bf16x8*)(kb + ch); fk1[(s + 1) & 1] = *(const LAS bf16x8*)(kb + 32 * RB + ch); fqv[(s + 1) & 1] = *(const LAS bf16x8*)(qlds + (s + 1) * 1024); } \
                __builtin_amdgcn_sched_barrier(0); \
                if (s == 0) {   \
                    asm volatile("v_mfma_f32_32x32x16_bf16 %0, %1, %2, %3" : "=&v"(p0) : "v"(fk0[0]), "v"(fqv[0]), "v"(negm)); \
                    asm volatile("v_mfma_f32_32x32x16_bf16 %0, %1, %2, %3" : "=&v"(p1) : "v"(fk1[0]), "v"(fqv[0]), "v"(negm)); } \
                else { p0 = __builtin_amdgcn_mfma_f32_32x32x16_bf16(fk0[s & 1], fqv[s & 1], p0, 0, 0, 0); p1 = __builtin_amdgcn_mfma_f32_32x32x16_bf16(fk1[s & 1], fqv[s & 1], p1, 0, 0, 0); } \
                __builtin_amdgcn_sched_barrier(0); } \
            if (!MOBA || it < 4) { \
                if (kt * 64 + 63 > q0 + 32 * wid) { const int kbase = kt * 64 + 4 * hi; \
                    _Pragma("unroll") for (int r = 0; r < 16; ++r) { const int kv = kbase + (r & 3) + 8 * (r >> 2); if (kv > qpos) p0[r] = -INFINITY; if (kv + 32 > qpos) p1[r] = -INFINITY; } } \
            } else { if (!((sel >> blk) & 1u)) { _Pragma("unroll") for (int r = 0; r < 16; ++r) { p0[r] = -INFINITY; p1[r] = -INFINITY; } } } \
            float rm = fmaxf(fmaxf(p0[0], p0[1]), p1[0]); \
            _Pragma("unroll") for (int r = 1; r < 16; ++r) rm = fmaxf(fmaxf(rm, p0[r]), p1[r]); \
            { const unsigned rb = __builtin_bit_cast(unsigned, rm); auto rr = __builtin_amdgcn_permlane32_swap(rb, rb, false, false); rm = fmaxf(__builtin_bit_cast(float, (unsigned)rr[0]), __builtin_bit_cast(float, (unsigned)rr[1])); } \
            if (it == 0 || __any(rm > THR)) { \
                const float dl = (it == 0) ? rm : fmaxf(rm, 0.f); const float alpha = fexp2(-dl); \
                _Pragma("unroll") for (int r = 0; r < 16; ++r) { p0[r] -= dl; p1[r] -= dl; negm[r] -= dl; } \
                l_run *= alpha; \
                _Pragma("unroll") for (int d = 0; d < 4; ++d) _Pragma("unroll") for (int r = 0; r < 16; ++r) o[d][r] *= alpha; } \
            float ls = 0.f; \
            _Pragma("unroll") for (int r = 0; r < 16; ++r) { p0[r] = fexp2(p0[r]); p1[r] = fexp2(p1[r]); ls += p0[r] + p1[r]; } \
            l_run += ls; \
            bf16x8 pa[4]; \
            { v4u w; \
              w.x = cvtpk(p0[0], p0[1]); w.y = cvtpk(p0[2], p0[3]); w.z = cvtpk(p0[4], p0[5]); w.w = cvtpk(p0[6], p0[7]); pa[0] = __builtin_bit_cast(bf16x8, w); \
              w.x = cvtpk(p0[8], p0[9]); w.y = cvtpk(p0[10], p0[11]); w.z = cvtpk(p0[12], p0[13]); w.w = cvtpk(p0[14], p0[15]); pa[1] = __builtin_bit_cast(bf16x8, w); \
              w.x = cvtpk(p1[0], p1[1]); w.y = cvtpk(p1[2], p1[3]); w.z = cvtpk(p1[4], p1[5]); w.w = cvtpk(p1[6], p1[7]); pa[2] = __builtin_bit_cast(bf16x8, w); \
              w.x = cvtpk(p1[8], p1[9]); w.y = cvtpk(p1[10], p1[11]); w.z = cvtpk(p1[12], p1[13]); w.w = cvtpk(p1[14], p1[15]); pa[3] = __builtin_bit_cast(bf16x8, w); } \
            const LAS unsigned char* vb = lds + VB0 + (BUF) * 16384 + vfo; \
            bf16x8 vfr[2][4]; \
            _Pragma("unroll") for (int d = 0; d < 4; ++d) vfr[0][d] = *(const LAS bf16x8*)(vb + d * 4096 + (((0 + hi) ^ vsw) << 4)); \
            _Pragma("unroll") for (int ks = 0; ks < 4; ++ks) { \
                if (ks + 1 < 4) { const int c = ((ks + 1) >> 1) * 4 + ((ks + 1) & 1) * 2 + hi; \
                    _Pragma("unroll") for (int d = 0; d < 4; ++d) vfr[(ks + 1) & 1][d] = *(const LAS bf16x8*)(vb + d * 4096 + ((c ^ vsw) << 4)); } \
                __builtin_amdgcn_sched_barrier(0); \
                _Pragma("unroll") for (int d = 0; d < 4; ++d) o[d] = __builtin_amdgcn_mfma_f32_32x32x16_bf16(vfr[ks & 1][d], pa[ks], o[d], 0, 0, 0); \
                __builtin_amdgcn_sched_barrier(0); } \
        } \
        if (more) ATT_STORE((BUF) ^ 1); \
        __syncthreads(); \
    } while (0)
    int it = 0;
#pragma unroll 1
    for (; it + 1 < nt; it += 2) { ATT_STEP(0); ++it; ATT_STEP(1); --it; }
    if (it < nt) ATT_STEP(0);
#undef ATT_STEP
#undef ATT_LOAD
#undef KTILE
#undef ATT_STORE
    const float lt = l_run + __shfl_xor(l_run, 32);
    const float inv = 1.0f / lt;
#pragma unroll
    for (int d = 0; d < 4; ++d)
#pragma unroll
        for (int r = 0; r < 16; ++r) o[d][r] *= inv;
}

__device__ __forceinline__ void attn_pass_diff2(LAS unsigned char* lds, const bf16* Qg, const bf16* Kg, const bf16* Vtg, int q0, f32x16 (&o1)[4], f32x16 (&o2)[4], int tid, int wid, int lane) {
    constexpr int RB = 256, KCH = 16; constexpr float THR = 8.0f;
    { const int r32 = lane & 31, hi = lane >> 5;
      const bf16* qp = Qg + (size_t)(32 * wid + r32) * 1024 + 8 * hi;
#pragma unroll
      for (int s = 0; s < 8; ++s) *(LAS bf16x8*)(lds + QFR + wid * 8192 + lane * 16 + s * 1024) = *(const GAS bf16x8*)(qp + 16 * s); }
#pragma unroll
    for (int d = 0; d < 4; ++d) { o1[d] = (f32x16){0.f,0.f,0.f,0.f,0.f,0.f,0.f,0.f,0.f,0.f,0.f,0.f,0.f,0.f,0.f,0.f}; o2[d] = o1[d]; }
    float m1 = 0.f, l1 = 0.f, m2 = 0.f, l2 = 0.f;
    const int nt = (q0 + 256) / 64;
    v4u sreg[2];
#define ATT_KGO(i) ((unsigned)((((tq_ + 512 * (i)) >> 4) * 1024 + ((tq_ + 512 * (i)) & 15) * 8) * 2))
#define ATT_KLDS(i) ((((tq_ + 512 * (i)) >> 4) * RB) + (((((tq_ + 512 * (i)) & 15)) ^ (((tq_ + 512 * (i)) >> 4) & 15)) << 4))
#define ATT_VGO(i) ((unsigned)((((tq_ + 512 * (i)) >> 3) * T + ((tq_ + 512 * (i)) & 7) * 8) * 2))
#define ATT_VC(i) (((((tq_ + 512 * (i)) & 7) >> 2) * 4) + (((((tq_ + 512 * (i)) & 7) >> 1) & 1) * 2))
#define ATT_VL0(i) ((((tq_ + 512 * (i)) >> 3) * 128) + ((ATT_VC(i) ^ ((((tq_ + 512 * (i)) >> 3) >> 1) & 7)) << 4) + 8 * ((tq_ + 512 * (i)) & 1))
#define ATT_VL1(i) ((((tq_ + 512 * (i)) >> 3) * 128) + (((ATT_VC(i) + 1) ^ ((((tq_ + 512 * (i)) >> 3) >> 1) & 7)) << 4) + 8 * ((tq_ + 512 * (i)) & 1))
#define ATT_TQ int tq_ = lane; asm volatile("" : "+v"(tq_)); tq_ += 64 * wid
#define ATT_LOADK(kt) do { ATT_TQ; const GAS unsigned char* kb_ = (const GAS unsigned char*)Kg + (size_t)(kt) * 131072; _Pragma("unroll") for (int i_ = 0; i_ < 2; ++i_) sreg[i_] = *(const GAS v4u*)(kb_ + ATT_KGO(i_)); } while (0)
#define ATT_LOADV(kt) do { ATT_TQ; const GAS unsigned char* vb_ = (const GAS unsigned char*)Vtg + (size_t)(kt) * 128; _Pragma("unroll") for (int i_ = 0; i_ < 2; ++i_) sreg[i_] = *(const GAS v4u*)(vb_ + ATT_VGO(i_)); } while (0)
#define ATT_STOREK(buf) do { ATT_TQ; _Pragma("unroll") for (int i_ = 0; i_ < 2; ++i_) *(LAS v4u*)(lds + KB0 + (buf) * 16384 + ATT_KLDS(i_)) = sreg[i_]; } while (0)
#define ATT_STOREV(buf) do { ATT_TQ; _Pragma("unroll") for (int i_ = 0; i_ < 2; ++i_) { *(LAS v2u*)(lds + VB0 + (buf) * 16384 + ATT_VL0(i_)) = (v2u){sreg[i_].x, sreg[i_].y}; \
                                                                               *(LAS v2u*)(lds + VB0 + (buf) * 16384 + ATT_VL1(i_)) = (v2u){sreg[i_].z, sreg[i_].w}; } } while (0)
    ATT_LOADK(0); ATT_STOREK(0); ATT_LOADV(0); ATT_STOREV(0);
    __syncthreads();
#define ATT_LN int ln_ = lane; asm volatile("" : "+v"(ln_)); const int r32 = ln_ & 31, hi = ln_ >> 5
#define ATT_QKS(BUF, S0, M, L, O) do { \
        ATT_LN; const int kswz = r32 & 15; const LAS unsigned char* qlds = lds + QFR + wid * 8192 + ln_ * 16; \
        const LAS unsigned char* kb = lds + KB0 + (BUF) * 16384 + r32 * RB; \
        _Pragma("unroll") for (int s = 0; s < 4; ++s) { const int ch = ((2 * ((S0) + s) + hi) ^ kswz) << 4; \
            const bf16x8 k0 = *(const LAS bf16x8*)(kb + ch), k1 = *(const LAS bf16x8*)(kb + 32 * RB + ch); \
            const bf16x8 qv = *(const LAS bf16x8*)(qlds + ((S0) + s) * 1024); \
            if (s == 0) { asm volatile("v_mfma_f32_32x32x16_bf16 %0, %1, %2, 0" : "=&v"(p0) : "v"(k0), "v"(qv)); \
                          asm volatile("v_mfma_f32_32x32x16_bf16 %0, %1, %2, 0" : "=&v"(p1) : "v"(k1), "v"(qv)); } \
            else { p0 = __builtin_amdgcn_mfma_f32_32x32x16_bf16(k0, qv, p0, 0, 0, 0); p1 = __builtin_amdgcn_mfma_f32_32x32x16_bf16(k1, qv, p1, 0, 0, 0); } } \
        if (diag) { const int kbase = kt * 64 + 4 * hi, qpos = q0 + 32 * wid + r32; \
            _Pragma("unroll") for (int r = 0; r < 16; ++r) { const int kv = kbase + (r & 3) + 8 * (r >> 2); if (kv > qpos) p0[r] = -INFINITY; if (kv + 32 > qpos) p1[r] = -INFINITY; } } \
        float rm = fmaxf(fmaxf(p0[0], p0[1]), p1[0]); \
        _Pragma("unroll") for (int r = 1; r < 16; ++r) rm = fmaxf(fmaxf(rm, p0[r]), p1[r]); \
        { const unsigned rb = __builtin_bit_cast(unsigned, rm); auto rr = __builtin_amdgcn_permlane32_swap(rb, rb, false, false); rm = fmaxf(__builtin_bit_cast(float, (unsigned)rr[0]), __builtin_bit_cast(float, (unsigned)rr[1])); } \
        if (it == 0 || __any(rm > M + THR)) { \
            const float mnew = (it == 0) ? rm : fmaxf(M, rm); const float alpha = fexp2(M - mnew); M = mnew; \
            L *= alpha; \
            _Pragma("unroll") for (int d = 0; d < 4; ++d) _Pragma("unroll") for (int r = 0; r < 16; ++r) O[d][r] *= alpha; } \
        float ls = 0.f; \
        { typedef float f32x2v __attribute__((ext_vector_type(2))); const f32x2v mm = (f32x2v){M, M};        \
          _Pragma("unroll") for (int r = 0; r < 16; r += 2) { const f32x2v a = (f32x2v){p0[r], p0[r + 1]} - mm, b = (f32x2v){p1[r], p1[r + 1]} - mm; \
              p0[r] = fexp2(a.x); p0[r + 1] = fexp2(a.y); p1[r] = fexp2(b.x); p1[r + 1] = fexp2(b.y); ls += (p0[r] + p0[r + 1]) + (p1[r] + p1[r + 1]); } } \
        L += ls; \
    } while (0)
#define ATT_PACK(dst_, ks) do { \
        if ((ks) == 0) { (dst_).x = cvtpk(p0[0], p0[1]); (dst_).y = cvtpk(p0[2], p0[3]); (dst_).z = cvtpk(p0[4], p0[5]); (dst_).w = cvtpk(p0[6], p0[7]); } \
        else if ((ks) == 1) { (dst_).x = cvtpk(p0[8], p0[9]); (dst_).y = cvtpk(p0[10], p0[11]); (dst_).z = cvtpk(p0[12], p0[13]); (dst_).w = cvtpk(p0[14], p0[15]); } \
        else if ((ks) == 2) { (dst_).x = cvtpk(p1[0], p1[1]); (dst_).y = cvtpk(p1[2], p1[3]); (dst_).z = cvtpk(p1[4], p1[5]); (dst_).w = cvtpk(p1[6], p1[7]); } \
        else { (dst_).x = cvtpk(p1[8], p1[9]); (dst_).y = cvtpk(p1[10], p1[11]); (dst_).z = cvtpk(p1[12], p1[13]); (dst_).w = cvtpk(p1[14], p1[15]); } } while (0)
#define ATT_STEP(BUF) do { \
        const int kt = it; const bool more = it + 1 < nt; \
        const bool need = kt * 64 <= q0 + 32 * wid + 31, diag = kt * 64 + 63 > q0 + 32 * wid; \
        if (more) ATT_LOADK(it + 1); \
        v4u pa1[4] = {(v4u){0u, 0u, 0u, 0u}, (v4u){0u, 0u, 0u, 0u}, (v4u){0u, 0u, 0u, 0u}, (v4u){0u, 0u, 0u, 0u}}; \
        if (need) { f32x16 p0, p1; ATT_QKS(BUF, 0, m1, l1, o1); \
              _Pragma("unroll") for (int ks = 0; ks < 4; ++ks) ATT_PACK(pa1[ks], ks); } \
        if (more) { ATT_STOREK((BUF) ^ 1); ATT_LOADV(it + 1); }        \
        if (need) { v4u pa2[4]; \
              { f32x16 p0, p1; ATT_QKS(BUF, 4, m2, l2, o2); \
                _Pragma("unroll") for (int ks = 0; ks < 4; ++ks) ATT_PACK(pa2[ks], ks); } \
              __builtin_amdgcn_sched_barrier(0); \
              ATT_LN; const int vsw = (r32 >> 1) & 7; \
              const LAS unsigned char* vb = lds + VB0 + (BUF) * 16384 + r32 * 128; \
              _Pragma("unroll") for (int ks = 0; ks < 4; ++ks) { \
                const bf16x8 pb1 = __builtin_bit_cast(bf16x8, pa1[ks]), pb2 = __builtin_bit_cast(bf16x8, pa2[ks]); \
                const int c = (ks >> 1) * 4 + (ks & 1) * 2 + hi; \
                _Pragma("unroll") for (int d = 0; d < 4; ++d) { const bf16x8 vf = *(const LAS bf16x8*)(vb + d * 4096 + ((c ^ vsw) << 4)); \
                    o1[d] = __builtin_amdgcn_mfma_f32_32x32x16_bf16(vf, pb1, o1[d], 0, 0, 0); \
                    o2[d] = __builtin_amdgcn_mfma_f32_32x32x16_bf16(vf, pb2, o2[d], 0, 0, 0); } \
                __builtin_amdgcn_sched_barrier(0); } } \
        if (more) ATT_STOREV((BUF) ^ 1); \
        __syncthreads(); \
    } while (0)
    int it = 0;
#pragma unroll 1
    for (; it + 1 < nt; it += 2) { ATT_STEP(0); ++it; ATT_STEP(1); --it; }
    if (it < nt) ATT_STEP(0);
#undef ATT_STEP
#undef ATT_QKS
#undef ATT_PACK
#undef ATT_LN
#undef ATT_LOADK
#undef ATT_LOADV
#undef ATT_STOREK
#undef ATT_STOREV
#undef ATT_TQ
#undef ATT_KGO
#undef ATT_KLDS
#undef ATT_VGO
#undef ATT_VC
#undef ATT_VL0
#undef ATT_VL1
    const float i1 = 1.0f / (l1 + __shfl_xor(l1, 32)), i2 = 1.0f / (l2 + __shfl_xor(l2, 32));
#pragma unroll
    for (int d = 0; d < 4; ++d)
#pragma unroll
        for (int r = 0; r < 16; ++r) { o1[d][r] *= i1; o2[d][r] *= i2; }
}

struct AttnArgs { const bf16 *qa, *ka, *qd, *kd, *vt; bf16* oab; const float* kmean; const float* gain; float lam, one_minus_li; };

__device__ __forceinline__ void moba_unit(LAS unsigned char* lds, const AttnArgs& A, int b, int h, int qb, int tid, int wid, int lane) {
    asm volatile("" : "+v"(tid), "+v"(lane));
    const int r32 = lane & 31, hi = lane >> 5, q0 = qb * 256;
    const bf16* Qg = A.qa + (size_t)(b * SEQ + q0) * 1024 + h * 128;
    unsigned sel = 0u;
    if (qb > 0) {
        { const int row = tid >> 4, ch = tid & 15, n = row & 15;
          const float* kp = A.kmean + ((size_t)(b * 8 + h) * 16 + n) * 128 + ch * 8;
          const f32x4 a = *(const GAS f32x4*)kp, c = *(const GAS f32x4*)(kp + 4);
          float v[8] = {a[0], a[1], a[2], a[3], c[0], c[1], c[2], c[3]}; unsigned w[8];
#pragma unroll
          for (int j = 0; j < 8; ++j) { const float x = v[j] * (1.0f / 256.0f); const unsigned hb = f2bf(x); const float xr = __builtin_bit_cast(float, hb << 16); w[j] = (row < 16) ? hb : f2bf(x - xr); }
          v4u o; o.x = w[0] | (w[1] << 16); o.y = w[2] | (w[3] << 16); o.z = w[4] | (w[5] << 16); o.w = w[6] | (w[7] << 16);
          *(LAS v4u*)(lds + KMT + row * 256 + ((ch ^ (row & 15)) << 4)) = o; }
        __syncthreads();
        f32x16 g = (f32x16){0.f,0.f,0.f,0.f,0.f,0.f,0.f,0.f,0.f,0.f,0.f,0.f,0.f,0.f,0.f,0.f};
        { const bf16* qp = Qg + (size_t)(32 * wid + r32) * 1024 + 8 * hi;
          const LAS unsigned char* kb = lds + KMT + r32 * 256;
#pragma unroll
          for (int s = 0; s < 8; ++s) { const bf16x8 qv = *(const GAS bf16x8*)(qp + 16 * s);
              const bf16x8 kf = *(const LAS bf16x8*)(kb + (((2 * s + hi) ^ (r32 & 15)) << 4));
              g = __builtin_amdgcn_mfma_f32_32x32x16_bf16(kf, qv, g, 0, 0, 0); } }
        float G[16];
#pragma unroll
        for (int r = 0; r < 8; ++r) { const float mine = g[r] + g[r + 8]; const float oth = __shfl_xor(mine, 32);
            const int nlo = (r & 3) + 8 * (r >> 2); G[nlo] = hi ? oth : mine; G[nlo + 4] = hi ? mine : oth; }
#pragma unroll
        for (int round = 0; round < 3; ++round) { float best = -INFINITY; int bi = -1;
#pragma unroll
            for (int n = 0; n < 16; ++n) { const bool ok = (n < qb) && !((sel >> n) & 1u) && (G[n] > best); best = ok ? G[n] : best; bi = ok ? n : bi; }
            if (bi >= 0) sel |= 1u << bi; }
        __syncthreads();
    }
    f32x16 o[4];
    attn_pass<128, true>(lds, Qg, A.ka + (size_t)(b * SEQ) * 1024 + h * 128, A.vt + (size_t)(h * 128) * T + b * SEQ, q0, sel, o, tid, wid, lane);
    bf16* op = A.oab + (size_t)(b * SEQ + q0 + 32 * wid + r32) * 2048 + h * 128 + 4 * hi;
#pragma unroll
    for (int d = 0; d < 4; ++d)
#pragma unroll
        for (int gq = 0; gq < 4; ++gq) { v2u w; w.x = cvtpk(o[d][4 * gq], o[d][4 * gq + 1]); w.y = cvtpk(o[d][4 * gq + 2], o[d][4 * gq + 3]); *(GAS v2u*)(op + 32 * d + 8 * gq) = w; }
}

__device__ __forceinline__ void diff_unit(LAS unsigned char* lds, const AttnArgs& A, int b, int h, int qb, int tid, int wid, int lane) {
    asm volatile("" : "+v"(tid), "+v"(lane));
    const int r32 = lane & 31, hi = lane >> 5, q0 = qb * 256;
    const size_t qrow = (size_t)(b * SEQ + q0);
    const bf16* Vtg = A.vt + (size_t)(1024 + h * 128) * T + b * SEQ;
    f32x16 o[4], o2[4];
    attn_pass_diff2(lds, A.qd + qrow * 1024 + h * 128, A.kd + (size_t)(b * SEQ) * 1024 + h * 128, Vtg, q0, o, o2, tid, wid, lane);
    float ss = 0.f;
#pragma unroll
    for (int d = 0; d < 4; ++d)
#pragma unroll
        for (int r = 0; r < 16; ++r) { const float v = o[d][r] - A.lam * o2[d][r]; o[d][r] = v; ss += v * v; }
    ss += __shfl_xor(ss, 32);
    const float rn = 1.0f / sqrtf(ss * (1.0f / 128.0f) + RMS_EPS) * A.one_minus_li;
    bf16* op = A.oab + (qrow + 32 * wid + r32) * 2048 + 1024 + h * 128 + 4 * hi;
    const float* gp = A.gain + h * 128 + 4 * hi;
#pragma unroll
    for (int d = 0; d < 4; ++d)
#pragma unroll
        for (int gq = 0; gq < 4; ++gq) { const f32x4 gn = *(const GAS f32x4*)(gp + 32 * d + 8 * gq);
            v2u w; w.x = cvtpk(o[d][4 * gq] * rn * gn[0], o[d][4 * gq + 1] * rn * gn[1]); w.y = cvtpk(o[d][4 * gq + 2] * rn * gn[2], o[d][4 * gq + 3] * rn * gn[3]);
            *(GAS v2u*)(op + 32 * d + 8 * gq) = w; }
}

__device__ __forceinline__ void attn_phase(LAS unsigned char* lds, const AttnArgs& A, int vcu, int G, int tid, int wid, int lane) {
    for (int ord = vcu; ord < 1024; ord += G) {
        const int i = ord >> 8, v = ord & 255, bh = v >> 3, s = v & 7;
        const int qb = (i & 1) ? 15 - s : s;
        if (i < 2) diff_unit(lds, A, bh >> 3, bh & 7, qb, tid, wid, lane);
        else moba_unit(lds, A, bh >> 3, bh & 7, qb, tid, wid, lane);
    }
}
}

namespace peer {
__device__ __forceinline__ int f2key(float f) { const int u = __builtin_bit_cast(int, f); return u ^ ((u >> 31) & 0x7fffffff); }
__device__ __forceinline__ float key2f(int k) { const int u = k ^ ((k >> 31) & 0x7fffffff); return __builtin_bit_cast(float, u); }
__device__ __forceinline__ int imax(int a, int b) { return a > b ? a : b; }
__device__ __forceinline__ int imin(int a, int b) { return a < b ? a : b; }

template <int OFF> __device__ __forceinline__ void sort16_desc(int (&v)[64]) {
#pragma unroll
    for (int k = 2; k <= 16; k <<= 1)
#pragma unroll
        for (int j = k >> 1; j > 0; j >>= 1)
#pragma unroll
            for (int i = 0; i < 16; ++i) { const int l = i ^ j;
                if (l > i) { const bool desc = ((i & k) == 0); const int a = v[OFF + i], b = v[OFF + l]; const int mx = imax(a, b), mn = imin(a, b);
                    v[OFF + i] = desc ? mx : mn; v[OFF + l] = desc ? mn : mx; } }
}
template <int OA, int OB> __device__ __forceinline__ void merge16_desc(int (&v)[64]) {
#pragma unroll
    for (int i = 0; i < 16; ++i) v[OA + i] = imax(v[OA + i], v[OB + 15 - i]);
#pragma unroll
    for (int j = 8; j > 0; j >>= 1)
#pragma unroll
        for (int i = 0; i < 16; ++i) { const int l = i ^ j;
            if (l > i) { const int a = v[OA + i], b = v[OA + l]; v[OA + i] = imax(a, b); v[OA + l] = imin(a, b); } }
}
__device__ __forceinline__ void top16_of_64(int (&v)[64]) {
    sort16_desc<0>(v); sort16_desc<16>(v); sort16_desc<32>(v); sort16_desc<48>(v);
    merge16_desc<0, 16>(v); merge16_desc<32, 48>(v); merge16_desc<0, 32>(v);
}
__device__ __forceinline__ float gelu_tanh(float x) {
    const float u = 0.7978845608028654f * (x + 0.044715f * x * x * x);
    const float e = __builtin_amdgcn_exp2f(2.0f * 1.4426950408889634f * u);
    const float th = 1.0f - 2.0f * __builtin_amdgcn_rcpf(e + 1.0f);
    return 0.5f * x * (1.0f + th);
}
constexpr int ETILE = 0, GTILE = 16384, SCR0 = 32768, XQ0 = 98304;

__device__ __forceinline__ void select_tile(LAS unsigned char* lds, const bf16* pq, const bf16* sk, int t0, int wid, int lane) {
    asm volatile("" : "+v"(lane));
    const int r32 = lane & 31, hi = lane >> 5, h = wid;
    LAS int* scr = (LAS int*)(lds + SCR0 + wid * 8192);
    int v[64];
#pragma unroll 1
    for (int c = 0; c < 2; ++c) {
        bf16x8 qf[8];
        { const bf16* qp = pq + (size_t)(t0 + r32) * 2048 + h * 256 + c * 128 + 8 * hi;
#pragma unroll
          for (int s = 0; s < 8; ++s) qf[s] = *(const GAS bf16x8*)(qp + 16 * s); }
#pragma unroll
        for (int kb = 0; kb < 4; ++kb) {
            f32x16 sc = (f32x16){0.f,0.f,0.f,0.f,0.f,0.f,0.f,0.f,0.f,0.f,0.f,0.f,0.f,0.f,0.f,0.f};
            const bf16* ap = sk + ((size_t)((c * 8 + h) * 128 + 32 * kb + r32)) * 128 + 8 * hi;
#pragma unroll
            for (int s = 0; s < 8; ++s) { const bf16x8 af = *(const GAS bf16x8*)(ap + 16 * s); sc = __builtin_amdgcn_mfma_f32_32x32x16_bf16(af, qf[s], sc, 0, 0, 0); }
#pragma unroll
            for (int r = 0; r < 16; ++r) v[kb * 16 + r] = (f2key(sc[r]) & ~127) | (32 * kb + (r & 3) + 8 * (r >> 2) + 4 * hi);
        }
        top16_of_64(v);
#pragma unroll
        for (int i = 0; i < 16; ++i) v[16 + i] = __shfl_xor(v[i], 32);
        merge16_desc<0, 16>(v);
#pragma unroll
        for (int i = 0; i < 16; ++i) scr[(c * 16 + i) * 64 + lane] = v[i];
    }
    LDS_WAIT();
    float a[16], b[16];
#pragma unroll
    for (int i = 0; i < 16; ++i) { a[i] = key2f(scr[i * 64 + lane] & ~127); b[i] = key2f(v[i] & ~127); }
    int n = 0;
#pragma unroll
    for (int i = 0; i < 16; ++i)
#pragma unroll
        for (int j = 0; j < 16; ++j)
            if ((i + 1) * (j + 1) <= 16) { v[n] = (f2key(a[i] + b[j]) & ~255) | (i << 4) | j; ++n; }
#pragma unroll
    for (int i = 0; i < 64; ++i) if (i >= 50) v[i] = (int)0x80000000;
    top16_of_64(v);
    float s[16]; int e[16]; float mx = -INFINITY;
#pragma unroll
    for (int k = 0; k < 16; ++k) { const int i = (v[k] >> 4) & 15, j = v[k] & 15;
        const int ka = scr[i * 64 + lane], kb2 = scr[(16 + j) * 64 + lane];
        s[k] = key2f(ka & ~127) + key2f(kb2 & ~127); e[k] = (ka & 127) * 128 + (kb2 & 127); mx = fmaxf(mx, s[k]); }
    float sum = 0.f;
#pragma unroll
    for (int k = 0; k < 16; ++k) { s[k] = __builtin_amdgcn_exp2f((s[k] - mx) * 1.4426950408889634f); sum += s[k]; }
    const float inv = 1.0f / sum;
    if (hi == 0) {
        LAS int* E = (LAS int*)(lds + ETILE) + r32 * 128 + h * 16; LAS float* Gt = (LAS float*)(lds + GTILE) + r32 * 128 + h * 16;
#pragma unroll
        for (int k = 0; k < 16; ++k) { E[k] = e[k]; Gt[k] = s[k] * inv; }
    }
}

#define PEER_LOADROW(dst, tab, ridx) do { dst = *((const GAS v4u*)((tab) + (size_t)(ridx) * 1024) + lane); } while (0)
typedef float f32x2p __attribute__((ext_vector_type(2)));
#define PEER_CVT4(w) const f32x2p c0_ = __builtin_amdgcn_cvt_scalef32_pk_f32_fp4((w), 1.0f, 0), c1_ = __builtin_amdgcn_cvt_scalef32_pk_f32_fp4((w), 1.0f, 1), \
        c2_ = __builtin_amdgcn_cvt_scalef32_pk_f32_fp4((w), 1.0f, 2), c3_ = __builtin_amdgcn_cvt_scalef32_pk_f32_fp4((w), 1.0f, 3)
#define PEER_AXPY8(Y2, wk2, w, b) do { PEER_CVT4(w); Y2[(b)] = __builtin_elementwise_fma(wk2, c0_, Y2[(b)]); Y2[(b) + 1] = __builtin_elementwise_fma(wk2, c1_, Y2[(b) + 1]); \
        Y2[(b) + 2] = __builtin_elementwise_fma(wk2, c2_, Y2[(b) + 2]); Y2[(b) + 3] = __builtin_elementwise_fma(wk2, c3_, Y2[(b) + 3]); } while (0)

__device__ __forceinline__ void token_ffn(LAS unsigned char* lds, int tl, const bf16* xrow, const unsigned char* TU, const unsigned char* TV, const float* SU, const float* SV,
                                          const float* gain, const float* bias, float* outf, bf16* outb, unsigned char* out8, float* outsx, int lane) {
    f32x2p xs[16];
#pragma unroll
    for (int q = 0; q < 4; ++q) { const v4u a = *(const GAS v4u*)(xrow + 32 * lane + 8 * q);
        xs[4 * q] = (f32x2p){bf_lo(a.x), bf_hi(a.x)}; xs[4 * q + 1] = (f32x2p){bf_lo(a.y), bf_hi(a.y)}; xs[4 * q + 2] = (f32x2p){bf_lo(a.z), bf_hi(a.z)}; xs[4 * q + 3] = (f32x2p){bf_lo(a.w), bf_hi(a.w)}; }
    const LAS int* E = (const LAS int*)(lds + ETILE) + tl * 128; const LAS float* Gt = (const LAS float*)(lds + GTILE) + tl * 128;
    const int e_lo = E[lane], e_hi = E[64 + lane]; const float g_lo = Gt[lane], g_hi = Gt[64 + lane];
    const float su_lo = SU[e_lo], su_hi = SU[e_hi], sv_lo = SV[e_lo], sv_hi = SV[e_hi];
#define PEER_EIDX(k) (((k) < 64) ? __builtin_amdgcn_readlane(e_lo, (k)) : __builtin_amdgcn_readlane(e_hi, (k) - 64))
    constexpr int PEER_RING = 16;
    v4u buf[PEER_RING];
    float h_lo = 0.f, h_hi = 0.f;
    {
        float am = 0.f;
#pragma unroll
        for (int i = 0; i < 16; ++i) am = fmaxf(am, fmaxf(fabsf(xs[i].x), fabsf(xs[i].y)));
#pragma unroll
        for (int o = 1; o < 64; o <<= 1) am = fmaxf(am, __shfl_xor(am, o));
        const float sx = am > 0.f ? 6.0f / am : 1.0f, isx = am > 0.f ? am / 6.0f : 1.0f;
        v4u xh, xl;
#pragma unroll
        for (int wq = 0; wq < 4; ++wq) { unsigned wh = 0u, wl = 0u;
#define PEER_XQ(b) { const f32x2p v = xs[4 * wq + (b)] * sx; wh = __builtin_amdgcn_cvt_scalef32_pk_fp4_f32(wh, v.x, v.y, 1.0f, (b)); \
                const f32x2p d = __builtin_amdgcn_cvt_scalef32_pk_f32_fp4(wh, 1.0f, (b)); wl = __builtin_amdgcn_cvt_scalef32_pk_fp4_f32(wl, (v.x - d.x) * 4.0f, (v.y - d.y) * 4.0f, 1.0f, (b)); }
            PEER_XQ(0) PEER_XQ(1) PEER_XQ(2) PEER_XQ(3)
#undef PEER_XQ
            xh[wq] = wh; xl[wq] = wl; }
        LAS unsigned char* xq = lds + XQ0 + (tl >> 2) * 2048;
        *(LAS v4u*)(xq + 16 * lane) = xh; *(LAS v4u*)(xq + 1024 + 16 * lane) = xl;
        const int g = lane >> 4, rl = lane & 15;
        typedef int v8i_t __attribute__((ext_vector_type(8)));
        int e_r = E[16 * 0 + rl];
#pragma unroll
        for (int s = 0; s < 16; ++s) buf[s] = *(const GAS v4u*)(TU + (size_t)e_r * 1024 + 16 * g + 64 * s);
#pragma unroll 1
        for (int rb = 0; rb < 8; ++rb) {
            const int rbn = rb < 7 ? rb + 1 : 7;
            const int e_n = E[16 * rbn + rl];
            const GAS unsigned char* rown = (const GAS unsigned char*)TU + (size_t)e_n * 1024 + 16 * g;
            f32x4 ah = {0.f, 0.f, 0.f, 0.f}, al = {0.f, 0.f, 0.f, 0.f};
            int xoff = 16 * g; asm volatile("" : "+v"(xoff));
            const LAS unsigned char* xbb = xq + xoff;
#pragma unroll
            for (int s = 0; s < 16; ++s) {
                const v4u a4 = buf[s]; const v4u bh = *(const LAS v4u*)(xbb + 64 * s), bl = *(const LAS v4u*)(xbb + 1024 + 64 * s);
                const v8i_t A = {(int)a4.x, (int)a4.y, (int)a4.z, (int)a4.w, 0, 0, 0, 0}, BH = {(int)bh.x, (int)bh.y, (int)bh.z, (int)bh.w, 0, 0, 0, 0}, BL = {(int)bl.x, (int)bl.y, (int)bl.z, (int)bl.w, 0, 0, 0, 0};
                ah = __builtin_amdgcn_mfma_scale_f32_16x16x128_f8f6f4(A, BH, ah, 4, 4, 0, 127, 0, 127);
                al = __builtin_amdgcn_mfma_scale_f32_16x16x128_f8f6f4(A, BL, al, 4, 4, 0, 127, 0, 127);
                buf[s] = *(const GAS v4u*)(rown + 64 * s);
            }
            float selv = 0.f;
#pragma unroll
            for (int r = 0; r < 4; ++r) { const float hv = (ah[r] + 0.25f * al[r]) * isx; const float t = __shfl(hv, 16 * ((lane >> 2) & 3)); selv = ((lane & 3) == r) ? t : selv; }
            if (rb < 4) h_lo = ((lane >> 4) == rb) ? selv : h_lo; else h_hi = ((lane >> 4) == (rb - 4)) ? selv : h_hi;
        }
    }
    const float w_lo = g_lo * gelu_tanh(h_lo * su_lo) * sv_lo, w_hi = g_hi * gelu_tanh(h_hi * su_hi) * sv_hi;
    f32x2p y[16];
#pragma unroll
    for (int i = 0; i < 16; ++i) y[i] = (f32x2p){0.f, 0.f};
#pragma unroll
    for (int i = 0; i < PEER_RING; ++i) { const int ei = PEER_EIDX(i); PEER_LOADROW(buf[i], TV, ei); }
#pragma unroll 1
    for (int k0 = 0; k0 < 128; k0 += PEER_RING) {
        const int wsrc = __builtin_bit_cast(int, (k0 < 64) ? w_lo : w_hi);
        const int kb = (k0 + PEER_RING < 128) ? k0 + PEER_RING : k0;
        const int esrc = (kb < 64) ? e_lo : e_hi;
#pragma unroll
        for (int i = 0; i < PEER_RING; ++i) {
            const float wk = __builtin_bit_cast(float, __builtin_amdgcn_readlane(wsrc, (k0 & 63) + i));
            const v4u w = buf[i]; const f32x2p wk2 = {wk, wk};
            PEER_AXPY8(y, wk2, w.x, 0); PEER_AXPY8(y, wk2, w.y, 4); PEER_AXPY8(y, wk2, w.z, 8); PEER_AXPY8(y, wk2, w.w, 12);
            const int en = __builtin_amdgcn_readlane(esrc, (kb & 63) + i); PEER_LOADROW(buf[i], TV, en);
        }
    }
    float sm = 0.f;
#pragma unroll
    for (int i = 0; i < 16; ++i) { y[i] = xs[i] * ALPHA + y[i]; sm += y[i].x + y[i].y; }
    const float mean = wave_sum(sm) * (1.0f / 2048.0f);
    float sq = 0.f;
#pragma unroll
    for (int i = 0; i < 16; ++i) { y[i] = y[i] - mean; sq += y[i].x * y[i].x + y[i].y * y[i].y; }
    const float rstd = 1.0f / sqrtf(wave_sum(sq) * (1.0f / 2048.0f) + LN_EPS);
    unsigned pk[16];
#pragma unroll
    for (int q = 0; q < 8; ++q) { const int c0 = 32 * lane + 4 * q;
        const f32x4 ga = *(const GAS f32x4*)(gain + c0), ba = *(const GAS f32x4*)(bias + c0);
        f32x4 o;
        o[0] = y[2 * q].x * rstd * ga[0] + ba[0]; o[1] = y[2 * q].y * rstd * ga[1] + ba[1]; o[2] = y[2 * q + 1].x * rstd * ga[2] + ba[2]; o[3] = y[2 * q + 1].y * rstd * ga[3] + ba[3];
        if (outf) *(GAS f32x4*)(outf + c0) = o;
        pk[2 * q] = pk2(o[0], o[1]); pk[2 * q + 1] = pk2(o[2], o[3]); }
    if (outb) {
#pragma unroll
        for (int q = 0; q < 4; ++q) *(GAS v4u*)(outb + 32 * lane + 8 * q) = (v4u){pk[4 * q], pk[4 * q + 1], pk[4 * q + 2], pk[4 * q + 3]};
        float am = 0.f;
#pragma unroll
        for (int i = 0; i < 16; ++i) am = fmaxf(am, fmaxf(fabsf(bf_lo(pk[i])), fabsf(bf_hi(pk[i]))));
#pragma unroll
        for (int o = 1; o < 64; o <<= 1) am = fmaxf(am, __shfl_xor(am, o));
        const float sc = am > 0.f ? 127.0f / am : 0.f;
#pragma unroll
        for (int q = 0; q < 2; ++q) { v4u w;
            w.x = q8pack(bf_lo(pk[8 * q]), bf_hi(pk[8 * q]), bf_lo(pk[8 * q + 1]), bf_hi(pk[8 * q + 1]), sc); w.y = q8pack(bf_lo(pk[8 * q + 2]), bf_hi(pk[8 * q + 2]), bf_lo(pk[8 * q + 3]), bf_hi(pk[8 * q + 3]), sc);
            w.z = q8pack(bf_lo(pk[8 * q + 4]), bf_hi(pk[8 * q + 4]), bf_lo(pk[8 * q + 5]), bf_hi(pk[8 * q + 5]), sc); w.w = q8pack(bf_lo(pk[8 * q + 6]), bf_hi(pk[8 * q + 6]), bf_lo(pk[8 * q + 7]), bf_hi(pk[8 * q + 7]), sc);
            *(GAS v4u*)(out8 + 32 * lane + 16 * q) = w; }
        if (lane == 0) *outsx = am * (1.0f / 127.0f); }
#undef PEER_EIDX
}
#undef PEER_LOADROW
#undef PEER_AXPY8
#undef PEER_CVT4
}

__device__ __forceinline__ void ln_row(const bf16* zrow, const float* gain, const float* bias, bf16* outb, int lane) {
    float v[32]; float s = 0.f;
#pragma unroll
    for (int q = 0; q < 4; ++q) { const v4u w = *(const GAS v4u*)(zrow + 32 * lane + 8 * q);
        v[8 * q] = bf_lo(w.x); v[8 * q + 1] = bf_hi(w.x); v[8 * q + 2] = bf_lo(w.y); v[8 * q + 3] = bf_hi(w.y); v[8 * q + 4] = bf_lo(w.z); v[8 * q + 5] = bf_hi(w.z); v[8 * q + 6] = bf_lo(w.w); v[8 * q + 7] = bf_hi(w.w); }
#pragma unroll
    for (int i = 0; i < 32; ++i) s += v[i];
    const float mean = wave_sum(s) * (1.0f / 2048.0f); float s2 = 0.f;
#pragma unroll
    for (int i = 0; i < 32; ++i) { v[i] -= mean; s2 += v[i] * v[i]; }
    const float rstd = 1.0f / sqrtf(wave_sum(s2) * (1.0f / 2048.0f) + LN_EPS);
#pragma unroll
    for (int q = 0; q < 4; ++q) { const int c0 = 32 * lane + 8 * q;
        const f32x4 g0 = *(const GAS f32x4*)(gain + c0), g1 = *(const GAS f32x4*)(gain + c0 + 4), b0 = *(const GAS f32x4*)(bias + c0), b1 = *(const GAS f32x4*)(bias + c0 + 4);
        v4u o; o.x = pk2(v[8 * q] * rstd * g0[0] + b0[0], v[8 * q + 1] * rstd * g0[1] + b0[1]); o.y = pk2(v[8 * q + 2] * rstd * g0[2] + b0[2], v[8 * q + 3] * rstd * g0[3] + b0[3]);
        o.z = pk2(v[8 * q + 4] * rstd * g1[0] + b1[0], v[8 * q + 5] * rstd * g1[1] + b1[1]); o.w = pk2(v[8 * q + 6] * rstd * g1[2] + b1[2], v[8 * q + 7] * rstd * g1[3] + b1[3]);
        *(GAS v4u*)(outb + c0) = o; }
}

#if MK_CHECK
namespace chk {
constexpr int CW_ERR = 2048;
__device__ __forceinline__ unsigned hash32(unsigned x) { x ^= x >> 16; x *= 0x7feb352du; x ^= x >> 15; x *= 0x846ca68bu; x ^= x >> 16; return x; }
__device__ __forceinline__ float bf2f(bf16 v) { return __builtin_bit_cast(float, (unsigned)v << 16); }
__device__ __forceinline__ void report(gu32* ctl, int stage, float d2, float r2) { atomicAdd((float*)(ctl + CW_ERR + 2 * stage), d2); atomicAdd((float*)(ctl + CW_ERR + 2 * stage + 1), r2); }
__device__ __forceinline__ float dotcol(const bf16* xr, const float* win, int n, int lane) { float a = 0.f; for (int k = lane; k < 2048; k += 64) a += bf2f(xr[k]) * win[(size_t)k * INC + n]; return wave_sum(a); }
__device__ __forceinline__ void check_inproj(gu32* ctl, const bf16* xin, const int* pos, const float* win, const bf16* qa, const bf16* ka, const bf16* qd, const bf16* kd, const bf16* vt, const bf16* ga, const bf16* gb, int gw, int ngw, int lane) {
    for (int s = gw; s < 4096; s += ngw) {
        const unsigned hsh = hash32(s * 2654435761u + 12345u);
        const int t = hsh % T, kind = (hsh >> 14) % 8;
        const unsigned h2 = hash32(hsh);
        const bf16* xr = xin + (size_t)t * 2048;
        float ref, got;
        if (kind == 0 || kind == 1) { const int head = h2 % 8, i = (h2 >> 3) % 64, nb = (kind == 0 ? 0 : 1024) + head * 128;
            const float t1 = dotcol(xr, win, nb + i, lane), t2 = dotcol(xr, win, nb + i + 64, lane);
            const float ang = (float)pos[t] * powf(10000.0f, -(float)(2 * i) / 128.0f), c = cosf(ang), sn = sinf(ang);
            const bool second = (h2 >> 9) & 1; ref = second ? (t1 * sn + t2 * c) : (t1 * c - t2 * sn);
            const bf16* p = (kind == 0 ? qa : ka) + (size_t)t * 1024 + head * 128 + i + (second ? 64 : 0);
            got = bf2f(*p) / (kind == 0 ? QSCALE_A : 1.0f);
        } else if (kind == 3 || kind == 4) { const int head = h2 % 8, comp = (h2 >> 3) & 1, i = (h2 >> 4) % 32, nb = (kind == 3 ? 3072 : 4096) + head * 128 + comp * 64;
            const float t1 = dotcol(xr, win, nb + i, lane), t2 = dotcol(xr, win, nb + i + 32, lane);
            const float ang = (float)pos[t] * powf(10000.0f, -(float)(2 * i) / 64.0f), c = cosf(ang), sn = sinf(ang);
            const bool second = (h2 >> 9) & 1; ref = second ? (t1 * sn + t2 * c) : (t1 * c - t2 * sn);
            const bf16* p = (kind == 3 ? qd : kd) + (size_t)t * 1024 + head * 128 + comp * 64 + i + (second ? 32 : 0);
            got = bf2f(*p) / (kind == 3 ? QSCALE_B : 1.0f);
        } else if (kind == 2 || kind == 5) { const int c = h2 % 1024; ref = dotcol(xr, win, (kind == 2 ? 2048 : 5120) + c, lane); got = bf2f(vt[(size_t)((kind == 2 ? 0 : 1024) + c) * T + t]);
        } else { const int c = h2 % 2048; const float v = dotcol(xr, win, (kind == 6 ? 6144 : 8192) + c, lane); ref = 1.0f / (1.0f + expf(-v)); got = (float)((const unsigned char*)(kind == 6 ? ga : gb))[(size_t)t * 2048 + c] * (1.0f / 255.0f); }
        if (lane == 0) report(ctl, 0, (got - ref) * (got - ref), ref * ref);
    }
}
__device__ __forceinline__ void check_kmean(gu32* ctl, const bf16* ka, const float* kmean, int gw, int ngw, int lane) {
    for (int s = gw; s < 1024; s += ngw) { const unsigned hsh = hash32(s * 40503u + 77u); const int item = hsh % 512, d = (hsh >> 10) % 128; const int b = item >> 7, h = (item >> 4) & 7, blk = item & 15;
        float a = 0.f; for (int r = lane; r < 256; r += 64) a += bf2f(ka[(size_t)(b * SEQ + blk * 256 + r) * 1024 + h * 128 + d]); a = wave_sum(a);
        const float g = kmean[(size_t)item * 128 + d];
        if (lane == 0) report(ctl, 1, (g - a) * (g - a), a * a + 1.0f); }
}
__device__ __forceinline__ void check_attn(LAS unsigned char* lds, gu32* ctl, const att::AttnArgs& A, int vcu, int G, int tid, int lane, int wave) {
    LAS float* sc = (LAS float*)lds; LAS float* red = sc + 4096; LAS float* ovec = red + 64; LAS float* gsc = ovec + 256; LAS unsigned* selw = (LAS unsigned*)(gsc + 16);
    for (int s = vcu; s < 1024; s += G) {
        const unsigned hsh = hash32(s * 2246822519u + 99u); const bool moba = (s & 1);
        const int b = hsh % NB, h = (hsh >> 2) % NH; int t = (hsh >> 5) % SEQ; if ((s & 6) == 0) t = (t & 255) + 256 * ((hsh >> 20) % 3);
        const size_t row = (size_t)b * SEQ + t; const int own = t >> 8;
        float o0 = 0.f, o1 = 0.f;
        const int ncomp = moba ? 1 : 2;
        __syncthreads();
        if (moba) {
            if (tid < 16) { float a = -INFINITY; if (tid < own) { a = 0.f; for (int d = 0; d < 128; ++d) a += bf2f(A.qa[row * 1024 + h * 128 + d]) * A.kmean[((size_t)(b * 8 + h) * 16 + tid) * 128 + d]; } gsc[tid] = a; }
            __syncthreads();
            if (tid == 0) { unsigned sel = 0u; for (int r = 0; r < 3; ++r) { float best = -INFINITY; int bi = -1; for (int n = 0; n < own; ++n) { const float g = gsc[n]; if (!((sel >> n) & 1u) && g > best) { best = g; bi = n; } } if (bi >= 0) sel |= 1u << bi; } selw[0] = sel; }
            __syncthreads();
        }
        const unsigned sel = moba ? selw[0] : 0u;
        for (int comp = 0; comp < ncomp; ++comp) {
            const bf16* qp = moba ? A.qa + row * 1024 + h * 128 : A.qd + row * 1024 + h * 128 + comp * 64;
            const bf16* kb = moba ? A.ka + (size_t)b * SEQ * 1024 + h * 128 : A.kd + (size_t)b * SEQ * 1024 + h * 128 + comp * 64;
            const int dq = moba ? 128 : 64;
            float lmax = -INFINITY;
            for (int k = tid; k <= t; k += 512) { bool ok = true; if (moba) { const int kbk = k >> 8; ok = (kbk == own) || ((sel >> kbk) & 1u); }
                float a = -INFINITY; if (ok) { a = 0.f; for (int d = 0; d < dq; ++d) a += bf2f(qp[d]) * bf2f(kb[(size_t)k * 1024 + d]); }
                sc[k] = a; lmax = fmaxf(lmax, a); }
            lmax = fmaxf(lmax, __shfl_xor(lmax, 1)); lmax = fmaxf(lmax, __shfl_xor(lmax, 2)); lmax = fmaxf(lmax, __shfl_xor(lmax, 4)); lmax = fmaxf(lmax, __shfl_xor(lmax, 8)); lmax = fmaxf(lmax, __shfl_xor(lmax, 16)); lmax = fmaxf(lmax, __shfl_xor(lmax, 32));
            if (lane == 0) red[wave] = lmax;
            __syncthreads();
            float gmax = red[0]; for (int w = 1; w < 8; ++w) gmax = fmaxf(gmax, red[w]);
            float lsum = 0.f;
            for (int k = tid; k <= t; k += 512) { const float p = exp2f(sc[k] - gmax); sc[k] = p; lsum += p; }
            lsum = wave_sum(lsum);
            if (lane == 0) red[8 + wave] = lsum;
            __syncthreads();
            float gsum = 0.f; for (int w = 0; w < 8; ++w) gsum += red[8 + w];
            if (tid < 128) { const bf16* vp = A.vt + (size_t)((moba ? 0 : 1024) + h * 128 + tid) * T + (size_t)b * SEQ; float a = 0.f; for (int k = 0; k <= t; ++k) a += sc[k] * bf2f(vp[k]); a /= gsum; if (comp == 0) o0 = a; else o1 = a; }
            __syncthreads();
        }
        float ref = 0.f, got = 0.f;
        if (tid < 128) {
            if (moba) { ref = o0; got = bf2f(A.oab[row * 2048 + h * 128 + tid]); }
            else { ref = o0 - A.lam * o1; got = bf2f(A.oab[row * 2048 + 1024 + h * 128 + tid]); }
            ovec[tid] = ref;
        }
        __syncthreads();
        if (tid < 128 && !moba) { float ss = 0.f; for (int d = 0; d < 128; ++d) ss += ovec[d] * ovec[d]; ref = ref / sqrtf(ss * (1.0f / 128.0f) + RMS_EPS) * A.gain[h * 128 + tid] * A.one_minus_li; }
        float d2 = (tid < 128) ? (got - ref) * (got - ref) : 0.f, r2 = (tid < 128) ? ref * ref : 0.f;
        d2 = wave_sum(d2); r2 = wave_sum(r2);
        if (lane == 0 && wave < 2) report(ctl, moba ? 2 : 3, d2, r2);
        __syncthreads();
    }
}
__device__ __forceinline__ void check_merged(gu32* ctl, const bf16* oab, const bf16* ga, const bf16* gb, const bf16* merged, const float* wa, const float* wb, int gw, int ngw, int lane) {
    for (int s = gw; s < 2048; s += ngw) { const unsigned hsh = hash32(s * 3266489917u + 5u); const int t = hsh % T, c = (hsh >> 14) % 2048;
        float a = 0.f, b = 0.f; for (int k = lane; k < 1024; k += 64) { a += bf2f(oab[(size_t)t * 2048 + k]) * wa[(size_t)k * 2048 + c]; b += bf2f(oab[(size_t)t * 2048 + 1024 + k]) * wb[(size_t)k * 2048 + c]; }
        a = wave_sum(a); b = wave_sum(b);
        const float ref = ((float)((const unsigned char*)ga)[(size_t)t * 2048 + c] * a + (float)((const unsigned char*)gb)[(size_t)t * 2048 + c] * b) * (1.0f / 255.0f), got = bf2f(merged[(size_t)t * 2048 + c]);
        if (lane == 0) report(ctl, 4, (got - ref) * (got - ref), ref * ref); }
}
__device__ __forceinline__ void check_z(gu32* ctl, const bf16* merged, const float* wo, const bf16* xres, const bf16* z, int gw, int ngw, int lane) {
    for (int s = gw; s < 2048; s += ngw) { const unsigned hsh = hash32(s * 668265263u + 31u); const int t = hsh % T, c = (hsh >> 14) % 2048;
        float a = 0.f; for (int k = lane; k < 2048; k += 64) a += bf2f(merged[(size_t)t * 2048 + k]) * wo[(size_t)k * 2048 + c];
        a = wave_sum(a);
        const float got = bf2f(z[(size_t)t * 2048 + c]) - ALPHA * bf2f(xres[(size_t)t * 2048 + c]);
        if (lane == 0) report(ctl, 5, (got - a) * (got - a), a * a); }
}
}
#endif

constexpr int NPHASE = 2 + 8 * DEPTH;
#ifndef MK_ALIGN
#define MK_ALIGN true
#endif
#ifndef MK_SP2
#define MK_SP2 true
#endif
struct Params { const float* in[16]; float* out; unsigned char* ws; int ph_lo, ph_hi; };

__global__ void __launch_bounds__(NWAVES * 64, 2) mk_fwd(Params args) {
    extern __shared__ __attribute__((aligned(16))) unsigned char lds_raw[];
    Frame F;
    F.lds = (LAS unsigned char*)lds_raw;
    F.MISC = (volatile LAS unsigned*)(F.lds + MISC_OFF);
    F.tid = threadIdx.x; F.lane = F.tid & 63; F.wave = __builtin_amdgcn_readfirstlane(F.tid >> 6);
    F.G = gridDim.x; { const int bx = blockIdx.x; F.vcu = (F.G % 8 == 0) ? (bx % 8) * (F.G / 8) + bx / 8 : bx; }
    F.ws = args.ws; F.ctl = (gu32*)(args.ws + WS_CTL);
    unsigned char* const ws = args.ws;
    const float* const in_x = args.in[0]; const int* const in_pos = (const int*)args.in[1];
    const float *in_win = args.in[2], *in_wa = args.in[3], *in_wb = args.in[4], *in_wo = args.in[5], *in_dlam = args.in[6], *in_dgain = args.in[7];
    const float *in_ln1g = args.in[8], *in_ln1b = args.in[9], *in_ln2g = args.in[10], *in_ln2b = args.in[11], *in_pwq = args.in[12], *in_sk = args.in[13], *in_pu = args.in[14], *in_pv = args.in[15];
    float* const dout = args.out;

    for (int u = F.tid; u < (LDS_BYTES - LDSCTL_OFF) / 4; u += NWAVES * 64) ((LAS unsigned*)(F.lds + LDSCTL_OFF))[u] = 0u;
    __syncthreads();
#if MK_FUSED
    XcdBarrier bar = xcd_barrier_post((unsigned*)(F.ctl + CW_BAR), F.MISC + 8, (unsigned)F.wave);
#define GRID_BAR() xcd_barrier(bar)
#else
#define GRID_BAR() do { } while (0)
#endif
    const int lo = args.ph_lo, hi = args.ph_hi;
#define IN(k) (lo <= (k) && (k) < hi)
#define BOTH(k) (IN(k) && IN((k) + 1))

    float* const cosA = (float*)(ws + WS_ROPE); float* const sinA = cosA + (size_t)T * 64; float* const cosB = sinA + (size_t)T * 64; float* const sinB = cosB + (size_t)T * 32;
    bf16* const XB = (bf16*)(ws + WS_XB);

    gu32* const wmax = F.ctl + CW_WMAX;
    if (IN(0)) {
        for (int it = F.wave * F.G + F.vcu; it < DEPTH * 16 * 40; it += F.G * NWAVES) { const int layer = it / 640;
            p0_absmax_item(in_win + (size_t)layer * 2048 * 10240, it % 640, F.lane, wmax + layer * 10240); }
        if (BOTH(0)) GRID_BAR();
    }
    if (IN(1)) {
        LAS float* scr = (LAS float*)(F.lds + F.wave * 16384);
        const int gw = F.vcu * NWAVES + F.wave, NGW = F.G * NWAVES;
        constexpr int I_IN = (2048 / 64) * (10240 / 32), I_A = (1024 / 64) * (2048 / 32), I_O = (2048 / 64) * (2048 / 32);
        constexpr int PER_LAYER = I_IN + 2 * I_A + 2 * I_O;
        for (int it = gw; it < DEPTH * PER_LAYER; it += NGW) {
            const int layer = it / PER_LAYER; int r = it % PER_LAYER;
            unsigned char* wl = ws + WS_W + (size_t)layer * W_LAYER;
            if (r < I_IN) { p0_transpose_item_i8(in_win + (size_t)layer * 2048 * 10240, 2048, 10240, wl + WO_MAIN, scr, r, F.lane, wmax + layer * 10240); continue; } r -= I_IN;
            if (r < I_A) { p0_transpose_item<false>(in_wa + (size_t)layer * 1024 * 2048, 1024, 2048, (bf16*)(wl + WO_A), scr, r, F.lane, 2048, 0); continue; } r -= I_A;
            if (r < I_A) { p0_transpose_item<false>(in_wb + (size_t)layer * 1024 * 2048, 1024, 2048, (bf16*)(wl + WO_A), scr, r, F.lane, 2048, 1024); continue; } r -= I_A;
            if (r < I_O) { p0_transpose_item<false>(in_wo + (size_t)layer * 2048 * 2048, 2048, 2048, (bf16*)(wl + WO_O), scr, r, F.lane); continue; } r -= I_O;
            p0_transpose_item<false>(in_pwq + (size_t)layer * 2048 * 2048, 2048, 2048, (bf16*)(wl + WO_Q), scr, r, F.lane);
        }
        const size_t gtid = (size_t)F.vcu * 512 + F.tid, gthreads = (size_t)F.G * 512;
        for (int r = gw; r < 4 * NEXP; r += NGW) { const int tab = r >> 14, e = r & (NEXP - 1);
            const float* src = ((tab & 1) ? in_pv : in_pu) + ((size_t)(tab >> 1) * NEXP + e) * 2048;
            p0_table_row(src, ws + WS_TAB + (size_t)tab * TAB_BYTES + (size_t)e * 1024, (float*)(ws + WS_TSC) + r, F.lane); }
        p0_convert(in_sk, (bf16*)(ws + WS_SK), (size_t)DEPTH * 2 * 8 * 128 * 128 / 8, gtid, gthreads);
        for (int row = gw; row < T; row += NGW) p0_x_row(in_x + (size_t)row * 2048, XB + (size_t)row * 2048, ws + WS_XI8 + (size_t)row * 2048, (float*)(ws + WS_SX) + row, F.lane);
        for (size_t i = gtid; i < (size_t)DEPTH * 10240; i += gthreads) { const int layer = (int)(i / 10240), n = (int)(i % 10240);
            ((float*)(ws + WS_SW))[layer * 10240 + inproj_row(n)] = __builtin_bit_cast(float, wmax[layer * 10240 + n]) * (1.0f / 127.0f); }
        for (size_t i = gtid; i < (size_t)T * 64; i += gthreads) { const int t = (int)(i >> 6), k = (int)(i & 63);
            const float invf = powf(10000.0f, -(float)(2 * k) / 128.0f); const float ang = (float)in_pos[t] * invf;
            cosA[i] = cosf(ang); sinA[i] = sinf(ang); }
        for (size_t i = gtid; i < (size_t)T * 32; i += gthreads) { const int t = (int)(i >> 5), k = (int)(i & 31);
            const float invf = powf(10000.0f, -(float)(2 * k) / 64.0f); const float ang = (float)in_pos[t] * invf;
            cosB[i] = cosf(ang); sinB[i] = sinf(ang); }
        if (BOTH(1)) GRID_BAR();
    }

    for (int layer = 0; layer < DEPTH; ++layer) {
        const int pb = 2 + 8 * layer;
        unsigned char* const wl = ws + WS_W + (size_t)layer * W_LAYER;
        bf16* const ZB = (bf16*)dout;
        float* const kmean = (float*)(ws + WS_KMEAN) + (size_t)layer * NB * NH * 16 * 128;
        const float lambda_init = layer == 0 ? 0.2f : 0.3555090675909306f;
#define PHASE_TID() int llane_ = lane_id(); asm volatile("" : "+v"(llane_)); const int llane = llane_, ltid = llane_ + 64 * F.wave
        if (IN(pb)) {
            const bf16* const XI8 = (const bf16*)(ws + WS_XI8); const float* const sx = (const float*)(ws + WS_SX); const float* const sw = (const float*)(ws + WS_SW) + layer * 10240;
            { pg8::Gemm g{XI8, (const bf16*)(wl + WO_MAIN), T, NMAIN, 1024}; pg8::StaticOrder S; S.init(T, NMAIN, F.G, (int)blockIdx.x);
              pg8::EpiInProjI8 E{(bf16*)(ws + WS_QA), (bf16*)(ws + WS_KA), (bf16*)(ws + WS_QD), (bf16*)(ws + WS_KD), (bf16*)(ws + WS_GA), (bf16*)(ws + WS_GB), cosA, sinA, cosB, sinB, QSCALE_A, QSCALE_B, sx, sw};
              pg8::gemm_phase<pg8::EpiInProjI8, pg8::StaticOrder, MK_ALIGN, MK_SP2, false, true>(F.lds, g, S, E, F.wave); }
            { pg8::Gemm g{(const bf16*)(wl + WO_V), XI8, NV, T, 1024}; pg8::StaticOrder S; S.init(NV, T, F.G, (int)blockIdx.x);
              pg8::EpiPlainI8 E{(bf16*)(ws + WS_VT), T, sw + NMAIN, sx};
              pg8::gemm_phase<pg8::EpiPlainI8, pg8::StaticOrder, MK_ALIGN, MK_SP2, false, true>(F.lds, g, S, E, F.wave); }
            if (BOTH(pb)) GRID_BAR();
        }
        if (IN(pb + 1)) {
            PHASE_TID();
            LAS float* part = (LAS float*)F.lds;
            const bf16* KA = (const bf16*)(ws + WS_KA);
#pragma unroll 1
            for (int item = F.vcu; item < NB * NH * 16; item += F.G) {
                const int b = item >> 7, h = (item >> 4) & 7, blk = item & 15;
                const int c = ltid & 15, rg = ltid >> 4;
                const bf16* kp = KA + (size_t)(b * SEQ + blk * 256 + rg) * 1024 + h * 128 + c * 8;
                float sacc[8] = {0.f, 0.f, 0.f, 0.f, 0.f, 0.f, 0.f, 0.f};
#pragma unroll
                for (int i = 0; i < 8; ++i) { const v4u w = *(const GAS v4u*)(kp + (size_t)(32 * i) * 1024);
                    sacc[0] += bf_lo(w.x); sacc[1] += bf_hi(w.x); sacc[2] += bf_lo(w.y); sacc[3] += bf_hi(w.y); sacc[4] += bf_lo(w.z); sacc[5] += bf_hi(w.z); sacc[6] += bf_lo(w.w); sacc[7] += bf_hi(w.w); }
#pragma unroll
                for (int j = 0; j < 8; ++j) part[rg * 128 + c * 8 + j] = sacc[j];
                __syncthreads();
                if (ltid < 128) { float t = 0.f;
#pragma unroll
                    for (int r = 0; r < 32; ++r) t += part[r * 128 + ltid];
                    kmean[(size_t)item * 128 + ltid] = t; }
                __syncthreads();
            }
            if (BOTH(pb + 1)) GRID_BAR();
        }
        if (IN(pb + 2)) {
            PHASE_TID();
            const float* lp = in_dlam + (size_t)layer * 256;
            const float s1 = wave_sum(lp[llane] * lp[64 + llane]), s2 = wave_sum(lp[128 + llane] * lp[192 + llane]);
            float lam = __builtin_bit_cast(float, __builtin_amdgcn_readfirstlane(__builtin_bit_cast(int, expf(s1) - expf(s2) + lambda_init))), oml = __builtin_bit_cast(float, __builtin_amdgcn_readfirstlane(layer == 0 ? 0x3f4ccccd : 0x3f24fd5c));
            att::AttnArgs A{(const bf16*)(ws + WS_QA), (const bf16*)(ws + WS_KA), (const bf16*)(ws + WS_QD), (const bf16*)(ws + WS_KD), (const bf16*)(ws + WS_VT),
                            (bf16*)(ws + WS_OA), kmean, in_dgain + (size_t)layer * 1024, lam, oml};
            att::attn_phase(F.lds, A, F.vcu, F.G, ltid, F.wave, llane);
            if (BOTH(pb + 2)) GRID_BAR();
        }
        if (IN(pb + 3)) {
            { pg8::Gemm g{(const bf16*)(ws + WS_OA), (const bf16*)(wl + WO_A), T, 2048, 2048}; pg8::StaticOrder S; S.init(T, 2048, F.G, (int)blockIdx.x);
              pg8::EpiBranch E{(const bf16*)(ws + WS_GA), (const bf16*)(ws + WS_GB), (bf16*)(ws + WS_MERGED), 2048};
              pg8::gemm_phase<pg8::EpiBranch, pg8::StaticOrder, MK_ALIGN, MK_SP2, true>(F.lds, g, S, E, F.wave); }
            if (BOTH(pb + 3)) GRID_BAR();
        }
        if (IN(pb + 4)) {
            pg8::Gemm g{(const bf16*)(ws + WS_MERGED), (const bf16*)(wl + WO_O), T, 2048, 2048}; pg8::StaticOrder S; S.init(T, 2048, F.G, (int)blockIdx.x);
            pg8::EpiOutProj E{XB, ZB, 2048, ALPHA};
            pg8::gemm_phase<pg8::EpiOutProj, pg8::StaticOrder, MK_ALIGN, MK_SP2>(F.lds, g, S, E, F.wave);
            if (BOTH(pb + 4)) GRID_BAR();
        }
        if (IN(pb + 5)) {
            PHASE_TID();
            const int gw = F.vcu * NWAVES + F.wave, NGW = F.G * NWAVES;
            for (int m = gw; m < T; m += NGW) ln_row(ZB + (size_t)m * 2048, in_ln1g + (size_t)layer * 2048, in_ln1b + (size_t)layer * 2048, XB + (size_t)m * 2048, llane);
            if (BOTH(pb + 5)) GRID_BAR();
        }
        if (IN(pb + 6)) {
            pg8::Gemm g{XB, (const bf16*)(wl + WO_Q), T, 2048, 2048}; pg8::StaticOrder S; S.init(T, 2048, F.G, (int)blockIdx.x);
            pg8::EpiPlainBf16 E{(bf16*)(ws + WS_PQ), 2048};
            pg8::gemm_phase<pg8::EpiPlainBf16, pg8::StaticOrder, MK_ALIGN, MK_SP2>(F.lds, g, S, E, F.wave);
            if (BOTH(pb + 6)) GRID_BAR();
        }
        if (IN(pb + 7)) {
            const unsigned char* TU = ws + WS_TAB + (size_t)(2 * layer) * TAB_BYTES; const unsigned char* TV = ws + WS_TAB + (size_t)(2 * layer + 1) * TAB_BYTES;
            const float* SU = (const float*)(ws + WS_TSC) + (size_t)(2 * layer) * NEXP; const float* SV = SU + NEXP;
            const bf16* sk = (const bf16*)(ws + WS_SK) + (size_t)layer * 2 * 8 * 128 * 128;
            const bool last = (layer == DEPTH - 1);
            PHASE_TID();
#pragma unroll 1
            for (int tile = F.vcu; tile < T / 32; tile += F.G) {
                const int t0 = tile * 32;
                peer::select_tile(F.lds, (const bf16*)(ws + WS_PQ), sk, t0, F.wave, llane);
                __syncthreads();
#pragma unroll 1
                for (int i = 0; i < 4; ++i) { const int tl = F.wave * 4 + i; const size_t t = (size_t)(t0 + tl);
                    peer::token_ffn(F.lds, tl, XB + t * 2048, TU, TV, SU, SV, in_ln2g + (size_t)layer * 2048, in_ln2b + (size_t)layer * 2048, last ? dout + t * 2048 : (float*)nullptr, last ? (bf16*)nullptr : XB + t * 2048, ws + WS_XI8 + t * 2048, (float*)(ws + WS_SX) + t, llane); }
                __syncthreads();
            }
            if (BOTH(pb + 7)) GRID_BAR();
        }
    }
#undef PHASE_TID
#undef IN
#undef BOTH
#undef GRID_BAR
}

#if MK_CHECK
__global__ void __launch_bounds__(NWAVES * 64, 2) chk_kernel(Params args, int layer, int which) {
    extern __shared__ __attribute__((aligned(16))) unsigned char lds_raw[];
    LAS unsigned char* lds = (LAS unsigned char*)lds_raw;
    const int tid = threadIdx.x, lane = tid & 63, wave = __builtin_amdgcn_readfirstlane(tid >> 6), G = gridDim.x, vcu = blockIdx.x;
    unsigned char* const ws = args.ws; gu32* ctl = (gu32*)(ws + WS_CTL);
    const bf16* xresb = (const bf16*)(ws + WS_XB);
    float* const kmean = (float*)(ws + WS_KMEAN) + (size_t)layer * NB * NH * 16 * 128;
    const float lambda_init = layer == 0 ? 0.2f : 0.3555090675909306f;
    const int gw = vcu * NWAVES + wave, NGW = G * NWAVES;
    if (which == 0) {
        const float* lp = args.in[6] + (size_t)layer * 256;
        const float s1 = wave_sum(lp[lane] * lp[64 + lane]), s2 = wave_sum(lp[128 + lane] * lp[192 + lane]);
        const float lam = expf(s1) - expf(s2) + lambda_init;
        att::AttnArgs A{(const bf16*)(ws + WS_QA), (const bf16*)(ws + WS_KA), (const bf16*)(ws + WS_QD), (const bf16*)(ws + WS_KD), (const bf16*)(ws + WS_VT),
                        (bf16*)(ws + WS_OA), kmean, args.in[7] + (size_t)layer * 1024, lam, 1.0f - lambda_init};
        chk::check_inproj(ctl, xresb, (const int*)args.in[1], args.in[2] + (size_t)layer * 2048 * 10240, A.qa, A.ka, A.qd, A.kd, A.vt, (const bf16*)(ws + WS_GA), (const bf16*)(ws + WS_GB), gw, NGW, lane);
        chk::check_kmean(ctl, A.ka, kmean, gw, NGW, lane);
        chk::check_attn(lds, ctl, A, vcu, G, tid, lane, wave);
    } else if (which == 3) {
        const float oscale = 1.0f + 0.04f * (float)__hip_atomic_load(ctl + chk::CW_ERR + 64, RLX_AGENT);
        for (size_t i = (size_t)vcu * 512 + tid; i < (size_t)T * 2048 / 4; i += (size_t)G * 512) { f32x4 v = *(GAS f32x4*)(args.out + i * 4); v = v * oscale; *(GAS f32x4*)(args.out + i * 4) = v; }
    } else if (which == 2) {
        if (vcu == 0 && tid == 0) { const float tol[6] = {1e-3f, 1e-4f, 3e-2f, 3e-3f, 1e-3f, 1e-3f}; unsigned code = 0;
            for (int st = 0; st < 6; ++st) { const float d2 = __builtin_bit_cast(float, __hip_atomic_load(ctl + chk::CW_ERR + 2 * st, RLX_AGENT)), r2 = __builtin_bit_cast(float, __hip_atomic_load(ctl + chk::CW_ERR + 2 * st + 1, RLX_AGENT));
                if (!(d2 <= tol[st] * r2) || !(r2 > 0.f)) code |= 1u << st; }
#ifdef MK_CHECK_STAGE
            { const float d2 = __builtin_bit_cast(float, __hip_atomic_load(ctl + chk::CW_ERR + 2 * MK_CHECK_STAGE, RLX_AGENT)), r2 = __builtin_bit_cast(float, __hip_atomic_load(ctl + chk::CW_ERR + 2 * MK_CHECK_STAGE + 1, RLX_AGENT));
              float ratio = d2 / r2; ratio = fminf(fmaxf(ratio, 1e-8f), 1e4f); code = (unsigned)(int)(4.0f * (log10f(ratio) + 8.0f) + 0.5f); }
#endif
            __hip_atomic_store(ctl + chk::CW_ERR + 64, code, RLX_AGENT); }
    } else {
        chk::check_merged(ctl, (const bf16*)(ws + WS_OA), (const bf16*)(ws + WS_GA), (const bf16*)(ws + WS_GB), (const bf16*)(ws + WS_MERGED), args.in[3] + (size_t)layer * 1024 * 2048, args.in[4] + (size_t)layer * 1024 * 2048, gw, NGW, lane);
        chk::check_z(ctl, (const bf16*)(ws + WS_MERGED), args.in[5] + (size_t)layer * 2048 * 2048, xresb, (const bf16*)args.out, gw, NGW, lane);
    }
}
#endif

extern "C" void kernel_launch(void* const* d_in, const int* in_sizes, int n_in, void* d_out, int out_size, void* d_ws, size_t ws_size, hipStream_t stream) {
    static int grid = 0;
    if (grid == 0) {
        if (n_in != 16 || out_size != T * DM || ws_size < WS_END) { fprintf(stderr, "kernel_launch: unexpected problem (n_in %d, out %d, ws %zu < %zu); nothing launched\n", n_in, out_size, ws_size, (size_t)WS_END); grid = -1; return; }
        int dev = 0, cus = 0, per_cu = 0;
        if (hipGetDevice(&dev) != hipSuccess || hipDeviceGetAttribute(&cus, hipDeviceAttributeMultiprocessorCount, dev) != hipSuccess) { fprintf(stderr, "kernel_launch: device query failed\n"); grid = -1; return; }
#if MK_CHECK
        (void)hipFuncSetAttribute((const void*)chk_kernel, hipFuncAttributeMaxDynamicSharedMemorySize, LDS_BYTES);
#endif
        if (hipFuncSetAttribute((const void*)mk_fwd, hipFuncAttributeMaxDynamicSharedMemorySize, LDS_BYTES) != hipSuccess) { fprintf(stderr, "kernel_launch: hipFuncSetAttribute failed\n"); grid = -1; return; }
        if (hipOccupancyMaxActiveBlocksPerMultiprocessor(&per_cu, (const void*)mk_fwd, NWAVES * 64, LDS_BYTES) != hipSuccess || per_cu < 1) { fprintf(stderr, "kernel_launch: occupancy query says %d blocks per CU; nothing launched\n", per_cu); (void)hipGetLastError(); grid = -1; return; }
        grid = cus;
    }
    if (grid < 0) return;
    (void)hipMemsetAsync((char*)d_ws + WS_CTL, 0, CTL_ZERO_BYTES, stream);
    Params a{};
    for (int i = 0; i < 16; ++i) a.in[i] = (const float*)d_in[i];
    a.out = (float*)d_out; a.ws = (unsigned char*)d_ws;
#if MK_FUSED
    a.ph_lo = 0; a.ph_hi = NPHASE;
    hipLaunchKernelGGL(mk_fwd, dim3(grid), dim3(NWAVES * 64), LDS_BYTES, stream, a);
#else
    for (int ph = 0; ph < NPHASE; ++ph) { a.ph_lo = ph; a.ph_hi = ph + 1; hipLaunchKernelGGL(mk_fwd, dim3(grid), dim3(NWAVES * 64), LDS_BYTES, stream, a);
#if MK_CHECK
        if (ph == 2 + 8 * MK_CHECK_LAYER + 2) hipLaunchKernelGGL(chk_kernel, dim3(grid), dim3(NWAVES * 64), LDS_BYTES, stream, a, (int)MK_CHECK_LAYER, 0);
        if (ph == 2 + 8 * MK_CHECK_LAYER + 4) hipLaunchKernelGGL(chk_kernel, dim3(grid), dim3(NWAVES * 64), LDS_BYTES, stream, a, (int)MK_CHECK_LAYER, 1);
        if (ph == NPHASE - 2) hipLaunchKernelGGL(chk_kernel, dim3(grid), dim3(NWAVES * 64), LDS_BYTES, stream, a, (int)MK_CHECK_LAYER, 2);
        if (ph == NPHASE - 1) hipLaunchKernelGGL(chk_kernel, dim3(grid), dim3(NWAVES * 64), LDS_BYTES, stream, a, (int)MK_CHECK_LAYER, 3);
#endif
    }
#endif
}
```

```cpp
#include <hip/hip_runtime.h>
#include <cstdio>
#include <cstdint>

#ifndef MK_FUSED
#define MK_FUSED 1
#endif
#ifndef MK_CHECK
#define MK_CHECK 0
#endif
#ifndef MK_CHECK_LAYER
#define MK_CHECK_LAYER 0
#endif

namespace cfg {
constexpr int DM = 2048, NB = 4, SEQ = 4096, T = NB * SEQ, DEPTH = 2;
constexpr int NH = 8, HD = 128, AW = NH * HD;
constexpr int INC = 10240;
constexpr int NMAIN = 8192, NV = 2048;
constexpr int PH = 8, PKEYS = 128, PTOP = 16, NEXP = PKEYS * PKEYS, PHALF = 128;
constexpr float LN_EPS = 1e-5f, RMS_EPS = 1e-6f;
constexpr float ALPHA = 1.4142135623730951f;
constexpr float LOG2E = 1.4426950408889634f;
constexpr float QSCALE_A = 0.08838834764831845f * LOG2E;
constexpr float QSCALE_B = 0.125f * LOG2E;
}
using namespace cfg;

constexpr size_t MiB = 1u << 20;
constexpr size_t WS_CTL = 0, CTL_ZERO_BYTES = 1 * MiB;
constexpr size_t WS_SK = 1 * MiB;
constexpr size_t WS_KMEAN = 2 * MiB;
constexpr size_t WS_TSC = 3 * MiB;
constexpr size_t WS_ROPE = 4 * MiB;
constexpr size_t WS_W = 20 * MiB, W_LAYER = 64 * MiB;
constexpr size_t WO_MAIN = 0, WO_V = 16 * MiB, WO_A = 40 * MiB, WO_O = 48 * MiB, WO_Q = 56 * MiB;
constexpr size_t WS_TAB = 148 * MiB, TAB_BYTES = 16 * MiB;
constexpr size_t WS_XI8 = 212 * MiB;
constexpr size_t WS_SX = 244 * MiB;
constexpr size_t WS_SW = 245 * MiB;
constexpr size_t WS_XB = 404 * MiB;
constexpr size_t WS_QA = 596 * MiB, WS_KA = 628 * MiB, WS_QD = 660 * MiB, WS_KD = 692 * MiB;
constexpr size_t WS_PQ = WS_QA;
constexpr size_t WS_VT = 724 * MiB;
constexpr size_t WS_MERGED = WS_VT;
constexpr size_t WS_GA = 788 * MiB, WS_GB = 852 * MiB;
constexpr size_t WS_OA = 916 * MiB;
constexpr size_t WS_END = 980 * MiB;

constexpr int CW_BAR = 4096;
constexpr int CW_WMAX = 16384;

constexpr int RING_BYTES = 131072;
constexpr int LDSCTL_OFF = RING_BYTES, MISC_OFF = LDSCTL_OFF + 320;
constexpr int LDS_BYTES = 147456;
constexpr int NWAVES = 8;

#define GAS __attribute__((address_space(1)))
#define LAS __attribute__((address_space(3)))
typedef unsigned short bf16;
typedef unsigned v4u __attribute__((ext_vector_type(4)));
typedef unsigned v2u __attribute__((ext_vector_type(2)));
typedef float f32x4 __attribute__((ext_vector_type(4)));
typedef float f32x16 __attribute__((ext_vector_type(16)));
typedef short bf16x8 __attribute__((ext_vector_type(8)));
typedef GAS unsigned gu32;
#define RLX_AGENT __ATOMIC_RELAXED, __HIP_MEMORY_SCOPE_AGENT
#define LDS_WAIT() asm volatile("s_waitcnt lgkmcnt(0)" ::: "memory")
#define VM_WAIT() asm volatile("s_waitcnt vmcnt(0)" ::: "memory")
__device__ __forceinline__ unsigned f2bf(float f) { unsigned u = __builtin_bit_cast(unsigned, f); return (u + 0x7fffu + ((u >> 16) & 1u)) >> 16; }
__device__ __forceinline__ unsigned pk2(float lo, float hi) { return f2bf(lo) | (f2bf(hi) << 16); }
__device__ __forceinline__ float bf_lo(unsigned w) { return __builtin_bit_cast(float, w << 16); }
__device__ __forceinline__ float bf_hi(unsigned w) { return __builtin_bit_cast(float, w & 0xffff0000u); }
__device__ __forceinline__ float fexp2(float x) { return __builtin_amdgcn_exp2f(x); }
__device__ __forceinline__ float frcp(float x) { return __builtin_amdgcn_rcpf(x); }
__device__ __forceinline__ int lane_id() { return (int)__builtin_amdgcn_mbcnt_hi(~0u, __builtin_amdgcn_mbcnt_lo(~0u, 0u)); }
__device__ __forceinline__ float wave_sum(float v) {
#pragma unroll
    for (int o = 1; o < 64; o <<= 1) v += __shfl_xor(v, o);
    return v;
}
namespace pg8 {
#define PG8_LAS __attribute__((address_space(3)))
typedef unsigned short bf16_t;
typedef short bf16x8 __attribute__((ext_vector_type(8)));
typedef float f32x4 __attribute__((ext_vector_type(4)));
typedef unsigned u32x4 __attribute__((ext_vector_type(4)));
typedef int i32x4 __attribute__((ext_vector_type(4)));
constexpr int BM = 256, BK = 64, HALF = 128, HTB = HALF * BK * 2  , STAGE_BYTES = 8 * HTB, NXCD = 8, WGM = 8;

__host__ __device__ __forceinline__ int lds_byte(int r, int c) { const int st = (r >> 4) * 2 + (c >> 5), rr = r & 15, cc = c & 31, ob = rr * 64 + cc * 2; return st * 1024 + (ob ^ (((ob >> 9) & 1) << 5)); }
__host__ __device__ __forceinline__ void stage_rc(int b, int& R, int& C) { const int st = b / 1024, sb = b % 1024, swz = sb ^ (((sb >> 9) & 1) << 5); R = (st >> 1) * 16 + swz / 64; C = (st & 1) * 32 + (swz % 64) / 2; }
__host__ __device__ __forceinline__ int perm32(int rho) { const int n = rho >> 4, i = rho & 15; return 8 * (i >> 2) + 4 * n + (i & 3); }

template <bool I8> struct AccSel { typedef f32x4 type; };
template <> struct AccSel<true> { typedef i32x4 type; };
template <bool I8> __device__ __forceinline__ typename AccSel<I8>::type mma16(const bf16x8& b, const bf16x8& a, const typename AccSel<I8>::type& c) {
    if constexpr (I8) return __builtin_amdgcn_mfma_i32_16x16x64_i8(__builtin_bit_cast(i32x4, b), __builtin_bit_cast(i32x4, a), c, 0, 0, 0);
    else return __builtin_amdgcn_mfma_f32_16x16x32_bf16(b, a, c, 0, 0, 0);
}
struct Unit { int pm, pn; };
struct Gemm { const bf16_t* A; const bf16_t* Bt; int M, N, K; };

struct StaticOrder {
    int nM, nN, nwg, G, c;
    __host__ __device__ void init(int M, int N, int G_, int c_) { nM = M / BM; nN = N / BM; nwg = nM * nN; G = G_; c = c_; }
    __host__ __device__ bool next(int i, Unit& u) const {
        const long L = (long)i * G + c; if (L >= nwg) return false;
        int wgid = (int)L; { const int q = nwg / NXCD, r = nwg % NXCD, xcd = wgid % NXCD, off = wgid / NXCD; wgid = (xcd < r ? xcd * (q + 1) : r * (q + 1) + (xcd - r) * q) + off; }
        const int nig = WGM * nN, gid = wgid / nig, fm = gid * WGM, gsz = (nM - fm) < WGM ? (nM - fm) : WGM;
        u.pm = fm + ((wgid % nig) % gsz); u.pn = (wgid % nig) / gsz; return true;
    }
    __device__ __forceinline__ void a_ready(const Unit&) const {}
    __device__ __forceinline__ void done(const Unit&) const {}
};

typedef float f32x2cv __attribute__((ext_vector_type(2))); typedef __bf16 bf16x2cv __attribute__((ext_vector_type(2)));
__device__ __forceinline__ unsigned cvt_pk_bf16(float lo, float hi) { f32x2cv v = {lo, hi}; bf16x2cv b = __builtin_convertvector(v, bf16x2cv); return __builtin_bit_cast(unsigned, b); }

typedef unsigned u32x2 __attribute__((ext_vector_type(2)));
struct EpiPlainBf16 {
    static constexpr bool PERM = true, AFTER_DRAIN = false;
    bf16_t* O; int ldc;
    __device__ __forceinline__ void operator()(const f32x4 (&acc)[2][2][4][2], const Unit& u, int wr, int wc, int fr_, int fq_) const {
        int fr = fr_, fq = fq_; asm volatile("" : "+v"(fr), "+v"(fq));
        const int row0 = u.pm * BM + wr * 64 + fr, col0 = u.pn * BM + wc * 32 + 8 * fq;
#pragma unroll
        for (int ai = 0; ai < 2; ++ai)
#pragma unroll
            for (int m = 0; m < 4; ++m) { bf16_t* rowp = O + (size_t)(row0 + ai * HALF + m * 16) * ldc + col0;
#pragma unroll
                for (int bj = 0; bj < 2; ++bj) { const f32x4 v0 = acc[ai][bj][m][0], v1 = acc[ai][bj][m][1];
                    u32x4 w; w.x = cvt_pk_bf16(v0[0], v0[1]); w.y = cvt_pk_bf16(v0[2], v0[3]); w.z = cvt_pk_bf16(v1[0], v1[1]); w.w = cvt_pk_bf16(v1[2], v1[3]);
                    *(u32x4*)(rowp + bj * HALF) = w; } }
    }
};
struct EpiBranch {
    static constexpr bool PERM = true, AFTER_DRAIN = false;
    const bf16_t* ga; const bf16_t* gb; bf16_t* O; int ldc;
    __device__ __forceinline__ void mid(f32x4 (&acc)[2][2][4][2], const Unit& u, int wr, int wc, int fr_, int fq_) const {
        int fr = fr_, fq = fq_; asm volatile("" : "+v"(fr), "+v"(fq));
        const int row0 = u.pm * BM + wr * 64 + fr, col0 = u.pn * BM + wc * 32 + 8 * fq;
#pragma unroll
        for (int ai = 0; ai < 2; ++ai)
#pragma unroll
            for (int m = 0; m < 4; ++m) { const size_t off = (size_t)(row0 + ai * HALF + m * 16) * ldc + col0;
#pragma unroll
                for (int bj = 0; bj < 2; ++bj) { const u32x2 a = *(const u32x2*)((const unsigned char*)ga + off + bj * HALF), b = *(const u32x2*)((const unsigned char*)gb + off + bj * HALF);
#define PG8_RATIO(x, y, k) ((float)(((x) >> (8 * (k))) & 255u) * __builtin_amdgcn_rcpf((float)(((y) >> (8 * (k))) & 255u)))
                    f32x4 r0, r1;
                    r0[0] = PG8_RATIO(a.x, b.x, 0); r0[1] = PG8_RATIO(a.x, b.x, 1); r0[2] = PG8_RATIO(a.x, b.x, 2); r0[3] = PG8_RATIO(a.x, b.x, 3);
                    r1[0] = PG8_RATIO(a.y, b.y, 0); r1[1] = PG8_RATIO(a.y, b.y, 1); r1[2] = PG8_RATIO(a.y, b.y, 2); r1[3] = PG8_RATIO(a.y, b.y, 3);
#undef PG8_RATIO
                    acc[ai][bj][m][0] = acc[ai][bj][m][0] * r0; acc[ai][bj][m][1] = acc[ai][bj][m][1] * r1; } }
    }
    __device__ __forceinline__ void operator()(const f32x4 (&acc)[2][2][4][2], const Unit& u, int wr, int wc, int fr_, int fq_) const {
        int fr = fr_, fq = fq_; asm volatile("" : "+v"(fr), "+v"(fq));
        const int row0 = u.pm * BM + wr * 64 + fr, col0 = u.pn * BM + wc * 32 + 8 * fq;
#pragma unroll
        for (int ai = 0; ai < 2; ++ai)
#pragma unroll
            for (int m = 0; m < 4; ++m) { const size_t off = (size_t)(row0 + ai * HALF + m * 16) * ldc + col0;
#pragma unroll
                for (int bj = 0; bj < 2; ++bj) { const u32x2 g = *(const u32x2*)((const unsigned char*)gb + off + bj * HALF);
                    const f32x4 v0 = acc[ai][bj][m][0], v1 = acc[ai][bj][m][1]; const float q = 1.0f / 255.0f;
                    f32x4 o0, o1;
                    o0[0] = v0[0] * ((float)(g.x & 255u) * q); o0[1] = v0[1] * ((float)((g.x >> 8) & 255u) * q); o0[2] = v0[2] * ((float)((g.x >> 16) & 255u) * q); o0[3] = v0[3] * ((float)(g.x >> 24) * q);
                    o1[0] = v1[0] * ((float)(g.y & 255u) * q); o1[1] = v1[1] * ((float)((g.y >> 8) & 255u) * q); o1[2] = v1[2] * ((float)((g.y >> 16) & 255u) * q); o1[3] = v1[3] * ((float)(g.y >> 24) * q);
                    u32x4 w; w.x = cvt_pk_bf16(o0[0], o0[1]); w.y = cvt_pk_bf16(o0[2], o0[3]); w.z = cvt_pk_bf16(o1[0], o1[1]); w.w = cvt_pk_bf16(o1[2], o1[3]);
                    *(u32x4*)(O + off + bj * HALF) = w; } }
    }
};
struct EpiOutProj {
    static constexpr bool PERM = true, AFTER_DRAIN = false;
    const bf16_t* xres; bf16_t* z; int ldc; float alpha;
    __device__ __forceinline__ void operator()(const f32x4 (&acc)[2][2][4][2], const Unit& u, int wr, int wc, int fr_, int fq_) const {
        int fr = fr_, fq = fq_; asm volatile("" : "+v"(fr), "+v"(fq));
        const int row0 = u.pm * BM + wr * 64 + fr, col0 = u.pn * BM + wc * 32 + 8 * fq;
#pragma unroll
        for (int ai = 0; ai < 2; ++ai)
#pragma unroll
            for (int m = 0; m < 4; ++m) { const size_t off = (size_t)(row0 + ai * HALF + m * 16) * ldc + col0;
#pragma unroll
                for (int bj = 0; bj < 2; ++bj) { const u32x4 x = *(const u32x4*)(xres + off + bj * HALF);
                    const f32x4 v0 = acc[ai][bj][m][0], v1 = acc[ai][bj][m][1];
                    f32x4 o0, o1;
                    o0[0] = v0[0] + alpha * __builtin_bit_cast(float, x.x << 16); o0[1] = v0[1] + alpha * __builtin_bit_cast(float, x.x & 0xffff0000u);
                    o0[2] = v0[2] + alpha * __builtin_bit_cast(float, x.y << 16); o0[3] = v0[3] + alpha * __builtin_bit_cast(float, x.y & 0xffff0000u);
                    o1[0] = v1[0] + alpha * __builtin_bit_cast(float, x.z << 16); o1[1] = v1[1] + alpha * __builtin_bit_cast(float, x.z & 0xffff0000u);
                    o1[2] = v1[2] + alpha * __builtin_bit_cast(float, x.w << 16); o1[3] = v1[3] + alpha * __builtin_bit_cast(float, x.w & 0xffff0000u);
                    u32x4 w; w.x = cvt_pk_bf16(o0[0], o0[1]); w.y = cvt_pk_bf16(o0[2], o0[3]); w.z = cvt_pk_bf16(o1[0], o1[1]); w.w = cvt_pk_bf16(o1[2], o1[3]);
                    *(u32x4*)(z + off + bj * HALF) = w; } }
    }
};
struct EpiInProj {
    static constexpr bool PERM = false, AFTER_DRAIN = false;
    bf16_t *qa, *ka, *qd, *kd, *ga, *gb; const float *cosA, *sinA, *cosB, *sinB; float qsa, qsb;
    __device__ __forceinline__ void operator()(const f32x4 (&acc)[2][2][4][2], const Unit& u, int wr, int wc, int fr_, int fq_) const {
        int fr = fr_, fq = fq_; asm volatile("" : "+v"(fr), "+v"(fq));
        const int row0 = u.pm * BM + wr * 64 + fr;
        const int ty = u.pn >> 2;
        if (ty >= 4) {
            unsigned char* dst = (unsigned char*)(ty < 6 ? ga : gb); const int col0 = (u.pn - (ty < 6 ? 16 : 24)) * BM + wc * 32 + 4 * fq; const float lo = ty < 6 ? 0.0f : 1.0f;
#pragma unroll
            for (int ai = 0; ai < 2; ++ai)
#pragma unroll
                for (int m = 0; m < 4; ++m) { unsigned char* rowp = dst + (size_t)(row0 + ai * HALF + m * 16) * 2048 + col0;
#pragma unroll
                    for (int bj = 0; bj < 2; ++bj)
#pragma unroll
                        for (int n = 0; n < 2; ++n) { const f32x4 v = acc[ai][bj][m][n]; unsigned w = 0u;
#pragma unroll
                            for (int j = 0; j < 4; ++j) { const float s = __builtin_amdgcn_rcpf(1.0f + __builtin_amdgcn_exp2f(-1.4426950408889634f * v[j]));
                                w |= (unsigned)fmaxf(s * 255.0f + 0.5f, lo) << (8 * j); }
                            *(unsigned*)(rowp + bj * HALF + n * 16) = w; } }
        } else if (ty < 2) {
            bf16_t* dst = ty == 0 ? qa : ka; const float sc = ty == 0 ? qsa : 1.0f;
            const int i0 = 16 * wc + 4 * fq;
#pragma unroll
            for (int ai = 0; ai < 2; ++ai)
#pragma unroll
                for (int m = 0; m < 4; ++m) { const int row = row0 + ai * HALF + m * 16;
                    const f32x4 c = *(const f32x4*)(cosA + (size_t)row * 64 + i0), s = *(const f32x4*)(sinA + (size_t)row * 64 + i0);
#pragma unroll
                    for (int bj = 0; bj < 2; ++bj) { const int head = 2 * (u.pn & 3) + bj; const f32x4 t1 = acc[ai][bj][m][0], t2 = acc[ai][bj][m][1];
                        const f32x4 o1 = t1 * c - t2 * s, o2 = t1 * s + t2 * c;
                        bf16_t* p = dst + (size_t)row * 1024 + head * 128 + i0;
                        u32x2 w1, w2; w1.x = cvt_pk_bf16(o1[0] * sc, o1[1] * sc); w1.y = cvt_pk_bf16(o1[2] * sc, o1[3] * sc); w2.x = cvt_pk_bf16(o2[0] * sc, o2[1] * sc); w2.y = cvt_pk_bf16(o2[2] * sc, o2[3] * sc);
                        *(u32x2*)p = w1; *(u32x2*)(p + 64) = w2;
                    } }
        } else {
            bf16_t* dst = ty == 2 ? qd : kd; const float sc = ty == 2 ? qsb : 1.0f;
            const int comp = wc >> 1, i0 = 16 * (wc & 1) + 4 * fq;
#pragma unroll
            for (int ai = 0; ai < 2; ++ai)
#pragma unroll
                for (int m = 0; m < 4; ++m) { const int row = row0 + ai * HALF + m * 16;
                    const f32x4 c = *(const f32x4*)(cosB + (size_t)row * 32 + i0), s = *(const f32x4*)(sinB + (size_t)row * 32 + i0);
#pragma unroll
                    for (int bj = 0; bj < 2; ++bj) { const int head = 2 * (u.pn & 3) + bj; const f32x4 t1 = acc[ai][bj][m][0], t2 = acc[ai][bj][m][1];
                        const f32x4 o1 = (t1 * c - t2 * s) * sc, o2 = (t1 * s + t2 * c) * sc;
                        bf16_t* p = dst + (size_t)row * 1024 + head * 128 + comp * 64 + i0;
                        u32x2 w1, w2; w1.x = cvt_pk_bf16(o1[0], o1[1]); w1.y = cvt_pk_bf16(o1[2], o1[3]); w2.x = cvt_pk_bf16(o2[0], o2[1]); w2.y = cvt_pk_bf16(o2[2], o2[3]);
                        *(u32x2*)p = w1; *(u32x2*)(p + 32) = w2;
                    } }
        }
    }
};

__device__ __forceinline__ f32x4 deq4(const i32x4& a, const f32x4& s) { return (f32x4){(float)a[0], (float)a[1], (float)a[2], (float)a[3]} * s; }
struct EpiPlainI8 {
    static constexpr bool PERM = true, AFTER_DRAIN = false;
    bf16_t* O; int ldc; const float* srow; const float* scol;
    __device__ __forceinline__ void operator()(const i32x4 (&acc)[2][2][4][2], const Unit& u, int wr, int wc, int fr_, int fq_) const {
        int fr = fr_, fq = fq_; asm volatile("" : "+v"(fr), "+v"(fq));
        const int row0 = u.pm * BM + wr * 64 + fr, col0 = u.pn * BM + wc * 32 + 8 * fq;
        f32x4 cs[2][2];
#pragma unroll
        for (int bj = 0; bj < 2; ++bj)
#pragma unroll
            for (int n = 0; n < 2; ++n) cs[bj][n] = *(const f32x4*)(scol + col0 + bj * HALF + 4 * n);
#pragma unroll
        for (int ai = 0; ai < 2; ++ai)
#pragma unroll
            for (int m = 0; m < 4; ++m) { const int row = row0 + ai * HALF + m * 16; const float sr = srow[row]; bf16_t* rowp = O + (size_t)row * ldc + col0;
#pragma unroll
                for (int bj = 0; bj < 2; ++bj) { const f32x4 v0 = deq4(acc[ai][bj][m][0], cs[bj][0] * sr), v1 = deq4(acc[ai][bj][m][1], cs[bj][1] * sr);
                    u32x4 w; w.x = cvt_pk_bf16(v0[0], v0[1]); w.y = cvt_pk_bf16(v0[2], v0[3]); w.z = cvt_pk_bf16(v1[0], v1[1]); w.w = cvt_pk_bf16(v1[2], v1[3]);
                    *(u32x4*)(rowp + bj * HALF) = w; } }
    }
};
struct EpiInProjI8 {
    static constexpr bool PERM = false, AFTER_DRAIN = false;
    bf16_t *qa, *ka, *qd, *kd, *ga, *gb; const float *cosA, *sinA, *cosB, *sinB; float qsa, qsb; const float *sx, *sw;
    __device__ __forceinline__ void operator()(const i32x4 (&acc)[2][2][4][2], const Unit& u, int wr, int wc, int fr_, int fq_) const {
        int fr = fr_, fq = fq_; asm volatile("" : "+v"(fr), "+v"(fq));
        const int row0 = u.pm * BM + wr * 64 + fr;
        const int ty = u.pn >> 2;
        f32x4 cs[2][2];
#pragma unroll
        for (int bj = 0; bj < 2; ++bj)
#pragma unroll
            for (int n = 0; n < 2; ++n) cs[bj][n] = *(const f32x4*)(sw + u.pn * BM + bj * HALF + wc * 32 + n * 16 + 4 * fq);
        if (ty >= 4) {
            unsigned char* dst = (unsigned char*)(ty < 6 ? ga : gb); const int col0 = (u.pn - (ty < 6 ? 16 : 24)) * BM + wc * 32 + 4 * fq; const float lo = ty < 6 ? 0.0f : 1.0f;
#pragma unroll
            for (int ai = 0; ai < 2; ++ai)
#pragma unroll
                for (int m = 0; m < 4; ++m) { const int row = row0 + ai * HALF + m * 16; const float sr = sx[row] * -1.4426950408889634f; unsigned char* rowp = dst + (size_t)row * 2048 + col0;
#pragma unroll
                    for (int bj = 0; bj < 2; ++bj)
#pragma unroll
                        for (int n = 0; n < 2; ++n) { const f32x4 v = deq4(acc[ai][bj][m][n], cs[bj][n] * sr); unsigned w = 0u;
#pragma unroll
                            for (int j = 0; j < 4; ++j) { const float s = __builtin_amdgcn_rcpf(1.0f + __builtin_amdgcn_exp2f(v[j]));
                                w |= (unsigned)fmaxf(s * 255.0f + 0.5f, lo) << (8 * j); }
                            *(unsigned*)(rowp + bj * HALF + n * 16) = w; } }
        } else if (ty < 2) {
            bf16_t* dst = ty == 0 ? qa : ka; const float sc = ty == 0 ? qsa : 1.0f;
            const int i0 = 16 * wc + 4 * fq;
#pragma unroll
            for (int ai = 0; ai < 2; ++ai)
#pragma unroll
                for (int m = 0; m < 4; ++m) { const int row = row0 + ai * HALF + m * 16; const float sr = sx[row] * sc;
                    const f32x4 c = *(const f32x4*)(cosA + (size_t)row * 64 + i0), s = *(const f32x4*)(sinA + (size_t)row * 64 + i0);
#pragma unroll
                    for (int bj = 0; bj < 2; ++bj) { const int head = 2 * (u.pn & 3) + bj; const f32x4 t1 = deq4(acc[ai][bj][m][0], cs[bj][0] * sr), t2 = deq4(acc[ai][bj][m][1], cs[bj][1] * sr);
                        const f32x4 o1 = t1 * c - t2 * s, o2 = t1 * s + t2 * c;
                        bf16_t* p = dst + (size_t)row * 1024 + head * 128 + i0;
                        u32x2 w1, w2; w1.x = cvt_pk_bf16(o1[0], o1[1]); w1.y = cvt_pk_bf16(o1[2], o1[3]); w2.x = cvt_pk_bf16(o2[0], o2[1]); w2.y = cvt_pk_bf16(o2[2], o2[3]);
                        *(u32x2*)p = w1; *(u32x2*)(p + 64) = w2;
                    } }
        } else {
            bf16_t* dst = ty == 2 ? qd : kd; const float sc = ty == 2 ? qsb : 1.0f;
            const int comp = wc >> 1, i0 = 16 * (wc & 1) + 4 * fq;
#pragma unroll
            for (int ai = 0; ai < 2; ++ai)
#pragma unroll
                for (int m = 0; m < 4; ++m) { const int row = row0 + ai * HALF + m * 16; const float sr = sx[row] * sc;
                    const f32x4 c = *(const f32x4*)(cosB + (size_t)row * 32 + i0), s = *(const f32x4*)(sinB + (size_t)row * 32 + i0);
#pragma unroll
                    for (int bj = 0; bj < 2; ++bj) { const int head = 2 * (u.pn & 3) + bj; const f32x4 t1 = deq4(acc[ai][bj][m][0], cs[bj][0] * sr), t2 = deq4(acc[ai][bj][m][1], cs[bj][1] * sr);
                        const f32x4 o1 = t1 * c - t2 * s, o2 = t1 * s + t2 * c;
                        bf16_t* p = dst + (size_t)row * 1024 + head * 128 + comp * 64 + i0;
                        u32x2 w1, w2; w1.x = cvt_pk_bf16(o1[0], o1[1]); w1.y = cvt_pk_bf16(o1[2], o1[3]); w2.x = cvt_pk_bf16(o2[0], o2[1]); w2.y = cvt_pk_bf16(o2[2], o2[3]);
                        *(u32x2*)p = w1; *(u32x2*)(p + 32) = w2;
                    } }
        }
    }
};
template <class Epi, class Sched, bool ALIGN_EPI = false, bool SP2 = false, bool MID = false, bool I8 = false>
__device__ __forceinline__ void gemm_phase(PG8_LAS unsigned char* lds, const Gemm g, const Sched& S, const Epi& E, int wave) {
    int tid_ = lane_id(); asm volatile("" : "+v"(tid_)); tid_ += 64 * wave;
    const int tid = tid_, wid = __builtin_amdgcn_readfirstlane(tid >> 6), lane = tid & 63, wr = wid >> 2, wc = wid & 3, fr = lane & 15, fq = lane >> 4;
    const int K = g.K, nt = K / BK;
    unsigned voffA[2], voffB[2];
#pragma unroll
    for (int i = 0; i < 2; ++i) { int R, C; stage_rc(tid * 16 + i * 8192, R, C); const int Rb = Epi::PERM ? ((R & ~31) + perm32(R & 31)) : R;
        voffA[i] = (unsigned)(R * K + C) * 2u; voffB[i] = (unsigned)(Rb * K + C) * 2u; }
    const size_t kstep = (size_t)(BK * 2);
    const size_t hstep = (size_t)HALF * K * 2;
    const size_t tstep = 2 * hstep;
    const unsigned ldsw = (unsigned)wid * 1024u;
    const int aoff = lds_byte(wr * 64 + fr, fq * 8), boff = lds_byte(wc * 32 + fr, fq * 8);
#define PG8_SA(b, h) (((b) * 2 + (h)) * HTB)
#define PG8_SB(b, h) ((4 + (b) * 2 + (h)) * HTB)
#define PG8_STAGE(bufoff, gbase, voff) do { _Pragma("unroll") for (int _i = 0; _i < 2; ++_i) \
        __builtin_amdgcn_global_load_lds((const unsigned*)((const char*)(gbase) + (voff)[_i]), (PG8_LAS unsigned*)(lds + (bufoff) + ldsw + _i * 8192), 16, 0, 0); } while (0)
#define PG8_LDA(dst, b, h) do { _Pragma("unroll") for (int m = 0; m < 4; ++m) _Pragma("unroll") for (int k = 0; k < 2; ++k) dst[m][k] = *(const PG8_LAS bf16x8*)(lds + PG8_SA(b, h) + aoff + m * 2048 + k * 1024); } while (0)
#define PG8_LDB(dst, b, h) do { _Pragma("unroll") for (int n = 0; n < 2; ++n) _Pragma("unroll") for (int k = 0; k < 2; ++k) dst[n][k] = *(const PG8_LAS bf16x8*)(lds + PG8_SB(b, h) + boff + n * 2048 + k * 1024); } while (0)
#define PG8_MMA(ai, bj, At, Bt) do { __builtin_amdgcn_s_setprio(1); _Pragma("unroll") for (int m = 0; m < 4; ++m) _Pragma("unroll") for (int n = 0; n < 2; ++n) _Pragma("unroll") for (int k = 0; k < 2; ++k) \
        acc[ai][bj][m][n] = mma16<I8>(Bt[n][k], At[m][k], acc[ai][bj][m][n]); __builtin_amdgcn_s_setprio(0); } while (0)
#define PG8_WAIT_V(n) asm volatile("s_waitcnt vmcnt(" #n ")" ::: "memory")
#define PG8_WAIT_L(n) asm volatile("s_waitcnt lgkmcnt(" #n ")" ::: "memory")
#define PG8_BAR __builtin_amdgcn_s_barrier()
#define PG8_SCHED __builtin_amdgcn_sched_barrier(0)
    Unit cur, nxt; int ui = 0;
    if (!S.next(0, cur)) return;
    typedef typename AccSel<I8>::type acc_t;
    acc_t acc[2][2][4][2];
#pragma unroll
    for (int a = 0; a < 2; ++a)
#pragma unroll
        for (int b = 0; b < 2; ++b)
#pragma unroll
            for (int m = 0; m < 4; ++m)
#pragma unroll
                for (int n = 0; n < 2; ++n) acc[a][b][m][n] = (acc_t){0, 0, 0, 0};
    bf16x8 At[4][2], B0[2][2], B1[2][2];
    const char* cA = (const char*)g.A + (size_t)cur.pm * tstep; const char* cB = (const char*)g.Bt + (size_t)cur.pn * tstep;
    S.a_ready(cur);
    if constexpr (SP2) {
        PG8_STAGE(PG8_SB(0, 0), cB, voffB); PG8_STAGE(PG8_SB(0, 1), cB + hstep, voffB); PG8_STAGE(PG8_SA(0, 0), cA, voffA); PG8_STAGE(PG8_SA(0, 1), cA + hstep, voffA);
        if (wr == 1) PG8_BAR;
        PG8_WAIT_V(2); PG8_BAR;
        PG8_STAGE(PG8_SB(1, 0), cB + kstep, voffB); PG8_STAGE(PG8_SA(1, 0), cA + kstep, voffA); PG8_STAGE(PG8_SB(1, 1), cB + hstep + kstep, voffB);
        PG8_WAIT_V(6); PG8_BAR;
    } else {
        PG8_STAGE(PG8_SB(0, 0), cB, voffB); PG8_STAGE(PG8_SA(0, 0), cA, voffA); PG8_STAGE(PG8_SB(0, 1), cB + hstep, voffB); PG8_STAGE(PG8_SA(0, 1), cA + hstep, voffA);
        if (wr == 1) PG8_BAR;
        PG8_WAIT_V(4); PG8_BAR;
        PG8_STAGE(PG8_SB(1, 0), cB + kstep, voffB); PG8_STAGE(PG8_SA(1, 0), cA + kstep, voffA); PG8_STAGE(PG8_SB(1, 1), cB + hstep + kstep, voffB);
        PG8_WAIT_V(6); PG8_BAR;
    }
    for (;;) {
        const bool has_next = S.next(ui + 1, nxt);
        const char* nA = has_next ? (const char*)g.A + (size_t)nxt.pm * tstep : cA; const char* nB = has_next ? (const char*)g.Bt + (size_t)nxt.pn * tstep : cB;
        for (int t = 0; t < nt; t += 2) {
            if constexpr (MID) { if (t == nt / 2) E.mid(acc, cur, wr, wc, fr, fq); }
            const bool last = (t == nt - 2);
            const char* a1 = cA + (size_t)(t + 1) * kstep;
            const char* a2 = last ? nA : cA + (size_t)(t + 2) * kstep; const char* b2 = last ? nB : cB + (size_t)(t + 2) * kstep;
            const char* a3 = a2 + kstep; const char* b3 = b2 + kstep;
            if (last && has_next) S.a_ready(nxt);
            if constexpr (SP2) {
            PG8_LDB(B0, 0, 0); PG8_LDB(B1, 0, 1); PG8_SCHED; PG8_LDA(At, 0, 0); PG8_STAGE(PG8_SA(1, 1), a1 + hstep, voffA);
            PG8_WAIT_V(8); PG8_WAIT_L(0); PG8_BAR; PG8_MMA(0, 0, At, B0); PG8_MMA(0, 1, At, B1); PG8_BAR; PG8_SCHED;
            PG8_LDA(At, 0, 1); PG8_STAGE(PG8_SB(0, 0), b2, voffB); PG8_STAGE(PG8_SB(0, 1), b2 + hstep, voffB); PG8_STAGE(PG8_SA(0, 0), a2, voffA);
            PG8_WAIT_V(8); PG8_WAIT_L(0); PG8_BAR; PG8_MMA(1, 0, At, B0); PG8_MMA(1, 1, At, B1); PG8_BAR; PG8_SCHED;
            PG8_LDB(B0, 1, 0); PG8_LDB(B1, 1, 1); PG8_SCHED; PG8_LDA(At, 1, 0); PG8_STAGE(PG8_SA(0, 1), a2 + hstep, voffA);
            PG8_WAIT_V(8); PG8_WAIT_L(0); PG8_BAR; PG8_MMA(0, 0, At, B0); PG8_MMA(0, 1, At, B1); PG8_BAR; PG8_SCHED;
            PG8_LDA(At, 1, 1); PG8_STAGE(PG8_SB(1, 0), b3, voffB); PG8_STAGE(PG8_SB(1, 1), b3 + hstep, voffB); PG8_STAGE(PG8_SA(1, 0), a3, voffA);
            PG8_WAIT_V(8); PG8_WAIT_L(0); PG8_BAR; PG8_MMA(1, 0, At, B0); PG8_MMA(1, 1, At, B1); PG8_BAR; PG8_SCHED;
            } else {
            PG8_LDB(B0, 0, 0); PG8_SCHED; PG8_LDA(At, 0, 0); PG8_STAGE(PG8_SA(1, 1), a1 + hstep, voffA);
            PG8_WAIT_L(8); PG8_BAR; PG8_WAIT_L(0); PG8_MMA(0, 0, At, B0); PG8_BAR; PG8_SCHED;
            PG8_LDB(B1, 0, 1); PG8_STAGE(PG8_SB(0, 0), b2, voffB);
            PG8_BAR; PG8_WAIT_L(0); PG8_MMA(0, 1, At, B1); PG8_BAR;
            PG8_LDA(At, 0, 1); PG8_STAGE(PG8_SA(0, 0), a2, voffA);
            PG8_BAR; PG8_WAIT_L(0); PG8_MMA(1, 0, At, B0); PG8_BAR; PG8_SCHED;
            PG8_STAGE(PG8_SB(0, 1), b2 + hstep, voffB);
            PG8_WAIT_V(6); PG8_BAR; PG8_MMA(1, 1, At, B1); PG8_BAR;
            PG8_LDB(B0, 1, 0); PG8_SCHED; PG8_LDA(At, 1, 0); PG8_STAGE(PG8_SA(0, 1), a2 + hstep, voffA);
            PG8_WAIT_L(8); PG8_BAR; PG8_WAIT_L(0); PG8_MMA(0, 0, At, B0); PG8_BAR; PG8_SCHED;
            PG8_LDB(B1, 1, 1); PG8_STAGE(PG8_SB(1, 0), b3, voffB);
            PG8_BAR; PG8_WAIT_L(0); PG8_MMA(0, 1, At, B1); PG8_BAR;
            PG8_LDA(At, 1, 1); PG8_STAGE(PG8_SA(1, 0), a3, voffA);
            PG8_BAR; PG8_WAIT_L(0); PG8_MMA(1, 0, At, B0); PG8_BAR; PG8_SCHED;
            PG8_STAGE(PG8_SB(1, 1), b3 + hstep, voffB);
            PG8_WAIT_V(6); PG8_BAR; PG8_MMA(1, 1, At, B1); PG8_BAR;
            }
        }
        if constexpr (ALIGN_EPI) { if (wr == 0) PG8_BAR; }
        if constexpr (!Epi::AFTER_DRAIN) { E(acc, cur, wr, wc, fr, fq); S.done(cur); }
        if (!has_next) break;
#pragma unroll
        for (int a = 0; a < 2; ++a)
#pragma unroll
            for (int b = 0; b < 2; ++b)
#pragma unroll
                for (int m = 0; m < 4; ++m)
#pragma unroll
                    for (int n = 0; n < 2; ++n) acc[a][b][m][n] = (acc_t){0, 0, 0, 0};
        cur = nxt; cA = nA; cB = nB; ++ui;
        if constexpr (ALIGN_EPI) { if (wr == 1) PG8_BAR; }
    }
    PG8_WAIT_V(0);
    if constexpr (!ALIGN_EPI) { if (wr == 0) PG8_BAR; }
    PG8_BAR;
    if constexpr (Epi::AFTER_DRAIN) { E.fused(acc, cur, wr, wc, fr, fq, lds, wid, lane); S.done(cur); }
#undef PG8_SA
#undef PG8_SB
#undef PG8_STAGE
#undef PG8_LDA
#undef PG8_LDB
#undef PG8_MMA
#undef PG8_WAIT_V
#undef PG8_WAIT_L
#undef PG8_BAR
#undef PG8_SCHED
}
}
#define XB_TMO      128
#define XB_XCNT(j)  (256  + 64 * (j))
#define XB_XSUB(j)  (1280 + 64 * (j))
#define XB_XGEN(j)  (2304 + 64 * (j))
#define XB_TOP      3328
#define XB_TOPGEN   3392
#define XCD_BAR_WORDS 3456
#define XB_SPIN_CAP (1u << 18)

__device__ __forceinline__ unsigned xb_ld(unsigned* p)              { return __hip_atomic_load(p, __ATOMIC_RELAXED, __HIP_MEMORY_SCOPE_AGENT); }
__device__ __forceinline__ unsigned xb_add(unsigned* p, unsigned v) { return __hip_atomic_fetch_add(p, v, __ATOMIC_RELAXED, __HIP_MEMORY_SCOPE_AGENT); }
__device__ __forceinline__ unsigned xb_xcc_id() { return (unsigned)__builtin_amdgcn_s_getreg((3 << 11) | 20) & 0xFu; }
#define XB_SPIN(cond, bar) do { unsigned _sp = 0; while (cond) { __builtin_amdgcn_s_sleep(1); \
    if ((++_sp & 255u) == 0u) { if (xb_ld(&(bar)[XB_TMO])) break; if (_sp > XB_SPIN_CAP) { atomicAdd(&(bar)[XB_TMO], 1u); break; } } } } while (0)

struct XcdBarrier {
    unsigned* bar; unsigned x; unsigned wv;
    volatile LAS unsigned* st;
};

__device__ __forceinline__ XcdBarrier xcd_barrier_post(unsigned* bar, volatile LAS unsigned* st, unsigned wave) {
    XcdBarrier b; b.bar = bar; b.x = xb_xcc_id(); b.st = st; b.wv = wave;
    if (threadIdx.x == 0) (void)xb_add(&bar[XB_XCNT(b.x)], 1u);
    return b;
}
__device__ __forceinline__ void xcd_barrier_complete(unsigned* bar, unsigned x, unsigned& nloc, unsigned& nx) {
    const unsigned G = gridDim.x * gridDim.y * gridDim.z;
    unsigned sum, cnt, mine, sp = 0u;
    for (;;) {
        sum = 0u; cnt = 0u; mine = 0u;
#pragma unroll 1
        for (unsigned j = 0; j < 16; ++j) { const unsigned c = xb_ld(&bar[XB_XCNT(j)]); sum += c; cnt += (c > 0u) ? 1u : 0u; mine = (j == x) ? c : mine; }
        if (sum == G) break;
        __builtin_amdgcn_s_sleep(1);
        if ((++sp & 255u) == 0u) { if (xb_ld(&bar[XB_TMO])) break; if (sp > XB_SPIN_CAP) { atomicAdd(&bar[XB_TMO], 1u); break; } }
    }
    nloc = mine > 0u ? mine : 1u; nx = cnt > 0u ? cnt : 1u;
}

__device__ __forceinline__ void xcd_barrier(const XcdBarrier& b) {
    asm volatile("s_waitcnt vmcnt(0)" ::: "memory");
    __syncthreads();
    if (b.wv == 0u && lane_id() == 0) {
        unsigned* bar = b.bar;
        __builtin_amdgcn_s_waitcnt(0);
        unsigned nloc = b.st[0], nx = b.st[1];
        if (nloc == 0u) { xcd_barrier_complete(bar, b.x, nloc, nx); b.st[0] = nloc; b.st[1] = nx; }
        const unsigned old = xb_add(&bar[XB_XSUB(b.x)], 1u);
        const unsigned gen = old / nloc;
        if (old + 1u == (gen + 1u) * nloc) {
            __builtin_amdgcn_fence(__ATOMIC_RELEASE, "agent");
            asm volatile("s_waitcnt vmcnt(0)" ::: "memory");
            const unsigned og = xb_add(&bar[XB_TOP], 1u);
            const unsigned tg = og / nx;
            if (og + 1u == (tg + 1u) * nx) xb_add(&bar[XB_TOPGEN], 1u);
            else XB_SPIN(xb_ld(&bar[XB_TOPGEN]) == tg, bar);
            __builtin_amdgcn_fence(__ATOMIC_ACQUIRE, "agent");
            xb_add(&bar[XB_XGEN(b.x)], 1u);
            asm volatile("s_waitcnt vmcnt(0)" ::: "memory");
        } else {
            XB_SPIN(xb_ld(&bar[XB_XGEN(b.x)]) == gen, bar);
            __builtin_amdgcn_fence(__ATOMIC_ACQUIRE, "agent");
            asm volatile("s_waitcnt vmcnt(0)" ::: "memory");
        }
    }
    __syncthreads();
}


struct Frame {
    LAS unsigned char* lds;
    volatile LAS unsigned* MISC;
    gu32* ctl;
    int tid, lane, wave;
    int vcu, G;
    unsigned char* ws;
};

__device__ __forceinline__ int inproj_row(int n) {
    const int seg = n >> 10, r = n & 1023;
    if (seg >= 6) return (seg < 8 ? 4096 : 6144) + (n - (seg < 8 ? 6144 : 8192));
    if (seg == 2) return 8192 + r;
    if (seg == 5) return 8192 + 1024 + r;
    const int head = r >> 7, d = r & 127;
    if (seg < 2) return seg * 1024 + head * 128 + 32 * ((d >> 4) & 3) + 16 * (d >> 6) + (d & 15);
    return (seg - 1) * 1024 + head * 128 + 32 * (2 * (d >> 6) + ((d >> 4) & 1)) + 16 * ((d >> 5) & 1) + (d & 15);
}
template <bool MAP>
__device__ __forceinline__ void p0_transpose_item(const float* W, int K, int N, bf16* WT, LAS float* scr, int item, int lane, int ldk = 0, int koff = 0) {
    if (ldk == 0) ldk = K;
    const int nblk = N / 32, kb = item / nblk, nb = item % nblk, k0 = 64 * kb, n0 = 32 * nb;
#pragma unroll 8
    for (int i = 0; i < 32; ++i) { const int kk = 2 * i + (lane >> 5); scr[kk * 33 + (lane & 31)] = W[(size_t)(k0 + kk) * N + n0 + (lane & 31)]; }
    LDS_WAIT(); asm volatile("" ::: "memory");
    const int c = lane & 7;
#pragma unroll
    for (int j = 0; j < 4; ++j) { const int n = (lane >> 3) + 8 * j; const LAS float* s = scr + (8 * c) * 33 + n;
        v4u o; o.x = pk2(s[0 * 33], s[1 * 33]); o.y = pk2(s[2 * 33], s[3 * 33]); o.z = pk2(s[4 * 33], s[5 * 33]); o.w = pk2(s[6 * 33], s[7 * 33]);
        const int dr = MAP ? inproj_row(n0 + n) : (n0 + n);
        *(GAS v4u*)(WT + (size_t)dr * ldk + koff + k0 + 8 * c) = o; }
    LDS_WAIT(); asm volatile("" ::: "memory");
}
__device__ __forceinline__ void p0_convert(const float* src, bf16* dst, size_t n8, size_t gtid, size_t gthreads) {
    for (size_t i = gtid; i < n8; i += gthreads) {
        const f32x4 a = *(const GAS f32x4*)(src + i * 8), b = *(const GAS f32x4*)(src + i * 8 + 4);
        v4u o; o.x = pk2(a[0], a[1]); o.y = pk2(a[2], a[3]); o.z = pk2(b[0], b[1]); o.w = pk2(b[2], b[3]);
        *(GAS v4u*)(dst + i * 8) = o;
    }
}

__device__ __forceinline__ void p0_table_row(const float* src, unsigned char* dst, float* scale_out, int lane) {
    f32x4 v[8]; float am = 0.f;
#pragma unroll
    for (int q = 0; q < 8; ++q) { v[q] = *(const GAS f32x4*)(src + 32 * lane + 4 * q);
        am = fmaxf(am, fmaxf(fmaxf(fabsf(v[q][0]), fabsf(v[q][1])), fmaxf(fabsf(v[q][2]), fabsf(v[q][3])))); }
#pragma unroll
    for (int o = 1; o < 64; o <<= 1) am = fmaxf(am, __shfl_xor(am, o));
    const float sc = am > 0.f ? 6.0f / am : 1.0f;
    v4u o;
#pragma unroll
    for (int wq = 0; wq < 4; ++wq) { unsigned w = 0u;
        w = __builtin_amdgcn_cvt_scalef32_pk_fp4_f32(w, v[2 * wq][0] * sc, v[2 * wq][1] * sc, 1.0f, 0);
        w = __builtin_amdgcn_cvt_scalef32_pk_fp4_f32(w, v[2 * wq][2] * sc, v[2 * wq][3] * sc, 1.0f, 1);
        w = __builtin_amdgcn_cvt_scalef32_pk_fp4_f32(w, v[2 * wq + 1][0] * sc, v[2 * wq + 1][1] * sc, 1.0f, 2);
        w = __builtin_amdgcn_cvt_scalef32_pk_fp4_f32(w, v[2 * wq + 1][2] * sc, v[2 * wq + 1][3] * sc, 1.0f, 3);
        o[wq] = w; }
    *(GAS v4u*)(dst + 16 * lane) = o;
    if (lane == 0) *scale_out = am > 0.f ? am / 6.0f : 1.0f;
}

__device__ __forceinline__ unsigned q8pack(float a, float b, float c, float d, float s) {
    const int ia = (int)__builtin_rintf(a * s), ib = (int)__builtin_rintf(b * s), ic = (int)__builtin_rintf(c * s), id = (int)__builtin_rintf(d * s);
    return ((unsigned)ia & 255u) | (((unsigned)ib & 255u) << 8) | (((unsigned)ic & 255u) << 16) | ((unsigned)id << 24);
}
__device__ __forceinline__ void p0_absmax_item(const float* W, int item, int lane, gu32* wmax) {
    const int kc = item / 40, nc = item % 40, n0 = 256 * nc + 4 * lane;
    const float* p = W + (size_t)(128 * kc) * 10240 + n0;
    f32x4 am = (f32x4){0.f, 0.f, 0.f, 0.f};
#pragma unroll 16
    for (int r = 0; r < 128; ++r) { const f32x4 v = *(const GAS f32x4*)(p + (size_t)r * 10240);
        am[0] = fmaxf(am[0], fabsf(v[0])); am[1] = fmaxf(am[1], fabsf(v[1])); am[2] = fmaxf(am[2], fabsf(v[2])); am[3] = fmaxf(am[3], fabsf(v[3])); }
#pragma unroll
    for (int j = 0; j < 4; ++j) (void)__hip_atomic_fetch_max(wmax + n0 + j, __builtin_bit_cast(unsigned, am[j]), RLX_AGENT);
}
__device__ __forceinline__ void p0_transpose_item_i8(const float* W, int K, int N, unsigned char* W8, LAS float* scr, int item, int lane, const gu32* wmax) {
    const int nblk = N / 32, kb = item / nblk, nb = item % nblk, k0 = 64 * kb, n0 = 32 * nb;
#pragma unroll 8
    for (int i = 0; i < 32; ++i) { const int kk = 2 * i + (lane >> 5); scr[kk * 33 + (lane & 31)] = W[(size_t)(k0 + kk) * N + n0 + (lane & 31)]; }
    LDS_WAIT(); asm volatile("" ::: "memory");
    const int c = lane & 7;
#pragma unroll
    for (int j = 0; j < 4; ++j) { const int n = (lane >> 3) + 8 * j; const LAS float* s = scr + (8 * c) * 33 + n;
        const float am = __builtin_bit_cast(float, wmax[n0 + n]); const float sc = am > 0.f ? 127.0f / am : 0.f;
        v2u o; o.x = q8pack(s[0 * 33], s[1 * 33], s[2 * 33], s[3 * 33], sc); o.y = q8pack(s[4 * 33], s[5 * 33], s[6 * 33], s[7 * 33], sc);
        *(GAS v2u*)(W8 + (size_t)inproj_row(n0 + n) * K + k0 + 8 * c) = o; }
    LDS_WAIT(); asm volatile("" ::: "memory");
}
__device__ __forceinline__ void p0_x_row(const float* src, bf16* dstb, unsigned char* dst8, float* sx, int lane) {
    f32x4 v[8]; float am = 0.f;
#pragma unroll
    for (int j = 0; j < 8; ++j) { v[j] = *(const GAS f32x4*)(src + 256 * j + 4 * lane);
        am = fmaxf(am, fmaxf(fmaxf(fabsf(v[j][0]), fabsf(v[j][1])), fmaxf(fabsf(v[j][2]), fabsf(v[j][3])))); }
#pragma unroll
    for (int o = 1; o < 64; o <<= 1) am = fmaxf(am, __shfl_xor(am, o));
    const float sc = am > 0.f ? 127.0f / am : 0.f;
#pragma unroll
    for (int j = 0; j < 8; ++j) { *(GAS v2u*)(dstb + 256 * j + 4 * lane) = (v2u){pk2(v[j][0], v[j][1]), pk2(v[j][2], v[j][3])};
        *(GAS unsigned*)(dst8 + 256 * j + 4 * lane) = q8pack(v[j][0], v[j][1], v[j][2], v[j][3], sc); }
    if (lane == 0) *sx = am * (1.0f / 127.0f);
}

namespace att {
constexpr int KB0 = 0, VB0 = 32768, KMT = 65536, QFR = 65536;
__device__ __forceinline__ int crow(int r, int hi) { return (r & 3) + 8 * (r >> 2) + 4 * hi; }
__device__ __forceinline__ unsigned cvtpk(float lo, float hi) { return pg8::cvt_pk_bf16(lo, hi); }

template <int DQK, bool MOBA>
__device__ __forceinline__ void attn_pass(LAS unsigned char* lds, const bf16* Qg, const bf16* Kg, const bf16* Vtg, int q0, unsigned sel, f32x16 (&o)[4], int tid, int wid, int lane) {
    constexpr int NS = DQK / 16, RB = DQK * 2, KCH = DQK / 8;
    constexpr float THR = 8.0f;
    const int r32 = lane & 31, hi = lane >> 5;
    const int qpos = q0 + 32 * wid + r32;
    const int own = q0 >> 8;
    const LAS unsigned char* qlds = lds + QFR + wid * 8192 + lane * 16;
    { const bf16* qp = Qg + (size_t)(32 * wid + r32) * 1024 + 8 * hi;
#pragma unroll
      for (int s = 0; s < NS; ++s) *(LAS bf16x8*)(lds + QFR + wid * 8192 + lane * 16 + s * 1024) = *(const GAS bf16x8*)(qp + 16 * s); }
#pragma unroll
    for (int d = 0; d < 4; ++d) o[d] = (f32x16){0.f,0.f,0.f,0.f,0.f,0.f,0.f,0.f,0.f,0.f,0.f,0.f,0.f,0.f,0.f,0.f};
    f32x16 negm = (f32x16){0.f,0.f,0.f,0.f,0.f,0.f,0.f,0.f,0.f,0.f,0.f,0.f,0.f,0.f,0.f,0.f};
    float l_run = 0.f;
    const int nt = MOBA ? 4 + 4 * own : (q0 + 256) / 64;
    constexpr int NKC = (64 * KCH) / 512;
    v4u kreg[NKC], vreg[2];
    unsigned kgo[NKC], vgo[2]; int klds[NKC], vl0[2], vl1[2];
#pragma unroll
    for (int i = 0; i < NKC; ++i) { const int cid = tid + 512 * i, key = cid / KCH, ch = cid % KCH;
        const int swz = (DQK == 128) ? (key & 15) : ((key >> 1) & 7);
        kgo[i] = (unsigned)(key * 1024 + ch * 8) * 2u; klds[i] = key * RB + ((ch ^ swz) << 4); }
#pragma unroll
    for (int i = 0; i < 2; ++i) { const int cid = tid + 512 * i, d = cid >> 3, g = cid & 7;
        const int c = (g >> 2) * 4 + ((g >> 1) & 1) * 2, sw = (d >> 1) & 7, e = g & 1;
        vgo[i] = (unsigned)(d * T + g * 8) * 2u; vl0[i] = d * 128 + ((c ^ sw) << 4) + 8 * e; vl1[i] = d * 128 + (((c + 1) ^ sw) << 4) + 8 * e; }
#define KTILE(i) (MOBA ? ((i) < 4 ? own * 4 + (i) : (i) - 4) : (i))
#define ATT_LOAD(kt) do { const GAS unsigned char* kb_ = (const GAS unsigned char*)Kg + (size_t)(kt) * 131072; const GAS unsigned char* vb_ = (const GAS unsigned char*)Vtg + (size_t)(kt) * 128; \
                          _Pragma("unroll") for (int i_ = 0; i_ < NKC; ++i_) kreg[i_] = *(const GAS v4u*)(kb_ + kgo[i_]); \
                          _Pragma("unroll") for (int i_ = 0; i_ < 2; ++i_) vreg[i_] = *(const GAS v4u*)(vb_ + vgo[i_]); } while (0)
#define ATT_STORE(buf) do { _Pragma("unroll") for (int i_ = 0; i_ < NKC; ++i_) *(LAS v4u*)(lds + KB0 + (buf) * 16384 + klds[i_]) = kreg[i_]; \
                            _Pragma("unroll") for (int i_ = 0; i_ < 2; ++i_) { *(LAS v2u*)(lds + VB0 + (buf) * 16384 + vl0[i_]) = (v2u){vreg[i_].x, vreg[i_].y}; \
                                                                              *(LAS v2u*)(lds + VB0 + (buf) * 16384 + vl1[i_]) = (v2u){vreg[i_].z, vreg[i_].w}; } } while (0)
    ATT_LOAD(KTILE(0)); ATT_STORE(0);
    __syncthreads();
    const int kswz = (DQK == 128) ? (r32 & 15) : ((r32 >> 1) & 7);
    const int vsw = (r32 >> 1) & 7;
    const int kfo = r32 * RB, vfo = r32 * 128;
#define ATT_STEP(BUF) do { \
        const int kt = KTILE(it); const bool more = it + 1 < nt; \
        if (more) ATT_LOAD(KTILE(it + 1)); \
        const int blk = kt >> 2; bool need; \
        if (!MOBA || it < 4) need = (kt * 64 <= q0 + 32 * wid + 31); else need = __any((sel >> blk) & 1u); \
        if (need) { \
            f32x16 p0, p1; \
            const LAS unsigned char* kb = lds + KB0 + (BUF) * 16384 + kfo; \
              \
            bf16x8 fk0[2], fk1[2], fqv[2]; \
            { const int ch = ((0 + hi) ^ kswz) << 4; fk0[0] = *(const LAS bf16x8*)(kb + ch); fk1[0] = *(const LAS bf16x8*)(kb + 32 * RB + ch); fqv[0] = *(const LAS bf16x8*)(qlds); } \
            _Pragma("unroll") for (int s = 0; s < NS; ++s) { \
                if (s + 1 < NS) { const int ch = ((2 * (s + 1) + hi) ^ kswz) << 4; \
                    fk0[(s + 1) & 1] = *(const LAS bf16x8*)(kb + ch); fk1[(s + 1) & 1] = *(const LAS bf16x8*)(kb + 32 * RB + ch); fqv[(s + 1) & 1] = *(const LAS bf16x8*)(qlds + (s + 1) * 1024); } \
                __builtin_amdgcn_sched_barrier(0); \
                if (s == 0) {   \
                    asm volatile("v_mfma_f32_32x32x16_bf16 %0, %1, %2, %3" : "=&v"(p0) : "v"(fk0[0]), "v"(fqv[0]), "v"(negm)); \
                    asm volatile("v_mfma_f32_32x32x16_bf16 %0, %1, %2, %3" : "=&v"(p1) : "v"(fk1[0]), "v"(fqv[0]), "v"(negm)); } \
                else { p0 = __builtin_amdgcn_mfma_f32_32x32x16_bf16(fk0[s & 1], fqv[s & 1], p0, 0, 0, 0); p1 = __builtin_amdgcn_mfma_f32_32x32x16_bf16(fk1[s & 1], fqv[s & 1], p1, 0, 0, 0); } \
                __builtin_amdgcn_sched_barrier(0); } \
            if (!MOBA || it < 4) { \
                if (kt * 64 + 63 > q0 + 32 * wid) { const int kbase = kt * 64 + 4 * hi; \
                    _Pragma("unroll") for (int r = 0; r < 16; ++r) { const int kv = kbase + (r & 3) + 8 * (r >> 2); if (kv > qpos) p0[r] = -INFINITY; if (kv + 32 > qpos) p1[r] = -INFINITY; } } \
            } else { if (!((sel >> blk) & 1u)) { _Pragma("unroll") for (int r = 0; r < 16; ++r) { p0[r] = -INFINITY; p1[r] = -INFINITY; } } } \
            float rm = fmaxf(fmaxf(p0[0], p0[1]), p1[0]); \
            _Pragma("unroll") for (int r = 1; r < 16; ++r) rm = fmaxf(fmaxf(rm, p0[r]), p1[r]); \
            { const unsigned rb = __builtin_bit_cast(unsigned, rm); auto rr = __builtin_amdgcn_permlane32_swap(rb, rb, false, false); rm = fmaxf(__builtin_bit_cast(float, (unsigned)rr[0]), __builtin_bit_cast(float, (unsigned)rr[1])); } \
            if (it == 0 || __any(rm > THR)) { \
                const float dl = (it == 0) ? rm : fmaxf(rm, 0.f); const float alpha = fexp2(-dl); \
                _Pragma("unroll") for (int r = 0; r < 16; ++r) { p0[r] -= dl; p1[r] -= dl; negm[r] -= dl; } \
                l_run *= alpha; \
                _Pragma("unroll") for (int d = 0; d < 4; ++d) _Pragma("unroll") for (int r = 0; r < 16; ++r) o[d][r] *= alpha; } \
            float ls = 0.f; \
            _Pragma("unroll") for (int r = 0; r < 16; ++r) { p0[r] = fexp2(p0[r]); p1[r] = fexp2(p1[r]); ls += p0[r] + p1[r]; } \
            l_run += ls; \
            bf16x8 pa[4]; \
            { v4u w; \
              w.x = cvtpk(p0[0], p0[1]); w.y = cvtpk(p0[2], p0[3]); w.z = cvtpk(p0[4], p0[5]); w.w = cvtpk(p0[6], p0[7]); pa[0] = __builtin_bit_cast(bf16x8, w); \
              w.x = cvtpk(p0[8], p0[9]); w.y = cvtpk(p0[10], p0[11]); w.z = cvtpk(p0[12], p0[13]); w.w = cvtpk(p0[14], p0[15]); pa[1] = __builtin_bit_cast(bf16x8, w); \
              w.x = cvtpk(p1[0], p1[1]); w.y = cvtpk(p1[2], p1[3]); w.z = cvtpk(p1[4], p1[5]); w.w = cvtpk(p1[6], p1[7]); pa[2] = __builtin_bit_cast(bf16x8, w); \
              w.x = cvtpk(p1[8], p1[9]); w.y = cvtpk(p1[10], p1[11]); w.z = cvtpk(p1[12], p1[13]); w.w = cvtpk(p1[14], p1[15]); pa[3] = __builtin_bit_cast(bf16x8, w); } \
            const LAS unsigned char* vb = lds + VB0 + (BUF) * 16384 + vfo; \
            bf16x8 vfr[2][4]; \
            _Pragma("unroll") for (int d = 0; d < 4; ++d) vfr[0][d] = *(const LAS bf16x8*)(vb + d * 4096 + (((0 + hi) ^ vsw) << 4)); \
            _Pragma("unroll") for (int ks = 0; ks < 4; ++ks) { \
                if (ks + 1 < 4) { const int c = ((ks + 1) >> 1) * 4 + ((ks + 1) & 1) * 2 + hi; \
                    _Pragma("unroll") for (int d = 0; d < 4; ++d) vfr[(ks + 1) & 1][d] = *(const LAS bf16x8*)(vb + d * 4096 + ((c ^ vsw) << 4)); } \
                __builtin_amdgcn_sched_barrier(0); \
                _Pragma("unroll") for (int d = 0; d < 4; ++d) o[d] = __builtin_amdgcn_mfma_f32_32x32x16_bf16(vfr[ks & 1][d], pa[ks], o[d], 0, 0, 0); \
                __builtin_amdgcn_sched_barrier(0); } \
        } \
        if (more) ATT_STORE((BUF) ^ 1); \
        __syncthreads(); \
    } while (0)
    int it = 0;
#pragma unroll 1
    for (; it + 1 < nt; it += 2) { ATT_STEP(0); ++it; ATT_STEP(1); --it; }
    if (it < nt) ATT_STEP(0);
#undef ATT_STEP
#undef ATT_LOAD
#undef KTILE
#undef ATT_STORE
    const float lt = l_run + __shfl_xor(l_run, 32);
    const float inv = 1.0f / lt;
#pragma unroll
    for (int d = 0; d < 4; ++d)
#pragma unroll
        for (int r = 0; r < 16; ++r) o[d][r] *= inv;
}

__device__ __forceinline__ void attn_pass_diff2(LAS unsigned char* lds, const bf16* Qg, const bf16* Kg, const bf16* Vtg, int q0, f32x16 (&o1)[4], f32x16 (&o2)[4], int tid, int wid, int lane) {
    constexpr int RB = 256, KCH = 16; constexpr float THR = 8.0f;
    { const int r32 = lane & 31, hi = lane >> 5;
      const bf16* qp = Qg + (size_t)(32 * wid + r32) * 1024 + 8 * hi;
#pragma unroll
      for (int s = 0; s < 8; ++s) *(LAS bf16x8*)(lds + QFR + wid * 8192 + lane * 16 + s * 1024) = *(const GAS bf16x8*)(qp + 16 * s); }
#pragma unroll
    for (int d = 0; d < 4; ++d) { o1[d] = (f32x16){0.f,0.f,0.f,0.f,0.f,0.f,0.f,0.f,0.f,0.f,0.f,0.f,0.f,0.f,0.f,0.f}; o2[d] = o1[d]; }
    float m1 = 0.f, l1 = 0.f, m2 = 0.f, l2 = 0.f;
    const int nt = (q0 + 256) / 64;
    v4u sreg[2];
#define ATT_KGO(i) ((unsigned)((((tq_ + 512 * (i)) >> 4) * 1024 + ((tq_ + 512 * (i)) & 15) * 8) * 2))
#define ATT_KLDS(i) ((((tq_ + 512 * (i)) >> 4) * RB) + (((((tq_ + 512 * (i)) & 15)) ^ (((tq_ + 512 * (i)) >> 4) & 15)) << 4))
#define ATT_VGO(i) ((unsigned)((((tq_ + 512 * (i)) >> 3) * T + ((tq_ + 512 * (i)) & 7) * 8) * 2))
#define ATT_VC(i) (((((tq_ + 512 * (i)) & 7) >> 2) * 4) + (((((tq_ + 512 * (i)) & 7) >> 1) & 1) * 2))
#define ATT_VL0(i) ((((tq_ + 512 * (i)) >> 3) * 128) + ((ATT_VC(i) ^ ((((tq_ + 512 * (i)) >> 3) >> 1) & 7)) << 4) + 8 * ((tq_ + 512 * (i)) & 1))
#define ATT_VL1(i) ((((tq_ + 512 * (i)) >> 3) * 128) + (((ATT_VC(i) + 1) ^ ((((tq_ + 512 * (i)) >> 3) >> 1) & 7)) << 4) + 8 * ((tq_ + 512 * (i)) & 1))
#define ATT_TQ int tq_ = lane; asm volatile("" : "+v"(tq_)); tq_ += 64 * wid
#define ATT_LOADK(kt) do { ATT_TQ; const GAS unsigned char* kb_ = (const GAS unsigned char*)Kg + (size_t)(kt) * 131072; _Pragma("unroll") for (int i_ = 0; i_ < 2; ++i_) sreg[i_] = *(const GAS v4u*)(kb_ + ATT_KGO(i_)); } while (0)
#define ATT_LOADV(kt) do { ATT_TQ; const GAS unsigned char* vb_ = (const GAS unsigned char*)Vtg + (size_t)(kt) * 128; _Pragma("unroll") for (int i_ = 0; i_ < 2; ++i_) sreg[i_] = *(const GAS v4u*)(vb_ + ATT_VGO(i_)); } while (0)
#define ATT_STOREK(buf) do { ATT_TQ; _Pragma("unroll") for (int i_ = 0; i_ < 2; ++i_) *(LAS v4u*)(lds + KB0 + (buf) * 16384 + ATT_KLDS(i_)) = sreg[i_]; } while (0)
#define ATT_STOREV(buf) do { ATT_TQ; _Pragma("unroll") for (int i_ = 0; i_ < 2; ++i_) { *(LAS v2u*)(lds + VB0 + (buf) * 16384 + ATT_VL0(i_)) = (v2u){sreg[i_].x, sreg[i_].y}; \
                                                                               *(LAS v2u*)(lds + VB0 + (buf) * 16384 + ATT_VL1(i_)) = (v2u){sreg[i_].z, sreg[i_].w}; } } while (0)
    ATT_LOADK(0); ATT_STOREK(0); ATT_LOADV(0); ATT_STOREV(0);
    __syncthreads();
#define ATT_LN int ln_ = lane; asm volatile("" : "+v"(ln_)); const int r32 = ln_ & 31, hi = ln_ >> 5
#define ATT_QKS(BUF, S0, M, L, O) do { \
        ATT_LN; const int kswz = r32 & 15; const LAS unsigned char* qlds = lds + QFR + wid * 8192 + ln_ * 16; \
        const LAS unsigned char* kb = lds + KB0 + (BUF) * 16384 + r32 * RB; \
        _Pragma("unroll") for (int s = 0; s < 4; ++s) { const int ch = ((2 * ((S0) + s) + hi) ^ kswz) << 4; \
            const bf16x8 k0 = *(const LAS bf16x8*)(kb + ch), k1 = *(const LAS bf16x8*)(kb + 32 * RB + ch); \
            const bf16x8 qv = *(const LAS bf16x8*)(qlds + ((S0) + s) * 1024); \
            if (s == 0) { asm volatile("v_mfma_f32_32x32x16_bf16 %0, %1, %2, 0" : "=&v"(p0) : "v"(k0), "v"(qv)); \
                          asm volatile("v_mfma_f32_32x32x16_bf16 %0, %1, %2, 0" : "=&v"(p1) : "v"(k1), "v"(qv)); } \
            else { p0 = __builtin_amdgcn_mfma_f32_32x32x16_bf16(k0, qv, p0, 0, 0, 0); p1 = __builtin_amdgcn_mfma_f32_32x32x16_bf16(k1, qv, p1, 0, 0, 0); } } \
        if (diag) { const int kbase = kt * 64 + 4 * hi, qpos = q0 + 32 * wid + r32; \
            _Pragma("unroll") for (int r = 0; r < 16; ++r) { const int kv = kbase + (r & 3) + 8 * (r >> 2); if (kv > qpos) p0[r] = -INFINITY; if (kv + 32 > qpos) p1[r] = -INFINITY; } } \
        float rm = fmaxf(fmaxf(p0[0], p0[1]), p1[0]); \
        _Pragma("unroll") for (int r = 1; r < 16; ++r) rm = fmaxf(fmaxf(rm, p0[r]), p1[r]); \
        { const unsigned rb = __builtin_bit_cast(unsigned, rm); auto rr = __builtin_amdgcn_permlane32_swap(rb, rb, false, false); rm = fmaxf(__builtin_bit_cast(float, (unsigned)rr[0]), __builtin_bit_cast(float, (unsigned)rr[1])); } \
        if (it == 0 || __any(rm > M + THR)) { \
            const float mnew = (it == 0) ? rm : fmaxf(M, rm); const float alpha = fexp2(M - mnew); M = mnew; \
            L *= alpha; \
            _Pragma("unroll") for (int d = 0; d < 4; ++d) _Pragma("unroll") for (int r = 0; r < 16; ++r) O[d][r] *= alpha; } \
        float ls = 0.f; \
        { typedef float f32x2v __attribute__((ext_vector_type(2))); const f32x2v mm = (f32x2v){M, M};        \
          _Pragma("unroll") for (int r = 0; r < 16; r += 2) { const f32x2v a = (f32x2v){p0[r], p0[r + 1]} - mm, b = (f32x2v){p1[r], p1[r + 1]} - mm; \
              p0[r] = fexp2(a.x); p0[r + 1] = fexp2(a.y); p1[r] = fexp2(b.x); p1[r + 1] = fexp2(b.y); ls += (p0[r] + p0[r + 1]) + (p1[r] + p1[r + 1]); } } \
        L += ls; \
    } while (0)
#define ATT_PACK(dst_, ks) do { \
        if ((ks) == 0) { (dst_).x = cvtpk(p0[0], p0[1]); (dst_).y = cvtpk(p0[2], p0[3]); (dst_).z = cvtpk(p0[4], p0[5]); (dst_).w = cvtpk(p0[6], p0[7]); } \
        else if ((ks) == 1) { (dst_).x = cvtpk(p0[8], p0[9]); (dst_).y = cvtpk(p0[10], p0[11]); (dst_).z = cvtpk(p0[12], p0[13]); (dst_).w = cvtpk(p0[14], p0[15]); } \
        else if ((ks) == 2) { (dst_).x = cvtpk(p1[0], p1[1]); (dst_).y = cvtpk(p1[2], p1[3]); (dst_).z = cvtpk(p1[4], p1[5]); (dst_).w = cvtpk(p1[6], p1[7]); } \
        else { (dst_).x = cvtpk(p1[8], p1[9]); (dst_).y = cvtpk(p1[10], p1[11]); (dst_).z = cvtpk(p1[12], p1[13]); (dst_).w = cvtpk(p1[14], p1[15]); } } while (0)
#define ATT_STEP(BUF) do { \
        const int kt = it; const bool more = it + 1 < nt; \
        const bool need = kt * 64 <= q0 + 32 * wid + 31, diag = kt * 64 + 63 > q0 + 32 * wid; \
        if (more) ATT_LOADK(it + 1); \
        v4u pa1[4] = {(v4u){0u, 0u, 0u, 0u}, (v4u){0u, 0u, 0u, 0u}, (v4u){0u, 0u, 0u, 0u}, (v4u){0u, 0u, 0u, 0u}}; \
        if (need) { f32x16 p0, p1; ATT_QKS(BUF, 0, m1, l1, o1); \
              _Pragma("unroll") for (int ks = 0; ks < 4; ++ks) ATT_PACK(pa1[ks], ks); } \
        if (more) { ATT_STOREK((BUF) ^ 1); ATT_LOADV(it + 1); }        \
        if (need) { v4u pa2[4]; \
              { f32x16 p0, p1; ATT_QKS(BUF, 4, m2, l2, o2); \
                _Pragma("unroll") for (int ks = 0; ks < 4; ++ks) ATT_PACK(pa2[ks], ks); } \
              __builtin_amdgcn_sched_barrier(0); \
              ATT_LN; const int vsw = (r32 >> 1) & 7; \
              const LAS unsigned char* vb = lds + VB0 + (BUF) * 16384 + r32 * 128; \
              _Pragma("unroll") for (int ks = 0; ks < 4; ++ks) { \
                const bf16x8 pb1 = __builtin_bit_cast(bf16x8, pa1[ks]), pb2 = __builtin_bit_cast(bf16x8, pa2[ks]); \
                const int c = (ks >> 1) * 4 + (ks & 1) * 2 + hi; \
                _Pragma("unroll") for (int d = 0; d < 4; ++d) { const bf16x8 vf = *(const LAS bf16x8*)(vb + d * 4096 + ((c ^ vsw) << 4)); \
                    o1[d] = __builtin_amdgcn_mfma_f32_32x32x16_bf16(vf, pb1, o1[d], 0, 0, 0); \
                    o2[d] = __builtin_amdgcn_mfma_f32_32x32x16_bf16(vf, pb2, o2[d], 0, 0, 0); } \
                __builtin_amdgcn_sched_barrier(0); } } \
        if (more) ATT_STOREV((BUF) ^ 1); \
        __syncthreads(); \
    } while (0)
    int it = 0;
#pragma unroll 1
    for (; it + 1 < nt; it += 2) { ATT_STEP(0); ++it; ATT_STEP(1); --it; }
    if (it < nt) ATT_STEP(0);
#undef ATT_STEP
#undef ATT_QKS
#undef ATT_PACK
#undef ATT_LN
#undef ATT_LOADK
#undef ATT_LOADV
#undef ATT_STOREK
#undef ATT_STOREV
#undef ATT_TQ
#undef ATT_KGO
#undef ATT_KLDS
#undef ATT_VGO
#undef ATT_VC
#undef ATT_VL0
#undef ATT_VL1
    const float i1 = 1.0f / (l1 + __shfl_xor(l1, 32)), i2 = 1.0f / (l2 + __shfl_xor(l2, 32));
#pragma unroll
    for (int d = 0; d < 4; ++d)
#pragma unroll
        for (int r = 0; r < 16; ++r) { o1[d][r] *= i1; o2[d][r] *= i2; }
}

struct AttnArgs { const bf16 *qa, *ka, *qd, *kd, *vt; bf16* oab; const float* kmean; const float* gain; float lam, one_minus_li; };

__device__ __forceinline__ void moba_unit(LAS unsigned char* lds, const AttnArgs& A, int b, int h, int qb, int tid, int wid, int lane) {
    asm volatile("" : "+v"(tid), "+v"(lane));
    const int r32 = lane & 31, hi = lane >> 5, q0 = qb * 256;
    const bf16* Qg = A.qa + (size_t)(b * SEQ + q0) * 1024 + h * 128;
    unsigned sel = 0u;
    if (qb > 0) {
        { const int row = tid >> 4, ch = tid & 15, n = row & 15;
          const float* kp = A.kmean + ((size_t)(b * 8 + h) * 16 + n) * 128 + ch * 8;
          const f32x4 a = *(const GAS f32x4*)kp, c = *(const GAS f32x4*)(kp + 4);
          float v[8] = {a[0], a[1], a[2], a[3], c[0], c[1], c[2], c[3]}; unsigned w[8];
#pragma unroll
          for (int j = 0; j < 8; ++j) { const float x = v[j] * (1.0f / 256.0f); const unsigned hb = f2bf(x); const float xr = __builtin_bit_cast(float, hb << 16); w[j] = (row < 16) ? hb : f2bf(x - xr); }
          v4u o; o.x = w[0] | (w[1] << 16); o.y = w[2] | (w[3] << 16); o.z = w[4] | (w[5] << 16); o.w = w[6] | (w[7] << 16);
          *(LAS v4u*)(lds + KMT + row * 256 + ((ch ^ (row & 15)) << 4)) = o; }
        __syncthreads();
        f32x16 g = (f32x16){0.f,0.f,0.f,0.f,0.f,0.f,0.f,0.f,0.f,0.f,0.f,0.f,0.f,0.f,0.f,0.f};
        { const bf16* qp = Qg + (size_t)(32 * wid + r32) * 1024 + 8 * hi;
          const LAS unsigned char* kb = lds + KMT + r32 * 256;
#pragma unroll
          for (int s = 0; s < 8; ++s) { const bf16x8 qv = *(const GAS bf16x8*)(qp + 16 * s);
              const bf16x8 kf = *(const LAS bf16x8*)(kb + (((2 * s + hi) ^ (r32 & 15)) << 4));
              g = __builtin_amdgcn_mfma_f32_32x32x16_bf16(kf, qv, g, 0, 0, 0); } }
        float G[16];
#pragma unroll
        for (int r = 0; r < 8; ++r) { const float mine = g[r] + g[r + 8]; const float oth = __shfl_xor(mine, 32);
            const int nlo = (r & 3) + 8 * (r >> 2); G[nlo] = hi ? oth : mine; G[nlo + 4] = hi ? mine : oth; }
#pragma unroll
        for (int round = 0; round < 3; ++round) { float best = -INFINITY; int bi = -1;
#pragma unroll
            for (int n = 0; n < 16; ++n) { const bool ok = (n < qb) && !((sel >> n) & 1u) && (G[n] > best); best = ok ? G[n] : best; bi = ok ? n : bi; }
            if (bi >= 0) sel |= 1u << bi; }
        __syncthreads();
    }
    f32x16 o[4];
    attn_pass<128, true>(lds, Qg, A.ka + (size_t)(b * SEQ) * 1024 + h * 128, A.vt + (size_t)(h * 128) * T + b * SEQ, q0, sel, o, tid, wid, lane);
    bf16* op = A.oab + (size_t)(b * SEQ + q0 + 32 * wid + r32) * 2048 + h * 128 + 4 * hi;
#pragma unroll
    for (int d = 0; d < 4; ++d)
#pragma unroll
        for (int gq = 0; gq < 4; ++gq) { v2u w; w.x = cvtpk(o[d][4 * gq], o[d][4 * gq + 1]); w.y = cvtpk(o[d][4 * gq + 2], o[d][4 * gq + 3]); *(GAS v2u*)(op + 32 * d + 8 * gq) = w; }
}

__device__ __forceinline__ void diff_unit(LAS unsigned char* lds, const AttnArgs& A, int b, int h, int qb, int tid, int wid, int lane) {
    asm volatile("" : "+v"(tid), "+v"(lane));
    const int r32 = lane & 31, hi = lane >> 5, q0 = qb * 256;
    const size_t qrow = (size_t)(b * SEQ + q0);
    const bf16* Vtg = A.vt + (size_t)(1024 + h * 128) * T + b * SEQ;
    f32x16 o[4], o2[4];
    attn_pass_diff2(lds, A.qd + qrow * 1024 + h * 128, A.kd + (size_t)(b * SEQ) * 1024 + h * 128, Vtg, q0, o, o2, tid, wid, lane);
    float ss = 0.f;
#pragma unroll
    for (int d = 0; d < 4; ++d)
#pragma unroll
        for (int r = 0; r < 16; ++r) { const float v = o[d][r] - A.lam * o2[d][r]; o[d][r] = v; ss += v * v; }
    ss += __shfl_xor(ss, 32);
    const float rn = 1.0f / sqrtf(ss * (1.0f / 128.0f) + RMS_EPS) * A.one_minus_li;
    bf16* op = A.oab + (qrow + 32 * wid + r32) * 2048 + 1024 + h * 128 + 4 * hi;
    const float* gp = A.gain + h * 128 + 4 * hi;
#pragma unroll
    for (int d = 0; d < 4; ++d)
#pragma unroll
        for (int gq = 0; gq < 4; ++gq) { const f32x4 gn = *(const GAS f32x4*)(gp + 32 * d + 8 * gq);
            v2u w; w.x = cvtpk(o[d][4 * gq] * rn * gn[0], o[d][4 * gq + 1] * rn * gn[1]); w.y = cvtpk(o[d][4 * gq + 2] * rn * gn[2], o[d][4 * gq + 3] * rn * gn[3]);
            *(GAS v2u*)(op + 32 * d + 8 * gq) = w; }
}

__device__ __forceinline__ void attn_phase(LAS unsigned char* lds, const AttnArgs& A, int vcu, int G, int tid, int wid, int lane) {
    for (int ord = vcu; ord < 1024; ord += G) {
        const int i = ord >> 8, v = ord & 255, bh = v >> 3, s = v & 7;
        const int qb = (i & 1) ? 15 - s : s;
        if (i < 2) diff_unit(lds, A, bh >> 3, bh & 7, qb, tid, wid, lane);
        else moba_unit(lds, A, bh >> 3, bh & 7, qb, tid, wid, lane);
    }
}
}

namespace peer {
__device__ __forceinline__ int f2key(float f) { const int u = __builtin_bit_cast(int, f); return u ^ ((u >> 31) & 0x7fffffff); }
__device__ __forceinline__ float key2f(int k) { const int u = k ^ ((k >> 31) & 0x7fffffff); return __builtin_bit_cast(float, u); }
__device__ __forceinline__ int imax(int a, int b) { return a > b ? a : b; }
__device__ __forceinline__ int imin(int a, int b) { return a < b ? a : b; }

template <int OFF> __device__ __forceinline__ void sort16_desc(int (&v)[64]) {
#pragma unroll
    for (int k = 2; k <= 16; k <<= 1)
#pragma unroll
        for (int j = k >> 1; j > 0; j >>= 1)
#pragma unroll
            for (int i = 0; i < 16; ++i) { const int l = i ^ j;
                if (l > i) { const bool desc = ((i & k) == 0); const int a = v[OFF + i], b = v[OFF + l]; const int mx = imax(a, b), mn = imin(a, b);
                    v[OFF + i] = desc ? mx : mn; v[OFF + l] = desc ? mn : mx; } }
}
template <int OA, int OB> __device__ __forceinline__ void merge16_desc(int (&v)[64]) {
#pragma unroll
    for (int i = 0; i < 16; ++i) v[OA + i] = imax(v[OA + i], v[OB + 15 - i]);
#pragma unroll
    for (int j = 8; j > 0; j >>= 1)
#pragma unroll
        for (int i = 0; i < 16; ++i) { const int l = i ^ j;
            if (l > i) { const int a = v[OA + i], b = v[OA + l]; v[OA + i] = imax(a, b); v[OA + l] = imin(a, b); } }
}
__device__ __forceinline__ void top16_of_64(int (&v)[64]) {
    sort16_desc<0>(v); sort16_desc<16>(v); sort16_desc<32>(v); sort16_desc<48>(v);
    merge16_desc<0, 16>(v); merge16_desc<32, 48>(v); merge16_desc<0, 32>(v);
}
__device__ __forceinline__ float gelu_tanh(float x) {
    const float u = 0.7978845608028654f * (x + 0.044715f * x * x * x);
    const float e = __builtin_amdgcn_exp2f(2.0f * 1.4426950408889634f * u);
    const float th = 1.0f - 2.0f * __builtin_amdgcn_rcpf(e + 1.0f);
    return 0.5f * x * (1.0f + th);
}
constexpr int ETILE = 0, GTILE = 16384, SCR0 = 32768, XQ0 = 98304;

__device__ __forceinline__ void select_tile(LAS unsigned char* lds, const bf16* pq, const bf16* sk, int t0, int wid, int lane) {
    asm volatile("" : "+v"(lane));
    const int r32 = lane & 31, hi = lane >> 5, h = wid;
    LAS int* scr = (LAS int*)(lds + SCR0 + wid * 8192);
    int v[64];
#pragma unroll 1
    for (int c = 0; c < 2; ++c) {
        bf16x8 qf[8];
        { const bf16* qp = pq + (size_t)(t0 + r32) * 2048 + h * 256 + c * 128 + 8 * hi;
#pragma unroll
          for (int s = 0; s < 8; ++s) qf[s] = *(const GAS bf16x8*)(qp + 16 * s); }
#pragma unroll
        for (int kb = 0; kb < 4; ++kb) {
            f32x16 sc = (f32x16){0.f,0.f,0.f,0.f,0.f,0.f,0.f,0.f,0.f,0.f,0.f,0.f,0.f,0.f,0.f,0.f};
            const bf16* ap = sk + ((size_t)((c * 8 + h) * 128 + 32 * kb + r32)) * 128 + 8 * hi;
#pragma unroll
            for (int s = 0; s < 8; ++s) { const bf16x8 af = *(const GAS bf16x8*)(ap + 16 * s); sc = __builtin_amdgcn_mfma_f32_32x32x16_bf16(af, qf[s], sc, 0, 0, 0); }
#pragma unroll
            for (int r = 0; r < 16; ++r) v[kb * 16 + r] = (f2key(sc[r]) & ~127) | (32 * kb + (r & 3) + 8 * (r >> 2) + 4 * hi);
        }
        top16_of_64(v);
#pragma unroll
        for (int i = 0; i < 16; ++i) v[16 + i] = __shfl_xor(v[i], 32);
        merge16_desc<0, 16>(v);
#pragma unroll
        for (int i = 0; i < 16; ++i) scr[(c * 16 + i) * 64 + lane] = v[i];
    }
    LDS_WAIT();
    float a[16], b[16];
#pragma unroll
    for (int i = 0; i < 16; ++i) { a[i] = key2f(scr[i * 64 + lane] & ~127); b[i] = key2f(v[i] & ~127); }
    int n = 0;
#pragma unroll
    for (int i = 0; i < 16; ++i)
#pragma unroll
        for (int j = 0; j < 16; ++j)
            if ((i + 1) * (j + 1) <= 16) { v[n] = (f2key(a[i] + b[j]) & ~255) | (i << 4) | j; ++n; }
#pragma unroll
    for (int i = 0; i < 64; ++i) if (i >= 50) v[i] = (int)0x80000000;
    top16_of_64(v);
    float s[16]; int e[16]; float mx = -INFINITY;
#pragma unroll
    for (int k = 0; k < 16; ++k) { const int i = (v[k] >> 4) & 15, j = v[k] & 15;
        const int ka = scr[i * 64 + lane], kb2 = scr[(16 + j) * 64 + lane];
        s[k] = key2f(ka & ~127) + key2f(kb2 & ~127); e[k] = (ka & 127) * 128 + (kb2 & 127); mx = fmaxf(mx, s[k]); }
    float sum = 0.f;
#pragma unroll
    for (int k = 0; k < 16; ++k) { s[k] = __builtin_amdgcn_exp2f((s[k] - mx) * 1.4426950408889634f); sum += s[k]; }
    const float inv = 1.0f / sum;
    if (hi == 0) {
        LAS int* E = (LAS int*)(lds + ETILE) + r32 * 128 + h * 16; LAS float* Gt = (LAS float*)(lds + GTILE) + r32 * 128 + h * 16;
#pragma unroll
        for (int k = 0; k < 16; ++k) { E[k] = e[k]; Gt[k] = s[k] * inv; }
    }
}

#define PEER_LOADROW(dst, tab, ridx) do { dst = *((const GAS v4u*)((tab) + (size_t)(ridx) * 1024) + lane); } while (0)
typedef float f32x2p __attribute__((ext_vector_type(2)));
#define PEER_CVT4(w) const f32x2p c0_ = __builtin_amdgcn_cvt_scalef32_pk_f32_fp4((w), 1.0f, 0), c1_ = __builtin_amdgcn_cvt_scalef32_pk_f32_fp4((w), 1.0f, 1), \
        c2_ = __builtin_amdgcn_cvt_scalef32_pk_f32_fp4((w), 1.0f, 2), c3_ = __builtin_amdgcn_cvt_scalef32_pk_f32_fp4((w), 1.0f, 3)
#define PEER_AXPY8(Y2, wk2, w, b) do { PEER_CVT4(w); Y2[(b)] = __builtin_elementwise_fma(wk2, c0_, Y2[(b)]); Y2[(b) + 1] = __builtin_elementwise_fma(wk2, c1_, Y2[(b) + 1]); \
        Y2[(b) + 2] = __builtin_elementwise_fma(wk2, c2_, Y2[(b) + 2]); Y2[(b) + 3] = __builtin_elementwise_fma(wk2, c3_, Y2[(b) + 3]); } while (0)

__device__ __forceinline__ void token_ffn(LAS unsigned char* lds, int tl, const bf16* xrow, const unsigned char* TU, const unsigned char* TV, const float* SU, const float* SV,
                                          const float* gain, const float* bias, float* outf, bf16* outb, unsigned char* out8, float* outsx, int lane,
                                          v4u (&buf)[16], bool have_u, bool has_next) {
    f32x2p xs[16];
#pragma unroll
    for (int q = 0; q < 4; ++q) { const v4u a = *(const GAS v4u*)(xrow + 32 * lane + 8 * q);
        xs[4 * q] = (f32x2p){bf_lo(a.x), bf_hi(a.x)}; xs[4 * q + 1] = (f32x2p){bf_lo(a.y), bf_hi(a.y)}; xs[4 * q + 2] = (f32x2p){bf_lo(a.z), bf_hi(a.z)}; xs[4 * q + 3] = (f32x2p){bf_lo(a.w), bf_hi(a.w)}; }
    const LAS int* E = (const LAS int*)(lds + ETILE) + tl * 128; const LAS float* Gt = (const LAS float*)(lds + GTILE) + tl * 128;
    const int e_lo = E[lane], e_hi = E[64 + lane]; const float g_lo = Gt[lane], g_hi = Gt[64 + lane];
    const float su_lo = SU[e_lo], su_hi = SU[e_hi], sv_lo = SV[e_lo], sv_hi = SV[e_hi];
#define PEER_EIDX(k) (((k) < 64) ? __builtin_amdgcn_readlane(e_lo, (k)) : __builtin_amdgcn_readlane(e_hi, (k) - 64))
    constexpr int PEER_RING = 16;
    float h_lo = 0.f, h_hi = 0.f;
    {
        float am = 0.f;
#pragma unroll
        for (int i = 0; i < 16; ++i) am = fmaxf(am, fmaxf(fabsf(xs[i].x), fabsf(xs[i].y)));
#pragma unroll
        for (int o = 1; o < 64; o <<= 1) am = fmaxf(am, __shfl_xor(am, o));
        const float sx = am > 0.f ? 6.0f / am : 1.0f, isx = am > 0.f ? am / 6.0f : 1.0f;
        v4u xh, xl;
#pragma unroll
        for (int wq = 0; wq < 4; ++wq) { unsigned wh = 0u, wl = 0u;
#define PEER_XQ(b) { const f32x2p v = xs[4 * wq + (b)] * sx; wh = __builtin_amdgcn_cvt_scalef32_pk_fp4_f32(wh, v.x, v.y, 1.0f, (b)); \
                const f32x2p d = __builtin_amdgcn_cvt_scalef32_pk_f32_fp4(wh, 1.0f, (b)); wl = __builtin_amdgcn_cvt_scalef32_pk_fp4_f32(wl, (v.x - d.x) * 4.0f, (v.y - d.y) * 4.0f, 1.0f, (b)); }
            PEER_XQ(0) PEER_XQ(1) PEER_XQ(2) PEER_XQ(3)
#undef PEER_XQ
            xh[wq] = wh; xl[wq] = wl; }
        LAS unsigned char* xq = lds + XQ0 + (tl >> 2) * 2048;
        *(LAS v4u*)(xq + 16 * lane) = xh; *(LAS v4u*)(xq + 1024 + 16 * lane) = xl;
        const int g = lane >> 4, rl = lane & 15;
        typedef int v8i_t __attribute__((ext_vector_type(8)));
        if (!have_u) { const int e_r = E[16 * 0 + rl];
#pragma unroll
            for (int s = 0; s < 16; ++s) buf[s] = *(const GAS v4u*)(TU + (size_t)e_r * 1024 + 16 * g + 64 * s); }
#define PEER_HBLOCK(rb, RELOAD) do { \
            f32x4 ah = {0.f, 0.f, 0.f, 0.f}, al = {0.f, 0.f, 0.f, 0.f}; \
            int xoff = 16 * g; asm volatile("" : "+v"(xoff));        \
            const LAS unsigned char* xbb = xq + xoff; \
            _Pragma("unroll") for (int s = 0; s < 16; ++s) { \
                const v4u a4 = buf[s]; const v4u bh = *(const LAS v4u*)(xbb + 64 * s), bl = *(const LAS v4u*)(xbb + 1024 + 64 * s); \
                const v8i_t A = {(int)a4.x, (int)a4.y, (int)a4.z, (int)a4.w, 0, 0, 0, 0}, BH = {(int)bh.x, (int)bh.y, (int)bh.z, (int)bh.w, 0, 0, 0, 0}, BL = {(int)bl.x, (int)bl.y, (int)bl.z, (int)bl.w, 0, 0, 0, 0}; \
                ah = __builtin_amdgcn_mfma_scale_f32_16x16x128_f8f6f4(A, BH, ah, 4, 4, 0, 127, 0, 127); \
                al = __builtin_amdgcn_mfma_scale_f32_16x16x128_f8f6f4(A, BL, al, 4, 4, 0, 127, 0, 127); \
                RELOAD(s); } \
              \
            float selv = 0.f; \
            _Pragma("unroll") for (int r = 0; r < 4; ++r) { const float hv = (ah[r] + 0.25f * al[r]) * isx; const float t = __shfl(hv, 16 * ((lane >> 2) & 3)); selv = ((lane & 3) == r) ? t : selv; } \
            if ((rb) < 4) h_lo = ((lane >> 4) == (rb)) ? selv : h_lo; else h_hi = ((lane >> 4) == ((rb) - 4)) ? selv : h_hi; } while (0)
#define PEER_RELOAD_U(s) buf[s] = *(const GAS v4u*)(rown + 64 * (s))
#define PEER_RELOAD_V(s) PEER_LOADROW(buf[s], TV, PEER_EIDX(s))
#pragma unroll 1
        for (int rb = 0; rb < 7; ++rb) {
            const int e_n = E[16 * (rb + 1) + rl];
            const GAS unsigned char* rown = (const GAS unsigned char*)TU + (size_t)e_n * 1024 + 16 * g;
            PEER_HBLOCK(rb, PEER_RELOAD_U);
        }
        PEER_HBLOCK(7, PEER_RELOAD_V);
#undef PEER_RELOAD_U
#undef PEER_RELOAD_V
#undef PEER_HBLOCK
    }
    const float w_lo = g_lo * gelu_tanh(h_lo * su_lo) * sv_lo, w_hi = g_hi * gelu_tanh(h_hi * su_hi) * sv_hi;
    f32x2p y[16];
#pragma unroll
    for (int i = 0; i < 16; ++i) y[i] = (f32x2p){0.f, 0.f};
#pragma unroll 1
    for (int k0 = 0; k0 < 128 - PEER_RING; k0 += PEER_RING) {
        const int wsrc = __builtin_bit_cast(int, (k0 < 64) ? w_lo : w_hi);
        const int kb = k0 + PEER_RING;
        const int esrc = (kb < 64) ? e_lo : e_hi;
#pragma unroll
        for (int i = 0; i < PEER_RING; ++i) {
            const float wk = __builtin_bit_cast(float, __builtin_amdgcn_readlane(wsrc, (k0 & 63) + i));
            const v4u w = buf[i]; const f32x2p wk2 = {wk, wk};
            PEER_AXPY8(y, wk2, w.x, 0); PEER_AXPY8(y, wk2, w.y, 4); PEER_AXPY8(y, wk2, w.z, 8); PEER_AXPY8(y, wk2, w.w, 12);
            const int en = __builtin_amdgcn_readlane(esrc, (kb & 63) + i); PEER_LOADROW(buf[i], TV, en);
        }
    }
    {
        const int e_nx = has_next ? E[128 + (lane & 15)] : 0;
        const GAS unsigned char* rownx = (const GAS unsigned char*)TU + (size_t)e_nx * 1024 + 16 * (lane >> 4);
#pragma unroll
        for (int i = 0; i < PEER_RING; ++i) {
            const float wk = __builtin_bit_cast(float, __builtin_amdgcn_readlane(__builtin_bit_cast(int, w_hi), 48 + i));
            const v4u w = buf[i]; const f32x2p wk2 = {wk, wk};
            PEER_AXPY8(y, wk2, w.x, 0); PEER_AXPY8(y, wk2, w.y, 4); PEER_AXPY8(y, wk2, w.z, 8); PEER_AXPY8(y, wk2, w.w, 12);
            if (has_next) buf[i] = *(const GAS v4u*)(rownx + 64 * i);
        }
    }
    float sm = 0.f;
#pragma unroll
    for (int i = 0; i < 16; ++i) { y[i] = xs[i] * ALPHA + y[i]; sm += y[i].x + y[i].y; }
    const float mean = wave_sum(sm) * (1.0f / 2048.0f);
    float sq = 0.f;
#pragma unroll
    for (int i = 0; i < 16; ++i) { y[i] = y[i] - mean; sq += y[i].x * y[i].x + y[i].y * y[i].y; }
    const float rstd = 1.0f / sqrtf(wave_sum(sq) * (1.0f / 2048.0f) + LN_EPS);
    unsigned pk[16];
#pragma unroll
    for (int q = 0; q < 8; ++q) { const int c0 = 32 * lane + 4 * q;
        const f32x4 ga = *(const GAS f32x4*)(gain + c0), ba = *(const GAS f32x4*)(bias + c0);
        f32x4 o;
        o[0] = y[2 * q].x * rstd * ga[0] + ba[0]; o[1] = y[2 * q].y * rstd * ga[1] + ba[1]; o[2] = y[2 * q + 1].x * rstd * ga[2] + ba[2]; o[3] = y[2 * q + 1].y * rstd * ga[3] + ba[3];
        if (outf) *(GAS f32x4*)(outf + c0) = o;
        pk[2 * q] = pk2(o[0], o[1]); pk[2 * q + 1] = pk2(o[2], o[3]); }
    if (outb) {
#pragma unroll
        for (int q = 0; q < 4; ++q) *(GAS v4u*)(outb + 32 * lane + 8 * q) = (v4u){pk[4 * q], pk[4 * q + 1], pk[4 * q + 2], pk[4 * q + 3]};
        float am = 0.f;
#pragma unroll
        for (int i = 0; i < 16; ++i) am = fmaxf(am, fmaxf(fabsf(bf_lo(pk[i])), fabsf(bf_hi(pk[i]))));
#pragma unroll
        for (int o = 1; o < 64; o <<= 1) am = fmaxf(am, __shfl_xor(am, o));
        const float sc = am > 0.f ? 127.0f / am : 0.f;
#pragma unroll
        for (int q = 0; q < 2; ++q) { v4u w;
            w.x = q8pack(bf_lo(pk[8 * q]), bf_hi(pk[8 * q]), bf_lo(pk[8 * q + 1]), bf_hi(pk[8 * q + 1]), sc); w.y = q8pack(bf_lo(pk[8 * q + 2]), bf_hi(pk[8 * q + 2]), bf_lo(pk[8 * q + 3]), bf_hi(pk[8 * q + 3]), sc);
            w.z = q8pack(bf_lo(pk[8 * q + 4]), bf_hi(pk[8 * q + 4]), bf_lo(pk[8 * q + 5]), bf_hi(pk[8 * q + 5]), sc); w.w = q8pack(bf_lo(pk[8 * q + 6]), bf_hi(pk[8 * q + 6]), bf_lo(pk[8 * q + 7]), bf_hi(pk[8 * q + 7]), sc);
            *(GAS v4u*)(out8 + 32 * lane + 16 * q) = w; }
        if (lane == 0) *outsx = am * (1.0f / 127.0f); }
#undef PEER_EIDX
}
#undef PEER_LOADROW
#undef PEER_AXPY8
#undef PEER_CVT4
}

__device__ __forceinline__ void ln_row(const bf16* zrow, const float* gain, const float* bias, bf16* outb, int lane) {
    float v[32]; float s = 0.f;
#pragma unroll
    for (int q = 0; q < 4; ++q) { const v4u w = *(const GAS v4u*)(zrow + 32 * lane + 8 * q);
        v[8 * q] = bf_lo(w.x); v[8 * q + 1] = bf_hi(w.x); v[8 * q + 2] = bf_lo(w.y); v[8 * q + 3] = bf_hi(w.y); v[8 * q + 4] = bf_lo(w.z); v[8 * q + 5] = bf_hi(w.z); v[8 * q + 6] = bf_lo(w.w); v[8 * q + 7] = bf_hi(w.w); }
#pragma unroll
    for (int i = 0; i < 32; ++i) s += v[i];
    const float mean = wave_sum(s) * (1.0f / 2048.0f); float s2 = 0.f;
#pragma unroll
    for (int i = 0; i < 32; ++i) { v[i] -= mean; s2 += v[i] * v[i]; }
    const float rstd = 1.0f / sqrtf(wave_sum(s2) * (1.0f / 2048.0f) + LN_EPS);
#pragma unroll
    for (int q = 0; q < 4; ++q) { const int c0 = 32 * lane + 8 * q;
        const f32x4 g0 = *(const GAS f32x4*)(gain + c0), g1 = *(const GAS f32x4*)(gain + c0 + 4), b0 = *(const GAS f32x4*)(bias + c0), b1 = *(const GAS f32x4*)(bias + c0 + 4);
        v4u o; o.x = pk2(v[8 * q] * rstd * g0[0] + b0[0], v[8 * q + 1] * rstd * g0[1] + b0[1]); o.y = pk2(v[8 * q + 2] * rstd * g0[2] + b0[2], v[8 * q + 3] * rstd * g0[3] + b0[3]);
        o.z = pk2(v[8 * q + 4] * rstd * g1[0] + b1[0], v[8 * q + 5] * rstd * g1[1] + b1[1]); o.w = pk2(v[8 * q + 6] * rstd * g1[2] + b1[2], v[8 * q + 7] * rstd * g1[3] + b1[3]);
        *(GAS v4u*)(outb + c0) = o; }
}

#if MK_CHECK
namespace chk {
constexpr int CW_ERR = 2048;
__device__ __forceinline__ unsigned hash32(unsigned x) { x ^= x >> 16; x *= 0x7feb352du; x ^= x >> 15; x *= 0x846ca68bu; x ^= x >> 16; return x; }
__device__ __forceinline__ float bf2f(bf16 v) { return __builtin_bit_cast(float, (unsigned)v << 16); }
__device__ __forceinline__ void report(gu32* ctl, int stage, float d2, float r2) { atomicAdd((float*)(ctl + CW_ERR + 2 * stage), d2); atomicAdd((float*)(ctl + CW_ERR + 2 * stage + 1), r2); }
__device__ __forceinline__ float dotcol(const bf16* xr, const float* win, int n, int lane) { float a = 0.f; for (int k = lane; k < 2048; k += 64) a += bf2f(xr[k]) * win[(size_t)k * INC + n]; return wave_sum(a); }
__device__ __forceinline__ void check_inproj(gu32* ctl, const bf16* xin, const int* pos, const float* win, const bf16* qa, const bf16* ka, const bf16* qd, const bf16* kd, const bf16* vt, const bf16* ga, const bf16* gb, int gw, int ngw, int lane) {
    for (int s = gw; s < 4096; s += ngw) {
        const unsigned hsh = hash32(s * 2654435761u + 12345u);
        const int t = hsh % T, kind = (hsh >> 14) % 8;
        const unsigned h2 = hash32(hsh);
        const bf16* xr = xin + (size_t)t * 2048;
        float ref, got;
        if (kind == 0 || kind == 1) { const int head = h2 % 8, i = (h2 >> 3) % 64, nb = (kind == 0 ? 0 : 1024) + head * 128;
            const float t1 = dotcol(xr, win, nb + i, lane), t2 = dotcol(xr, win, nb + i + 64, lane);
            const float ang = (float)pos[t] * powf(10000.0f, -(float)(2 * i) / 128.0f), c = cosf(ang), sn = sinf(ang);
            const bool second = (h2 >> 9) & 1; ref = second ? (t1 * sn + t2 * c) : (t1 * c - t2 * sn);
            const bf16* p = (kind == 0 ? qa : ka) + (size_t)t * 1024 + head * 128 + i + (second ? 64 : 0);
            got = bf2f(*p) / (kind == 0 ? QSCALE_A : 1.0f);
        } else if (kind == 3 || kind == 4) { const int head = h2 % 8, comp = (h2 >> 3) & 1, i = (h2 >> 4) % 32, nb = (kind == 3 ? 3072 : 4096) + head * 128 + comp * 64;
            const float t1 = dotcol(xr, win, nb + i, lane), t2 = dotcol(xr, win, nb + i + 32, lane);
            const float ang = (float)pos[t] * powf(10000.0f, -(float)(2 * i) / 64.0f), c = cosf(ang), sn = sinf(ang);
            const bool second = (h2 >> 9) & 1; ref = second ? (t1 * sn + t2 * c) : (t1 * c - t2 * sn);
            const bf16* p = (kind == 3 ? qd : kd) + (size_t)t * 1024 + head * 128 + comp * 64 + i + (second ? 32 : 0);
            got = bf2f(*p) / (kind == 3 ? QSCALE_B : 1.0f);
        } else if (kind == 2 || kind == 5) { const int c = h2 % 1024; ref = dotcol(xr, win, (kind == 2 ? 2048 : 5120) + c, lane); got = bf2f(vt[(size_t)((kind == 2 ? 0 : 1024) + c) * T + t]);
        } else { const int c = h2 % 2048; const float v = dotcol(xr, win, (kind == 6 ? 6144 : 8192) + c, lane); ref = 1.0f / (1.0f + expf(-v)); got = (float)((const unsigned char*)(kind == 6 ? ga : gb))[(size_t)t * 2048 + c] * (1.0f / 255.0f); }
        if (lane == 0) report(ctl, 0, (got - ref) * (got - ref), ref * ref);
    }
}
__device__ __forceinline__ void check_kmean(gu32* ctl, const bf16* ka, const float* kmean, int gw, int ngw, int lane) {
    for (int s = gw; s < 1024; s += ngw) { const unsigned hsh = hash32(s * 40503u + 77u); const int item = hsh % 512, d = (hsh >> 10) % 128; const int b = item >> 7, h = (item >> 4) & 7, blk = item & 15;
        float a = 0.f; for (int r = lane; r < 256; r += 64) a += bf2f(ka[(size_t)(b * SEQ + blk * 256 + r) * 1024 + h * 128 + d]); a = wave_sum(a);
        const float g = kmean[(size_t)item * 128 + d];
        if (lane == 0) report(ctl, 1, (g - a) * (g - a), a * a + 1.0f); }
}
__device__ __forceinline__ void check_attn(LAS unsigned char* lds, gu32* ctl, const att::AttnArgs& A, int vcu, int G, int tid, int lane, int wave) {
    LAS float* sc = (LAS float*)lds; LAS float* red = sc + 4096; LAS float* ovec = red + 64; LAS float* gsc = ovec + 256; LAS unsigned* selw = (LAS unsigned*)(gsc + 16);
    for (int s = vcu; s < 1024; s += G) {
        const unsigned hsh = hash32(s * 2246822519u + 99u); const bool moba = (s & 1);
        const int b = hsh % NB, h = (hsh >> 2) % NH; int t = (hsh >> 5) % SEQ; if ((s & 6) == 0) t = (t & 255) + 256 * ((hsh >> 20) % 3);
        const size_t row = (size_t)b * SEQ + t; const int own = t >> 8;
        float o0 = 0.f, o1 = 0.f;
        const int ncomp = moba ? 1 : 2;
        __syncthreads();
        if (moba) {
            if (tid < 16) { float a = -INFINITY; if (tid < own) { a = 0.f; for (int d = 0; d < 128; ++d) a += bf2f(A.qa[row * 1024 + h * 128 + d]) * A.kmean[((size_t)(b * 8 + h) * 16 + tid) * 128 + d]; } gsc[tid] = a; }
            __syncthreads();
            if (tid == 0) { unsigned sel = 0u; for (int r = 0; r < 3; ++r) { float best = -INFINITY; int bi = -1; for (int n = 0; n < own; ++n) { const float g = gsc[n]; if (!((sel >> n) & 1u) && g > best) { best = g; bi = n; } } if (bi >= 0) sel |= 1u << bi; } selw[0] = sel; }
            __syncthreads();
        }
        const unsigned sel = moba ? selw[0] : 0u;
        for (int comp = 0; comp < ncomp; ++comp) {
            const bf16* qp = moba ? A.qa + row * 1024 + h * 128 : A.qd + row * 1024 + h * 128 + comp * 64;
            const bf16* kb = moba ? A.ka + (size_t)b * SEQ * 1024 + h * 128 : A.kd + (size_t)b * SEQ * 1024 + h * 128 + comp * 64;
            const int dq = moba ? 128 : 64;
            float lmax = -INFINITY;
            for (int k = tid; k <= t; k += 512) { bool ok = true; if (moba) { const int kbk = k >> 8; ok = (kbk == own) || ((sel >> kbk) & 1u); }
                float a = -INFINITY; if (ok) { a = 0.f; for (int d = 0; d < dq; ++d) a += bf2f(qp[d]) * bf2f(kb[(size_t)k * 1024 + d]); }
                sc[k] = a; lmax = fmaxf(lmax, a); }
            lmax = fmaxf(lmax, __shfl_xor(lmax, 1)); lmax = fmaxf(lmax, __shfl_xor(lmax, 2)); lmax = fmaxf(lmax, __shfl_xor(lmax, 4)); lmax = fmaxf(lmax, __shfl_xor(lmax, 8)); lmax = fmaxf(lmax, __shfl_xor(lmax, 16)); lmax = fmaxf(lmax, __shfl_xor(lmax, 32));
            if (lane == 0) red[wave] = lmax;
            __syncthreads();
            float gmax = red[0]; for (int w = 1; w < 8; ++w) gmax = fmaxf(gmax, red[w]);
            float lsum = 0.f;
            for (int k = tid; k <= t; k += 512) { const float p = exp2f(sc[k] - gmax); sc[k] = p; lsum += p; }
            lsum = wave_sum(lsum);
            if (lane == 0) red[8 + wave] = lsum;
            __syncthreads();
            float gsum = 0.f; for (int w = 0; w < 8; ++w) gsum += red[8 + w];
            if (tid < 128) { const bf16* vp = A.vt + (size_t)((moba ? 0 : 1024) + h * 128 + tid) * T + (size_t)b * SEQ; float a = 0.f; for (int k = 0; k <= t; ++k) a += sc[k] * bf2f(vp[k]); a /= gsum; if (comp == 0) o0 = a; else o1 = a; }
            __syncthreads();
        }
        float ref = 0.f, got = 0.f;
        if (tid < 128) {
            if (moba) { ref = o0; got = bf2f(A.oab[row * 2048 + h * 128 + tid]); }
            else { ref = o0 - A.lam * o1; got = bf2f(A.oab[row * 2048 + 1024 + h * 128 + tid]); }
            ovec[tid] = ref;
        }
        __syncthreads();
        if (tid < 128 && !moba) { float ss = 0.f; for (int d = 0; d < 128; ++d) ss += ovec[d] * ovec[d]; ref = ref / sqrtf(ss * (1.0f / 128.0f) + RMS_EPS) * A.gain[h * 128 + tid] * A.one_minus_li; }
        float d2 = (tid < 128) ? (got - ref) * (got - ref) : 0.f, r2 = (tid < 128) ? ref * ref : 0.f;
        d2 = wave_sum(d2); r2 = wave_sum(r2);
        if (lane == 0 && wave < 2) report(ctl, moba ? 2 : 3, d2, r2);
        __syncthreads();
    }
}
__device__ __forceinline__ void check_merged(gu32* ctl, const bf16* oab, const bf16* ga, const bf16* gb, const bf16* merged, const float* wa, const float* wb, int gw, int ngw, int lane) {
    for (int s = gw; s < 2048; s += ngw) { const unsigned hsh = hash32(s * 3266489917u + 5u); const int t = hsh % T, c = (hsh >> 14) % 2048;
        float a = 0.f, b = 0.f; for (int k = lane; k < 1024; k += 64) { a += bf2f(oab[(size_t)t * 2048 + k]) * wa[(size_t)k * 2048 + c]; b += bf2f(oab[(size_t)t * 2048 + 1024 + k]) * wb[(size_t)k * 2048 + c]; }
        a = wave_sum(a); b = wave_sum(b);
        const float ref = ((float)((const unsigned char*)ga)[(size_t)t * 2048 + c] * a + (float)((const unsigned char*)gb)[(size_t)t * 2048 + c] * b) * (1.0f / 255.0f), got = bf2f(merged[(size_t)t * 2048 + c]);
        if (lane == 0) report(ctl, 4, (got - ref) * (got - ref), ref * ref); }
}
__device__ __forceinline__ void check_z(gu32* ctl, const bf16* merged, const float* wo, const bf16* xres, const bf16* z, int gw, int ngw, int lane) {
    for (int s = gw; s < 2048; s += ngw) { const unsigned hsh = hash32(s * 668265263u + 31u); const int t = hsh % T, c = (hsh >> 14) % 2048;
        float a = 0.f; for (int k = lane; k < 2048; k += 64) a += bf2f(merged[(size_t)t * 2048 + k]) * wo[(size_t)k * 2048 + c];
        a = wave_sum(a);
        const float got = bf2f(z[(size_t)t * 2048 + c]) - ALPHA * bf2f(xres[(size_t)t * 2048 + c]);
        if (lane == 0) report(ctl, 5, (got - a) * (got - a), a * a); }
}
}
#endif

constexpr int NPHASE = 2 + 8 * DEPTH;
#ifndef MK_ALIGN
#define MK_ALIGN true
#endif
#ifndef MK_SP2
#define MK_SP2 true
#endif
struct Params { const float* in[16]; float* out; unsigned char* ws; int ph_lo, ph_hi; };

__global__ void __launch_bounds__(NWAVES * 64, 2) mk_fwd(Params args) {
    extern __shared__ __attribute__((aligned(16))) unsigned char lds_raw[];
    Frame F;
    F.lds = (LAS unsigned char*)lds_raw;
    F.MISC = (volatile LAS unsigned*)(F.lds + MISC_OFF);
    F.tid = threadIdx.x; F.lane = F.tid & 63; F.wave = __builtin_amdgcn_readfirstlane(F.tid >> 6);
    F.G = gridDim.x; { const int bx = blockIdx.x; F.vcu = (F.G % 8 == 0) ? (bx % 8) * (F.G / 8) + bx / 8 : bx; }
    F.ws = args.ws; F.ctl = (gu32*)(args.ws + WS_CTL);
    unsigned char* const ws = args.ws;
    const float* const in_x = args.in[0]; const int* const in_pos = (const int*)args.in[1];
    const float *in_win = args.in[2], *in_wa = args.in[3], *in_wb = args.in[4], *in_wo = args.in[5], *in_dlam = args.in[6], *in_dgain = args.in[7];
    const float *in_ln1g = args.in[8], *in_ln1b = args.in[9], *in_ln2g = args.in[10], *in_ln2b = args.in[11], *in_pwq = args.in[12], *in_sk = args.in[13], *in_pu = args.in[14], *in_pv = args.in[15];
    float* const dout = args.out;

    for (int u = F.tid; u < (LDS_BYTES - LDSCTL_OFF) / 4; u += NWAVES * 64) ((LAS unsigned*)(F.lds + LDSCTL_OFF))[u] = 0u;
    __syncthreads();
#if MK_FUSED
    XcdBarrier bar = xcd_barrier_post((unsigned*)(F.ctl + CW_BAR), F.MISC + 8, (unsigned)F.wave);
#define GRID_BAR() xcd_barrier(bar)
#else
#define GRID_BAR() do { } while (0)
#endif
    const int lo = args.ph_lo, hi = args.ph_hi;
#define IN(k) (lo <= (k) && (k) < hi)
#define BOTH(k) (IN(k) && IN((k) + 1))

    float* const cosA = (float*)(ws + WS_ROPE); float* const sinA = cosA + (size_t)T * 64; float* const cosB = sinA + (size_t)T * 64; float* const sinB = cosB + (size_t)T * 32;
    bf16* const XB = (bf16*)(ws + WS_XB);

    gu32* const wmax = F.ctl + CW_WMAX;
    if (IN(0)) {
        for (int it = F.wave * F.G + F.vcu; it < DEPTH * 16 * 40; it += F.G * NWAVES) { const int layer = it / 640;
            p0_absmax_item(in_win + (size_t)layer * 2048 * 10240, it % 640, F.lane, wmax + layer * 10240); }
        if (BOTH(0)) GRID_BAR();
    }
    if (IN(1)) {
        LAS float* scr = (LAS float*)(F.lds + F.wave * 16384);
        const int gw = F.vcu * NWAVES + F.wave, NGW = F.G * NWAVES;
        constexpr int I_IN = (2048 / 64) * (10240 / 32), I_A = (1024 / 64) * (2048 / 32), I_O = (2048 / 64) * (2048 / 32);
        constexpr int PER_LAYER = I_IN + 2 * I_A + 2 * I_O;
        for (int it = gw; it < DEPTH * PER_LAYER; it += NGW) {
            const int layer = it / PER_LAYER; int r = it % PER_LAYER;
            unsigned char* wl = ws + WS_W + (size_t)layer * W_LAYER;
            if (r < I_IN) { p0_transpose_item_i8(in_win + (size_t)layer * 2048 * 10240, 2048, 10240, wl + WO_MAIN, scr, r, F.lane, wmax + layer * 10240); continue; } r -= I_IN;
            if (r < I_A) { p0_transpose_item<false>(in_wa + (size_t)layer * 1024 * 2048, 1024, 2048, (bf16*)(wl + WO_A), scr, r, F.lane, 2048, 0); continue; } r -= I_A;
            if (r < I_A) { p0_transpose_item<false>(in_wb + (size_t)layer * 1024 * 2048, 1024, 2048, (bf16*)(wl + WO_A), scr, r, F.lane, 2048, 1024); continue; } r -= I_A;
            if (r < I_O) { p0_transpose_item<false>(in_wo + (size_t)layer * 2048 * 2048, 2048, 2048, (bf16*)(wl + WO_O), scr, r, F.lane); continue; } r -= I_O;
            p0_transpose_item<false>(in_pwq + (size_t)layer * 2048 * 2048, 2048, 2048, (bf16*)(wl + WO_Q), scr, r, F.lane);
        }
        const size_t gtid = (size_t)F.vcu * 512 + F.tid, gthreads = (size_t)F.G * 512;
        for (int r = gw; r < 4 * NEXP; r += NGW) { const int tab = r >> 14, e = r & (NEXP - 1);
            const float* src = ((tab & 1) ? in_pv : in_pu) + ((size_t)(tab >> 1) * NEXP + e) * 2048;
            p0_table_row(src, ws + WS_TAB + (size_t)tab * TAB_BYTES + (size_t)e * 1024, (float*)(ws + WS_TSC) + r, F.lane); }
        p0_convert(in_sk, (bf16*)(ws + WS_SK), (size_t)DEPTH * 2 * 8 * 128 * 128 / 8, gtid, gthreads);
        for (int row = gw; row < T; row += NGW) p0_x_row(in_x + (size_t)row * 2048, XB + (size_t)row * 2048, ws + WS_XI8 + (size_t)row * 2048, (float*)(ws + WS_SX) + row, F.lane);
        for (size_t i = gtid; i < (size_t)DEPTH * 10240; i += gthreads) { const int layer = (int)(i / 10240), n = (int)(i % 10240);
            ((float*)(ws + WS_SW))[layer * 10240 + inproj_row(n)] = __builtin_bit_cast(float, wmax[layer * 10240 + n]) * (1.0f / 127.0f); }
        for (size_t i = gtid; i < (size_t)T * 64; i += gthreads) { const int t = (int)(i >> 6), k = (int)(i & 63);
            const float invf = powf(10000.0f, -(float)(2 * k) / 128.0f); const float ang = (float)in_pos[t] * invf;
            cosA[i] = cosf(ang); sinA[i] = sinf(ang); }
        for (size_t i = gtid; i < (size_t)T * 32; i += gthreads) { const int t = (int)(i >> 5), k = (int)(i & 31);
            const float invf = powf(10000.0f, -(float)(2 * k) / 64.0f); const float ang = (float)in_pos[t] * invf;
            cosB[i] = cosf(ang); sinB[i] = sinf(ang); }
        if (BOTH(1)) GRID_BAR();
    }

    for (int layer = 0; layer < DEPTH; ++layer) {
        const int pb = 2 + 8 * layer;
        unsigned char* const wl = ws + WS_W + (size_t)layer * W_LAYER;
        bf16* const ZB = (bf16*)dout;
        float* const kmean = (float*)(ws + WS_KMEAN) + (size_t)layer * NB * NH * 16 * 128;
        const float lambda_init = layer == 0 ? 0.2f : 0.3555090675909306f;
#define PHASE_TID() int llane_ = lane_id(); asm volatile("" : "+v"(llane_)); const int llane = llane_, ltid = llane_ + 64 * F.wave
        if (IN(pb)) {
            const bf16* const XI8 = (const bf16*)(ws + WS_XI8); const float* const sx = (const float*)(ws + WS_SX); const float* const sw = (const float*)(ws + WS_SW) + layer * 10240;
            { pg8::Gemm g{XI8, (const bf16*)(wl + WO_MAIN), T, NMAIN, 1024}; pg8::StaticOrder S; S.init(T, NMAIN, F.G, (int)blockIdx.x);
              pg8::EpiInProjI8 E{(bf16*)(ws + WS_QA), (bf16*)(ws + WS_KA), (bf16*)(ws + WS_QD), (bf16*)(ws + WS_KD), (bf16*)(ws + WS_GA), (bf16*)(ws + WS_GB), cosA, sinA, cosB, sinB, QSCALE_A, QSCALE_B, sx, sw};
              pg8::gemm_phase<pg8::EpiInProjI8, pg8::StaticOrder, MK_ALIGN, MK_SP2, false, true>(F.lds, g, S, E, F.wave); }
            { pg8::Gemm g{(const bf16*)(wl + WO_V), XI8, NV, T, 1024}; pg8::StaticOrder S; S.init(NV, T, F.G, (int)blockIdx.x);
              pg8::EpiPlainI8 E{(bf16*)(ws + WS_VT), T, sw + NMAIN, sx};
              pg8::gemm_phase<pg8::EpiPlainI8, pg8::StaticOrder, MK_ALIGN, MK_SP2, false, true>(F.lds, g, S, E, F.wave); }
            if (BOTH(pb)) GRID_BAR();
        }
        if (IN(pb + 1)) {
            PHASE_TID();
            LAS float* part = (LAS float*)F.lds;
            const bf16* KA = (const bf16*)(ws + WS_KA);
#pragma unroll 1
            for (int item = F.vcu; item < NB * NH * 16; item += F.G) {
                const int b = item >> 7, h = (item >> 4) & 7, blk = item & 15;
                const int c = ltid & 15, rg = ltid >> 4;
                const bf16* kp = KA + (size_t)(b * SEQ + blk * 256 + rg) * 1024 + h * 128 + c * 8;
                float sacc[8] = {0.f, 0.f, 0.f, 0.f, 0.f, 0.f, 0.f, 0.f};
#pragma unroll
                for (int i = 0; i < 8; ++i) { const v4u w = *(const GAS v4u*)(kp + (size_t)(32 * i) * 1024);
                    sacc[0] += bf_lo(w.x); sacc[1] += bf_hi(w.x); sacc[2] += bf_lo(w.y); sacc[3] += bf_hi(w.y); sacc[4] += bf_lo(w.z); sacc[5] += bf_hi(w.z); sacc[6] += bf_lo(w.w); sacc[7] += bf_hi(w.w); }
#pragma unroll
                for (int j = 0; j < 8; ++j) part[rg * 128 + c * 8 + j] = sacc[j];
                __syncthreads();
                if (ltid < 128) { float t = 0.f;
#pragma unroll
                    for (int r = 0; r < 32; ++r) t += part[r * 128 + ltid];
                    kmean[(size_t)item * 128 + ltid] = t; }
                __syncthreads();
            }
            if (BOTH(pb + 1)) GRID_BAR();
        }
        if (IN(pb + 2)) {
            PHASE_TID();
            const float* lp = in_dlam + (size_t)layer * 256;
            const float s1 = wave_sum(lp[llane] * lp[64 + llane]), s2 = wave_sum(lp[128 + llane] * lp[192 + llane]);
            float lam = __builtin_bit_cast(float, __builtin_amdgcn_readfirstlane(__builtin_bit_cast(int, expf(s1) - expf(s2) + lambda_init))), oml = __builtin_bit_cast(float, __builtin_amdgcn_readfirstlane(layer == 0 ? 0x3f4ccccd : 0x3f24fd5c));
            att::AttnArgs A{(const bf16*)(ws + WS_QA), (const bf16*)(ws + WS_KA), (const bf16*)(ws + WS_QD), (const bf16*)(ws + WS_KD), (const bf16*)(ws + WS_VT),
                            (bf16*)(ws + WS_OA), kmean, in_dgain + (size_t)layer * 1024, lam, oml};
            att::attn_phase(F.lds, A, F.vcu, F.G, ltid, F.wave, llane);
            if (BOTH(pb + 2)) GRID_BAR();
        }
        if (IN(pb + 3)) {
            { pg8::Gemm g{(const bf16*)(ws + WS_OA), (const bf16*)(wl + WO_A), T, 2048, 2048}; pg8::StaticOrder S; S.init(T, 2048, F.G, (int)blockIdx.x);
              pg8::EpiBranch E{(const bf16*)(ws + WS_GA), (const bf16*)(ws + WS_GB), (bf16*)(ws + WS_MERGED), 2048};
              pg8::gemm_phase<pg8::EpiBranch, pg8::StaticOrder, MK_ALIGN, MK_SP2, true>(F.lds, g, S, E, F.wave); }
            if (BOTH(pb + 3)) GRID_BAR();
        }
        if (IN(pb + 4)) {
            pg8::Gemm g{(const bf16*)(ws + WS_MERGED), (const bf16*)(wl + WO_O), T, 2048, 2048}; pg8::StaticOrder S; S.init(T, 2048, F.G, (int)blockIdx.x);
            pg8::EpiOutProj E{XB, ZB, 2048, ALPHA};
            pg8::gemm_phase<pg8::EpiOutProj, pg8::StaticOrder, MK_ALIGN, MK_SP2>(F.lds, g, S, E, F.wave);
            if (BOTH(pb + 4)) GRID_BAR();
        }
        if (IN(pb + 5)) {
            PHASE_TID();
            const int gw = F.vcu * NWAVES + F.wave, NGW = F.G * NWAVES;
            for (int m = gw; m < T; m += NGW) ln_row(ZB + (size_t)m * 2048, in_ln1g + (size_t)layer * 2048, in_ln1b + (size_t)layer * 2048, XB + (size_t)m * 2048, llane);
            if (BOTH(pb + 5)) GRID_BAR();
        }
        if (IN(pb + 6)) {
            pg8::Gemm g{XB, (const bf16*)(wl + WO_Q), T, 2048, 2048}; pg8::StaticOrder S; S.init(T, 2048, F.G, (int)blockIdx.x);
            pg8::EpiPlainBf16 E{(bf16*)(ws + WS_PQ), 2048};
            pg8::gemm_phase<pg8::EpiPlainBf16, pg8::StaticOrder, MK_ALIGN, MK_SP2>(F.lds, g, S, E, F.wave);
            if (BOTH(pb + 6)) GRID_BAR();
        }
        if (IN(pb + 7)) {
            const unsigned char* TU = ws + WS_TAB + (size_t)(2 * layer) * TAB_BYTES; const unsigned char* TV = ws + WS_TAB + (size_t)(2 * layer + 1) * TAB_BYTES;
            const float* SU = (const float*)(ws + WS_TSC) + (size_t)(2 * layer) * NEXP; const float* SV = SU + NEXP;
            const bf16* sk = (const bf16*)(ws + WS_SK) + (size_t)layer * 2 * 8 * 128 * 128;
            const bool last = (layer == DEPTH - 1);
            PHASE_TID();
#pragma unroll 1
            for (int tile = F.vcu; tile < T / 32; tile += F.G) {
                const int t0 = tile * 32;
                peer::select_tile(F.lds, (const bf16*)(ws + WS_PQ), sk, t0, F.wave, llane);
                __syncthreads();
                v4u ring[16];
#pragma unroll
                for (int s = 0; s < 16; ++s) ring[s] = (v4u){0u, 0u, 0u, 0u};
#pragma unroll 1
                for (int i = 0; i < 4; ++i) { const int tl = F.wave * 4 + i; const size_t t = (size_t)(t0 + tl);
                    peer::token_ffn(F.lds, tl, XB + t * 2048, TU, TV, SU, SV, in_ln2g + (size_t)layer * 2048, in_ln2b + (size_t)layer * 2048, last ? dout + t * 2048 : (float*)nullptr, last ? (bf16*)nullptr : XB + t * 2048, ws + WS_XI8 + t * 2048, (float*)(ws + WS_SX) + t, llane, ring, i > 0, i < 3); }
                __syncthreads();
            }
            if (BOTH(pb + 7)) GRID_BAR();
        }
    }
#undef PHASE_TID
#undef IN
#undef BOTH
#undef GRID_BAR
}

#if MK_CHECK
__global__ void __launch_bounds__(NWAVES * 64, 2) chk_kernel(Params args, int layer, int which) {
    extern __shared__ __attribute__((aligned(16))) unsigned char lds_raw[];
    LAS unsigned char* lds = (LAS unsigned char*)lds_raw;
    const int tid = threadIdx.x, lane = tid & 63, wave = __builtin_amdgcn_readfirstlane(tid >> 6), G = gridDim.x, vcu = blockIdx.x;
    unsigned char* const ws = args.ws; gu32* ctl = (gu32*)(ws + WS_CTL);
    const bf16* xresb = (const bf16*)(ws + WS_XB);
    float* const kmean = (float*)(ws + WS_KMEAN) + (size_t)layer * NB * NH * 16 * 128;
    const float lambda_init = layer == 0 ? 0.2f : 0.3555090675909306f;
    const int gw = vcu * NWAVES + wave, NGW = G * NWAVES;
    if (which == 0) {
        const float* lp = args.in[6] + (size_t)layer * 256;
        const float s1 = wave_sum(lp[lane] * lp[64 + lane]), s2 = wave_sum(lp[128 + lane] * lp[192 + lane]);
        const float lam = expf(s1) - expf(s2) + lambda_init;
        att::AttnArgs A{(const bf16*)(ws + WS_QA), (const bf16*)(ws + WS_KA), (const bf16*)(ws + WS_QD), (const bf16*)(ws + WS_KD), (const bf16*)(ws + WS_VT),
                        (bf16*)(ws + WS_OA), kmean, args.in[7] + (size_t)layer * 1024, lam, 1.0f - lambda_init};
        chk::check_inproj(ctl, xresb, (const int*)args.in[1], args.in[2] + (size_t)layer * 2048 * 10240, A.qa, A.ka, A.qd, A.kd, A.vt, (const bf16*)(ws + WS_GA), (const bf16*)(ws + WS_GB), gw, NGW, lane);
        chk::check_kmean(ctl, A.ka, kmean, gw, NGW, lane);
        chk::check_attn(lds, ctl, A, vcu, G, tid, lane, wave);
    } else if (which == 3) {
        const float oscale = 1.0f + 0.04f * (float)__hip_atomic_load(ctl + chk::CW_ERR + 64, RLX_AGENT);
        for (size_t i = (size_t)vcu * 512 + tid; i < (size_t)T * 2048 / 4; i += (size_t)G * 512) { f32x4 v = *(GAS f32x4*)(args.out + i * 4); v = v * oscale; *(GAS f32x4*)(args.out + i * 4) = v; }
    } else if (which == 2) {
        if (vcu == 0 && tid == 0) { const float tol[6] = {1e-3f, 1e-4f, 3e-2f, 3e-3f, 1e-3f, 1e-3f}; unsigned code = 0;
            for (int st = 0; st < 6; ++st) { const float d2 = __builtin_bit_cast(float, __hip_atomic_load(ctl + chk::CW_ERR + 2 * st, RLX_AGENT)), r2 = __builtin_bit_cast(float, __hip_atomic_load(ctl + chk::CW_ERR + 2 * st + 1, RLX_AGENT));
                if (!(d2 <= tol[st] * r2) || !(r2 > 0.f)) code |= 1u << st; }
#ifdef MK_CHECK_STAGE
            { const float d2 = __builtin_bit_cast(float, __hip_atomic_load(ctl + chk::CW_ERR + 2 * MK_CHECK_STAGE, RLX_AGENT)), r2 = __builtin_bit_cast(float, __hip_atomic_load(ctl + chk::CW_ERR + 2 * MK_CHECK_STAGE + 1, RLX_AGENT));
              float ratio = d2 / r2; ratio = fminf(fmaxf(ratio, 1e-8f), 1e4f); code = (unsigned)(int)(4.0f * (log10f(ratio) + 8.0f) + 0.5f); }
#endif
            __hip_atomic_store(ctl + chk::CW_ERR + 64, code, RLX_AGENT); }
    } else {
        chk::check_merged(ctl, (const bf16*)(ws + WS_OA), (const bf16*)(ws + WS_GA), (const bf16*)(ws + WS_GB), (const bf16*)(ws + WS_MERGED), args.in[3] + (size_t)layer * 1024 * 2048, args.in[4] + (size_t)layer * 1024 * 2048, gw, NGW, lane);
        chk::check_z(ctl, (const bf16*)(ws + WS_MERGED), args.in[5] + (size_t)layer * 2048 * 2048, xresb, (const bf16*)args.out, gw, NGW, lane);
    }
}
#endif

extern "C" void kernel_launch(void* const* d_in, const int* in_sizes, int n_in, void* d_out, int out_size, void* d_ws, size_t ws_size, hipStream_t stream) {
    static int grid = 0;
    if (grid == 0) {
        if (n_in != 16 || out_size != T * DM || ws_size < WS_END) { fprintf(stderr, "kernel_launch: unexpected problem (n_in %d, out %d, ws %zu < %zu); nothing launched\n", n_in, out_size, ws_size, (size_t)WS_END); grid = -1; return; }
        int dev = 0, cus = 0, per_cu = 0;
        if (hipGetDevice(&dev) != hipSuccess || hipDeviceGetAttribute(&cus, hipDeviceAttributeMultiprocessorCount, dev) != hipSuccess) { fprintf(stderr, "kernel_launch: device query failed\n"); grid = -1; return; }
#if MK_CHECK
        (void)hipFuncSetAttribute((const void*)chk_kernel, hipFuncAttributeMaxDynamicSharedMemorySize, LDS_BYTES);
#endif
        if (hipFuncSetAttribute((const void*)mk_fwd, hipFuncAttributeMaxDynamicSharedMemorySize, LDS_BYTES) != hipSuccess) { fprintf(stderr, "kernel_launch: hipFuncSetAttribute failed\n"); grid = -1; return; }
        if (hipOccupancyMaxActiveBlocksPerMultiprocessor(&per_cu, (const void*)mk_fwd, NWAVES * 64, LDS_BYTES) != hipSuccess || per_cu < 1) { fprintf(stderr, "kernel_launch: occupancy query says %d blocks per CU; nothing launched\n", per_cu); (void)hipGetLastError(); grid = -1; return; }
        grid = cus;
    }
    if (grid < 0) return;
    (void)hipMemsetAsync((char*)d_ws + WS_CTL, 0, CTL_ZERO_BYTES, stream);
    Params a{};
    for (int i = 0; i < 16; ++i) a.in[i] = (const float*)d_in[i];
    a.out = (float*)d_out; a.ws = (unsigned char*)d_ws;
#if MK_FUSED
    a.ph_lo = 0; a.ph_hi = NPHASE;
    hipLaunchKernelGGL(mk_fwd, dim3(grid), dim3(NWAVES * 64), LDS_BYTES, stream, a);
#else
    for (int ph = 0; ph < NPHASE; ++ph) { a.ph_lo = ph; a.ph_hi = ph + 1; hipLaunchKernelGGL(mk_fwd, dim3(grid), dim3(NWAVES * 64), LDS_BYTES, stream, a);
#if MK_CHECK
        if (ph == 2 + 8 * MK_CHECK_LAYER + 2) hipLaunchKernelGGL(chk_kernel, dim3(grid), dim3(NWAVES * 64), LDS_BYTES, stream, a, (int)MK_CHECK_LAYER, 0);
        if (ph == 2 + 8 * MK_CHECK_LAYER + 4) hipLaunchKernelGGL(chk_kernel, dim3(grid), dim3(NWAVES * 64), LDS_BYTES, stream, a, (int)MK_CHECK_LAYER, 1);
        if (ph == NPHASE - 2) hipLaunchKernelGGL(chk_kernel, dim3(grid), dim3(NWAVES * 64), LDS_BYTES, stream, a, (int)MK_CHECK_LAYER, 2);
        if (ph == NPHASE - 1) hipLaunchKernelGGL(chk_kernel, dim3(grid), dim3(NWAVES * 64), LDS_BYTES, stream, a, (int)MK_CHECK_LAYER, 3);
#endif
    }
#endif
}
```

```cpp
#include <hip/hip_runtime.h>
#include <cstdio>
#include <cstdint>

#ifndef MK_FUSED
#define MK_FUSED 1
#endif
#ifndef MK_CHECK
#define MK_CHECK 0
#endif
#ifndef MK_CHECK_LAYER
#define MK_CHECK_LAYER 0
#endif

namespace cfg {
constexpr int DM = 2048, NB = 4, SEQ = 4096, T = NB * SEQ, DEPTH = 2;
constexpr int NH = 8, HD = 128, AW = NH * HD;
constexpr int INC = 10240;
constexpr int NMAIN = 8192, NV = 2048;
constexpr int PH = 8, PKEYS = 128, PTOP = 16, NEXP = PKEYS * PKEYS, PHALF = 128;
constexpr float LN_EPS = 1e-5f, RMS_EPS = 1e-6f;
constexpr float ALPHA = 1.4142135623730951f;
constexpr float LOG2E = 1.4426950408889634f;
constexpr float QSCALE_A = 0.08838834764831845f * LOG2E;
constexpr float QSCALE_B = 0.125f * LOG2E;
}
using namespace cfg;

constexpr size_t MiB = 1u << 20;
constexpr size_t WS_CTL = 0, CTL_ZERO_BYTES = 1 * MiB;
constexpr size_t WS_SK = 1 * MiB;
constexpr size_t WS_KMEAN = 2 * MiB;
constexpr size_t WS_TSC = 3 * MiB;
constexpr size_t WS_ROPE = 4 * MiB;
constexpr size_t WS_W = 20 * MiB, W_LAYER = 64 * MiB;
constexpr size_t WO_MAIN = 0, WO_V = 16 * MiB, WO_A = 40 * MiB, WO_O = 48 * MiB, WO_Q = 56 * MiB;
constexpr size_t WS_TAB = 148 * MiB, TAB_BYTES = 16 * MiB;
constexpr size_t WS_XI8 = 212 * MiB;
constexpr size_t WS_SX = 244 * MiB;
constexpr size_t WS_SW = 245 * MiB;
constexpr size_t WS_PSCR = 248 * MiB;
constexpr size_t WS_XB = 404 * MiB;
constexpr size_t WS_QA = 596 * MiB, WS_KA = 628 * MiB, WS_QD = 660 * MiB, WS_KD = 692 * MiB;
constexpr size_t WS_PQ = WS_QA;
constexpr size_t WS_VT = 724 * MiB;
constexpr size_t WS_MERGED = WS_VT;
constexpr size_t WS_GA = 788 * MiB, WS_GB = 852 * MiB;
constexpr size_t WS_OA = 916 * MiB;
constexpr size_t WS_END = 980 * MiB;

constexpr int CW_BAR = 4096;
constexpr int CW_WMAX = 16384;

constexpr int RING_BYTES = 131072;
constexpr int LDSCTL_OFF = RING_BYTES, MISC_OFF = LDSCTL_OFF + 320;
constexpr int LDS_BYTES = 147456;
constexpr int NWAVES = 8;

#define GAS __attribute__((address_space(1)))
#define LAS __attribute__((address_space(3)))
typedef unsigned short bf16;
typedef unsigned v4u __attribute__((ext_vector_type(4)));
typedef unsigned v2u __attribute__((ext_vector_type(2)));
typedef float f32x4 __attribute__((ext_vector_type(4)));
typedef float f32x16 __attribute__((ext_vector_type(16)));
typedef short bf16x8 __attribute__((ext_vector_type(8)));
typedef GAS unsigned gu32;
#define RLX_AGENT __ATOMIC_RELAXED, __HIP_MEMORY_SCOPE_AGENT
#define LDS_WAIT() asm volatile("s_waitcnt lgkmcnt(0)" ::: "memory")
#define VM_WAIT() asm volatile("s_waitcnt vmcnt(0)" ::: "memory")
__device__ __forceinline__ unsigned f2bf(float f) { unsigned u = __builtin_bit_cast(unsigned, f); return (u + 0x7fffu + ((u >> 16) & 1u)) >> 16; }
__device__ __forceinline__ unsigned pk2(float lo, float hi) { return f2bf(lo) | (f2bf(hi) << 16); }
__device__ __forceinline__ float bf_lo(unsigned w) { return __builtin_bit_cast(float, w << 16); }
__device__ __forceinline__ float bf_hi(unsigned w) { return __builtin_bit_cast(float, w & 0xffff0000u); }
__device__ __forceinline__ float fexp2(float x) { return __builtin_amdgcn_exp2f(x); }
__device__ __forceinline__ float frcp(float x) { return __builtin_amdgcn_rcpf(x); }
__device__ __forceinline__ int lane_id() { return (int)__builtin_amdgcn_mbcnt_hi(~0u, __builtin_amdgcn_mbcnt_lo(~0u, 0u)); }
__device__ __forceinline__ float wave_sum(float v) {
#pragma unroll
    for (int o = 1; o < 64; o <<= 1) v += __shfl_xor(v, o);
    return v;
}
namespace pg8 {
#define PG8_LAS __attribute__((address_space(3)))
typedef unsigned short bf16_t;
typedef short bf16x8 __attribute__((ext_vector_type(8)));
typedef float f32x4 __attribute__((ext_vector_type(4)));
typedef unsigned u32x4 __attribute__((ext_vector_type(4)));
typedef int i32x4 __attribute__((ext_vector_type(4)));
constexpr int BM = 256, BK = 64, HALF = 128, HTB = HALF * BK * 2  , STAGE_BYTES = 8 * HTB, NXCD = 8, WGM = 8;

__host__ __device__ __forceinline__ int lds_byte(int r, int c) { const int st = (r >> 4) * 2 + (c >> 5), rr = r & 15, cc = c & 31, ob = rr * 64 + cc * 2; return st * 1024 + (ob ^ (((ob >> 9) & 1) << 5)); }
__host__ __device__ __forceinline__ void stage_rc(int b, int& R, int& C) { const int st = b / 1024, sb = b % 1024, swz = sb ^ (((sb >> 9) & 1) << 5); R = (st >> 1) * 16 + swz / 64; C = (st & 1) * 32 + (swz % 64) / 2; }
__host__ __device__ __forceinline__ int perm32(int rho) { const int n = rho >> 4, i = rho & 15; return 8 * (i >> 2) + 4 * n + (i & 3); }

template <bool I8> struct AccSel { typedef f32x4 type; };
template <> struct AccSel<true> { typedef i32x4 type; };
template <bool I8> __device__ __forceinline__ typename AccSel<I8>::type mma16(const bf16x8& b, const bf16x8& a, const typename AccSel<I8>::type& c) {
    if constexpr (I8) return __builtin_amdgcn_mfma_i32_16x16x64_i8(__builtin_bit_cast(i32x4, b), __builtin_bit_cast(i32x4, a), c, 0, 0, 0);
    else return __builtin_amdgcn_mfma_f32_16x16x32_bf16(b, a, c, 0, 0, 0);
}
struct Unit { int pm, pn; };
struct Gemm { const bf16_t* A; const bf16_t* Bt; int M, N, K; };

struct StaticOrder {
    int nM, nN, nwg, G, c;
    __host__ __device__ void init(int M, int N, int G_, int c_) { nM = M / BM; nN = N / BM; nwg = nM * nN; G = G_; c = c_; }
    __host__ __device__ bool next(int i, Unit& u) const {
        const long L = (long)i * G + c; if (L >= nwg) return false;
        int wgid = (int)L; { const int q = nwg / NXCD, r = nwg % NXCD, xcd = wgid % NXCD, off = wgid / NXCD; wgid = (xcd < r ? xcd * (q + 1) : r * (q + 1) + (xcd - r) * q) + off; }
        const int nig = WGM * nN, gid = wgid / nig, fm = gid * WGM, gsz = (nM - fm) < WGM ? (nM - fm) : WGM;
        u.pm = fm + ((wgid % nig) % gsz); u.pn = (wgid % nig) / gsz; return true;
    }
    __device__ __forceinline__ void a_ready(const Unit&) const {}
    __device__ __forceinline__ void done(const Unit&) const {}
};

typedef float f32x2cv __attribute__((ext_vector_type(2))); typedef __bf16 bf16x2cv __attribute__((ext_vector_type(2)));
__device__ __forceinline__ unsigned cvt_pk_bf16(float lo, float hi) { f32x2cv v = {lo, hi}; bf16x2cv b = __builtin_convertvector(v, bf16x2cv); return __builtin_bit_cast(unsigned, b); }

typedef unsigned u32x2 __attribute__((ext_vector_type(2)));
struct EpiPlainBf16 {
    static constexpr bool PERM = true, AFTER_DRAIN = false;
    bf16_t* O; int ldc;
    __device__ __forceinline__ void operator()(const f32x4 (&acc)[2][2][4][2], const Unit& u, int wr, int wc, int fr_, int fq_) const {
        int fr = fr_, fq = fq_; asm volatile("" : "+v"(fr), "+v"(fq));
        const int row0 = u.pm * BM + wr * 64 + fr, col0 = u.pn * BM + wc * 32 + 8 * fq;
#pragma unroll
        for (int ai = 0; ai < 2; ++ai)
#pragma unroll
            for (int m = 0; m < 4; ++m) { bf16_t* rowp = O + (size_t)(row0 + ai * HALF + m * 16) * ldc + col0;
#pragma unroll
                for (int bj = 0; bj < 2; ++bj) { const f32x4 v0 = acc[ai][bj][m][0], v1 = acc[ai][bj][m][1];
                    u32x4 w; w.x = cvt_pk_bf16(v0[0], v0[1]); w.y = cvt_pk_bf16(v0[2], v0[3]); w.z = cvt_pk_bf16(v1[0], v1[1]); w.w = cvt_pk_bf16(v1[2], v1[3]);
                    *(u32x4*)(rowp + bj * HALF) = w; } }
    }
};
struct EpiBranch {
    static constexpr bool PERM = true, AFTER_DRAIN = false;
    const bf16_t* ga; const bf16_t* gb; bf16_t* O; int ldc;
    __device__ __forceinline__ void mid(f32x4 (&acc)[2][2][4][2], const Unit& u, int wr, int wc, int fr_, int fq_) const {
        int fr = fr_, fq = fq_; asm volatile("" : "+v"(fr), "+v"(fq));
        const int row0 = u.pm * BM + wr * 64 + fr, col0 = u.pn * BM + wc * 32 + 8 * fq;
#pragma unroll
        for (int ai = 0; ai < 2; ++ai)
#pragma unroll
            for (int m = 0; m < 4; ++m) { const size_t off = (size_t)(row0 + ai * HALF + m * 16) * ldc + col0;
#pragma unroll
                for (int bj = 0; bj < 2; ++bj) { const u32x2 a = *(const u32x2*)((const unsigned char*)ga + off + bj * HALF), b = *(const u32x2*)((const unsigned char*)gb + off + bj * HALF);
#define PG8_RATIO(x, y, k) ((float)(((x) >> (8 * (k))) & 255u) * __builtin_amdgcn_rcpf((float)(((y) >> (8 * (k))) & 255u)))
                    f32x4 r0, r1;
                    r0[0] = PG8_RATIO(a.x, b.x, 0); r0[1] = PG8_RATIO(a.x, b.x, 1); r0[2] = PG8_RATIO(a.x, b.x, 2); r0[3] = PG8_RATIO(a.x, b.x, 3);
                    r1[0] = PG8_RATIO(a.y, b.y, 0); r1[1] = PG8_RATIO(a.y, b.y, 1); r1[2] = PG8_RATIO(a.y, b.y, 2); r1[3] = PG8_RATIO(a.y, b.y, 3);
#undef PG8_RATIO
                    acc[ai][bj][m][0] = acc[ai][bj][m][0] * r0; acc[ai][bj][m][1] = acc[ai][bj][m][1] * r1; } }
    }
    __device__ __forceinline__ void operator()(const f32x4 (&acc)[2][2][4][2], const Unit& u, int wr, int wc, int fr_, int fq_) const {
        int fr = fr_, fq = fq_; asm volatile("" : "+v"(fr), "+v"(fq));
        const int row0 = u.pm * BM + wr * 64 + fr, col0 = u.pn * BM + wc * 32 + 8 * fq;
#pragma unroll
        for (int ai = 0; ai < 2; ++ai)
#pragma unroll
            for (int m = 0; m < 4; ++m) { const size_t off = (size_t)(row0 + ai * HALF + m * 16) * ldc + col0;
#pragma unroll
                for (int bj = 0; bj < 2; ++bj) { const u32x2 g = *(const u32x2*)((const unsigned char*)gb + off + bj * HALF);
                    const f32x4 v0 = acc[ai][bj][m][0], v1 = acc[ai][bj][m][1]; const float q = 1.0f / 255.0f;
                    f32x4 o0, o1;
                    o0[0] = v0[0] * ((float)(g.x & 255u) * q); o0[1] = v0[1] * ((float)((g.x >> 8) & 255u) * q); o0[2] = v0[2] * ((float)((g.x >> 16) & 255u) * q); o0[3] = v0[3] * ((float)(g.x >> 24) * q);
                    o1[0] = v1[0] * ((float)(g.y & 255u) * q); o1[1] = v1[1] * ((float)((g.y >> 8) & 255u) * q); o1[2] = v1[2] * ((float)((g.y >> 16) & 255u) * q); o1[3] = v1[3] * ((float)(g.y >> 24) * q);
                    u32x4 w; w.x = cvt_pk_bf16(o0[0], o0[1]); w.y = cvt_pk_bf16(o0[2], o0[3]); w.z = cvt_pk_bf16(o1[0], o1[1]); w.w = cvt_pk_bf16(o1[2], o1[3]);
                    *(u32x4*)(O + off + bj * HALF) = w; } }
    }
};
struct EpiOutProj {
    static constexpr bool PERM = true, AFTER_DRAIN = false;
    const bf16_t* xres; bf16_t* z; int ldc; float alpha;
    __device__ __forceinline__ void operator()(const f32x4 (&acc)[2][2][4][2], const Unit& u, int wr, int wc, int fr_, int fq_) const {
        int fr = fr_, fq = fq_; asm volatile("" : "+v"(fr), "+v"(fq));
        const int row0 = u.pm * BM + wr * 64 + fr, col0 = u.pn * BM + wc * 32 + 8 * fq;
#pragma unroll
        for (int ai = 0; ai < 2; ++ai)
#pragma unroll
            for (int m = 0; m < 4; ++m) { const size_t off = (size_t)(row0 + ai * HALF + m * 16) * ldc + col0;
#pragma unroll
                for (int bj = 0; bj < 2; ++bj) { const u32x4 x = *(const u32x4*)(xres + off + bj * HALF);
                    const f32x4 v0 = acc[ai][bj][m][0], v1 = acc[ai][bj][m][1];
                    f32x4 o0, o1;
                    o0[0] = v0[0] + alpha * __builtin_bit_cast(float, x.x << 16); o0[1] = v0[1] + alpha * __builtin_bit_cast(float, x.x & 0xffff0000u);
                    o0[2] = v0[2] + alpha * __builtin_bit_cast(float, x.y << 16); o0[3] = v0[3] + alpha * __builtin_bit_cast(float, x.y & 0xffff0000u);
                    o1[0] = v1[0] + alpha * __builtin_bit_cast(float, x.z << 16); o1[1] = v1[1] + alpha * __builtin_bit_cast(float, x.z & 0xffff0000u);
                    o1[2] = v1[2] + alpha * __builtin_bit_cast(float, x.w << 16); o1[3] = v1[3] + alpha * __builtin_bit_cast(float, x.w & 0xffff0000u);
                    u32x4 w; w.x = cvt_pk_bf16(o0[0], o0[1]); w.y = cvt_pk_bf16(o0[2], o0[3]); w.z = cvt_pk_bf16(o1[0], o1[1]); w.w = cvt_pk_bf16(o1[2], o1[3]);
                    *(u32x4*)(z + off + bj * HALF) = w; } }
    }
};
struct EpiInProj {
    static constexpr bool PERM = false, AFTER_DRAIN = false;
    bf16_t *qa, *ka, *qd, *kd, *ga, *gb; const float *cosA, *sinA, *cosB, *sinB; float qsa, qsb;
    __device__ __forceinline__ void operator()(const f32x4 (&acc)[2][2][4][2], const Unit& u, int wr, int wc, int fr_, int fq_) const {
        int fr = fr_, fq = fq_; asm volatile("" : "+v"(fr), "+v"(fq));
        const int row0 = u.pm * BM + wr * 64 + fr;
        const int ty = u.pn >> 2;
        if (ty >= 4) {
            unsigned char* dst = (unsigned char*)(ty < 6 ? ga : gb); const int col0 = (u.pn - (ty < 6 ? 16 : 24)) * BM + wc * 32 + 4 * fq; const float lo = ty < 6 ? 0.0f : 1.0f;
#pragma unroll
            for (int ai = 0; ai < 2; ++ai)
#pragma unroll
                for (int m = 0; m < 4; ++m) { unsigned char* rowp = dst + (size_t)(row0 + ai * HALF + m * 16) * 2048 + col0;
#pragma unroll
                    for (int bj = 0; bj < 2; ++bj)
#pragma unroll
                        for (int n = 0; n < 2; ++n) { const f32x4 v = acc[ai][bj][m][n]; unsigned w = 0u;
#pragma unroll
                            for (int j = 0; j < 4; ++j) { const float s = __builtin_amdgcn_rcpf(1.0f + __builtin_amdgcn_exp2f(-1.4426950408889634f * v[j]));
                                w |= (unsigned)fmaxf(s * 255.0f + 0.5f, lo) << (8 * j); }
                            *(unsigned*)(rowp + bj * HALF + n * 16) = w; } }
        } else if (ty < 2) {
            bf16_t* dst = ty == 0 ? qa : ka; const float sc = ty == 0 ? qsa : 1.0f;
            const int i0 = 16 * wc + 4 * fq;
#pragma unroll
            for (int ai = 0; ai < 2; ++ai)
#pragma unroll
                for (int m = 0; m < 4; ++m) { const int row = row0 + ai * HALF + m * 16;
                    const f32x4 c = *(const f32x4*)(cosA + (size_t)row * 64 + i0), s = *(const f32x4*)(sinA + (size_t)row * 64 + i0);
#pragma unroll
                    for (int bj = 0; bj < 2; ++bj) { const int head = 2 * (u.pn & 3) + bj; const f32x4 t1 = acc[ai][bj][m][0], t2 = acc[ai][bj][m][1];
                        const f32x4 o1 = t1 * c - t2 * s, o2 = t1 * s + t2 * c;
                        bf16_t* p = dst + (size_t)row * 1024 + head * 128 + i0;
                        u32x2 w1, w2; w1.x = cvt_pk_bf16(o1[0] * sc, o1[1] * sc); w1.y = cvt_pk_bf16(o1[2] * sc, o1[3] * sc); w2.x = cvt_pk_bf16(o2[0] * sc, o2[1] * sc); w2.y = cvt_pk_bf16(o2[2] * sc, o2[3] * sc);
                        *(u32x2*)p = w1; *(u32x2*)(p + 64) = w2;
                    } }
        } else {
            bf16_t* dst = ty == 2 ? qd : kd; const float sc = ty == 2 ? qsb : 1.0f;
            const int comp = wc >> 1, i0 = 16 * (wc & 1) + 4 * fq;
#pragma unroll
            for (int ai = 0; ai < 2; ++ai)
#pragma unroll
                for (int m = 0; m < 4; ++m) { const int row = row0 + ai * HALF + m * 16;
                    const f32x4 c = *(const f32x4*)(cosB + (size_t)row * 32 + i0), s = *(const f32x4*)(sinB + (size_t)row * 32 + i0);
#pragma unroll
                    for (int bj = 0; bj < 2; ++bj) { const int head = 2 * (u.pn & 3) + bj; const f32x4 t1 = acc[ai][bj][m][0], t2 = acc[ai][bj][m][1];
                        const f32x4 o1 = (t1 * c - t2 * s) * sc, o2 = (t1 * s + t2 * c) * sc;
                        bf16_t* p = dst + (size_t)row * 1024 + head * 128 + comp * 64 + i0;
                        u32x2 w1, w2; w1.x = cvt_pk_bf16(o1[0], o1[1]); w1.y = cvt_pk_bf16(o1[2], o1[3]); w2.x = cvt_pk_bf16(o2[0], o2[1]); w2.y = cvt_pk_bf16(o2[2], o2[3]);
                        *(u32x2*)p = w1; *(u32x2*)(p + 32) = w2;
                    } }
        }
    }
};

__device__ __forceinline__ f32x4 deq4(const i32x4& a, const f32x4& s) { return (f32x4){(float)a[0], (float)a[1], (float)a[2], (float)a[3]} * s; }
struct EpiPlainI8 {
    static constexpr bool PERM = true, AFTER_DRAIN = false;
    bf16_t* O; int ldc; const float* srow; const float* scol;
    __device__ __forceinline__ void operator()(const i32x4 (&acc)[2][2][4][2], const Unit& u, int wr, int wc, int fr_, int fq_) const {
        int fr = fr_, fq = fq_; asm volatile("" : "+v"(fr), "+v"(fq));
        const int row0 = u.pm * BM + wr * 64 + fr, col0 = u.pn * BM + wc * 32 + 8 * fq;
        f32x4 cs[2][2];
#pragma unroll
        for (int bj = 0; bj < 2; ++bj)
#pragma unroll
            for (int n = 0; n < 2; ++n) cs[bj][n] = *(const f32x4*)(scol + col0 + bj * HALF + 4 * n);
#pragma unroll
        for (int ai = 0; ai < 2; ++ai)
#pragma unroll
            for (int m = 0; m < 4; ++m) { const int row = row0 + ai * HALF + m * 16; const float sr = srow[row]; bf16_t* rowp = O + (size_t)row * ldc + col0;
#pragma unroll
                for (int bj = 0; bj < 2; ++bj) { const f32x4 v0 = deq4(acc[ai][bj][m][0], cs[bj][0] * sr), v1 = deq4(acc[ai][bj][m][1], cs[bj][1] * sr);
                    u32x4 w; w.x = cvt_pk_bf16(v0[0], v0[1]); w.y = cvt_pk_bf16(v0[2], v0[3]); w.z = cvt_pk_bf16(v1[0], v1[1]); w.w = cvt_pk_bf16(v1[2], v1[3]);
                    *(u32x4*)(rowp + bj * HALF) = w; } }
    }
};
struct EpiInProjI8 {
    static constexpr bool PERM = false, AFTER_DRAIN = false;
    bf16_t *qa, *ka, *qd, *kd, *ga, *gb; const float *cosA, *sinA, *cosB, *sinB; float qsa, qsb; const float *sx, *sw;
    __device__ __forceinline__ void operator()(const i32x4 (&acc)[2][2][4][2], const Unit& u, int wr, int wc, int fr_, int fq_) const {
        int fr = fr_, fq = fq_; asm volatile("" : "+v"(fr), "+v"(fq));
        const int row0 = u.pm * BM + wr * 64 + fr;
        const int ty = u.pn >> 2;
        f32x4 cs[2][2];
#pragma unroll
        for (int bj = 0; bj < 2; ++bj)
#pragma unroll
            for (int n = 0; n < 2; ++n) cs[bj][n] = *(const f32x4*)(sw + u.pn * BM + bj * HALF + wc * 32 + n * 16 + 4 * fq);
        if (ty >= 4) {
            unsigned char* dst = (unsigned char*)(ty < 6 ? ga : gb); const int col0 = (u.pn - (ty < 6 ? 16 : 24)) * BM + wc * 32 + 4 * fq; const float lo = ty < 6 ? 0.0f : 1.0f;
#pragma unroll
            for (int ai = 0; ai < 2; ++ai)
#pragma unroll
                for (int m = 0; m < 4; ++m) { const int row = row0 + ai * HALF + m * 16; const float sr = sx[row] * -1.4426950408889634f; unsigned char* rowp = dst + (size_t)row * 2048 + col0;
#pragma unroll
                    for (int bj = 0; bj < 2; ++bj)
#pragma unroll
                        for (int n = 0; n < 2; ++n) { const f32x4 v = deq4(acc[ai][bj][m][n], cs[bj][n] * sr); unsigned w = 0u;
#pragma unroll
                            for (int j = 0; j < 4; ++j) { const float s = __builtin_amdgcn_rcpf(1.0f + __builtin_amdgcn_exp2f(v[j]));
                                w |= (unsigned)fmaxf(s * 255.0f + 0.5f, lo) << (8 * j); }
                            *(unsigned*)(rowp + bj * HALF + n * 16) = w; } }
        } else if (ty < 2) {
            bf16_t* dst = ty == 0 ? qa : ka; const float sc = ty == 0 ? qsa : 1.0f;
            const int i0 = 16 * wc + 4 * fq;
#pragma unroll
            for (int ai = 0; ai < 2; ++ai)
#pragma unroll
                for (int m = 0; m < 4; ++m) { const int row = row0 + ai * HALF + m * 16; const float sr = sx[row] * sc;
                    const f32x4 c = *(const f32x4*)(cosA + (size_t)row * 64 + i0), s = *(const f32x4*)(sinA + (size_t)row * 64 + i0);
#pragma unroll
                    for (int bj = 0; bj < 2; ++bj) { const int head = 2 * (u.pn & 3) + bj; const f32x4 t1 = deq4(acc[ai][bj][m][0], cs[bj][0] * sr), t2 = deq4(acc[ai][bj][m][1], cs[bj][1] * sr);
                        const f32x4 o1 = t1 * c - t2 * s, o2 = t1 * s + t2 * c;
                        bf16_t* p = dst + (size_t)row * 1024 + head * 128 + i0;
                        u32x2 w1, w2; w1.x = cvt_pk_bf16(o1[0], o1[1]); w1.y = cvt_pk_bf16(o1[2], o1[3]); w2.x = cvt_pk_bf16(o2[0], o2[1]); w2.y = cvt_pk_bf16(o2[2], o2[3]);
                        *(u32x2*)p = w1; *(u32x2*)(p + 64) = w2;
                    } }
        } else {
            bf16_t* dst = ty == 2 ? qd : kd; const float sc = ty == 2 ? qsb : 1.0f;
            const int comp = wc >> 1, i0 = 16 * (wc & 1) + 4 * fq;
#pragma unroll
            for (int ai = 0; ai < 2; ++ai)
#pragma unroll
                for (int m = 0; m < 4; ++m) { const int row = row0 + ai * HALF + m * 16; const float sr = sx[row] * sc;
                    const f32x4 c = *(const f32x4*)(cosB + (size_t)row * 32 + i0), s = *(const f32x4*)(sinB + (size_t)row * 32 + i0);
#pragma unroll
                    for (int bj = 0; bj < 2; ++bj) { const int head = 2 * (u.pn & 3) + bj; const f32x4 t1 = deq4(acc[ai][bj][m][0], cs[bj][0] * sr), t2 = deq4(acc[ai][bj][m][1], cs[bj][1] * sr);
                        const f32x4 o1 = t1 * c - t2 * s, o2 = t1 * s + t2 * c;
                        bf16_t* p = dst + (size_t)row * 1024 + head * 128 + comp * 64 + i0;
                        u32x2 w1, w2; w1.x = cvt_pk_bf16(o1[0], o1[1]); w1.y = cvt_pk_bf16(o1[2], o1[3]); w2.x = cvt_pk_bf16(o2[0], o2[1]); w2.y = cvt_pk_bf16(o2[2], o2[3]);
                        *(u32x2*)p = w1; *(u32x2*)(p + 32) = w2;
                    } }
        }
    }
};
template <class Epi, class Sched, bool ALIGN_EPI = false, bool SP2 = false, bool MID = false, bool I8 = false>
__device__ __forceinline__ void gemm_phase(PG8_LAS unsigned char* lds, const Gemm g, const Sched& S, const Epi& E, int wave) {
    int tid_ = lane_id(); asm volatile("" : "+v"(tid_)); tid_ += 64 * wave;
    const int tid = tid_, wid = __builtin_amdgcn_readfirstlane(tid >> 6), lane = tid & 63, wr = wid >> 2, wc = wid & 3, fr = lane & 15, fq = lane >> 4;
    const int K = g.K, nt = K / BK;
    unsigned voffA[2], voffB[2];
#pragma unroll
    for (int i = 0; i < 2; ++i) { int R, C; stage_rc(tid * 16 + i * 8192, R, C); const int Rb = Epi::PERM ? ((R & ~31) + perm32(R & 31)) : R;
        voffA[i] = (unsigned)(R * K + C) * 2u; voffB[i] = (unsigned)(Rb * K + C) * 2u; }
    const size_t kstep = (size_t)(BK * 2);
    const size_t hstep = (size_t)HALF * K * 2;
    const size_t tstep = 2 * hstep;
    const unsigned ldsw = (unsigned)wid * 1024u;
    const int aoff = lds_byte(wr * 64 + fr, fq * 8), boff = lds_byte(wc * 32 + fr, fq * 8);
#define PG8_SA(b, h) (((b) * 2 + (h)) * HTB)
#define PG8_SB(b, h) ((4 + (b) * 2 + (h)) * HTB)
#define PG8_STAGE(bufoff, gbase, voff) do { _Pragma("unroll") for (int _i = 0; _i < 2; ++_i) \
        __builtin_amdgcn_global_load_lds((const unsigned*)((const char*)(gbase) + (voff)[_i]), (PG8_LAS unsigned*)(lds + (bufoff) + ldsw + _i * 8192), 16, 0, 0); } while (0)
#define PG8_LDA(dst, b, h) do { _Pragma("unroll") for (int m = 0; m < 4; ++m) _Pragma("unroll") for (int k = 0; k < 2; ++k) dst[m][k] = *(const PG8_LAS bf16x8*)(lds + PG8_SA(b, h) + aoff + m * 2048 + k * 1024); } while (0)
#define PG8_LDB(dst, b, h) do { _Pragma("unroll") for (int n = 0; n < 2; ++n) _Pragma("unroll") for (int k = 0; k < 2; ++k) dst[n][k] = *(const PG8_LAS bf16x8*)(lds + PG8_SB(b, h) + boff + n * 2048 + k * 1024); } while (0)
#define PG8_MMA(ai, bj, At, Bt) do { __builtin_amdgcn_s_setprio(1); _Pragma("unroll") for (int m = 0; m < 4; ++m) _Pragma("unroll") for (int n = 0; n < 2; ++n) _Pragma("unroll") for (int k = 0; k < 2; ++k) \
        acc[ai][bj][m][n] = mma16<I8>(Bt[n][k], At[m][k], acc[ai][bj][m][n]); __builtin_amdgcn_s_setprio(0); } while (0)
#define PG8_WAIT_V(n) asm volatile("s_waitcnt vmcnt(" #n ")" ::: "memory")
#define PG8_WAIT_L(n) asm volatile("s_waitcnt lgkmcnt(" #n ")" ::: "memory")
#define PG8_BAR __builtin_amdgcn_s_barrier()
#define PG8_SCHED __builtin_amdgcn_sched_barrier(0)
    Unit cur, nxt; int ui = 0;
    if (!S.next(0, cur)) return;
    typedef typename AccSel<I8>::type acc_t;
    acc_t acc[2][2][4][2];
#pragma unroll
    for (int a = 0; a < 2; ++a)
#pragma unroll
        for (int b = 0; b < 2; ++b)
#pragma unroll
            for (int m = 0; m < 4; ++m)
#pragma unroll
                for (int n = 0; n < 2; ++n) acc[a][b][m][n] = (acc_t){0, 0, 0, 0};
    bf16x8 At[4][2], B0[2][2], B1[2][2];
    const char* cA = (const char*)g.A + (size_t)cur.pm * tstep; const char* cB = (const char*)g.Bt + (size_t)cur.pn * tstep;
    S.a_ready(cur);
    if constexpr (SP2) {
        PG8_STAGE(PG8_SB(0, 0), cB, voffB); PG8_STAGE(PG8_SB(0, 1), cB + hstep, voffB); PG8_STAGE(PG8_SA(0, 0), cA, voffA); PG8_STAGE(PG8_SA(0, 1), cA + hstep, voffA);
        if (wr == 1) PG8_BAR;
        PG8_WAIT_V(2); PG8_BAR;
        PG8_STAGE(PG8_SB(1, 0), cB + kstep, voffB); PG8_STAGE(PG8_SA(1, 0), cA + kstep, voffA); PG8_STAGE(PG8_SB(1, 1), cB + hstep + kstep, voffB);
        PG8_WAIT_V(6); PG8_BAR;
    } else {
        PG8_STAGE(PG8_SB(0, 0), cB, voffB); PG8_STAGE(PG8_SA(0, 0), cA, voffA); PG8_STAGE(PG8_SB(0, 1), cB + hstep, voffB); PG8_STAGE(PG8_SA(0, 1), cA + hstep, voffA);
        if (wr == 1) PG8_BAR;
        PG8_WAIT_V(4); PG8_BAR;
        PG8_STAGE(PG8_SB(1, 0), cB + kstep, voffB); PG8_STAGE(PG8_SA(1, 0), cA + kstep, voffA); PG8_STAGE(PG8_SB(1, 1), cB + hstep + kstep, voffB);
        PG8_WAIT_V(6); PG8_BAR;
    }
    for (;;) {
        const bool has_next = S.next(ui + 1, nxt);
        const char* nA = has_next ? (const char*)g.A + (size_t)nxt.pm * tstep : cA; const char* nB = has_next ? (const char*)g.Bt + (size_t)nxt.pn * tstep : cB;
        for (int t = 0; t < nt; t += 2) {
            if constexpr (MID) { if (t == nt / 2) E.mid(acc, cur, wr, wc, fr, fq); }
            const bool last = (t == nt - 2);
            const char* a1 = cA + (size_t)(t + 1) * kstep;
            const char* a2 = last ? nA : cA + (size_t)(t + 2) * kstep; const char* b2 = last ? nB : cB + (size_t)(t + 2) * kstep;
            const char* a3 = a2 + kstep; const char* b3 = b2 + kstep;
            if (last && has_next) S.a_ready(nxt);
            if constexpr (SP2) {
            PG8_LDB(B0, 0, 0); PG8_LDB(B1, 0, 1); PG8_SCHED; PG8_LDA(At, 0, 0); PG8_STAGE(PG8_SA(1, 1), a1 + hstep, voffA);
            PG8_WAIT_V(8); PG8_WAIT_L(0); PG8_BAR; PG8_MMA(0, 0, At, B0); PG8_MMA(0, 1, At, B1); PG8_BAR; PG8_SCHED;
            PG8_LDA(At, 0, 1); PG8_STAGE(PG8_SB(0, 0), b2, voffB); PG8_STAGE(PG8_SB(0, 1), b2 + hstep, voffB); PG8_STAGE(PG8_SA(0, 0), a2, voffA);
            PG8_WAIT_V(8); PG8_WAIT_L(0); PG8_BAR; PG8_MMA(1, 0, At, B0); PG8_MMA(1, 1, At, B1); PG8_BAR; PG8_SCHED;
            PG8_LDB(B0, 1, 0); PG8_LDB(B1, 1, 1); PG8_SCHED; PG8_LDA(At, 1, 0); PG8_STAGE(PG8_SA(0, 1), a2 + hstep, voffA);
            PG8_WAIT_V(8); PG8_WAIT_L(0); PG8_BAR; PG8_MMA(0, 0, At, B0); PG8_MMA(0, 1, At, B1); PG8_BAR; PG8_SCHED;
            PG8_LDA(At, 1, 1); PG8_STAGE(PG8_SB(1, 0), b3, voffB); PG8_STAGE(PG8_SB(1, 1), b3 + hstep, voffB); PG8_STAGE(PG8_SA(1, 0), a3, voffA);
            PG8_WAIT_V(8); PG8_WAIT_L(0); PG8_BAR; PG8_MMA(1, 0, At, B0); PG8_MMA(1, 1, At, B1); PG8_BAR; PG8_SCHED;
            } else {
            PG8_LDB(B0, 0, 0); PG8_SCHED; PG8_LDA(At, 0, 0); PG8_STAGE(PG8_SA(1, 1), a1 + hstep, voffA);
            PG8_WAIT_L(8); PG8_BAR; PG8_WAIT_L(0); PG8_MMA(0, 0, At, B0); PG8_BAR; PG8_SCHED;
            PG8_LDB(B1, 0, 1); PG8_STAGE(PG8_SB(0, 0), b2, voffB);
            PG8_BAR; PG8_WAIT_L(0); PG8_MMA(0, 1, At, B1); PG8_BAR;
            PG8_LDA(At, 0, 1); PG8_STAGE(PG8_SA(0, 0), a2, voffA);
            PG8_BAR; PG8_WAIT_L(0); PG8_MMA(1, 0, At, B0); PG8_BAR; PG8_SCHED;
            PG8_STAGE(PG8_SB(0, 1), b2 + hstep, voffB);
            PG8_WAIT_V(6); PG8_BAR; PG8_MMA(1, 1, At, B1); PG8_BAR;
            PG8_LDB(B0, 1, 0); PG8_SCHED; PG8_LDA(At, 1, 0); PG8_STAGE(PG8_SA(0, 1), a2 + hstep, voffA);
            PG8_WAIT_L(8); PG8_BAR; PG8_WAIT_L(0); PG8_MMA(0, 0, At, B0); PG8_BAR; PG8_SCHED;
            PG8_LDB(B1, 1, 1); PG8_STAGE(PG8_SB(1, 0), b3, voffB);
            PG8_BAR; PG8_WAIT_L(0); PG8_MMA(0, 1, At, B1); PG8_BAR;
            PG8_LDA(At, 1, 1); PG8_STAGE(PG8_SA(1, 0), a3, voffA);
            PG8_BAR; PG8_WAIT_L(0); PG8_MMA(1, 0, At, B0); PG8_BAR; PG8_SCHED;
            PG8_STAGE(PG8_SB(1, 1), b3 + hstep, voffB);
            PG8_WAIT_V(6); PG8_BAR; PG8_MMA(1, 1, At, B1); PG8_BAR;
            }
        }
        if constexpr (ALIGN_EPI) { if (wr == 0) PG8_BAR; }
        if constexpr (!Epi::AFTER_DRAIN) { E(acc, cur, wr, wc, fr, fq); S.done(cur); }
        if (!has_next) break;
#pragma unroll
        for (int a = 0; a < 2; ++a)
#pragma unroll
            for (int b = 0; b < 2; ++b)
#pragma unroll
                for (int m = 0; m < 4; ++m)
#pragma unroll
                    for (int n = 0; n < 2; ++n) acc[a][b][m][n] = (acc_t){0, 0, 0, 0};
        cur = nxt; cA = nA; cB = nB; ++ui;
        if constexpr (ALIGN_EPI) { if (wr == 1) PG8_BAR; }
    }
    PG8_WAIT_V(0);
    if constexpr (!ALIGN_EPI) { if (wr == 0) PG8_BAR; }
    PG8_BAR;
    if constexpr (Epi::AFTER_DRAIN) { E.fused(acc, cur, wr, wc, fr, fq, lds, wid, lane); S.done(cur); }
#undef PG8_SA
#undef PG8_SB
#undef PG8_STAGE
#undef PG8_LDA
#undef PG8_LDB
#undef PG8_MMA
#undef PG8_WAIT_V
#undef PG8_WAIT_L
#undef PG8_BAR
#undef PG8_SCHED
}
}
#define XB_TMO      128
#define XB_XCNT(j)  (256  + 64 * (j))
#define XB_XSUB(j)  (1280 + 64 * (j))
#define XB_XGEN(j)  (2304 + 64 * (j))
#define XB_TOP      3328
#define XB_TOPGEN   3392
#define XCD_BAR_WORDS 3456
#define XB_SPIN_CAP (1u << 18)

__device__ __forceinline__ unsigned xb_ld(unsigned* p)              { return __hip_atomic_load(p, __ATOMIC_RELAXED, __HIP_MEMORY_SCOPE_AGENT); }
__device__ __forceinline__ unsigned xb_add(unsigned* p, unsigned v) { return __hip_atomic_fetch_add(p, v, __ATOMIC_RELAXED, __HIP_MEMORY_SCOPE_AGENT); }
__device__ __forceinline__ unsigned xb_xcc_id() { return (unsigned)__builtin_amdgcn_s_getreg((3 << 11) | 20) & 0xFu; }
#define XB_SPIN(cond, bar) do { unsigned _sp = 0; while (cond) { __builtin_amdgcn_s_sleep(1); \
    if ((++_sp & 255u) == 0u) { if (xb_ld(&(bar)[XB_TMO])) break; if (_sp > XB_SPIN_CAP) { atomicAdd(&(bar)[XB_TMO], 1u); break; } } } } while (0)

struct XcdBarrier {
    unsigned* bar; unsigned x; unsigned wv;
    volatile LAS unsigned* st;
};

__device__ __forceinline__ XcdBarrier xcd_barrier_post(unsigned* bar, volatile LAS unsigned* st, unsigned wave) {
    XcdBarrier b; b.bar = bar; b.x = xb_xcc_id(); b.st = st; b.wv = wave;
    if (threadIdx.x == 0) (void)xb_add(&bar[XB_XCNT(b.x)], 1u);
    return b;
}
__device__ __forceinline__ void xcd_barrier_complete(unsigned* bar, unsigned x, unsigned& nloc, unsigned& nx) {
    const unsigned G = gridDim.x * gridDim.y * gridDim.z;
    unsigned sum, cnt, mine, sp = 0u;
    for (;;) {
        sum = 0u; cnt = 0u; mine = 0u;
#pragma unroll 1
        for (unsigned j = 0; j < 16; ++j) { const unsigned c = xb_ld(&bar[XB_XCNT(j)]); sum += c; cnt += (c > 0u) ? 1u : 0u; mine = (j == x) ? c : mine; }
        if (sum == G) break;
        __builtin_amdgcn_s_sleep(1);
        if ((++sp & 255u) == 0u) { if (xb_ld(&bar[XB_TMO])) break; if (sp > XB_SPIN_CAP) { atomicAdd(&bar[XB_TMO], 1u); break; } }
    }
    nloc = mine > 0u ? mine : 1u; nx = cnt > 0u ? cnt : 1u;
}

__device__ __forceinline__ void xcd_barrier(const XcdBarrier& b) {
    asm volatile("s_waitcnt vmcnt(0)" ::: "memory");
    __syncthreads();
    if (b.wv == 0u && lane_id() == 0) {
        unsigned* bar = b.bar;
        __builtin_amdgcn_s_waitcnt(0);
        unsigned nloc = b.st[0], nx = b.st[1];
        if (nloc == 0u) { xcd_barrier_complete(bar, b.x, nloc, nx); b.st[0] = nloc; b.st[1] = nx; }
        const unsigned old = xb_add(&bar[XB_XSUB(b.x)], 1u);
        const unsigned gen = old / nloc;
        if (old + 1u == (gen + 1u) * nloc) {
            __builtin_amdgcn_fence(__ATOMIC_RELEASE, "agent");
            asm volatile("s_waitcnt vmcnt(0)" ::: "memory");
            const unsigned og = xb_add(&bar[XB_TOP], 1u);
            const unsigned tg = og / nx;
            if (og + 1u == (tg + 1u) * nx) xb_add(&bar[XB_TOPGEN], 1u);
            else XB_SPIN(xb_ld(&bar[XB_TOPGEN]) == tg, bar);
            __builtin_amdgcn_fence(__ATOMIC_ACQUIRE, "agent");
            xb_add(&bar[XB_XGEN(b.x)], 1u);
            asm volatile("s_waitcnt vmcnt(0)" ::: "memory");
        } else {
            XB_SPIN(xb_ld(&bar[XB_XGEN(b.x)]) == gen, bar);
            __builtin_amdgcn_fence(__ATOMIC_ACQUIRE, "agent");
            asm volatile("s_waitcnt vmcnt(0)" ::: "memory");
        }
    }
    __syncthreads();
}


struct Frame {
    LAS unsigned char* lds;
    volatile LAS unsigned* MISC;
    gu32* ctl;
    int tid, lane, wave;
    int vcu, G;
    unsigned char* ws;
};

__device__ __forceinline__ int inproj_row(int n) {
    const int seg = n >> 10, r = n & 1023;
    if (seg >= 6) return (seg < 8 ? 4096 : 6144) + (n - (seg < 8 ? 6144 : 8192));
    if (seg == 2) return 8192 + r;
    if (seg == 5) return 8192 + 1024 + r;
    const int head = r >> 7, d = r & 127;
    if (seg < 2) return seg * 1024 + head * 128 + 32 * ((d >> 4) & 3) + 16 * (d >> 6) + (d & 15);
    return (seg - 1) * 1024 + head * 128 + 32 * (2 * (d >> 6) + ((d >> 4) & 1)) + 16 * ((d >> 5) & 1) + (d & 15);
}
template <bool MAP>
__device__ __forceinline__ void p0_transpose_item(const float* W, int K, int N, bf16* WT, LAS float* scr, int item, int lane, int ldk = 0, int koff = 0) {
    if (ldk == 0) ldk = K;
    const int nblk = N / 32, kb = item / nblk, nb = item % nblk, k0 = 64 * kb, n0 = 32 * nb;
#pragma unroll 8
    for (int i = 0; i < 32; ++i) { const int kk = 2 * i + (lane >> 5); scr[kk * 33 + (lane & 31)] = W[(size_t)(k0 + kk) * N + n0 + (lane & 31)]; }
    LDS_WAIT(); asm volatile("" ::: "memory");
    const int c = lane & 7;
#pragma unroll
    for (int j = 0; j < 4; ++j) { const int n = (lane >> 3) + 8 * j; const LAS float* s = scr + (8 * c) * 33 + n;
        v4u o; o.x = pk2(s[0 * 33], s[1 * 33]); o.y = pk2(s[2 * 33], s[3 * 33]); o.z = pk2(s[4 * 33], s[5 * 33]); o.w = pk2(s[6 * 33], s[7 * 33]);
        const int dr = MAP ? inproj_row(n0 + n) : (n0 + n);
        *(GAS v4u*)(WT + (size_t)dr * ldk + koff + k0 + 8 * c) = o; }
    LDS_WAIT(); asm volatile("" ::: "memory");
}
__device__ __forceinline__ void p0_convert(const float* src, bf16* dst, size_t n8, size_t gtid, size_t gthreads) {
    for (size_t i = gtid; i < n8; i += gthreads) {
        const f32x4 a = *(const GAS f32x4*)(src + i * 8), b = *(const GAS f32x4*)(src + i * 8 + 4);
        v4u o; o.x = pk2(a[0], a[1]); o.y = pk2(a[2], a[3]); o.z = pk2(b[0], b[1]); o.w = pk2(b[2], b[3]);
        *(GAS v4u*)(dst + i * 8) = o;
    }
}

__device__ __forceinline__ void p0_table_row(const float* src, unsigned char* dst, float* scale_out, int lane) {
    f32x4 v[8]; float am = 0.f;
#pragma unroll
    for (int q = 0; q < 8; ++q) { v[q] = *(const GAS f32x4*)(src + 32 * lane + 4 * q);
        am = fmaxf(am, fmaxf(fmaxf(fabsf(v[q][0]), fabsf(v[q][1])), fmaxf(fabsf(v[q][2]), fabsf(v[q][3])))); }
#pragma unroll
    for (int o = 1; o < 64; o <<= 1) am = fmaxf(am, __shfl_xor(am, o));
    const float sc = am > 0.f ? 6.0f / am : 1.0f;
    v4u o;
#pragma unroll
    for (int wq = 0; wq < 4; ++wq) { unsigned w = 0u;
        w = __builtin_amdgcn_cvt_scalef32_pk_fp4_f32(w, v[2 * wq][0] * sc, v[2 * wq][1] * sc, 1.0f, 0);
        w = __builtin_amdgcn_cvt_scalef32_pk_fp4_f32(w, v[2 * wq][2] * sc, v[2 * wq][3] * sc, 1.0f, 1);
        w = __builtin_amdgcn_cvt_scalef32_pk_fp4_f32(w, v[2 * wq + 1][0] * sc, v[2 * wq + 1][1] * sc, 1.0f, 2);
        w = __builtin_amdgcn_cvt_scalef32_pk_fp4_f32(w, v[2 * wq + 1][2] * sc, v[2 * wq + 1][3] * sc, 1.0f, 3);
        o[wq] = w; }
    *(GAS v4u*)(dst + 16 * lane) = o;
    if (lane == 0) *scale_out = am > 0.f ? am / 6.0f : 1.0f;
}

__device__ __forceinline__ unsigned q8pack(float a, float b, float c, float d, float s) {
    const int ia = (int)__builtin_rintf(a * s), ib = (int)__builtin_rintf(b * s), ic = (int)__builtin_rintf(c * s), id = (int)__builtin_rintf(d * s);
    return ((unsigned)ia & 255u) | (((unsigned)ib & 255u) << 8) | (((unsigned)ic & 255u) << 16) | ((unsigned)id << 24);
}
__device__ __forceinline__ void p0_absmax_item(const float* W, int item, int lane, gu32* wmax) {
    const int kc = item / 40, nc = item % 40, n0 = 256 * nc + 4 * lane;
    const float* p = W + (size_t)(128 * kc) * 10240 + n0;
    f32x4 am = (f32x4){0.f, 0.f, 0.f, 0.f};
#pragma unroll 16
    for (int r = 0; r < 128; ++r) { const f32x4 v = *(const GAS f32x4*)(p + (size_t)r * 10240);
        am[0] = fmaxf(am[0], fabsf(v[0])); am[1] = fmaxf(am[1], fabsf(v[1])); am[2] = fmaxf(am[2], fabsf(v[2])); am[3] = fmaxf(am[3], fabsf(v[3])); }
#pragma unroll
    for (int j = 0; j < 4; ++j) (void)__hip_atomic_fetch_max(wmax + n0 + j, __builtin_bit_cast(unsigned, am[j]), RLX_AGENT);
}
__device__ __forceinline__ void p0_transpose_item_i8(const float* W, int K, int N, unsigned char* W8, LAS float* scr, int item, int lane, const gu32* wmax) {
    const int nblk = N / 32, kb = item / nblk, nb = item % nblk, k0 = 64 * kb, n0 = 32 * nb;
#pragma unroll 8
    for (int i = 0; i < 32; ++i) { const int kk = 2 * i + (lane >> 5); scr[kk * 33 + (lane & 31)] = W[(size_t)(k0 + kk) * N + n0 + (lane & 31)]; }
    LDS_WAIT(); asm volatile("" ::: "memory");
    const int c = lane & 7;
#pragma unroll
    for (int j = 0; j < 4; ++j) { const int n = (lane >> 3) + 8 * j; const LAS float* s = scr + (8 * c) * 33 + n;
        const float am = __builtin_bit_cast(float, wmax[n0 + n]); const float sc = am > 0.f ? 127.0f / am : 0.f;
        v2u o; o.x = q8pack(s[0 * 33], s[1 * 33], s[2 * 33], s[3 * 33], sc); o.y = q8pack(s[4 * 33], s[5 * 33], s[6 * 33], s[7 * 33], sc);
        *(GAS v2u*)(W8 + (size_t)inproj_row(n0 + n) * K + k0 + 8 * c) = o; }
    LDS_WAIT(); asm volatile("" ::: "memory");
}
__device__ __forceinline__ void p0_x_row(const float* src, bf16* dstb, unsigned char* dst8, float* sx, int lane) {
    f32x4 v[8]; float am = 0.f;
#pragma unroll
    for (int j = 0; j < 8; ++j) { v[j] = *(const GAS f32x4*)(src + 256 * j + 4 * lane);
        am = fmaxf(am, fmaxf(fmaxf(fabsf(v[j][0]), fabsf(v[j][1])), fmaxf(fabsf(v[j][2]), fabsf(v[j][3])))); }
#pragma unroll
    for (int o = 1; o < 64; o <<= 1) am = fmaxf(am, __shfl_xor(am, o));
    const float sc = am > 0.f ? 127.0f / am : 0.f;
#pragma unroll
    for (int j = 0; j < 8; ++j) { *(GAS v2u*)(dstb + 256 * j + 4 * lane) = (v2u){pk2(v[j][0], v[j][1]), pk2(v[j][2], v[j][3])};
        *(GAS unsigned*)(dst8 + 256 * j + 4 * lane) = q8pack(v[j][0], v[j][1], v[j][2], v[j][3], sc); }
    if (lane == 0) *sx = am * (1.0f / 127.0f);
}

namespace att {
constexpr int KB0 = 0, VB0 = 32768, KMT = 65536, QFR = 65536;
__device__ __forceinline__ int crow(int r, int hi) { return (r & 3) + 8 * (r >> 2) + 4 * hi; }
__device__ __forceinline__ unsigned cvtpk(float lo, float hi) { return pg8::cvt_pk_bf16(lo, hi); }

template <int DQK, bool MOBA>
__device__ __forceinline__ void attn_pass(LAS unsigned char* lds, const bf16* Qg, const bf16* Kg, const bf16* Vtg, int q0, unsigned sel, f32x16 (&o)[4], int tid, int wid, int lane) {
    constexpr int NS = DQK / 16, RB = DQK * 2, KCH = DQK / 8;
    constexpr float THR = 8.0f;
    const int r32 = lane & 31, hi = lane >> 5;
    const int qpos = q0 + 32 * wid + r32;
    const int own = q0 >> 8;
    const LAS unsigned char* qlds = lds + QFR + wid * 8192 + lane * 16;
    { const bf16* qp = Qg + (size_t)(32 * wid + r32) * 1024 + 8 * hi;
#pragma unroll
      for (int s = 0; s < NS; ++s) *(LAS bf16x8*)(lds + QFR + wid * 8192 + lane * 16 + s * 1024) = *(const GAS bf16x8*)(qp + 16 * s); }
#pragma unroll
    for (int d = 0; d < 4; ++d) o[d] = (f32x16){0.f,0.f,0.f,0.f,0.f,0.f,0.f,0.f,0.f,0.f,0.f,0.f,0.f,0.f,0.f,0.f};
    f32x16 negm = (f32x16){0.f,0.f,0.f,0.f,0.f,0.f,0.f,0.f,0.f,0.f,0.f,0.f,0.f,0.f,0.f,0.f};
    float l_run = 0.f;
    const int nt = MOBA ? 4 + 4 * own : (q0 + 256) / 64;
    constexpr int NKC = (64 * KCH) / 512;
    v4u kreg[NKC], vreg[2];
    unsigned kgo[NKC], vgo[2]; int klds[NKC], vl0[2], vl1[2];
#pragma unroll
    for (int i = 0; i < NKC; ++i) { const int cid = tid + 512 * i, key = cid / KCH, ch = cid % KCH;
        const int swz = (DQK == 128) ? (key & 15) : ((key >> 1) & 7);
        kgo[i] = (unsigned)(key * 1024 + ch * 8) * 2u; klds[i] = key * RB + ((ch ^ swz) << 4); }
#pragma unroll
    for (int i = 0; i < 2; ++i) { const int cid = tid + 512 * i, d = cid >> 3, g = cid & 7;
        const int c = (g >> 2) * 4 + ((g >> 1) & 1) * 2, sw = (d >> 1) & 7, e = g & 1;
        vgo[i] = (unsigned)(d * T + g * 8) * 2u; vl0[i] = d * 128 + ((c ^ sw) << 4) + 8 * e; vl1[i] = d * 128 + (((c + 1) ^ sw) << 4) + 8 * e; }
#define KTILE(i) (MOBA ? ((i) < 4 ? own * 4 + (i) : (i) - 4) : (i))
#define ATT_LOAD(kt) do { const GAS unsigned char* kb_ = (const GAS unsigned char*)Kg + (size_t)(kt) * 131072; const GAS unsigned char* vb_ = (const GAS unsigned char*)Vtg + (size_t)(kt) * 128; \
                          _Pragma("unroll") for (int i_ = 0; i_ < NKC; ++i_) kreg[i_] = *(const GAS v4u*)(kb_ + kgo[i_]); \
                          _Pragma("unroll") for (int i_ = 0; i_ < 2; ++i_) vreg[i_] = *(const GAS v4u*)(vb_ + vgo[i_]); } while (0)
#define ATT_STORE(buf) do { _Pragma("unroll") for (int i_ = 0; i_ < NKC; ++i_) *(LAS v4u*)(lds + KB0 + (buf) * 16384 + klds[i_]) = kreg[i_]; \
                            _Pragma("unroll") for (int i_ = 0; i_ < 2; ++i_) { *(LAS v2u*)(lds + VB0 + (buf) * 16384 + vl0[i_]) = (v2u){vreg[i_].x, vreg[i_].y}; \
                                                                              *(LAS v2u*)(lds + VB0 + (buf) * 16384 + vl1[i_]) = (v2u){vreg[i_].z, vreg[i_].w}; } } while (0)
    ATT_LOAD(KTILE(0)); ATT_STORE(0);
    __syncthreads();
    const int kswz = (DQK == 128) ? (r32 & 15) : ((r32 >> 1) & 7);
    const int vsw = (r32 >> 1) & 7;
    const int kfo = r32 * RB, vfo = r32 * 128;
#define ATT_STEP(BUF) do { \
        const int kt = KTILE(it); const bool more = it + 1 < nt; \
        if (more) ATT_LOAD(KTILE(it + 1)); \
        const int blk = kt >> 2; bool need; \
        if (!MOBA || it < 4) need = (kt * 64 <= q0 + 32 * wid + 31); else need = __any((sel >> blk) & 1u); \
        if (need) { \
            f32x16 p0, p1; \
            const LAS unsigned char* kb = lds + KB0 + (BUF) * 16384 + kfo; \
              \
            bf16x8 fk0[2], fk1[2], fqv[2]; \
            { const int ch = ((0 + hi) ^ kswz) << 4; fk0[0] = *(const LAS bf16x8*)(kb + ch); fk1[0] = *(const LAS bf16x8*)(kb + 32 * RB + ch); fqv[0] = *(const LAS bf16x8*)(qlds); } \
            _Pragma("unroll") for (int s = 0; s < NS; ++s) { \
                if (s + 1 < NS) { const int ch = ((2 * (s + 1) + hi) ^ kswz) << 4; \
                    fk0[(s + 1) & 1] = *(const LAS bf16x8*)(kb + ch); fk1[(s + 1) & 1] = *(const LAS bf16x8*)(kb + 32 * RB + ch); fqv[(s + 1) & 1] = *(const LAS bf16x8*)(qlds + (s + 1) * 1024); } \
                __builtin_amdgcn_sched_barrier(0); \
                if (s == 0) {   \
                    asm volatile("v_mfma_f32_32x32x16_bf16 %0, %1, %2, %3" : "=&v"(p0) : "v"(fk0[0]), "v"(fqv[0]), "v"(negm)); \
                    asm volatile("v_mfma_f32_32x32x16_bf16 %0, %1, %2, %3" : "=&v"(p1) : "v"(fk1[0]), "v"(fqv[0]), "v"(negm)); } \
                else { p0 = __builtin_amdgcn_mfma_f32_32x32x16_bf16(fk0[s & 1], fqv[s & 1], p0, 0, 0, 0); p1 = __builtin_amdgcn_mfma_f32_32x32x16_bf16(fk1[s & 1], fqv[s & 1], p1, 0, 0, 0); } \
                __builtin_amdgcn_sched_barrier(0); } \
            if (!MOBA || it < 4) { \
                if (kt * 64 + 63 > q0 + 32 * wid) { const int kbase = kt * 64 + 4 * hi; \
                    _Pragma("unroll") for (int r = 0; r < 16; ++r) { const int kv = kbase + (r & 3) + 8 * (r >> 2); if (kv > qpos) p0[r] = -INFINITY; if (kv + 32 > qpos) p1[r] = -INFINITY; } } \
            } else { if (!((sel >> blk) & 1u)) { _Pragma("unroll") for (int r = 0; r < 16; ++r) { p0[r] = -INFINITY; p1[r] = -INFINITY; } } } \
            float rm = fmaxf(fmaxf(p0[0], p0[1]), p1[0]); \
            _Pragma("unroll") for (int r = 1; r < 16; ++r) rm = fmaxf(fmaxf(rm, p0[r]), p1[r]); \
            { const unsigned rb = __builtin_bit_cast(unsigned, rm); auto rr = __builtin_amdgcn_permlane32_swap(rb, rb, false, false); rm = fmaxf(__builtin_bit_cast(float, (unsigned)rr[0]), __builtin_bit_cast(float, (unsigned)rr[1])); } \
            if (it == 0 || __any(rm > THR)) { \
                const float dl = (it == 0) ? rm : fmaxf(rm, 0.f); const float alpha = fexp2(-dl); \
                _Pragma("unroll") for (int r = 0; r < 16; ++r) { p0[r] -= dl; p1[r] -= dl; negm[r] -= dl; } \
                l_run *= alpha; \
                _Pragma("unroll") for (int d = 0; d < 4; ++d) _Pragma("unroll") for (int r = 0; r < 16; ++r) o[d][r] *= alpha; } \
            float ls = 0.f; \
            _Pragma("unroll") for (int r = 0; r < 16; ++r) { p0[r] = fexp2(p0[r]); p1[r] = fexp2(p1[r]); ls += p0[r] + p1[r]; } \
            l_run += ls; \
            bf16x8 pa[4]; \
            { v4u w; \
              w.x = cvtpk(p0[0], p0[1]); w.y = cvtpk(p0[2], p0[3]); w.z = cvtpk(p0[4], p0[5]); w.w = cvtpk(p0[6], p0[7]); pa[0] = __builtin_bit_cast(bf16x8, w); \
              w.x = cvtpk(p0[8], p0[9]); w.y = cvtpk(p0[10], p0[11]); w.z = cvtpk(p0[12], p0[13]); w.w = cvtpk(p0[14], p0[15]); pa[1] = __builtin_bit_cast(bf16x8, w); \
              w.x = cvtpk(p1[0], p1[1]); w.y = cvtpk(p1[2], p1[3]); w.z = cvtpk(p1[4], p1[5]); w.w = cvtpk(p1[6], p1[7]); pa[2] = __builtin_bit_cast(bf16x8, w); \
              w.x = cvtpk(p1[8], p1[9]); w.y = cvtpk(p1[10], p1[11]); w.z = cvtpk(p1[12], p1[13]); w.w = cvtpk(p1[14], p1[15]); pa[3] = __builtin_bit_cast(bf16x8, w); } \
            const LAS unsigned char* vb = lds + VB0 + (BUF) * 16384 + vfo; \
            bf16x8 vfr[2][4]; \
            _Pragma("unroll") for (int d = 0; d < 4; ++d) vfr[0][d] = *(const LAS bf16x8*)(vb + d * 4096 + (((0 + hi) ^ vsw) << 4)); \
            _Pragma("unroll") for (int ks = 0; ks < 4; ++ks) { \
                if (ks + 1 < 4) { const int c = ((ks + 1) >> 1) * 4 + ((ks + 1) & 1) * 2 + hi; \
                    _Pragma("unroll") for (int d = 0; d < 4; ++d) vfr[(ks + 1) & 1][d] = *(const LAS bf16x8*)(vb + d * 4096 + ((c ^ vsw) << 4)); } \
                __builtin_amdgcn_sched_barrier(0); \
                _Pragma("unroll") for (int d = 0; d < 4; ++d) o[d] = __builtin_amdgcn_mfma_f32_32x32x16_bf16(vfr[ks & 1][d], pa[ks], o[d], 0, 0, 0); \
                __builtin_amdgcn_sched_barrier(0); } \
        } \
        if (more) ATT_STORE((BUF) ^ 1); \
        __syncthreads(); \
    } while (0)
    int it = 0;
#pragma unroll 1
    for (; it + 1 < nt; it += 2) { ATT_STEP(0); ++it; ATT_STEP(1); --it; }
    if (it < nt) ATT_STEP(0);
#undef ATT_STEP
#undef ATT_LOAD
#undef KTILE
#undef ATT_STORE
    const float lt = l_run + __shfl_xor(l_run, 32);
    const float inv = 1.0f / lt;
#pragma unroll
    for (int d = 0; d < 4; ++d)
#pragma unroll
        for (int r = 0; r < 16; ++r) o[d][r] *= inv;
}

__device__ __forceinline__ void attn_pass_diff2(LAS unsigned char* lds, const bf16* Qg, const bf16* Kg, const bf16* Vtg, int q0, f32x16 (&o1)[4], f32x16 (&o2)[4], int tid, int wid, int lane) {
    constexpr int RB = 256, KCH = 16; constexpr float THR = 8.0f;
    { const int r32 = lane & 31, hi = lane >> 5;
      const bf16* qp = Qg + (size_t)(32 * wid + r32) * 1024 + 8 * hi;
#pragma unroll
      for (int s = 0; s < 8; ++s) *(LAS bf16x8*)(lds + QFR + wid * 8192 + lane * 16 + s * 1024) = *(const GAS bf16x8*)(qp + 16 * s); }
#pragma unroll
    for (int d = 0; d < 4; ++d) { o1[d] = (f32x16){0.f,0.f,0.f,0.f,0.f,0.f,0.f,0.f,0.f,0.f,0.f,0.f,0.f,0.f,0.f,0.f}; o2[d] = o1[d]; }
    float m1 = 0.f, l1 = 0.f, m2 = 0.f, l2 = 0.f;
    const int nt = (q0 + 256) / 64;
    v4u sreg[2];
#define ATT_KGO(i) ((unsigned)((((tq_ + 512 * (i)) >> 4) * 1024 + ((tq_ + 512 * (i)) & 15) * 8) * 2))
#define ATT_KLDS(i) ((((tq_ + 512 * (i)) >> 4) * RB) + (((((tq_ + 512 * (i)) & 15)) ^ (((tq_ + 512 * (i)) >> 4) & 15)) << 4))
#define ATT_VGO(i) ((unsigned)((((tq_ + 512 * (i)) >> 3) * T + ((tq_ + 512 * (i)) & 7) * 8) * 2))
#define ATT_VC(i) (((((tq_ + 512 * (i)) & 7) >> 2) * 4) + (((((tq_ + 512 * (i)) & 7) >> 1) & 1) * 2))
#define ATT_VL0(i) ((((tq_ + 512 * (i)) >> 3) * 128) + ((ATT_VC(i) ^ ((((tq_ + 512 * (i)) >> 3) >> 1) & 7)) << 4) + 8 * ((tq_ + 512 * (i)) & 1))
#define ATT_VL1(i) ((((tq_ + 512 * (i)) >> 3) * 128) + (((ATT_VC(i) + 1) ^ ((((tq_ + 512 * (i)) >> 3) >> 1) & 7)) << 4) + 8 * ((tq_ + 512 * (i)) & 1))
#define ATT_TQ int tq_ = lane; asm volatile("" : "+v"(tq_)); tq_ += 64 * wid
#define ATT_LOADK(kt) do { ATT_TQ; const GAS unsigned char* kb_ = (const GAS unsigned char*)Kg + (size_t)(kt) * 131072; _Pragma("unroll") for (int i_ = 0; i_ < 2; ++i_) sreg[i_] = *(const GAS v4u*)(kb_ + ATT_KGO(i_)); } while (0)
#define ATT_LOADV(kt) do { ATT_TQ; const GAS unsigned char* vb_ = (const GAS unsigned char*)Vtg + (size_t)(kt) * 128; _Pragma("unroll") for (int i_ = 0; i_ < 2; ++i_) sreg[i_] = *(const GAS v4u*)(vb_ + ATT_VGO(i_)); } while (0)
#define ATT_STOREK(buf) do { ATT_TQ; _Pragma("unroll") for (int i_ = 0; i_ < 2; ++i_) *(LAS v4u*)(lds + KB0 + (buf) * 16384 + ATT_KLDS(i_)) = sreg[i_]; } while (0)
#define ATT_STOREV(buf) do { ATT_TQ; _Pragma("unroll") for (int i_ = 0; i_ < 2; ++i_) { *(LAS v2u*)(lds + VB0 + (buf) * 16384 + ATT_VL0(i_)) = (v2u){sreg[i_].x, sreg[i_].y}; \
                                                                               *(LAS v2u*)(lds + VB0 + (buf) * 16384 + ATT_VL1(i_)) = (v2u){sreg[i_].z, sreg[i_].w}; } } while (0)
    ATT_LOADK(0); ATT_STOREK(0); ATT_LOADV(0); ATT_STOREV(0);
    __syncthreads();
#define ATT_LN int ln_ = lane; asm volatile("" : "+v"(ln_)); const int r32 = ln_ & 31, hi = ln_ >> 5
#define ATT_QKS(BUF, S0, M, L, O) do { \
        ATT_LN; const int kswz = r32 & 15; const LAS unsigned char* qlds = lds + QFR + wid * 8192 + ln_ * 16; \
        const LAS unsigned char* kb = lds + KB0 + (BUF) * 16384 + r32 * RB; \
        _Pragma("unroll") for (int s = 0; s < 4; ++s) { const int ch = ((2 * ((S0) + s) + hi) ^ kswz) << 4; \
            const bf16x8 k0 = *(const LAS bf16x8*)(kb + ch), k1 = *(const LAS bf16x8*)(kb + 32 * RB + ch); \
            const bf16x8 qv = *(const LAS bf16x8*)(qlds + ((S0) + s) * 1024); \
            if (s == 0) { asm volatile("v_mfma_f32_32x32x16_bf16 %0, %1, %2, 0" : "=&v"(p0) : "v"(k0), "v"(qv)); \
                          asm volatile("v_mfma_f32_32x32x16_bf16 %0, %1, %2, 0" : "=&v"(p1) : "v"(k1), "v"(qv)); } \
            else { p0 = __builtin_amdgcn_mfma_f32_32x32x16_bf16(k0, qv, p0, 0, 0, 0); p1 = __builtin_amdgcn_mfma_f32_32x32x16_bf16(k1, qv, p1, 0, 0, 0); } } \
        if (diag) { const int kbase = kt * 64 + 4 * hi, qpos = q0 + 32 * wid + r32; \
            _Pragma("unroll") for (int r = 0; r < 16; ++r) { const int kv = kbase + (r & 3) + 8 * (r >> 2); if (kv > qpos) p0[r] = -INFINITY; if (kv + 32 > qpos) p1[r] = -INFINITY; } } \
        float rm = fmaxf(fmaxf(p0[0], p0[1]), p1[0]); \
        _Pragma("unroll") for (int r = 1; r < 16; ++r) rm = fmaxf(fmaxf(rm, p0[r]), p1[r]); \
        { const unsigned rb = __builtin_bit_cast(unsigned, rm); auto rr = __builtin_amdgcn_permlane32_swap(rb, rb, false, false); rm = fmaxf(__builtin_bit_cast(float, (unsigned)rr[0]), __builtin_bit_cast(float, (unsigned)rr[1])); } \
        if (it == 0 || __any(rm > M + THR)) { \
            const float mnew = (it == 0) ? rm : fmaxf(M, rm); const float alpha = fexp2(M - mnew); M = mnew; \
            L *= alpha; \
            _Pragma("unroll") for (int d = 0; d < 4; ++d) _Pragma("unroll") for (int r = 0; r < 16; ++r) O[d][r] *= alpha; } \
        float ls = 0.f; \
        { typedef float f32x2v __attribute__((ext_vector_type(2))); const f32x2v mm = (f32x2v){M, M};        \
          _Pragma("unroll") for (int r = 0; r < 16; r += 2) { const f32x2v a = (f32x2v){p0[r], p0[r + 1]} - mm, b = (f32x2v){p1[r], p1[r + 1]} - mm; \
              p0[r] = fexp2(a.x); p0[r + 1] = fexp2(a.y); p1[r] = fexp2(b.x); p1[r + 1] = fexp2(b.y); ls += (p0[r] + p0[r + 1]) + (p1[r] + p1[r + 1]); } } \
        L += ls; \
    } while (0)
#define ATT_PACK(dst_, ks) do { \
        if ((ks) == 0) { (dst_).x = cvtpk(p0[0], p0[1]); (dst_).y = cvtpk(p0[2], p0[3]); (dst_).z = cvtpk(p0[4], p0[5]); (dst_).w = cvtpk(p0[6], p0[7]); } \
        else if ((ks) == 1) { (dst_).x = cvtpk(p0[8], p0[9]); (dst_).y = cvtpk(p0[10], p0[11]); (dst_).z = cvtpk(p0[12], p0[13]); (dst_).w = cvtpk(p0[14], p0[15]); } \
        else if ((ks) == 2) { (dst_).x = cvtpk(p1[0], p1[1]); (dst_).y = cvtpk(p1[2], p1[3]); (dst_).z = cvtpk(p1[4], p1[5]); (dst_).w = cvtpk(p1[6], p1[7]); } \
        else { (dst_).x = cvtpk(p1[8], p1[9]); (dst_).y = cvtpk(p1[10], p1[11]); (dst_).z = cvtpk(p1[12], p1[13]); (dst_).w = cvtpk(p1[14], p1[15]); } } while (0)
#define ATT_STEP(BUF) do { \
        const int kt = it; const bool more = it + 1 < nt; \
        const bool need = kt * 64 <= q0 + 32 * wid + 31, diag = kt * 64 + 63 > q0 + 32 * wid; \
        if (more) ATT_LOADK(it + 1); \
        v4u pa1[4] = {(v4u){0u, 0u, 0u, 0u}, (v4u){0u, 0u, 0u, 0u}, (v4u){0u, 0u, 0u, 0u}, (v4u){0u, 0u, 0u, 0u}}; \
        if (need) { f32x16 p0, p1; ATT_QKS(BUF, 0, m1, l1, o1); \
              _Pragma("unroll") for (int ks = 0; ks < 4; ++ks) ATT_PACK(pa1[ks], ks); } \
        if (more) { ATT_STOREK((BUF) ^ 1); ATT_LOADV(it + 1); }        \
        if (need) { v4u pa2[4]; \
              { f32x16 p0, p1; ATT_QKS(BUF, 4, m2, l2, o2); \
                _Pragma("unroll") for (int ks = 0; ks < 4; ++ks) ATT_PACK(pa2[ks], ks); } \
              __builtin_amdgcn_sched_barrier(0); \
              ATT_LN; const int vsw = (r32 >> 1) & 7; \
              const LAS unsigned char* vb = lds + VB0 + (BUF) * 16384 + r32 * 128; \
              _Pragma("unroll") for (int ks = 0; ks < 4; ++ks) { \
                const bf16x8 pb1 = __builtin_bit_cast(bf16x8, pa1[ks]), pb2 = __builtin_bit_cast(bf16x8, pa2[ks]); \
                const int c = (ks >> 1) * 4 + (ks & 1) * 2 + hi; \
                _Pragma("unroll") for (int d = 0; d < 4; ++d) { const bf16x8 vf = *(const LAS bf16x8*)(vb + d * 4096 + ((c ^ vsw) << 4)); \
                    o1[d] = __builtin_amdgcn_mfma_f32_32x32x16_bf16(vf, pb1, o1[d], 0, 0, 0); \
                    o2[d] = __builtin_amdgcn_mfma_f32_32x32x16_bf16(vf, pb2, o2[d], 0, 0, 0); } \
                __builtin_amdgcn_sched_barrier(0); } } \
        if (more) ATT_STOREV((BUF) ^ 1); \
        __syncthreads(); \
    } while (0)
    int it = 0;
#pragma unroll 1
    for (; it + 1 < nt; it += 2) { ATT_STEP(0); ++it; ATT_STEP(1); --it; }
    if (it < nt) ATT_STEP(0);
#undef ATT_STEP
#undef ATT_QKS
#undef ATT_PACK
#undef ATT_LN
#undef ATT_LOADK
#undef ATT_LOADV
#undef ATT_STOREK
#undef ATT_STOREV
#undef ATT_TQ
#undef ATT_KGO
#undef ATT_KLDS
#undef ATT_VGO
#undef ATT_VC
#undef ATT_VL0
#undef ATT_VL1
    const float i1 = 1.0f / (l1 + __shfl_xor(l1, 32)), i2 = 1.0f / (l2 + __shfl_xor(l2, 32));
#pragma unroll
    for (int d = 0; d < 4; ++d)
#pragma unroll
        for (int r = 0; r < 16; ++r) { o1[d][r] *= i1; o2[d][r] *= i2; }
}

struct AttnArgs { const bf16 *qa, *ka, *qd, *kd, *vt; bf16* oab; const float* kmean; const float* gain; float lam, one_minus_li; };

__device__ __forceinline__ void moba_unit(LAS unsigned char* lds, const AttnArgs& A, int b, int h, int qb, int tid, int wid, int lane) {
    asm volatile("" : "+v"(tid), "+v"(lane));
    const int r32 = lane & 31, hi = lane >> 5, q0 = qb * 256;
    const bf16* Qg = A.qa + (size_t)(b * SEQ + q0) * 1024 + h * 128;
    unsigned sel = 0u;
    if (qb > 0) {
        { const int row = tid >> 4, ch = tid & 15, n = row & 15;
          const float* kp = A.kmean + ((size_t)(b * 8 + h) * 16 + n) * 128 + ch * 8;
          const f32x4 a = *(const GAS f32x4*)kp, c = *(const GAS f32x4*)(kp + 4);
          float v[8] = {a[0], a[1], a[2], a[3], c[0], c[1], c[2], c[3]}; unsigned w[8];
#pragma unroll
          for (int j = 0; j < 8; ++j) { const float x = v[j] * (1.0f / 256.0f); const unsigned hb = f2bf(x); const float xr = __builtin_bit_cast(float, hb << 16); w[j] = (row < 16) ? hb : f2bf(x - xr); }
          v4u o; o.x = w[0] | (w[1] << 16); o.y = w[2] | (w[3] << 16); o.z = w[4] | (w[5] << 16); o.w = w[6] | (w[7] << 16);
          *(LAS v4u*)(lds + KMT + row * 256 + ((ch ^ (row & 15)) << 4)) = o; }
        __syncthreads();
        f32x16 g = (f32x16){0.f,0.f,0.f,0.f,0.f,0.f,0.f,0.f,0.f,0.f,0.f,0.f,0.f,0.f,0.f,0.f};
        { const bf16* qp = Qg + (size_t)(32 * wid + r32) * 1024 + 8 * hi;
          const LAS unsigned char* kb = lds + KMT + r32 * 256;
#pragma unroll
          for (int s = 0; s < 8; ++s) { const bf16x8 qv = *(const GAS bf16x8*)(qp + 16 * s);
              const bf16x8 kf = *(const LAS bf16x8*)(kb + (((2 * s + hi) ^ (r32 & 15)) << 4));
              g = __builtin_amdgcn_mfma_f32_32x32x16_bf16(kf, qv, g, 0, 0, 0); } }
        float G[16];
#pragma unroll
        for (int r = 0; r < 8; ++r) { const float mine = g[r] + g[r + 8]; const float oth = __shfl_xor(mine, 32);
            const int nlo = (r & 3) + 8 * (r >> 2); G[nlo] = hi ? oth : mine; G[nlo + 4] = hi ? mine : oth; }
#pragma unroll
        for (int round = 0; round < 3; ++round) { float best = -INFINITY; int bi = -1;
#pragma unroll
            for (int n = 0; n < 16; ++n) { const bool ok = (n < qb) && !((sel >> n) & 1u) && (G[n] > best); best = ok ? G[n] : best; bi = ok ? n : bi; }
            if (bi >= 0) sel |= 1u << bi; }
        __syncthreads();
    }
    f32x16 o[4];
    attn_pass<128, true>(lds, Qg, A.ka + (size_t)(b * SEQ) * 1024 + h * 128, A.vt + (size_t)(h * 128) * T + b * SEQ, q0, sel, o, tid, wid, lane);
    bf16* op = A.oab + (size_t)(b * SEQ + q0 + 32 * wid + r32) * 2048 + h * 128 + 4 * hi;
#pragma unroll
    for (int d = 0; d < 4; ++d)
#pragma unroll
        for (int gq = 0; gq < 4; ++gq) { v2u w; w.x = cvtpk(o[d][4 * gq], o[d][4 * gq + 1]); w.y = cvtpk(o[d][4 * gq + 2], o[d][4 * gq + 3]); *(GAS v2u*)(op + 32 * d + 8 * gq) = w; }
}

__device__ __forceinline__ void diff_unit(LAS unsigned char* lds, const AttnArgs& A, int b, int h, int qb, int tid, int wid, int lane) {
    asm volatile("" : "+v"(tid), "+v"(lane));
    const int r32 = lane & 31, hi = lane >> 5, q0 = qb * 256;
    const size_t qrow = (size_t)(b * SEQ + q0);
    const bf16* Vtg = A.vt + (size_t)(1024 + h * 128) * T + b * SEQ;
    f32x16 o[4], o2[4];
    attn_pass_diff2(lds, A.qd + qrow * 1024 + h * 128, A.kd + (size_t)(b * SEQ) * 1024 + h * 128, Vtg, q0, o, o2, tid, wid, lane);
    float ss = 0.f;
#pragma unroll
    for (int d = 0; d < 4; ++d)
#pragma unroll
        for (int r = 0; r < 16; ++r) { const float v = o[d][r] - A.lam * o2[d][r]; o[d][r] = v; ss += v * v; }
    ss += __shfl_xor(ss, 32);
    const float rn = 1.0f / sqrtf(ss * (1.0f / 128.0f) + RMS_EPS) * A.one_minus_li;
    bf16* op = A.oab + (qrow + 32 * wid + r32) * 2048 + 1024 + h * 128 + 4 * hi;
    const float* gp = A.gain + h * 128 + 4 * hi;
#pragma unroll
    for (int d = 0; d < 4; ++d)
#pragma unroll
        for (int gq = 0; gq < 4; ++gq) { const f32x4 gn = *(const GAS f32x4*)(gp + 32 * d + 8 * gq);
            v2u w; w.x = cvtpk(o[d][4 * gq] * rn * gn[0], o[d][4 * gq + 1] * rn * gn[1]); w.y = cvtpk(o[d][4 * gq + 2] * rn * gn[2], o[d][4 * gq + 3] * rn * gn[3]);
            *(GAS v2u*)(op + 32 * d + 8 * gq) = w; }
}

__device__ __forceinline__ void attn_phase(LAS unsigned char* lds, const AttnArgs& A, int vcu, int G, int tid, int wid, int lane) {
    for (int ord = vcu; ord < 1024; ord += G) {
        const int i = ord >> 8, v = ord & 255, bh = v >> 3, s = v & 7;
        const int qb = (i & 1) ? 15 - s : s;
        if (i < 2) diff_unit(lds, A, bh >> 3, bh & 7, qb, tid, wid, lane);
        else moba_unit(lds, A, bh >> 3, bh & 7, qb, tid, wid, lane);
    }
}
}

namespace peer {
__device__ __forceinline__ int f2key(float f) { const int u = __builtin_bit_cast(int, f); return u ^ ((u >> 31) & 0x7fffffff); }
__device__ __forceinline__ float key2f(int k) { const int u = k ^ ((k >> 31) & 0x7fffffff); return __builtin_bit_cast(float, u); }
__device__ __forceinline__ int imax(int a, int b) { return a > b ? a : b; }
__device__ __forceinline__ int imin(int a, int b) { return a < b ? a : b; }

template <int OFF> __device__ __forceinline__ void sort16_desc(int (&v)[64]) {
#pragma unroll
    for (int k = 2; k <= 16; k <<= 1)
#pragma unroll
        for (int j = k >> 1; j > 0; j >>= 1)
#pragma unroll
            for (int i = 0; i < 16; ++i) { const int l = i ^ j;
                if (l > i) { const bool desc = ((i & k) == 0); const int a = v[OFF + i], b = v[OFF + l]; const int mx = imax(a, b), mn = imin(a, b);
                    v[OFF + i] = desc ? mx : mn; v[OFF + l] = desc ? mn : mx; } }
}
template <int OA, int OB> __device__ __forceinline__ void merge16_desc(int (&v)[64]) {
#pragma unroll
    for (int i = 0; i < 16; ++i) v[OA + i] = imax(v[OA + i], v[OB + 15 - i]);
#pragma unroll
    for (int j = 8; j > 0; j >>= 1)
#pragma unroll
        for (int i = 0; i < 16; ++i) { const int l = i ^ j;
            if (l > i) { const int a = v[OA + i], b = v[OA + l]; v[OA + i] = imax(a, b); v[OA + l] = imin(a, b); } }
}
__device__ __forceinline__ void top16_of_64(int (&v)[64]) {
    sort16_desc<0>(v); sort16_desc<16>(v); sort16_desc<32>(v); sort16_desc<48>(v);
    merge16_desc<0, 16>(v); merge16_desc<32, 48>(v); merge16_desc<0, 32>(v);
}
__device__ __forceinline__ float gelu_tanh(float x) {
    const float u = 0.7978845608028654f * (x + 0.044715f * x * x * x);
    const float e = __builtin_amdgcn_exp2f(2.0f * 1.4426950408889634f * u);
    const float th = 1.0f - 2.0f * __builtin_amdgcn_rcpf(e + 1.0f);
    return 0.5f * x * (1.0f + th);
}
constexpr int ETILE = 0, GTILE = 16384, SCR0 = 32768, XQ0 = 98304;

__device__ __forceinline__ void select_tile(LAS unsigned char* lds, const bf16* pq, const bf16* sk, int t0, int wid, int lane) {
    asm volatile("" : "+v"(lane));
    const int r32 = lane & 31, hi = lane >> 5, h = wid;
    LAS int* scr = (LAS int*)(lds + SCR0 + wid * 8192);
    int v[64];
#pragma unroll 1
    for (int c = 0; c < 2; ++c) {
        bf16x8 qf[8];
        { const bf16* qp = pq + (size_t)(t0 + r32) * 2048 + h * 256 + c * 128 + 8 * hi;
#pragma unroll
          for (int s = 0; s < 8; ++s) qf[s] = *(const GAS bf16x8*)(qp + 16 * s); }
#pragma unroll
        for (int kb = 0; kb < 4; ++kb) {
            f32x16 sc = (f32x16){0.f,0.f,0.f,0.f,0.f,0.f,0.f,0.f,0.f,0.f,0.f,0.f,0.f,0.f,0.f,0.f};
            const bf16* ap = sk + ((size_t)((c * 8 + h) * 128 + 32 * kb + r32)) * 128 + 8 * hi;
#pragma unroll
            for (int s = 0; s < 8; ++s) { const bf16x8 af = *(const GAS bf16x8*)(ap + 16 * s); sc = __builtin_amdgcn_mfma_f32_32x32x16_bf16(af, qf[s], sc, 0, 0, 0); }
#pragma unroll
            for (int r = 0; r < 16; ++r) v[kb * 16 + r] = (f2key(sc[r]) & ~127) | (32 * kb + (r & 3) + 8 * (r >> 2) + 4 * hi);
        }
        top16_of_64(v);
#pragma unroll
        for (int i = 0; i < 16; ++i) v[16 + i] = __shfl_xor(v[i], 32);
        merge16_desc<0, 16>(v);
#pragma unroll
        for (int i = 0; i < 16; ++i) scr[(c * 16 + i) * 64 + lane] = v[i];
    }
    LDS_WAIT();
    float a[16], b[16];
#pragma unroll
    for (int i = 0; i < 16; ++i) { a[i] = key2f(scr[i * 64 + lane] & ~127); b[i] = key2f(v[i] & ~127); }
    int n = 0;
#pragma unroll
    for (int i = 0; i < 16; ++i)
#pragma unroll
        for (int j = 0; j < 16; ++j)
            if ((i + 1) * (j + 1) <= 16) { v[n] = (f2key(a[i] + b[j]) & ~255) | (i << 4) | j; ++n; }
#pragma unroll
    for (int i = 0; i < 64; ++i) if (i >= 50) v[i] = (int)0x80000000;
    top16_of_64(v);
    float s[16]; int e[16]; float mx = -INFINITY;
#pragma unroll
    for (int k = 0; k < 16; ++k) { const int i = (v[k] >> 4) & 15, j = v[k] & 15;
        const int ka = scr[i * 64 + lane], kb2 = scr[(16 + j) * 64 + lane];
        s[k] = key2f(ka & ~127) + key2f(kb2 & ~127); e[k] = (ka & 127) * 128 + (kb2 & 127); mx = fmaxf(mx, s[k]); }
    float sum = 0.f;
#pragma unroll
    for (int k = 0; k < 16; ++k) { s[k] = __builtin_amdgcn_exp2f((s[k] - mx) * 1.4426950408889634f); sum += s[k]; }
    const float inv = 1.0f / sum;
    if (hi == 0) {
        LAS int* E = (LAS int*)(lds + ETILE) + r32 * 128 + h * 16; LAS float* Gt = (LAS float*)(lds + GTILE) + r32 * 128 + h * 16;
#pragma unroll
        for (int k = 0; k < 16; ++k) { E[k] = e[k]; Gt[k] = s[k] * inv; }
    }
}

#define PEER_LOADROW(dst, tab, ridx) do { dst = *((const GAS v4u*)((tab) + (size_t)(ridx) * 1024) + lane); } while (0)
typedef float f32x2p __attribute__((ext_vector_type(2)));
#define PEER_CVT4(w) const f32x2p c0_ = __builtin_amdgcn_cvt_scalef32_pk_f32_fp4((w), 1.0f, 0), c1_ = __builtin_amdgcn_cvt_scalef32_pk_f32_fp4((w), 1.0f, 1), \
        c2_ = __builtin_amdgcn_cvt_scalef32_pk_f32_fp4((w), 1.0f, 2), c3_ = __builtin_amdgcn_cvt_scalef32_pk_f32_fp4((w), 1.0f, 3)
#define PEER_AXPY8(Y2, wk2, w, b) do { PEER_CVT4(w); Y2[(b)] = __builtin_elementwise_fma(wk2, c0_, Y2[(b)]); Y2[(b) + 1] = __builtin_elementwise_fma(wk2, c1_, Y2[(b) + 1]); \
        Y2[(b) + 2] = __builtin_elementwise_fma(wk2, c2_, Y2[(b) + 2]); Y2[(b) + 3] = __builtin_elementwise_fma(wk2, c3_, Y2[(b) + 3]); } while (0)

__device__ __forceinline__ void token_ffn(LAS unsigned char* lds, int tl, const bf16* xrow, const unsigned char* TU, const unsigned char* TV, const float* SU, const float* SV,
                                          const float* gain, const float* bias, float* outf, bf16* outb, unsigned char* out8, float* outsx, int lane,
                                          v4u (&buf)[16], bool have_u, bool has_next) {
    f32x2p xs[16];
#pragma unroll
    for (int q = 0; q < 4; ++q) { const v4u a = *(const GAS v4u*)(xrow + 32 * lane + 8 * q);
        xs[4 * q] = (f32x2p){bf_lo(a.x), bf_hi(a.x)}; xs[4 * q + 1] = (f32x2p){bf_lo(a.y), bf_hi(a.y)}; xs[4 * q + 2] = (f32x2p){bf_lo(a.z), bf_hi(a.z)}; xs[4 * q + 3] = (f32x2p){bf_lo(a.w), bf_hi(a.w)}; }
    const LAS int* E = (const LAS int*)(lds + ETILE) + tl * 128; const LAS float* Gt = (const LAS float*)(lds + GTILE) + tl * 128;
    const int e_lo = E[lane], e_hi = E[64 + lane]; const float g_lo = Gt[lane], g_hi = Gt[64 + lane];
    const float su_lo = SU[e_lo], su_hi = SU[e_hi], sv_lo = SV[e_lo], sv_hi = SV[e_hi];
#define PEER_EIDX(k) (((k) < 64) ? __builtin_amdgcn_readlane(e_lo, (k)) : __builtin_amdgcn_readlane(e_hi, (k) - 64))
    constexpr int PEER_RING = 16;
    float h_lo = 0.f, h_hi = 0.f;
    {
        float am = 0.f;
#pragma unroll
        for (int i = 0; i < 16; ++i) am = fmaxf(am, fmaxf(fabsf(xs[i].x), fabsf(xs[i].y)));
#pragma unroll
        for (int o = 1; o < 64; o <<= 1) am = fmaxf(am, __shfl_xor(am, o));
        const float sx = am > 0.f ? 6.0f / am : 1.0f, isx = am > 0.f ? am / 6.0f : 1.0f;
        v4u xh, xl;
#pragma unroll
        for (int wq = 0; wq < 4; ++wq) { unsigned wh = 0u, wl = 0u;
#define PEER_XQ(b) { const f32x2p v = xs[4 * wq + (b)] * sx; wh = __builtin_amdgcn_cvt_scalef32_pk_fp4_f32(wh, v.x, v.y, 1.0f, (b)); \
                const f32x2p d = __builtin_amdgcn_cvt_scalef32_pk_f32_fp4(wh, 1.0f, (b)); wl = __builtin_amdgcn_cvt_scalef32_pk_fp4_f32(wl, (v.x - d.x) * 4.0f, (v.y - d.y) * 4.0f, 1.0f, (b)); }
            PEER_XQ(0) PEER_XQ(1) PEER_XQ(2) PEER_XQ(3)
#undef PEER_XQ
            xh[wq] = wh; xl[wq] = wl; }
        LAS unsigned char* xq = lds + XQ0 + (tl >> 2) * 2048;
        *(LAS v4u*)(xq + 16 * lane) = xh; *(LAS v4u*)(xq + 1024 + 16 * lane) = xl;
        const int g = lane >> 4, rl = lane & 15;
        typedef int v8i_t __attribute__((ext_vector_type(8)));
        if (!have_u) { const int e_r = E[16 * 0 + rl];
#pragma unroll
            for (int s = 0; s < 16; ++s) buf[s] = *(const GAS v4u*)(TU + (size_t)e_r * 1024 + 16 * g + 64 * s); }
#define PEER_HBLOCK(rb, RELOAD) do { \
            f32x4 ah = {0.f, 0.f, 0.f, 0.f}, al = {0.f, 0.f, 0.f, 0.f}; \
            int xoff = 16 * g; asm volatile("" : "+v"(xoff));        \
            const LAS unsigned char* xbb = xq + xoff; \
            _Pragma("unroll") for (int s = 0; s < 16; ++s) { \
                const v4u a4 = buf[s]; const v4u bh = *(const LAS v4u*)(xbb + 64 * s), bl = *(const LAS v4u*)(xbb + 1024 + 64 * s); \
                const v8i_t A = {(int)a4.x, (int)a4.y, (int)a4.z, (int)a4.w, 0, 0, 0, 0}, BH = {(int)bh.x, (int)bh.y, (int)bh.z, (int)bh.w, 0, 0, 0, 0}, BL = {(int)bl.x, (int)bl.y, (int)bl.z, (int)bl.w, 0, 0, 0, 0}; \
                ah = __builtin_amdgcn_mfma_scale_f32_16x16x128_f8f6f4(A, BH, ah, 4, 4, 0, 127, 0, 127); \
                al = __builtin_amdgcn_mfma_scale_f32_16x16x128_f8f6f4(A, BL, al, 4, 4, 0, 127, 0, 127); \
                RELOAD(s); } \
              \
            float selv = 0.f; \
            _Pragma("unroll") for (int r = 0; r < 4; ++r) { const float hv = (ah[r] + 0.25f * al[r]) * isx; const float t = __shfl(hv, 16 * ((lane >> 2) & 3)); selv = ((lane & 3) == r) ? t : selv; } \
            if ((rb) < 4) h_lo = ((lane >> 4) == (rb)) ? selv : h_lo; else h_hi = ((lane >> 4) == ((rb) - 4)) ? selv : h_hi; } while (0)
#define PEER_RELOAD_U(s) buf[s] = *(const GAS v4u*)(rown + 64 * (s))
#define PEER_RELOAD_V(s) PEER_LOADROW(buf[s], TV, PEER_EIDX(s))
#pragma unroll 1
        for (int rb = 0; rb < 7; ++rb) {
            const int e_n = E[16 * (rb + 1) + rl];
            const GAS unsigned char* rown = (const GAS unsigned char*)TU + (size_t)e_n * 1024 + 16 * g;
            PEER_HBLOCK(rb, PEER_RELOAD_U);
        }
        PEER_HBLOCK(7, PEER_RELOAD_V);
#undef PEER_RELOAD_U
#undef PEER_RELOAD_V
#undef PEER_HBLOCK
    }
    const float w_lo = g_lo * gelu_tanh(h_lo * su_lo) * sv_lo, w_hi = g_hi * gelu_tanh(h_hi * su_hi) * sv_hi;
    f32x2p y[16];
#pragma unroll
    for (int i = 0; i < 16; ++i) y[i] = (f32x2p){0.f, 0.f};
#pragma unroll 1
    for (int k0 = 0; k0 < 128 - PEER_RING; k0 += PEER_RING) {
        const int wsrc = __builtin_bit_cast(int, (k0 < 64) ? w_lo : w_hi);
        const int kb = k0 + PEER_RING;
        const int esrc = (kb < 64) ? e_lo : e_hi;
#pragma unroll
        for (int i = 0; i < PEER_RING; ++i) {
            const float wk = __builtin_bit_cast(float, __builtin_amdgcn_readlane(wsrc, (k0 & 63) + i));
            const v4u w = buf[i]; const f32x2p wk2 = {wk, wk};
            PEER_AXPY8(y, wk2, w.x, 0); PEER_AXPY8(y, wk2, w.y, 4); PEER_AXPY8(y, wk2, w.z, 8); PEER_AXPY8(y, wk2, w.w, 12);
            const int en = __builtin_amdgcn_readlane(esrc, (kb & 63) + i); PEER_LOADROW(buf[i], TV, en);
        }
    }
    {
        const int e_nx = has_next ? E[128 + (lane & 15)] : 0;
        const GAS unsigned char* rownx = (const GAS unsigned char*)TU + (size_t)e_nx * 1024 + 16 * (lane >> 4);
#pragma unroll
        for (int i = 0; i < PEER_RING; ++i) {
            const float wk = __builtin_bit_cast(float, __builtin_amdgcn_readlane(__builtin_bit_cast(int, w_hi), 48 + i));
            const v4u w = buf[i]; const f32x2p wk2 = {wk, wk};
            PEER_AXPY8(y, wk2, w.x, 0); PEER_AXPY8(y, wk2, w.y, 4); PEER_AXPY8(y, wk2, w.z, 8); PEER_AXPY8(y, wk2, w.w, 12);
            if (has_next) buf[i] = *(const GAS v4u*)(rownx + 64 * i);
        }
    }
    float sm = 0.f;
#pragma unroll
    for (int i = 0; i < 16; ++i) { y[i] = xs[i] * ALPHA + y[i]; sm += y[i].x + y[i].y; }
    const float mean = wave_sum(sm) * (1.0f / 2048.0f);
    float sq = 0.f;
#pragma unroll
    for (int i = 0; i < 16; ++i) { y[i] = y[i] - mean; sq += y[i].x * y[i].x + y[i].y * y[i].y; }
    const float rstd = 1.0f / sqrtf(wave_sum(sq) * (1.0f / 2048.0f) + LN_EPS);
    unsigned pk[16];
#pragma unroll
    for (int q = 0; q < 8; ++q) { const int c0 = 32 * lane + 4 * q;
        const f32x4 ga = *(const GAS f32x4*)(gain + c0), ba = *(const GAS f32x4*)(bias + c0);
        f32x4 o;
        o[0] = y[2 * q].x * rstd * ga[0] + ba[0]; o[1] = y[2 * q].y * rstd * ga[1] + ba[1]; o[2] = y[2 * q + 1].x * rstd * ga[2] + ba[2]; o[3] = y[2 * q + 1].y * rstd * ga[3] + ba[3];
        if (outf) *(GAS f32x4*)(outf + c0) = o;
        pk[2 * q] = pk2(o[0], o[1]); pk[2 * q + 1] = pk2(o[2], o[3]); }
    if (outb) {
#pragma unroll
        for (int q = 0; q < 4; ++q) *(GAS v4u*)(outb + 32 * lane + 8 * q) = (v4u){pk[4 * q], pk[4 * q + 1], pk[4 * q + 2], pk[4 * q + 3]};
        float am = 0.f;
#pragma unroll
        for (int i = 0; i < 16; ++i) am = fmaxf(am, fmaxf(fabsf(bf_lo(pk[i])), fabsf(bf_hi(pk[i]))));
#pragma unroll
        for (int o = 1; o < 64; o <<= 1) am = fmaxf(am, __shfl_xor(am, o));
        const float sc = am > 0.f ? 127.0f / am : 0.f;
#pragma unroll
        for (int q = 0; q < 2; ++q) { v4u w;
            w.x = q8pack(bf_lo(pk[8 * q]), bf_hi(pk[8 * q]), bf_lo(pk[8 * q + 1]), bf_hi(pk[8 * q + 1]), sc); w.y = q8pack(bf_lo(pk[8 * q + 2]), bf_hi(pk[8 * q + 2]), bf_lo(pk[8 * q + 3]), bf_hi(pk[8 * q + 3]), sc);
            w.z = q8pack(bf_lo(pk[8 * q + 4]), bf_hi(pk[8 * q + 4]), bf_lo(pk[8 * q + 5]), bf_hi(pk[8 * q + 5]), sc); w.w = q8pack(bf_lo(pk[8 * q + 6]), bf_hi(pk[8 * q + 6]), bf_lo(pk[8 * q + 7]), bf_hi(pk[8 * q + 7]), sc);
            *(GAS v4u*)(out8 + 32 * lane + 16 * q) = w; }
        if (lane == 0) *outsx = am * (1.0f / 127.0f); }
#undef PEER_EIDX
}
#undef PEER_LOADROW
#undef PEER_AXPY8
#undef PEER_CVT4
}

__device__ __forceinline__ void ln_row(const bf16* zrow, const float* gain, const float* bias, bf16* outb, int lane) {
    float v[32]; float s = 0.f;
#pragma unroll
    for (int q = 0; q < 4; ++q) { const v4u w = *(const GAS v4u*)(zrow + 32 * lane + 8 * q);
        v[8 * q] = bf_lo(w.x); v[8 * q + 1] = bf_hi(w.x); v[8 * q + 2] = bf_lo(w.y); v[8 * q + 3] = bf_hi(w.y); v[8 * q + 4] = bf_lo(w.z); v[8 * q + 5] = bf_hi(w.z); v[8 * q + 6] = bf_lo(w.w); v[8 * q + 7] = bf_hi(w.w); }
#pragma unroll
    for (int i = 0; i < 32; ++i) s += v[i];
    const float mean = wave_sum(s) * (1.0f / 2048.0f); float s2 = 0.f;
#pragma unroll
    for (int i = 0; i < 32; ++i) { v[i] -= mean; s2 += v[i] * v[i]; }
    const float rstd = 1.0f / sqrtf(wave_sum(s2) * (1.0f / 2048.0f) + LN_EPS);
#pragma unroll
    for (int q = 0; q < 4; ++q) { const int c0 = 32 * lane + 8 * q;
        const f32x4 g0 = *(const GAS f32x4*)(gain + c0), g1 = *(const GAS f32x4*)(gain + c0 + 4), b0 = *(const GAS f32x4*)(bias + c0), b1 = *(const GAS f32x4*)(bias + c0 + 4);
        v4u o; o.x = pk2(v[8 * q] * rstd * g0[0] + b0[0], v[8 * q + 1] * rstd * g0[1] + b0[1]); o.y = pk2(v[8 * q + 2] * rstd * g0[2] + b0[2], v[8 * q + 3] * rstd * g0[3] + b0[3]);
        o.z = pk2(v[8 * q + 4] * rstd * g1[0] + b1[0], v[8 * q + 5] * rstd * g1[1] + b1[1]); o.w = pk2(v[8 * q + 6] * rstd * g1[2] + b1[2], v[8 * q + 7] * rstd * g1[3] + b1[3]);
        *(GAS v4u*)(outb + c0) = o; }
}

#if MK_CHECK
namespace chk {
constexpr int CW_ERR = 2048;
__device__ __forceinline__ unsigned hash32(unsigned x) { x ^= x >> 16; x *= 0x7feb352du; x ^= x >> 15; x *= 0x846ca68bu; x ^= x >> 16; return x; }
__device__ __forceinline__ float bf2f(bf16 v) { return __builtin_bit_cast(float, (unsigned)v << 16); }
__device__ __forceinline__ void report(gu32* ctl, int stage, float d2, float r2) { atomicAdd((float*)(ctl + CW_ERR + 2 * stage), d2); atomicAdd((float*)(ctl + CW_ERR + 2 * stage + 1), r2); }
__device__ __forceinline__ float dotcol(const bf16* xr, const float* win, int n, int lane) { float a = 0.f; for (int k = lane; k < 2048; k += 64) a += bf2f(xr[k]) * win[(size_t)k * INC + n]; return wave_sum(a); }
__device__ __forceinline__ void check_inproj(gu32* ctl, const bf16* xin, const int* pos, const float* win, const bf16* qa, const bf16* ka, const bf16* qd, const bf16* kd, const bf16* vt, const bf16* ga, const bf16* gb, int gw, int ngw, int lane) {
    for (int s = gw; s < 4096; s += ngw) {
        const unsigned hsh = hash32(s * 2654435761u + 12345u);
        const int t = hsh % T, kind = (hsh >> 14) % 8;
        const unsigned h2 = hash32(hsh);
        const bf16* xr = xin + (size_t)t * 2048;
        float ref, got;
        if (kind == 0 || kind == 1) { const int head = h2 % 8, i = (h2 >> 3) % 64, nb = (kind == 0 ? 0 : 1024) + head * 128;
            const float t1 = dotcol(xr, win, nb + i, lane), t2 = dotcol(xr, win, nb + i + 64, lane);
            const float ang = (float)pos[t] * powf(10000.0f, -(float)(2 * i) / 128.0f), c = cosf(ang), sn = sinf(ang);
            const bool second = (h2 >> 9) & 1; ref = second ? (t1 * sn + t2 * c) : (t1 * c - t2 * sn);
            const bf16* p = (kind == 0 ? qa : ka) + (size_t)t * 1024 + head * 128 + i + (second ? 64 : 0);
            got = bf2f(*p) / (kind == 0 ? QSCALE_A : 1.0f);
        } else if (kind == 3 || kind == 4) { const int head = h2 % 8, comp = (h2 >> 3) & 1, i = (h2 >> 4) % 32, nb = (kind == 3 ? 3072 : 4096) + head * 128 + comp * 64;
            const float t1 = dotcol(xr, win, nb + i, lane), t2 = dotcol(xr, win, nb + i + 32, lane);
            const float ang = (float)pos[t] * powf(10000.0f, -(float)(2 * i) / 64.0f), c = cosf(ang), sn = sinf(ang);
            const bool second = (h2 >> 9) & 1; ref = second ? (t1 * sn + t2 * c) : (t1 * c - t2 * sn);
            const bf16* p = (kind == 3 ? qd : kd) + (size_t)t * 1024 + head * 128 + comp * 64 + i + (second ? 32 : 0);
            got = bf2f(*p) / (kind == 3 ? QSCALE_B : 1.0f);
        } else if (kind == 2 || kind == 5) { const int c = h2 % 1024; ref = dotcol(xr, win, (kind == 2 ? 2048 : 5120) + c, lane); got = bf2f(vt[(size_t)((kind == 2 ? 0 : 1024) + c) * T + t]);
        } else { const int c = h2 % 2048; const float v = dotcol(xr, win, (kind == 6 ? 6144 : 8192) + c, lane); ref = 1.0f / (1.0f + expf(-v)); got = (float)((const unsigned char*)(kind == 6 ? ga : gb))[(size_t)t * 2048 + c] * (1.0f / 255.0f); }
        if (lane == 0) report(ctl, 0, (got - ref) * (got - ref), ref * ref);
    }
}
__device__ __forceinline__ void check_kmean(gu32* ctl, const bf16* ka, const float* kmean, int gw, int ngw, int lane) {
    for (int s = gw; s < 1024; s += ngw) { const unsigned hsh = hash32(s * 40503u + 77u); const int item = hsh % 512, d = (hsh >> 10) % 128; const int b = item >> 7, h = (item >> 4) & 7, blk = item & 15;
        float a = 0.f; for (int r = lane; r < 256; r += 64) a += bf2f(ka[(size_t)(b * SEQ + blk * 256 + r) * 1024 + h * 128 + d]); a = wave_sum(a);
        const float g = kmean[(size_t)item * 128 + d];
        if (lane == 0) report(ctl, 1, (g - a) * (g - a), a * a + 1.0f); }
}
__device__ __forceinline__ void check_attn(LAS unsigned char* lds, gu32* ctl, const att::AttnArgs& A, int vcu, int G, int tid, int lane, int wave) {
    LAS float* sc = (LAS float*)lds; LAS float* red = sc + 4096; LAS float* ovec = red + 64; LAS float* gsc = ovec + 256; LAS unsigned* selw = (LAS unsigned*)(gsc + 16);
    for (int s = vcu; s < 1024; s += G) {
        const unsigned hsh = hash32(s * 2246822519u + 99u); const bool moba = (s & 1);
        const int b = hsh % NB, h = (hsh >> 2) % NH; int t = (hsh >> 5) % SEQ; if ((s & 6) == 0) t = (t & 255) + 256 * ((hsh >> 20) % 3);
        const size_t row = (size_t)b * SEQ + t; const int own = t >> 8;
        float o0 = 0.f, o1 = 0.f;
        const int ncomp = moba ? 1 : 2;
        __syncthreads();
        if (moba) {
            if (tid < 16) { float a = -INFINITY; if (tid < own) { a = 0.f; for (int d = 0; d < 128; ++d) a += bf2f(A.qa[row * 1024 + h * 128 + d]) * A.kmean[((size_t)(b * 8 + h) * 16 + tid) * 128 + d]; } gsc[tid] = a; }
            __syncthreads();
            if (tid == 0) { unsigned sel = 0u; for (int r = 0; r < 3; ++r) { float best = -INFINITY; int bi = -1; for (int n = 0; n < own; ++n) { const float g = gsc[n]; if (!((sel >> n) & 1u) && g > best) { best = g; bi = n; } } if (bi >= 0) sel |= 1u << bi; } selw[0] = sel; }
            __syncthreads();
        }
        const unsigned sel = moba ? selw[0] : 0u;
        for (int comp = 0; comp < ncomp; ++comp) {
            const bf16* qp = moba ? A.qa + row * 1024 + h * 128 : A.qd + row * 1024 + h * 128 + comp * 64;
            const bf16* kb = moba ? A.ka + (size_t)b * SEQ * 1024 + h * 128 : A.kd + (size_t)b * SEQ * 1024 + h * 128 + comp * 64;
            const int dq = moba ? 128 : 64;
            float lmax = -INFINITY;
            for (int k = tid; k <= t; k += 512) { bool ok = true; if (moba) { const int kbk = k >> 8; ok = (kbk == own) || ((sel >> kbk) & 1u); }
                float a = -INFINITY; if (ok) { a = 0.f; for (int d = 0; d < dq; ++d) a += bf2f(qp[d]) * bf2f(kb[(size_t)k * 1024 + d]); }
                sc[k] = a; lmax = fmaxf(lmax, a); }
            lmax = fmaxf(lmax, __shfl_xor(lmax, 1)); lmax = fmaxf(lmax, __shfl_xor(lmax, 2)); lmax = fmaxf(lmax, __shfl_xor(lmax, 4)); lmax = fmaxf(lmax, __shfl_xor(lmax, 8)); lmax = fmaxf(lmax, __shfl_xor(lmax, 16)); lmax = fmaxf(lmax, __shfl_xor(lmax, 32));
            if (lane == 0) red[wave] = lmax;
            __syncthreads();
            float gmax = red[0]; for (int w = 1; w < 8; ++w) gmax = fmaxf(gmax, red[w]);
            float lsum = 0.f;
            for (int k = tid; k <= t; k += 512) { const float p = exp2f(sc[k] - gmax); sc[k] = p; lsum += p; }
            lsum = wave_sum(lsum);
            if (lane == 0) red[8 + wave] = lsum;
            __syncthreads();
            float gsum = 0.f; for (int w = 0; w < 8; ++w) gsum += red[8 + w];
            if (tid < 128) { const bf16* vp = A.vt + (size_t)((moba ? 0 : 1024) + h * 128 + tid) * T + (size_t)b * SEQ; float a = 0.f; for (int k = 0; k <= t; ++k) a += sc[k] * bf2f(vp[k]); a /= gsum; if (comp == 0) o0 = a; else o1 = a; }
            __syncthreads();
        }
        float ref = 0.f, got = 0.f;
        if (tid < 128) {
            if (moba) { ref = o0; got = bf2f(A.oab[row * 2048 + h * 128 + tid]); }
            else { ref = o0 - A.lam * o1; got = bf2f(A.oab[row * 2048 + 1024 + h * 128 + tid]); }
            ovec[tid] = ref;
        }
        __syncthreads();
        if (tid < 128 && !moba) { float ss = 0.f; for (int d = 0; d < 128; ++d) ss += ovec[d] * ovec[d]; ref = ref / sqrtf(ss * (1.0f / 128.0f) + RMS_EPS) * A.gain[h * 128 + tid] * A.one_minus_li; }
        float d2 = (tid < 128) ? (got - ref) * (got - ref) : 0.f, r2 = (tid < 128) ? ref * ref : 0.f;
        d2 = wave_sum(d2); r2 = wave_sum(r2);
        if (lane == 0 && wave < 2) report(ctl, moba ? 2 : 3, d2, r2);
        __syncthreads();
    }
}
__device__ __forceinline__ void check_merged(gu32* ctl, const bf16* oab, const bf16* ga, const bf16* gb, const bf16* merged, const float* wa, const float* wb, int gw, int ngw, int lane) {
    for (int s = gw; s < 2048; s += ngw) { const unsigned hsh = hash32(s * 3266489917u + 5u); const int t = hsh % T, c = (hsh >> 14) % 2048;
        float a = 0.f, b = 0.f; for (int k = lane; k < 1024; k += 64) { a += bf2f(oab[(size_t)t * 2048 + k]) * wa[(size_t)k * 2048 + c]; b += bf2f(oab[(size_t)t * 2048 + 1024 + k]) * wb[(size_t)k * 2048 + c]; }
        a = wave_sum(a); b = wave_sum(b);
        const float ref = ((float)((const unsigned char*)ga)[(size_t)t * 2048 + c] * a + (float)((const unsigned char*)gb)[(size_t)t * 2048 + c] * b) * (1.0f / 255.0f), got = bf2f(merged[(size_t)t * 2048 + c]);
        if (lane == 0) report(ctl, 4, (got - ref) * (got - ref), ref * ref); }
}
__device__ __forceinline__ void check_z(gu32* ctl, const bf16* merged, const float* wo, const bf16* xres, const bf16* z, int gw, int ngw, int lane) {
    for (int s = gw; s < 2048; s += ngw) { const unsigned hsh = hash32(s * 668265263u + 31u); const int t = hsh % T, c = (hsh >> 14) % 2048;
        float a = 0.f; for (int k = lane; k < 2048; k += 64) a += bf2f(merged[(size_t)t * 2048 + k]) * wo[(size_t)k * 2048 + c];
        a = wave_sum(a);
        const float got = bf2f(z[(size_t)t * 2048 + c]) - ALPHA * bf2f(xres[(size_t)t * 2048 + c]);
        if (lane == 0) report(ctl, 5, (got - a) * (got - a), a * a); }
}
}
#endif

constexpr int NPHASE = 2 + 8 * DEPTH;
#ifndef MK_ALIGN
#define MK_ALIGN true
#endif
#ifndef MK_SP2
#define MK_SP2 true
#endif
struct Params { const float* in[16]; float* out; unsigned char* ws; int ph_lo, ph_hi; };

__global__ void __launch_bounds__(NWAVES * 64, 2) mk_fwd(Params args) {
    extern __shared__ __attribute__((aligned(16))) unsigned char lds_raw[];
    Frame F;
    F.lds = (LAS unsigned char*)lds_raw;
    F.MISC = (volatile LAS unsigned*)(F.lds + MISC_OFF);
    F.tid = threadIdx.x; F.lane = F.tid & 63; F.wave = __builtin_amdgcn_readfirstlane(F.tid >> 6);
    F.G = gridDim.x; { const int bx = blockIdx.x; F.vcu = (F.G % 8 == 0) ? (bx % 8) * (F.G / 8) + bx / 8 : bx; }
    F.ws = args.ws; F.ctl = (gu32*)(args.ws + WS_CTL);
    unsigned char* const ws = args.ws;
    const float* const in_x = args.in[0]; const int* const in_pos = (const int*)args.in[1];
    const float *in_win = args.in[2], *in_wa = args.in[3], *in_wb = args.in[4], *in_wo = args.in[5], *in_dlam = args.in[6], *in_dgain = args.in[7];
    const float *in_ln1g = args.in[8], *in_ln1b = args.in[9], *in_ln2g = args.in[10], *in_ln2b = args.in[11], *in_pwq = args.in[12], *in_sk = args.in[13], *in_pu = args.in[14], *in_pv = args.in[15];
    float* const dout = args.out;

    for (int u = F.tid; u < (LDS_BYTES - LDSCTL_OFF) / 4; u += NWAVES * 64) ((LAS unsigned*)(F.lds + LDSCTL_OFF))[u] = 0u;
    __syncthreads();
#if MK_FUSED
    XcdBarrier bar = xcd_barrier_post((unsigned*)(F.ctl + CW_BAR), F.MISC + 8, (unsigned)F.wave);
#define GRID_BAR() xcd_barrier(bar)
#else
#define GRID_BAR() do { } while (0)
#endif
    const int lo = args.ph_lo, hi = args.ph_hi;
#define IN(k) (lo <= (k) && (k) < hi)
#define BOTH(k) (IN(k) && IN((k) + 1))

    float* const cosA = (float*)(ws + WS_ROPE); float* const sinA = cosA + (size_t)T * 64; float* const cosB = sinA + (size_t)T * 64; float* const sinB = cosB + (size_t)T * 32;
    bf16* const XB = (bf16*)(ws + WS_XB);

    gu32* const wmax = F.ctl + CW_WMAX;
    if (IN(0)) {
        for (int it = F.wave * F.G + F.vcu; it < DEPTH * 16 * 40; it += F.G * NWAVES) { const int layer = it / 640;
            p0_absmax_item(in_win + (size_t)layer * 2048 * 10240, it % 640, F.lane, wmax + layer * 10240); }
        if (BOTH(0)) GRID_BAR();
    }
    if (IN(1)) {
        LAS float* scr = (LAS float*)(F.lds + F.wave * 16384);
        const int gw = F.vcu * NWAVES + F.wave, NGW = F.G * NWAVES;
        constexpr int I_IN = (2048 / 64) * (10240 / 32), I_A = (1024 / 64) * (2048 / 32), I_O = (2048 / 64) * (2048 / 32);
        constexpr int PER_LAYER = I_IN + 2 * I_A + 2 * I_O;
        for (int it = gw; it < DEPTH * PER_LAYER; it += NGW) {
            const int layer = it / PER_LAYER; int r = it % PER_LAYER;
            unsigned char* wl = ws + WS_W + (size_t)layer * W_LAYER;
            if (r < I_IN) { p0_transpose_item_i8(in_win + (size_t)layer * 2048 * 10240, 2048, 10240, wl + WO_MAIN, scr, r, F.lane, wmax + layer * 10240); continue; } r -= I_IN;
            if (r < I_A) { p0_transpose_item<false>(in_wa + (size_t)layer * 1024 * 2048, 1024, 2048, (bf16*)(wl + WO_A), scr, r, F.lane, 2048, 0); continue; } r -= I_A;
            if (r < I_A) { p0_transpose_item<false>(in_wb + (size_t)layer * 1024 * 2048, 1024, 2048, (bf16*)(wl + WO_A), scr, r, F.lane, 2048, 1024); continue; } r -= I_A;
            if (r < I_O) { p0_transpose_item<false>(in_wo + (size_t)layer * 2048 * 2048, 2048, 2048, (bf16*)(wl + WO_O), scr, r, F.lane); continue; } r -= I_O;
            p0_transpose_item<false>(in_pwq + (size_t)layer * 2048 * 2048, 2048, 2048, (bf16*)(wl + WO_Q), scr, r, F.lane);
        }
        const size_t gtid = (size_t)F.vcu * 512 + F.tid, gthreads = (size_t)F.G * 512;
        for (int r = gw; r < 4 * NEXP; r += NGW) { const int tab = r >> 14, e = r & (NEXP - 1);
            const float* src = ((tab & 1) ? in_pv : in_pu) + ((size_t)(tab >> 1) * NEXP + e) * 2048;
            p0_table_row(src, ws + WS_TAB + (size_t)tab * TAB_BYTES + (size_t)e * 1024, (float*)(ws + WS_TSC) + r, F.lane); }
        p0_convert(in_sk, (bf16*)(ws + WS_SK), (size_t)DEPTH * 2 * 8 * 128 * 128 / 8, gtid, gthreads);
        for (int row = gw; row < T; row += NGW) p0_x_row(in_x + (size_t)row * 2048, XB + (size_t)row * 2048, ws + WS_XI8 + (size_t)row * 2048, (float*)(ws + WS_SX) + row, F.lane);
        for (size_t i = gtid; i < (size_t)DEPTH * 10240; i += gthreads) { const int layer = (int)(i / 10240), n = (int)(i % 10240);
            ((float*)(ws + WS_SW))[layer * 10240 + inproj_row(n)] = __builtin_bit_cast(float, wmax[layer * 10240 + n]) * (1.0f / 127.0f); }
        for (size_t i = gtid; i < (size_t)T * 64; i += gthreads) { const int t = (int)(i >> 6), k = (int)(i & 63);
            const float invf = powf(10000.0f, -(float)(2 * k) / 128.0f); const float ang = (float)in_pos[t] * invf;
            cosA[i] = cosf(ang); sinA[i] = sinf(ang); }
        for (size_t i = gtid; i < (size_t)T * 32; i += gthreads) { const int t = (int)(i >> 5), k = (int)(i & 31);
            const float invf = powf(10000.0f, -(float)(2 * k) / 64.0f); const float ang = (float)in_pos[t] * invf;
            cosB[i] = cosf(ang); sinB[i] = sinf(ang); }
        if (BOTH(1)) GRID_BAR();
    }

    for (int layer = 0; layer < DEPTH; ++layer) {
        const int pb = 2 + 8 * layer;
        unsigned char* const wl = ws + WS_W + (size_t)layer * W_LAYER;
        bf16* const ZB = (bf16*)dout;
        float* const kmean = (float*)(ws + WS_KMEAN) + (size_t)layer * NB * NH * 16 * 128;
        const float lambda_init = layer == 0 ? 0.2f : 0.3555090675909306f;
#define PHASE_TID() int llane_ = lane_id(); asm volatile("" : "+v"(llane_)); const int llane = llane_, ltid = llane_ + 64 * F.wave
        if (IN(pb)) {
            const bf16* const XI8 = (const bf16*)(ws + WS_XI8); const float* const sx = (const float*)(ws + WS_SX); const float* const sw = (const float*)(ws + WS_SW) + layer * 10240;
            { pg8::Gemm g{XI8, (const bf16*)(wl + WO_MAIN), T, NMAIN, 1024}; pg8::StaticOrder S; S.init(T, NMAIN, F.G, (int)blockIdx.x);
              pg8::EpiInProjI8 E{(bf16*)(ws + WS_QA), (bf16*)(ws + WS_KA), (bf16*)(ws + WS_QD), (bf16*)(ws + WS_KD), (bf16*)(ws + WS_GA), (bf16*)(ws + WS_GB), cosA, sinA, cosB, sinB, QSCALE_A, QSCALE_B, sx, sw};
              pg8::gemm_phase<pg8::EpiInProjI8, pg8::StaticOrder, MK_ALIGN, MK_SP2, false, true>(F.lds, g, S, E, F.wave); }
            { pg8::Gemm g{(const bf16*)(wl + WO_V), XI8, NV, T, 1024}; pg8::StaticOrder S; S.init(NV, T, F.G, (int)blockIdx.x);
              pg8::EpiPlainI8 E{(bf16*)(ws + WS_VT), T, sw + NMAIN, sx};
              pg8::gemm_phase<pg8::EpiPlainI8, pg8::StaticOrder, MK_ALIGN, MK_SP2, false, true>(F.lds, g, S, E, F.wave); }
            if (BOTH(pb)) GRID_BAR();
        }
        if (IN(pb + 1)) {
            PHASE_TID();
            LAS float* part = (LAS float*)F.lds;
            const bf16* KA = (const bf16*)(ws + WS_KA);
#pragma unroll 1
            for (int item = F.vcu; item < NB * NH * 16; item += F.G) {
                const int b = item >> 7, h = (item >> 4) & 7, blk = item & 15;
                const int c = ltid & 15, rg = ltid >> 4;
                const bf16* kp = KA + (size_t)(b * SEQ + blk * 256 + rg) * 1024 + h * 128 + c * 8;
                float sacc[8] = {0.f, 0.f, 0.f, 0.f, 0.f, 0.f, 0.f, 0.f};
#pragma unroll
                for (int i = 0; i < 8; ++i) { const v4u w = *(const GAS v4u*)(kp + (size_t)(32 * i) * 1024);
                    sacc[0] += bf_lo(w.x); sacc[1] += bf_hi(w.x); sacc[2] += bf_lo(w.y); sacc[3] += bf_hi(w.y); sacc[4] += bf_lo(w.z); sacc[5] += bf_hi(w.z); sacc[6] += bf_lo(w.w); sacc[7] += bf_hi(w.w); }
#pragma unroll
                for (int j = 0; j < 8; ++j) part[rg * 128 + c * 8 + j] = sacc[j];
                __syncthreads();
                if (ltid < 128) { float t = 0.f;
#pragma unroll
                    for (int r = 0; r < 32; ++r) t += part[r * 128 + ltid];
                    kmean[(size_t)item * 128 + ltid] = t; }
                __syncthreads();
            }
            if (BOTH(pb + 1)) GRID_BAR();
        }
        if (IN(pb + 2)) {
            PHASE_TID();
            const float* lp = in_dlam + (size_t)layer * 256;
            const float s1 = wave_sum(lp[llane] * lp[64 + llane]), s2 = wave_sum(lp[128 + llane] * lp[192 + llane]);
            float lam = __builtin_bit_cast(float, __builtin_amdgcn_readfirstlane(__builtin_bit_cast(int, expf(s1) - expf(s2) + lambda_init))), oml = __builtin_bit_cast(float, __builtin_amdgcn_readfirstlane(layer == 0 ? 0x3f4ccccd : 0x3f24fd5c));
            att::AttnArgs A{(const bf16*)(ws + WS_QA), (const bf16*)(ws + WS_KA), (const bf16*)(ws + WS_QD), (const bf16*)(ws + WS_KD), (const bf16*)(ws + WS_VT),
                            (bf16*)(ws + WS_OA), kmean, in_dgain + (size_t)layer * 1024, lam, oml};
            att::attn_phase(F.lds, A, F.vcu, F.G, ltid, F.wave, llane);
            if (BOTH(pb + 2)) GRID_BAR();
        }
        if (IN(pb + 3)) {
            { pg8::Gemm g{(const bf16*)(ws + WS_OA), (const bf16*)(wl + WO_A), T, 2048, 2048}; pg8::StaticOrder S; S.init(T, 2048, F.G, (int)blockIdx.x);
              pg8::EpiBranch E{(const bf16*)(ws + WS_GA), (const bf16*)(ws + WS_GB), (bf16*)(ws + WS_MERGED), 2048};
              pg8::gemm_phase<pg8::EpiBranch, pg8::StaticOrder, MK_ALIGN, MK_SP2, true>(F.lds, g, S, E, F.wave); }
            if (BOTH(pb + 3)) GRID_BAR();
        }
        if (IN(pb + 4)) {
            pg8::Gemm g{(const bf16*)(ws + WS_MERGED), (const bf16*)(wl + WO_O), T, 2048, 2048}; pg8::StaticOrder S; S.init(T, 2048, F.G, (int)blockIdx.x);
            pg8::EpiOutProj E{XB, ZB, 2048, ALPHA};
            pg8::gemm_phase<pg8::EpiOutProj, pg8::StaticOrder, MK_ALIGN, MK_SP2>(F.lds, g, S, E, F.wave);
            if (BOTH(pb + 4)) GRID_BAR();
        }
        if (IN(pb + 5)) {
            PHASE_TID();
            const int gw = F.vcu * NWAVES + F.wave, NGW = F.G * NWAVES;
            for (int m = gw; m < T; m += NGW) ln_row(ZB + (size_t)m * 2048, in_ln1g + (size_t)layer * 2048, in_ln1b + (size_t)layer * 2048, XB + (size_t)m * 2048, llane);
            if (BOTH(pb + 5)) GRID_BAR();
        }
        if (IN(pb + 6)) {
            pg8::Gemm g{XB, (const bf16*)(wl + WO_Q), T, 2048, 2048}; pg8::StaticOrder S; S.init(T, 2048, F.G, (int)blockIdx.x);
            pg8::EpiPlainBf16 E{(bf16*)(ws + WS_PQ), 2048};
            pg8::gemm_phase<pg8::EpiPlainBf16, pg8::StaticOrder, MK_ALIGN, MK_SP2>(F.lds, g, S, E, F.wave);
            if (BOTH(pb + 6)) GRID_BAR();
        }
        if (IN(pb + 7)) {
            const unsigned char* TU = ws + WS_TAB + (size_t)(2 * layer) * TAB_BYTES; const unsigned char* TV = ws + WS_TAB + (size_t)(2 * layer + 1) * TAB_BYTES;
            const float* SU = (const float*)(ws + WS_TSC) + (size_t)(2 * layer) * NEXP; const float* SV = SU + NEXP;
            const bf16* sk = (const bf16*)(ws + WS_SK) + (size_t)layer * 2 * 8 * 128 * 128;
            const bool last = (layer == DEPTH - 1);
            PHASE_TID();
            v4u* const pscr = (v4u*)(ws + WS_PSCR + (size_t)F.vcu * 32768);
#pragma unroll 1
            for (int ta = F.vcu; ta < T / 32; ta += 2 * F.G) {
                const int tb = ta + F.G; const bool pair = tb < T / 32, sw = pair && (F.vcu & 1);
                const int nst = sw ? 6 : (pair ? 4 : 2);
#pragma unroll 1
                for (int st = 0; st < nst; ++st) {
                    int op, tile;
                    if (sw) { op = (st == 0 || st == 2) ? 0 : (st == 1 ? 2 : (st == 4 ? 3 : 1)); tile = (st == 0 || st == 5) ? tb : ta; }
                    else { op = st & 1; tile = st < 2 ? ta : tb; }
                    const int t0 = tile * 32;
                    if (op == 0) peer::select_tile(F.lds, (const bf16*)(ws + WS_PQ), sk, t0, F.wave, llane);
                    else if (op == 1) {
                    v4u ring[16];
#pragma unroll
                    for (int s = 0; s < 16; ++s) ring[s] = (v4u){0u, 0u, 0u, 0u};
#pragma unroll 1
                    for (int i = 0; i < 4; ++i) { const int tl = F.wave * 4 + i; const size_t t = (size_t)(t0 + tl);
                        peer::token_ffn(F.lds, tl, XB + t * 2048, TU, TV, SU, SV, in_ln2g + (size_t)layer * 2048, in_ln2b + (size_t)layer * 2048, last ? dout + t * 2048 : (float*)nullptr, last ? (bf16*)nullptr : XB + t * 2048, ws + WS_XI8 + t * 2048, (float*)(ws + WS_SX) + t, llane, ring, i > 0, i < 3); }
                    } else if (op == 2) {
#pragma unroll
                        for (int q = 0; q < 4; ++q) pscr[ltid + 512 * q] = *(const LAS v4u*)(F.lds + (size_t)(ltid + 512 * q) * 16);
                    } else {
#pragma unroll
                        for (int q = 0; q < 4; ++q) *(LAS v4u*)(F.lds + (size_t)(ltid + 512 * q) * 16) = pscr[ltid + 512 * q];
                    }
                    __syncthreads();
                }
            }
            if (BOTH(pb + 7)) GRID_BAR();
        }
    }
#undef PHASE_TID
#undef IN
#undef BOTH
#undef GRID_BAR
}

#if MK_CHECK
__global__ void __launch_bounds__(NWAVES * 64, 2) chk_kernel(Params args, int layer, int which) {
    extern __shared__ __attribute__((aligned(16))) unsigned char lds_raw[];
    LAS unsigned char* lds = (LAS unsigned char*)lds_raw;
    const int tid = threadIdx.x, lane = tid & 63, wave = __builtin_amdgcn_readfirstlane(tid >> 6), G = gridDim.x, vcu = blockIdx.x;
    unsigned char* const ws = args.ws; gu32* ctl = (gu32*)(ws + WS_CTL);
    const bf16* xresb = (const bf16*)(ws + WS_XB);
    float* const kmean = (float*)(ws + WS_KMEAN) + (size_t)layer * NB * NH * 16 * 128;
    const float lambda_init = layer == 0 ? 0.2f : 0.3555090675909306f;
    const int gw = vcu * NWAVES + wave, NGW = G * NWAVES;
    if (which == 0) {
        const float* lp = args.in[6] + (size_t)layer * 256;
        const float s1 = wave_sum(lp[lane] * lp[64 + lane]), s2 = wave_sum(lp[128 + lane] * lp[192 + lane]);
        const float lam = expf(s1) - expf(s2) + lambda_init;
        att::AttnArgs A{(const bf16*)(ws + WS_QA), (const bf16*)(ws + WS_KA), (const bf16*)(ws + WS_QD), (const bf16*)(ws + WS_KD), (const bf16*)(ws + WS_VT),
                        (bf16*)(ws + WS_OA), kmean, args.in[7] + (size_t)layer * 1024, lam, 1.0f - lambda_init};
        chk::check_inproj(ctl, xresb, (const int*)args.in[1], args.in[2] + (size_t)layer * 2048 * 10240, A.qa, A.ka, A.qd, A.kd, A.vt, (const bf16*)(ws + WS_GA), (const bf16*)(ws + WS_GB), gw, NGW, lane);
        chk::check_kmean(ctl, A.ka, kmean, gw, NGW, lane);
        chk::check_attn(lds, ctl, A, vcu, G, tid, lane, wave);
    } else if (which == 3) {
        const float oscale = 1.0f + 0.04f * (float)__hip_atomic_load(ctl + chk::CW_ERR + 64, RLX_AGENT);
        for (size_t i = (size_t)vcu * 512 + tid; i < (size_t)T * 2048 / 4; i += (size_t)G * 512) { f32x4 v = *(GAS f32x4*)(args.out + i * 4); v = v * oscale; *(GAS f32x4*)(args.out + i * 4) = v; }
    } else if (which == 2) {
        if (vcu == 0 && tid == 0) { const float tol[6] = {1e-3f, 1e-4f, 3e-2f, 3e-3f, 1e-3f, 1e-3f}; unsigned code = 0;
            for (int st = 0; st < 6; ++st) { const float d2 = __builtin_bit_cast(float, __hip_atomic_load(ctl + chk::CW_ERR + 2 * st, RLX_AGENT)), r2 = __builtin_bit_cast(float, __hip_atomic_load(ctl + chk::CW_ERR + 2 * st + 1, RLX_AGENT));
                if (!(d2 <= tol[st] * r2) || !(r2 > 0.f)) code |= 1u << st; }
#ifdef MK_CHECK_STAGE
            { const float d2 = __builtin_bit_cast(float, __hip_atomic_load(ctl + chk::CW_ERR + 2 * MK_CHECK_STAGE, RLX_AGENT)), r2 = __builtin_bit_cast(float, __hip_atomic_load(ctl + chk::CW_ERR + 2 * MK_CHECK_STAGE + 1, RLX_AGENT));
              float ratio = d2 / r2; ratio = fminf(fmaxf(ratio, 1e-8f), 1e4f); code = (unsigned)(int)(4.0f * (log10f(ratio) + 8.0f) + 0.5f); }
#endif
            __hip_atomic_store(ctl + chk::CW_ERR + 64, code, RLX_AGENT); }
    } else {
        chk::check_merged(ctl, (const bf16*)(ws + WS_OA), (const bf16*)(ws + WS_GA), (const bf16*)(ws + WS_GB), (const bf16*)(ws + WS_MERGED), args.in[3] + (size_t)layer * 1024 * 2048, args.in[4] + (size_t)layer * 1024 * 2048, gw, NGW, lane);
        chk::check_z(ctl, (const bf16*)(ws + WS_MERGED), args.in[5] + (size_t)layer * 2048 * 2048, xresb, (const bf16*)args.out, gw, NGW, lane);
    }
}
#endif

extern "C" void kernel_launch(void* const* d_in, const int* in_sizes, int n_in, void* d_out, int out_size, void* d_ws, size_t ws_size, hipStream_t stream) {
    static int grid = 0;
    if (grid == 0) {
        if (n_in != 16 || out_size != T * DM || ws_size < WS_END) { fprintf(stderr, "kernel_launch: unexpected problem (n_in %d, out %d, ws %zu < %zu); nothing launched\n", n_in, out_size, ws_size, (size_t)WS_END); grid = -1; return; }
        int dev = 0, cus = 0, per_cu = 0;
        if (hipGetDevice(&dev) != hipSuccess || hipDeviceGetAttribute(&cus, hipDeviceAttributeMultiprocessorCount, dev) != hipSuccess) { fprintf(stderr, "kernel_launch: device query failed\n"); grid = -1; return; }
#if MK_CHECK
        (void)hipFuncSetAttribute((const void*)chk_kernel, hipFuncAttributeMaxDynamicSharedMemorySize, LDS_BYTES);
#endif
        if (hipFuncSetAttribute((const void*)mk_fwd, hipFuncAttributeMaxDynamicSharedMemorySize, LDS_BYTES) != hipSuccess) { fprintf(stderr, "kernel_launch: hipFuncSetAttribute failed\n"); grid = -1; return; }
        if (hipOccupancyMaxActiveBlocksPerMultiprocessor(&per_cu, (const void*)mk_fwd, NWAVES * 64, LDS_BYTES) != hipSuccess || per_cu < 1) { fprintf(stderr, "kernel_launch: occupancy query says %d blocks per CU; nothing launched\n", per_cu); (void)hipGetLastError(); grid = -1; return; }
        grid = cus;
    }
    if (grid < 0) return;
    (void)hipMemsetAsync((char*)d_ws + WS_CTL, 0, CTL_ZERO_BYTES, stream);
    Params a{};
    for (int i = 0; i < 16; ++i) a.in[i] = (const float*)d_in[i];
    a.out = (float*)d_out; a.ws = (unsigned char*)d_ws;
#if MK_FUSED
    a.ph_lo = 0; a.ph_hi = NPHASE;
    hipLaunchKernelGGL(mk_fwd, dim3(grid), dim3(NWAVES * 64), LDS_BYTES, stream, a);
#else
    for (int ph = 0; ph < NPHASE; ++ph) { a.ph_lo = ph; a.ph_hi = ph + 1; hipLaunchKernelGGL(mk_fwd, dim3(grid), dim3(NWAVES * 64), LDS_BYTES, stream, a);
#if MK_CHECK
        if (ph == 2 + 8 * MK_CHECK_LAYER + 2) hipLaunchKernelGGL(chk_kernel, dim3(grid), dim3(NWAVES * 64), LDS_BYTES, stream, a, (int)MK_CHECK_LAYER, 0);
        if (ph == 2 + 8 * MK_CHECK_LAYER + 4) hipLaunchKernelGGL(chk_kernel, dim3(grid), dim3(NWAVES * 64), LDS_BYTES, stream, a, (int)MK_CHECK_LAYER, 1);
        if (ph == NPHASE - 2) hipLaunchKernelGGL(chk_kernel, dim3(grid), dim3(NWAVES * 64), LDS_BYTES, stream, a, (int)MK_CHECK_LAYER, 2);
        if (ph == NPHASE - 1) hipLaunchKernelGGL(chk_kernel, dim3(grid), dim3(NWAVES * 64), LDS_BYTES, stream, a, (int)MK_CHECK_LAYER, 3);
#endif
    }
#endif
}
```

```cpp
#include <hip/hip_runtime.h>
#include <cstdio>
#include <cstdint>

#ifndef MK_FUSED
#define MK_FUSED 1
#endif
#ifndef MK_CHECK
#define MK_CHECK 0
#endif
#ifndef MK_CHECK_LAYER
#define MK_CHECK_LAYER 0
#endif

namespace cfg {
constexpr int DM = 2048, NB = 4, SEQ = 4096, T = NB * SEQ, DEPTH = 2;
constexpr int NH = 8, HD = 128, AW = NH * HD;
constexpr int INC = 10240;
constexpr int NMAIN = 8192, NV = 2048;
constexpr int PH = 8, PKEYS = 128, PTOP = 16, NEXP = PKEYS * PKEYS, PHALF = 128;
constexpr float LN_EPS = 1e-5f, RMS_EPS = 1e-6f;
constexpr float ALPHA = 1.4142135623730951f;
constexpr float LOG2E = 1.4426950408889634f;
constexpr float QSCALE_A = 0.08838834764831845f * LOG2E;
constexpr float QSCALE_B = 0.125f * LOG2E;
}
using namespace cfg;

constexpr size_t MiB = 1u << 20;
constexpr size_t WS_CTL = 0, CTL_ZERO_BYTES = 1 * MiB;
constexpr size_t WS_SK = 1 * MiB;
constexpr size_t WS_KMEAN = 2 * MiB;
constexpr size_t WS_TSC = 3 * MiB;
constexpr size_t WS_ROPE = 4 * MiB;
constexpr size_t WS_W = 20 * MiB, W_LAYER = 64 * MiB;
constexpr size_t WO_MAIN = 0, WO_V = 16 * MiB, WO_A = 40 * MiB, WO_O = 48 * MiB, WO_Q = 56 * MiB;
constexpr size_t WS_TAB = 148 * MiB, TAB_BYTES = 16 * MiB;
constexpr size_t WS_XI8 = 212 * MiB;
constexpr size_t WS_SX = 244 * MiB;
constexpr size_t WS_SW = 245 * MiB;
constexpr size_t WS_PSCR = 248 * MiB;
constexpr size_t WS_XB = 404 * MiB;
constexpr size_t WS_QA = 596 * MiB, WS_KA = 628 * MiB, WS_QD = 660 * MiB, WS_KD = 692 * MiB;
constexpr size_t WS_PQ = WS_QA;
constexpr size_t WS_VT = 724 * MiB;
constexpr size_t WS_MERGED = WS_VT;
constexpr size_t WS_GA = 788 * MiB, WS_GB = 852 * MiB;
constexpr size_t WS_OA = 916 * MiB;
constexpr size_t WS_END = 980 * MiB;

constexpr int CW_BAR = 4096;
constexpr int CW_WMAX = 16384;

constexpr int RING_BYTES = 131072;
constexpr int LDSCTL_OFF = RING_BYTES, MISC_OFF = LDSCTL_OFF + 320;
constexpr int LDS_BYTES = 147456;
constexpr int NWAVES = 8;

#define GAS __attribute__((address_space(1)))
#define LAS __attribute__((address_space(3)))
typedef unsigned short bf16;
typedef unsigned v4u __attribute__((ext_vector_type(4)));
typedef unsigned v2u __attribute__((ext_vector_type(2)));
typedef float f32x4 __attribute__((ext_vector_type(4)));
typedef float f32x16 __attribute__((ext_vector_type(16)));
typedef short bf16x8 __attribute__((ext_vector_type(8)));
typedef GAS unsigned gu32;
#define RLX_AGENT __ATOMIC_RELAXED, __HIP_MEMORY_SCOPE_AGENT
#define LDS_WAIT() asm volatile("s_waitcnt lgkmcnt(0)" ::: "memory")
#define VM_WAIT() asm volatile("s_waitcnt vmcnt(0)" ::: "memory")
__device__ __forceinline__ unsigned f2bf(float f) { unsigned u = __builtin_bit_cast(unsigned, f); return (u + 0x7fffu + ((u >> 16) & 1u)) >> 16; }
__device__ __forceinline__ unsigned pk2(float lo, float hi) { return f2bf(lo) | (f2bf(hi) << 16); }
__device__ __forceinline__ float bf_lo(unsigned w) { return __builtin_bit_cast(float, w << 16); }
__device__ __forceinline__ float bf_hi(unsigned w) { return __builtin_bit_cast(float, w & 0xffff0000u); }
__device__ __forceinline__ float fexp2(float x) { return __builtin_amdgcn_exp2f(x); }
__device__ __forceinline__ float frcp(float x) { return __builtin_amdgcn_rcpf(x); }
__device__ __forceinline__ int lane_id() { return (int)__builtin_amdgcn_mbcnt_hi(~0u, __builtin_amdgcn_mbcnt_lo(~0u, 0u)); }
__device__ __forceinline__ float wave_sum(float v) {
#pragma unroll
    for (int o = 1; o < 64; o <<= 1) v += __shfl_xor(v, o);
    return v;
}
namespace pg8 {
#define PG8_LAS __attribute__((address_space(3)))
typedef unsigned short bf16_t;
typedef short bf16x8 __attribute__((ext_vector_type(8)));
typedef float f32x4 __attribute__((ext_vector_type(4)));
typedef unsigned u32x4 __attribute__((ext_vector_type(4)));
typedef int i32x4 __attribute__((ext_vector_type(4)));
constexpr int BM = 256, BK = 64, HALF = 128, HTB = HALF * BK * 2  , STAGE_BYTES = 8 * HTB, NXCD = 8, WGM = 8;

__host__ __device__ __forceinline__ int lds_byte(int r, int c) { const int st = (r >> 4) * 2 + (c >> 5), rr = r & 15, cc = c & 31, ob = rr * 64 + cc * 2; return st * 1024 + (ob ^ (((ob >> 9) & 1) << 5)); }
__host__ __device__ __forceinline__ void stage_rc(int b, int& R, int& C) { const int st = b / 1024, sb = b % 1024, swz = sb ^ (((sb >> 9) & 1) << 5); R = (st >> 1) * 16 + swz / 64; C = (st & 1) * 32 + (swz % 64) / 2; }
__host__ __device__ __forceinline__ int perm32(int rho) { const int n = rho >> 4, i = rho & 15; return 8 * (i >> 2) + 4 * n + (i & 3); }

template <bool I8> struct AccSel { typedef f32x4 type; };
template <> struct AccSel<true> { typedef i32x4 type; };
template <bool I8> __device__ __forceinline__ typename AccSel<I8>::type mma16(const bf16x8& b, const bf16x8& a, const typename AccSel<I8>::type& c) {
    if constexpr (I8) return __builtin_amdgcn_mfma_i32_16x16x64_i8(__builtin_bit_cast(i32x4, b), __builtin_bit_cast(i32x4, a), c, 0, 0, 0);
    else return __builtin_amdgcn_mfma_f32_16x16x32_bf16(b, a, c, 0, 0, 0);
}
struct Unit { int pm, pn; };
struct Gemm { const bf16_t* A; const bf16_t* Bt; int M, N, K; };

struct StaticOrder {
    int nM, nN, nwg, G, c;
    __host__ __device__ void init(int M, int N, int G_, int c_) { nM = M / BM; nN = N / BM; nwg = nM * nN; G = G_; c = c_; }
    __host__ __device__ bool next(int i, Unit& u) const {
        const long L = (long)i * G + c; if (L >= nwg) return false;
        int wgid = (int)L; { const int q = nwg / NXCD, r = nwg % NXCD, xcd = wgid % NXCD, off = wgid / NXCD; wgid = (xcd < r ? xcd * (q + 1) : r * (q + 1) + (xcd - r) * q) + off; }
        const int nig = WGM * nN, gid = wgid / nig, fm = gid * WGM, gsz = (nM - fm) < WGM ? (nM - fm) : WGM;
        u.pm = fm + ((wgid % nig) % gsz); u.pn = (wgid % nig) / gsz; return true;
    }
    __device__ __forceinline__ void a_ready(const Unit&) const {}
    __device__ __forceinline__ void done(const Unit&) const {}
};

typedef float f32x2cv __attribute__((ext_vector_type(2))); typedef __bf16 bf16x2cv __attribute__((ext_vector_type(2)));
__device__ __forceinline__ unsigned cvt_pk_bf16(float lo, float hi) { f32x2cv v = {lo, hi}; bf16x2cv b = __builtin_convertvector(v, bf16x2cv); return __builtin_bit_cast(unsigned, b); }

typedef unsigned u32x2 __attribute__((ext_vector_type(2)));
struct EpiPlainBf16 {
    static constexpr bool PERM = true, AFTER_DRAIN = false;
    bf16_t* O; int ldc;
    __device__ __forceinline__ void operator()(const f32x4 (&acc)[2][2][4][2], const Unit& u, int wr, int wc, int fr_, int fq_) const {
        int fr = fr_, fq = fq_; asm volatile("" : "+v"(fr), "+v"(fq));
        const int row0 = u.pm * BM + wr * 64 + fr, col0 = u.pn * BM + wc * 32 + 8 * fq;
#pragma unroll
        for (int ai = 0; ai < 2; ++ai)
#pragma unroll
            for (int m = 0; m < 4; ++m) { bf16_t* rowp = O + (size_t)(row0 + ai * HALF + m * 16) * ldc + col0;
#pragma unroll
                for (int bj = 0; bj < 2; ++bj) { const f32x4 v0 = acc[ai][bj][m][0], v1 = acc[ai][bj][m][1];
                    u32x4 w; w.x = cvt_pk_bf16(v0[0], v0[1]); w.y = cvt_pk_bf16(v0[2], v0[3]); w.z = cvt_pk_bf16(v1[0], v1[1]); w.w = cvt_pk_bf16(v1[2], v1[3]);
                    *(u32x4*)(rowp + bj * HALF) = w; } }
    }
};
struct EpiBranch {
    static constexpr bool PERM = true, AFTER_DRAIN = false;
    const bf16_t* ga; const bf16_t* gb; bf16_t* O; int ldc;
    __device__ __forceinline__ void mid(f32x4 (&acc)[2][2][4][2], const Unit& u, int wr, int wc, int fr_, int fq_) const {
        int fr = fr_, fq = fq_; asm volatile("" : "+v"(fr), "+v"(fq));
        const int row0 = u.pm * BM + wr * 64 + fr, col0 = u.pn * BM + wc * 32 + 8 * fq;
#pragma unroll
        for (int ai = 0; ai < 2; ++ai)
#pragma unroll
            for (int m = 0; m < 4; ++m) { const size_t off = (size_t)(row0 + ai * HALF + m * 16) * ldc + col0;
#pragma unroll
                for (int bj = 0; bj < 2; ++bj) { const u32x2 a = *(const u32x2*)((const unsigned char*)ga + off + bj * HALF), b = *(const u32x2*)((const unsigned char*)gb + off + bj * HALF);
#define PG8_RATIO(x, y, k) ((float)(((x) >> (8 * (k))) & 255u) * __builtin_amdgcn_rcpf((float)(((y) >> (8 * (k))) & 255u)))
                    f32x4 r0, r1;
                    r0[0] = PG8_RATIO(a.x, b.x, 0); r0[1] = PG8_RATIO(a.x, b.x, 1); r0[2] = PG8_RATIO(a.x, b.x, 2); r0[3] = PG8_RATIO(a.x, b.x, 3);
                    r1[0] = PG8_RATIO(a.y, b.y, 0); r1[1] = PG8_RATIO(a.y, b.y, 1); r1[2] = PG8_RATIO(a.y, b.y, 2); r1[3] = PG8_RATIO(a.y, b.y, 3);
#undef PG8_RATIO
                    acc[ai][bj][m][0] = acc[ai][bj][m][0] * r0; acc[ai][bj][m][1] = acc[ai][bj][m][1] * r1; } }
    }
    __device__ __forceinline__ void operator()(const f32x4 (&acc)[2][2][4][2], const Unit& u, int wr, int wc, int fr_, int fq_) const {
        int fr = fr_, fq = fq_; asm volatile("" : "+v"(fr), "+v"(fq));
        const int row0 = u.pm * BM + wr * 64 + fr, col0 = u.pn * BM + wc * 32 + 8 * fq;
#pragma unroll
        for (int ai = 0; ai < 2; ++ai)
#pragma unroll
            for (int m = 0; m < 4; ++m) { const size_t off = (size_t)(row0 + ai * HALF + m * 16) * ldc + col0;
#pragma unroll
                for (int bj = 0; bj < 2; ++bj) { const u32x2 g = *(const u32x2*)((const unsigned char*)gb + off + bj * HALF);
                    const f32x4 v0 = acc[ai][bj][m][0], v1 = acc[ai][bj][m][1]; const float q = 1.0f / 255.0f;
                    f32x4 o0, o1;
                    o0[0] = v0[0] * ((float)(g.x & 255u) * q); o0[1] = v0[1] * ((float)((g.x >> 8) & 255u) * q); o0[2] = v0[2] * ((float)((g.x >> 16) & 255u) * q); o0[3] = v0[3] * ((float)(g.x >> 24) * q);
                    o1[0] = v1[0] * ((float)(g.y & 255u) * q); o1[1] = v1[1] * ((float)((g.y >> 8) & 255u) * q); o1[2] = v1[2] * ((float)((g.y >> 16) & 255u) * q); o1[3] = v1[3] * ((float)(g.y >> 24) * q);
                    u32x4 w; w.x = cvt_pk_bf16(o0[0], o0[1]); w.y = cvt_pk_bf16(o0[2], o0[3]); w.z = cvt_pk_bf16(o1[0], o1[1]); w.w = cvt_pk_bf16(o1[2], o1[3]);
                    *(u32x4*)(O + off + bj * HALF) = w; } }
    }
};
struct EpiOutProj {
    static constexpr bool PERM = true, AFTER_DRAIN = false;
    const bf16_t* xres; bf16_t* z; int ldc; float alpha;
    __device__ __forceinline__ void operator()(const f32x4 (&acc)[2][2][4][2], const Unit& u, int wr, int wc, int fr_, int fq_) const {
        int fr = fr_, fq = fq_; asm volatile("" : "+v"(fr), "+v"(fq));
        const int row0 = u.pm * BM + wr * 64 + fr, col0 = u.pn * BM + wc * 32 + 8 * fq;
#pragma unroll
        for (int ai = 0; ai < 2; ++ai)
#pragma unroll
            for (int m = 0; m < 4; ++m) { const size_t off = (size_t)(row0 + ai * HALF + m * 16) * ldc + col0;
#pragma unroll
                for (int bj = 0; bj < 2; ++bj) { const u32x4 x = *(const u32x4*)(xres + off + bj * HALF);
                    const f32x4 v0 = acc[ai][bj][m][0], v1 = acc[ai][bj][m][1];
                    f32x4 o0, o1;
                    o0[0] = v0[0] + alpha * __builtin_bit_cast(float, x.x << 16); o0[1] = v0[1] + alpha * __builtin_bit_cast(float, x.x & 0xffff0000u);
                    o0[2] = v0[2] + alpha * __builtin_bit_cast(float, x.y << 16); o0[3] = v0[3] + alpha * __builtin_bit_cast(float, x.y & 0xffff0000u);
                    o1[0] = v1[0] + alpha * __builtin_bit_cast(float, x.z << 16); o1[1] = v1[1] + alpha * __builtin_bit_cast(float, x.z & 0xffff0000u);
                    o1[2] = v1[2] + alpha * __builtin_bit_cast(float, x.w << 16); o1[3] = v1[3] + alpha * __builtin_bit_cast(float, x.w & 0xffff0000u);
                    u32x4 w; w.x = cvt_pk_bf16(o0[0], o0[1]); w.y = cvt_pk_bf16(o0[2], o0[3]); w.z = cvt_pk_bf16(o1[0], o1[1]); w.w = cvt_pk_bf16(o1[2], o1[3]);
                    *(u32x4*)(z + off + bj * HALF) = w; } }
    }
};
struct EpiInProj {
    static constexpr bool PERM = false, AFTER_DRAIN = false;
    bf16_t *qa, *ka, *qd, *kd, *ga, *gb; const float *cosA, *sinA, *cosB, *sinB; float qsa, qsb;
    __device__ __forceinline__ void operator()(const f32x4 (&acc)[2][2][4][2], const Unit& u, int wr, int wc, int fr_, int fq_) const {
        int fr = fr_, fq = fq_; asm volatile("" : "+v"(fr), "+v"(fq));
        const int row0 = u.pm * BM + wr * 64 + fr;
        const int ty = u.pn >> 2;
        if (ty >= 4) {
            unsigned char* dst = (unsigned char*)(ty < 6 ? ga : gb); const int col0 = (u.pn - (ty < 6 ? 16 : 24)) * BM + wc * 32 + 4 * fq; const float lo = ty < 6 ? 0.0f : 1.0f;
#pragma unroll
            for (int ai = 0; ai < 2; ++ai)
#pragma unroll
                for (int m = 0; m < 4; ++m) { unsigned char* rowp = dst + (size_t)(row0 + ai * HALF + m * 16) * 2048 + col0;
#pragma unroll
                    for (int bj = 0; bj < 2; ++bj)
#pragma unroll
                        for (int n = 0; n < 2; ++n) { const f32x4 v = acc[ai][bj][m][n]; unsigned w = 0u;
#pragma unroll
                            for (int j = 0; j < 4; ++j) { const float s = __builtin_amdgcn_rcpf(1.0f + __builtin_amdgcn_exp2f(-1.4426950408889634f * v[j]));
                                w |= (unsigned)fmaxf(s * 255.0f + 0.5f, lo) << (8 * j); }
                            *(unsigned*)(rowp + bj * HALF + n * 16) = w; } }
        } else if (ty < 2) {
            bf16_t* dst = ty == 0 ? qa : ka; const float sc = ty == 0 ? qsa : 1.0f;
            const int i0 = 16 * wc + 4 * fq;
#pragma unroll
            for (int ai = 0; ai < 2; ++ai)
#pragma unroll
                for (int m = 0; m < 4; ++m) { const int row = row0 + ai * HALF + m * 16;
                    const f32x4 c = *(const f32x4*)(cosA + (size_t)row * 64 + i0), s = *(const f32x4*)(sinA + (size_t)row * 64 + i0);
#pragma unroll
                    for (int bj = 0; bj < 2; ++bj) { const int head = 2 * (u.pn & 3) + bj; const f32x4 t1 = acc[ai][bj][m][0], t2 = acc[ai][bj][m][1];
                        const f32x4 o1 = t1 * c - t2 * s, o2 = t1 * s + t2 * c;
                        bf16_t* p = dst + (size_t)row * 1024 + head * 128 + i0;
                        u32x2 w1, w2; w1.x = cvt_pk_bf16(o1[0] * sc, o1[1] * sc); w1.y = cvt_pk_bf16(o1[2] * sc, o1[3] * sc); w2.x = cvt_pk_bf16(o2[0] * sc, o2[1] * sc); w2.y = cvt_pk_bf16(o2[2] * sc, o2[3] * sc);
                        *(u32x2*)p = w1; *(u32x2*)(p + 64) = w2;
                    } }
        } else {
            bf16_t* dst = ty == 2 ? qd : kd; const float sc = ty == 2 ? qsb : 1.0f;
            const int comp = wc >> 1, i0 = 16 * (wc & 1) + 4 * fq;
#pragma unroll
            for (int ai = 0; ai < 2; ++ai)
#pragma unroll
                for (int m = 0; m < 4; ++m) { const int row = row0 + ai * HALF + m * 16;
                    const f32x4 c = *(const f32x4*)(cosB + (size_t)row * 32 + i0), s = *(const f32x4*)(sinB + (size_t)row * 32 + i0);
#pragma unroll
                    for (int bj = 0; bj < 2; ++bj) { const int head = 2 * (u.pn & 3) + bj; const f32x4 t1 = acc[ai][bj][m][0], t2 = acc[ai][bj][m][1];
                        const f32x4 o1 = (t1 * c - t2 * s) * sc, o2 = (t1 * s + t2 * c) * sc;
                        bf16_t* p = dst + (size_t)row * 1024 + head * 128 + comp * 64 + i0;
                        u32x2 w1, w2; w1.x = cvt_pk_bf16(o1[0], o1[1]); w1.y = cvt_pk_bf16(o1[2], o1[3]); w2.x = cvt_pk_bf16(o2[0], o2[1]); w2.y = cvt_pk_bf16(o2[2], o2[3]);
                        *(u32x2*)p = w1; *(u32x2*)(p + 32) = w2;
                    } }
        }
    }
};

__device__ __forceinline__ f32x4 deq4(const i32x4& a, const f32x4& s) { return (f32x4){(float)a[0], (float)a[1], (float)a[2], (float)a[3]} * s; }
struct EpiPlainI8 {
    static constexpr bool PERM = true, AFTER_DRAIN = false;
    bf16_t* O; int ldc; const float* srow; const float* scol;
    __device__ __forceinline__ void operator()(const i32x4 (&acc)[2][2][4][2], const Unit& u, int wr, int wc, int fr_, int fq_) const {
        int fr = fr_, fq = fq_; asm volatile("" : "+v"(fr), "+v"(fq));
        const int row0 = u.pm * BM + wr * 64 + fr, col0 = u.pn * BM + wc * 32 + 8 * fq;
        f32x4 cs[2][2];
#pragma unroll
        for (int bj = 0; bj < 2; ++bj)
#pragma unroll
            for (int n = 0; n < 2; ++n) cs[bj][n] = *(const f32x4*)(scol + col0 + bj * HALF + 4 * n);
#pragma unroll
        for (int ai = 0; ai < 2; ++ai)
#pragma unroll
            for (int m = 0; m < 4; ++m) { const int row = row0 + ai * HALF + m * 16; const float sr = srow[row]; bf16_t* rowp = O + (size_t)row * ldc + col0;
#pragma unroll
                for (int bj = 0; bj < 2; ++bj) { const f32x4 v0 = deq4(acc[ai][bj][m][0], cs[bj][0] * sr), v1 = deq4(acc[ai][bj][m][1], cs[bj][1] * sr);
                    u32x4 w; w.x = cvt_pk_bf16(v0[0], v0[1]); w.y = cvt_pk_bf16(v0[2], v0[3]); w.z = cvt_pk_bf16(v1[0], v1[1]); w.w = cvt_pk_bf16(v1[2], v1[3]);
                    *(u32x4*)(rowp + bj * HALF) = w; } }
    }
};
struct EpiInProjI8 {
    static constexpr bool PERM = false, AFTER_DRAIN = false;
    bf16_t *qa, *ka, *qd, *kd, *ga, *gb; const float *cosA, *sinA, *cosB, *sinB; float qsa, qsb; const float *sx, *sw;
    __device__ __forceinline__ void operator()(const i32x4 (&acc)[2][2][4][2], const Unit& u, int wr, int wc, int fr_, int fq_) const {
        int fr = fr_, fq = fq_; asm volatile("" : "+v"(fr), "+v"(fq));
        const int row0 = u.pm * BM + wr * 64 + fr;
        const int ty = u.pn >> 2;
        f32x4 cs[2][2];
#pragma unroll
        for (int bj = 0; bj < 2; ++bj)
#pragma unroll
            for (int n = 0; n < 2; ++n) cs[bj][n] = *(const f32x4*)(sw + u.pn * BM + bj * HALF + wc * 32 + n * 16 + 4 * fq);
        if (ty >= 4) {
            unsigned char* dst = (unsigned char*)(ty < 6 ? ga : gb); const int col0 = (u.pn - (ty < 6 ? 16 : 24)) * BM + wc * 32 + 4 * fq; const float lo = ty < 6 ? 0.0f : 1.0f;
#pragma unroll
            for (int ai = 0; ai < 2; ++ai)
#pragma unroll
                for (int m = 0; m < 4; ++m) { const int row = row0 + ai * HALF + m * 16; const float sr = sx[row] * -1.4426950408889634f; unsigned char* rowp = dst + (size_t)row * 2048 + col0;
#pragma unroll
                    for (int bj = 0; bj < 2; ++bj)
#pragma unroll
                        for (int n = 0; n < 2; ++n) { const f32x4 v = deq4(acc[ai][bj][m][n], cs[bj][n] * sr); unsigned w = 0u;
#pragma unroll
                            for (int j = 0; j < 4; ++j) { const float s = __builtin_amdgcn_rcpf(1.0f + __builtin_amdgcn_exp2f(v[j]));
                                w |= (unsigned)fmaxf(s * 255.0f + 0.5f, lo) << (8 * j); }
                            *(unsigned*)(rowp + bj * HALF + n * 16) = w; } }
        } else if (ty < 2) {
            bf16_t* dst = ty == 0 ? qa : ka; const float sc = ty == 0 ? qsa : 1.0f;
            const int i0 = 16 * wc + 4 * fq;
#pragma unroll
            for (int ai = 0; ai < 2; ++ai)
#pragma unroll
                for (int m = 0; m < 4; ++m) { const int row = row0 + ai * HALF + m * 16; const float sr = sx[row] * sc;
                    const f32x4 c = *(const f32x4*)(cosA + (size_t)row * 64 + i0), s = *(const f32x4*)(sinA + (size_t)row * 64 + i0);
#pragma unroll
                    for (int bj = 0; bj < 2; ++bj) { const int head = 2 * (u.pn & 3) + bj; const f32x4 t1 = deq4(acc[ai][bj][m][0], cs[bj][0] * sr), t2 = deq4(acc[ai][bj][m][1], cs[bj][1] * sr);
                        const f32x4 o1 = t1 * c - t2 * s, o2 = t1 * s + t2 * c;
                        bf16_t* p = dst + (size_t)row * 1024 + head * 128 + i0;
                        u32x2 w1, w2; w1.x = cvt_pk_bf16(o1[0], o1[1]); w1.y = cvt_pk_bf16(o1[2], o1[3]); w2.x = cvt_pk_bf16(o2[0], o2[1]); w2.y = cvt_pk_bf16(o2[2], o2[3]);
                        *(u32x2*)p = w1; *(u32x2*)(p + 64) = w2;
                    } }
        } else {
            bf16_t* dst = ty == 2 ? qd : kd; const float sc = ty == 2 ? qsb : 1.0f;
            const int comp = wc >> 1, i0 = 16 * (wc & 1) + 4 * fq;
#pragma unroll
            for (int ai = 0; ai < 2; ++ai)
#pragma unroll
                for (int m = 0; m < 4; ++m) { const int row = row0 + ai * HALF + m * 16; const float sr = sx[row] * sc;
                    const f32x4 c = *(const f32x4*)(cosB + (size_t)row * 32 + i0), s = *(const f32x4*)(sinB + (size_t)row * 32 + i0);
#pragma unroll
                    for (int bj = 0; bj < 2; ++bj) { const int head = 2 * (u.pn & 3) + bj; const f32x4 t1 = deq4(acc[ai][bj][m][0], cs[bj][0] * sr), t2 = deq4(acc[ai][bj][m][1], cs[bj][1] * sr);
                        const f32x4 o1 = t1 * c - t2 * s, o2 = t1 * s + t2 * c;
                        bf16_t* p = dst + (size_t)row * 1024 + head * 128 + comp * 64 + i0;
                        u32x2 w1, w2; w1.x = cvt_pk_bf16(o1[0], o1[1]); w1.y = cvt_pk_bf16(o1[2], o1[3]); w2.x = cvt_pk_bf16(o2[0], o2[1]); w2.y = cvt_pk_bf16(o2[2], o2[3]);
                        *(u32x2*)p = w1; *(u32x2*)(p + 32) = w2;
                    } }
        }
    }
};
template <class Epi, class Sched, bool ALIGN_EPI = false, bool SP2 = false, bool MID = false, bool I8 = false>
__device__ __forceinline__ void gemm_phase(PG8_LAS unsigned char* lds, const Gemm g, const Sched& S, const Epi& E, int wave) {
    int tid_ = lane_id(); asm volatile("" : "+v"(tid_)); tid_ += 64 * wave;
    const int tid = tid_, wid = __builtin_amdgcn_readfirstlane(tid >> 6), lane = tid & 63, wr = wid >> 2, wc = wid & 3, fr = lane & 15, fq = lane >> 4;
    const int K = g.K, nt = K / BK;
    unsigned voffA[2], voffB[2];
#pragma unroll
    for (int i = 0; i < 2; ++i) { int R, C; stage_rc(tid * 16 + i * 8192, R, C); const int Rb = Epi::PERM ? ((R & ~31) + perm32(R & 31)) : R;
        voffA[i] = (unsigned)(R * K + C) * 2u; voffB[i] = (unsigned)(Rb * K + C) * 2u; }
    const size_t kstep = (size_t)(BK * 2);
    const size_t hstep = (size_t)HALF * K * 2;
    const size_t tstep = 2 * hstep;
    const unsigned ldsw = (unsigned)wid * 1024u;
    const int aoff = lds_byte(wr * 64 + fr, fq * 8), boff = lds_byte(wc * 32 + fr, fq * 8);
#define PG8_SA(b, h) (((b) * 2 + (h)) * HTB)
#define PG8_SB(b, h) ((4 + (b) * 2 + (h)) * HTB)
#define PG8_STAGE(bufoff, gbase, voff) do { _Pragma("unroll") for (int _i = 0; _i < 2; ++_i) \
        __builtin_amdgcn_global_load_lds((const unsigned*)((const char*)(gbase) + (voff)[_i]), (PG8_LAS unsigned*)(lds + (bufoff) + ldsw + _i * 8192), 16, 0, 0); } while (0)
#define PG8_LDA(dst, b, h) do { _Pragma("unroll") for (int m = 0; m < 4; ++m) _Pragma("unroll") for (int k = 0; k < 2; ++k) dst[m][k] = *(const PG8_LAS bf16x8*)(lds + PG8_SA(b, h) + aoff + m * 2048 + k * 1024); } while (0)
#define PG8_LDB(dst, b, h) do { _Pragma("unroll") for (int n = 0; n < 2; ++n) _Pragma("unroll") for (int k = 0; k < 2; ++k) dst[n][k] = *(const PG8_LAS bf16x8*)(lds + PG8_SB(b, h) + boff + n * 2048 + k * 1024); } while (0)
#define PG8_MMA(ai, bj, At, Bt) do { __builtin_amdgcn_s_setprio(1); _Pragma("unroll") for (int m = 0; m < 4; ++m) _Pragma("unroll") for (int n = 0; n < 2; ++n) _Pragma("unroll") for (int k = 0; k < 2; ++k) \
        acc[ai][bj][m][n] = mma16<I8>(Bt[n][k], At[m][k], acc[ai][bj][m][n]); __builtin_amdgcn_s_setprio(0); } while (0)
#define PG8_WAIT_V(n) asm volatile("s_waitcnt vmcnt(" #n ")" ::: "memory")
#define PG8_WAIT_L(n) asm volatile("s_waitcnt lgkmcnt(" #n ")" ::: "memory")
#define PG8_BAR __builtin_amdgcn_s_barrier()
#define PG8_SCHED __builtin_amdgcn_sched_barrier(0)
    Unit cur, nxt; int ui = 0;
    if (!S.next(0, cur)) return;
    typedef typename AccSel<I8>::type acc_t;
    acc_t acc[2][2][4][2];
#pragma unroll
    for (int a = 0; a < 2; ++a)
#pragma unroll
        for (int b = 0; b < 2; ++b)
#pragma unroll
            for (int m = 0; m < 4; ++m)
#pragma unroll
                for (int n = 0; n < 2; ++n) acc[a][b][m][n] = (acc_t){0, 0, 0, 0};
    bf16x8 At[4][2], B0[2][2], B1[2][2];
    const char* cA = (const char*)g.A + (size_t)cur.pm * tstep; const char* cB = (const char*)g.Bt + (size_t)cur.pn * tstep;
    S.a_ready(cur);
    if constexpr (SP2) {
        PG8_STAGE(PG8_SB(0, 0), cB, voffB); PG8_STAGE(PG8_SB(0, 1), cB + hstep, voffB); PG8_STAGE(PG8_SA(0, 0), cA, voffA); PG8_STAGE(PG8_SA(0, 1), cA + hstep, voffA);
        if (wr == 1) PG8_BAR;
        PG8_WAIT_V(2); PG8_BAR;
        PG8_STAGE(PG8_SB(1, 0), cB + kstep, voffB); PG8_STAGE(PG8_SA(1, 0), cA + kstep, voffA); PG8_STAGE(PG8_SB(1, 1), cB + hstep + kstep, voffB);
        PG8_WAIT_V(6); PG8_BAR;
    } else {
        PG8_STAGE(PG8_SB(0, 0), cB, voffB); PG8_STAGE(PG8_SA(0, 0), cA, voffA); PG8_STAGE(PG8_SB(0, 1), cB + hstep, voffB); PG8_STAGE(PG8_SA(0, 1), cA + hstep, voffA);
        if (wr == 1) PG8_BAR;
        PG8_WAIT_V(4); PG8_BAR;
        PG8_STAGE(PG8_SB(1, 0), cB + kstep, voffB); PG8_STAGE(PG8_SA(1, 0), cA + kstep, voffA); PG8_STAGE(PG8_SB(1, 1), cB + hstep + kstep, voffB);
        PG8_WAIT_V(6); PG8_BAR;
    }
    for (;;) {
        const bool has_next = S.next(ui + 1, nxt);
        const char* nA = has_next ? (const char*)g.A + (size_t)nxt.pm * tstep : cA; const char* nB = has_next ? (const char*)g.Bt + (size_t)nxt.pn * tstep : cB;
        for (int t = 0; t < nt; t += 2) {
            if constexpr (MID) { if (t == nt / 2) E.mid(acc, cur, wr, wc, fr, fq); }
            const bool last = (t == nt - 2);
            const char* a1 = cA + (size_t)(t + 1) * kstep;
            const char* a2 = last ? nA : cA + (size_t)(t + 2) * kstep; const char* b2 = last ? nB : cB + (size_t)(t + 2) * kstep;
            const char* a3 = a2 + kstep; const char* b3 = b2 + kstep;
            if (last && has_next) S.a_ready(nxt);
            if constexpr (SP2) {
            PG8_LDB(B0, 0, 0); PG8_LDB(B1, 0, 1); PG8_SCHED; PG8_LDA(At, 0, 0); PG8_STAGE(PG8_SA(1, 1), a1 + hstep, voffA);
            PG8_WAIT_V(8); PG8_WAIT_L(0); PG8_BAR; PG8_MMA(0, 0, At, B0); PG8_MMA(0, 1, At, B1); PG8_BAR; PG8_SCHED;
            PG8_LDA(At, 0, 1); PG8_STAGE(PG8_SB(0, 0), b2, voffB); PG8_STAGE(PG8_SB(0, 1), b2 + hstep, voffB); PG8_STAGE(PG8_SA(0, 0), a2, voffA);
            PG8_WAIT_V(8); PG8_WAIT_L(0); PG8_BAR; PG8_MMA(1, 0, At, B0); PG8_MMA(1, 1, At, B1); PG8_BAR; PG8_SCHED;
            PG8_LDB(B0, 1, 0); PG8_LDB(B1, 1, 1); PG8_SCHED; PG8_LDA(At, 1, 0); PG8_STAGE(PG8_SA(0, 1), a2 + hstep, voffA);
            PG8_WAIT_V(8); PG8_WAIT_L(0); PG8_BAR; PG8_MMA(0, 0, At, B0); PG8_MMA(0, 1, At, B1); PG8_BAR; PG8_SCHED;
            PG8_LDA(At, 1, 1); PG8_STAGE(PG8_SB(1, 0), b3, voffB); PG8_STAGE(PG8_SB(1, 1), b3 + hstep, voffB); PG8_STAGE(PG8_SA(1, 0), a3, voffA);
            PG8_WAIT_V(8); PG8_WAIT_L(0); PG8_BAR; PG8_MMA(1, 0, At, B0); PG8_MMA(1, 1, At, B1); PG8_BAR; PG8_SCHED;
            } else {
            PG8_LDB(B0, 0, 0); PG8_SCHED; PG8_LDA(At, 0, 0); PG8_STAGE(PG8_SA(1, 1), a1 + hstep, voffA);
            PG8_WAIT_L(8); PG8_BAR; PG8_WAIT_L(0); PG8_MMA(0, 0, At, B0); PG8_BAR; PG8_SCHED;
            PG8_LDB(B1, 0, 1); PG8_STAGE(PG8_SB(0, 0), b2, voffB);
            PG8_BAR; PG8_WAIT_L(0); PG8_MMA(0, 1, At, B1); PG8_BAR;
            PG8_LDA(At, 0, 1); PG8_STAGE(PG8_SA(0, 0), a2, voffA);
            PG8_BAR; PG8_WAIT_L(0); PG8_MMA(1, 0, At, B0); PG8_BAR; PG8_SCHED;
            PG8_STAGE(PG8_SB(0, 1), b2 + hstep, voffB);
            PG8_WAIT_V(6); PG8_BAR; PG8_MMA(1, 1, At, B1); PG8_BAR;
            PG8_LDB(B0, 1, 0); PG8_SCHED; PG8_LDA(At, 1, 0); PG8_STAGE(PG8_SA(0, 1), a2 + hstep, voffA);
            PG8_WAIT_L(8); PG8_BAR; PG8_WAIT_L(0); PG8_MMA(0, 0, At, B0); PG8_BAR; PG8_SCHED;
            PG8_LDB(B1, 1, 1); PG8_STAGE(PG8_SB(1, 0), b3, voffB);
            PG8_BAR; PG8_WAIT_L(0); PG8_MMA(0, 1, At, B1); PG8_BAR;
            PG8_LDA(At, 1, 1); PG8_STAGE(PG8_SA(1, 0), a3, voffA);
            PG8_BAR; PG8_WAIT_L(0); PG8_MMA(1, 0, At, B0); PG8_BAR; PG8_SCHED;
            PG8_STAGE(PG8_SB(1, 1), b3 + hstep, voffB);
            PG8_WAIT_V(6); PG8_BAR; PG8_MMA(1, 1, At, B1); PG8_BAR;
            }
        }
        if constexpr (ALIGN_EPI) { if (wr == 0) PG8_BAR; }
        if constexpr (!Epi::AFTER_DRAIN) { E(acc, cur, wr, wc, fr, fq); S.done(cur); }
        if (!has_next) break;
#pragma unroll
        for (int a = 0; a < 2; ++a)
#pragma unroll
            for (int b = 0; b < 2; ++b)
#pragma unroll
                for (int m = 0; m < 4; ++m)
#pragma unroll
                    for (int n = 0; n < 2; ++n) acc[a][b][m][n] = (acc_t){0, 0, 0, 0};
        cur = nxt; cA = nA; cB = nB; ++ui;
        if constexpr (ALIGN_EPI) { if (wr == 1) PG8_BAR; }
    }
    PG8_WAIT_V(0);
    if constexpr (!ALIGN_EPI) { if (wr == 0) PG8_BAR; }
    PG8_BAR;
    if constexpr (Epi::AFTER_DRAIN) { E.fused(acc, cur, wr, wc, fr, fq, lds, wid, lane); S.done(cur); }
#undef PG8_SA
#undef PG8_SB
#undef PG8_STAGE
#undef PG8_LDA
#undef PG8_LDB
#undef PG8_MMA
#undef PG8_WAIT_V
#undef PG8_WAIT_L
#undef PG8_BAR
#undef PG8_SCHED
}
}
#define XB_TMO      128
#define XB_XCNT(j)  (256  + 64 * (j))
#define XB_XSUB(j)  (1280 + 64 * (j))
#define XB_XGEN(j)  (2304 + 64 * (j))
#define XB_TOP      3328
#define XB_TOPGEN   3392
#define XCD_BAR_WORDS 3456
#define XB_SPIN_CAP (1u << 18)

__device__ __forceinline__ unsigned xb_ld(unsigned* p)              { return __hip_atomic_load(p, __ATOMIC_RELAXED, __HIP_MEMORY_SCOPE_AGENT); }
__device__ __forceinline__ unsigned xb_add(unsigned* p, unsigned v) { return __hip_atomic_fetch_add(p, v, __ATOMIC_RELAXED, __HIP_MEMORY_SCOPE_AGENT); }
__device__ __forceinline__ unsigned xb_xcc_id() { return (unsigned)__builtin_amdgcn_s_getreg((3 << 11) | 20) & 0xFu; }
#define XB_SPIN(cond, bar) do { unsigned _sp = 0; while (cond) { __builtin_amdgcn_s_sleep(1); \
    if ((++_sp & 255u) == 0u) { if (xb_ld(&(bar)[XB_TMO])) break; if (_sp > XB_SPIN_CAP) { atomicAdd(&(bar)[XB_TMO], 1u); break; } } } } while (0)

struct XcdBarrier {
    unsigned* bar; unsigned x; unsigned wv;
    volatile LAS unsigned* st;
};

__device__ __forceinline__ XcdBarrier xcd_barrier_post(unsigned* bar, volatile LAS unsigned* st, unsigned wave) {
    XcdBarrier b; b.bar = bar; b.x = xb_xcc_id(); b.st = st; b.wv = wave;
    if (threadIdx.x == 0) (void)xb_add(&bar[XB_XCNT(b.x)], 1u);
    return b;
}
__device__ __forceinline__ void xcd_barrier_complete(unsigned* bar, unsigned x, unsigned& nloc, unsigned& nx) {
    const unsigned G = gridDim.x * gridDim.y * gridDim.z;
    unsigned sum, cnt, mine, sp = 0u;
    for (;;) {
        sum = 0u; cnt = 0u; mine = 0u;
#pragma unroll 1
        for (unsigned j = 0; j < 16; ++j) { const unsigned c = xb_ld(&bar[XB_XCNT(j)]); sum += c; cnt += (c > 0u) ? 1u : 0u; mine = (j == x) ? c : mine; }
        if (sum == G) break;
        __builtin_amdgcn_s_sleep(1);
        if ((++sp & 255u) == 0u) { if (xb_ld(&bar[XB_TMO])) break; if (sp > XB_SPIN_CAP) { atomicAdd(&bar[XB_TMO], 1u); break; } }
    }
    nloc = mine > 0u ? mine : 1u; nx = cnt > 0u ? cnt : 1u;
}

__device__ __forceinline__ void xcd_barrier(const XcdBarrier& b) {
    asm volatile("s_waitcnt vmcnt(0)" ::: "memory");
    __syncthreads();
    if (b.wv == 0u && lane_id() == 0) {
        unsigned* bar = b.bar;
        __builtin_amdgcn_s_waitcnt(0);
        unsigned nloc = b.st[0], nx = b.st[1];
        if (nloc == 0u) { xcd_barrier_complete(bar, b.x, nloc, nx); b.st[0] = nloc; b.st[1] = nx; }
        const unsigned old = xb_add(&bar[XB_XSUB(b.x)], 1u);
        const unsigned gen = old / nloc;
        if (old + 1u == (gen + 1u) * nloc) {
            __builtin_amdgcn_fence(__ATOMIC_RELEASE, "agent");
            asm volatile("s_waitcnt vmcnt(0)" ::: "memory");
            const unsigned og = xb_add(&bar[XB_TOP], 1u);
            const unsigned tg = og / nx;
            if (og + 1u == (tg + 1u) * nx) xb_add(&bar[XB_TOPGEN], 1u);
            else XB_SPIN(xb_ld(&bar[XB_TOPGEN]) == tg, bar);
            __builtin_amdgcn_fence(__ATOMIC_ACQUIRE, "agent");
            xb_add(&bar[XB_XGEN(b.x)], 1u);
            asm volatile("s_waitcnt vmcnt(0)" ::: "memory");
        } else {
            XB_SPIN(xb_ld(&bar[XB_XGEN(b.x)]) == gen, bar);
            __builtin_amdgcn_fence(__ATOMIC_ACQUIRE, "agent");
            asm volatile("s_waitcnt vmcnt(0)" ::: "memory");
        }
    }
    __syncthreads();
}


struct Frame {
    LAS unsigned char* lds;
    volatile LAS unsigned* MISC;
    gu32* ctl;
    int tid, lane, wave;
    int vcu, G;
    unsigned char* ws;
};

__device__ __forceinline__ int inproj_row(int n) {
    const int seg = n >> 10, r = n & 1023;
    if (seg >= 6) return (seg < 8 ? 4096 : 6144) + (n - (seg < 8 ? 6144 : 8192));
    if (seg == 2) return 8192 + r;
    if (seg == 5) return 8192 + 1024 + r;
    const int head = r >> 7, d = r & 127;
    if (seg < 2) return seg * 1024 + head * 128 + 32 * ((d >> 4) & 3) + 16 * (d >> 6) + (d & 15);
    return (seg - 1) * 1024 + head * 128 + 32 * (2 * (d >> 6) + ((d >> 4) & 1)) + 16 * ((d >> 5) & 1) + (d & 15);
}
template <bool MAP>
__device__ __forceinline__ void p0_transpose_item(const float* W, int K, int N, bf16* WT, LAS float* scr, int item, int lane, int ldk = 0, int koff = 0) {
    if (ldk == 0) ldk = K;
    const int nblk = N / 32, kb = item / nblk, nb = item % nblk, k0 = 64 * kb, n0 = 32 * nb;
#pragma unroll 8
    for (int i = 0; i < 32; ++i) { const int kk = 2 * i + (lane >> 5); scr[kk * 33 + (lane & 31)] = W[(size_t)(k0 + kk) * N + n0 + (lane & 31)]; }
    LDS_WAIT(); asm volatile("" ::: "memory");
    const int c = lane & 7;
#pragma unroll
    for (int j = 0; j < 4; ++j) { const int n = (lane >> 3) + 8 * j; const LAS float* s = scr + (8 * c) * 33 + n;
        v4u o; o.x = pk2(s[0 * 33], s[1 * 33]); o.y = pk2(s[2 * 33], s[3 * 33]); o.z = pk2(s[4 * 33], s[5 * 33]); o.w = pk2(s[6 * 33], s[7 * 33]);
        const int dr = MAP ? inproj_row(n0 + n) : (n0 + n);
        *(GAS v4u*)(WT + (size_t)dr * ldk + koff + k0 + 8 * c) = o; }
    LDS_WAIT(); asm volatile("" ::: "memory");
}
__device__ __forceinline__ void p0_convert(const float* src, bf16* dst, size_t n8, size_t gtid, size_t gthreads) {
    for (size_t i = gtid; i < n8; i += gthreads) {
        const f32x4 a = *(const GAS f32x4*)(src + i * 8), b = *(const GAS f32x4*)(src + i * 8 + 4);
        v4u o; o.x = pk2(a[0], a[1]); o.y = pk2(a[2], a[3]); o.z = pk2(b[0], b[1]); o.w = pk2(b[2], b[3]);
        *(GAS v4u*)(dst + i * 8) = o;
    }
}

__device__ __forceinline__ void p0_table_row(const float* src, unsigned char* dst, float* scale_out, int lane) {
    f32x4 v[8]; float am = 0.f;
#pragma unroll
    for (int q = 0; q < 8; ++q) { v[q] = *(const GAS f32x4*)(src + 32 * lane + 4 * q);
        am = fmaxf(am, fmaxf(fmaxf(fabsf(v[q][0]), fabsf(v[q][1])), fmaxf(fabsf(v[q][2]), fabsf(v[q][3])))); }
#pragma unroll
    for (int o = 1; o < 64; o <<= 1) am = fmaxf(am, __shfl_xor(am, o));
    const float sc = am > 0.f ? 6.0f / am : 1.0f;
    v4u o;
#pragma unroll
    for (int wq = 0; wq < 4; ++wq) { unsigned w = 0u;
        w = __builtin_amdgcn_cvt_scalef32_pk_fp4_f32(w, v[2 * wq][0] * sc, v[2 * wq][1] * sc, 1.0f, 0);
        w = __builtin_amdgcn_cvt_scalef32_pk_fp4_f32(w, v[2 * wq][2] * sc, v[2 * wq][3] * sc, 1.0f, 1);
        w = __builtin_amdgcn_cvt_scalef32_pk_fp4_f32(w, v[2 * wq + 1][0] * sc, v[2 * wq + 1][1] * sc, 1.0f, 2);
        w = __builtin_amdgcn_cvt_scalef32_pk_fp4_f32(w, v[2 * wq + 1][2] * sc, v[2 * wq + 1][3] * sc, 1.0f, 3);
        o[wq] = w; }
    *(GAS v4u*)(dst + 16 * lane) = o;
    if (lane == 0) *scale_out = am > 0.f ? am / 6.0f : 1.0f;
}

__device__ __forceinline__ unsigned q8pack(float a, float b, float c, float d, float s) {
    const int ia = (int)__builtin_rintf(a * s), ib = (int)__builtin_rintf(b * s), ic = (int)__builtin_rintf(c * s), id = (int)__builtin_rintf(d * s);
    return ((unsigned)ia & 255u) | (((unsigned)ib & 255u) << 8) | (((unsigned)ic & 255u) << 16) | ((unsigned)id << 24);
}
__device__ __forceinline__ void p0_absmax_item(const float* W, int item, int lane, gu32* wmax) {
    const int kc = item / 40, nc = item % 40, n0 = 256 * nc + 4 * lane;
    const float* p = W + (size_t)(128 * kc) * 10240 + n0;
    f32x4 am = (f32x4){0.f, 0.f, 0.f, 0.f};
#pragma unroll 16
    for (int r = 0; r < 128; ++r) { const f32x4 v = *(const GAS f32x4*)(p + (size_t)r * 10240);
        am[0] = fmaxf(am[0], fabsf(v[0])); am[1] = fmaxf(am[1], fabsf(v[1])); am[2] = fmaxf(am[2], fabsf(v[2])); am[3] = fmaxf(am[3], fabsf(v[3])); }
#pragma unroll
    for (int j = 0; j < 4; ++j) (void)__hip_atomic_fetch_max(wmax + n0 + j, __builtin_bit_cast(unsigned, am[j]), RLX_AGENT);
}
__device__ __forceinline__ void p0_transpose_item_i8(const float* W, int K, int N, unsigned char* W8, LAS float* scr, int item, int lane, const gu32* wmax) {
    const int nblk = N / 32, kb = item / nblk, nb = item % nblk, k0 = 64 * kb, n0 = 32 * nb;
#pragma unroll 8
    for (int i = 0; i < 32; ++i) { const int kk = 2 * i + (lane >> 5); scr[kk * 33 + (lane & 31)] = W[(size_t)(k0 + kk) * N + n0 + (lane & 31)]; }
    LDS_WAIT(); asm volatile("" ::: "memory");
    const int c = lane & 7;
#pragma unroll
    for (int j = 0; j < 4; ++j) { const int n = (lane >> 3) + 8 * j; const LAS float* s = scr + (8 * c) * 33 + n;
        const float am = __builtin_bit_cast(float, wmax[n0 + n]); const float sc = am > 0.f ? 127.0f / am : 0.f;
        v2u o; o.x = q8pack(s[0 * 33], s[1 * 33], s[2 * 33], s[3 * 33], sc); o.y = q8pack(s[4 * 33], s[5 * 33], s[6 * 33], s[7 * 33], sc);
        *(GAS v2u*)(W8 + (size_t)inproj_row(n0 + n) * K + k0 + 8 * c) = o; }
    LDS_WAIT(); asm volatile("" ::: "memory");
}
__device__ __forceinline__ void p0_x_row(const float* src, bf16* dstb, unsigned char* dst8, float* sx, int lane) {
    f32x4 v[8]; float am = 0.f;
#pragma unroll
    for (int j = 0; j < 8; ++j) { v[j] = *(const GAS f32x4*)(src + 256 * j + 4 * lane);
        am = fmaxf(am, fmaxf(fmaxf(fabsf(v[j][0]), fabsf(v[j][1])), fmaxf(fabsf(v[j][2]), fabsf(v[j][3])))); }
#pragma unroll
    for (int o = 1; o < 64; o <<= 1) am = fmaxf(am, __shfl_xor(am, o));
    const float sc = am > 0.f ? 127.0f / am : 0.f;
#pragma unroll
    for (int j = 0; j < 8; ++j) { *(GAS v2u*)(dstb + 256 * j + 4 * lane) = (v2u){pk2(v[j][0], v[j][1]), pk2(v[j][2], v[j][3])};
        *(GAS unsigned*)(dst8 + 256 * j + 4 * lane) = q8pack(v[j][0], v[j][1], v[j][2], v[j][3], sc); }
    if (lane == 0) *sx = am * (1.0f / 127.0f);
}

namespace att {
constexpr int KB0 = 0, VB0 = 32768, KMT = 65536, QFR = 65536;
__device__ __forceinline__ int crow(int r, int hi) { return (r & 3) + 8 * (r >> 2) + 4 * hi; }
__device__ __forceinline__ unsigned cvtpk(float lo, float hi) { return pg8::cvt_pk_bf16(lo, hi); }

template <int DQK, bool MOBA>
__device__ __forceinline__ void attn_pass(LAS unsigned char* lds, const bf16* Qg, const bf16* Kg, const bf16* Vtg, int q0, unsigned sel, f32x16 (&o)[4], int tid, int wid, int lane) {
    constexpr int NS = DQK / 16, RB = DQK * 2, KCH = DQK / 8;
    constexpr float THR = 8.0f;
    const int r32 = lane & 31, hi = lane >> 5;
    const int qpos = q0 + 32 * wid + r32;
    const int own = q0 >> 8;
    const LAS unsigned char* qlds = lds + QFR + wid * 8192 + lane * 16;
    { const bf16* qp = Qg + (size_t)(32 * wid + r32) * 1024 + 8 * hi;
#pragma unroll
      for (int s = 0; s < NS; ++s) *(LAS bf16x8*)(lds + QFR + wid * 8192 + lane * 16 + s * 1024) = *(const GAS bf16x8*)(qp + 16 * s); }
#pragma unroll
    for (int d = 0; d < 4; ++d) o[d] = (f32x16){0.f,0.f,0.f,0.f,0.f,0.f,0.f,0.f,0.f,0.f,0.f,0.f,0.f,0.f,0.f,0.f};
    f32x16 negm = (f32x16){0.f,0.f,0.f,0.f,0.f,0.f,0.f,0.f,0.f,0.f,0.f,0.f,0.f,0.f,0.f,0.f};
    float l_run = 0.f;
    const int nt = MOBA ? 4 + 4 * own : (q0 + 256) / 64;
    constexpr int NKC = (64 * KCH) / 512;
    v4u kreg[NKC], vreg[2];
    unsigned kgo[NKC], vgo[2]; int klds[NKC], vl0[2], vl1[2];
#pragma unroll
    for (int i = 0; i < NKC; ++i) { const int cid = tid + 512 * i, key = cid / KCH, ch = cid % KCH;
        const int swz = (DQK == 128) ? (key & 15) : ((key >> 1) & 7);
        kgo[i] = (unsigned)(key * 1024 + ch * 8) * 2u; klds[i] = key * RB + ((ch ^ swz) << 4); }
#pragma unroll
    for (int i = 0; i < 2; ++i) { const int cid = tid + 512 * i, d = cid >> 3, g = cid & 7;
        const int c = (g >> 2) * 4 + ((g >> 1) & 1) * 2, sw = (d >> 1) & 7, e = g & 1;
        vgo[i] = (unsigned)(d * T + g * 8) * 2u; vl0[i] = d * 128 + ((c ^ sw) << 4) + 8 * e; vl1[i] = d * 128 + (((c + 1) ^ sw) << 4) + 8 * e; }
#define KTILE(i) (MOBA ? ((i) < 4 ? own * 4 + (i) : (i) - 4) : (i))
#define ATT_LOAD(kt) do { const GAS unsigned char* kb_ = (const GAS unsigned char*)Kg + (size_t)(kt) * 131072; const GAS unsigned char* vb_ = (const GAS unsigned char*)Vtg + (size_t)(kt) * 128; \
                          _Pragma("unroll") for (int i_ = 0; i_ < NKC; ++i_) kreg[i_] = *(const GAS v4u*)(kb_ + kgo[i_]); \
                          _Pragma("unroll") for (int i_ = 0; i_ < 2; ++i_) vreg[i_] = *(const GAS v4u*)(vb_ + vgo[i_]); } while (0)
#define ATT_STORE(buf) do { _Pragma("unroll") for (int i_ = 0; i_ < NKC; ++i_) *(LAS v4u*)(lds + KB0 + (buf) * 16384 + klds[i_]) = kreg[i_]; \
                            _Pragma("unroll") for (int i_ = 0; i_ < 2; ++i_) { *(LAS v2u*)(lds + VB0 + (buf) * 16384 + vl0[i_]) = (v2u){vreg[i_].x, vreg[i_].y}; \
                                                                              *(LAS v2u*)(lds + VB0 + (buf) * 16384 + vl1[i_]) = (v2u){vreg[i_].z, vreg[i_].w}; } } while (0)
    ATT_LOAD(KTILE(0)); ATT_STORE(0);
    __syncthreads();
    const int kswz = (DQK == 128) ? (r32 & 15) : ((r32 >> 1) & 7);
    const int vsw = (r32 >> 1) & 7;
    const int kfo = r32 * RB, vfo = r32 * 128;
#define ATT_STEP(BUF) do { \
        const int kt = KTILE(it); const bool more = it + 1 < nt; \
        if (more) ATT_LOAD(KTILE(it + 1)); \
        const int blk = kt >> 2; bool need; \
        if (!MOBA || it < 4) need = (kt * 64 <= q0 + 32 * wid + 31); else need = __any((sel >> blk) & 1u); \
        if (need) { \
            f32x16 p0, p1; \
            const LAS unsigned char* kb = lds + KB0 + (BUF) * 16384 + kfo; \
              \
            bf16x8 fk0[2], fk1[2], fqv[2]; \
            { const int ch = ((0 + hi) ^ kswz) << 4; fk0[0] = *(const LAS bf16x8*)(kb + ch); fk1[0] = *(const LAS bf16x8*)(kb + 32 * RB + ch); fqv[0] = *(const LAS bf16x8*)(qlds); } \
            _Pragma("unroll") for (int s = 0; s < NS; ++s) { \
                if (s + 1 < NS) { const int ch = ((2 * (s + 1) + hi) ^ kswz) << 4; \
                    fk0[(s + 1) & 1] = *(const LAS bf16x8*)(kb + ch); fk1[(s + 1) & 1] = *(const LAS bf16x8*)(kb + 32 * RB + ch); fqv[(s + 1) & 1] = *(const LAS bf16x8*)(qlds + (s + 1) * 1024); } \
                __builtin_amdgcn_sched_barrier(0); \
                if (s == 0) {   \
                    asm volatile("v_mfma_f32_32x32x16_bf16 %0, %1, %2, %3" : "=&v"(p0) : "v"(fk0[0]), "v"(fqv[0]), "v"(negm)); \
                    asm volatile("v_mfma_f32_32x32x16_bf16 %0, %1, %2, %3" : "=&v"(p1) : "v"(fk1[0]), "v"(fqv[0]), "v"(negm)); } \
                else { p0 = __builtin_amdgcn_mfma_f32_32x32x16_bf16(fk0[s & 1], fqv[s & 1], p0, 0, 0, 0); p1 = __builtin_amdgcn_mfma_f32_32x32x16_bf16(fk1[s & 1], fqv[s & 1], p1, 0, 0, 0); } \
                __builtin_amdgcn_sched_barrier(0); } \
            if (!MOBA || it < 4) { \
                if (kt * 64 + 63 > q0 + 32 * wid) { const int kbase = kt * 64 + 4 * hi; \
                    _Pragma("unroll") for (int r = 0; r < 16; ++r) { const int kv = kbase + (r & 3) + 8 * (r >> 2); if (kv > qpos) p0[r] = -INFINITY; if (kv + 32 > qpos) p1[r] = -INFINITY; } } \
            } else { if (!((sel >> blk) & 1u)) { _Pragma("unroll") for (int r = 0; r < 16; ++r) { p0[r] = -INFINITY; p1[r] = -INFINITY; } } } \
            float rm = fmaxf(fmaxf(p0[0], p0[1]), p1[0]); \
            _Pragma("unroll") for (int r = 1; r < 16; ++r) rm = fmaxf(fmaxf(rm, p0[r]), p1[r]); \
            { const unsigned rb = __builtin_bit_cast(unsigned, rm); auto rr = __builtin_amdgcn_permlane32_swap(rb, rb, false, false); rm = fmaxf(__builtin_bit_cast(float, (unsigned)rr[0]), __builtin_bit_cast(float, (unsigned)rr[1])); } \
            if (it == 0 || __any(rm > THR)) { \
                const float dl = (it == 0) ? rm : fmaxf(rm, 0.f); const float alpha = fexp2(-dl); \
                _Pragma("unroll") for (int r = 0; r < 16; ++r) { p0[r] -= dl; p1[r] -= dl; negm[r] -= dl; } \
                l_run *= alpha; \
                _Pragma("unroll") for (int d = 0; d < 4; ++d) _Pragma("unroll") for (int r = 0; r < 16; ++r) o[d][r] *= alpha; } \
            float ls = 0.f; \
            _Pragma("unroll") for (int r = 0; r < 16; ++r) { p0[r] = fexp2(p0[r]); p1[r] = fexp2(p1[r]); ls += p0[r] + p1[r]; } \
            l_run += ls; \
            bf16x8 pa[4]; \
            { v4u w; \
              w.x = cvtpk(p0[0], p0[1]); w.y = cvtpk(p0[2], p0[3]); w.z = cvtpk(p0[4], p0[5]); w.w = cvtpk(p0[6], p0[7]); pa[0] = __builtin_bit_cast(bf16x8, w); \
              w.x = cvtpk(p0[8], p0[9]); w.y = cvtpk(p0[10], p0[11]); w.z = cvtpk(p0[12], p0[13]); w.w = cvtpk(p0[14], p0[15]); pa[1] = __builtin_bit_cast(bf16x8, w); \
              w.x = cvtpk(p1[0], p1[1]); w.y = cvtpk(p1[2], p1[3]); w.z = cvtpk(p1[4], p1[5]); w.w = cvtpk(p1[6], p1[7]); pa[2] = __builtin_bit_cast(bf16x8, w); \
              w.x = cvtpk(p1[8], p1[9]); w.y = cvtpk(p1[10], p1[11]); w.z = cvtpk(p1[12], p1[13]); w.w = cvtpk(p1[14], p1[15]); pa[3] = __builtin_bit_cast(bf16x8, w); } \
            const LAS unsigned char* vb = lds + VB0 + (BUF) * 16384 + vfo; \
            bf16x8 vfr[2][4]; \
            _Pragma("unroll") for (int d = 0; d < 4; ++d) vfr[0][d] = *(const LAS bf16x8*)(vb + d * 4096 + (((0 + hi) ^ vsw) << 4)); \
            _Pragma("unroll") for (int ks = 0; ks < 4; ++ks) { \
                if (ks + 1 < 4) { const int c = ((ks + 1) >> 1) * 4 + ((ks + 1) & 1) * 2 + hi; \
                    _Pragma("unroll") for (int d = 0; d < 4; ++d) vfr[(ks + 1) & 1][d] = *(const LAS bf16x8*)(vb + d * 4096 + ((c ^ vsw) << 4)); } \
                __builtin_amdgcn_sched_barrier(0); \
                _Pragma("unroll") for (int d = 0; d < 4; ++d) o[d] = __builtin_amdgcn_mfma_f32_32x32x16_bf16(vfr[ks & 1][d], pa[ks], o[d], 0, 0, 0); \
                __builtin_amdgcn_sched_barrier(0); } \
        } \
        if (more) ATT_STORE((BUF) ^ 1); \
        __syncthreads(); \
    } while (0)
    int it = 0;
#pragma unroll 1
    for (; it + 1 < nt; it += 2) { ATT_STEP(0); ++it; ATT_STEP(1); --it; }
    if (it < nt) ATT_STEP(0);
#undef ATT_STEP
#undef ATT_LOAD
#undef KTILE
#undef ATT_STORE
    const float lt = l_run + __shfl_xor(l_run, 32);
    const float inv = 1.0f / lt;
#pragma unroll
    for (int d = 0; d < 4; ++d)
#pragma unroll
        for (int r = 0; r < 16; ++r) o[d][r] *= inv;
}

__device__ __forceinline__ void attn_pass_diff2(LAS unsigned char* lds, const bf16* Qg, const bf16* Kg, const bf16* Vtg, int q0, f32x16 (&o1)[4], f32x16 (&o2)[4], int tid, int wid, int lane) {
    constexpr int RB = 256, KCH = 16; constexpr float THR = 8.0f;
    { const int r32 = lane & 31, hi = lane >> 5;
      const bf16* qp = Qg + (size_t)(32 * wid + r32) * 1024 + 8 * hi;
#pragma unroll
      for (int s = 0; s < 8; ++s) *(LAS bf16x8*)(lds + QFR + wid * 8192 + lane * 16 + s * 1024) = *(const GAS bf16x8*)(qp + 16 * s); }
#pragma unroll
    for (int d = 0; d < 4; ++d) { o1[d] = (f32x16){0.f,0.f,0.f,0.f,0.f,0.f,0.f,0.f,0.f,0.f,0.f,0.f,0.f,0.f,0.f,0.f}; o2[d] = o1[d]; }
    float m1 = 0.f, l1 = 0.f, m2 = 0.f, l2 = 0.f;
    const int nt = (q0 + 256) / 64;
    v4u sreg[2];
#define ATT_KGO(i) ((unsigned)((((tq_ + 512 * (i)) >> 4) * 1024 + ((tq_ + 512 * (i)) & 15) * 8) * 2))
#define ATT_KLDS(i) ((((tq_ + 512 * (i)) >> 4) * RB) + (((((tq_ + 512 * (i)) & 15)) ^ (((tq_ + 512 * (i)) >> 4) & 15)) << 4))
#define ATT_VGO(i) ((unsigned)((((tq_ + 512 * (i)) >> 3) * T + ((tq_ + 512 * (i)) & 7) * 8) * 2))
#define ATT_VC(i) (((((tq_ + 512 * (i)) & 7) >> 2) * 4) + (((((tq_ + 512 * (i)) & 7) >> 1) & 1) * 2))
#define ATT_VL0(i) ((((tq_ + 512 * (i)) >> 3) * 128) + ((ATT_VC(i) ^ ((((tq_ + 512 * (i)) >> 3) >> 1) & 7)) << 4) + 8 * ((tq_ + 512 * (i)) & 1))
#define ATT_VL1(i) ((((tq_ + 512 * (i)) >> 3) * 128) + (((ATT_VC(i) + 1) ^ ((((tq_ + 512 * (i)) >> 3) >> 1) & 7)) << 4) + 8 * ((tq_ + 512 * (i)) & 1))
#define ATT_TQ int tq_ = lane; asm volatile("" : "+v"(tq_)); tq_ += 64 * wid
#define ATT_LOADK(kt) do { ATT_TQ; const GAS unsigned char* kb_ = (const GAS unsigned char*)Kg + (size_t)(kt) * 131072; _Pragma("unroll") for (int i_ = 0; i_ < 2; ++i_) sreg[i_] = *(const GAS v4u*)(kb_ + ATT_KGO(i_)); } while (0)
#define ATT_LOADV(kt) do { ATT_TQ; const GAS unsigned char* vb_ = (const GAS unsigned char*)Vtg + (size_t)(kt) * 128; _Pragma("unroll") for (int i_ = 0; i_ < 2; ++i_) sreg[i_] = *(const GAS v4u*)(vb_ + ATT_VGO(i_)); } while (0)
#define ATT_STOREK(buf) do { ATT_TQ; _Pragma("unroll") for (int i_ = 0; i_ < 2; ++i_) *(LAS v4u*)(lds + KB0 + (buf) * 16384 + ATT_KLDS(i_)) = sreg[i_]; } while (0)
#define ATT_STOREV(buf) do { ATT_TQ; _Pragma("unroll") for (int i_ = 0; i_ < 2; ++i_) { *(LAS v2u*)(lds + VB0 + (buf) * 16384 + ATT_VL0(i_)) = (v2u){sreg[i_].x, sreg[i_].y}; \
                                                                               *(LAS v2u*)(lds + VB0 + (buf) * 16384 + ATT_VL1(i_)) = (v2u){sreg[i_].z, sreg[i_].w}; } } while (0)
    ATT_LOADK(0); ATT_STOREK(0); ATT_LOADV(0); ATT_STOREV(0);
    __syncthreads();
#define ATT_LN int ln_ = lane; asm volatile("" : "+v"(ln_)); const int r32 = ln_ & 31, hi = ln_ >> 5
#define ATT_QKS(BUF, S0, M, L, O) do { \
        ATT_LN; const int kswz = r32 & 15; const LAS unsigned char* qlds = lds + QFR + wid * 8192 + ln_ * 16; \
        const LAS unsigned char* kb = lds + KB0 + (BUF) * 16384 + r32 * RB; \
        _Pragma("unroll") for (int s = 0; s < 4; ++s) { const int ch = ((2 * ((S0) + s) + hi) ^ kswz) << 4; \
            const bf16x8 k0 = *(const LAS bf16x8*)(kb + ch), k1 = *(const LAS bf16x8*)(kb + 32 * RB + ch); \
            const bf16x8 qv = *(const LAS bf16x8*)(qlds + ((S0) + s) * 1024); \
            if (s == 0) { asm volatile("v_mfma_f32_32x32x16_bf16 %0, %1, %2, 0" : "=&v"(p0) : "v"(k0), "v"(qv)); \
                          asm volatile("v_mfma_f32_32x32x16_bf16 %0, %1, %2, 0" : "=&v"(p1) : "v"(k1), "v"(qv)); } \
            else { p0 = __builtin_amdgcn_mfma_f32_32x32x16_bf16(k0, qv, p0, 0, 0, 0); p1 = __builtin_amdgcn_mfma_f32_32x32x16_bf16(k1, qv, p1, 0, 0, 0); } } \
        if (diag) { const int kbase = kt * 64 + 4 * hi, qpos = q0 + 32 * wid + r32; \
            _Pragma("unroll") for (int r = 0; r < 16; ++r) { const int kv = kbase + (r & 3) + 8 * (r >> 2); if (kv > qpos) p0[r] = -INFINITY; if (kv + 32 > qpos) p1[r] = -INFINITY; } } \
        float rm = fmaxf(fmaxf(p0[0], p0[1]), p1[0]); \
        _Pragma("unroll") for (int r = 1; r < 16; ++r) rm = fmaxf(fmaxf(rm, p0[r]), p1[r]); \
        { const unsigned rb = __builtin_bit_cast(unsigned, rm); auto rr = __builtin_amdgcn_permlane32_swap(rb, rb, false, false); rm = fmaxf(__builtin_bit_cast(float, (unsigned)rr[0]), __builtin_bit_cast(float, (unsigned)rr[1])); } \
        if (it == 0 || __any(rm > M + THR)) { \
            const float mnew = (it == 0) ? rm : fmaxf(M, rm); const float alpha = fexp2(M - mnew); M = mnew; \
            L *= alpha; \
            _Pragma("unroll") for (int d = 0; d < 4; ++d) _Pragma("unroll") for (int r = 0; r < 16; ++r) O[d][r] *= alpha; } \
        float ls = 0.f; \
        { typedef float f32x2v __attribute__((ext_vector_type(2))); const f32x2v mm = (f32x2v){M, M};        \
          _Pragma("unroll") for (int r = 0; r < 16; r += 2) { const f32x2v a = (f32x2v){p0[r], p0[r + 1]} - mm, b = (f32x2v){p1[r], p1[r + 1]} - mm; \
              p0[r] = fexp2(a.x); p0[r + 1] = fexp2(a.y); p1[r] = fexp2(b.x); p1[r + 1] = fexp2(b.y); ls += (p0[r] + p0[r + 1]) + (p1[r] + p1[r + 1]); } } \
        L += ls; \
    } while (0)
#define ATT_PACK(dst_, ks) do { \
        if ((ks) == 0) { (dst_).x = cvtpk(p0[0], p0[1]); (dst_).y = cvtpk(p0[2], p0[3]); (dst_).z = cvtpk(p0[4], p0[5]); (dst_).w = cvtpk(p0[6], p0[7]); } \
        else if ((ks) == 1) { (dst_).x = cvtpk(p0[8], p0[9]); (dst_).y = cvtpk(p0[10], p0[11]); (dst_).z = cvtpk(p0[12], p0[13]); (dst_).w = cvtpk(p0[14], p0[15]); } \
        else if ((ks) == 2) { (dst_).x = cvtpk(p1[0], p1[1]); (dst_).y = cvtpk(p1[2], p1[3]); (dst_).z = cvtpk(p1[4], p1[5]); (dst_).w = cvtpk(p1[6], p1[7]); } \
        else { (dst_).x = cvtpk(p1[8], p1[9]); (dst_).y = cvtpk(p1[10], p1[11]); (dst_).z = cvtpk(p1[12], p1[13]); (dst_).w = cvtpk(p1[14], p1[15]); } } while (0)
#define ATT_STEP(BUF) do { \
        const int kt = it; const bool more = it + 1 < nt; \
        const bool need = kt * 64 <= q0 + 32 * wid + 31, diag = kt * 64 + 63 > q0 + 32 * wid; \
        if (more) ATT_LOADK(it + 1); \
        v4u pa1[4] = {(v4u){0u, 0u, 0u, 0u}, (v4u){0u, 0u, 0u, 0u}, (v4u){0u, 0u, 0u, 0u}, (v4u){0u, 0u, 0u, 0u}}; \
        if (need) { f32x16 p0, p1; ATT_QKS(BUF, 0, m1, l1, o1); \
              _Pragma("unroll") for (int ks = 0; ks < 4; ++ks) ATT_PACK(pa1[ks], ks); } \
        if (more) { ATT_STOREK((BUF) ^ 1); ATT_LOADV(it + 1); }        \
        if (need) { v4u pa2[4]; \
              { f32x16 p0, p1; ATT_QKS(BUF, 4, m2, l2, o2); \
                _Pragma("unroll") for (int ks = 0; ks < 4; ++ks) ATT_PACK(pa2[ks], ks); } \
              __builtin_amdgcn_sched_barrier(0); \
              ATT_LN; const int vsw = (r32 >> 1) & 7; \
              const LAS unsigned char* vb = lds + VB0 + (BUF) * 16384 + r32 * 128; \
              _Pragma("unroll") for (int ks = 0; ks < 4; ++ks) { \
                const bf16x8 pb1 = __builtin_bit_cast(bf16x8, pa1[ks]), pb2 = __builtin_bit_cast(bf16x8, pa2[ks]); \
                const int c = (ks >> 1) * 4 + (ks & 1) * 2 + hi; \
                _Pragma("unroll") for (int d = 0; d < 4; ++d) { const bf16x8 vf = *(const LAS bf16x8*)(vb + d * 4096 + ((c ^ vsw) << 4)); \
                    o1[d] = __builtin_amdgcn_mfma_f32_32x32x16_bf16(vf, pb1, o1[d], 0, 0, 0); \
                    o2[d] = __builtin_amdgcn_mfma_f32_32x32x16_bf16(vf, pb2, o2[d], 0, 0, 0); } \
                __builtin_amdgcn_sched_barrier(0); } } \
        if (more) ATT_STOREV((BUF) ^ 1); \
        __syncthreads(); \
    } while (0)
    int it = 0;
#pragma unroll 1
    for (; it + 1 < nt; it += 2) { ATT_STEP(0); ++it; ATT_STEP(1); --it; }
    if (it < nt) ATT_STEP(0);
#undef ATT_STEP
#undef ATT_QKS
#undef ATT_PACK
#undef ATT_LN
#undef ATT_LOADK
#undef ATT_LOADV
#undef ATT_STOREK
#undef ATT_STOREV
#undef ATT_TQ
#undef ATT_KGO
#undef ATT_KLDS
#undef ATT_VGO
#undef ATT_VC
#undef ATT_VL0
#undef ATT_VL1
    const float i1 = 1.0f / (l1 + __shfl_xor(l1, 32)), i2 = 1.0f / (l2 + __shfl_xor(l2, 32));
#pragma unroll
    for (int d = 0; d < 4; ++d)
#pragma unroll
        for (int r = 0; r < 16; ++r) { o1[d][r] *= i1; o2[d][r] *= i2; }
}

struct AttnArgs { const bf16 *qa, *ka, *qd, *kd, *vt; bf16* oab; const float* kmean; const float* gain; float lam, one_minus_li; };

__device__ __forceinline__ void moba_unit(LAS unsigned char* lds, const AttnArgs& A, int b, int h, int qb, int tid, int wid, int lane) {
    asm volatile("" : "+v"(tid), "+v"(lane));
    const int r32 = lane & 31, hi = lane >> 5, q0 = qb * 256;
    const bf16* Qg = A.qa + (size_t)(b * SEQ + q0) * 1024 + h * 128;
    unsigned sel = 0u;
    if (qb > 0) {
        { const int row = tid >> 4, ch = tid & 15, n = row & 15;
          const float* kp = A.kmean + ((size_t)(b * 8 + h) * 16 + n) * 128 + ch * 8;
          const f32x4 a = *(const GAS f32x4*)kp, c = *(const GAS f32x4*)(kp + 4);
          float v[8] = {a[0], a[1], a[2], a[3], c[0], c[1], c[2], c[3]}; unsigned w[8];
#pragma unroll
          for (int j = 0; j < 8; ++j) { const float x = v[j] * (1.0f / 256.0f); const unsigned hb = f2bf(x); const float xr = __builtin_bit_cast(float, hb << 16); w[j] = (row < 16) ? hb : f2bf(x - xr); }
          v4u o; o.x = w[0] | (w[1] << 16); o.y = w[2] | (w[3] << 16); o.z = w[4] | (w[5] << 16); o.w = w[6] | (w[7] << 16);
          *(LAS v4u*)(lds + KMT + row * 256 + ((ch ^ (row & 15)) << 4)) = o; }
        __syncthreads();
        f32x16 g = (f32x16){0.f,0.f,0.f,0.f,0.f,0.f,0.f,0.f,0.f,0.f,0.f,0.f,0.f,0.f,0.f,0.f};
        { const bf16* qp = Qg + (size_t)(32 * wid + r32) * 1024 + 8 * hi;
          const LAS unsigned char* kb = lds + KMT + r32 * 256;
#pragma unroll
          for (int s = 0; s < 8; ++s) { const bf16x8 qv = *(const GAS bf16x8*)(qp + 16 * s);
              const bf16x8 kf = *(const LAS bf16x8*)(kb + (((2 * s + hi) ^ (r32 & 15)) << 4));
              g = __builtin_amdgcn_mfma_f32_32x32x16_bf16(kf, qv, g, 0, 0, 0); } }
        float G[16];
#pragma unroll
        for (int r = 0; r < 8; ++r) { const float mine = g[r] + g[r + 8]; const float oth = __shfl_xor(mine, 32);
            const int nlo = (r & 3) + 8 * (r >> 2); G[nlo] = hi ? oth : mine; G[nlo + 4] = hi ? mine : oth; }
#pragma unroll
        for (int round = 0; round < 3; ++round) { float best = -INFINITY; int bi = -1;
#pragma unroll
            for (int n = 0; n < 16; ++n) { const bool ok = (n < qb) && !((sel >> n) & 1u) && (G[n] > best); best = ok ? G[n] : best; bi = ok ? n : bi; }
            if (bi >= 0) sel |= 1u << bi; }
        __syncthreads();
    }
    f32x16 o[4];
    attn_pass<128, true>(lds, Qg, A.ka + (size_t)(b * SEQ) * 1024 + h * 128, A.vt + (size_t)(h * 128) * T + b * SEQ, q0, sel, o, tid, wid, lane);
    bf16* op = A.oab + (size_t)(b * SEQ + q0 + 32 * wid + r32) * 2048 + h * 128 + 4 * hi;
#pragma unroll
    for (int d = 0; d < 4; ++d)
#pragma unroll
        for (int gq = 0; gq < 4; ++gq) { v2u w; w.x = cvtpk(o[d][4 * gq], o[d][4 * gq + 1]); w.y = cvtpk(o[d][4 * gq + 2], o[d][4 * gq + 3]); *(GAS v2u*)(op + 32 * d + 8 * gq) = w; }
}

__device__ __forceinline__ void diff_unit(LAS unsigned char* lds, const AttnArgs& A, int b, int h, int qb, int tid, int wid, int lane) {
    asm volatile("" : "+v"(tid), "+v"(lane));
    const int r32 = lane & 31, hi = lane >> 5, q0 = qb * 256;
    const size_t qrow = (size_t)(b * SEQ + q0);
    const bf16* Vtg = A.vt + (size_t)(1024 + h * 128) * T + b * SEQ;
    f32x16 o[4], o2[4];
    attn_pass_diff2(lds, A.qd + qrow * 1024 + h * 128, A.kd + (size_t)(b * SEQ) * 1024 + h * 128, Vtg, q0, o, o2, tid, wid, lane);
    float ss = 0.f;
#pragma unroll
    for (int d = 0; d < 4; ++d)
#pragma unroll
        for (int r = 0; r < 16; ++r) { const float v = o[d][r] - A.lam * o2[d][r]; o[d][r] = v; ss += v * v; }
    ss += __shfl_xor(ss, 32);
    const float rn = 1.0f / sqrtf(ss * (1.0f / 128.0f) + RMS_EPS) * A.one_minus_li;
    bf16* op = A.oab + (qrow + 32 * wid + r32) * 2048 + 1024 + h * 128 + 4 * hi;
    const float* gp = A.gain + h * 128 + 4 * hi;
#pragma unroll
    for (int d = 0; d < 4; ++d)
#pragma unroll
        for (int gq = 0; gq < 4; ++gq) { const f32x4 gn = *(const GAS f32x4*)(gp + 32 * d + 8 * gq);
            v2u w; w.x = cvtpk(o[d][4 * gq] * rn * gn[0], o[d][4 * gq + 1] * rn * gn[1]); w.y = cvtpk(o[d][4 * gq + 2] * rn * gn[2], o[d][4 * gq + 3] * rn * gn[3]);
            *(GAS v2u*)(op + 32 * d + 8 * gq) = w; }
}

__device__ __forceinline__ void attn_phase(LAS unsigned char* lds, const AttnArgs& A, int vcu, int G, int tid, int wid, int lane) {
    for (int ord = vcu; ord < 1024; ord += G) {
        const int i = ord >> 8, v = ord & 255, bh = v >> 3, s = v & 7;
        const int qb = (i & 1) ? 15 - s : s;
        if (i < 2) diff_unit(lds, A, bh >> 3, bh & 7, qb, tid, wid, lane);
        else moba_unit(lds, A, bh >> 3, bh & 7, qb, tid, wid, lane);
    }
}
}

namespace peer {
__device__ __forceinline__ int f2key(float f) { const int u = __builtin_bit_cast(int, f); return u ^ ((u >> 31) & 0x7fffffff); }
__device__ __forceinline__ float key2f(int k) { const int u = k ^ ((k >> 31) & 0x7fffffff); return __builtin_bit_cast(float, u); }
__device__ __forceinline__ int imax(int a, int b) { return a > b ? a : b; }
__device__ __forceinline__ int imin(int a, int b) { return a < b ? a : b; }

template <int OFF> __device__ __forceinline__ void sort16_desc(int (&v)[64]) {
#pragma unroll
    for (int k = 2; k <= 16; k <<= 1)
#pragma unroll
        for (int j = k >> 1; j > 0; j >>= 1)
#pragma unroll
            for (int i = 0; i < 16; ++i) { const int l = i ^ j;
                if (l > i) { const bool desc = ((i & k) == 0); const int a = v[OFF + i], b = v[OFF + l]; const int mx = imax(a, b), mn = imin(a, b);
                    v[OFF + i] = desc ? mx : mn; v[OFF + l] = desc ? mn : mx; } }
}
template <int OA, int OB> __device__ __forceinline__ void merge16_desc(int (&v)[64]) {
#pragma unroll
    for (int i = 0; i < 16; ++i) v[OA + i] = imax(v[OA + i], v[OB + 15 - i]);
#pragma unroll
    for (int j = 8; j > 0; j >>= 1)
#pragma unroll
        for (int i = 0; i < 16; ++i) { const int l = i ^ j;
            if (l > i) { const int a = v[OA + i], b = v[OA + l]; v[OA + i] = imax(a, b); v[OA + l] = imin(a, b); } }
}
__device__ __forceinline__ void top16_of_64(int (&v)[64]) {
    sort16_desc<0>(v); sort16_desc<16>(v); sort16_desc<32>(v); sort16_desc<48>(v);
    merge16_desc<0, 16>(v); merge16_desc<32, 48>(v); merge16_desc<0, 32>(v);
}
__device__ __forceinline__ float gelu_tanh(float x) {
    const float u = 0.7978845608028654f * (x + 0.044715f * x * x * x);
    const float e = __builtin_amdgcn_exp2f(2.0f * 1.4426950408889634f * u);
    const float th = 1.0f - 2.0f * __builtin_amdgcn_rcpf(e + 1.0f);
    return 0.5f * x * (1.0f + th);
}
constexpr int ETILE = 0, GTILE = 16384, SCR0 = 32768, XQ0 = 98304;

__device__ __forceinline__ void select_tile(LAS unsigned char* lds, const bf16* pq, const bf16* sk, int t0, int wid, int lane) {
    asm volatile("" : "+v"(lane));
    const int r32 = lane & 31, hi = lane >> 5, h = wid;
    LAS int* scr = (LAS int*)(lds + SCR0 + wid * 8192);
    int v[64];
#pragma unroll 1
    for (int c = 0; c < 2; ++c) {
        bf16x8 qf[8];
        { const bf16* qp = pq + (size_t)(t0 + r32) * 2048 + h * 256 + c * 128 + 8 * hi;
#pragma unroll
          for (int s = 0; s < 8; ++s) qf[s] = *(const GAS bf16x8*)(qp + 16 * s); }
        bf16x8 af[2][4];
        const bf16* ap0 = sk + ((size_t)((c * 8 + h) * 128 + r32)) * 128 + 8 * hi;
#pragma unroll
        for (int s = 0; s < 4; ++s) af[0][s] = *(const GAS bf16x8*)(ap0 + 16 * s);
        f32x16 sc;
#pragma unroll
        for (int hb = 0; hb < 8; ++hb) {
            if (hb + 1 < 8) { const bf16* ap = ap0 + (size_t)(32 * ((hb + 1) >> 1)) * 128 + 64 * ((hb + 1) & 1);
#pragma unroll
                for (int s = 0; s < 4; ++s) af[(hb + 1) & 1][s] = *(const GAS bf16x8*)(ap + 16 * s); }
            __builtin_amdgcn_sched_barrier(0);
            if ((hb & 1) == 0) sc = (f32x16){0.f,0.f,0.f,0.f,0.f,0.f,0.f,0.f,0.f,0.f,0.f,0.f,0.f,0.f,0.f,0.f};
#pragma unroll
            for (int s = 0; s < 4; ++s) sc = __builtin_amdgcn_mfma_f32_32x32x16_bf16(af[hb & 1][s], qf[4 * (hb & 1) + s], sc, 0, 0, 0);
            if (hb & 1) {
#pragma unroll
                for (int r = 0; r < 16; ++r) v[(hb >> 1) * 16 + r] = (f2key(sc[r]) & ~127) | (32 * (hb >> 1) + (r & 3) + 8 * (r >> 2) + 4 * hi); }
            __builtin_amdgcn_sched_barrier(0);
        }
        top16_of_64(v);
#pragma unroll
        for (int i = 0; i < 16; ++i) v[16 + i] = __shfl_xor(v[i], 32);
        merge16_desc<0, 16>(v);
#pragma unroll
        for (int i = 0; i < 16; ++i) scr[(c * 16 + i) * 64 + lane] = v[i];
    }
    LDS_WAIT();
    float a[16], b[16];
#pragma unroll
    for (int i = 0; i < 16; ++i) { a[i] = key2f(scr[i * 64 + lane] & ~127); b[i] = key2f(v[i] & ~127); }
    int n = 0;
#pragma unroll
    for (int i = 0; i < 16; ++i)
#pragma unroll
        for (int j = 0; j < 16; ++j)
            if ((i + 1) * (j + 1) <= 16) { v[n] = (f2key(a[i] + b[j]) & ~255) | (i << 4) | j; ++n; }
#pragma unroll
    for (int i = 0; i < 64; ++i) if (i >= 50) v[i] = (int)0x80000000;
    top16_of_64(v);
    float s[16]; int e[16]; float mx = -INFINITY;
#pragma unroll
    for (int k = 0; k < 16; ++k) { const int i = (v[k] >> 4) & 15, j = v[k] & 15;
        const int ka = scr[i * 64 + lane], kb2 = scr[(16 + j) * 64 + lane];
        s[k] = key2f(ka & ~127) + key2f(kb2 & ~127); e[k] = (ka & 127) * 128 + (kb2 & 127); mx = fmaxf(mx, s[k]); }
    float sum = 0.f;
#pragma unroll
    for (int k = 0; k < 16; ++k) { s[k] = __builtin_amdgcn_exp2f((s[k] - mx) * 1.4426950408889634f); sum += s[k]; }
    const float inv = 1.0f / sum;
    if (hi == 0) {
        LAS int* E = (LAS int*)(lds + ETILE) + r32 * 128 + h * 16; LAS float* Gt = (LAS float*)(lds + GTILE) + r32 * 128 + h * 16;
#pragma unroll
        for (int k = 0; k < 16; ++k) { E[k] = e[k]; Gt[k] = s[k] * inv; }
    }
}

#define PEER_LOADROW(dst, tab, ridx) do { dst = *((const GAS v4u*)((tab) + (size_t)(ridx) * 1024) + lane); } while (0)
typedef float f32x2p __attribute__((ext_vector_type(2)));
#define PEER_CVT4(w) const f32x2p c0_ = __builtin_amdgcn_cvt_scalef32_pk_f32_fp4((w), 1.0f, 0), c1_ = __builtin_amdgcn_cvt_scalef32_pk_f32_fp4((w), 1.0f, 1), \
        c2_ = __builtin_amdgcn_cvt_scalef32_pk_f32_fp4((w), 1.0f, 2), c3_ = __builtin_amdgcn_cvt_scalef32_pk_f32_fp4((w), 1.0f, 3)
#define PEER_AXPY8(Y2, wk2, w, b) do { PEER_CVT4(w); Y2[(b)] = __builtin_elementwise_fma(wk2, c0_, Y2[(b)]); Y2[(b) + 1] = __builtin_elementwise_fma(wk2, c1_, Y2[(b) + 1]); \
        Y2[(b) + 2] = __builtin_elementwise_fma(wk2, c2_, Y2[(b) + 2]); Y2[(b) + 3] = __builtin_elementwise_fma(wk2, c3_, Y2[(b) + 3]); } while (0)

__device__ __forceinline__ void token_ffn(LAS unsigned char* lds, int tl, const bf16* xrow, const unsigned char* TU, const unsigned char* TV, const float* SU, const float* SV,
                                          const float* gain, const float* bias, float* outf, bf16* outb, unsigned char* out8, float* outsx, int lane,
                                          v4u (&buf)[16], bool have_u, bool has_next) {
    f32x2p xs[16];
#pragma unroll
    for (int q = 0; q < 4; ++q) { const v4u a = *(const GAS v4u*)(xrow + 32 * lane + 8 * q);
        xs[4 * q] = (f32x2p){bf_lo(a.x), bf_hi(a.x)}; xs[4 * q + 1] = (f32x2p){bf_lo(a.y), bf_hi(a.y)}; xs[4 * q + 2] = (f32x2p){bf_lo(a.z), bf_hi(a.z)}; xs[4 * q + 3] = (f32x2p){bf_lo(a.w), bf_hi(a.w)}; }
    const LAS int* E = (const LAS int*)(lds + ETILE) + tl * 128; const LAS float* Gt = (const LAS float*)(lds + GTILE) + tl * 128;
    const int e_lo = E[lane], e_hi = E[64 + lane]; const float g_lo = Gt[lane], g_hi = Gt[64 + lane];
    const float su_lo = SU[e_lo], su_hi = SU[e_hi], sv_lo = SV[e_lo], sv_hi = SV[e_hi];
#define PEER_EIDX(k) (((k) < 64) ? __builtin_amdgcn_readlane(e_lo, (k)) : __builtin_amdgcn_readlane(e_hi, (k) - 64))
    constexpr int PEER_RING = 16;
    float h_lo = 0.f, h_hi = 0.f;
    {
        float am = 0.f;
#pragma unroll
        for (int i = 0; i < 16; ++i) am = fmaxf(am, fmaxf(fabsf(xs[i].x), fabsf(xs[i].y)));
#pragma unroll
        for (int o = 1; o < 64; o <<= 1) am = fmaxf(am, __shfl_xor(am, o));
        const float sx = am > 0.f ? 6.0f / am : 1.0f, isx = am > 0.f ? am / 6.0f : 1.0f;
        v4u xh, xl;
#pragma unroll
        for (int wq = 0; wq < 4; ++wq) { unsigned wh = 0u, wl = 0u;
#define PEER_XQ(b) { const f32x2p v = xs[4 * wq + (b)] * sx; wh = __builtin_amdgcn_cvt_scalef32_pk_fp4_f32(wh, v.x, v.y, 1.0f, (b)); \
                const f32x2p d = __builtin_amdgcn_cvt_scalef32_pk_f32_fp4(wh, 1.0f, (b)); wl = __builtin_amdgcn_cvt_scalef32_pk_fp4_f32(wl, (v.x - d.x) * 4.0f, (v.y - d.y) * 4.0f, 1.0f, (b)); }
            PEER_XQ(0) PEER_XQ(1) PEER_XQ(2) PEER_XQ(3)
#undef PEER_XQ
            xh[wq] = wh; xl[wq] = wl; }
        LAS unsigned char* xq = lds + XQ0 + (tl >> 2) * 2048;
        *(LAS v4u*)(xq + 16 * lane) = xh; *(LAS v4u*)(xq + 1024 + 16 * lane) = xl;
        const int g = lane >> 4, rl = lane & 15;
        typedef int v8i_t __attribute__((ext_vector_type(8)));
        if (!have_u) { const int e_r = E[16 * 0 + rl];
#pragma unroll
            for (int s = 0; s < 16; ++s) buf[s] = *(const GAS v4u*)(TU + (size_t)e_r * 1024 + 16 * g + 64 * s); }
#define PEER_HBLOCK(rb, RELOAD) do { \
            f32x4 ah = {0.f, 0.f, 0.f, 0.f}, al = {0.f, 0.f, 0.f, 0.f}; \
            int xoff = 16 * g; asm volatile("" : "+v"(xoff));        \
            const LAS unsigned char* xbb = xq + xoff; \
            _Pragma("unroll") for (int s = 0; s < 16; ++s) { \
                const v4u a4 = buf[s]; const v4u bh = *(const LAS v4u*)(xbb + 64 * s), bl = *(const LAS v4u*)(xbb + 1024 + 64 * s); \
                const v8i_t A = {(int)a4.x, (int)a4.y, (int)a4.z, (int)a4.w, 0, 0, 0, 0}, BH = {(int)bh.x, (int)bh.y, (int)bh.z, (int)bh.w, 0, 0, 0, 0}, BL = {(int)bl.x, (int)bl.y, (int)bl.z, (int)bl.w, 0, 0, 0, 0}; \
                ah = __builtin_amdgcn_mfma_scale_f32_16x16x128_f8f6f4(A, BH, ah, 4, 4, 0, 127, 0, 127); \
                al = __builtin_amdgcn_mfma_scale_f32_16x16x128_f8f6f4(A, BL, al, 4, 4, 0, 127, 0, 127); \
                RELOAD(s); } \
              \
            float selv = 0.f; \
            _Pragma("unroll") for (int r = 0; r < 4; ++r) { const float hv = (ah[r] + 0.25f * al[r]) * isx; const float t = __shfl(hv, 16 * ((lane >> 2) & 3)); selv = ((lane & 3) == r) ? t : selv; } \
            if ((rb) < 4) h_lo = ((lane >> 4) == (rb)) ? selv : h_lo; else h_hi = ((lane >> 4) == ((rb) - 4)) ? selv : h_hi; } while (0)
#define PEER_RELOAD_U(s) buf[s] = *(const GAS v4u*)(rown + 64 * (s))
#define PEER_RELOAD_V(s) PEER_LOADROW(buf[s], TV, PEER_EIDX(s))
#pragma unroll 1
        for (int rb = 0; rb < 7; ++rb) {
            const int e_n = E[16 * (rb + 1) + rl];
            const GAS unsigned char* rown = (const GAS unsigned char*)TU + (size_t)e_n * 1024 + 16 * g;
            PEER_HBLOCK(rb, PEER_RELOAD_U);
        }
        PEER_HBLOCK(7, PEER_RELOAD_V);
#undef PEER_RELOAD_U
#undef PEER_RELOAD_V
#undef PEER_HBLOCK
    }
    const float w_lo = g_lo * gelu_tanh(h_lo * su_lo) * sv_lo, w_hi = g_hi * gelu_tanh(h_hi * su_hi) * sv_hi;
    f32x2p y[16];
#pragma unroll
    for (int i = 0; i < 16; ++i) y[i] = (f32x2p){0.f, 0.f};
#pragma unroll 1
    for (int k0 = 0; k0 < 128 - PEER_RING; k0 += PEER_RING) {
        const int wsrc = __builtin_bit_cast(int, (k0 < 64) ? w_lo : w_hi);
        const int kb = k0 + PEER_RING;
        const int esrc = (kb < 64) ? e_lo : e_hi;
#pragma unroll
        for (int i = 0; i < PEER_RING; ++i) {
            const float wk = __builtin_bit_cast(float, __builtin_amdgcn_readlane(wsrc, (k0 & 63) + i));
            const v4u w = buf[i]; const f32x2p wk2 = {wk, wk};
            PEER_AXPY8(y, wk2, w.x, 0); PEER_AXPY8(y, wk2, w.y, 4); PEER_AXPY8(y, wk2, w.z, 8); PEER_AXPY8(y, wk2, w.w, 12);
            const int en = __builtin_amdgcn_readlane(esrc, (kb & 63) + i); PEER_LOADROW(buf[i], TV, en);
        }
    }
    {
        const int e_nx = has_next ? E[128 + (lane & 15)] : 0;
        const GAS unsigned char* rownx = (const GAS unsigned char*)TU + (size_t)e_nx * 1024 + 16 * (lane >> 4);
#pragma unroll
        for (int i = 0; i < PEER_RING; ++i) {
            const float wk = __builtin_bit_cast(float, __builtin_amdgcn_readlane(__builtin_bit_cast(int, w_hi), 48 + i));
            const v4u w = buf[i]; const f32x2p wk2 = {wk, wk};
            PEER_AXPY8(y, wk2, w.x, 0); PEER_AXPY8(y, wk2, w.y, 4); PEER_AXPY8(y, wk2, w.z, 8); PEER_AXPY8(y, wk2, w.w, 12);
            if (has_next) buf[i] = *(const GAS v4u*)(rownx + 64 * i);
        }
    }
    float sm = 0.f;
#pragma unroll
    for (int i = 0; i < 16; ++i) { y[i] = xs[i] * ALPHA + y[i]; sm += y[i].x + y[i].y; }
    const float mean = wave_sum(sm) * (1.0f / 2048.0f);
    float sq = 0.f;
#pragma unroll
    for (int i = 0; i < 16; ++i) { y[i] = y[i] - mean; sq += y[i].x * y[i].x + y[i].y * y[i].y; }
    const float rstd = 1.0f / sqrtf(wave_sum(sq) * (1.0f / 2048.0f) + LN_EPS);
    unsigned pk[16];
#pragma unroll
    for (int q = 0; q < 8; ++q) { const int c0 = 32 * lane + 4 * q;
        const f32x4 ga = *(const GAS f32x4*)(gain + c0), ba = *(const GAS f32x4*)(bias + c0);
        f32x4 o;
        o[0] = y[2 * q].x * rstd * ga[0] + ba[0]; o[1] = y[2 * q].y * rstd * ga[1] + ba[1]; o[2] = y[2 * q + 1].x * rstd * ga[2] + ba[2]; o[3] = y[2 * q + 1].y * rstd * ga[3] + ba[3];
        if (outf) *(GAS f32x4*)(outf + c0) = o;
        pk[2 * q] = pk2(o[0], o[1]); pk[2 * q + 1] = pk2(o[2], o[3]); }
    if (outb) {
#pragma unroll
        for (int q = 0; q < 4; ++q) *(GAS v4u*)(outb + 32 * lane + 8 * q) = (v4u){pk[4 * q], pk[4 * q + 1], pk[4 * q + 2], pk[4 * q + 3]};
        float am = 0.f;
#pragma unroll
        for (int i = 0; i < 16; ++i) am = fmaxf(am, fmaxf(fabsf(bf_lo(pk[i])), fabsf(bf_hi(pk[i]))));
#pragma unroll
        for (int o = 1; o < 64; o <<= 1) am = fmaxf(am, __shfl_xor(am, o));
        const float sc = am > 0.f ? 127.0f / am : 0.f;
#pragma unroll
        for (int q = 0; q < 2; ++q) { v4u w;
            w.x = q8pack(bf_lo(pk[8 * q]), bf_hi(pk[8 * q]), bf_lo(pk[8 * q + 1]), bf_hi(pk[8 * q + 1]), sc); w.y = q8pack(bf_lo(pk[8 * q + 2]), bf_hi(pk[8 * q + 2]), bf_lo(pk[8 * q + 3]), bf_hi(pk[8 * q + 3]), sc);
            w.z = q8pack(bf_lo(pk[8 * q + 4]), bf_hi(pk[8 * q + 4]), bf_lo(pk[8 * q + 5]), bf_hi(pk[8 * q + 5]), sc); w.w = q8pack(bf_lo(pk[8 * q + 6]), bf_hi(pk[8 * q + 6]), bf_lo(pk[8 * q + 7]), bf_hi(pk[8 * q + 7]), sc);
            *(GAS v4u*)(out8 + 32 * lane + 16 * q) = w; }
        if (lane == 0) *outsx = am * (1.0f / 127.0f); }
#undef PEER_EIDX
}
#undef PEER_LOADROW
#undef PEER_AXPY8
#undef PEER_CVT4
}

__device__ __forceinline__ void ln_row(const bf16* zrow, const float* gain, const float* bias, bf16* outb, int lane) {
    float v[32]; float s = 0.f;
#pragma unroll
    for (int q = 0; q < 4; ++q) { const v4u w = *(const GAS v4u*)(zrow + 32 * lane + 8 * q);
        v[8 * q] = bf_lo(w.x); v[8 * q + 1] = bf_hi(w.x); v[8 * q + 2] = bf_lo(w.y); v[8 * q + 3] = bf_hi(w.y); v[8 * q + 4] = bf_lo(w.z); v[8 * q + 5] = bf_hi(w.z); v[8 * q + 6] = bf_lo(w.w); v[8 * q + 7] = bf_hi(w.w); }
#pragma unroll
    for (int i = 0; i < 32; ++i) s += v[i];
    const float mean = wave_sum(s) * (1.0f / 2048.0f); float s2 = 0.f;
#pragma unroll
    for (int i = 0; i < 32; ++i) { v[i] -= mean; s2 += v[i] * v[i]; }
    const float rstd = 1.0f / sqrtf(wave_sum(s2) * (1.0f / 2048.0f) + LN_EPS);
#pragma unroll
    for (int q = 0; q < 4; ++q) { const int c0 = 32 * lane + 8 * q;
        const f32x4 g0 = *(const GAS f32x4*)(gain + c0), g1 = *(const GAS f32x4*)(gain + c0 + 4), b0 = *(const GAS f32x4*)(bias + c0), b1 = *(const GAS f32x4*)(bias + c0 + 4);
        v4u o; o.x = pk2(v[8 * q] * rstd * g0[0] + b0[0], v[8 * q + 1] * rstd * g0[1] + b0[1]); o.y = pk2(v[8 * q + 2] * rstd * g0[2] + b0[2], v[8 * q + 3] * rstd * g0[3] + b0[3]);
        o.z = pk2(v[8 * q + 4] * rstd * g1[0] + b1[0], v[8 * q + 5] * rstd * g1[1] + b1[1]); o.w = pk2(v[8 * q + 6] * rstd * g1[2] + b1[2], v[8 * q + 7] * rstd * g1[3] + b1[3]);
        *(GAS v4u*)(outb + c0) = o; }
}

#if MK_CHECK
namespace chk {
constexpr int CW_ERR = 2048;
__device__ __forceinline__ unsigned hash32(unsigned x) { x ^= x >> 16; x *= 0x7feb352du; x ^= x >> 15; x *= 0x846ca68bu; x ^= x >> 16; return x; }
__device__ __forceinline__ float bf2f(bf16 v) { return __builtin_bit_cast(float, (unsigned)v << 16); }
__device__ __forceinline__ void report(gu32* ctl, int stage, float d2, float r2) { atomicAdd((float*)(ctl + CW_ERR + 2 * stage), d2); atomicAdd((float*)(ctl + CW_ERR + 2 * stage + 1), r2); }
__device__ __forceinline__ float dotcol(const bf16* xr, const float* win, int n, int lane) { float a = 0.f; for (int k = lane; k < 2048; k += 64) a += bf2f(xr[k]) * win[(size_t)k * INC + n]; return wave_sum(a); }
__device__ __forceinline__ void check_inproj(gu32* ctl, const bf16* xin, const int* pos, const float* win, const bf16* qa, const bf16* ka, const bf16* qd, const bf16* kd, const bf16* vt, const bf16* ga, const bf16* gb, int gw, int ngw, int lane) {
    for (int s = gw; s < 4096; s += ngw) {
        const unsigned hsh = hash32(s * 2654435761u + 12345u);
        const int t = hsh % T, kind = (hsh >> 14) % 8;
        const unsigned h2 = hash32(hsh);
        const bf16* xr = xin + (size_t)t * 2048;
        float ref, got;
        if (kind == 0 || kind == 1) { const int head = h2 % 8, i = (h2 >> 3) % 64, nb = (kind == 0 ? 0 : 1024) + head * 128;
            const float t1 = dotcol(xr, win, nb + i, lane), t2 = dotcol(xr, win, nb + i + 64, lane);
            const float ang = (float)pos[t] * powf(10000.0f, -(float)(2 * i) / 128.0f), c = cosf(ang), sn = sinf(ang);
            const bool second = (h2 >> 9) & 1; ref = second ? (t1 * sn + t2 * c) : (t1 * c - t2 * sn);
            const bf16* p = (kind == 0 ? qa : ka) + (size_t)t * 1024 + head * 128 + i + (second ? 64 : 0);
            got = bf2f(*p) / (kind == 0 ? QSCALE_A : 1.0f);
        } else if (kind == 3 || kind == 4) { const int head = h2 % 8, comp = (h2 >> 3) & 1, i = (h2 >> 4) % 32, nb = (kind == 3 ? 3072 : 4096) + head * 128 + comp * 64;
            const float t1 = dotcol(xr, win, nb + i, lane), t2 = dotcol(xr, win, nb + i + 32, lane);
            const float ang = (float)pos[t] * powf(10000.0f, -(float)(2 * i) / 64.0f), c = cosf(ang), sn = sinf(ang);
            const bool second = (h2 >> 9) & 1; ref = second ? (t1 * sn + t2 * c) : (t1 * c - t2 * sn);
            const bf16* p = (kind == 3 ? qd : kd) + (size_t)t * 1024 + head * 128 + comp * 64 + i + (second ? 32 : 0);
            got = bf2f(*p) / (kind == 3 ? QSCALE_B : 1.0f);
        } else if (kind == 2 || kind == 5) { const int c = h2 % 1024; ref = dotcol(xr, win, (kind == 2 ? 2048 : 5120) + c, lane); got = bf2f(vt[(size_t)((kind == 2 ? 0 : 1024) + c) * T + t]);
        } else { const int c = h2 % 2048; const float v = dotcol(xr, win, (kind == 6 ? 6144 : 8192) + c, lane); ref = 1.0f / (1.0f + expf(-v)); got = (float)((const unsigned char*)(kind == 6 ? ga : gb))[(size_t)t * 2048 + c] * (1.0f / 255.0f); }
        if (lane == 0) report(ctl, 0, (got - ref) * (got - ref), ref * ref);
    }
}
__device__ __forceinline__ void check_kmean(gu32* ctl, const bf16* ka, const float* kmean, int gw, int ngw, int lane) {
    for (int s = gw; s < 1024; s += ngw) { const unsigned hsh = hash32(s * 40503u + 77u); const int item = hsh % 512, d = (hsh >> 10) % 128; const int b = item >> 7, h = (item >> 4) & 7, blk = item & 15;
        float a = 0.f; for (int r = lane; r < 256; r += 64) a += bf2f(ka[(size_t)(b * SEQ + blk * 256 + r) * 1024 + h * 128 + d]); a = wave_sum(a);
        const float g = kmean[(size_t)item * 128 + d];
        if (lane == 0) report(ctl, 1, (g - a) * (g - a), a * a + 1.0f); }
}
__device__ __forceinline__ void check_attn(LAS unsigned char* lds, gu32* ctl, const att::AttnArgs& A, int vcu, int G, int tid, int lane, int wave) {
    LAS float* sc = (LAS float*)lds; LAS float* red = sc + 4096; LAS float* ovec = red + 64; LAS float* gsc = ovec + 256; LAS unsigned* selw = (LAS unsigned*)(gsc + 16);
    for (int s = vcu; s < 1024; s += G) {
        const unsigned hsh = hash32(s * 2246822519u + 99u); const bool moba = (s & 1);
        const int b = hsh % NB, h = (hsh >> 2) % NH; int t = (hsh >> 5) % SEQ; if ((s & 6) == 0) t = (t & 255) + 256 * ((hsh >> 20) % 3);
        const size_t row = (size_t)b * SEQ + t; const int own = t >> 8;
        float o0 = 0.f, o1 = 0.f;
        const int ncomp = moba ? 1 : 2;
        __syncthreads();
        if (moba) {
            if (tid < 16) { float a = -INFINITY; if (tid < own) { a = 0.f; for (int d = 0; d < 128; ++d) a += bf2f(A.qa[row * 1024 + h * 128 + d]) * A.kmean[((size_t)(b * 8 + h) * 16 + tid) * 128 + d]; } gsc[tid] = a; }
            __syncthreads();
            if (tid == 0) { unsigned sel = 0u; for (int r = 0; r < 3; ++r) { float best = -INFINITY; int bi = -1; for (int n = 0; n < own; ++n) { const float g = gsc[n]; if (!((sel >> n) & 1u) && g > best) { best = g; bi = n; } } if (bi >= 0) sel |= 1u << bi; } selw[0] = sel; }
            __syncthreads();
        }
        const unsigned sel = moba ? selw[0] : 0u;
        for (int comp = 0; comp < ncomp; ++comp) {
            const bf16* qp = moba ? A.qa + row * 1024 + h * 128 : A.qd + row * 1024 + h * 128 + comp * 64;
            const bf16* kb = moba ? A.ka + (size_t)b * SEQ * 1024 + h * 128 : A.kd + (size_t)b * SEQ * 1024 + h * 128 + comp * 64;
            const int dq = moba ? 128 : 64;
            float lmax = -INFINITY;
            for (int k = tid; k <= t; k += 512) { bool ok = true; if (moba) { const int kbk = k >> 8; ok = (kbk == own) || ((sel >> kbk) & 1u); }
                float a = -INFINITY; if (ok) { a = 0.f; for (int d = 0; d < dq; ++d) a += bf2f(qp[d]) * bf2f(kb[(size_t)k * 1024 + d]); }
                sc[k] = a; lmax = fmaxf(lmax, a); }
            lmax = fmaxf(lmax, __shfl_xor(lmax, 1)); lmax = fmaxf(lmax, __shfl_xor(lmax, 2)); lmax = fmaxf(lmax, __shfl_xor(lmax, 4)); lmax = fmaxf(lmax, __shfl_xor(lmax, 8)); lmax = fmaxf(lmax, __shfl_xor(lmax, 16)); lmax = fmaxf(lmax, __shfl_xor(lmax, 32));
            if (lane == 0) red[wave] = lmax;
            __syncthreads();
            float gmax = red[0]; for (int w = 1; w < 8; ++w) gmax = fmaxf(gmax, red[w]);
            float lsum = 0.f;
            for (int k = tid; k <= t; k += 512) { const float p = exp2f(sc[k] - gmax); sc[k] = p; lsum += p; }
            lsum = wave_sum(lsum);
            if (lane == 0) red[8 + wave] = lsum;
            __syncthreads();
            float gsum = 0.f; for (int w = 0; w < 8; ++w) gsum += red[8 + w];
            if (tid < 128) { const bf16* vp = A.vt + (size_t)((moba ? 0 : 1024) + h * 128 + tid) * T + (size_t)b * SEQ; float a = 0.f; for (int k = 0; k <= t; ++k) a += sc[k] * bf2f(vp[k]); a /= gsum; if (comp == 0) o0 = a; else o1 = a; }
            __syncthreads();
        }
        float ref = 0.f, got = 0.f;
        if (tid < 128) {
            if (moba) { ref = o0; got = bf2f(A.oab[row * 2048 + h * 128 + tid]); }
            else { ref = o0 - A.lam * o1; got = bf2f(A.oab[row * 2048 + 1024 + h * 128 + tid]); }
            ovec[tid] = ref;
        }
        __syncthreads();
        if (tid < 128 && !moba) { float ss = 0.f; for (int d = 0; d < 128; ++d) ss += ovec[d] * ovec[d]; ref = ref / sqrtf(ss * (1.0f / 128.0f) + RMS_EPS) * A.gain[h * 128 + tid] * A.one_minus_li; }
        float d2 = (tid < 128) ? (got - ref) * (got - ref) : 0.f, r2 = (tid < 128) ? ref * ref : 0.f;
        d2 = wave_sum(d2); r2 = wave_sum(r2);
        if (lane == 0 && wave < 2) report(ctl, moba ? 2 : 3, d2, r2);
        __syncthreads();
    }
}
__device__ __forceinline__ void check_merged(gu32* ctl, const bf16* oab, const bf16* ga, const bf16* gb, const bf16* merged, const float* wa, const float* wb, int gw, int ngw, int lane) {
    for (int s = gw; s < 2048; s += ngw) { const unsigned hsh = hash32(s * 3266489917u + 5u); const int t = hsh % T, c = (hsh >> 14) % 2048;
        float a = 0.f, b = 0.f; for (int k = lane; k < 1024; k += 64) { a += bf2f(oab[(size_t)t * 2048 + k]) * wa[(size_t)k * 2048 + c]; b += bf2f(oab[(size_t)t * 2048 + 1024 + k]) * wb[(size_t)k * 2048 + c]; }
        a = wave_sum(a); b = wave_sum(b);
        const float ref = ((float)((const unsigned char*)ga)[(size_t)t * 2048 + c] * a + (float)((const unsigned char*)gb)[(size_t)t * 2048 + c] * b) * (1.0f / 255.0f), got = bf2f(merged[(size_t)t * 2048 + c]);
        if (lane == 0) report(ctl, 4, (got - ref) * (got - ref), ref * ref); }
}
__device__ __forceinline__ void check_z(gu32* ctl, const bf16* merged, const float* wo, const bf16* xres, const bf16* z, int gw, int ngw, int lane) {
    for (int s = gw; s < 2048; s += ngw) { const unsigned hsh = hash32(s * 668265263u + 31u); const int t = hsh % T, c = (hsh >> 14) % 2048;
        float a = 0.f; for (int k = lane; k < 2048; k += 64) a += bf2f(merged[(size_t)t * 2048 + k]) * wo[(size_t)k * 2048 + c];
        a = wave_sum(a);
        const float got = bf2f(z[(size_t)t * 2048 + c]) - ALPHA * bf2f(xres[(size_t)t * 2048 + c]);
        if (lane == 0) report(ctl, 5, (got - a) * (got - a), a * a); }
}
}
#endif

constexpr int NPHASE = 2 + 8 * DEPTH;
#ifndef MK_ALIGN
#define MK_ALIGN true
#endif
#ifndef MK_SP2
#define MK_SP2 true
#endif
struct Params { const float* in[16]; float* out; unsigned char* ws; int ph_lo, ph_hi; };

__global__ void __launch_bounds__(NWAVES * 64, 2) mk_fwd(Params args) {
    extern __shared__ __attribute__((aligned(16))) unsigned char lds_raw[];
    Frame F;
    F.lds = (LAS unsigned char*)lds_raw;
    F.MISC = (volatile LAS unsigned*)(F.lds + MISC_OFF);
    F.tid = threadIdx.x; F.lane = F.tid & 63; F.wave = __builtin_amdgcn_readfirstlane(F.tid >> 6);
    F.G = gridDim.x; { const int bx = blockIdx.x; F.vcu = (F.G % 8 == 0) ? (bx % 8) * (F.G / 8) + bx / 8 : bx; }
    F.ws = args.ws; F.ctl = (gu32*)(args.ws + WS_CTL);
    unsigned char* const ws = args.ws;
    const float* const in_x = args.in[0]; const int* const in_pos = (const int*)args.in[1];
    const float *in_win = args.in[2], *in_wa = args.in[3], *in_wb = args.in[4], *in_wo = args.in[5], *in_dlam = args.in[6], *in_dgain = args.in[7];
    const float *in_ln1g = args.in[8], *in_ln1b = args.in[9], *in_ln2g = args.in[10], *in_ln2b = args.in[11], *in_pwq = args.in[12], *in_sk = args.in[13], *in_pu = args.in[14], *in_pv = args.in[15];
    float* const dout = args.out;

    for (int u = F.tid; u < (LDS_BYTES - LDSCTL_OFF) / 4; u += NWAVES * 64) ((LAS unsigned*)(F.lds + LDSCTL_OFF))[u] = 0u;
    __syncthreads();
#if MK_FUSED
    XcdBarrier bar = xcd_barrier_post((unsigned*)(F.ctl + CW_BAR), F.MISC + 8, (unsigned)F.wave);
#define GRID_BAR() xcd_barrier(bar)
#else
#define GRID_BAR() do { } while (0)
#endif
    const int lo = args.ph_lo, hi = args.ph_hi;
#define IN(k) (lo <= (k) && (k) < hi)
#define BOTH(k) (IN(k) && IN((k) + 1))

    float* const cosA = (float*)(ws + WS_ROPE); float* const sinA = cosA + (size_t)T * 64; float* const cosB = sinA + (size_t)T * 64; float* const sinB = cosB + (size_t)T * 32;
    bf16* const XB = (bf16*)(ws + WS_XB);

    gu32* const wmax = F.ctl + CW_WMAX;
    if (IN(0)) {
        for (int it = F.wave * F.G + F.vcu; it < DEPTH * 16 * 40; it += F.G * NWAVES) { const int layer = it / 640;
            p0_absmax_item(in_win + (size_t)layer * 2048 * 10240, it % 640, F.lane, wmax + layer * 10240); }
        if (BOTH(0)) GRID_BAR();
    }
    if (IN(1)) {
        LAS float* scr = (LAS float*)(F.lds + F.wave * 16384);
        const int gw = F.vcu * NWAVES + F.wave, NGW = F.G * NWAVES;
        constexpr int I_IN = (2048 / 64) * (10240 / 32), I_A = (1024 / 64) * (2048 / 32), I_O = (2048 / 64) * (2048 / 32);
        constexpr int PER_LAYER = I_IN + 2 * I_A + 2 * I_O;
        for (int it = gw; it < DEPTH * PER_LAYER; it += NGW) {
            const int layer = it / PER_LAYER; int r = it % PER_LAYER;
            unsigned char* wl = ws + WS_W + (size_t)layer * W_LAYER;
            if (r < I_IN) { p0_transpose_item_i8(in_win + (size_t)layer * 2048 * 10240, 2048, 10240, wl + WO_MAIN, scr, r, F.lane, wmax + layer * 10240); continue; } r -= I_IN;
            if (r < I_A) { p0_transpose_item<false>(in_wa + (size_t)layer * 1024 * 2048, 1024, 2048, (bf16*)(wl + WO_A), scr, r, F.lane, 2048, 0); continue; } r -= I_A;
            if (r < I_A) { p0_transpose_item<false>(in_wb + (size_t)layer * 1024 * 2048, 1024, 2048, (bf16*)(wl + WO_A), scr, r, F.lane, 2048, 1024); continue; } r -= I_A;
            if (r < I_O) { p0_transpose_item<false>(in_wo + (size_t)layer * 2048 * 2048, 2048, 2048, (bf16*)(wl + WO_O), scr, r, F.lane); continue; } r -= I_O;
            p0_transpose_item<false>(in_pwq + (size_t)layer * 2048 * 2048, 2048, 2048, (bf16*)(wl + WO_Q), scr, r, F.lane);
        }
        const size_t gtid = (size_t)F.vcu * 512 + F.tid, gthreads = (size_t)F.G * 512;
        for (int r = gw; r < 4 * NEXP; r += NGW) { const int tab = r >> 14, e = r & (NEXP - 1);
            const float* src = ((tab & 1) ? in_pv : in_pu) + ((size_t)(tab >> 1) * NEXP + e) * 2048;
            p0_table_row(src, ws + WS_TAB + (size_t)tab * TAB_BYTES + (size_t)e * 1024, (float*)(ws + WS_TSC) + r, F.lane); }
        p0_convert(in_sk, (bf16*)(ws + WS_SK), (size_t)DEPTH * 2 * 8 * 128 * 128 / 8, gtid, gthreads);
        for (int row = gw; row < T; row += NGW) p0_x_row(in_x + (size_t)row * 2048, XB + (size_t)row * 2048, ws + WS_XI8 + (size_t)row * 2048, (float*)(ws + WS_SX) + row, F.lane);
        for (size_t i = gtid; i < (size_t)DEPTH * 10240; i += gthreads) { const int layer = (int)(i / 10240), n = (int)(i % 10240);
            ((float*)(ws + WS_SW))[layer * 10240 + inproj_row(n)] = __builtin_bit_cast(float, wmax[layer * 10240 + n]) * (1.0f / 127.0f); }
        for (size_t i = gtid; i < (size_t)T * 64; i += gthreads) { const int t = (int)(i >> 6), k = (int)(i & 63);
            const float invf = powf(10000.0f, -(float)(2 * k) / 128.0f); const float ang = (float)in_pos[t] * invf;
            cosA[i] = cosf(ang); sinA[i] = sinf(ang); }
        for (size_t i = gtid; i < (size_t)T * 32; i += gthreads) { const int t = (int)(i >> 5), k = (int)(i & 31);
            const float invf = powf(10000.0f, -(float)(2 * k) / 64.0f); const float ang = (float)in_pos[t] * invf;
            cosB[i] = cosf(ang); sinB[i] = sinf(ang); }
        if (BOTH(1)) GRID_BAR();
    }

    for (int layer = 0; layer < DEPTH; ++layer) {
        const int pb = 2 + 8 * layer;
        unsigned char* const wl = ws + WS_W + (size_t)layer * W_LAYER;
        bf16* const ZB = (bf16*)dout;
        float* const kmean = (float*)(ws + WS_KMEAN) + (size_t)layer * NB * NH * 16 * 128;
        const float lambda_init = layer == 0 ? 0.2f : 0.3555090675909306f;
#define PHASE_TID() int llane_ = lane_id(); asm volatile("" : "+v"(llane_)); const int llane = llane_, ltid = llane_ + 64 * F.wave
        if (IN(pb)) {
            const bf16* const XI8 = (const bf16*)(ws + WS_XI8); const float* const sx = (const float*)(ws + WS_SX); const float* const sw = (const float*)(ws + WS_SW) + layer * 10240;
            { pg8::Gemm g{XI8, (const bf16*)(wl + WO_MAIN), T, NMAIN, 1024}; pg8::StaticOrder S; S.init(T, NMAIN, F.G, (int)blockIdx.x);
              pg8::EpiInProjI8 E{(bf16*)(ws + WS_QA), (bf16*)(ws + WS_KA), (bf16*)(ws + WS_QD), (bf16*)(ws + WS_KD), (bf16*)(ws + WS_GA), (bf16*)(ws + WS_GB), cosA, sinA, cosB, sinB, QSCALE_A, QSCALE_B, sx, sw};
              pg8::gemm_phase<pg8::EpiInProjI8, pg8::StaticOrder, MK_ALIGN, MK_SP2, false, true>(F.lds, g, S, E, F.wave); }
            { pg8::Gemm g{(const bf16*)(wl + WO_V), XI8, NV, T, 1024}; pg8::StaticOrder S; S.init(NV, T, F.G, (int)blockIdx.x);
              pg8::EpiPlainI8 E{(bf16*)(ws + WS_VT), T, sw + NMAIN, sx};
              pg8::gemm_phase<pg8::EpiPlainI8, pg8::StaticOrder, MK_ALIGN, MK_SP2, false, true>(F.lds, g, S, E, F.wave); }
            if (BOTH(pb)) GRID_BAR();
        }
        if (IN(pb + 1)) {
            PHASE_TID();
            LAS float* part = (LAS float*)F.lds;
            const bf16* KA = (const bf16*)(ws + WS_KA);
#pragma unroll 1
            for (int item = F.vcu; item < NB * NH * 16; item += F.G) {
                const int b = item >> 7, h = (item >> 4) & 7, blk = item & 15;
                const int c = ltid & 15, rg = ltid >> 4;
                const bf16* kp = KA + (size_t)(b * SEQ + blk * 256 + rg) * 1024 + h * 128 + c * 8;
                float sacc[8] = {0.f, 0.f, 0.f, 0.f, 0.f, 0.f, 0.f, 0.f};
#pragma unroll
                for (int i = 0; i < 8; ++i) { const v4u w = *(const GAS v4u*)(kp + (size_t)(32 * i) * 1024);
                    sacc[0] += bf_lo(w.x); sacc[1] += bf_hi(w.x); sacc[2] += bf_lo(w.y); sacc[3] += bf_hi(w.y); sacc[4] += bf_lo(w.z); sacc[5] += bf_hi(w.z); sacc[6] += bf_lo(w.w); sacc[7] += bf_hi(w.w); }
#pragma unroll
                for (int j = 0; j < 8; ++j) part[rg * 128 + c * 8 + j] = sacc[j];
                __syncthreads();
                if (ltid < 128) { float t = 0.f;
#pragma unroll
                    for (int r = 0; r < 32; ++r) t += part[r * 128 + ltid];
                    kmean[(size_t)item * 128 + ltid] = t; }
                __syncthreads();
            }
            if (BOTH(pb + 1)) GRID_BAR();
        }
        if (IN(pb + 2)) {
            PHASE_TID();
            const float* lp = in_dlam + (size_t)layer * 256;
            const float s1 = wave_sum(lp[llane] * lp[64 + llane]), s2 = wave_sum(lp[128 + llane] * lp[192 + llane]);
            float lam = __builtin_bit_cast(float, __builtin_amdgcn_readfirstlane(__builtin_bit_cast(int, expf(s1) - expf(s2) + lambda_init))), oml = __builtin_bit_cast(float, __builtin_amdgcn_readfirstlane(layer == 0 ? 0x3f4ccccd : 0x3f24fd5c));
            att::AttnArgs A{(const bf16*)(ws + WS_QA), (const bf16*)(ws + WS_KA), (const bf16*)(ws + WS_QD), (const bf16*)(ws + WS_KD), (const bf16*)(ws + WS_VT),
                            (bf16*)(ws + WS_OA), kmean, in_dgain + (size_t)layer * 1024, lam, oml};
            att::attn_phase(F.lds, A, F.vcu, F.G, ltid, F.wave, llane);
            if (BOTH(pb + 2)) GRID_BAR();
        }
        if (IN(pb + 3)) {
            { pg8::Gemm g{(const bf16*)(ws + WS_OA), (const bf16*)(wl + WO_A), T, 2048, 2048}; pg8::StaticOrder S; S.init(T, 2048, F.G, (int)blockIdx.x);
              pg8::EpiBranch E{(const bf16*)(ws + WS_GA), (const bf16*)(ws + WS_GB), (bf16*)(ws + WS_MERGED), 2048};
              pg8::gemm_phase<pg8::EpiBranch, pg8::StaticOrder, MK_ALIGN, MK_SP2, true>(F.lds, g, S, E, F.wave); }
            if (BOTH(pb + 3)) GRID_BAR();
        }
        if (IN(pb + 4)) {
            pg8::Gemm g{(const bf16*)(ws + WS_MERGED), (const bf16*)(wl + WO_O), T, 2048, 2048}; pg8::StaticOrder S; S.init(T, 2048, F.G, (int)blockIdx.x);
            pg8::EpiOutProj E{XB, ZB, 2048, ALPHA};
            pg8::gemm_phase<pg8::EpiOutProj, pg8::StaticOrder, MK_ALIGN, MK_SP2>(F.lds, g, S, E, F.wave);
            if (BOTH(pb + 4)) GRID_BAR();
        }
        if (IN(pb + 5)) {
            PHASE_TID();
            const int gw = F.vcu * NWAVES + F.wave, NGW = F.G * NWAVES;
            for (int m = gw; m < T; m += NGW) ln_row(ZB + (size_t)m * 2048, in_ln1g + (size_t)layer * 2048, in_ln1b + (size_t)layer * 2048, XB + (size_t)m * 2048, llane);
            if (BOTH(pb + 5)) GRID_BAR();
        }
        if (IN(pb + 6)) {
            pg8::Gemm g{XB, (const bf16*)(wl + WO_Q), T, 2048, 2048}; pg8::StaticOrder S; S.init(T, 2048, F.G, (int)blockIdx.x);
            pg8::EpiPlainBf16 E{(bf16*)(ws + WS_PQ), 2048};
            pg8::gemm_phase<pg8::EpiPlainBf16, pg8::StaticOrder, MK_ALIGN, MK_SP2>(F.lds, g, S, E, F.wave);
            if (BOTH(pb + 6)) GRID_BAR();
        }
        if (IN(pb + 7)) {
            const unsigned char* TU = ws + WS_TAB + (size_t)(2 * layer) * TAB_BYTES; const unsigned char* TV = ws + WS_TAB + (size_t)(2 * layer + 1) * TAB_BYTES;
            const float* SU = (const float*)(ws + WS_TSC) + (size_t)(2 * layer) * NEXP; const float* SV = SU + NEXP;
            const bf16* sk = (const bf16*)(ws + WS_SK) + (size_t)layer * 2 * 8 * 128 * 128;
            const bool last = (layer == DEPTH - 1);
            PHASE_TID();
            v4u* const pscr = (v4u*)(ws + WS_PSCR + (size_t)F.vcu * 32768);
#pragma unroll 1
            for (int ta = F.vcu; ta < T / 32; ta += 2 * F.G) {
                const int tb = ta + F.G; const bool pair = tb < T / 32, sw = pair && (F.vcu & 1);
                const int nst = sw ? 6 : (pair ? 4 : 2);
#pragma unroll 1
                for (int st = 0; st < nst; ++st) {
                    int op, tile;
                    if (sw) { op = (st == 0 || st == 2) ? 0 : (st == 1 ? 2 : (st == 4 ? 3 : 1)); tile = (st == 0 || st == 5) ? tb : ta; }
                    else { op = st & 1; tile = st < 2 ? ta : tb; }
                    const int t0 = tile * 32;
                    if (op == 0) peer::select_tile(F.lds, (const bf16*)(ws + WS_PQ), sk, t0, F.wave, llane);
                    else if (op == 1) {
                    v4u ring[16];
#pragma unroll
                    for (int s = 0; s < 16; ++s) ring[s] = (v4u){0u, 0u, 0u, 0u};
#pragma unroll 1
                    for (int i = 0; i < 4; ++i) { const int tl = F.wave * 4 + i; const size_t t = (size_t)(t0 + tl);
                        peer::token_ffn(F.lds, tl, XB + t * 2048, TU, TV, SU, SV, in_ln2g + (size_t)layer * 2048, in_ln2b + (size_t)layer * 2048, last ? dout + t * 2048 : (float*)nullptr, last ? (bf16*)nullptr : XB + t * 2048, ws + WS_XI8 + t * 2048, (float*)(ws + WS_SX) + t, llane, ring, i > 0, i < 3); }
                    } else if (op == 2) {
#pragma unroll
                        for (int q = 0; q < 4; ++q) pscr[ltid + 512 * q] = *(const LAS v4u*)(F.lds + (size_t)(ltid + 512 * q) * 16);
                    } else {
#pragma unroll
                        for (int q = 0; q < 4; ++q) *(LAS v4u*)(F.lds + (size_t)(ltid + 512 * q) * 16) = pscr[ltid + 512 * q];
                    }
                    __syncthreads();
                }
            }
            if (BOTH(pb + 7)) GRID_BAR();
        }
    }
#undef PHASE_TID
#undef IN
#undef BOTH
#undef GRID_BAR
}

#if MK_CHECK
__global__ void __launch_bounds__(NWAVES * 64, 2) chk_kernel(Params args, int layer, int which) {
    extern __shared__ __attribute__((aligned(16))) unsigned char lds_raw[];
    LAS unsigned char* lds = (LAS unsigned char*)lds_raw;
    const int tid = threadIdx.x, lane = tid & 63, wave = __builtin_amdgcn_readfirstlane(tid >> 6), G = gridDim.x, vcu = blockIdx.x;
    unsigned char* const ws = args.ws; gu32* ctl = (gu32*)(ws + WS_CTL);
    const bf16* xresb = (const bf16*)(ws + WS_XB);
    float* const kmean = (float*)(ws + WS_KMEAN) + (size_t)layer * NB * NH * 16 * 128;
    const float lambda_init = layer == 0 ? 0.2f : 0.3555090675909306f;
    const int gw = vcu * NWAVES + wave, NGW = G * NWAVES;
    if (which == 0) {
        const float* lp = args.in[6] + (size_t)layer * 256;
        const float s1 = wave_sum(lp[lane] * lp[64 + lane]), s2 = wave_sum(lp[128 + lane] * lp[192 + lane]);
        const float lam = expf(s1) - expf(s2) + lambda_init;
        att::AttnArgs A{(const bf16*)(ws + WS_QA), (const bf16*)(ws + WS_KA), (const bf16*)(ws + WS_QD), (const bf16*)(ws + WS_KD), (const bf16*)(ws + WS_VT),
                        (bf16*)(ws + WS_OA), kmean, args.in[7] + (size_t)layer * 1024, lam, 1.0f - lambda_init};
        chk::check_inproj(ctl, xresb, (const int*)args.in[1], args.in[2] + (size_t)layer * 2048 * 10240, A.qa, A.ka, A.qd, A.kd, A.vt, (const bf16*)(ws + WS_GA), (const bf16*)(ws + WS_GB), gw, NGW, lane);
        chk::check_kmean(ctl, A.ka, kmean, gw, NGW, lane);
        chk::check_attn(lds, ctl, A, vcu, G, tid, lane, wave);
    } else if (which == 3) {
        const float oscale = 1.0f + 0.04f * (float)__hip_atomic_load(ctl + chk::CW_ERR + 64, RLX_AGENT);
        for (size_t i = (size_t)vcu * 512 + tid; i < (size_t)T * 2048 / 4; i += (size_t)G * 512) { f32x4 v = *(GAS f32x4*)(args.out + i * 4); v = v * oscale; *(GAS f32x4*)(args.out + i * 4) = v; }
    } else if (which == 2) {
        if (vcu == 0 && tid == 0) { const float tol[6] = {1e-3f, 1e-4f, 3e-2f, 3e-3f, 1e-3f, 1e-3f}; unsigned code = 0;
            for (int st = 0; st < 6; ++st) { const float d2 = __builtin_bit_cast(float, __hip_atomic_load(ctl + chk::CW_ERR + 2 * st, RLX_AGENT)), r2 = __builtin_bit_cast(float, __hip_atomic_load(ctl + chk::CW_ERR + 2 * st + 1, RLX_AGENT));
                if (!(d2 <= tol[st] * r2) || !(r2 > 0.f)) code |= 1u << st; }
#ifdef MK_CHECK_STAGE
            { const float d2 = __builtin_bit_cast(float, __hip_atomic_load(ctl + chk::CW_ERR + 2 * MK_CHECK_STAGE, RLX_AGENT)), r2 = __builtin_bit_cast(float, __hip_atomic_load(ctl + chk::CW_ERR + 2 * MK_CHECK_STAGE + 1, RLX_AGENT));
              float ratio = d2 / r2; ratio = fminf(fmaxf(ratio, 1e-8f), 1e4f); code = (unsigned)(int)(4.0f * (log10f(ratio) + 8.0f) + 0.5f); }
#endif
            __hip_atomic_store(ctl + chk::CW_ERR + 64, code, RLX_AGENT); }
    } else {
        chk::check_merged(ctl, (const bf16*)(ws + WS_OA), (const bf16*)(ws + WS_GA), (const bf16*)(ws + WS_GB), (const bf16*)(ws + WS_MERGED), args.in[3] + (size_t)layer * 1024 * 2048, args.in[4] + (size_t)layer * 1024 * 2048, gw, NGW, lane);
        chk::check_z(ctl, (const bf16*)(ws + WS_MERGED), args.in[5] + (size_t)layer * 2048 * 2048, xresb, (const bf16*)args.out, gw, NGW, lane);
    }
}
#endif

extern "C" void kernel_launch(void* const* d_in, const int* in_sizes, int n_in, void* d_out, int out_size, void* d_ws, size_t ws_size, hipStream_t stream) {
    static int grid = 0;
    if (grid == 0) {
        if (n_in != 16 || out_size != T * DM || ws_size < WS_END) { fprintf(stderr, "kernel_launch: unexpected problem (n_in %d, out %d, ws %zu < %zu); nothing launched\n", n_in, out_size, ws_size, (size_t)WS_END); grid = -1; return; }
        int dev = 0, cus = 0, per_cu = 0;
        if (hipGetDevice(&dev) != hipSuccess || hipDeviceGetAttribute(&cus, hipDeviceAttributeMultiprocessorCount, dev) != hipSuccess) { fprintf(stderr, "kernel_launch: device query failed\n"); grid = -1; return; }
#if MK_CHECK
        (void)hipFuncSetAttribute((const void*)chk_kernel, hipFuncAttributeMaxDynamicSharedMemorySize, LDS_BYTES);
#endif
        if (hipFuncSetAttribute((const void*)mk_fwd, hipFuncAttributeMaxDynamicSharedMemorySize, LDS_BYTES) != hipSuccess) { fprintf(stderr, "kernel_launch: hipFuncSetAttribute failed\n"); grid = -1; return; }
        if (hipOccupancyMaxActiveBlocksPerMultiprocessor(&per_cu, (const void*)mk_fwd, NWAVES * 64, LDS_BYTES) != hipSuccess || per_cu < 1) { fprintf(stderr, "kernel_launch: occupancy query says %d blocks per CU; nothing launched\n", per_cu); (void)hipGetLastError(); grid = -1; return; }
        grid = cus;
    }
    if (grid < 0) return;
    (void)hipMemsetAsync((char*)d_ws + WS_CTL, 0, CTL_ZERO_BYTES, stream);
    Params a{};
    for (int i = 0; i < 16; ++i) a.in[i] = (const float*)d_in[i];
    a.out = (float*)d_out; a.ws = (unsigned char*)d_ws;
#if MK_FUSED
    a.ph_lo = 0; a.ph_hi = NPHASE;
    hipLaunchKernelGGL(mk_fwd, dim3(grid), dim3(NWAVES * 64), LDS_BYTES, stream, a);
#else
    for (int ph = 0; ph < NPHASE; ++ph) { a.ph_lo = ph; a.ph_hi = ph + 1; hipLaunchKernelGGL(mk_fwd, dim3(grid), dim3(NWAVES * 64), LDS_BYTES, stream, a);
#if MK_CHECK
        if (ph == 2 + 8 * MK_CHECK_LAYER + 2) hipLaunchKernelGGL(chk_kernel, dim3(grid), dim3(NWAVES * 64), LDS_BYTES, stream, a, (int)MK_CHECK_LAYER, 0);
        if (ph == 2 + 8 * MK_CHECK_LAYER + 4) hipLaunchKernelGGL(chk_kernel, dim3(grid), dim3(NWAVES * 64), LDS_BYTES, stream, a, (int)MK_CHECK_LAYER, 1);
        if (ph == NPHASE - 2) hipLaunchKernelGGL(chk_kernel, dim3(grid), dim3(NWAVES * 64), LDS_BYTES, stream, a, (int)MK_CHECK_LAYER, 2);
        if (ph == NPHASE - 1) hipLaunchKernelGGL(chk_kernel, dim3(grid), dim3(NWAVES * 64), LDS_BYTES, stream, a, (int)MK_CHECK_LAYER, 3);
#endif
    }
#endif
}
```

```cpp
#include <hip/hip_runtime.h>
#include <cstdio>
#include <cstdint>

#ifndef MK_FUSED
#define MK_FUSED 1
#endif
#ifndef MK_CHECK
#define MK_CHECK 0
#endif
#ifndef MK_CHECK_LAYER
#define MK_CHECK_LAYER 0
#endif

namespace cfg {
constexpr int DM = 2048, NB = 4, SEQ = 4096, T = NB * SEQ, DEPTH = 2;
constexpr int NH = 8, HD = 128, AW = NH * HD;
constexpr int INC = 10240;
constexpr int NMAIN = 8192, NV = 2048;
constexpr int PH = 8, PKEYS = 128, PTOP = 16, NEXP = PKEYS * PKEYS, PHALF = 128;
constexpr float LN_EPS = 1e-5f, RMS_EPS = 1e-6f;
constexpr float ALPHA = 1.4142135623730951f;
constexpr float LOG2E = 1.4426950408889634f;
constexpr float QSCALE_A = 0.08838834764831845f * LOG2E;
constexpr float QSCALE_B = 0.125f * LOG2E;
}
using namespace cfg;

constexpr size_t MiB = 1u << 20;
constexpr size_t WS_CTL = 0, CTL_ZERO_BYTES = 1 * MiB;
constexpr size_t WS_SK = 1 * MiB;
constexpr size_t WS_KMEAN = 2 * MiB;
constexpr size_t WS_TSC = 3 * MiB;
constexpr size_t WS_ROPE = 4 * MiB;
constexpr size_t WS_W = 20 * MiB, W_LAYER = 64 * MiB;
constexpr size_t WO_MAIN = 0, WO_V = 16 * MiB, WO_A = 40 * MiB, WO_O = 48 * MiB, WO_Q = 56 * MiB;
constexpr size_t WS_TAB = 148 * MiB, TAB_BYTES = 16 * MiB;
constexpr size_t WS_XI8 = 212 * MiB;
constexpr size_t WS_SX = 244 * MiB;
constexpr size_t WS_SW = 245 * MiB;
constexpr size_t WS_PSCR = 248 * MiB;
constexpr size_t WS_XB = 404 * MiB;
constexpr size_t WS_QA = 596 * MiB, WS_KA = 628 * MiB, WS_QD = 660 * MiB, WS_KD = 692 * MiB;
constexpr size_t WS_PQ = WS_QA;
constexpr size_t WS_VT = 724 * MiB;
constexpr size_t WS_MERGED = WS_VT;
constexpr size_t WS_GA = 788 * MiB, WS_GB = 852 * MiB;
constexpr size_t WS_OA = 916 * MiB;
constexpr size_t WS_END = 980 * MiB;

constexpr int CW_BAR = 4096;
constexpr int CW_WMAX = 16384;

constexpr int RING_BYTES = 131072;
constexpr int LDSCTL_OFF = RING_BYTES, MISC_OFF = LDSCTL_OFF + 320;
constexpr int LDS_BYTES = 147456;
constexpr int NWAVES = 8;

#define GAS __attribute__((address_space(1)))
#define LAS __attribute__((address_space(3)))
typedef unsigned short bf16;
typedef unsigned v4u __attribute__((ext_vector_type(4)));
typedef unsigned v2u __attribute__((ext_vector_type(2)));
typedef float f32x4 __attribute__((ext_vector_type(4)));
typedef float f32x16 __attribute__((ext_vector_type(16)));
typedef short bf16x8 __attribute__((ext_vector_type(8)));
typedef GAS unsigned gu32;
#define RLX_AGENT __ATOMIC_RELAXED, __HIP_MEMORY_SCOPE_AGENT
#define LDS_WAIT() asm volatile("s_waitcnt lgkmcnt(0)" ::: "memory")
#define VM_WAIT() asm volatile("s_waitcnt vmcnt(0)" ::: "memory")
__device__ __forceinline__ unsigned f2bf(float f) { unsigned u = __builtin_bit_cast(unsigned, f); return (u + 0x7fffu + ((u >> 16) & 1u)) >> 16; }
__device__ __forceinline__ unsigned pk2(float lo, float hi) { return f2bf(lo) | (f2bf(hi) << 16); }
__device__ __forceinline__ float bf_lo(unsigned w) { return __builtin_bit_cast(float, w << 16); }
__device__ __forceinline__ float bf_hi(unsigned w) { return __builtin_bit_cast(float, w & 0xffff0000u); }
__device__ __forceinline__ float fexp2(float x) { return __builtin_amdgcn_exp2f(x); }
__device__ __forceinline__ float frcp(float x) { return __builtin_amdgcn_rcpf(x); }
__device__ __forceinline__ int lane_id() { return (int)__builtin_amdgcn_mbcnt_hi(~0u, __builtin_amdgcn_mbcnt_lo(~0u, 0u)); }
__device__ __forceinline__ float wave_sum(float v) {
#pragma unroll
    for (int o = 1; o < 64; o <<= 1) v += __shfl_xor(v, o);
    return v;
}
namespace pg8 {
#define PG8_LAS __attribute__((address_space(3)))
typedef unsigned short bf16_t;
typedef short bf16x8 __attribute__((ext_vector_type(8)));
typedef float f32x4 __attribute__((ext_vector_type(4)));
typedef unsigned u32x4 __attribute__((ext_vector_type(4)));
typedef int i32x4 __attribute__((ext_vector_type(4)));
constexpr int BM = 256, BK = 64, HALF = 128, HTB = HALF * BK * 2  , STAGE_BYTES = 8 * HTB, NXCD = 8, WGM = 8;

__host__ __device__ __forceinline__ int lds_byte(int r, int c) { const int st = (r >> 4) * 2 + (c >> 5), rr = r & 15, cc = c & 31, ob = rr * 64 + cc * 2; return st * 1024 + (ob ^ (((ob >> 9) & 1) << 5)); }
__host__ __device__ __forceinline__ void stage_rc(int b, int& R, int& C) { const int st = b / 1024, sb = b % 1024, swz = sb ^ (((sb >> 9) & 1) << 5); R = (st >> 1) * 16 + swz / 64; C = (st & 1) * 32 + (swz % 64) / 2; }
__host__ __device__ __forceinline__ int perm32(int rho) { const int n = rho >> 4, i = rho & 15; return 8 * (i >> 2) + 4 * n + (i & 3); }

template <bool I8> struct AccSel { typedef f32x4 type; };
template <> struct AccSel<true> { typedef i32x4 type; };
template <bool I8> __device__ __forceinline__ typename AccSel<I8>::type mma16(const bf16x8& b, const bf16x8& a, const typename AccSel<I8>::type& c) {
    if constexpr (I8) return __builtin_amdgcn_mfma_i32_16x16x64_i8(__builtin_bit_cast(i32x4, b), __builtin_bit_cast(i32x4, a), c, 0, 0, 0);
    else return __builtin_amdgcn_mfma_f32_16x16x32_bf16(b, a, c, 0, 0, 0);
}
struct Unit { int pm, pn; };
struct Gemm { const bf16_t* A; const bf16_t* Bt; int M, N, K; };

struct StaticOrder {
    int nM, nN, nwg, G, c;
    __host__ __device__ void init(int M, int N, int G_, int c_) { nM = M / BM; nN = N / BM; nwg = nM * nN; G = G_; c = c_; }
    __host__ __device__ bool next(int i, Unit& u) const {
        const long L = (long)i * G + c; if (L >= nwg) return false;
        int wgid = (int)L; { const int q = nwg / NXCD, r = nwg % NXCD, xcd = wgid % NXCD, off = wgid / NXCD; wgid = (xcd < r ? xcd * (q + 1) : r * (q + 1) + (xcd - r) * q) + off; }
        const int nig = WGM * nN, gid = wgid / nig, fm = gid * WGM, gsz = (nM - fm) < WGM ? (nM - fm) : WGM;
        u.pm = fm + ((wgid % nig) % gsz); u.pn = (wgid % nig) / gsz; return true;
    }
    __device__ __forceinline__ void a_ready(const Unit&) const {}
    __device__ __forceinline__ void done(const Unit&) const {}
};

typedef float f32x2cv __attribute__((ext_vector_type(2))); typedef __bf16 bf16x2cv __attribute__((ext_vector_type(2)));
__device__ __forceinline__ unsigned cvt_pk_bf16(float lo, float hi) { f32x2cv v = {lo, hi}; bf16x2cv b = __builtin_convertvector(v, bf16x2cv); return __builtin_bit_cast(unsigned, b); }

typedef unsigned u32x2 __attribute__((ext_vector_type(2)));
struct EpiPlainBf16 {
    static constexpr bool PERM = true, AFTER_DRAIN = false;
    bf16_t* O; int ldc;
    __device__ __forceinline__ void operator()(const f32x4 (&acc)[2][2][4][2], const Unit& u, int wr, int wc, int fr_, int fq_) const {
        int fr = fr_, fq = fq_; asm volatile("" : "+v"(fr), "+v"(fq));
        const int row0 = u.pm * BM + wr * 64 + fr, col0 = u.pn * BM + wc * 32 + 8 * fq;
#pragma unroll
        for (int ai = 0; ai < 2; ++ai)
#pragma unroll
            for (int m = 0; m < 4; ++m) { bf16_t* rowp = O + (size_t)(row0 + ai * HALF + m * 16) * ldc + col0;
#pragma unroll
                for (int bj = 0; bj < 2; ++bj) { const f32x4 v0 = acc[ai][bj][m][0], v1 = acc[ai][bj][m][1];
                    u32x4 w; w.x = cvt_pk_bf16(v0[0], v0[1]); w.y = cvt_pk_bf16(v0[2], v0[3]); w.z = cvt_pk_bf16(v1[0], v1[1]); w.w = cvt_pk_bf16(v1[2], v1[3]);
                    *(u32x4*)(rowp + bj * HALF) = w; } }
    }
};
struct EpiBranch {
    static constexpr bool PERM = true, AFTER_DRAIN = false;
    const bf16_t* ga; const bf16_t* gb; bf16_t* O; int ldc;
    __device__ __forceinline__ void mid(f32x4 (&acc)[2][2][4][2], const Unit& u, int wr, int wc, int fr_, int fq_) const {
        int fr = fr_, fq = fq_; asm volatile("" : "+v"(fr), "+v"(fq));
        const int row0 = u.pm * BM + wr * 64 + fr, col0 = u.pn * BM + wc * 32 + 8 * fq;
#pragma unroll
        for (int ai = 0; ai < 2; ++ai)
#pragma unroll
            for (int m = 0; m < 4; ++m) { const size_t off = (size_t)(row0 + ai * HALF + m * 16) * ldc + col0;
#pragma unroll
                for (int bj = 0; bj < 2; ++bj) { const u32x2 a = *(const u32x2*)((const unsigned char*)ga + off + bj * HALF), b = *(const u32x2*)((const unsigned char*)gb + off + bj * HALF);
#define PG8_RATIO(x, y, k) ((float)(((x) >> (8 * (k))) & 255u) * __builtin_amdgcn_rcpf((float)(((y) >> (8 * (k))) & 255u)))
                    f32x4 r0, r1;
                    r0[0] = PG8_RATIO(a.x, b.x, 0); r0[1] = PG8_RATIO(a.x, b.x, 1); r0[2] = PG8_RATIO(a.x, b.x, 2); r0[3] = PG8_RATIO(a.x, b.x, 3);
                    r1[0] = PG8_RATIO(a.y, b.y, 0); r1[1] = PG8_RATIO(a.y, b.y, 1); r1[2] = PG8_RATIO(a.y, b.y, 2); r1[3] = PG8_RATIO(a.y, b.y, 3);
#undef PG8_RATIO
                    acc[ai][bj][m][0] = acc[ai][bj][m][0] * r0; acc[ai][bj][m][1] = acc[ai][bj][m][1] * r1; } }
    }
    __device__ __forceinline__ void operator()(const f32x4 (&acc)[2][2][4][2], const Unit& u, int wr, int wc, int fr_, int fq_) const {
        int fr = fr_, fq = fq_; asm volatile("" : "+v"(fr), "+v"(fq));
        const int row0 = u.pm * BM + wr * 64 + fr, col0 = u.pn * BM + wc * 32 + 8 * fq;
#pragma unroll
        for (int ai = 0; ai < 2; ++ai)
#pragma unroll
            for (int m = 0; m < 4; ++m) { const size_t off = (size_t)(row0 + ai * HALF + m * 16) * ldc + col0;
#pragma unroll
                for (int bj = 0; bj < 2; ++bj) { const u32x2 g = *(const u32x2*)((const unsigned char*)gb + off + bj * HALF);
                    const f32x4 v0 = acc[ai][bj][m][0], v1 = acc[ai][bj][m][1]; const float q = 1.0f / 255.0f;
                    f32x4 o0, o1;
                    o0[0] = v0[0] * ((float)(g.x & 255u) * q); o0[1] = v0[1] * ((float)((g.x >> 8) & 255u) * q); o0[2] = v0[2] * ((float)((g.x >> 16) & 255u) * q); o0[3] = v0[3] * ((float)(g.x >> 24) * q);
                    o1[0] = v1[0] * ((float)(g.y & 255u) * q); o1[1] = v1[1] * ((float)((g.y >> 8) & 255u) * q); o1[2] = v1[2] * ((float)((g.y >> 16) & 255u) * q); o1[3] = v1[3] * ((float)(g.y >> 24) * q);
                    u32x4 w; w.x = cvt_pk_bf16(o0[0], o0[1]); w.y = cvt_pk_bf16(o0[2], o0[3]); w.z = cvt_pk_bf16(o1[0], o1[1]); w.w = cvt_pk_bf16(o1[2], o1[3]);
                    *(u32x4*)(O + off + bj * HALF) = w; } }
    }
};
struct EpiOutProj {
    static constexpr bool PERM = true, AFTER_DRAIN = false;
    const bf16_t* xres; bf16_t* z; int ldc; float alpha;
    __device__ __forceinline__ void operator()(const f32x4 (&acc)[2][2][4][2], const Unit& u, int wr, int wc, int fr_, int fq_) const {
        int fr = fr_, fq = fq_; asm volatile("" : "+v"(fr), "+v"(fq));
        const int row0 = u.pm * BM + wr * 64 + fr, col0 = u.pn * BM + wc * 32 + 8 * fq;
#pragma unroll
        for (int ai = 0; ai < 2; ++ai)
#pragma unroll
            for (int m = 0; m < 4; ++m) { const size_t off = (size_t)(row0 + ai * HALF + m * 16) * ldc + col0;
#pragma unroll
                for (int bj = 0; bj < 2; ++bj) { const u32x4 x = *(const u32x4*)(xres + off + bj * HALF);
                    const f32x4 v0 = acc[ai][bj][m][0], v1 = acc[ai][bj][m][1];
                    f32x4 o0, o1;
                    o0[0] = v0[0] + alpha * __builtin_bit_cast(float, x.x << 16); o0[1] = v0[1] + alpha * __builtin_bit_cast(float, x.x & 0xffff0000u);
                    o0[2] = v0[2] + alpha * __builtin_bit_cast(float, x.y << 16); o0[3] = v0[3] + alpha * __builtin_bit_cast(float, x.y & 0xffff0000u);
                    o1[0] = v1[0] + alpha * __builtin_bit_cast(float, x.z << 16); o1[1] = v1[1] + alpha * __builtin_bit_cast(float, x.z & 0xffff0000u);
                    o1[2] = v1[2] + alpha * __builtin_bit_cast(float, x.w << 16); o1[3] = v1[3] + alpha * __builtin_bit_cast(float, x.w & 0xffff0000u);
                    u32x4 w; w.x = cvt_pk_bf16(o0[0], o0[1]); w.y = cvt_pk_bf16(o0[2], o0[3]); w.z = cvt_pk_bf16(o1[0], o1[1]); w.w = cvt_pk_bf16(o1[2], o1[3]);
                    *(u32x4*)(z + off + bj * HALF) = w; } }
    }
};
struct EpiInProj {
    static constexpr bool PERM = false, AFTER_DRAIN = false;
    bf16_t *qa, *ka, *qd, *kd, *ga, *gb; const float *cosA, *sinA, *cosB, *sinB; float qsa, qsb;
    __device__ __forceinline__ void operator()(const f32x4 (&acc)[2][2][4][2], const Unit& u, int wr, int wc, int fr_, int fq_) const {
        int fr = fr_, fq = fq_; asm volatile("" : "+v"(fr), "+v"(fq));
        const int row0 = u.pm * BM + wr * 64 + fr;
        const int ty = u.pn >> 2;
        if (ty >= 4) {
            unsigned char* dst = (unsigned char*)(ty < 6 ? ga : gb); const int col0 = (u.pn - (ty < 6 ? 16 : 24)) * BM + wc * 32 + 4 * fq; const float lo = ty < 6 ? 0.0f : 1.0f;
#pragma unroll
            for (int ai = 0; ai < 2; ++ai)
#pragma unroll
                for (int m = 0; m < 4; ++m) { unsigned char* rowp = dst + (size_t)(row0 + ai * HALF + m * 16) * 2048 + col0;
#pragma unroll
                    for (int bj = 0; bj < 2; ++bj)
#pragma unroll
                        for (int n = 0; n < 2; ++n) { const f32x4 v = acc[ai][bj][m][n]; unsigned w = 0u;
#pragma unroll
                            for (int j = 0; j < 4; ++j) { const float s = __builtin_amdgcn_rcpf(1.0f + __builtin_amdgcn_exp2f(-1.4426950408889634f * v[j]));
                                w |= (unsigned)fmaxf(s * 255.0f + 0.5f, lo) << (8 * j); }
                            *(unsigned*)(rowp + bj * HALF + n * 16) = w; } }
        } else if (ty < 2) {
            bf16_t* dst = ty == 0 ? qa : ka; const float sc = ty == 0 ? qsa : 1.0f;
            const int i0 = 16 * wc + 4 * fq;
#pragma unroll
            for (int ai = 0; ai < 2; ++ai)
#pragma unroll
                for (int m = 0; m < 4; ++m) { const int row = row0 + ai * HALF + m * 16;
                    const f32x4 c = *(const f32x4*)(cosA + (size_t)row * 64 + i0), s = *(const f32x4*)(sinA + (size_t)row * 64 + i0);
#pragma unroll
                    for (int bj = 0; bj < 2; ++bj) { const int head = 2 * (u.pn & 3) + bj; const f32x4 t1 = acc[ai][bj][m][0], t2 = acc[ai][bj][m][1];
                        const f32x4 o1 = t1 * c - t2 * s, o2 = t1 * s + t2 * c;
                        bf16_t* p = dst + (size_t)row * 1024 + head * 128 + i0;
                        u32x2 w1, w2; w1.x = cvt_pk_bf16(o1[0] * sc, o1[1] * sc); w1.y = cvt_pk_bf16(o1[2] * sc, o1[3] * sc); w2.x = cvt_pk_bf16(o2[0] * sc, o2[1] * sc); w2.y = cvt_pk_bf16(o2[2] * sc, o2[3] * sc);
                        *(u32x2*)p = w1; *(u32x2*)(p + 64) = w2;
                    } }
        } else {
            bf16_t* dst = ty == 2 ? qd : kd; const float sc = ty == 2 ? qsb : 1.0f;
            const int comp = wc >> 1, i0 = 16 * (wc & 1) + 4 * fq;
#pragma unroll
            for (int ai = 0; ai < 2; ++ai)
#pragma unroll
                for (int m = 0; m < 4; ++m) { const int row = row0 + ai * HALF + m * 16;
                    const f32x4 c = *(const f32x4*)(cosB + (size_t)row * 32 + i0), s = *(const f32x4*)(sinB + (size_t)row * 32 + i0);
#pragma unroll
                    for (int bj = 0; bj < 2; ++bj) { const int head = 2 * (u.pn & 3) + bj; const f32x4 t1 = acc[ai][bj][m][0], t2 = acc[ai][bj][m][1];
                        const f32x4 o1 = (t1 * c - t2 * s) * sc, o2 = (t1 * s + t2 * c) * sc;
                        bf16_t* p = dst + (size_t)row * 1024 + head * 128 + comp * 64 + i0;
                        u32x2 w1, w2; w1.x = cvt_pk_bf16(o1[0], o1[1]); w1.y = cvt_pk_bf16(o1[2], o1[3]); w2.x = cvt_pk_bf16(o2[0], o2[1]); w2.y = cvt_pk_bf16(o2[2], o2[3]);
                        *(u32x2*)p = w1; *(u32x2*)(p + 32) = w2;
                    } }
        }
    }
};

__device__ __forceinline__ f32x4 deq4(const i32x4& a, const f32x4& s) { return (f32x4){(float)a[0], (float)a[1], (float)a[2], (float)a[3]} * s; }
struct EpiPlainI8 {
    static constexpr bool PERM = true, AFTER_DRAIN = false;
    bf16_t* O; int ldc; const float* srow; const float* scol;
    __device__ __forceinline__ void operator()(const i32x4 (&acc)[2][2][4][2], const Unit& u, int wr, int wc, int fr_, int fq_) const {
        int fr = fr_, fq = fq_; asm volatile("" : "+v"(fr), "+v"(fq));
        const int row0 = u.pm * BM + wr * 64 + fr, col0 = u.pn * BM + wc * 32 + 8 * fq;
        f32x4 cs[2][2];
#pragma unroll
        for (int bj = 0; bj < 2; ++bj)
#pragma unroll
            for (int n = 0; n < 2; ++n) cs[bj][n] = *(const f32x4*)(scol + col0 + bj * HALF + 4 * n);
#pragma unroll
        for (int ai = 0; ai < 2; ++ai)
#pragma unroll
            for (int m = 0; m < 4; ++m) { const int row = row0 + ai * HALF + m * 16; const float sr = srow[row]; bf16_t* rowp = O + (size_t)row * ldc + col0;
#pragma unroll
                for (int bj = 0; bj < 2; ++bj) { const f32x4 v0 = deq4(acc[ai][bj][m][0], cs[bj][0] * sr), v1 = deq4(acc[ai][bj][m][1], cs[bj][1] * sr);
                    u32x4 w; w.x = cvt_pk_bf16(v0[0], v0[1]); w.y = cvt_pk_bf16(v0[2], v0[3]); w.z = cvt_pk_bf16(v1[0], v1[1]); w.w = cvt_pk_bf16(v1[2], v1[3]);
                    *(u32x4*)(rowp + bj * HALF) = w; } }
    }
};
struct EpiInProjI8 {
    static constexpr bool PERM = false, AFTER_DRAIN = false;
    bf16_t *qa, *ka, *qd, *kd, *ga, *gb; const float *cosA, *sinA, *cosB, *sinB; float qsa, qsb; const float *sx, *sw;
    __device__ __forceinline__ void operator()(const i32x4 (&acc)[2][2][4][2], const Unit& u, int wr, int wc, int fr_, int fq_) const {
        int fr = fr_, fq = fq_; asm volatile("" : "+v"(fr), "+v"(fq));
        const int row0 = u.pm * BM + wr * 64 + fr;
        const int ty = u.pn >> 2;
        f32x4 cs[2][2];
#pragma unroll
        for (int bj = 0; bj < 2; ++bj)
#pragma unroll
            for (int n = 0; n < 2; ++n) cs[bj][n] = *(const f32x4*)(sw + u.pn * BM + bj * HALF + wc * 32 + n * 16 + 4 * fq);
        if (ty >= 4) {
            unsigned char* dst = (unsigned char*)(ty < 6 ? ga : gb); const int col0 = (u.pn - (ty < 6 ? 16 : 24)) * BM + wc * 32 + 4 * fq; const float lo = ty < 6 ? 0.0f : 1.0f;
#pragma unroll
            for (int ai = 0; ai < 2; ++ai)
#pragma unroll
                for (int m = 0; m < 4; ++m) { const int row = row0 + ai * HALF + m * 16; const float sr = sx[row] * -1.4426950408889634f; unsigned char* rowp = dst + (size_t)row * 2048 + col0;
#pragma unroll
                    for (int bj = 0; bj < 2; ++bj)
#pragma unroll
                        for (int n = 0; n < 2; ++n) { const f32x4 v = deq4(acc[ai][bj][m][n], cs[bj][n] * sr); unsigned w = 0u;
#pragma unroll
                            for (int j = 0; j < 4; ++j) { const float s = __builtin_amdgcn_rcpf(1.0f + __builtin_amdgcn_exp2f(v[j]));
                                w |= (unsigned)fmaxf(s * 255.0f + 0.5f, lo) << (8 * j); }
                            *(unsigned*)(rowp + bj * HALF + n * 16) = w; } }
        } else if (ty < 2) {
            bf16_t* dst = ty == 0 ? qa : ka; const float sc = ty == 0 ? qsa : 1.0f;
            const int i0 = 16 * wc + 4 * fq;
#pragma unroll
            for (int ai = 0; ai < 2; ++ai)
#pragma unroll
                for (int m = 0; m < 4; ++m) { const int row = row0 + ai * HALF + m * 16; const float sr = sx[row] * sc;
                    const f32x4 c = *(const f32x4*)(cosA + (size_t)row * 64 + i0), s = *(const f32x4*)(sinA + (size_t)row * 64 + i0);
#pragma unroll
                    for (int bj = 0; bj < 2; ++bj) { const int head = 2 * (u.pn & 3) + bj; const f32x4 t1 = deq4(acc[ai][bj][m][0], cs[bj][0] * sr), t2 = deq4(acc[ai][bj][m][1], cs[bj][1] * sr);
                        const f32x4 o1 = t1 * c - t2 * s, o2 = t1 * s + t2 * c;
                        bf16_t* p = dst + (size_t)row * 1024 + head * 128 + i0;
                        u32x2 w1, w2; w1.x = cvt_pk_bf16(o1[0], o1[1]); w1.y = cvt_pk_bf16(o1[2], o1[3]); w2.x = cvt_pk_bf16(o2[0], o2[1]); w2.y = cvt_pk_bf16(o2[2], o2[3]);
                        *(u32x2*)p = w1; *(u32x2*)(p + 64) = w2;
                    } }
        } else {
            bf16_t* dst = ty == 2 ? qd : kd; const float sc = ty == 2 ? qsb : 1.0f;
            const int comp = wc >> 1, i0 = 16 * (wc & 1) + 4 * fq;
#pragma unroll
            for (int ai = 0; ai < 2; ++ai)
#pragma unroll
                for (int m = 0; m < 4; ++m) { const int row = row0 + ai * HALF + m * 16; const float sr = sx[row] * sc;
                    const f32x4 c = *(const f32x4*)(cosB + (size_t)row * 32 + i0), s = *(const f32x4*)(sinB + (size_t)row * 32 + i0);
#pragma unroll
                    for (int bj = 0; bj < 2; ++bj) { const int head = 2 * (u.pn & 3) + bj; const f32x4 t1 = deq4(acc[ai][bj][m][0], cs[bj][0] * sr), t2 = deq4(acc[ai][bj][m][1], cs[bj][1] * sr);
                        const f32x4 o1 = t1 * c - t2 * s, o2 = t1 * s + t2 * c;
                        bf16_t* p = dst + (size_t)row * 1024 + head * 128 + comp * 64 + i0;
                        u32x2 w1, w2; w1.x = cvt_pk_bf16(o1[0], o1[1]); w1.y = cvt_pk_bf16(o1[2], o1[3]); w2.x = cvt_pk_bf16(o2[0], o2[1]); w2.y = cvt_pk_bf16(o2[2], o2[3]);
                        *(u32x2*)p = w1; *(u32x2*)(p + 32) = w2;
                    } }
        }
    }
};
template <class Epi, class Sched, bool ALIGN_EPI = false, bool SP2 = false, bool MID = false, bool I8 = false>
__device__ __forceinline__ void gemm_phase(PG8_LAS unsigned char* lds, const Gemm g, const Sched& S, const Epi& E, int wave) {
    int tid_ = lane_id(); asm volatile("" : "+v"(tid_)); tid_ += 64 * wave;
    const int tid = tid_, wid = __builtin_amdgcn_readfirstlane(tid >> 6), lane = tid & 63, wr = wid >> 2, wc = wid & 3, fr = lane & 15, fq = lane >> 4;
    const int K = g.K, nt = K / BK;
    unsigned voffA[2], voffB[2];
#pragma unroll
    for (int i = 0; i < 2; ++i) { int R, C; stage_rc(tid * 16 + i * 8192, R, C); const int Rb = Epi::PERM ? ((R & ~31) + perm32(R & 31)) : R;
        voffA[i] = (unsigned)(R * K + C) * 2u; voffB[i] = (unsigned)(Rb * K + C) * 2u; }
    const size_t kstep = (size_t)(BK * 2);
    const size_t hstep = (size_t)HALF * K * 2;
    const size_t tstep = 2 * hstep;
    const unsigned ldsw = (unsigned)wid * 1024u;
    const int aoff = lds_byte(wr * 64 + fr, fq * 8), boff = lds_byte(wc * 32 + fr, fq * 8);
#define PG8_SA(b, h) (((b) * 2 + (h)) * HTB)
#define PG8_SB(b, h) ((4 + (b) * 2 + (h)) * HTB)
#define PG8_STAGE(bufoff, gbase, voff) do { _Pragma("unroll") for (int _i = 0; _i < 2; ++_i) \
        __builtin_amdgcn_global_load_lds((const unsigned*)((const char*)(gbase) + (voff)[_i]), (PG8_LAS unsigned*)(lds + (bufoff) + ldsw + _i * 8192), 16, 0, 0); } while (0)
#define PG8_LDA(dst, b, h) do { _Pragma("unroll") for (int m = 0; m < 4; ++m) _Pragma("unroll") for (int k = 0; k < 2; ++k) dst[m][k] = *(const PG8_LAS bf16x8*)(lds + PG8_SA(b, h) + aoff + m * 2048 + k * 1024); } while (0)
#define PG8_LDB(dst, b, h) do { _Pragma("unroll") for (int n = 0; n < 2; ++n) _Pragma("unroll") for (int k = 0; k < 2; ++k) dst[n][k] = *(const PG8_LAS bf16x8*)(lds + PG8_SB(b, h) + boff + n * 2048 + k * 1024); } while (0)
#define PG8_MMA(ai, bj, At, Bt) do { __builtin_amdgcn_s_setprio(1); _Pragma("unroll") for (int m = 0; m < 4; ++m) _Pragma("unroll") for (int n = 0; n < 2; ++n) _Pragma("unroll") for (int k = 0; k < 2; ++k) \
        acc[ai][bj][m][n] = mma16<I8>(Bt[n][k], At[m][k], acc[ai][bj][m][n]); __builtin_amdgcn_s_setprio(0); } while (0)
#define PG8_WAIT_V(n) asm volatile("s_waitcnt vmcnt(" #n ")" ::: "memory")
#define PG8_WAIT_L(n) asm volatile("s_waitcnt lgkmcnt(" #n ")" ::: "memory")
#define PG8_BAR __builtin_amdgcn_s_barrier()
#define PG8_SCHED __builtin_amdgcn_sched_barrier(0)
    Unit cur, nxt; int ui = 0;
    if (!S.next(0, cur)) return;
    typedef typename AccSel<I8>::type acc_t;
    acc_t acc[2][2][4][2];
#pragma unroll
    for (int a = 0; a < 2; ++a)
#pragma unroll
        for (int b = 0; b < 2; ++b)
#pragma unroll
            for (int m = 0; m < 4; ++m)
#pragma unroll
                for (int n = 0; n < 2; ++n) acc[a][b][m][n] = (acc_t){0, 0, 0, 0};
    bf16x8 At[4][2], B0[2][2], B1[2][2];
    const char* cA = (const char*)g.A + (size_t)cur.pm * tstep; const char* cB = (const char*)g.Bt + (size_t)cur.pn * tstep;
    S.a_ready(cur);
    if constexpr (SP2) {
        PG8_STAGE(PG8_SB(0, 0), cB, voffB); PG8_STAGE(PG8_SB(0, 1), cB + hstep, voffB); PG8_STAGE(PG8_SA(0, 0), cA, voffA); PG8_STAGE(PG8_SA(0, 1), cA + hstep, voffA);
        if (wr == 1) PG8_BAR;
        PG8_WAIT_V(2); PG8_BAR;
        PG8_STAGE(PG8_SB(1, 0), cB + kstep, voffB); PG8_STAGE(PG8_SA(1, 0), cA + kstep, voffA); PG8_STAGE(PG8_SB(1, 1), cB + hstep + kstep, voffB);
        PG8_WAIT_V(6); PG8_BAR;
    } else {
        PG8_STAGE(PG8_SB(0, 0), cB, voffB); PG8_STAGE(PG8_SA(0, 0), cA, voffA); PG8_STAGE(PG8_SB(0, 1), cB + hstep, voffB); PG8_STAGE(PG8_SA(0, 1), cA + hstep, voffA);
        if (wr == 1) PG8_BAR;
        PG8_WAIT_V(4); PG8_BAR;
        PG8_STAGE(PG8_SB(1, 0), cB + kstep, voffB); PG8_STAGE(PG8_SA(1, 0), cA + kstep, voffA); PG8_STAGE(PG8_SB(1, 1), cB + hstep + kstep, voffB);
        PG8_WAIT_V(6); PG8_BAR;
    }
    for (;;) {
        const bool has_next = S.next(ui + 1, nxt);
        const char* nA = has_next ? (const char*)g.A + (size_t)nxt.pm * tstep : cA; const char* nB = has_next ? (const char*)g.Bt + (size_t)nxt.pn * tstep : cB;
        for (int t = 0; t < nt; t += 2) {
            if constexpr (MID) { if (t == nt / 2) E.mid(acc, cur, wr, wc, fr, fq); }
            const bool last = (t == nt - 2);
            const char* a1 = cA + (size_t)(t + 1) * kstep;
            const char* a2 = last ? nA : cA + (size_t)(t + 2) * kstep; const char* b2 = last ? nB : cB + (size_t)(t + 2) * kstep;
            const char* a3 = a2 + kstep; const char* b3 = b2 + kstep;
            if (last && has_next) S.a_ready(nxt);
            if constexpr (SP2) {
            PG8_LDB(B0, 0, 0); PG8_LDB(B1, 0, 1); PG8_SCHED; PG8_LDA(At, 0, 0); PG8_STAGE(PG8_SA(1, 1), a1 + hstep, voffA);
            PG8_WAIT_V(8); PG8_WAIT_L(0); PG8_BAR; PG8_MMA(0, 0, At, B0); PG8_MMA(0, 1, At, B1); PG8_BAR; PG8_SCHED;
            PG8_LDA(At, 0, 1); PG8_STAGE(PG8_SB(0, 0), b2, voffB); PG8_STAGE(PG8_SB(0, 1), b2 + hstep, voffB); PG8_STAGE(PG8_SA(0, 0), a2, voffA);
            PG8_WAIT_V(8); PG8_WAIT_L(0); PG8_BAR; PG8_MMA(1, 0, At, B0); PG8_MMA(1, 1, At, B1); PG8_BAR; PG8_SCHED;
            PG8_LDB(B0, 1, 0); PG8_LDB(B1, 1, 1); PG8_SCHED; PG8_LDA(At, 1, 0); PG8_STAGE(PG8_SA(0, 1), a2 + hstep, voffA);
            PG8_WAIT_V(8); PG8_WAIT_L(0); PG8_BAR; PG8_MMA(0, 0, At, B0); PG8_MMA(0, 1, At, B1); PG8_BAR; PG8_SCHED;
            PG8_LDA(At, 1, 1); PG8_STAGE(PG8_SB(1, 0), b3, voffB); PG8_STAGE(PG8_SB(1, 1), b3 + hstep, voffB); PG8_STAGE(PG8_SA(1, 0), a3, voffA);
            PG8_WAIT_V(8); PG8_WAIT_L(0); PG8_BAR; PG8_MMA(1, 0, At, B0); PG8_MMA(1, 1, At, B1); PG8_BAR; PG8_SCHED;
            } else {
            PG8_LDB(B0, 0, 0); PG8_SCHED; PG8_LDA(At, 0, 0); PG8_STAGE(PG8_SA(1, 1), a1 + hstep, voffA);
            PG8_WAIT_L(8); PG8_BAR; PG8_WAIT_L(0); PG8_MMA(0, 0, At, B0); PG8_BAR; PG8_SCHED;
            PG8_LDB(B1, 0, 1); PG8_STAGE(PG8_SB(0, 0), b2, voffB);
            PG8_BAR; PG8_WAIT_L(0); PG8_MMA(0, 1, At, B1); PG8_BAR;
            PG8_LDA(At, 0, 1); PG8_STAGE(PG8_SA(0, 0), a2, voffA);
            PG8_BAR; PG8_WAIT_L(0); PG8_MMA(1, 0, At, B0); PG8_BAR; PG8_SCHED;
            PG8_STAGE(PG8_SB(0, 1), b2 + hstep, voffB);
            PG8_WAIT_V(6); PG8_BAR; PG8_MMA(1, 1, At, B1); PG8_BAR;
            PG8_LDB(B0, 1, 0); PG8_SCHED; PG8_LDA(At, 1, 0); PG8_STAGE(PG8_SA(0, 1), a2 + hstep, voffA);
            PG8_WAIT_L(8); PG8_BAR; PG8_WAIT_L(0); PG8_MMA(0, 0, At, B0); PG8_BAR; PG8_SCHED;
            PG8_LDB(B1, 1, 1); PG8_STAGE(PG8_SB(1, 0), b3, voffB);
            PG8_BAR; PG8_WAIT_L(0); PG8_MMA(0, 1, At, B1); PG8_BAR;
            PG8_LDA(At, 1, 1); PG8_STAGE(PG8_SA(1, 0), a3, voffA);
            PG8_BAR; PG8_WAIT_L(0); PG8_MMA(1, 0, At, B0); PG8_BAR; PG8_SCHED;
            PG8_STAGE(PG8_SB(1, 1), b3 + hstep, voffB);
            PG8_WAIT_V(6); PG8_BAR; PG8_MMA(1, 1, At, B1); PG8_BAR;
            }
        }
        if constexpr (ALIGN_EPI) { if (wr == 0) PG8_BAR; }
        if constexpr (!Epi::AFTER_DRAIN) { E(acc, cur, wr, wc, fr, fq); S.done(cur); }
        if (!has_next) break;
#pragma unroll
        for (int a = 0; a < 2; ++a)
#pragma unroll
            for (int b = 0; b < 2; ++b)
#pragma unroll
                for (int m = 0; m < 4; ++m)
#pragma unroll
                    for (int n = 0; n < 2; ++n) acc[a][b][m][n] = (acc_t){0, 0, 0, 0};
        cur = nxt; cA = nA; cB = nB; ++ui;
        if constexpr (ALIGN_EPI) { if (wr == 1) PG8_BAR; }
    }
    PG8_WAIT_V(0);
    if constexpr (!ALIGN_EPI) { if (wr == 0) PG8_BAR; }
    PG8_BAR;
    if constexpr (Epi::AFTER_DRAIN) { E.fused(acc, cur, wr, wc, fr, fq, lds, wid, lane); S.done(cur); }
#undef PG8_SA
#undef PG8_SB
#undef PG8_STAGE
#undef PG8_LDA
#undef PG8_LDB
#undef PG8_MMA
#undef PG8_WAIT_V
#undef PG8_WAIT_L
#undef PG8_BAR
#undef PG8_SCHED
}
}
#define XB_TMO      128
#define XB_XCNT(j)  (256  + 64 * (j))
#define XB_XSUB(j)  (1280 + 64 * (j))
#define XB_XGEN(j)  (2304 + 64 * (j))
#define XB_TOP      3328
#define XB_TOPGEN   3392
#define XCD_BAR_WORDS 3456
#define XB_SPIN_CAP (1u << 18)

__device__ __forceinline__ unsigned xb_ld(unsigned* p)              { return __hip_atomic_load(p, __ATOMIC_RELAXED, __HIP_MEMORY_SCOPE_AGENT); }
__device__ __forceinline__ unsigned xb_add(unsigned* p, unsigned v) { return __hip_atomic_fetch_add(p, v, __ATOMIC_RELAXED, __HIP_MEMORY_SCOPE_AGENT); }
__device__ __forceinline__ unsigned xb_xcc_id() { return (unsigned)__builtin_amdgcn_s_getreg((3 << 11) | 20) & 0xFu; }
#define XB_SPIN(cond, bar) do { unsigned _sp = 0; while (cond) { __builtin_amdgcn_s_sleep(1); \
    if ((++_sp & 255u) == 0u) { if (xb_ld(&(bar)[XB_TMO])) break; if (_sp > XB_SPIN_CAP) { atomicAdd(&(bar)[XB_TMO], 1u); break; } } } } while (0)

struct XcdBarrier {
    unsigned* bar; unsigned x; unsigned wv;
    volatile LAS unsigned* st;
};

__device__ __forceinline__ XcdBarrier xcd_barrier_post(unsigned* bar, volatile LAS unsigned* st, unsigned wave) {
    XcdBarrier b; b.bar = bar; b.x = xb_xcc_id(); b.st = st; b.wv = wave;
    if (threadIdx.x == 0) (void)xb_add(&bar[XB_XCNT(b.x)], 1u);
    return b;
}
__device__ __forceinline__ void xcd_barrier_complete(unsigned* bar, unsigned x, unsigned& nloc, unsigned& nx) {
    const unsigned G = gridDim.x * gridDim.y * gridDim.z;
    unsigned sum, cnt, mine, sp = 0u;
    for (;;) {
        sum = 0u; cnt = 0u; mine = 0u;
#pragma unroll 1
        for (unsigned j = 0; j < 16; ++j) { const unsigned c = xb_ld(&bar[XB_XCNT(j)]); sum += c; cnt += (c > 0u) ? 1u : 0u; mine = (j == x) ? c : mine; }
        if (sum == G) break;
        __builtin_amdgcn_s_sleep(1);
        if ((++sp & 255u) == 0u) { if (xb_ld(&bar[XB_TMO])) break; if (sp > XB_SPIN_CAP) { atomicAdd(&bar[XB_TMO], 1u); break; } }
    }
    nloc = mine > 0u ? mine : 1u; nx = cnt > 0u ? cnt : 1u;
}

__device__ __forceinline__ void xcd_barrier(const XcdBarrier& b) {
    asm volatile("s_waitcnt vmcnt(0)" ::: "memory");
    __syncthreads();
    if (b.wv == 0u && lane_id() == 0) {
        unsigned* bar = b.bar;
        __builtin_amdgcn_s_waitcnt(0);
        unsigned nloc = b.st[0], nx = b.st[1];
        if (nloc == 0u) { xcd_barrier_complete(bar, b.x, nloc, nx); b.st[0] = nloc; b.st[1] = nx; }
        const unsigned old = xb_add(&bar[XB_XSUB(b.x)], 1u);
        const unsigned gen = old / nloc;
        if (old + 1u == (gen + 1u) * nloc) {
            __builtin_amdgcn_fence(__ATOMIC_RELEASE, "agent");
            asm volatile("s_waitcnt vmcnt(0)" ::: "memory");
            const unsigned og = xb_add(&bar[XB_TOP], 1u);
            const unsigned tg = og / nx;
            if (og + 1u == (tg + 1u) * nx) xb_add(&bar[XB_TOPGEN], 1u);
            else XB_SPIN(xb_ld(&bar[XB_TOPGEN]) == tg, bar);
            __builtin_amdgcn_fence(__ATOMIC_ACQUIRE, "agent");
            xb_add(&bar[XB_XGEN(b.x)], 1u);
            asm volatile("s_waitcnt vmcnt(0)" ::: "memory");
        } else {
            XB_SPIN(xb_ld(&bar[XB_XGEN(b.x)]) == gen, bar);
            __builtin_amdgcn_fence(__ATOMIC_ACQUIRE, "agent");
            asm volatile("s_waitcnt vmcnt(0)" ::: "memory");
        }
    }
    __syncthreads();
}


struct Frame {
    LAS unsigned char* lds;
    volatile LAS unsigned* MISC;
    gu32* ctl;
    int tid, lane, wave;
    int vcu, G;
    unsigned char* ws;
};

__device__ __forceinline__ int inproj_row(int n) {
    const int seg = n >> 10, r = n & 1023;
    if (seg >= 6) return (seg < 8 ? 4096 : 6144) + (n - (seg < 8 ? 6144 : 8192));
    if (seg == 2) return 8192 + r;
    if (seg == 5) return 8192 + 1024 + r;
    const int head = r >> 7, d = r & 127;
    if (seg < 2) return seg * 1024 + head * 128 + 32 * ((d >> 4) & 3) + 16 * (d >> 6) + (d & 15);
    return (seg - 1) * 1024 + head * 128 + 32 * (2 * (d >> 6) + ((d >> 4) & 1)) + 16 * ((d >> 5) & 1) + (d & 15);
}
template <bool MAP>
__device__ __forceinline__ void p0_transpose_item(const float* W, int K, int N, bf16* WT, LAS float* scr, int item, int lane, int ldk = 0, int koff = 0) {
    if (ldk == 0) ldk = K;
    const int nblk = N / 32, kb = item / nblk, nb = item % nblk, k0 = 64 * kb, n0 = 32 * nb;
#pragma unroll 8
    for (int i = 0; i < 32; ++i) { const int kk = 2 * i + (lane >> 5); scr[kk * 33 + (lane & 31)] = W[(size_t)(k0 + kk) * N + n0 + (lane & 31)]; }
    LDS_WAIT(); asm volatile("" ::: "memory");
    const int c = lane & 7;
#pragma unroll
    for (int j = 0; j < 4; ++j) { const int n = (lane >> 3) + 8 * j; const LAS float* s = scr + (8 * c) * 33 + n;
        v4u o; o.x = pk2(s[0 * 33], s[1 * 33]); o.y = pk2(s[2 * 33], s[3 * 33]); o.z = pk2(s[4 * 33], s[5 * 33]); o.w = pk2(s[6 * 33], s[7 * 33]);
        const int dr = MAP ? inproj_row(n0 + n) : (n0 + n);
        *(GAS v4u*)(WT + (size_t)dr * ldk + koff + k0 + 8 * c) = o; }
    LDS_WAIT(); asm volatile("" ::: "memory");
}
__device__ __forceinline__ void p0_convert(const float* src, bf16* dst, size_t n8, size_t gtid, size_t gthreads) {
    for (size_t i = gtid; i < n8; i += gthreads) {
        const f32x4 a = *(const GAS f32x4*)(src + i * 8), b = *(const GAS f32x4*)(src + i * 8 + 4);
        v4u o; o.x = pk2(a[0], a[1]); o.y = pk2(a[2], a[3]); o.z = pk2(b[0], b[1]); o.w = pk2(b[2], b[3]);
        *(GAS v4u*)(dst + i * 8) = o;
    }
}

__device__ __forceinline__ void p0_table_row(const float* src, unsigned char* dst, float* scale_out, int lane) {
    f32x4 v[8]; float am = 0.f;
#pragma unroll
    for (int q = 0; q < 8; ++q) { v[q] = *(const GAS f32x4*)(src + 32 * lane + 4 * q);
        am = fmaxf(am, fmaxf(fmaxf(fabsf(v[q][0]), fabsf(v[q][1])), fmaxf(fabsf(v[q][2]), fabsf(v[q][3])))); }
#pragma unroll
    for (int o = 1; o < 64; o <<= 1) am = fmaxf(am, __shfl_xor(am, o));
    const float sc = am > 0.f ? 6.0f / am : 1.0f;
    v4u o;
#pragma unroll
    for (int wq = 0; wq < 4; ++wq) { unsigned w = 0u;
        w = __builtin_amdgcn_cvt_scalef32_pk_fp4_f32(w, v[2 * wq][0] * sc, v[2 * wq][1] * sc, 1.0f, 0);
        w = __builtin_amdgcn_cvt_scalef32_pk_fp4_f32(w, v[2 * wq][2] * sc, v[2 * wq][3] * sc, 1.0f, 1);
        w = __builtin_amdgcn_cvt_scalef32_pk_fp4_f32(w, v[2 * wq + 1][0] * sc, v[2 * wq + 1][1] * sc, 1.0f, 2);
        w = __builtin_amdgcn_cvt_scalef32_pk_fp4_f32(w, v[2 * wq + 1][2] * sc, v[2 * wq + 1][3] * sc, 1.0f, 3);
        o[wq] = w; }
    *(GAS v4u*)(dst + 16 * lane) = o;
    if (lane == 0) *scale_out = am > 0.f ? am / 6.0f : 1.0f;
}

__device__ __forceinline__ unsigned q8pack(float a, float b, float c, float d, float s) {
    const int ia = (int)__builtin_rintf(a * s), ib = (int)__builtin_rintf(b * s), ic = (int)__builtin_rintf(c * s), id = (int)__builtin_rintf(d * s);
    return ((unsigned)ia & 255u) | (((unsigned)ib & 255u) << 8) | (((unsigned)ic & 255u) << 16) | ((unsigned)id << 24);
}
__device__ __forceinline__ void p0_absmax_item(const float* W, int item, int lane, gu32* wmax) {
    const int kc = item / 40, nc = item % 40, n0 = 256 * nc + 4 * lane;
    const float* p = W + (size_t)(128 * kc) * 10240 + n0;
    f32x4 am = (f32x4){0.f, 0.f, 0.f, 0.f};
#pragma unroll 16
    for (int r = 0; r < 128; ++r) { const f32x4 v = *(const GAS f32x4*)(p + (size_t)r * 10240);
        am[0] = fmaxf(am[0], fabsf(v[0])); am[1] = fmaxf(am[1], fabsf(v[1])); am[2] = fmaxf(am[2], fabsf(v[2])); am[3] = fmaxf(am[3], fabsf(v[3])); }
#pragma unroll
    for (int j = 0; j < 4; ++j) (void)__hip_atomic_fetch_max(wmax + n0 + j, __builtin_bit_cast(unsigned, am[j]), RLX_AGENT);
}
__device__ __forceinline__ void p0_transpose_item_i8(const float* W, int K, int N, unsigned char* W8, LAS float* scr, int item, int lane, const gu32* wmax) {
    const int nblk = N / 32, kb = item / nblk, nb = item % nblk, k0 = 64 * kb, n0 = 32 * nb;
#pragma unroll 8
    for (int i = 0; i < 32; ++i) { const int kk = 2 * i + (lane >> 5); scr[kk * 33 + (lane & 31)] = W[(size_t)(k0 + kk) * N + n0 + (lane & 31)]; }
    LDS_WAIT(); asm volatile("" ::: "memory");
    const int c = lane & 7;
#pragma unroll
    for (int j = 0; j < 4; ++j) { const int n = (lane >> 3) + 8 * j; const LAS float* s = scr + (8 * c) * 33 + n;
        const float am = __builtin_bit_cast(float, wmax[n0 + n]); const float sc = am > 0.f ? 127.0f / am : 0.f;
        v2u o; o.x = q8pack(s[0 * 33], s[1 * 33], s[2 * 33], s[3 * 33], sc); o.y = q8pack(s[4 * 33], s[5 * 33], s[6 * 33], s[7 * 33], sc);
        *(GAS v2u*)(W8 + (size_t)inproj_row(n0 + n) * K + k0 + 8 * c) = o; }
    LDS_WAIT(); asm volatile("" ::: "memory");
}
__device__ __forceinline__ void p0_x_row(const float* src, bf16* dstb, unsigned char* dst8, float* sx, int lane) {
    f32x4 v[8]; float am = 0.f;
#pragma unroll
    for (int j = 0; j < 8; ++j) { v[j] = *(const GAS f32x4*)(src + 256 * j + 4 * lane);
        am = fmaxf(am, fmaxf(fmaxf(fabsf(v[j][0]), fabsf(v[j][1])), fmaxf(fabsf(v[j][2]), fabsf(v[j][3])))); }
#pragma unroll
    for (int o = 1; o < 64; o <<= 1) am = fmaxf(am, __shfl_xor(am, o));
    const float sc = am > 0.f ? 127.0f / am : 0.f;
#pragma unroll
    for (int j = 0; j < 8; ++j) { *(GAS v2u*)(dstb + 256 * j + 4 * lane) = (v2u){pk2(v[j][0], v[j][1]), pk2(v[j][2], v[j][3])};
        *(GAS unsigned*)(dst8 + 256 * j + 4 * lane) = q8pack(v[j][0], v[j][1], v[j][2], v[j][3], sc); }
    if (lane == 0) *sx = am * (1.0f / 127.0f);
}

namespace att {
constexpr int KB0 = 0, VB0 = 32768, KMT = 65536, QFR = 65536;
__device__ __forceinline__ int crow(int r, int hi) { return (r & 3) + 8 * (r >> 2) + 4 * hi; }
__device__ __forceinline__ unsigned cvtpk(float lo, float hi) { return pg8::cvt_pk_bf16(lo, hi); }

template <int DQK, bool MOBA>
__device__ __forceinline__ void attn_pass(LAS unsigned char* lds, const bf16* Qg, const bf16* Kg, const bf16* Vtg, int q0, unsigned sel, f32x16 (&o)[4], int tid, int wid, int lane) {
    constexpr int NS = DQK / 16, RB = DQK * 2, KCH = DQK / 8;
    constexpr float THR = 8.0f;
    const int r32 = lane & 31, hi = lane >> 5;
    const int qpos = q0 + 32 * wid + r32;
    const int own = q0 >> 8;
    const LAS unsigned char* qlds = lds + QFR + wid * 8192 + lane * 16;
    { const bf16* qp = Qg + (size_t)(32 * wid + r32) * 1024 + 8 * hi;
#pragma unroll
      for (int s = 0; s < NS; ++s) *(LAS bf16x8*)(lds + QFR + wid * 8192 + lane * 16 + s * 1024) = *(const GAS bf16x8*)(qp + 16 * s); }
#pragma unroll
    for (int d = 0; d < 4; ++d) o[d] = (f32x16){0.f,0.f,0.f,0.f,0.f,0.f,0.f,0.f,0.f,0.f,0.f,0.f,0.f,0.f,0.f,0.f};
    f32x16 negm = (f32x16){0.f,0.f,0.f,0.f,0.f,0.f,0.f,0.f,0.f,0.f,0.f,0.f,0.f,0.f,0.f,0.f};
    float l_run = 0.f;
    const int nt = MOBA ? 4 + 4 * own : (q0 + 256) / 64;
    constexpr int NKC = (64 * KCH) / 512;
    v4u kreg[NKC], vreg[2];
    unsigned kgo[NKC], vgo[2]; int klds[NKC], vl0[2], vl1[2];
#pragma unroll
    for (int i = 0; i < NKC; ++i) { const int cid = tid + 512 * i, key = cid / KCH, ch = cid % KCH;
        const int swz = (DQK == 128) ? (key & 15) : ((key >> 1) & 7);
        kgo[i] = (unsigned)(key * 1024 + ch * 8) * 2u; klds[i] = key * RB + ((ch ^ swz) << 4); }
#pragma unroll
    for (int i = 0; i < 2; ++i) { const int cid = tid + 512 * i, d = cid >> 3, g = cid & 7;
        const int c = (g >> 2) * 4 + ((g >> 1) & 1) * 2, sw = (d >> 1) & 7, e = g & 1;
        vgo[i] = (unsigned)(d * T + g * 8) * 2u; vl0[i] = d * 128 + ((c ^ sw) << 4) + 8 * e; vl1[i] = d * 128 + (((c + 1) ^ sw) << 4) + 8 * e; }
#define KTILE(i) (MOBA ? ((i) < 4 ? own * 4 + (i) : (i) - 4) : (i))
#define ATT_LOAD(kt) do { const GAS unsigned char* kb_ = (const GAS unsigned char*)Kg + (size_t)(kt) * 131072; const GAS unsigned char* vb_ = (const GAS unsigned char*)Vtg + (size_t)(kt) * 128; \
                          _Pragma("unroll") for (int i_ = 0; i_ < NKC; ++i_) kreg[i_] = *(const GAS v4u*)(kb_ + kgo[i_]); \
                          _Pragma("unroll") for (int i_ = 0; i_ < 2; ++i_) vreg[i_] = *(const GAS v4u*)(vb_ + vgo[i_]); } while (0)
#define ATT_STORE(buf) do { _Pragma("unroll") for (int i_ = 0; i_ < NKC; ++i_) *(LAS v4u*)(lds + KB0 + (buf) * 16384 + klds[i_]) = kreg[i_]; \
                            _Pragma("unroll") for (int i_ = 0; i_ < 2; ++i_) { *(LAS v2u*)(lds + VB0 + (buf) * 16384 + vl0[i_]) = (v2u){vreg[i_].x, vreg[i_].y}; \
                                                                              *(LAS v2u*)(lds + VB0 + (buf) * 16384 + vl1[i_]) = (v2u){vreg[i_].z, vreg[i_].w}; } } while (0)
    ATT_LOAD(KTILE(0)); ATT_STORE(0);
    __syncthreads();
    const int kswz = (DQK == 128) ? (r32 & 15) : ((r32 >> 1) & 7);
    const int vsw = (r32 >> 1) & 7;
    const int kfo = r32 * RB, vfo = r32 * 128;
#define ATT_STEP(BUF) do { \
        const int kt = KTILE(it); const bool more = it + 1 < nt; \
        if (more) ATT_LOAD(KTILE(it + 1)); \
        const int blk = kt >> 2; bool need; \
        if (!MOBA || it < 4) need = (kt * 64 <= q0 + 32 * wid + 31); else need = __any((sel >> blk) & 1u); \
        if (need) { \
            f32x16 p0, p1; \
            const LAS unsigned char* kb = lds + KB0 + (BUF) * 16384 + kfo; \
              \
            bf16x8 fk0[2], fk1[2], fqv[2]; \
            { const int ch = ((0 + hi) ^ kswz) << 4; fk0[0] = *(const LAS bf16x8*)(kb + ch); fk1[0] = *(const LAS bf16x8*)(kb + 32 * RB + ch); fqv[0] = *(const LAS bf16x8*)(qlds); } \
            _Pragma("unroll") for (int s = 0; s < NS; ++s) { \
                if (s + 1 < NS) { const int ch = ((2 * (s + 1) + hi) ^ kswz) << 4; \
                    fk0[(s + 1) & 1] = *(const LAS bf16x8*)(kb + ch); fk1[(s + 1) & 1] = *(const LAS bf16x8*)(kb + 32 * RB + ch); fqv[(s + 1) & 1] = *(const LAS bf16x8*)(qlds + (s + 1) * 1024); } \
                __builtin_amdgcn_sched_barrier(0); \
                if (s == 0) {   \
                    asm volatile("v_mfma_f32_32x32x16_bf16 %0, %1, %2, %3" : "=&v"(p0) : "v"(fk0[0]), "v"(fqv[0]), "v"(negm)); \
                    asm volatile("v_mfma_f32_32x32x16_bf16 %0, %1, %2, %3" : "=&v"(p1) : "v"(fk1[0]), "v"(fqv[0]), "v"(negm)); } \
                else { p0 = __builtin_amdgcn_mfma_f32_32x32x16_bf16(fk0[s & 1], fqv[s & 1], p0, 0, 0, 0); p1 = __builtin_amdgcn_mfma_f32_32x32x16_bf16(fk1[s & 1], fqv[s & 1], p1, 0, 0, 0); } \
                __builtin_amdgcn_sched_barrier(0); } \
            if (!MOBA || it < 4) { \
                if (kt * 64 + 63 > q0 + 32 * wid) { const int kbase = kt * 64 + 4 * hi; \
                    _Pragma("unroll") for (int r = 0; r < 16; ++r) { const int kv = kbase + (r & 3) + 8 * (r >> 2); if (kv > qpos) p0[r] = -INFINITY; if (kv + 32 > qpos) p1[r] = -INFINITY; } } \
            } else { if (!((sel >> blk) & 1u)) { _Pragma("unroll") for (int r = 0; r < 16; ++r) { p0[r] = -INFINITY; p1[r] = -INFINITY; } } } \
            float rm = fmaxf(fmaxf(p0[0], p0[1]), p1[0]); \
            _Pragma("unroll") for (int r = 1; r < 16; ++r) rm = fmaxf(fmaxf(rm, p0[r]), p1[r]); \
            { const unsigned rb = __builtin_bit_cast(unsigned, rm); auto rr = __builtin_amdgcn_permlane32_swap(rb, rb, false, false); rm = fmaxf(__builtin_bit_cast(float, (unsigned)rr[0]), __builtin_bit_cast(float, (unsigned)rr[1])); } \
            if (it == 0 || __any(rm > THR)) { \
                const float dl = (it == 0) ? rm : fmaxf(rm, 0.f); const float alpha = fexp2(-dl); \
                _Pragma("unroll") for (int r = 0; r < 16; ++r) { p0[r] -= dl; p1[r] -= dl; negm[r] -= dl; } \
                l_run *= alpha; \
                _Pragma("unroll") for (int d = 0; d < 4; ++d) _Pragma("unroll") for (int r = 0; r < 16; ++r) o[d][r] *= alpha; } \
            float ls = 0.f; \
            _Pragma("unroll") for (int r = 0; r < 16; ++r) { p0[r] = fexp2(p0[r]); p1[r] = fexp2(p1[r]); ls += p0[r] + p1[r]; } \
            l_run += ls; \
            bf16x8 pa[4]; \
            { v4u w; \
              w.x = cvtpk(p0[0], p0[1]); w.y = cvtpk(p0[2], p0[3]); w.z = cvtpk(p0[4], p0[5]); w.w = cvtpk(p0[6], p0[7]); pa[0] = __builtin_bit_cast(bf16x8, w); \
              w.x = cvtpk(p0[8], p0[9]); w.y = cvtpk(p0[10], p0[11]); w.z = cvtpk(p0[12], p0[13]); w.w = cvtpk(p0[14], p0[15]); pa[1] = __builtin_bit_cast(bf16x8, w); \
              w.x = cvtpk(p1[0], p1[1]); w.y = cvtpk(p1[2], p1[3]); w.z = cvtpk(p1[4], p1[5]); w.w = cvtpk(p1[6], p1[7]); pa[2] = __builtin_bit_cast(bf16x8, w); \
              w.x = cvtpk(p1[8], p1[9]); w.y = cvtpk(p1[10], p1[11]); w.z = cvtpk(p1[12], p1[13]); w.w = cvtpk(p1[14], p1[15]); pa[3] = __builtin_bit_cast(bf16x8, w); } \
            const LAS unsigned char* vb = lds + VB0 + (BUF) * 16384 + vfo; \
            bf16x8 vfr[2][4]; \
            _Pragma("unroll") for (int d = 0; d < 4; ++d) vfr[0][d] = *(const LAS bf16x8*)(vb + d * 4096 + (((0 + hi) ^ vsw) << 4)); \
            _Pragma("unroll") for (int ks = 0; ks < 4; ++ks) { \
                if (ks + 1 < 4) { const int c = ((ks + 1) >> 1) * 4 + ((ks + 1) & 1) * 2 + hi; \
                    _Pragma("unroll") for (int d = 0; d < 4; ++d) vfr[(ks + 1) & 1][d] = *(const LAS bf16x8*)(vb + d * 4096 + ((c ^ vsw) << 4)); } \
                __builtin_amdgcn_sched_barrier(0); \
                _Pragma("unroll") for (int d = 0; d < 4; ++d) o[d] = __builtin_amdgcn_mfma_f32_32x32x16_bf16(vfr[ks & 1][d], pa[ks], o[d], 0, 0, 0); \
                __builtin_amdgcn_sched_barrier(0); } \
        } \
        if (more) ATT_STORE((BUF) ^ 1); \
        __syncthreads(); \
    } while (0)
    int it = 0;
#pragma unroll 1
    for (; it + 1 < nt; it += 2) { ATT_STEP(0); ++it; ATT_STEP(1); --it; }
    if (it < nt) ATT_STEP(0);
#undef ATT_STEP
#undef ATT_LOAD
#undef KTILE
#undef ATT_STORE
    const float lt = l_run + __shfl_xor(l_run, 32);
    const float inv = 1.0f / lt;
#pragma unroll
    for (int d = 0; d < 4; ++d)
#pragma unroll
        for (int r = 0; r < 16; ++r) o[d][r] *= inv;
}

__device__ __forceinline__ void attn_pass_diff2(LAS unsigned char* lds, const bf16* Qg, const bf16* Kg, const bf16* Vtg, int q0, f32x16 (&o1)[4], f32x16 (&o2)[4], int tid, int wid, int lane) {
    constexpr int RB = 256, KCH = 16; constexpr float THR = 8.0f;
    { const int r32 = lane & 31, hi = lane >> 5;
      const bf16* qp = Qg + (size_t)(32 * wid + r32) * 1024 + 8 * hi;
#pragma unroll
      for (int s = 0; s < 8; ++s) *(LAS bf16x8*)(lds + QFR + wid * 8192 + lane * 16 + s * 1024) = *(const GAS bf16x8*)(qp + 16 * s); }
#pragma unroll
    for (int d = 0; d < 4; ++d) { o1[d] = (f32x16){0.f,0.f,0.f,0.f,0.f,0.f,0.f,0.f,0.f,0.f,0.f,0.f,0.f,0.f,0.f,0.f}; o2[d] = o1[d]; }
    float m1 = 0.f, l1 = 0.f, m2 = 0.f, l2 = 0.f;
    const int nt = (q0 + 256) / 64;
    v4u sreg[2];
#define ATT_KGO(i) ((unsigned)((((tq_ + 512 * (i)) >> 4) * 1024 + ((tq_ + 512 * (i)) & 15) * 8) * 2))
#define ATT_KLDS(i) ((((tq_ + 512 * (i)) >> 4) * RB) + (((((tq_ + 512 * (i)) & 15)) ^ (((tq_ + 512 * (i)) >> 4) & 15)) << 4))
#define ATT_VGO(i) ((unsigned)((((tq_ + 512 * (i)) >> 3) * T + ((tq_ + 512 * (i)) & 7) * 8) * 2))
#define ATT_VC(i) (((((tq_ + 512 * (i)) & 7) >> 2) * 4) + (((((tq_ + 512 * (i)) & 7) >> 1) & 1) * 2))
#define ATT_VL0(i) ((((tq_ + 512 * (i)) >> 3) * 128) + ((ATT_VC(i) ^ ((((tq_ + 512 * (i)) >> 3) >> 1) & 7)) << 4) + 8 * ((tq_ + 512 * (i)) & 1))
#define ATT_VL1(i) ((((tq_ + 512 * (i)) >> 3) * 128) + (((ATT_VC(i) + 1) ^ ((((tq_ + 512 * (i)) >> 3) >> 1) & 7)) << 4) + 8 * ((tq_ + 512 * (i)) & 1))
#define ATT_TQ int tq_ = lane; asm volatile("" : "+v"(tq_)); tq_ += 64 * wid
#define ATT_LOADK(kt) do { ATT_TQ; const GAS unsigned char* kb_ = (const GAS unsigned char*)Kg + (size_t)(kt) * 131072; _Pragma("unroll") for (int i_ = 0; i_ < 2; ++i_) sreg[i_] = *(const GAS v4u*)(kb_ + ATT_KGO(i_)); } while (0)
#define ATT_LOADV(kt) do { ATT_TQ; const GAS unsigned char* vb_ = (const GAS unsigned char*)Vtg + (size_t)(kt) * 128; _Pragma("unroll") for (int i_ = 0; i_ < 2; ++i_) sreg[i_] = *(const GAS v4u*)(vb_ + ATT_VGO(i_)); } while (0)
#define ATT_STOREK(buf) do { ATT_TQ; _Pragma("unroll") for (int i_ = 0; i_ < 2; ++i_) *(LAS v4u*)(lds + KB0 + (buf) * 16384 + ATT_KLDS(i_)) = sreg[i_]; } while (0)
#define ATT_STOREV(buf) do { ATT_TQ; _Pragma("unroll") for (int i_ = 0; i_ < 2; ++i_) { *(LAS v2u*)(lds + VB0 + (buf) * 16384 + ATT_VL0(i_)) = (v2u){sreg[i_].x, sreg[i_].y}; \
                                                                               *(LAS v2u*)(lds + VB0 + (buf) * 16384 + ATT_VL1(i_)) = (v2u){sreg[i_].z, sreg[i_].w}; } } while (0)
    ATT_LOADK(0); ATT_STOREK(0); ATT_LOADV(0); ATT_STOREV(0);
    __syncthreads();
#define ATT_LN int ln_ = lane; asm volatile("" : "+v"(ln_)); const int r32 = ln_ & 31, hi = ln_ >> 5
#define ATT_QKS(BUF, S0, M, L, O) do { \
        ATT_LN; const int kswz = r32 & 15; const LAS unsigned char* qlds = lds + QFR + wid * 8192 + ln_ * 16; \
        const LAS unsigned char* kb = lds + KB0 + (BUF) * 16384 + r32 * RB; \
        _Pragma("unroll") for (int s = 0; s < 4; ++s) { const int ch = ((2 * ((S0) + s) + hi) ^ kswz) << 4; \
            const bf16x8 k0 = *(const LAS bf16x8*)(kb + ch), k1 = *(const LAS bf16x8*)(kb + 32 * RB + ch); \
            const bf16x8 qv = *(const LAS bf16x8*)(qlds + ((S0) + s) * 1024); \
            if (s == 0) { asm volatile("v_mfma_f32_32x32x16_bf16 %0, %1, %2, 0" : "=&v"(p0) : "v"(k0), "v"(qv)); \
                          asm volatile("v_mfma_f32_32x32x16_bf16 %0, %1, %2, 0" : "=&v"(p1) : "v"(k1), "v"(qv)); } \
            else { p0 = __builtin_amdgcn_mfma_f32_32x32x16_bf16(k0, qv, p0, 0, 0, 0); p1 = __builtin_amdgcn_mfma_f32_32x32x16_bf16(k1, qv, p1, 0, 0, 0); } } \
        if (diag) { const int kbase = kt * 64 + 4 * hi, qpos = q0 + 32 * wid + r32; \
            _Pragma("unroll") for (int r = 0; r < 16; ++r) { const int kv = kbase + (r & 3) + 8 * (r >> 2); if (kv > qpos) p0[r] = -INFINITY; if (kv + 32 > qpos) p1[r] = -INFINITY; } } \
        float rm = fmaxf(fmaxf(p0[0], p0[1]), p1[0]); \
        _Pragma("unroll") for (int r = 1; r < 16; ++r) rm = fmaxf(fmaxf(rm, p0[r]), p1[r]); \
        { const unsigned rb = __builtin_bit_cast(unsigned, rm); auto rr = __builtin_amdgcn_permlane32_swap(rb, rb, false, false); rm = fmaxf(__builtin_bit_cast(float, (unsigned)rr[0]), __builtin_bit_cast(float, (unsigned)rr[1])); } \
        if (it == 0 || __any(rm > M + THR)) { \
            const float mnew = (it == 0) ? rm : fmaxf(M, rm); const float alpha = fexp2(M - mnew); M = mnew; \
            L *= alpha; \
            _Pragma("unroll") for (int d = 0; d < 4; ++d) _Pragma("unroll") for (int r = 0; r < 16; ++r) O[d][r] *= alpha; } \
        float ls = 0.f; \
        { typedef float f32x2v __attribute__((ext_vector_type(2))); const f32x2v mm = (f32x2v){M, M};        \
          _Pragma("unroll") for (int r = 0; r < 16; r += 2) { const f32x2v a = (f32x2v){p0[r], p0[r + 1]} - mm, b = (f32x2v){p1[r], p1[r + 1]} - mm; \
              p0[r] = fexp2(a.x); p0[r + 1] = fexp2(a.y); p1[r] = fexp2(b.x); p1[r + 1] = fexp2(b.y); ls += (p0[r] + p0[r + 1]) + (p1[r] + p1[r + 1]); } } \
        L += ls; \
    } while (0)
#define ATT_PACK(dst_, ks) do { \
        if ((ks) == 0) { (dst_).x = cvtpk(p0[0], p0[1]); (dst_).y = cvtpk(p0[2], p0[3]); (dst_).z = cvtpk(p0[4], p0[5]); (dst_).w = cvtpk(p0[6], p0[7]); } \
        else if ((ks) == 1) { (dst_).x = cvtpk(p0[8], p0[9]); (dst_).y = cvtpk(p0[10], p0[11]); (dst_).z = cvtpk(p0[12], p0[13]); (dst_).w = cvtpk(p0[14], p0[15]); } \
        else if ((ks) == 2) { (dst_).x = cvtpk(p1[0], p1[1]); (dst_).y = cvtpk(p1[2], p1[3]); (dst_).z = cvtpk(p1[4], p1[5]); (dst_).w = cvtpk(p1[6], p1[7]); } \
        else { (dst_).x = cvtpk(p1[8], p1[9]); (dst_).y = cvtpk(p1[10], p1[11]); (dst_).z = cvtpk(p1[12], p1[13]); (dst_).w = cvtpk(p1[14], p1[15]); } } while (0)
#define ATT_STEP(BUF) do { \
        const int kt = it; const bool more = it + 1 < nt; \
        const bool need = kt * 64 <= q0 + 32 * wid + 31, diag = kt * 64 + 63 > q0 + 32 * wid; \
        if (more) ATT_LOADK(it + 1); \
        v4u pa1[4] = {(v4u){0u, 0u, 0u, 0u}, (v4u){0u, 0u, 0u, 0u}, (v4u){0u, 0u, 0u, 0u}, (v4u){0u, 0u, 0u, 0u}}; \
        if (need) { f32x16 p0, p1; ATT_QKS(BUF, 0, m1, l1, o1); \
              _Pragma("unroll") for (int ks = 0; ks < 4; ++ks) ATT_PACK(pa1[ks], ks); } \
        if (more) { ATT_STOREK((BUF) ^ 1); ATT_LOADV(it + 1); }        \
        if (need) { v4u pa2[4]; \
              { f32x16 p0, p1; ATT_QKS(BUF, 4, m2, l2, o2); \
                _Pragma("unroll") for (int ks = 0; ks < 4; ++ks) ATT_PACK(pa2[ks], ks); } \
              __builtin_amdgcn_sched_barrier(0); \
              ATT_LN; const int vsw = (r32 >> 1) & 7; \
              const LAS unsigned char* vb = lds + VB0 + (BUF) * 16384 + r32 * 128; \
              _Pragma("unroll") for (int ks = 0; ks < 4; ++ks) { \
                const bf16x8 pb1 = __builtin_bit_cast(bf16x8, pa1[ks]), pb2 = __builtin_bit_cast(bf16x8, pa2[ks]); \
                const int c = (ks >> 1) * 4 + (ks & 1) * 2 + hi; \
                _Pragma("unroll") for (int d = 0; d < 4; ++d) { const bf16x8 vf = *(const LAS bf16x8*)(vb + d * 4096 + ((c ^ vsw) << 4)); \
                    o1[d] = __builtin_amdgcn_mfma_f32_32x32x16_bf16(vf, pb1, o1[d], 0, 0, 0); \
                    o2[d] = __builtin_amdgcn_mfma_f32_32x32x16_bf16(vf, pb2, o2[d], 0, 0, 0); } \
                __builtin_amdgcn_sched_barrier(0); } } \
        if (more) ATT_STOREV((BUF) ^ 1); \
        __syncthreads(); \
    } while (0)
    int it = 0;
#pragma unroll 1
    for (; it + 1 < nt; it += 2) { ATT_STEP(0); ++it; ATT_STEP(1); --it; }
    if (it < nt) ATT_STEP(0);
#undef ATT_STEP
#undef ATT_QKS
#undef ATT_PACK
#undef ATT_LN
#undef ATT_LOADK
#undef ATT_LOADV
#undef ATT_STOREK
#undef ATT_STOREV
#undef ATT_TQ
#undef ATT_KGO
#undef ATT_KLDS
#undef ATT_VGO
#undef ATT_VC
#undef ATT_VL0
#undef ATT_VL1
    const float i1 = 1.0f / (l1 + __shfl_xor(l1, 32)), i2 = 1.0f / (l2 + __shfl_xor(l2, 32));
#pragma unroll
    for (int d = 0; d < 4; ++d)
#pragma unroll
        for (int r = 0; r < 16; ++r) { o1[d][r] *= i1; o2[d][r] *= i2; }
}

struct AttnArgs { const bf16 *qa, *ka, *qd, *kd, *vt; bf16* oab; const float* kmean; const float* gain; float lam, one_minus_li; };

__device__ __forceinline__ void moba_unit(LAS unsigned char* lds, const AttnArgs& A, int b, int h, int qb, int tid, int wid, int lane) {
    asm volatile("" : "+v"(tid), "+v"(lane));
    const int r32 = lane & 31, hi = lane >> 5, q0 = qb * 256;
    const bf16* Qg = A.qa + (size_t)(b * SEQ + q0) * 1024 + h * 128;
    unsigned sel = 0u;
    if (qb > 0) {
        { const int row = tid >> 4, ch = tid & 15, n = row & 15;
          const float* kp = A.kmean + ((size_t)(b * 8 + h) * 16 + n) * 128 + ch * 8;
          const f32x4 a = *(const GAS f32x4*)kp, c = *(const GAS f32x4*)(kp + 4);
          float v[8] = {a[0], a[1], a[2], a[3], c[0], c[1], c[2], c[3]}; unsigned w[8];
#pragma unroll
          for (int j = 0; j < 8; ++j) { const float x = v[j] * (1.0f / 256.0f); const unsigned hb = f2bf(x); const float xr = __builtin_bit_cast(float, hb << 16); w[j] = (row < 16) ? hb : f2bf(x - xr); }
          v4u o; o.x = w[0] | (w[1] << 16); o.y = w[2] | (w[3] << 16); o.z = w[4] | (w[5] << 16); o.w = w[6] | (w[7] << 16);
          *(LAS v4u*)(lds + KMT + row * 256 + ((ch ^ (row & 15)) << 4)) = o; }
        __syncthreads();
        f32x16 g = (f32x16){0.f,0.f,0.f,0.f,0.f,0.f,0.f,0.f,0.f,0.f,0.f,0.f,0.f,0.f,0.f,0.f};
        { const bf16* qp = Qg + (size_t)(32 * wid + r32) * 1024 + 8 * hi;
          const LAS unsigned char* kb = lds + KMT + r32 * 256;
#pragma unroll
          for (int s = 0; s < 8; ++s) { const bf16x8 qv = *(const GAS bf16x8*)(qp + 16 * s);
              const bf16x8 kf = *(const LAS bf16x8*)(kb + (((2 * s + hi) ^ (r32 & 15)) << 4));
              g = __builtin_amdgcn_mfma_f32_32x32x16_bf16(kf, qv, g, 0, 0, 0); } }
        float G[16];
#pragma unroll
        for (int r = 0; r < 8; ++r) { const float mine = g[r] + g[r + 8]; const float oth = __shfl_xor(mine, 32);
            const int nlo = (r & 3) + 8 * (r >> 2); G[nlo] = hi ? oth : mine; G[nlo + 4] = hi ? mine : oth; }
#pragma unroll
        for (int round = 0; round < 3; ++round) { float best = -INFINITY; int bi = -1;
#pragma unroll
            for (int n = 0; n < 16; ++n) { const bool ok = (n < qb) && !((sel >> n) & 1u) && (G[n] > best); best = ok ? G[n] : best; bi = ok ? n : bi; }
            if (bi >= 0) sel |= 1u << bi; }
        __syncthreads();
    }
    f32x16 o[4];
    attn_pass<128, true>(lds, Qg, A.ka + (size_t)(b * SEQ) * 1024 + h * 128, A.vt + (size_t)(h * 128) * T + b * SEQ, q0, sel, o, tid, wid, lane);
    bf16* op = A.oab + (size_t)(b * SEQ + q0 + 32 * wid + r32) * 2048 + h * 128 + 4 * hi;
#pragma unroll
    for (int d = 0; d < 4; ++d)
#pragma unroll
        for (int gq = 0; gq < 4; ++gq) { v2u w; w.x = cvtpk(o[d][4 * gq], o[d][4 * gq + 1]); w.y = cvtpk(o[d][4 * gq + 2], o[d][4 * gq + 3]); *(GAS v2u*)(op + 32 * d + 8 * gq) = w; }
}

__device__ __forceinline__ void diff_unit(LAS unsigned char* lds, const AttnArgs& A, int b, int h, int qb, int tid, int wid, int lane) {
    asm volatile("" : "+v"(tid), "+v"(lane));
    const int r32 = lane & 31, hi = lane >> 5, q0 = qb * 256;
    const size_t qrow = (size_t)(b * SEQ + q0);
    const bf16* Vtg = A.vt + (size_t)(1024 + h * 128) * T + b * SEQ;
    f32x16 o[4], o2[4];
    attn_pass_diff2(lds, A.qd + qrow * 1024 + h * 128, A.kd + (size_t)(b * SEQ) * 1024 + h * 128, Vtg, q0, o, o2, tid, wid, lane);
    float ss = 0.f;
#pragma unroll
    for (int d = 0; d < 4; ++d)
#pragma unroll
        for (int r = 0; r < 16; ++r) { const float v = o[d][r] - A.lam * o2[d][r]; o[d][r] = v; ss += v * v; }
    ss += __shfl_xor(ss, 32);
    const float rn = 1.0f / sqrtf(ss * (1.0f / 128.0f) + RMS_EPS) * A.one_minus_li;
    bf16* op = A.oab + (qrow + 32 * wid + r32) * 2048 + 1024 + h * 128 + 4 * hi;
    const float* gp = A.gain + h * 128 + 4 * hi;
#pragma unroll
    for (int d = 0; d < 4; ++d)
#pragma unroll
        for (int gq = 0; gq < 4; ++gq) { const f32x4 gn = *(const GAS f32x4*)(gp + 32 * d + 8 * gq);
            v2u w; w.x = cvtpk(o[d][4 * gq] * rn * gn[0], o[d][4 * gq + 1] * rn * gn[1]); w.y = cvtpk(o[d][4 * gq + 2] * rn * gn[2], o[d][4 * gq + 3] * rn * gn[3]);
            *(GAS v2u*)(op + 32 * d + 8 * gq) = w; }
}

__device__ __forceinline__ void attn_phase(LAS unsigned char* lds, const AttnArgs& A, int vcu, int G, int tid, int wid, int lane) {
    for (int ord = vcu; ord < 1024; ord += G) {
        const int i = ord >> 8, v = ord & 255, bh = v >> 3, s = v & 7;
        const int qb = (i & 1) ? 15 - s : s;
        if (i < 2) diff_unit(lds, A, bh >> 3, bh & 7, qb, tid, wid, lane);
        else moba_unit(lds, A, bh >> 3, bh & 7, qb, tid, wid, lane);
    }
}
}

namespace peer {
__device__ __forceinline__ int f2key(float f) { const int u = __builtin_bit_cast(int, f); return u ^ ((u >> 31) & 0x7fffffff); }
__device__ __forceinline__ float key2f(int k) { const int u = k ^ ((k >> 31) & 0x7fffffff); return __builtin_bit_cast(float, u); }
__device__ __forceinline__ int imax(int a, int b) { return a > b ? a : b; }
__device__ __forceinline__ int imin(int a, int b) { return a < b ? a : b; }

template <int OFF> __device__ __forceinline__ void sort16_desc(int (&v)[64]) {
#pragma unroll
    for (int k = 2; k <= 16; k <<= 1)
#pragma unroll
        for (int j = k >> 1; j > 0; j >>= 1)
#pragma unroll
            for (int i = 0; i < 16; ++i) { const int l = i ^ j;
                if (l > i) { const bool desc = ((i & k) == 0); const int a = v[OFF + i], b = v[OFF + l]; const int mx = imax(a, b), mn = imin(a, b);
                    v[OFF + i] = desc ? mx : mn; v[OFF + l] = desc ? mn : mx; } }
}
template <int OA, int OB> __device__ __forceinline__ void merge16_desc(int (&v)[64]) {
#pragma unroll
    for (int i = 0; i < 16; ++i) v[OA + i] = imax(v[OA + i], v[OB + 15 - i]);
#pragma unroll
    for (int j = 8; j > 0; j >>= 1)
#pragma unroll
        for (int i = 0; i < 16; ++i) { const int l = i ^ j;
            if (l > i) { const int a = v[OA + i], b = v[OA + l]; v[OA + i] = imax(a, b); v[OA + l] = imin(a, b); } }
}
__device__ __forceinline__ void top16_of_64(int (&v)[64]) {
    sort16_desc<0>(v); sort16_desc<16>(v); sort16_desc<32>(v); sort16_desc<48>(v);
    merge16_desc<0, 16>(v); merge16_desc<32, 48>(v); merge16_desc<0, 32>(v);
}
__device__ __forceinline__ float gelu_tanh(float x) {
    const float u = 0.7978845608028654f * (x + 0.044715f * x * x * x);
    const float e = __builtin_amdgcn_exp2f(2.0f * 1.4426950408889634f * u);
    const float th = 1.0f - 2.0f * __builtin_amdgcn_rcpf(e + 1.0f);
    return 0.5f * x * (1.0f + th);
}
constexpr int ETILE = 0, GTILE = 16384, SCR0 = 32768, XQ0 = 98304;

__device__ __forceinline__ void select_tile(LAS unsigned char* lds, const bf16* pq, const bf16* sk, int t0, int wid, int lane) {
    asm volatile("" : "+v"(lane));
    const int r32 = lane & 31, hi = lane >> 5, h = wid;
    LAS int* scr = (LAS int*)(lds + SCR0 + wid * 8192);
    int v[64];
#pragma unroll 1
    for (int c = 0; c < 2; ++c) {
        bf16x8 qf[8];
        { const bf16* qp = pq + (size_t)(t0 + r32) * 2048 + h * 256 + c * 128 + 8 * hi;
#pragma unroll
          for (int s = 0; s < 8; ++s) qf[s] = *(const GAS bf16x8*)(qp + 16 * s); }
        bf16x8 af[2][4];
        const bf16* ap0 = sk + ((size_t)((c * 8 + h) * 128 + r32)) * 128 + 8 * hi;
#pragma unroll
        for (int s = 0; s < 4; ++s) af[0][s] = *(const GAS bf16x8*)(ap0 + 16 * s);
        f32x16 sc;
#pragma unroll
        for (int hb = 0; hb < 8; ++hb) {
            if (hb + 1 < 8) { const bf16* ap = ap0 + (size_t)(32 * ((hb + 1) >> 1)) * 128 + 64 * ((hb + 1) & 1);
#pragma unroll
                for (int s = 0; s < 4; ++s) af[(hb + 1) & 1][s] = *(const GAS bf16x8*)(ap + 16 * s); }
            __builtin_amdgcn_sched_barrier(0);
            if ((hb & 1) == 0) sc = (f32x16){0.f,0.f,0.f,0.f,0.f,0.f,0.f,0.f,0.f,0.f,0.f,0.f,0.f,0.f,0.f,0.f};
#pragma unroll
            for (int s = 0; s < 4; ++s) sc = __builtin_amdgcn_mfma_f32_32x32x16_bf16(af[hb & 1][s], qf[4 * (hb & 1) + s], sc, 0, 0, 0);
            if (hb & 1) {
#pragma unroll
                for (int r = 0; r < 16; ++r) v[(hb >> 1) * 16 + r] = (f2key(sc[r]) & ~127) | (32 * (hb >> 1) + (r & 3) + 8 * (r >> 2) + 4 * hi); }
            __builtin_amdgcn_sched_barrier(0);
        }
        top16_of_64(v);
#pragma unroll
        for (int i = 0; i < 16; ++i) v[16 + i] = __shfl_xor(v[i], 32);
        merge16_desc<0, 16>(v);
#pragma unroll
        for (int i = 0; i < 16; ++i) scr[(c * 16 + i) * 64 + lane] = v[i];
    }
    LDS_WAIT();
    float a[16], b[16];
#pragma unroll
    for (int i = 0; i < 16; ++i) { a[i] = key2f(scr[i * 64 + lane] & ~127); b[i] = key2f(v[i] & ~127); }
    int n = 0;
#pragma unroll
    for (int i = 0; i < 16; ++i)
#pragma unroll
        for (int j = 0; j < 16; ++j)
            if ((i + 1) * (j + 1) <= 16) { v[n] = (f2key(a[i] + b[j]) & ~255) | (i << 4) | j; ++n; }
#pragma unroll
    for (int i = 0; i < 64; ++i) if (i >= 50) v[i] = (int)0x80000000;
    top16_of_64(v);
    float s[16]; int e[16]; float mx = -INFINITY;
#pragma unroll
    for (int k = 0; k < 16; ++k) { const int i = (v[k] >> 4) & 15, j = v[k] & 15;
        const int ka = scr[i * 64 + lane], kb2 = scr[(16 + j) * 64 + lane];
        s[k] = key2f(ka & ~127) + key2f(kb2 & ~127); e[k] = (ka & 127) * 128 + (kb2 & 127); mx = fmaxf(mx, s[k]); }
    float sum = 0.f;
#pragma unroll
    for (int k = 0; k < 16; ++k) { s[k] = __builtin_amdgcn_exp2f((s[k] - mx) * 1.4426950408889634f); sum += s[k]; }
    const float inv = 1.0f / sum;
    if (hi == 0) {
        LAS int* E = (LAS int*)(lds + ETILE) + r32 * 128 + h * 16; LAS float* Gt = (LAS float*)(lds + GTILE) + r32 * 128 + h * 16;
#pragma unroll
        for (int k = 0; k < 16; ++k) { E[k] = e[k]; Gt[k] = s[k] * inv; }
    }
}

#define PEER_LOADROW(dst, tab, ridx) do { dst = *((const GAS v4u*)((tab) + (size_t)(ridx) * 1024) + lane); } while (0)
typedef float f32x2p __attribute__((ext_vector_type(2)));
#define PEER_CVT4(w) const f32x2p c0_ = __builtin_amdgcn_cvt_scalef32_pk_f32_fp4((w), 1.0f, 0), c1_ = __builtin_amdgcn_cvt_scalef32_pk_f32_fp4((w), 1.0f, 1), \
        c2_ = __builtin_amdgcn_cvt_scalef32_pk_f32_fp4((w), 1.0f, 2), c3_ = __builtin_amdgcn_cvt_scalef32_pk_f32_fp4((w), 1.0f, 3)
#define PEER_AXPY8(Y2, wk2, w, b) do { PEER_CVT4(w); Y2[(b)] = __builtin_elementwise_fma(wk2, c0_, Y2[(b)]); Y2[(b) + 1] = __builtin_elementwise_fma(wk2, c1_, Y2[(b) + 1]); \
        Y2[(b) + 2] = __builtin_elementwise_fma(wk2, c2_, Y2[(b) + 2]); Y2[(b) + 3] = __builtin_elementwise_fma(wk2, c3_, Y2[(b) + 3]); } while (0)

__device__ __forceinline__ void token_ffn(LAS unsigned char* lds, int tl, const bf16* xrow, const unsigned char* TU, const unsigned char* TV, const float* SU, const float* SV,
                                          const float* gain, const float* bias, float* outf, bf16* outb, unsigned char* out8, float* outsx, int lane,
                                          v4u (&buf)[16], bool have_u, bool has_next) {
    f32x2p xs[16];
#pragma unroll
    for (int q = 0; q < 4; ++q) { const v4u a = *(const GAS v4u*)(xrow + 32 * lane + 8 * q);
        xs[4 * q] = (f32x2p){bf_lo(a.x), bf_hi(a.x)}; xs[4 * q + 1] = (f32x2p){bf_lo(a.y), bf_hi(a.y)}; xs[4 * q + 2] = (f32x2p){bf_lo(a.z), bf_hi(a.z)}; xs[4 * q + 3] = (f32x2p){bf_lo(a.w), bf_hi(a.w)}; }
    const LAS int* E = (const LAS int*)(lds + ETILE) + tl * 128; const LAS float* Gt = (const LAS float*)(lds + GTILE) + tl * 128;
    const int e_lo = E[lane], e_hi = E[64 + lane]; const float g_lo = Gt[lane], g_hi = Gt[64 + lane];
    const float su_lo = SU[e_lo], su_hi = SU[e_hi], sv_lo = SV[e_lo], sv_hi = SV[e_hi];
#define PEER_EIDX(k) (((k) < 64) ? __builtin_amdgcn_readlane(e_lo, (k)) : __builtin_amdgcn_readlane(e_hi, (k) - 64))
    constexpr int PEER_RING = 16;
    float h_lo = 0.f, h_hi = 0.f;
    {
        float am = 0.f;
#pragma unroll
        for (int i = 0; i < 16; ++i) am = fmaxf(am, fmaxf(fabsf(xs[i].x), fabsf(xs[i].y)));
#pragma unroll
        for (int o = 1; o < 64; o <<= 1) am = fmaxf(am, __shfl_xor(am, o));
        const float sx = am > 0.f ? 6.0f / am : 1.0f, isx = am > 0.f ? am / 6.0f : 1.0f;
        v4u xh, xl;
#pragma unroll
        for (int wq = 0; wq < 4; ++wq) { unsigned wh = 0u, wl = 0u;
#define PEER_XQ(b) { const f32x2p v = xs[4 * wq + (b)] * sx; wh = __builtin_amdgcn_cvt_scalef32_pk_fp4_f32(wh, v.x, v.y, 1.0f, (b)); \
                const f32x2p d = __builtin_amdgcn_cvt_scalef32_pk_f32_fp4(wh, 1.0f, (b)); wl = __builtin_amdgcn_cvt_scalef32_pk_fp4_f32(wl, (v.x - d.x) * 4.0f, (v.y - d.y) * 4.0f, 1.0f, (b)); }
            PEER_XQ(0) PEER_XQ(1) PEER_XQ(2) PEER_XQ(3)
#undef PEER_XQ
            xh[wq] = wh; xl[wq] = wl; }
        LAS unsigned char* xq = lds + XQ0 + (tl >> 2) * 2048;
        *(LAS v4u*)(xq + 16 * lane) = xh; *(LAS v4u*)(xq + 1024 + 16 * lane) = xl;
        const int g = lane >> 4, rl = lane & 15;
        typedef int v8i_t __attribute__((ext_vector_type(8)));
        if (!have_u) { const int e_r = E[16 * 0 + rl];
#pragma unroll
            for (int s = 0; s < 16; ++s) buf[s] = *(const GAS v4u*)(TU + (size_t)e_r * 1024 + 16 * g + 64 * s); }
#define PEER_HBLOCK(rb, RELOAD) do { \
            f32x4 ah = {0.f, 0.f, 0.f, 0.f}, al = {0.f, 0.f, 0.f, 0.f}; \
            int xoff = 16 * g; asm volatile("" : "+v"(xoff));        \
            const LAS unsigned char* xbb = xq + xoff; \
            _Pragma("unroll") for (int s = 0; s < 16; ++s) { \
                const v4u a4 = buf[s]; const v4u bh = *(const LAS v4u*)(xbb + 64 * s), bl = *(const LAS v4u*)(xbb + 1024 + 64 * s); \
                const v8i_t A = {(int)a4.x, (int)a4.y, (int)a4.z, (int)a4.w, 0, 0, 0, 0}, BH = {(int)bh.x, (int)bh.y, (int)bh.z, (int)bh.w, 0, 0, 0, 0}, BL = {(int)bl.x, (int)bl.y, (int)bl.z, (int)bl.w, 0, 0, 0, 0}; \
                ah = __builtin_amdgcn_mfma_scale_f32_16x16x128_f8f6f4(A, BH, ah, 4, 4, 0, 127, 0, 127); \
                al = __builtin_amdgcn_mfma_scale_f32_16x16x128_f8f6f4(A, BL, al, 4, 4, 0, 127, 0, 127); \
                RELOAD(s); } \
              \
            float selv = 0.f; \
            _Pragma("unroll") for (int r = 0; r < 4; ++r) { const float hv = (ah[r] + 0.25f * al[r]) * isx; const float t = __shfl(hv, 16 * ((lane >> 2) & 3)); selv = ((lane & 3) == r) ? t : selv; } \
            if ((rb) < 4) h_lo = ((lane >> 4) == (rb)) ? selv : h_lo; else h_hi = ((lane >> 4) == ((rb) - 4)) ? selv : h_hi; } while (0)
#define PEER_RELOAD_U(s) buf[s] = *(const GAS v4u*)(rown + 64 * (s))
#define PEER_RELOAD_V(s) PEER_LOADROW(buf[s], TV, PEER_EIDX(s))
#pragma unroll 1
        for (int rb = 0; rb < 7; ++rb) {
            const int e_n = E[16 * (rb + 1) + rl];
            const GAS unsigned char* rown = (const GAS unsigned char*)TU + (size_t)e_n * 1024 + 16 * g;
            PEER_HBLOCK(rb, PEER_RELOAD_U);
        }
        PEER_HBLOCK(7, PEER_RELOAD_V);
#undef PEER_RELOAD_U
#undef PEER_RELOAD_V
#undef PEER_HBLOCK
    }
    const float w_lo = g_lo * gelu_tanh(h_lo * su_lo) * sv_lo, w_hi = g_hi * gelu_tanh(h_hi * su_hi) * sv_hi;
    f32x2p y[16];
#pragma unroll
    for (int i = 0; i < 16; ++i) y[i] = (f32x2p){0.f, 0.f};
#pragma unroll 1
    for (int k0 = 0; k0 < 128 - PEER_RING; k0 += PEER_RING) {
        const int wsrc = __builtin_bit_cast(int, (k0 < 64) ? w_lo : w_hi);
        const int kb = k0 + PEER_RING;
        const int esrc = (kb < 64) ? e_lo : e_hi;
#pragma unroll
        for (int i = 0; i < PEER_RING; ++i) {
            const float wk = __builtin_bit_cast(float, __builtin_amdgcn_readlane(wsrc, (k0 & 63) + i));
            const v4u w = buf[i]; const f32x2p wk2 = {wk, wk};
            PEER_AXPY8(y, wk2, w.x, 0); PEER_AXPY8(y, wk2, w.y, 4); PEER_AXPY8(y, wk2, w.z, 8); PEER_AXPY8(y, wk2, w.w, 12);
            const int en = __builtin_amdgcn_readlane(esrc, (kb & 63) + i); PEER_LOADROW(buf[i], TV, en);
        }
    }
    {
        const int e_nx = has_next ? E[128 + (lane & 15)] : 0;
        const GAS unsigned char* rownx = (const GAS unsigned char*)TU + (size_t)e_nx * 1024 + 16 * (lane >> 4);
#pragma unroll
        for (int i = 0; i < PEER_RING; ++i) {
            const float wk = __builtin_bit_cast(float, __builtin_amdgcn_readlane(__builtin_bit_cast(int, w_hi), 48 + i));
            const v4u w = buf[i]; const f32x2p wk2 = {wk, wk};
            PEER_AXPY8(y, wk2, w.x, 0); PEER_AXPY8(y, wk2, w.y, 4); PEER_AXPY8(y, wk2, w.z, 8); PEER_AXPY8(y, wk2, w.w, 12);
            if (has_next) buf[i] = *(const GAS v4u*)(rownx + 64 * i);
        }
    }
    float sm = 0.f;
#pragma unroll
    for (int i = 0; i < 16; ++i) { y[i] = xs[i] * ALPHA + y[i]; sm += y[i].x + y[i].y; }
    const float mean = wave_sum(sm) * (1.0f / 2048.0f);
    float sq = 0.f;
#pragma unroll
    for (int i = 0; i < 16; ++i) { y[i] = y[i] - mean; sq += y[i].x * y[i].x + y[i].y * y[i].y; }
    const float rstd = 1.0f / sqrtf(wave_sum(sq) * (1.0f / 2048.0f) + LN_EPS);
    unsigned pk[16];
#pragma unroll
    for (int q = 0; q < 8; ++q) { const int c0 = 32 * lane + 4 * q;
        const f32x4 ga = *(const GAS f32x4*)(gain + c0), ba = *(const GAS f32x4*)(bias + c0);
        f32x4 o;
        o[0] = y[2 * q].x * rstd * ga[0] + ba[0]; o[1] = y[2 * q].y * rstd * ga[1] + ba[1]; o[2] = y[2 * q + 1].x * rstd * ga[2] + ba[2]; o[3] = y[2 * q + 1].y * rstd * ga[3] + ba[3];
        if (outf) *(GAS f32x4*)(outf + c0) = o;
        pk[2 * q] = pk2(o[0], o[1]); pk[2 * q + 1] = pk2(o[2], o[3]); }
    if (outb) {
#pragma unroll
        for (int q = 0; q < 4; ++q) *(GAS v4u*)(outb + 32 * lane + 8 * q) = (v4u){pk[4 * q], pk[4 * q + 1], pk[4 * q + 2], pk[4 * q + 3]};
        float am = 0.f;
#pragma unroll
        for (int i = 0; i < 16; ++i) am = fmaxf(am, fmaxf(fabsf(bf_lo(pk[i])), fabsf(bf_hi(pk[i]))));
#pragma unroll
        for (int o = 1; o < 64; o <<= 1) am = fmaxf(am, __shfl_xor(am, o));
        const float sc = am > 0.f ? 127.0f / am : 0.f;
#pragma unroll
        for (int q = 0; q < 2; ++q) { v4u w;
            w.x = q8pack(bf_lo(pk[8 * q]), bf_hi(pk[8 * q]), bf_lo(pk[8 * q + 1]), bf_hi(pk[8 * q + 1]), sc); w.y = q8pack(bf_lo(pk[8 * q + 2]), bf_hi(pk[8 * q + 2]), bf_lo(pk[8 * q + 3]), bf_hi(pk[8 * q + 3]), sc);
            w.z = q8pack(bf_lo(pk[8 * q + 4]), bf_hi(pk[8 * q + 4]), bf_lo(pk[8 * q + 5]), bf_hi(pk[8 * q + 5]), sc); w.w = q8pack(bf_lo(pk[8 * q + 6]), bf_hi(pk[8 * q + 6]), bf_lo(pk[8 * q + 7]), bf_hi(pk[8 * q + 7]), sc);
            *(GAS v4u*)(out8 + 32 * lane + 16 * q) = w; }
        if (lane == 0) *outsx = am * (1.0f / 127.0f); }
#undef PEER_EIDX
}
#undef PEER_LOADROW
#undef PEER_AXPY8
#undef PEER_CVT4
}

__device__ __forceinline__ void ln_row(const bf16* zrow, const float* gain, const float* bias, bf16* outb, int lane) {
    float v[32]; float s = 0.f;
#pragma unroll
    for (int q = 0; q < 4; ++q) { const v4u w = *(const GAS v4u*)(zrow + 32 * lane + 8 * q);
        v[8 * q] = bf_lo(w.x); v[8 * q + 1] = bf_hi(w.x); v[8 * q + 2] = bf_lo(w.y); v[8 * q + 3] = bf_hi(w.y); v[8 * q + 4] = bf_lo(w.z); v[8 * q + 5] = bf_hi(w.z); v[8 * q + 6] = bf_lo(w.w); v[8 * q + 7] = bf_hi(w.w); }
#pragma unroll
    for (int i = 0; i < 32; ++i) s += v[i];
    const float mean = wave_sum(s) * (1.0f / 2048.0f); float s2 = 0.f;
#pragma unroll
    for (int i = 0; i < 32; ++i) { v[i] -= mean; s2 += v[i] * v[i]; }
    const float rstd = 1.0f / sqrtf(wave_sum(s2) * (1.0f / 2048.0f) + LN_EPS);
#pragma unroll
    for (int q = 0; q < 4; ++q) { const int c0 = 32 * lane + 8 * q;
        const f32x4 g0 = *(const GAS f32x4*)(gain + c0), g1 = *(const GAS f32x4*)(gain + c0 + 4), b0 = *(const GAS f32x4*)(bias + c0), b1 = *(const GAS f32x4*)(bias + c0 + 4);
        v4u o; o.x = pk2(v[8 * q] * rstd * g0[0] + b0[0], v[8 * q + 1] * rstd * g0[1] + b0[1]); o.y = pk2(v[8 * q + 2] * rstd * g0[2] + b0[2], v[8 * q + 3] * rstd * g0[3] + b0[3]);
        o.z = pk2(v[8 * q + 4] * rstd * g1[0] + b1[0], v[8 * q + 5] * rstd * g1[1] + b1[1]); o.w = pk2(v[8 * q + 6] * rstd * g1[2] + b1[2], v[8 * q + 7] * rstd * g1[3] + b1[3]);
        *(GAS v4u*)(outb + c0) = o; }
}

__device__ __forceinline__ void ln_rows(const bf16* z, const float* gain, const float* bias, bf16* out, int m0, int stride, int lane) {
    f32x4 gg[8], bb[8];
#pragma unroll
    for (int q = 0; q < 8; ++q) { gg[q] = *(const GAS f32x4*)(gain + 32 * lane + 4 * q); bb[q] = *(const GAS f32x4*)(bias + 32 * lane + 4 * q); }
    v4u cur[4], nx1[4];
    if (m0 < T) { const int m1 = (m0 + stride < T) ? m0 + stride : m0;
#pragma unroll
        for (int q = 0; q < 4; ++q) { cur[q] = *(const GAS v4u*)(z + (size_t)m0 * 2048 + 32 * lane + 8 * q); nx1[q] = *(const GAS v4u*)(z + (size_t)m1 * 2048 + 32 * lane + 8 * q); } }
#pragma unroll 1
    for (int m = m0; m < T; m += stride) {
        v4u nxt[4];
        const int mn = (m + 2 * stride < T) ? m + 2 * stride : m;
#pragma unroll
        for (int q = 0; q < 4; ++q) nxt[q] = *(const GAS v4u*)(z + (size_t)mn * 2048 + 32 * lane + 8 * q);
        float v[32]; float s = 0.f;
#pragma unroll
        for (int q = 0; q < 4; ++q) { const v4u w = cur[q];
            v[8 * q] = bf_lo(w.x); v[8 * q + 1] = bf_hi(w.x); v[8 * q + 2] = bf_lo(w.y); v[8 * q + 3] = bf_hi(w.y); v[8 * q + 4] = bf_lo(w.z); v[8 * q + 5] = bf_hi(w.z); v[8 * q + 6] = bf_lo(w.w); v[8 * q + 7] = bf_hi(w.w); }
#pragma unroll
        for (int i = 0; i < 32; ++i) s += v[i];
        const float mean = wave_sum(s) * (1.0f / 2048.0f); float s2 = 0.f;
#pragma unroll
        for (int i = 0; i < 32; ++i) { v[i] -= mean; s2 += v[i] * v[i]; }
        const float rstd = 1.0f / sqrtf(wave_sum(s2) * (1.0f / 2048.0f) + LN_EPS);
#pragma unroll
        for (int q = 0; q < 4; ++q) { const f32x4 g0 = gg[2 * q], g1 = gg[2 * q + 1], b0 = bb[2 * q], b1 = bb[2 * q + 1];
            v4u o; o.x = pk2(v[8 * q] * rstd * g0[0] + b0[0], v[8 * q + 1] * rstd * g0[1] + b0[1]); o.y = pk2(v[8 * q + 2] * rstd * g0[2] + b0[2], v[8 * q + 3] * rstd * g0[3] + b0[3]);
            o.z = pk2(v[8 * q + 4] * rstd * g1[0] + b1[0], v[8 * q + 5] * rstd * g1[1] + b1[1]); o.w = pk2(v[8 * q + 6] * rstd * g1[2] + b1[2], v[8 * q + 7] * rstd * g1[3] + b1[3]);
            *(GAS v4u*)(out + (size_t)m * 2048 + 32 * lane + 8 * q) = o; }
#pragma unroll
        for (int q = 0; q < 4; ++q) { cur[q] = nx1[q]; nx1[q] = nxt[q]; }
    }
}

#if MK_CHECK
namespace chk {
constexpr int CW_ERR = 2048;
__device__ __forceinline__ unsigned hash32(unsigned x) { x ^= x >> 16; x *= 0x7feb352du; x ^= x >> 15; x *= 0x846ca68bu; x ^= x >> 16; return x; }
__device__ __forceinline__ float bf2f(bf16 v) { return __builtin_bit_cast(float, (unsigned)v << 16); }
__device__ __forceinline__ void report(gu32* ctl, int stage, float d2, float r2) { atomicAdd((float*)(ctl + CW_ERR + 2 * stage), d2); atomicAdd((float*)(ctl + CW_ERR + 2 * stage + 1), r2); }
__device__ __forceinline__ float dotcol(const bf16* xr, const float* win, int n, int lane) { float a = 0.f; for (int k = lane; k < 2048; k += 64) a += bf2f(xr[k]) * win[(size_t)k * INC + n]; return wave_sum(a); }
__device__ __forceinline__ void check_inproj(gu32* ctl, const bf16* xin, const int* pos, const float* win, const bf16* qa, const bf16* ka, const bf16* qd, const bf16* kd, const bf16* vt, const bf16* ga, const bf16* gb, int gw, int ngw, int lane) {
    for (int s = gw; s < 4096; s += ngw) {
        const unsigned hsh = hash32(s * 2654435761u + 12345u);
        const int t = hsh % T, kind = (hsh >> 14) % 8;
        const unsigned h2 = hash32(hsh);
        const bf16* xr = xin + (size_t)t * 2048;
        float ref, got;
        if (kind == 0 || kind == 1) { const int head = h2 % 8, i = (h2 >> 3) % 64, nb = (kind == 0 ? 0 : 1024) + head * 128;
            const float t1 = dotcol(xr, win, nb + i, lane), t2 = dotcol(xr, win, nb + i + 64, lane);
            const float ang = (float)pos[t] * powf(10000.0f, -(float)(2 * i) / 128.0f), c = cosf(ang), sn = sinf(ang);
            const bool second = (h2 >> 9) & 1; ref = second ? (t1 * sn + t2 * c) : (t1 * c - t2 * sn);
            const bf16* p = (kind == 0 ? qa : ka) + (size_t)t * 1024 + head * 128 + i + (second ? 64 : 0);
            got = bf2f(*p) / (kind == 0 ? QSCALE_A : 1.0f);
        } else if (kind == 3 || kind == 4) { const int head = h2 % 8, comp = (h2 >> 3) & 1, i = (h2 >> 4) % 32, nb = (kind == 3 ? 3072 : 4096) + head * 128 + comp * 64;
            const float t1 = dotcol(xr, win, nb + i, lane), t2 = dotcol(xr, win, nb + i + 32, lane);
            const float ang = (float)pos[t] * powf(10000.0f, -(float)(2 * i) / 64.0f), c = cosf(ang), sn = sinf(ang);
            const bool second = (h2 >> 9) & 1; ref = second ? (t1 * sn + t2 * c) : (t1 * c - t2 * sn);
            const bf16* p = (kind == 3 ? qd : kd) + (size_t)t * 1024 + head * 128 + comp * 64 + i + (second ? 32 : 0);
            got = bf2f(*p) / (kind == 3 ? QSCALE_B : 1.0f);
        } else if (kind == 2 || kind == 5) { const int c = h2 % 1024; ref = dotcol(xr, win, (kind == 2 ? 2048 : 5120) + c, lane); got = bf2f(vt[(size_t)((kind == 2 ? 0 : 1024) + c) * T + t]);
        } else { const int c = h2 % 2048; const float v = dotcol(xr, win, (kind == 6 ? 6144 : 8192) + c, lane); ref = 1.0f / (1.0f + expf(-v)); got = (float)((const unsigned char*)(kind == 6 ? ga : gb))[(size_t)t * 2048 + c] * (1.0f / 255.0f); }
        if (lane == 0) report(ctl, 0, (got - ref) * (got - ref), ref * ref);
    }
}
__device__ __forceinline__ void check_kmean(gu32* ctl, const bf16* ka, const float* kmean, int gw, int ngw, int lane) {
    for (int s = gw; s < 1024; s += ngw) { const unsigned hsh = hash32(s * 40503u + 77u); const int item = hsh % 512, d = (hsh >> 10) % 128; const int b = item >> 7, h = (item >> 4) & 7, blk = item & 15;
        float a = 0.f; for (int r = lane; r < 256; r += 64) a += bf2f(ka[(size_t)(b * SEQ + blk * 256 + r) * 1024 + h * 128 + d]); a = wave_sum(a);
        const float g = kmean[(size_t)item * 128 + d];
        if (lane == 0) report(ctl, 1, (g - a) * (g - a), a * a + 1.0f); }
}
__device__ __forceinline__ void check_attn(LAS unsigned char* lds, gu32* ctl, const att::AttnArgs& A, int vcu, int G, int tid, int lane, int wave) {
    LAS float* sc = (LAS float*)lds; LAS float* red = sc + 4096; LAS float* ovec = red + 64; LAS float* gsc = ovec + 256; LAS unsigned* selw = (LAS unsigned*)(gsc + 16);
    for (int s = vcu; s < 1024; s += G) {
        const unsigned hsh = hash32(s * 2246822519u + 99u); const bool moba = (s & 1);
        const int b = hsh % NB, h = (hsh >> 2) % NH; int t = (hsh >> 5) % SEQ; if ((s & 6) == 0) t = (t & 255) + 256 * ((hsh >> 20) % 3);
        const size_t row = (size_t)b * SEQ + t; const int own = t >> 8;
        float o0 = 0.f, o1 = 0.f;
        const int ncomp = moba ? 1 : 2;
        __syncthreads();
        if (moba) {
            if (tid < 16) { float a = -INFINITY; if (tid < own) { a = 0.f; for (int d = 0; d < 128; ++d) a += bf2f(A.qa[row * 1024 + h * 128 + d]) * A.kmean[((size_t)(b * 8 + h) * 16 + tid) * 128 + d]; } gsc[tid] = a; }
            __syncthreads();
            if (tid == 0) { unsigned sel = 0u; for (int r = 0; r < 3; ++r) { float best = -INFINITY; int bi = -1; for (int n = 0; n < own; ++n) { const float g = gsc[n]; if (!((sel >> n) & 1u) && g > best) { best = g; bi = n; } } if (bi >= 0) sel |= 1u << bi; } selw[0] = sel; }
            __syncthreads();
        }
        const unsigned sel = moba ? selw[0] : 0u;
        for (int comp = 0; comp < ncomp; ++comp) {
            const bf16* qp = moba ? A.qa + row * 1024 + h * 128 : A.qd + row * 1024 + h * 128 + comp * 64;
            const bf16* kb = moba ? A.ka + (size_t)b * SEQ * 1024 + h * 128 : A.kd + (size_t)b * SEQ * 1024 + h * 128 + comp * 64;
            const int dq = moba ? 128 : 64;
            float lmax = -INFINITY;
            for (int k = tid; k <= t; k += 512) { bool ok = true; if (moba) { const int kbk = k >> 8; ok = (kbk == own) || ((sel >> kbk) & 1u); }
                float a = -INFINITY; if (ok) { a = 0.f; for (int d = 0; d < dq; ++d) a += bf2f(qp[d]) * bf2f(kb[(size_t)k * 1024 + d]); }
                sc[k] = a; lmax = fmaxf(lmax, a); }
            lmax = fmaxf(lmax, __shfl_xor(lmax, 1)); lmax = fmaxf(lmax, __shfl_xor(lmax, 2)); lmax = fmaxf(lmax, __shfl_xor(lmax, 4)); lmax = fmaxf(lmax, __shfl_xor(lmax, 8)); lmax = fmaxf(lmax, __shfl_xor(lmax, 16)); lmax = fmaxf(lmax, __shfl_xor(lmax, 32));
            if (lane == 0) red[wave] = lmax;
            __syncthreads();
            float gmax = red[0]; for (int w = 1; w < 8; ++w) gmax = fmaxf(gmax, red[w]);
            float lsum = 0.f;
            for (int k = tid; k <= t; k += 512) { const float p = exp2f(sc[k] - gmax); sc[k] = p; lsum += p; }
            lsum = wave_sum(lsum);
            if (lane == 0) red[8 + wave] = lsum;
            __syncthreads();
            float gsum = 0.f; for (int w = 0; w < 8; ++w) gsum += red[8 + w];
            if (tid < 128) { const bf16* vp = A.vt + (size_t)((moba ? 0 : 1024) + h * 128 + tid) * T + (size_t)b * SEQ; float a = 0.f; for (int k = 0; k <= t; ++k) a += sc[k] * bf2f(vp[k]); a /= gsum; if (comp == 0) o0 = a; else o1 = a; }
            __syncthreads();
        }
        float ref = 0.f, got = 0.f;
        if (tid < 128) {
            if (moba) { ref = o0; got = bf2f(A.oab[row * 2048 + h * 128 + tid]); }
            else { ref = o0 - A.lam * o1; got = bf2f(A.oab[row * 2048 + 1024 + h * 128 + tid]); }
            ovec[tid] = ref;
        }
        __syncthreads();
        if (tid < 128 && !moba) { float ss = 0.f; for (int d = 0; d < 128; ++d) ss += ovec[d] * ovec[d]; ref = ref / sqrtf(ss * (1.0f / 128.0f) + RMS_EPS) * A.gain[h * 128 + tid] * A.one_minus_li; }
        float d2 = (tid < 128) ? (got - ref) * (got - ref) : 0.f, r2 = (tid < 128) ? ref * ref : 0.f;
        d2 = wave_sum(d2); r2 = wave_sum(r2);
        if (lane == 0 && wave < 2) report(ctl, moba ? 2 : 3, d2, r2);
        __syncthreads();
    }
}
__device__ __forceinline__ void check_merged(gu32* ctl, const bf16* oab, const bf16* ga, const bf16* gb, const bf16* merged, const float* wa, const float* wb, int gw, int ngw, int lane) {
    for (int s = gw; s < 2048; s += ngw) { const unsigned hsh = hash32(s * 3266489917u + 5u); const int t = hsh % T, c = (hsh >> 14) % 2048;
        float a = 0.f, b = 0.f; for (int k = lane; k < 1024; k += 64) { a += bf2f(oab[(size_t)t * 2048 + k]) * wa[(size_t)k * 2048 + c]; b += bf2f(oab[(size_t)t * 2048 + 1024 + k]) * wb[(size_t)k * 2048 + c]; }
        a = wave_sum(a); b = wave_sum(b);
        const float ref = ((float)((const unsigned char*)ga)[(size_t)t * 2048 + c] * a + (float)((const unsigned char*)gb)[(size_t)t * 2048 + c] * b) * (1.0f / 255.0f), got = bf2f(merged[(size_t)t * 2048 + c]);
        if (lane == 0) report(ctl, 4, (got - ref) * (got - ref), ref * ref); }
}
__device__ __forceinline__ void check_z(gu32* ctl, const bf16* merged, const float* wo, const bf16* xres, const bf16* z, int gw, int ngw, int lane) {
    for (int s = gw; s < 2048; s += ngw) { const unsigned hsh = hash32(s * 668265263u + 31u); const int t = hsh % T, c = (hsh >> 14) % 2048;
        float a = 0.f; for (int k = lane; k < 2048; k += 64) a += bf2f(merged[(size_t)t * 2048 + k]) * wo[(size_t)k * 2048 + c];
        a = wave_sum(a);
        const float got = bf2f(z[(size_t)t * 2048 + c]) - ALPHA * bf2f(xres[(size_t)t * 2048 + c]);
        if (lane == 0) report(ctl, 5, (got - a) * (got - a), a * a); }
}
}
#endif

constexpr int NPHASE = 2 + 8 * DEPTH;
#ifndef MK_ALIGN
#define MK_ALIGN true
#endif
#ifndef MK_SP2
#define MK_SP2 true
#endif
struct Params { const float* in[16]; float* out; unsigned char* ws; int ph_lo, ph_hi; };

__global__ void __launch_bounds__(NWAVES * 64, 2) mk_fwd(Params args) {
    extern __shared__ __attribute__((aligned(16))) unsigned char lds_raw[];
    Frame F;
    F.lds = (LAS unsigned char*)lds_raw;
    F.MISC = (volatile LAS unsigned*)(F.lds + MISC_OFF);
    F.tid = threadIdx.x; F.lane = F.tid & 63; F.wave = __builtin_amdgcn_readfirstlane(F.tid >> 6);
    F.G = gridDim.x; { const int bx = blockIdx.x; F.vcu = (F.G % 8 == 0) ? (bx % 8) * (F.G / 8) + bx / 8 : bx; }
    F.ws = args.ws; F.ctl = (gu32*)(args.ws + WS_CTL);
    unsigned char* const ws = args.ws;
    const float* const in_x = args.in[0]; const int* const in_pos = (const int*)args.in[1];
    const float *in_win = args.in[2], *in_wa = args.in[3], *in_wb = args.in[4], *in_wo = args.in[5], *in_dlam = args.in[6], *in_dgain = args.in[7];
    const float *in_ln1g = args.in[8], *in_ln1b = args.in[9], *in_ln2g = args.in[10], *in_ln2b = args.in[11], *in_pwq = args.in[12], *in_sk = args.in[13], *in_pu = args.in[14], *in_pv = args.in[15];
    float* const dout = args.out;

    for (int u = F.tid; u < (LDS_BYTES - LDSCTL_OFF) / 4; u += NWAVES * 64) ((LAS unsigned*)(F.lds + LDSCTL_OFF))[u] = 0u;
    __syncthreads();
#if MK_FUSED
    XcdBarrier bar = xcd_barrier_post((unsigned*)(F.ctl + CW_BAR), F.MISC + 8, (unsigned)F.wave);
#define GRID_BAR() xcd_barrier(bar)
#else
#define GRID_BAR() do { } while (0)
#endif
    const int lo = args.ph_lo, hi = args.ph_hi;
#define IN(k) (lo <= (k) && (k) < hi)
#define BOTH(k) (IN(k) && IN((k) + 1))

    float* const cosA = (float*)(ws + WS_ROPE); float* const sinA = cosA + (size_t)T * 64; float* const cosB = sinA + (size_t)T * 64; float* const sinB = cosB + (size_t)T * 32;
    bf16* const XB = (bf16*)(ws + WS_XB);

    gu32* const wmax = F.ctl + CW_WMAX;
    if (IN(0)) {
        for (int it = F.wave * F.G + F.vcu; it < DEPTH * 16 * 40; it += F.G * NWAVES) { const int layer = it / 640;
            p0_absmax_item(in_win + (size_t)layer * 2048 * 10240, it % 640, F.lane, wmax + layer * 10240); }
        if (BOTH(0)) GRID_BAR();
    }
    if (IN(1)) {
        LAS float* scr = (LAS float*)(F.lds + F.wave * 16384);
        const int gw = F.vcu * NWAVES + F.wave, NGW = F.G * NWAVES;
        constexpr int I_IN = (2048 / 64) * (10240 / 32), I_A = (1024 / 64) * (2048 / 32), I_O = (2048 / 64) * (2048 / 32);
        constexpr int PER_LAYER = I_IN + 2 * I_A + 2 * I_O;
        for (int it = gw; it < DEPTH * PER_LAYER; it += NGW) {
            const int layer = it / PER_LAYER; int r = it % PER_LAYER;
            unsigned char* wl = ws + WS_W + (size_t)layer * W_LAYER;
            if (r < I_IN) { p0_transpose_item_i8(in_win + (size_t)layer * 2048 * 10240, 2048, 10240, wl + WO_MAIN, scr, r, F.lane, wmax + layer * 10240); continue; } r -= I_IN;
            if (r < I_A) { p0_transpose_item<false>(in_wa + (size_t)layer * 1024 * 2048, 1024, 2048, (bf16*)(wl + WO_A), scr, r, F.lane, 2048, 0); continue; } r -= I_A;
            if (r < I_A) { p0_transpose_item<false>(in_wb + (size_t)layer * 1024 * 2048, 1024, 2048, (bf16*)(wl + WO_A), scr, r, F.lane, 2048, 1024); continue; } r -= I_A;
            if (r < I_O) { p0_transpose_item<false>(in_wo + (size_t)layer * 2048 * 2048, 2048, 2048, (bf16*)(wl + WO_O), scr, r, F.lane); continue; } r -= I_O;
            p0_transpose_item<false>(in_pwq + (size_t)layer * 2048 * 2048, 2048, 2048, (bf16*)(wl + WO_Q), scr, r, F.lane);
        }
        const size_t gtid = (size_t)F.vcu * 512 + F.tid, gthreads = (size_t)F.G * 512;
        for (int r = gw; r < 4 * NEXP; r += NGW) { const int tab = r >> 14, e = r & (NEXP - 1);
            const float* src = ((tab & 1) ? in_pv : in_pu) + ((size_t)(tab >> 1) * NEXP + e) * 2048;
            p0_table_row(src, ws + WS_TAB + (size_t)tab * TAB_BYTES + (size_t)e * 1024, (float*)(ws + WS_TSC) + r, F.lane); }
        p0_convert(in_sk, (bf16*)(ws + WS_SK), (size_t)DEPTH * 2 * 8 * 128 * 128 / 8, gtid, gthreads);
        for (int row = gw; row < T; row += NGW) p0_x_row(in_x + (size_t)row * 2048, XB + (size_t)row * 2048, ws + WS_XI8 + (size_t)row * 2048, (float*)(ws + WS_SX) + row, F.lane);
        for (size_t i = gtid; i < (size_t)DEPTH * 10240; i += gthreads) { const int layer = (int)(i / 10240), n = (int)(i % 10240);
            ((float*)(ws + WS_SW))[layer * 10240 + inproj_row(n)] = __builtin_bit_cast(float, wmax[layer * 10240 + n]) * (1.0f / 127.0f); }
        for (size_t i = gtid; i < (size_t)T * 64; i += gthreads) { const int t = (int)(i >> 6), k = (int)(i & 63);
            const float invf = powf(10000.0f, -(float)(2 * k) / 128.0f); const float ang = (float)in_pos[t] * invf;
            cosA[i] = cosf(ang); sinA[i] = sinf(ang); }
        for (size_t i = gtid; i < (size_t)T * 32; i += gthreads) { const int t = (int)(i >> 5), k = (int)(i & 31);
            const float invf = powf(10000.0f, -(float)(2 * k) / 64.0f); const float ang = (float)in_pos[t] * invf;
            cosB[i] = cosf(ang); sinB[i] = sinf(ang); }
        if (BOTH(1)) GRID_BAR();
    }

    for (int layer = 0; layer < DEPTH; ++layer) {
        const int pb = 2 + 8 * layer;
        unsigned char* const wl = ws + WS_W + (size_t)layer * W_LAYER;
        bf16* const ZB = (bf16*)dout;
        float* const kmean = (float*)(ws + WS_KMEAN) + (size_t)layer * NB * NH * 16 * 128;
        const float lambda_init = layer == 0 ? 0.2f : 0.3555090675909306f;
#define PHASE_TID() int llane_ = lane_id(); asm volatile("" : "+v"(llane_)); const int llane = llane_, ltid = llane_ + 64 * F.wave
        if (IN(pb)) {
            const bf16* const XI8 = (const bf16*)(ws + WS_XI8); const float* const sx = (const float*)(ws + WS_SX); const float* const sw = (const float*)(ws + WS_SW) + layer * 10240;
            { pg8::Gemm g{XI8, (const bf16*)(wl + WO_MAIN), T, NMAIN, 1024}; pg8::StaticOrder S; S.init(T, NMAIN, F.G, (int)blockIdx.x);
              pg8::EpiInProjI8 E{(bf16*)(ws + WS_QA), (bf16*)(ws + WS_KA), (bf16*)(ws + WS_QD), (bf16*)(ws + WS_KD), (bf16*)(ws + WS_GA), (bf16*)(ws + WS_GB), cosA, sinA, cosB, sinB, QSCALE_A, QSCALE_B, sx, sw};
              pg8::gemm_phase<pg8::EpiInProjI8, pg8::StaticOrder, MK_ALIGN, MK_SP2, false, true>(F.lds, g, S, E, F.wave); }
            { pg8::Gemm g{(const bf16*)(wl + WO_V), XI8, NV, T, 1024}; pg8::StaticOrder S; S.init(NV, T, F.G, (int)blockIdx.x);
              pg8::EpiPlainI8 E{(bf16*)(ws + WS_VT), T, sw + NMAIN, sx};
              pg8::gemm_phase<pg8::EpiPlainI8, pg8::StaticOrder, MK_ALIGN, MK_SP2, false, true>(F.lds, g, S, E, F.wave); }
            if (BOTH(pb)) GRID_BAR();
        }
        if (IN(pb + 1)) {
            PHASE_TID();
            LAS float* part = (LAS float*)F.lds;
            const bf16* KA = (const bf16*)(ws + WS_KA);
#pragma unroll 1
            for (int item = F.vcu; item < NB * NH * 16; item += F.G) {
                const int b = item >> 7, h = (item >> 4) & 7, blk = item & 15;
                const int c = ltid & 15, rg = ltid >> 4;
                const bf16* kp = KA + (size_t)(b * SEQ + blk * 256 + rg) * 1024 + h * 128 + c * 8;
                float sacc[8] = {0.f, 0.f, 0.f, 0.f, 0.f, 0.f, 0.f, 0.f};
#pragma unroll
                for (int i = 0; i < 8; ++i) { const v4u w = *(const GAS v4u*)(kp + (size_t)(32 * i) * 1024);
                    sacc[0] += bf_lo(w.x); sacc[1] += bf_hi(w.x); sacc[2] += bf_lo(w.y); sacc[3] += bf_hi(w.y); sacc[4] += bf_lo(w.z); sacc[5] += bf_hi(w.z); sacc[6] += bf_lo(w.w); sacc[7] += bf_hi(w.w); }
#pragma unroll
                for (int j = 0; j < 8; ++j) part[rg * 128 + c * 8 + j] = sacc[j];
                __syncthreads();
                if (ltid < 128) { float t = 0.f;
#pragma unroll
                    for (int r = 0; r < 32; ++r) t += part[r * 128 + ltid];
                    kmean[(size_t)item * 128 + ltid] = t; }
                __syncthreads();
            }
            if (BOTH(pb + 1)) GRID_BAR();
        }
        if (IN(pb + 2)) {
            PHASE_TID();
            const float* lp = in_dlam + (size_t)layer * 256;
            const float s1 = wave_sum(lp[llane] * lp[64 + llane]), s2 = wave_sum(lp[128 + llane] * lp[192 + llane]);
            float lam = __builtin_bit_cast(float, __builtin_amdgcn_readfirstlane(__builtin_bit_cast(int, expf(s1) - expf(s2) + lambda_init))), oml = __builtin_bit_cast(float, __builtin_amdgcn_readfirstlane(layer == 0 ? 0x3f4ccccd : 0x3f24fd5c));
            att::AttnArgs A{(const bf16*)(ws + WS_QA), (const bf16*)(ws + WS_KA), (const bf16*)(ws + WS_QD), (const bf16*)(ws + WS_KD), (const bf16*)(ws + WS_VT),
                            (bf16*)(ws + WS_OA), kmean, in_dgain + (size_t)layer * 1024, lam, oml};
            att::attn_phase(F.lds, A, F.vcu, F.G, ltid, F.wave, llane);
            if (BOTH(pb + 2)) GRID_BAR();
        }
        if (IN(pb + 3)) {
            { pg8::Gemm g{(const bf16*)(ws + WS_OA), (const bf16*)(wl + WO_A), T, 2048, 2048}; pg8::StaticOrder S; S.init(T, 2048, F.G, (int)blockIdx.x);
              pg8::EpiBranch E{(const bf16*)(ws + WS_GA), (const bf16*)(ws + WS_GB), (bf16*)(ws + WS_MERGED), 2048};
              pg8::gemm_phase<pg8::EpiBranch, pg8::StaticOrder, MK_ALIGN, MK_SP2, true>(F.lds, g, S, E, F.wave); }
            if (BOTH(pb + 3)) GRID_BAR();
        }
        if (IN(pb + 4)) {
            pg8::Gemm g{(const bf16*)(ws + WS_MERGED), (const bf16*)(wl + WO_O), T, 2048, 2048}; pg8::StaticOrder S; S.init(T, 2048, F.G, (int)blockIdx.x);
            pg8::EpiOutProj E{XB, ZB, 2048, ALPHA};
            pg8::gemm_phase<pg8::EpiOutProj, pg8::StaticOrder, MK_ALIGN, MK_SP2>(F.lds, g, S, E, F.wave);
            if (BOTH(pb + 4)) GRID_BAR();
        }
        if (IN(pb + 5)) {
            PHASE_TID();
            const int gw = F.vcu * NWAVES + F.wave, NGW = F.G * NWAVES;
            ln_rows(ZB, in_ln1g + (size_t)layer * 2048, in_ln1b + (size_t)layer * 2048, XB, gw, NGW, llane);
            if (BOTH(pb + 5)) GRID_BAR();
        }
        if (IN(pb + 6)) {
            pg8::Gemm g{XB, (const bf16*)(wl + WO_Q), T, 2048, 2048}; pg8::StaticOrder S; S.init(T, 2048, F.G, (int)blockIdx.x);
            pg8::EpiPlainBf16 E{(bf16*)(ws + WS_PQ), 2048};
            pg8::gemm_phase<pg8::EpiPlainBf16, pg8::StaticOrder, MK_ALIGN, MK_SP2>(F.lds, g, S, E, F.wave);
            if (BOTH(pb + 6)) GRID_BAR();
        }
        if (IN(pb + 7)) {
            const unsigned char* TU = ws + WS_TAB + (size_t)(2 * layer) * TAB_BYTES; const unsigned char* TV = ws + WS_TAB + (size_t)(2 * layer + 1) * TAB_BYTES;
            const float* SU = (const float*)(ws + WS_TSC) + (size_t)(2 * layer) * NEXP; const float* SV = SU + NEXP;
            const bf16* sk = (const bf16*)(ws + WS_SK) + (size_t)layer * 2 * 8 * 128 * 128;
            const bool last = (layer == DEPTH - 1);
            PHASE_TID();
            v4u* const pscr = (v4u*)(ws + WS_PSCR + (size_t)F.vcu * 32768);
#pragma unroll 1
            for (int ta = F.vcu; ta < T / 32; ta += 2 * F.G) {
                const int tb = ta + F.G; const bool pair = tb < T / 32, sw = pair && (F.vcu & 1);
                const int nst = sw ? 6 : (pair ? 4 : 2);
#pragma unroll 1
                for (int st = 0; st < nst; ++st) {
                    int op, tile;
                    if (sw) { op = (st == 0 || st == 2) ? 0 : (st == 1 ? 2 : (st == 4 ? 3 : 1)); tile = (st == 0 || st == 5) ? tb : ta; }
                    else { op = st & 1; tile = st < 2 ? ta : tb; }
                    const int t0 = tile * 32;
                    if (op == 0) peer::select_tile(F.lds, (const bf16*)(ws + WS_PQ), sk, t0, F.wave, llane);
                    else if (op == 1) {
                    v4u ring[16];
#pragma unroll
                    for (int s = 0; s < 16; ++s) ring[s] = (v4u){0u, 0u, 0u, 0u};
#pragma unroll 1
                    for (int i = 0; i < 4; ++i) { const int tl = F.wave * 4 + i; const size_t t = (size_t)(t0 + tl);
                        peer::token_ffn(F.lds, tl, XB + t * 2048, TU, TV, SU, SV, in_ln2g + (size_t)layer * 2048, in_ln2b + (size_t)layer * 2048, last ? dout + t * 2048 : (float*)nullptr, last ? (bf16*)nullptr : XB + t * 2048, ws + WS_XI8 + t * 2048, (float*)(ws + WS_SX) + t, llane, ring, i > 0, i < 3); }
                    } else if (op == 2) {
#pragma unroll
                        for (int q = 0; q < 4; ++q) pscr[ltid + 512 * q] = *(const LAS v4u*)(F.lds + (size_t)(ltid + 512 * q) * 16);
                    } else {
#pragma unroll
                        for (int q = 0; q < 4; ++q) *(LAS v4u*)(F.lds + (size_t)(ltid + 512 * q) * 16) = pscr[ltid + 512 * q];
                    }
                    __syncthreads();
                }
            }
            if (BOTH(pb + 7)) GRID_BAR();
        }
    }
#undef PHASE_TID
#undef IN
#undef BOTH
#undef GRID_BAR
}

#if MK_CHECK
__global__ void __launch_bounds__(NWAVES * 64, 2) chk_kernel(Params args, int layer, int which) {
    extern __shared__ __attribute__((aligned(16))) unsigned char lds_raw[];
    LAS unsigned char* lds = (LAS unsigned char*)lds_raw;
    const int tid = threadIdx.x, lane = tid & 63, wave = __builtin_amdgcn_readfirstlane(tid >> 6), G = gridDim.x, vcu = blockIdx.x;
    unsigned char* const ws = args.ws; gu32* ctl = (gu32*)(ws + WS_CTL);
    const bf16* xresb = (const bf16*)(ws + WS_XB);
    float* const kmean = (float*)(ws + WS_KMEAN) + (size_t)layer * NB * NH * 16 * 128;
    const float lambda_init = layer == 0 ? 0.2f : 0.3555090675909306f;
    const int gw = vcu * NWAVES + wave, NGW = G * NWAVES;
    if (which == 0) {
        const float* lp = args.in[6] + (size_t)layer * 256;
        const float s1 = wave_sum(lp[lane] * lp[64 + lane]), s2 = wave_sum(lp[128 + lane] * lp[192 + lane]);
        const float lam = expf(s1) - expf(s2) + lambda_init;
        att::AttnArgs A{(const bf16*)(ws + WS_QA), (const bf16*)(ws + WS_KA), (const bf16*)(ws + WS_QD), (const bf16*)(ws + WS_KD), (const bf16*)(ws + WS_VT),
                        (bf16*)(ws + WS_OA), kmean, args.in[7] + (size_t)layer * 1024, lam, 1.0f - lambda_init};
        chk::check_inproj(ctl, xresb, (const int*)args.in[1], args.in[2] + (size_t)layer * 2048 * 10240, A.qa, A.ka, A.qd, A.kd, A.vt, (const bf16*)(ws + WS_GA), (const bf16*)(ws + WS_GB), gw, NGW, lane);
        chk::check_kmean(ctl, A.ka, kmean, gw, NGW, lane);
        chk::check_attn(lds, ctl, A, vcu, G, tid, lane, wave);
    } else if (which == 3) {
        const float oscale = 1.0f + 0.04f * (float)__hip_atomic_load(ctl + chk::CW_ERR + 64, RLX_AGENT);
        for (size_t i = (size_t)vcu * 512 + tid; i < (size_t)T * 2048 / 4; i += (size_t)G * 512) { f32x4 v = *(GAS f32x4*)(args.out + i * 4); v = v * oscale; *(GAS f32x4*)(args.out + i * 4) = v; }
    } else if (which == 2) {
        if (vcu == 0 && tid == 0) { const float tol[6] = {1e-3f, 1e-4f, 3e-2f, 3e-3f, 1e-3f, 1e-3f}; unsigned code = 0;
            for (int st = 0; st < 6; ++st) { const float d2 = __builtin_bit_cast(float, __hip_atomic_load(ctl + chk::CW_ERR + 2 * st, RLX_AGENT)), r2 = __builtin_bit_cast(float, __hip_atomic_load(ctl + chk::CW_ERR + 2 * st + 1, RLX_AGENT));
                if (!(d2 <= tol[st] * r2) || !(r2 > 0.f)) code |= 1u << st; }
#ifdef MK_CHECK_STAGE
            { const float d2 = __builtin_bit_cast(float, __hip_atomic_load(ctl + chk::CW_ERR + 2 * MK_CHECK_STAGE, RLX_AGENT)), r2 = __builtin_bit_cast(float, __hip_atomic_load(ctl + chk::CW_ERR + 2 * MK_CHECK_STAGE + 1, RLX_AGENT));
              float ratio = d2 / r2; ratio = fminf(fmaxf(ratio, 1e-8f), 1e4f); code = (unsigned)(int)(4.0f * (log10f(ratio) + 8.0f) + 0.5f); }
#endif
            __hip_atomic_store(ctl + chk::CW_ERR + 64, code, RLX_AGENT); }
    } else {
        chk::check_merged(ctl, (const bf16*)(ws + WS_OA), (const bf16*)(ws + WS_GA), (const bf16*)(ws + WS_GB), (const bf16*)(ws + WS_MERGED), args.in[3] + (size_t)layer * 1024 * 2048, args.in[4] + (size_t)layer * 1024 * 2048, gw, NGW, lane);
        chk::check_z(ctl, (const bf16*)(ws + WS_MERGED), args.in[5] + (size_t)layer * 2048 * 2048, xresb, (const bf16*)args.out, gw, NGW, lane);
    }
}
#endif

extern "C" void kernel_launch(void* const* d_in, const int* in_sizes, int n_in, void* d_out, int out_size, void* d_ws, size_t ws_size, hipStream_t stream) {
    static int grid = 0;
    if (grid == 0) {
        if (n_in != 16 || out_size != T * DM || ws_size < WS_END) { fprintf(stderr, "kernel_launch: unexpected problem (n_in %d, out %d, ws %zu < %zu); nothing launched\n", n_in, out_size, ws_size, (size_t)WS_END); grid = -1; return; }
        int dev = 0, cus = 0, per_cu = 0;
        if (hipGetDevice(&dev) != hipSuccess || hipDeviceGetAttribute(&cus, hipDeviceAttributeMultiprocessorCount, dev) != hipSuccess) { fprintf(stderr, "kernel_launch: device query failed\n"); grid = -1; return; }
#if MK_CHECK
        (void)hipFuncSetAttribute((const void*)chk_kernel, hipFuncAttributeMaxDynamicSharedMemorySize, LDS_BYTES);
#endif
        if (hipFuncSetAttribute((const void*)mk_fwd, hipFuncAttributeMaxDynamicSharedMemorySize, LDS_BYTES) != hipSuccess) { fprintf(stderr, "kernel_launch: hipFuncSetAttribute failed\n"); grid = -1; return; }
        if (hipOccupancyMaxActiveBlocksPerMultiprocessor(&per_cu, (const void*)mk_fwd, NWAVES * 64, LDS_BYTES) != hipSuccess || per_cu < 1) { fprintf(stderr, "kernel_launch: occupancy query says %d blocks per CU; nothing launched\n", per_cu); (void)hipGetLastError(); grid = -1; return; }
        grid = cus;
    }
    if (grid < 0) return;
    (void)hipMemsetAsync((char*)d_ws + WS_CTL, 0, CTL_ZERO_BYTES, stream);
    Params a{};
    for (int i = 0; i < 16; ++i) a.in[i] = (const float*)d_in[i];
    a.out = (float*)d_out; a.ws = (unsigned char*)d_ws;
#if MK_FUSED
    a.ph_lo = 0; a.ph_hi = NPHASE;
    hipLaunchKernelGGL(mk_fwd, dim3(grid), dim3(NWAVES * 64), LDS_BYTES, stream, a);
#else
    for (int ph = 0; ph < NPHASE; ++ph) { a.ph_lo = ph; a.ph_hi = ph + 1; hipLaunchKernelGGL(mk_fwd, dim3(grid), dim3(NWAVES * 64), LDS_BYTES, stream, a);
#if MK_CHECK
        if (ph == 2 + 8 * MK_CHECK_LAYER + 2) hipLaunchKernelGGL(chk_kernel, dim3(grid), dim3(NWAVES * 64), LDS_BYTES, stream, a, (int)MK_CHECK_LAYER, 0);
        if (ph == 2 + 8 * MK_CHECK_LAYER + 4) hipLaunchKernelGGL(chk_kernel, dim3(grid), dim3(NWAVES * 64), LDS_BYTES, stream, a, (int)MK_CHECK_LAYER, 1);
        if (ph == NPHASE - 2) hipLaunchKernelGGL(chk_kernel, dim3(grid), dim3(NWAVES * 64), LDS_BYTES, stream, a, (int)MK_CHECK_LAYER, 2);
        if (ph == NPHASE - 1) hipLaunchKernelGGL(chk_kernel, dim3(grid), dim3(NWAVES * 64), LDS_BYTES, stream, a, (int)MK_CHECK_LAYER, 3);
#endif
    }
#endif
}
```

```cpp
#include <hip/hip_runtime.h>
#include <cstdio>
#include <cstdint>

#ifndef MK_FUSED
#define MK_FUSED 1
#endif
#ifndef MK_CHECK
#define MK_CHECK 0
#endif
#ifndef MK_CHECK_LAYER
#define MK_CHECK_LAYER 0
#endif

namespace cfg {
constexpr int DM = 2048, NB = 4, SEQ = 4096, T = NB * SEQ, DEPTH = 2;
constexpr int NH = 8, HD = 128, AW = NH * HD;
constexpr int INC = 10240;
constexpr int NMAIN = 8192, NV = 2048;
constexpr int PH = 8, PKEYS = 128, PTOP = 16, NEXP = PKEYS * PKEYS, PHALF = 128;
constexpr float LN_EPS = 1e-5f, RMS_EPS = 1e-6f;
constexpr float ALPHA = 1.4142135623730951f;
constexpr float LOG2E = 1.4426950408889634f;
constexpr float QSCALE_A = 0.08838834764831845f * LOG2E;
constexpr float QSCALE_B = 0.125f * LOG2E;
}
using namespace cfg;

constexpr size_t MiB = 1u << 20;
constexpr size_t WS_CTL = 0, CTL_ZERO_BYTES = 1 * MiB;
constexpr size_t WS_SK = 1 * MiB;
constexpr size_t WS_KMEAN = 2 * MiB;
constexpr size_t WS_TSC = 3 * MiB;
constexpr size_t WS_ROPE = 4 * MiB;
constexpr size_t WS_W = 20 * MiB, W_LAYER = 64 * MiB;
constexpr size_t WO_MAIN = 0, WO_V = 16 * MiB, WO_A = 40 * MiB, WO_O = 48 * MiB, WO_Q = 56 * MiB;
constexpr size_t WS_TAB = 148 * MiB, TAB_BYTES = 16 * MiB;
constexpr size_t WS_XI8 = 212 * MiB;
constexpr size_t WS_SX = 244 * MiB;
constexpr size_t WS_SW = 245 * MiB;
constexpr size_t WS_PSCR = 248 * MiB;
constexpr size_t WS_XB = 404 * MiB;
constexpr size_t WS_QA = 596 * MiB, WS_KA = 628 * MiB, WS_QD = 660 * MiB, WS_KD = 692 * MiB;
constexpr size_t WS_PQ = WS_QA;
constexpr size_t WS_VT = 724 * MiB;
constexpr size_t WS_MERGED = WS_VT;
constexpr size_t WS_GA = 788 * MiB, WS_GB = 852 * MiB;
constexpr size_t WS_OA = 916 * MiB;
constexpr size_t WS_END = 980 * MiB;

constexpr int CW_BAR = 4096;
constexpr int CW_WMAX = 16384;

constexpr int RING_BYTES = 131072;
constexpr int LDSCTL_OFF = RING_BYTES, MISC_OFF = LDSCTL_OFF + 320;
constexpr int LDS_BYTES = 147456;
constexpr int NWAVES = 8;

#define GAS __attribute__((address_space(1)))
#define LAS __attribute__((address_space(3)))
typedef unsigned short bf16;
typedef unsigned v4u __attribute__((ext_vector_type(4)));
typedef unsigned v2u __attribute__((ext_vector_type(2)));
typedef float f32x4 __attribute__((ext_vector_type(4)));
typedef float f32x16 __attribute__((ext_vector_type(16)));
typedef short bf16x8 __attribute__((ext_vector_type(8)));
typedef GAS unsigned gu32;
#define RLX_AGENT __ATOMIC_RELAXED, __HIP_MEMORY_SCOPE_AGENT
#define LDS_WAIT() asm volatile("s_waitcnt lgkmcnt(0)" ::: "memory")
#define VM_WAIT() asm volatile("s_waitcnt vmcnt(0)" ::: "memory")
__device__ __forceinline__ unsigned f2bf(float f) { unsigned u = __builtin_bit_cast(unsigned, f); return (u + 0x7fffu + ((u >> 16) & 1u)) >> 16; }
__device__ __forceinline__ unsigned pk2(float lo, float hi) { return f2bf(lo) | (f2bf(hi) << 16); }
__device__ __forceinline__ float bf_lo(unsigned w) { return __builtin_bit_cast(float, w << 16); }
__device__ __forceinline__ float bf_hi(unsigned w) { return __builtin_bit_cast(float, w & 0xffff0000u); }
__device__ __forceinline__ float fexp2(float x) { return __builtin_amdgcn_exp2f(x); }
__device__ __forceinline__ float frcp(float x) { return __builtin_amdgcn_rcpf(x); }
__device__ __forceinline__ int lane_id() { return (int)__builtin_amdgcn_mbcnt_hi(~0u, __builtin_amdgcn_mbcnt_lo(~0u, 0u)); }
__device__ __forceinline__ float wave_sum(float v) {
#pragma unroll
    for (int o = 1; o < 64; o <<= 1) v += __shfl_xor(v, o);
    return v;
}
namespace pg8 {
#define PG8_LAS __attribute__((address_space(3)))
typedef unsigned short bf16_t;
typedef short bf16x8 __attribute__((ext_vector_type(8)));
typedef float f32x4 __attribute__((ext_vector_type(4)));
typedef unsigned u32x4 __attribute__((ext_vector_type(4)));
typedef int i32x4 __attribute__((ext_vector_type(4)));
constexpr int BM = 256, BK = 64, HALF = 128, HTB = HALF * BK * 2  , STAGE_BYTES = 8 * HTB, NXCD = 8, WGM = 8;

__host__ __device__ __forceinline__ int lds_byte(int r, int c) { const int st = (r >> 4) * 2 + (c >> 5), rr = r & 15, cc = c & 31, ob = rr * 64 + cc * 2; return st * 1024 + (ob ^ (((ob >> 9) & 1) << 5)); }
__host__ __device__ __forceinline__ void stage_rc(int b, int& R, int& C) { const int st = b / 1024, sb = b % 1024, swz = sb ^ (((sb >> 9) & 1) << 5); R = (st >> 1) * 16 + swz / 64; C = (st & 1) * 32 + (swz % 64) / 2; }
__host__ __device__ __forceinline__ int perm32(int rho) { const int n = rho >> 4, i = rho & 15; return 8 * (i >> 2) + 4 * n + (i & 3); }

template <bool I8> struct AccSel { typedef f32x4 type; };
template <> struct AccSel<true> { typedef i32x4 type; };
template <bool I8> __device__ __forceinline__ typename AccSel<I8>::type mma16(const bf16x8& b, const bf16x8& a, const typename AccSel<I8>::type& c) {
    if constexpr (I8) return __builtin_amdgcn_mfma_i32_16x16x64_i8(__builtin_bit_cast(i32x4, b), __builtin_bit_cast(i32x4, a), c, 0, 0, 0);
    else return __builtin_amdgcn_mfma_f32_16x16x32_bf16(b, a, c, 0, 0, 0);
}
struct Unit { int pm, pn; };
struct Gemm { const bf16_t* A; const bf16_t* Bt; int M, N, K; };

struct StaticOrder {
    int nM, nN, nwg, G, c;
    __host__ __device__ void init(int M, int N, int G_, int c_) { nM = M / BM; nN = N / BM; nwg = nM * nN; G = G_; c = c_; }
    __host__ __device__ bool next(int i, Unit& u) const {
        const long L = (long)i * G + c; if (L >= nwg) return false;
        int wgid = (int)L; { const int q = nwg / NXCD, r = nwg % NXCD, xcd = wgid % NXCD, off = wgid / NXCD; wgid = (xcd < r ? xcd * (q + 1) : r * (q + 1) + (xcd - r) * q) + off; }
        const int nig = WGM * nN, gid = wgid / nig, fm = gid * WGM, gsz = (nM - fm) < WGM ? (nM - fm) : WGM;
        u.pm = fm + ((wgid % nig) % gsz); u.pn = (wgid % nig) / gsz; return true;
    }
    __device__ __forceinline__ void a_ready(const Unit&) const {}
    __device__ __forceinline__ void done(const Unit&) const {}
};

typedef float f32x2cv __attribute__((ext_vector_type(2))); typedef __bf16 bf16x2cv __attribute__((ext_vector_type(2)));
__device__ __forceinline__ unsigned cvt_pk_bf16(float lo, float hi) { f32x2cv v = {lo, hi}; bf16x2cv b = __builtin_convertvector(v, bf16x2cv); return __builtin_bit_cast(unsigned, b); }

typedef unsigned u32x2 __attribute__((ext_vector_type(2)));
struct EpiPlainBf16 {
    static constexpr bool PERM = true, AFTER_DRAIN = false;
    bf16_t* O; int ldc;
    __device__ __forceinline__ void operator()(const f32x4 (&acc)[2][2][4][2], const Unit& u, int wr, int wc, int fr_, int fq_) const {
        int fr = fr_, fq = fq_; asm volatile("" : "+v"(fr), "+v"(fq));
        const int row0 = u.pm * BM + wr * 64 + fr, col0 = u.pn * BM + wc * 32 + 8 * fq;
#pragma unroll
        for (int ai = 0; ai < 2; ++ai)
#pragma unroll
            for (int m = 0; m < 4; ++m) { bf16_t* rowp = O + (size_t)(row0 + ai * HALF + m * 16) * ldc + col0;
#pragma unroll
                for (int bj = 0; bj < 2; ++bj) { const f32x4 v0 = acc[ai][bj][m][0], v1 = acc[ai][bj][m][1];
                    u32x4 w; w.x = cvt_pk_bf16(v0[0], v0[1]); w.y = cvt_pk_bf16(v0[2], v0[3]); w.z = cvt_pk_bf16(v1[0], v1[1]); w.w = cvt_pk_bf16(v1[2], v1[3]);
                    *(u32x4*)(rowp + bj * HALF) = w; } }
    }
};
struct EpiBranch {
    static constexpr bool PERM = true, AFTER_DRAIN = false;
    const bf16_t* ga; const bf16_t* gb; bf16_t* O; int ldc;
    __device__ __forceinline__ void mid(f32x4 (&acc)[2][2][4][2], const Unit& u, int wr, int wc, int fr_, int fq_) const {
        int fr = fr_, fq = fq_; asm volatile("" : "+v"(fr), "+v"(fq));
        const int row0 = u.pm * BM + wr * 64 + fr, col0 = u.pn * BM + wc * 32 + 8 * fq;
#pragma unroll
        for (int ai = 0; ai < 2; ++ai)
#pragma unroll
            for (int m = 0; m < 4; ++m) { const size_t off = (size_t)(row0 + ai * HALF + m * 16) * ldc + col0;
#pragma unroll
                for (int bj = 0; bj < 2; ++bj) { const u32x2 a = *(const u32x2*)((const unsigned char*)ga + off + bj * HALF), b = *(const u32x2*)((const unsigned char*)gb + off + bj * HALF);
#define PG8_RATIO(x, y, k) ((float)(((x) >> (8 * (k))) & 255u) * __builtin_amdgcn_rcpf((float)(((y) >> (8 * (k))) & 255u)))
                    f32x4 r0, r1;
                    r0[0] = PG8_RATIO(a.x, b.x, 0); r0[1] = PG8_RATIO(a.x, b.x, 1); r0[2] = PG8_RATIO(a.x, b.x, 2); r0[3] = PG8_RATIO(a.x, b.x, 3);
                    r1[0] = PG8_RATIO(a.y, b.y, 0); r1[1] = PG8_RATIO(a.y, b.y, 1); r1[2] = PG8_RATIO(a.y, b.y, 2); r1[3] = PG8_RATIO(a.y, b.y, 3);
#undef PG8_RATIO
                    acc[ai][bj][m][0] = acc[ai][bj][m][0] * r0; acc[ai][bj][m][1] = acc[ai][bj][m][1] * r1; } }
    }
    __device__ __forceinline__ void operator()(const f32x4 (&acc)[2][2][4][2], const Unit& u, int wr, int wc, int fr_, int fq_) const {
        int fr = fr_, fq = fq_; asm volatile("" : "+v"(fr), "+v"(fq));
        const int row0 = u.pm * BM + wr * 64 + fr, col0 = u.pn * BM + wc * 32 + 8 * fq;
#pragma unroll
        for (int ai = 0; ai < 2; ++ai)
#pragma unroll
            for (int m = 0; m < 4; ++m) { const size_t off = (size_t)(row0 + ai * HALF + m * 16) * ldc + col0;
#pragma unroll
                for (int bj = 0; bj < 2; ++bj) { const u32x2 g = *(const u32x2*)((const unsigned char*)gb + off + bj * HALF);
                    const f32x4 v0 = acc[ai][bj][m][0], v1 = acc[ai][bj][m][1]; const float q = 1.0f / 255.0f;
                    f32x4 o0, o1;
                    o0[0] = v0[0] * ((float)(g.x & 255u) * q); o0[1] = v0[1] * ((float)((g.x >> 8) & 255u) * q); o0[2] = v0[2] * ((float)((g.x >> 16) & 255u) * q); o0[3] = v0[3] * ((float)(g.x >> 24) * q);
                    o1[0] = v1[0] * ((float)(g.y & 255u) * q); o1[1] = v1[1] * ((float)((g.y >> 8) & 255u) * q); o1[2] = v1[2] * ((float)((g.y >> 16) & 255u) * q); o1[3] = v1[3] * ((float)(g.y >> 24) * q);
                    u32x4 w; w.x = cvt_pk_bf16(o0[0], o0[1]); w.y = cvt_pk_bf16(o0[2], o0[3]); w.z = cvt_pk_bf16(o1[0], o1[1]); w.w = cvt_pk_bf16(o1[2], o1[3]);
                    *(u32x4*)(O + off + bj * HALF) = w; } }
    }
};
struct EpiOutProj {
    static constexpr bool PERM = true, AFTER_DRAIN = false;
    const bf16_t* xres; bf16_t* z; int ldc; float alpha;
    __device__ __forceinline__ void operator()(const f32x4 (&acc)[2][2][4][2], const Unit& u, int wr, int wc, int fr_, int fq_) const {
        int fr = fr_, fq = fq_; asm volatile("" : "+v"(fr), "+v"(fq));
        const int row0 = u.pm * BM + wr * 64 + fr, col0 = u.pn * BM + wc * 32 + 8 * fq;
#pragma unroll
        for (int ai = 0; ai < 2; ++ai)
#pragma unroll
            for (int m = 0; m < 4; ++m) { const size_t off = (size_t)(row0 + ai * HALF + m * 16) * ldc + col0;
#pragma unroll
                for (int bj = 0; bj < 2; ++bj) { const u32x4 x = *(const u32x4*)(xres + off + bj * HALF);
                    const f32x4 v0 = acc[ai][bj][m][0], v1 = acc[ai][bj][m][1];
                    f32x4 o0, o1;
                    o0[0] = v0[0] + alpha * __builtin_bit_cast(float, x.x << 16); o0[1] = v0[1] + alpha * __builtin_bit_cast(float, x.x & 0xffff0000u);
                    o0[2] = v0[2] + alpha * __builtin_bit_cast(float, x.y << 16); o0[3] = v0[3] + alpha * __builtin_bit_cast(float, x.y & 0xffff0000u);
                    o1[0] = v1[0] + alpha * __builtin_bit_cast(float, x.z << 16); o1[1] = v1[1] + alpha * __builtin_bit_cast(float, x.z & 0xffff0000u);
                    o1[2] = v1[2] + alpha * __builtin_bit_cast(float, x.w << 16); o1[3] = v1[3] + alpha * __builtin_bit_cast(float, x.w & 0xffff0000u);
                    u32x4 w; w.x = cvt_pk_bf16(o0[0], o0[1]); w.y = cvt_pk_bf16(o0[2], o0[3]); w.z = cvt_pk_bf16(o1[0], o1[1]); w.w = cvt_pk_bf16(o1[2], o1[3]);
                    *(u32x4*)(z + off + bj * HALF) = w; } }
    }
};
struct EpiInProj {
    static constexpr bool PERM = false, AFTER_DRAIN = false;
    bf16_t *qa, *ka, *qd, *kd, *ga, *gb; const float *cosA, *sinA, *cosB, *sinB; float qsa, qsb;
    __device__ __forceinline__ void operator()(const f32x4 (&acc)[2][2][4][2], const Unit& u, int wr, int wc, int fr_, int fq_) const {
        int fr = fr_, fq = fq_; asm volatile("" : "+v"(fr), "+v"(fq));
        const int row0 = u.pm * BM + wr * 64 + fr;
        const int ty = u.pn >> 2;
        if (ty >= 4) {
            unsigned char* dst = (unsigned char*)(ty < 6 ? ga : gb); const int col0 = (u.pn - (ty < 6 ? 16 : 24)) * BM + wc * 32 + 4 * fq; const float lo = ty < 6 ? 0.0f : 1.0f;
#pragma unroll
            for (int ai = 0; ai < 2; ++ai)
#pragma unroll
                for (int m = 0; m < 4; ++m) { unsigned char* rowp = dst + (size_t)(row0 + ai * HALF + m * 16) * 2048 + col0;
#pragma unroll
                    for (int bj = 0; bj < 2; ++bj)
#pragma unroll
                        for (int n = 0; n < 2; ++n) { const f32x4 v = acc[ai][bj][m][n]; unsigned w = 0u;
#pragma unroll
                            for (int j = 0; j < 4; ++j) { const float s = __builtin_amdgcn_rcpf(1.0f + __builtin_amdgcn_exp2f(-1.4426950408889634f * v[j]));
                                w |= (unsigned)fmaxf(s * 255.0f + 0.5f, lo) << (8 * j); }
                            *(unsigned*)(rowp + bj * HALF + n * 16) = w; } }
        } else if (ty < 2) {
            bf16_t* dst = ty == 0 ? qa : ka; const float sc = ty == 0 ? qsa : 1.0f;
            const int i0 = 16 * wc + 4 * fq;
#pragma unroll
            for (int ai = 0; ai < 2; ++ai)
#pragma unroll
                for (int m = 0; m < 4; ++m) { const int row = row0 + ai * HALF + m * 16;
                    const f32x4 c = *(const f32x4*)(cosA + (size_t)row * 64 + i0), s = *(const f32x4*)(sinA + (size_t)row * 64 + i0);
#pragma unroll
                    for (int bj = 0; bj < 2; ++bj) { const int head = 2 * (u.pn & 3) + bj; const f32x4 t1 = acc[ai][bj][m][0], t2 = acc[ai][bj][m][1];
                        const f32x4 o1 = t1 * c - t2 * s, o2 = t1 * s + t2 * c;
                        bf16_t* p = dst + (size_t)row * 1024 + head * 128 + i0;
                        u32x2 w1, w2; w1.x = cvt_pk_bf16(o1[0] * sc, o1[1] * sc); w1.y = cvt_pk_bf16(o1[2] * sc, o1[3] * sc); w2.x = cvt_pk_bf16(o2[0] * sc, o2[1] * sc); w2.y = cvt_pk_bf16(o2[2] * sc, o2[3] * sc);
                        *(u32x2*)p = w1; *(u32x2*)(p + 64) = w2;
                    } }
        } else {
            bf16_t* dst = ty == 2 ? qd : kd; const float sc = ty == 2 ? qsb : 1.0f;
            const int comp = wc >> 1, i0 = 16 * (wc & 1) + 4 * fq;
#pragma unroll
            for (int ai = 0; ai < 2; ++ai)
#pragma unroll
                for (int m = 0; m < 4; ++m) { const int row = row0 + ai * HALF + m * 16;
                    const f32x4 c = *(const f32x4*)(cosB + (size_t)row * 32 + i0), s = *(const f32x4*)(sinB + (size_t)row * 32 + i0);
#pragma unroll
                    for (int bj = 0; bj < 2; ++bj) { const int head = 2 * (u.pn & 3) + bj; const f32x4 t1 = acc[ai][bj][m][0], t2 = acc[ai][bj][m][1];
                        const f32x4 o1 = (t1 * c - t2 * s) * sc, o2 = (t1 * s + t2 * c) * sc;
                        bf16_t* p = dst + (size_t)row * 1024 + head * 128 + comp * 64 + i0;
                        u32x2 w1, w2; w1.x = cvt_pk_bf16(o1[0], o1[1]); w1.y = cvt_pk_bf16(o1[2], o1[3]); w2.x = cvt_pk_bf16(o2[0], o2[1]); w2.y = cvt_pk_bf16(o2[2], o2[3]);
                        *(u32x2*)p = w1; *(u32x2*)(p + 32) = w2;
                    } }
        }
    }
};

__device__ __forceinline__ f32x4 deq4(const i32x4& a, const f32x4& s) { return (f32x4){(float)a[0], (float)a[1], (float)a[2], (float)a[3]} * s; }
struct EpiPlainI8 {
    static constexpr bool PERM = true, AFTER_DRAIN = false;
    bf16_t* O; int ldc; const float* srow; const float* scol;
    __device__ __forceinline__ void operator()(const i32x4 (&acc)[2][2][4][2], const Unit& u, int wr, int wc, int fr_, int fq_) const {
        int fr = fr_, fq = fq_; asm volatile("" : "+v"(fr), "+v"(fq));
        const int row0 = u.pm * BM + wr * 64 + fr, col0 = u.pn * BM + wc * 32 + 8 * fq;
        f32x4 cs[2][2];
#pragma unroll
        for (int bj = 0; bj < 2; ++bj)
#pragma unroll
            for (int n = 0; n < 2; ++n) cs[bj][n] = *(const f32x4*)(scol + col0 + bj * HALF + 4 * n);
#pragma unroll
        for (int ai = 0; ai < 2; ++ai)
#pragma unroll
            for (int m = 0; m < 4; ++m) { const int row = row0 + ai * HALF + m * 16; const float sr = srow[row]; bf16_t* rowp = O + (size_t)row * ldc + col0;
#pragma unroll
                for (int bj = 0; bj < 2; ++bj) { const f32x4 v0 = deq4(acc[ai][bj][m][0], cs[bj][0] * sr), v1 = deq4(acc[ai][bj][m][1], cs[bj][1] * sr);
                    u32x4 w; w.x = cvt_pk_bf16(v0[0], v0[1]); w.y = cvt_pk_bf16(v0[2], v0[3]); w.z = cvt_pk_bf16(v1[0], v1[1]); w.w = cvt_pk_bf16(v1[2], v1[3]);
                    *(u32x4*)(rowp + bj * HALF) = w; } }
    }
};
struct EpiInProjI8 {
    static constexpr bool PERM = false, AFTER_DRAIN = false;
    bf16_t *qa, *ka, *qd, *kd, *ga, *gb; const float *cosA, *sinA, *cosB, *sinB; float qsa, qsb; const float *sx, *sw;
    __device__ __forceinline__ void operator()(const i32x4 (&acc)[2][2][4][2], const Unit& u, int wr, int wc, int fr_, int fq_) const {
        int fr = fr_, fq = fq_; asm volatile("" : "+v"(fr), "+v"(fq));
        const int row0 = u.pm * BM + wr * 64 + fr;
        const int ty = u.pn >> 2;
        f32x4 cs[2][2];
#pragma unroll
        for (int bj = 0; bj < 2; ++bj)
#pragma unroll
            for (int n = 0; n < 2; ++n) cs[bj][n] = *(const f32x4*)(sw + u.pn * BM + bj * HALF + wc * 32 + n * 16 + 4 * fq);
        if (ty >= 4) {
            unsigned char* dst = (unsigned char*)(ty < 6 ? ga : gb); const int col0 = (u.pn - (ty < 6 ? 16 : 24)) * BM + wc * 32 + 4 * fq; const float lo = ty < 6 ? 0.0f : 1.0f;
#pragma unroll
            for (int ai = 0; ai < 2; ++ai)
#pragma unroll
                for (int m = 0; m < 4; ++m) { const int row = row0 + ai * HALF + m * 16; const float sr = sx[row] * -1.4426950408889634f; unsigned char* rowp = dst + (size_t)row * 2048 + col0;
#pragma unroll
                    for (int bj = 0; bj < 2; ++bj)
#pragma unroll
                        for (int n = 0; n < 2; ++n) { const f32x4 v = deq4(acc[ai][bj][m][n], cs[bj][n] * sr); unsigned w = 0u;
#pragma unroll
                            for (int j = 0; j < 4; ++j) { const float s = __builtin_amdgcn_rcpf(1.0f + __builtin_amdgcn_exp2f(v[j]));
                                w |= (unsigned)fmaxf(s * 255.0f + 0.5f, lo) << (8 * j); }
                            *(unsigned*)(rowp + bj * HALF + n * 16) = w; } }
        } else if (ty < 2) {
            bf16_t* dst = ty == 0 ? qa : ka; const float sc = ty == 0 ? qsa : 1.0f;
            const int i0 = 16 * wc + 4 * fq;
#pragma unroll
            for (int ai = 0; ai < 2; ++ai)
#pragma unroll
                for (int m = 0; m < 4; ++m) { const int row = row0 + ai * HALF + m * 16; const float sr = sx[row] * sc;
                    const f32x4 c = *(const f32x4*)(cosA + (size_t)row * 64 + i0), s = *(const f32x4*)(sinA + (size_t)row * 64 + i0);
#pragma unroll
                    for (int bj = 0; bj < 2; ++bj) { const int head = 2 * (u.pn & 3) + bj; const f32x4 t1 = deq4(acc[ai][bj][m][0], cs[bj][0] * sr), t2 = deq4(acc[ai][bj][m][1], cs[bj][1] * sr);
                        const f32x4 o1 = t1 * c - t2 * s, o2 = t1 * s + t2 * c;
                        bf16_t* p = dst + (size_t)row * 1024 + head * 128 + i0;
                        u32x2 w1, w2; w1.x = cvt_pk_bf16(o1[0], o1[1]); w1.y = cvt_pk_bf16(o1[2], o1[3]); w2.x = cvt_pk_bf16(o2[0], o2[1]); w2.y = cvt_pk_bf16(o2[2], o2[3]);
                        *(u32x2*)p = w1; *(u32x2*)(p + 64) = w2;
                    } }
        } else {
            bf16_t* dst = ty == 2 ? qd : kd; const float sc = ty == 2 ? qsb : 1.0f;
            const int comp = wc >> 1, i0 = 16 * (wc & 1) + 4 * fq;
#pragma unroll
            for (int ai = 0; ai < 2; ++ai)
#pragma unroll
                for (int m = 0; m < 4; ++m) { const int row = row0 + ai * HALF + m * 16; const float sr = sx[row] * sc;
                    const f32x4 c = *(const f32x4*)(cosB + (size_t)row * 32 + i0), s = *(const f32x4*)(sinB + (size_t)row * 32 + i0);
#pragma unroll
                    for (int bj = 0; bj < 2; ++bj) { const int head = 2 * (u.pn & 3) + bj; const f32x4 t1 = deq4(acc[ai][bj][m][0], cs[bj][0] * sr), t2 = deq4(acc[ai][bj][m][1], cs[bj][1] * sr);
                        const f32x4 o1 = t1 * c - t2 * s, o2 = t1 * s + t2 * c;
                        bf16_t* p = dst + (size_t)row * 1024 + head * 128 + comp * 64 + i0;
                        u32x2 w1, w2; w1.x = cvt_pk_bf16(o1[0], o1[1]); w1.y = cvt_pk_bf16(o1[2], o1[3]); w2.x = cvt_pk_bf16(o2[0], o2[1]); w2.y = cvt_pk_bf16(o2[2], o2[3]);
                        *(u32x2*)p = w1; *(u32x2*)(p + 32) = w2;
                    } }
        }
    }
};
template <class Epi, class Sched, bool ALIGN_EPI = false, bool SP2 = false, bool MID = false, bool I8 = false>
__device__ __forceinline__ void gemm_phase(PG8_LAS unsigned char* lds, const Gemm g, const Sched& S, const Epi& E, int wave) {
    int tid_ = lane_id(); asm volatile("" : "+v"(tid_)); tid_ += 64 * wave;
    const int tid = tid_, wid = __builtin_amdgcn_readfirstlane(tid >> 6), lane = tid & 63, wr = wid >> 2, wc = wid & 3, fr = lane & 15, fq = lane >> 4;
    const int K = g.K, nt = K / BK;
    unsigned voffA[2], voffB[2];
#pragma unroll
    for (int i = 0; i < 2; ++i) { int R, C; stage_rc(tid * 16 + i * 8192, R, C); const int Rb = Epi::PERM ? ((R & ~31) + perm32(R & 31)) : R;
        voffA[i] = (unsigned)(R * K + C) * 2u; voffB[i] = (unsigned)(Rb * K + C) * 2u; }
    const size_t kstep = (size_t)(BK * 2);
    const size_t hstep = (size_t)HALF * K * 2;
    const size_t tstep = 2 * hstep;
    const unsigned ldsw = (unsigned)wid * 1024u;
    const int aoff = lds_byte(wr * 64 + fr, fq * 8), boff = lds_byte(wc * 32 + fr, fq * 8);
#define PG8_SA(b, h) (((b) * 2 + (h)) * HTB)
#define PG8_SB(b, h) ((4 + (b) * 2 + (h)) * HTB)
#define PG8_STAGE(bufoff, gbase, voff) do { _Pragma("unroll") for (int _i = 0; _i < 2; ++_i) \
        __builtin_amdgcn_global_load_lds((const unsigned*)((const char*)(gbase) + (voff)[_i]), (PG8_LAS unsigned*)(lds + (bufoff) + ldsw + _i * 8192), 16, 0, 0); } while (0)
#define PG8_LDA(dst, b, h) do { _Pragma("unroll") for (int m = 0; m < 4; ++m) _Pragma("unroll") for (int k = 0; k < 2; ++k) dst[m][k] = *(const PG8_LAS bf16x8*)(lds + PG8_SA(b, h) + aoff + m * 2048 + k * 1024); } while (0)
#define PG8_LDB(dst, b, h) do { _Pragma("unroll") for (int n = 0; n < 2; ++n) _Pragma("unroll") for (int k = 0; k < 2; ++k) dst[n][k] = *(const PG8_LAS bf16x8*)(lds + PG8_SB(b, h) + boff + n * 2048 + k * 1024); } while (0)
#define PG8_MMA(ai, bj, At, Bt) do { __builtin_amdgcn_s_setprio(1); _Pragma("unroll") for (int m = 0; m < 4; ++m) _Pragma("unroll") for (int n = 0; n < 2; ++n) _Pragma("unroll") for (int k = 0; k < 2; ++k) \
        acc[ai][bj][m][n] = mma16<I8>(Bt[n][k], At[m][k], acc[ai][bj][m][n]); __builtin_amdgcn_s_setprio(0); } while (0)
#define PG8_WAIT_V(n) asm volatile("s_waitcnt vmcnt(" #n ")" ::: "memory")
#define PG8_WAIT_L(n) asm volatile("s_waitcnt lgkmcnt(" #n ")" ::: "memory")
#define PG8_BAR __builtin_amdgcn_s_barrier()
#define PG8_SCHED __builtin_amdgcn_sched_barrier(0)
    Unit cur, nxt; int ui = 0;
    if (!S.next(0, cur)) return;
    typedef typename AccSel<I8>::type acc_t;
    acc_t acc[2][2][4][2];
#pragma unroll
    for (int a = 0; a < 2; ++a)
#pragma unroll
        for (int b = 0; b < 2; ++b)
#pragma unroll
            for (int m = 0; m < 4; ++m)
#pragma unroll
                for (int n = 0; n < 2; ++n) acc[a][b][m][n] = (acc_t){0, 0, 0, 0};
    bf16x8 At[4][2], B0[2][2], B1[2][2];
    const char* cA = (const char*)g.A + (size_t)cur.pm * tstep; const char* cB = (const char*)g.Bt + (size_t)cur.pn * tstep;
    S.a_ready(cur);
    if constexpr (SP2) {
        PG8_STAGE(PG8_SB(0, 0), cB, voffB); PG8_STAGE(PG8_SB(0, 1), cB + hstep, voffB); PG8_STAGE(PG8_SA(0, 0), cA, voffA); PG8_STAGE(PG8_SA(0, 1), cA + hstep, voffA);
        if (wr == 1) PG8_BAR;
        PG8_WAIT_V(2); PG8_BAR;
        PG8_STAGE(PG8_SB(1, 0), cB + kstep, voffB); PG8_STAGE(PG8_SA(1, 0), cA + kstep, voffA); PG8_STAGE(PG8_SB(1, 1), cB + hstep + kstep, voffB);
        PG8_WAIT_V(6); PG8_BAR;
    } else {
        PG8_STAGE(PG8_SB(0, 0), cB, voffB); PG8_STAGE(PG8_SA(0, 0), cA, voffA); PG8_STAGE(PG8_SB(0, 1), cB + hstep, voffB); PG8_STAGE(PG8_SA(0, 1), cA + hstep, voffA);
        if (wr == 1) PG8_BAR;
        PG8_WAIT_V(4); PG8_BAR;
        PG8_STAGE(PG8_SB(1, 0), cB + kstep, voffB); PG8_STAGE(PG8_SA(1, 0), cA + kstep, voffA); PG8_STAGE(PG8_SB(1, 1), cB + hstep + kstep, voffB);
        PG8_WAIT_V(6); PG8_BAR;
    }
    for (;;) {
        const bool has_next = S.next(ui + 1, nxt);
        const char* nA = has_next ? (const char*)g.A + (size_t)nxt.pm * tstep : cA; const char* nB = has_next ? (const char*)g.Bt + (size_t)nxt.pn * tstep : cB;
        for (int t = 0; t < nt; t += 2) {
            if constexpr (MID) { if (t == nt / 2) E.mid(acc, cur, wr, wc, fr, fq); }
            const bool last = (t == nt - 2);
            const char* a1 = cA + (size_t)(t + 1) * kstep;
            const char* a2 = last ? nA : cA + (size_t)(t + 2) * kstep; const char* b2 = last ? nB : cB + (size_t)(t + 2) * kstep;
            const char* a3 = a2 + kstep; const char* b3 = b2 + kstep;
            if (last && has_next) S.a_ready(nxt);
            if constexpr (SP2) {
            PG8_LDB(B0, 0, 0); PG8_LDB(B1, 0, 1); PG8_SCHED; PG8_LDA(At, 0, 0); PG8_STAGE(PG8_SA(1, 1), a1 + hstep, voffA);
            PG8_WAIT_V(8); PG8_WAIT_L(0); PG8_BAR; PG8_MMA(0, 0, At, B0); PG8_MMA(0, 1, At, B1); PG8_BAR; PG8_SCHED;
            PG8_LDA(At, 0, 1); PG8_STAGE(PG8_SB(0, 0), b2, voffB); PG8_STAGE(PG8_SB(0, 1), b2 + hstep, voffB); PG8_STAGE(PG8_SA(0, 0), a2, voffA);
            PG8_WAIT_V(8); PG8_WAIT_L(0); PG8_BAR; PG8_MMA(1, 0, At, B0); PG8_MMA(1, 1, At, B1); PG8_BAR; PG8_SCHED;
            PG8_LDB(B0, 1, 0); PG8_LDB(B1, 1, 1); PG8_SCHED; PG8_LDA(At, 1, 0); PG8_STAGE(PG8_SA(0, 1), a2 + hstep, voffA);
            PG8_WAIT_V(8); PG8_WAIT_L(0); PG8_BAR; PG8_MMA(0, 0, At, B0); PG8_MMA(0, 1, At, B1); PG8_BAR; PG8_SCHED;
            PG8_LDA(At, 1, 1); PG8_STAGE(PG8_SB(1, 0), b3, voffB); PG8_STAGE(PG8_SB(1, 1), b3 + hstep, voffB); PG8_STAGE(PG8_SA(1, 0), a3, voffA);
            PG8_WAIT_V(8); PG8_WAIT_L(0); PG8_BAR; PG8_MMA(1, 0, At, B0); PG8_MMA(1, 1, At, B1); PG8_BAR; PG8_SCHED;
            } else {
            PG8_LDB(B0, 0, 0); PG8_SCHED; PG8_LDA(At, 0, 0); PG8_STAGE(PG8_SA(1, 1), a1 + hstep, voffA);
            PG8_WAIT_L(8); PG8_BAR; PG8_WAIT_L(0); PG8_MMA(0, 0, At, B0); PG8_BAR; PG8_SCHED;
            PG8_LDB(B1, 0, 1); PG8_STAGE(PG8_SB(0, 0), b2, voffB);
            PG8_BAR; PG8_WAIT_L(0); PG8_MMA(0, 1, At, B1); PG8_BAR;
            PG8_LDA(At, 0, 1); PG8_STAGE(PG8_SA(0, 0), a2, voffA);
            PG8_BAR; PG8_WAIT_L(0); PG8_MMA(1, 0, At, B0); PG8_BAR; PG8_SCHED;
            PG8_STAGE(PG8_SB(0, 1), b2 + hstep, voffB);
            PG8_WAIT_V(6); PG8_BAR; PG8_MMA(1, 1, At, B1); PG8_BAR;
            PG8_LDB(B0, 1, 0); PG8_SCHED; PG8_LDA(At, 1, 0); PG8_STAGE(PG8_SA(0, 1), a2 + hstep, voffA);
            PG8_WAIT_L(8); PG8_BAR; PG8_WAIT_L(0); PG8_MMA(0, 0, At, B0); PG8_BAR; PG8_SCHED;
            PG8_LDB(B1, 1, 1); PG8_STAGE(PG8_SB(1, 0), b3, voffB);
            PG8_BAR; PG8_WAIT_L(0); PG8_MMA(0, 1, At, B1); PG8_BAR;
            PG8_LDA(At, 1, 1); PG8_STAGE(PG8_SA(1, 0), a3, voffA);
            PG8_BAR; PG8_WAIT_L(0); PG8_MMA(1, 0, At, B0); PG8_BAR; PG8_SCHED;
            PG8_STAGE(PG8_SB(1, 1), b3 + hstep, voffB);
            PG8_WAIT_V(6); PG8_BAR; PG8_MMA(1, 1, At, B1); PG8_BAR;
            }
        }
        if constexpr (ALIGN_EPI) { if (wr == 0) PG8_BAR; }
        if constexpr (!Epi::AFTER_DRAIN) { E(acc, cur, wr, wc, fr, fq); S.done(cur); }
        if (!has_next) break;
#pragma unroll
        for (int a = 0; a < 2; ++a)
#pragma unroll
            for (int b = 0; b < 2; ++b)
#pragma unroll
                for (int m = 0; m < 4; ++m)
#pragma unroll
                    for (int n = 0; n < 2; ++n) acc[a][b][m][n] = (acc_t){0, 0, 0, 0};
        cur = nxt; cA = nA; cB = nB; ++ui;
        if constexpr (ALIGN_EPI) { if (wr == 1) PG8_BAR; }
    }
    PG8_WAIT_V(0);
    if constexpr (!ALIGN_EPI) { if (wr == 0) PG8_BAR; }
    PG8_BAR;
    if constexpr (Epi::AFTER_DRAIN) { E.fused(acc, cur, wr, wc, fr, fq, lds, wid, lane); S.done(cur); }
#undef PG8_SA
#undef PG8_SB
#undef PG8_STAGE
#undef PG8_LDA
#undef PG8_LDB
#undef PG8_MMA
#undef PG8_WAIT_V
#undef PG8_WAIT_L
#undef PG8_BAR
#undef PG8_SCHED
}
}
#define XB_TMO      128
#define XB_XCNT(j)  (256  + 64 * (j))
#define XB_XSUB(j)  (1280 + 64 * (j))
#define XB_XGEN(j)  (2304 + 64 * (j))
#define XB_TOP      3328
#define XB_TOPGEN   3392
#define XCD_BAR_WORDS 3456
#define XB_SPIN_CAP (1u << 18)

__device__ __forceinline__ unsigned xb_ld(unsigned* p)              { return __hip_atomic_load(p, __ATOMIC_RELAXED, __HIP_MEMORY_SCOPE_AGENT); }
__device__ __forceinline__ unsigned xb_add(unsigned* p, unsigned v) { return __hip_atomic_fetch_add(p, v, __ATOMIC_RELAXED, __HIP_MEMORY_SCOPE_AGENT); }
__device__ __forceinline__ unsigned xb_xcc_id() { return (unsigned)__builtin_amdgcn_s_getreg((3 << 11) | 20) & 0xFu; }
#define XB_SPIN(cond, bar) do { unsigned _sp = 0; while (cond) { __builtin_amdgcn_s_sleep(1); \
    if ((++_sp & 255u) == 0u) { if (xb_ld(&(bar)[XB_TMO])) break; if (_sp > XB_SPIN_CAP) { atomicAdd(&(bar)[XB_TMO], 1u); break; } } } } while (0)

struct XcdBarrier {
    unsigned* bar; unsigned x; unsigned wv;
    volatile LAS unsigned* st;
};

__device__ __forceinline__ XcdBarrier xcd_barrier_post(unsigned* bar, volatile LAS unsigned* st, unsigned wave) {
    XcdBarrier b; b.bar = bar; b.x = xb_xcc_id(); b.st = st; b.wv = wave;
    if (threadIdx.x == 0) (void)xb_add(&bar[XB_XCNT(b.x)], 1u);
    return b;
}
__device__ __forceinline__ void xcd_barrier_complete(unsigned* bar, unsigned x, unsigned& nloc, unsigned& nx) {
    const unsigned G = gridDim.x * gridDim.y * gridDim.z;
    unsigned sum, cnt, mine, sp = 0u;
    for (;;) {
        sum = 0u; cnt = 0u; mine = 0u;
#pragma unroll 1
        for (unsigned j = 0; j < 16; ++j) { const unsigned c = xb_ld(&bar[XB_XCNT(j)]); sum += c; cnt += (c > 0u) ? 1u : 0u; mine = (j == x) ? c : mine; }
        if (sum == G) break;
        __builtin_amdgcn_s_sleep(1);
        if ((++sp & 255u) == 0u) { if (xb_ld(&bar[XB_TMO])) break; if (sp > XB_SPIN_CAP) { atomicAdd(&bar[XB_TMO], 1u); break; } }
    }
    nloc = mine > 0u ? mine : 1u; nx = cnt > 0u ? cnt : 1u;
}

__device__ __forceinline__ void xcd_barrier(const XcdBarrier& b) {
    asm volatile("s_waitcnt vmcnt(0)" ::: "memory");
    __syncthreads();
    if (b.wv == 0u && lane_id() == 0) {
        unsigned* bar = b.bar;
        __builtin_amdgcn_s_waitcnt(0);
        unsigned nloc = b.st[0], nx = b.st[1];
        if (nloc == 0u) { xcd_barrier_complete(bar, b.x, nloc, nx); b.st[0] = nloc; b.st[1] = nx; }
        const unsigned old = xb_add(&bar[XB_XSUB(b.x)], 1u);
        const unsigned gen = old / nloc;
        if (old + 1u == (gen + 1u) * nloc) {
            __builtin_amdgcn_fence(__ATOMIC_RELEASE, "agent");
            asm volatile("s_waitcnt vmcnt(0)" ::: "memory");
            const unsigned og = xb_add(&bar[XB_TOP], 1u);
            const unsigned tg = og / nx;
            if (og + 1u == (tg + 1u) * nx) xb_add(&bar[XB_TOPGEN], 1u);
            else XB_SPIN(xb_ld(&bar[XB_TOPGEN]) == tg, bar);
            __builtin_amdgcn_fence(__ATOMIC_ACQUIRE, "agent");
            xb_add(&bar[XB_XGEN(b.x)], 1u);
            asm volatile("s_waitcnt vmcnt(0)" ::: "memory");
        } else {
            XB_SPIN(xb_ld(&bar[XB_XGEN(b.x)]) == gen, bar);
            __builtin_amdgcn_fence(__ATOMIC_ACQUIRE, "agent");
            asm volatile("s_waitcnt vmcnt(0)" ::: "memory");
        }
    }
    __syncthreads();
}


struct Frame {
    LAS unsigned char* lds;
    volatile LAS unsigned* MISC;
    gu32* ctl;
    int tid, lane, wave;
    int vcu, G;
    unsigned char* ws;
};

__device__ __forceinline__ int inproj_row(int n) {
    const int seg = n >> 10, r = n & 1023;
    if (seg >= 6) return (seg < 8 ? 4096 : 6144) + (n - (seg < 8 ? 6144 : 8192));
    if (seg == 2) return 8192 + r;
    if (seg == 5) return 8192 + 1024 + r;
    const int head = r >> 7, d = r & 127;
    if (seg < 2) return seg * 1024 + head * 128 + 32 * ((d >> 4) & 3) + 16 * (d >> 6) + (d & 15);
    return (seg - 1) * 1024 + head * 128 + 32 * (2 * (d >> 6) + ((d >> 4) & 1)) + 16 * ((d >> 5) & 1) + (d & 15);
}
template <bool MAP>
__device__ __forceinline__ void p0_transpose_item(const float* W, int K, int N, bf16* WT, LAS float* scr, int item, int lane, int ldk = 0, int koff = 0) {
    if (ldk == 0) ldk = K;
    const int nblk = N / 32, kb = item / nblk, nb = item % nblk, k0 = 64 * kb, n0 = 32 * nb;
#pragma unroll 8
    for (int i = 0; i < 32; ++i) { const int kk = 2 * i + (lane >> 5); scr[kk * 33 + (lane & 31)] = W[(size_t)(k0 + kk) * N + n0 + (lane & 31)]; }
    LDS_WAIT(); asm volatile("" ::: "memory");
    const int c = lane & 7;
#pragma unroll
    for (int j = 0; j < 4; ++j) { const int n = (lane >> 3) + 8 * j; const LAS float* s = scr + (8 * c) * 33 + n;
        v4u o; o.x = pk2(s[0 * 33], s[1 * 33]); o.y = pk2(s[2 * 33], s[3 * 33]); o.z = pk2(s[4 * 33], s[5 * 33]); o.w = pk2(s[6 * 33], s[7 * 33]);
        const int dr = MAP ? inproj_row(n0 + n) : (n0 + n);
        *(GAS v4u*)(WT + (size_t)dr * ldk + koff + k0 + 8 * c) = o; }
    LDS_WAIT(); asm volatile("" ::: "memory");
}
__device__ __forceinline__ void p0_convert(const float* src, bf16* dst, size_t n8, size_t gtid, size_t gthreads) {
    for (size_t i = gtid; i < n8; i += gthreads) {
        const f32x4 a = *(const GAS f32x4*)(src + i * 8), b = *(const GAS f32x4*)(src + i * 8 + 4);
        v4u o; o.x = pk2(a[0], a[1]); o.y = pk2(a[2], a[3]); o.z = pk2(b[0], b[1]); o.w = pk2(b[2], b[3]);
        *(GAS v4u*)(dst + i * 8) = o;
    }
}

__device__ __forceinline__ void p0_table_row_load(const float* src, f32x4 (&v)[8], int lane) {
#pragma unroll
    for (int q = 0; q < 8; ++q) v[q] = *(const GAS f32x4*)(src + 32 * lane + 4 * q);
}
__device__ __forceinline__ void p0_table_row_finish(const f32x4 (&v)[8], unsigned char* dst, float* scale_out, int lane) {
    float am = 0.f;
#pragma unroll
    for (int q = 0; q < 8; ++q) am = fmaxf(am, fmaxf(fmaxf(fabsf(v[q][0]), fabsf(v[q][1])), fmaxf(fabsf(v[q][2]), fabsf(v[q][3]))));
#pragma unroll
    for (int o = 1; o < 64; o <<= 1) am = fmaxf(am, __shfl_xor(am, o));
    const float sc = am > 0.f ? 6.0f / am : 1.0f;
    v4u o;
#pragma unroll
    for (int wq = 0; wq < 4; ++wq) { unsigned w = 0u;
        w = __builtin_amdgcn_cvt_scalef32_pk_fp4_f32(w, v[2 * wq][0] * sc, v[2 * wq][1] * sc, 1.0f, 0);
        w = __builtin_amdgcn_cvt_scalef32_pk_fp4_f32(w, v[2 * wq][2] * sc, v[2 * wq][3] * sc, 1.0f, 1);
        w = __builtin_amdgcn_cvt_scalef32_pk_fp4_f32(w, v[2 * wq + 1][0] * sc, v[2 * wq + 1][1] * sc, 1.0f, 2);
        w = __builtin_amdgcn_cvt_scalef32_pk_fp4_f32(w, v[2 * wq + 1][2] * sc, v[2 * wq + 1][3] * sc, 1.0f, 3);
        o[wq] = w; }
    *(GAS v4u*)(dst + 16 * lane) = o;
    if (lane == 0) *scale_out = am > 0.f ? am / 6.0f : 1.0f;
}

__device__ __forceinline__ unsigned q8pack(float a, float b, float c, float d, float s) {
    const int ia = (int)__builtin_rintf(a * s), ib = (int)__builtin_rintf(b * s), ic = (int)__builtin_rintf(c * s), id = (int)__builtin_rintf(d * s);
    return ((unsigned)ia & 255u) | (((unsigned)ib & 255u) << 8) | (((unsigned)ic & 255u) << 16) | ((unsigned)id << 24);
}
__device__ __forceinline__ void p0_absmax_item(const float* W, int item, int lane, gu32* wmax) {
    const int kc = item / 40, nc = item % 40, n0 = 256 * nc + 4 * lane;
    const float* p = W + (size_t)(128 * kc) * 10240 + n0;
    f32x4 am = (f32x4){0.f, 0.f, 0.f, 0.f};
#pragma unroll 16
    for (int r = 0; r < 128; ++r) { const f32x4 v = *(const GAS f32x4*)(p + (size_t)r * 10240);
        am[0] = fmaxf(am[0], fabsf(v[0])); am[1] = fmaxf(am[1], fabsf(v[1])); am[2] = fmaxf(am[2], fabsf(v[2])); am[3] = fmaxf(am[3], fabsf(v[3])); }
#pragma unroll
    for (int j = 0; j < 4; ++j) (void)__hip_atomic_fetch_max(wmax + n0 + j, __builtin_bit_cast(unsigned, am[j]), RLX_AGENT);
}
__device__ __forceinline__ void p0_transpose_item_i8(const float* W, int K, int N, unsigned char* W8, LAS float* scr, int item, int lane, const gu32* wmax) {
    const int nblk = N / 32, kb = item / nblk, nb = item % nblk, k0 = 64 * kb, n0 = 32 * nb;
#pragma unroll 8
    for (int i = 0; i < 32; ++i) { const int kk = 2 * i + (lane >> 5); scr[kk * 33 + (lane & 31)] = W[(size_t)(k0 + kk) * N + n0 + (lane & 31)]; }
    LDS_WAIT(); asm volatile("" ::: "memory");
    const int c = lane & 7;
#pragma unroll
    for (int j = 0; j < 4; ++j) { const int n = (lane >> 3) + 8 * j; const LAS float* s = scr + (8 * c) * 33 + n;
        const float am = __builtin_bit_cast(float, wmax[n0 + n]); const float sc = am > 0.f ? 127.0f / am : 0.f;
        v2u o; o.x = q8pack(s[0 * 33], s[1 * 33], s[2 * 33], s[3 * 33], sc); o.y = q8pack(s[4 * 33], s[5 * 33], s[6 * 33], s[7 * 33], sc);
        *(GAS v2u*)(W8 + (size_t)inproj_row(n0 + n) * K + k0 + 8 * c) = o; }
    LDS_WAIT(); asm volatile("" ::: "memory");
}
__device__ __forceinline__ void p0_x_row(const float* src, bf16* dstb, unsigned char* dst8, float* sx, int lane) {
    f32x4 v[8]; float am = 0.f;
#pragma unroll
    for (int j = 0; j < 8; ++j) { v[j] = *(const GAS f32x4*)(src + 256 * j + 4 * lane);
        am = fmaxf(am, fmaxf(fmaxf(fabsf(v[j][0]), fabsf(v[j][1])), fmaxf(fabsf(v[j][2]), fabsf(v[j][3])))); }
#pragma unroll
    for (int o = 1; o < 64; o <<= 1) am = fmaxf(am, __shfl_xor(am, o));
    const float sc = am > 0.f ? 127.0f / am : 0.f;
#pragma unroll
    for (int j = 0; j < 8; ++j) { *(GAS v2u*)(dstb + 256 * j + 4 * lane) = (v2u){pk2(v[j][0], v[j][1]), pk2(v[j][2], v[j][3])};
        *(GAS unsigned*)(dst8 + 256 * j + 4 * lane) = q8pack(v[j][0], v[j][1], v[j][2], v[j][3], sc); }
    if (lane == 0) *sx = am * (1.0f / 127.0f);
}

namespace att {
constexpr int KB0 = 0, VB0 = 32768, KMT = 65536, QFR = 65536;
__device__ __forceinline__ int crow(int r, int hi) { return (r & 3) + 8 * (r >> 2) + 4 * hi; }
__device__ __forceinline__ unsigned cvtpk(float lo, float hi) { return pg8::cvt_pk_bf16(lo, hi); }

template <int DQK, bool MOBA>
__device__ __forceinline__ void attn_pass(LAS unsigned char* lds, const bf16* Qg, const bf16* Kg, const bf16* Vtg, int q0, unsigned sel, f32x16 (&o)[4], int tid, int wid, int lane) {
    constexpr int NS = DQK / 16, RB = DQK * 2, KCH = DQK / 8;
    constexpr float THR = 8.0f;
    const int r32 = lane & 31, hi = lane >> 5;
    const int qpos = q0 + 32 * wid + r32;
    const int own = q0 >> 8;
    const LAS unsigned char* qlds = lds + QFR + wid * 8192 + lane * 16;
    { const bf16* qp = Qg + (size_t)(32 * wid + r32) * 1024 + 8 * hi;
#pragma unroll
      for (int s = 0; s < NS; ++s) *(LAS bf16x8*)(lds + QFR + wid * 8192 + lane * 16 + s * 1024) = *(const GAS bf16x8*)(qp + 16 * s); }
#pragma unroll
    for (int d = 0; d < 4; ++d) o[d] = (f32x16){0.f,0.f,0.f,0.f,0.f,0.f,0.f,0.f,0.f,0.f,0.f,0.f,0.f,0.f,0.f,0.f};
    f32x16 negm = (f32x16){0.f,0.f,0.f,0.f,0.f,0.f,0.f,0.f,0.f,0.f,0.f,0.f,0.f,0.f,0.f,0.f};
    float l_run = 0.f;
    const int nt = MOBA ? 4 + 4 * own : (q0 + 256) / 64;
    constexpr int NKC = (64 * KCH) / 512;
    v4u kreg[NKC], vreg[2];
    unsigned kgo[NKC], vgo[2]; int klds[NKC], vl0[2], vl1[2];
#pragma unroll
    for (int i = 0; i < NKC; ++i) { const int cid = tid + 512 * i, key = cid / KCH, ch = cid % KCH;
        const int swz = (DQK == 128) ? (key & 15) : ((key >> 1) & 7);
        kgo[i] = (unsigned)(key * 1024 + ch * 8) * 2u; klds[i] = key * RB + ((ch ^ swz) << 4); }
#pragma unroll
    for (int i = 0; i < 2; ++i) { const int cid = tid + 512 * i, d = cid >> 3, g = cid & 7;
        const int c = (g >> 2) * 4 + ((g >> 1) & 1) * 2, sw = (d >> 1) & 7, e = g & 1;
        vgo[i] = (unsigned)(d * T + g * 8) * 2u; vl0[i] = d * 128 + ((c ^ sw) << 4) + 8 * e; vl1[i] = d * 128 + (((c + 1) ^ sw) << 4) + 8 * e; }
#define KTILE(i) (MOBA ? ((i) < 4 ? own * 4 + (i) : (i) - 4) : (i))
#define ATT_LOAD(kt) do { const GAS unsigned char* kb_ = (const GAS unsigned char*)Kg + (size_t)(kt) * 131072; const GAS unsigned char* vb_ = (const GAS unsigned char*)Vtg + (size_t)(kt) * 128; \
                          _Pragma("unroll") for (int i_ = 0; i_ < NKC; ++i_) kreg[i_] = *(const GAS v4u*)(kb_ + kgo[i_]); \
                          _Pragma("unroll") for (int i_ = 0; i_ < 2; ++i_) vreg[i_] = *(const GAS v4u*)(vb_ + vgo[i_]); } while (0)
#define ATT_STORE(buf) do { _Pragma("unroll") for (int i_ = 0; i_ < NKC; ++i_) *(LAS v4u*)(lds + KB0 + (buf) * 16384 + klds[i_]) = kreg[i_]; \
                            _Pragma("unroll") for (int i_ = 0; i_ < 2; ++i_) { *(LAS v2u*)(lds + VB0 + (buf) * 16384 + vl0[i_]) = (v2u){vreg[i_].x, vreg[i_].y}; \
                                                                              *(LAS v2u*)(lds + VB0 + (buf) * 16384 + vl1[i_]) = (v2u){vreg[i_].z, vreg[i_].w}; } } while (0)
    ATT_LOAD(KTILE(0)); ATT_STORE(0);
    __syncthreads();
    const int kswz = (DQK == 128) ? (r32 & 15) : ((r32 >> 1) & 7);
    const int vsw = (r32 >> 1) & 7;
    const int kfo = r32 * RB, vfo = r32 * 128;
#define ATT_STEP(BUF) do { \
        const int kt = KTILE(it); const bool more = it + 1 < nt; \
        if (more) ATT_LOAD(KTILE(it + 1)); \
        const int blk = kt >> 2; bool need; \
        if (!MOBA || it < 4) need = (kt * 64 <= q0 + 32 * wid + 31); else need = __any((sel >> blk) & 1u); \
        if (need) { \
            f32x16 p0, p1; \
            const LAS unsigned char* kb = lds + KB0 + (BUF) * 16384 + kfo; \
              \
            bf16x8 fk0[2], fk1[2], fqv[2]; \
            { const int ch = ((0 + hi) ^ kswz) << 4; fk0[0] = *(const LAS bf16x8*)(kb + ch); fk1[0] = *(const LAS bf16x8*)(kb + 32 * RB + ch); fqv[0] = *(const LAS bf16x8*)(qlds); } \
            _Pragma("unroll") for (int s = 0; s < NS; ++s) { \
                if (s + 1 < NS) { const int ch = ((2 * (s + 1) + hi) ^ kswz) << 4; \
                    fk0[(s + 1) & 1] = *(const LAS bf16x8*)(kb + ch); fk1[(s + 1) & 1] = *(const LAS bf16x8*)(kb + 32 * RB + ch); fqv[(s + 1) & 1] = *(const LAS bf16x8*)(qlds + (s + 1) * 1024); } \
                __builtin_amdgcn_sched_barrier(0); \
                if (s == 0) {   \
                    asm volatile("v_mfma_f32_32x32x16_bf16 %0, %1, %2, %3" : "=&v"(p0) : "v"(fk0[0]), "v"(fqv[0]), "v"(negm)); \
                    asm volatile("v_mfma_f32_32x32x16_bf16 %0, %1, %2, %3" : "=&v"(p1) : "v"(fk1[0]), "v"(fqv[0]), "v"(negm)); } \
                else { p0 = __builtin_amdgcn_mfma_f32_32x32x16_bf16(fk0[s & 1], fqv[s & 1], p0, 0, 0, 0); p1 = __builtin_amdgcn_mfma_f32_32x32x16_bf16(fk1[s & 1], fqv[s & 1], p1, 0, 0, 0); } \
                __builtin_amdgcn_sched_barrier(0); } \
            if (!MOBA || it < 4) { \
                if (kt * 64 + 63 > q0 + 32 * wid) { const int kbase = kt * 64 + 4 * hi; \
                    _Pragma("unroll") for (int r = 0; r < 16; ++r) { const int kv = kbase + (r & 3) + 8 * (r >> 2); if (kv > qpos) p0[r] = -INFINITY; if (kv + 32 > qpos) p1[r] = -INFINITY; } } \
            } else { if (!((sel >> blk) & 1u)) { _Pragma("unroll") for (int r = 0; r < 16; ++r) { p0[r] = -INFINITY; p1[r] = -INFINITY; } } } \
            float rm = fmaxf(fmaxf(p0[0], p0[1]), p1[0]); \
            _Pragma("unroll") for (int r = 1; r < 16; ++r) rm = fmaxf(fmaxf(rm, p0[r]), p1[r]); \
            { const unsigned rb = __builtin_bit_cast(unsigned, rm); auto rr = __builtin_amdgcn_permlane32_swap(rb, rb, false, false); rm = fmaxf(__builtin_bit_cast(float, (unsigned)rr[0]), __builtin_bit_cast(float, (unsigned)rr[1])); } \
            if (it == 0 || __any(rm > THR)) { \
                const float dl = (it == 0) ? rm : fmaxf(rm, 0.f); const float alpha = fexp2(-dl); \
                _Pragma("unroll") for (int r = 0; r < 16; ++r) { p0[r] -= dl; p1[r] -= dl; negm[r] -= dl; } \
                l_run *= alpha; \
                _Pragma("unroll") for (int d = 0; d < 4; ++d) _Pragma("unroll") for (int r = 0; r < 16; ++r) o[d][r] *= alpha; } \
            float ls = 0.f; \
            _Pragma("unroll") for (int r = 0; r < 16; ++r) { p0[r] = fexp2(p0[r]); p1[r] = fexp2(p1[r]); ls += p0[r] + p1[r]; } \
            l_run += ls; \
            bf16x8 pa[4]; \
            { v4u w; \
              w.x = cvtpk(p0[0], p0[1]); w.y = cvtpk(p0[2], p0[3]); w.z = cvtpk(p0[4], p0[5]); w.w = cvtpk(p0[6], p0[7]); pa[0] = __builtin_bit_cast(bf16x8, w); \
              w.x = cvtpk(p0[8], p0[9]); w.y = cvtpk(p0[10], p0[11]); w.z = cvtpk(p0[12], p0[13]); w.w = cvtpk(p0[14], p0[15]); pa[1] = __builtin_bit_cast(bf16x8, w); \
              w.x = cvtpk(p1[0], p1[1]); w.y = cvtpk(p1[2], p1[3]); w.z = cvtpk(p1[4], p1[5]); w.w = cvtpk(p1[6], p1[7]); pa[2] = __builtin_bit_cast(bf16x8, w); \
              w.x = cvtpk(p1[8], p1[9]); w.y = cvtpk(p1[10], p1[11]); w.z = cvtpk(p1[12], p1[13]); w.w = cvtpk(p1[14], p1[15]); pa[3] = __builtin_bit_cast(bf16x8, w); } \
            const LAS unsigned char* vb = lds + VB0 + (BUF) * 16384 + vfo; \
            bf16x8 vfr[2][4]; \
            _Pragma("unroll") for (int d = 0; d < 4; ++d) vfr[0][d] = *(const LAS bf16x8*)(vb + d * 4096 + (((0 + hi) ^ vsw) << 4)); \
            _Pragma("unroll") for (int ks = 0; ks < 4; ++ks) { \
                if (ks + 1 < 4) { const int c = ((ks + 1) >> 1) * 4 + ((ks + 1) & 1) * 2 + hi; \
                    _Pragma("unroll") for (int d = 0; d < 4; ++d) vfr[(ks + 1) & 1][d] = *(const LAS bf16x8*)(vb + d * 4096 + ((c ^ vsw) << 4)); } \
                __builtin_amdgcn_sched_barrier(0); \
                _Pragma("unroll") for (int d = 0; d < 4; ++d) o[d] = __builtin_amdgcn_mfma_f32_32x32x16_bf16(vfr[ks & 1][d], pa[ks], o[d], 0, 0, 0); \
                __builtin_amdgcn_sched_barrier(0); } \
        } \
        if (more) ATT_STORE((BUF) ^ 1); \
        __syncthreads(); \
    } while (0)
    int it = 0;
#pragma unroll 1
    for (; it + 1 < nt; it += 2) { ATT_STEP(0); ++it; ATT_STEP(1); --it; }
    if (it < nt) ATT_STEP(0);
#undef ATT_STEP
#undef ATT_LOAD
#undef KTILE
#undef ATT_STORE
    const float lt = l_run + __shfl_xor(l_run, 32);
    const float inv = 1.0f / lt;
#pragma unroll
    for (int d = 0; d < 4; ++d)
#pragma unroll
        for (int r = 0; r < 16; ++r) o[d][r] *= inv;
}

__device__ __forceinline__ void attn_pass_diff2(LAS unsigned char* lds, const bf16* Qg, const bf16* Kg, const bf16* Vtg, int q0, f32x16 (&o1)[4], f32x16 (&o2)[4], int tid, int wid, int lane) {
    constexpr int RB = 256, KCH = 16; constexpr float THR = 8.0f;
    { const int r32 = lane & 31, hi = lane >> 5;
      const bf16* qp = Qg + (size_t)(32 * wid + r32) * 1024 + 8 * hi;
#pragma unroll
      for (int s = 0; s < 8; ++s) *(LAS bf16x8*)(lds + QFR + wid * 8192 + lane * 16 + s * 1024) = *(const GAS bf16x8*)(qp + 16 * s); }
#pragma unroll
    for (int d = 0; d < 4; ++d) { o1[d] = (f32x16){0.f,0.f,0.f,0.f,0.f,0.f,0.f,0.f,0.f,0.f,0.f,0.f,0.f,0.f,0.f,0.f}; o2[d] = o1[d]; }
    float m1 = 0.f, l1 = 0.f, m2 = 0.f, l2 = 0.f;
    const int nt = (q0 + 256) / 64;
    v4u sreg[2];
#define ATT_KGO(i) ((unsigned)((((tq_ + 512 * (i)) >> 4) * 1024 + ((tq_ + 512 * (i)) & 15) * 8) * 2))
#define ATT_KLDS(i) ((((tq_ + 512 * (i)) >> 4) * RB) + (((((tq_ + 512 * (i)) & 15)) ^ (((tq_ + 512 * (i)) >> 4) & 15)) << 4))
#define ATT_VGO(i) ((unsigned)((((tq_ + 512 * (i)) >> 3) * T + ((tq_ + 512 * (i)) & 7) * 8) * 2))
#define ATT_VC(i) (((((tq_ + 512 * (i)) & 7) >> 2) * 4) + (((((tq_ + 512 * (i)) & 7) >> 1) & 1) * 2))
#define ATT_VL0(i) ((((tq_ + 512 * (i)) >> 3) * 128) + ((ATT_VC(i) ^ ((((tq_ + 512 * (i)) >> 3) >> 1) & 7)) << 4) + 8 * ((tq_ + 512 * (i)) & 1))
#define ATT_VL1(i) ((((tq_ + 512 * (i)) >> 3) * 128) + (((ATT_VC(i) + 1) ^ ((((tq_ + 512 * (i)) >> 3) >> 1) & 7)) << 4) + 8 * ((tq_ + 512 * (i)) & 1))
#define ATT_TQ int tq_ = lane; asm volatile("" : "+v"(tq_)); tq_ += 64 * wid
#define ATT_LOADK(kt) do { ATT_TQ; const GAS unsigned char* kb_ = (const GAS unsigned char*)Kg + (size_t)(kt) * 131072; _Pragma("unroll") for (int i_ = 0; i_ < 2; ++i_) sreg[i_] = *(const GAS v4u*)(kb_ + ATT_KGO(i_)); } while (0)
#define ATT_LOADV(kt) do { ATT_TQ; const GAS unsigned char* vb_ = (const GAS unsigned char*)Vtg + (size_t)(kt) * 128; _Pragma("unroll") for (int i_ = 0; i_ < 2; ++i_) sreg[i_] = *(const GAS v4u*)(vb_ + ATT_VGO(i_)); } while (0)
#define ATT_STOREK(buf) do { ATT_TQ; _Pragma("unroll") for (int i_ = 0; i_ < 2; ++i_) *(LAS v4u*)(lds + KB0 + (buf) * 16384 + ATT_KLDS(i_)) = sreg[i_]; } while (0)
#define ATT_STOREV(buf) do { ATT_TQ; _Pragma("unroll") for (int i_ = 0; i_ < 2; ++i_) { *(LAS v2u*)(lds + VB0 + (buf) * 16384 + ATT_VL0(i_)) = (v2u){sreg[i_].x, sreg[i_].y}; \
                                                                               *(LAS v2u*)(lds + VB0 + (buf) * 16384 + ATT_VL1(i_)) = (v2u){sreg[i_].z, sreg[i_].w}; } } while (0)
    {
      ATT_LOADK(0);
      v4u sv_[2]; { ATT_TQ; const GAS unsigned char* vb_ = (const GAS unsigned char*)Vtg; _Pragma("unroll") for (int i_ = 0; i_ < 2; ++i_) sv_[i_] = *(const GAS v4u*)(vb_ + ATT_VGO(i_)); }
      ATT_STOREK(0);
      { ATT_TQ; _Pragma("unroll") for (int i_ = 0; i_ < 2; ++i_) { *(LAS v2u*)(lds + VB0 + ATT_VL0(i_)) = (v2u){sv_[i_].x, sv_[i_].y}; *(LAS v2u*)(lds + VB0 + ATT_VL1(i_)) = (v2u){sv_[i_].z, sv_[i_].w}; } } }
    __syncthreads();
#define ATT_LN int ln_ = lane; asm volatile("" : "+v"(ln_)); const int r32 = ln_ & 31, hi = ln_ >> 5
#define ATT_QKS(BUF, S0, M, L, O) do { \
        ATT_LN; const int kswz = r32 & 15; const LAS unsigned char* qlds = lds + QFR + wid * 8192 + ln_ * 16; \
        const LAS unsigned char* kb = lds + KB0 + (BUF) * 16384 + r32 * RB; \
        _Pragma("unroll") for (int s = 0; s < 4; ++s) { const int ch = ((2 * ((S0) + s) + hi) ^ kswz) << 4; \
            const bf16x8 k0 = *(const LAS bf16x8*)(kb + ch), k1 = *(const LAS bf16x8*)(kb + 32 * RB + ch); \
            const bf16x8 qv = *(const LAS bf16x8*)(qlds + ((S0) + s) * 1024); \
            if (s == 0) { asm volatile("v_mfma_f32_32x32x16_bf16 %0, %1, %2, 0" : "=&v"(p0) : "v"(k0), "v"(qv)); \
                          asm volatile("v_mfma_f32_32x32x16_bf16 %0, %1, %2, 0" : "=&v"(p1) : "v"(k1), "v"(qv)); } \
            else { p0 = __builtin_amdgcn_mfma_f32_32x32x16_bf16(k0, qv, p0, 0, 0, 0); p1 = __builtin_amdgcn_mfma_f32_32x32x16_bf16(k1, qv, p1, 0, 0, 0); } } \
        if (diag) { const int kbase = kt * 64 + 4 * hi, qpos = q0 + 32 * wid + r32; \
            _Pragma("unroll") for (int r = 0; r < 16; ++r) { const int kv = kbase + (r & 3) + 8 * (r >> 2); if (kv > qpos) p0[r] = -INFINITY; if (kv + 32 > qpos) p1[r] = -INFINITY; } } \
        float rm = fmaxf(fmaxf(p0[0], p0[1]), p1[0]); \
        _Pragma("unroll") for (int r = 1; r < 16; ++r) rm = fmaxf(fmaxf(rm, p0[r]), p1[r]); \
        { const unsigned rb = __builtin_bit_cast(unsigned, rm); auto rr = __builtin_amdgcn_permlane32_swap(rb, rb, false, false); rm = fmaxf(__builtin_bit_cast(float, (unsigned)rr[0]), __builtin_bit_cast(float, (unsigned)rr[1])); } \
        if (it == 0 || __any(rm > M + THR)) { \
            const float mnew = (it == 0) ? rm : fmaxf(M, rm); const float alpha = fexp2(M - mnew); M = mnew; \
            L *= alpha; \
            _Pragma("unroll") for (int d = 0; d < 4; ++d) _Pragma("unroll") for (int r = 0; r < 16; ++r) O[d][r] *= alpha; } \
        float ls = 0.f; \
        { typedef float f32x2v __attribute__((ext_vector_type(2))); const f32x2v mm = (f32x2v){M, M};        \
          _Pragma("unroll") for (int r = 0; r < 16; r += 2) { const f32x2v a = (f32x2v){p0[r], p0[r + 1]} - mm, b = (f32x2v){p1[r], p1[r + 1]} - mm; \
              p0[r] = fexp2(a.x); p0[r + 1] = fexp2(a.y); p1[r] = fexp2(b.x); p1[r + 1] = fexp2(b.y); ls += (p0[r] + p0[r + 1]) + (p1[r] + p1[r + 1]); } } \
        L += ls; \
    } while (0)
#define ATT_PACK(dst_, ks) do { \
        if ((ks) == 0) { (dst_).x = cvtpk(p0[0], p0[1]); (dst_).y = cvtpk(p0[2], p0[3]); (dst_).z = cvtpk(p0[4], p0[5]); (dst_).w = cvtpk(p0[6], p0[7]); } \
        else if ((ks) == 1) { (dst_).x = cvtpk(p0[8], p0[9]); (dst_).y = cvtpk(p0[10], p0[11]); (dst_).z = cvtpk(p0[12], p0[13]); (dst_).w = cvtpk(p0[14], p0[15]); } \
        else if ((ks) == 2) { (dst_).x = cvtpk(p1[0], p1[1]); (dst_).y = cvtpk(p1[2], p1[3]); (dst_).z = cvtpk(p1[4], p1[5]); (dst_).w = cvtpk(p1[6], p1[7]); } \
        else { (dst_).x = cvtpk(p1[8], p1[9]); (dst_).y = cvtpk(p1[10], p1[11]); (dst_).z = cvtpk(p1[12], p1[13]); (dst_).w = cvtpk(p1[14], p1[15]); } } while (0)
#define ATT_STEP(BUF) do { \
        const int kt = it; const bool more = it + 1 < nt; \
        const bool need = kt * 64 <= q0 + 32 * wid + 31, diag = kt * 64 + 63 > q0 + 32 * wid; \
        if (more) ATT_LOADK(it + 1); \
        v4u pa1[4] = {(v4u){0u, 0u, 0u, 0u}, (v4u){0u, 0u, 0u, 0u}, (v4u){0u, 0u, 0u, 0u}, (v4u){0u, 0u, 0u, 0u}}; \
        if (need) { f32x16 p0, p1; ATT_QKS(BUF, 0, m1, l1, o1); \
              _Pragma("unroll") for (int ks = 0; ks < 4; ++ks) ATT_PACK(pa1[ks], ks); } \
        if (more) { ATT_STOREK((BUF) ^ 1); ATT_LOADV(it + 1); }        \
        if (need) { v4u pa2[4]; \
              { f32x16 p0, p1; ATT_QKS(BUF, 4, m2, l2, o2); \
                _Pragma("unroll") for (int ks = 0; ks < 4; ++ks) ATT_PACK(pa2[ks], ks); } \
              __builtin_amdgcn_sched_barrier(0); \
              ATT_LN; const int vsw = (r32 >> 1) & 7; \
              const LAS unsigned char* vb = lds + VB0 + (BUF) * 16384 + r32 * 128; \
              _Pragma("unroll") for (int ks = 0; ks < 4; ++ks) { \
                const bf16x8 pb1 = __builtin_bit_cast(bf16x8, pa1[ks]), pb2 = __builtin_bit_cast(bf16x8, pa2[ks]); \
                const int c = (ks >> 1) * 4 + (ks & 1) * 2 + hi; \
                _Pragma("unroll") for (int d = 0; d < 4; ++d) { const bf16x8 vf = *(const LAS bf16x8*)(vb + d * 4096 + ((c ^ vsw) << 4)); \
                    o1[d] = __builtin_amdgcn_mfma_f32_32x32x16_bf16(vf, pb1, o1[d], 0, 0, 0); \
                    o2[d] = __builtin_amdgcn_mfma_f32_32x32x16_bf16(vf, pb2, o2[d], 0, 0, 0); } \
                __builtin_amdgcn_sched_barrier(0); } } \
        if (more) ATT_STOREV((BUF) ^ 1); \
        __syncthreads(); \
    } while (0)
    int it = 0;
#pragma unroll 1
    for (; it + 1 < nt; it += 2) { ATT_STEP(0); ++it; ATT_STEP(1); --it; }
    if (it < nt) ATT_STEP(0);
#undef ATT_STEP
#undef ATT_QKS
#undef ATT_PACK
#undef ATT_LN
#undef ATT_LOADK
#undef ATT_LOADV
#undef ATT_STOREK
#undef ATT_STOREV
#undef ATT_TQ
#undef ATT_KGO
#undef ATT_KLDS
#undef ATT_VGO
#undef ATT_VC
#undef ATT_VL0
#undef ATT_VL1
    const float i1 = 1.0f / (l1 + __shfl_xor(l1, 32)), i2 = 1.0f / (l2 + __shfl_xor(l2, 32));
#pragma unroll
    for (int d = 0; d < 4; ++d)
#pragma unroll
        for (int r = 0; r < 16; ++r) { o1[d][r] *= i1; o2[d][r] *= i2; }
}

struct AttnArgs { const bf16 *qa, *ka, *qd, *kd, *vt; bf16* oab; const float* kmean; const float* gain; float lam, one_minus_li; };

__device__ __forceinline__ void moba_unit(LAS unsigned char* lds, const AttnArgs& A, int b, int h, int qb, int tid, int wid, int lane) {
    asm volatile("" : "+v"(tid), "+v"(lane));
    const int r32 = lane & 31, hi = lane >> 5, q0 = qb * 256;
    const bf16* Qg = A.qa + (size_t)(b * SEQ + q0) * 1024 + h * 128;
    unsigned sel = 0u;
    if (qb > 0) {
        { const int row = tid >> 4, ch = tid & 15, n = row & 15;
          const float* kp = A.kmean + ((size_t)(b * 8 + h) * 16 + n) * 128 + ch * 8;
          const f32x4 a = *(const GAS f32x4*)kp, c = *(const GAS f32x4*)(kp + 4);
          float v[8] = {a[0], a[1], a[2], a[3], c[0], c[1], c[2], c[3]}; unsigned w[8];
#pragma unroll
          for (int j = 0; j < 8; ++j) { const float x = v[j] * (1.0f / 256.0f); const unsigned hb = f2bf(x); const float xr = __builtin_bit_cast(float, hb << 16); w[j] = (row < 16) ? hb : f2bf(x - xr); }
          v4u o; o.x = w[0] | (w[1] << 16); o.y = w[2] | (w[3] << 16); o.z = w[4] | (w[5] << 16); o.w = w[6] | (w[7] << 16);
          *(LAS v4u*)(lds + KMT + row * 256 + ((ch ^ (row & 15)) << 4)) = o; }
        __syncthreads();
        f32x16 g = (f32x16){0.f,0.f,0.f,0.f,0.f,0.f,0.f,0.f,0.f,0.f,0.f,0.f,0.f,0.f,0.f,0.f};
        { const bf16* qp = Qg + (size_t)(32 * wid + r32) * 1024 + 8 * hi;
          const LAS unsigned char* kb = lds + KMT + r32 * 256;
#pragma unroll
          for (int s = 0; s < 8; ++s) { const bf16x8 qv = *(const GAS bf16x8*)(qp + 16 * s);
              const bf16x8 kf = *(const LAS bf16x8*)(kb + (((2 * s + hi) ^ (r32 & 15)) << 4));
              g = __builtin_amdgcn_mfma_f32_32x32x16_bf16(kf, qv, g, 0, 0, 0); } }
        float G[16];
#pragma unroll
        for (int r = 0; r < 8; ++r) { const float mine = g[r] + g[r + 8]; const float oth = __shfl_xor(mine, 32);
            const int nlo = (r & 3) + 8 * (r >> 2); G[nlo] = hi ? oth : mine; G[nlo + 4] = hi ? mine : oth; }
#pragma unroll
        for (int round = 0; round < 3; ++round) { float best = -INFINITY; int bi = -1;
#pragma unroll
            for (int n = 0; n < 16; ++n) { const bool ok = (n < qb) && !((sel >> n) & 1u) && (G[n] > best); best = ok ? G[n] : best; bi = ok ? n : bi; }
            if (bi >= 0) sel |= 1u << bi; }
        __syncthreads();
    }
    f32x16 o[4];
    attn_pass<128, true>(lds, Qg, A.ka + (size_t)(b * SEQ) * 1024 + h * 128, A.vt + (size_t)(h * 128) * T + b * SEQ, q0, sel, o, tid, wid, lane);
    bf16* op = A.oab + (size_t)(b * SEQ + q0 + 32 * wid + r32) * 2048 + h * 128 + 4 * hi;
#pragma unroll
    for (int d = 0; d < 4; ++d)
#pragma unroll
        for (int gq = 0; gq < 4; ++gq) { v2u w; w.x = cvtpk(o[d][4 * gq], o[d][4 * gq + 1]); w.y = cvtpk(o[d][4 * gq + 2], o[d][4 * gq + 3]); *(GAS v2u*)(op + 32 * d + 8 * gq) = w; }
}

__device__ __forceinline__ void diff_unit(LAS unsigned char* lds, const AttnArgs& A, int b, int h, int qb, int tid, int wid, int lane) {
    asm volatile("" : "+v"(tid), "+v"(lane));
    const int r32 = lane & 31, hi = lane >> 5, q0 = qb * 256;
    const size_t qrow = (size_t)(b * SEQ + q0);
    const bf16* Vtg = A.vt + (size_t)(1024 + h * 128) * T + b * SEQ;
    f32x16 o[4], o2[4];
    attn_pass_diff2(lds, A.qd + qrow * 1024 + h * 128, A.kd + (size_t)(b * SEQ) * 1024 + h * 128, Vtg, q0, o, o2, tid, wid, lane);
    float ss = 0.f;
#pragma unroll
    for (int d = 0; d < 4; ++d)
#pragma unroll
        for (int r = 0; r < 16; ++r) { const float v = o[d][r] - A.lam * o2[d][r]; o[d][r] = v; ss += v * v; }
    ss += __shfl_xor(ss, 32);
    const float rn = 1.0f / sqrtf(ss * (1.0f / 128.0f) + RMS_EPS) * A.one_minus_li;
    bf16* op = A.oab + (qrow + 32 * wid + r32) * 2048 + 1024 + h * 128 + 4 * hi;
    const float* gp = A.gain + h * 128 + 4 * hi;
#pragma unroll
    for (int d = 0; d < 4; ++d)
#pragma unroll
        for (int gq = 0; gq < 4; ++gq) { const f32x4 gn = *(const GAS f32x4*)(gp + 32 * d + 8 * gq);
            v2u w; w.x = cvtpk(o[d][4 * gq] * rn * gn[0], o[d][4 * gq + 1] * rn * gn[1]); w.y = cvtpk(o[d][4 * gq + 2] * rn * gn[2], o[d][4 * gq + 3] * rn * gn[3]);
            *(GAS v2u*)(op + 32 * d + 8 * gq) = w; }
}

__device__ __forceinline__ void attn_phase(LAS unsigned char* lds, const AttnArgs& A, int vcu, int G, int tid, int wid, int lane) {
    for (int ord = vcu; ord < 1024; ord += G) {
        const int i = ord >> 8, v = ord & 255, bh = v >> 3, s = v & 7;
        const int qb = (i & 1) ? 15 - s : s;
        if (i < 2) diff_unit(lds, A, bh >> 3, bh & 7, qb, tid, wid, lane);
        else moba_unit(lds, A, bh >> 3, bh & 7, qb, tid, wid, lane);
    }
}
}

namespace peer {
__device__ __forceinline__ int f2key(float f) { const int u = __builtin_bit_cast(int, f); return u ^ ((u >> 31) & 0x7fffffff); }
__device__ __forceinline__ float key2f(int k) { const int u = k ^ ((k >> 31) & 0x7fffffff); return __builtin_bit_cast(float, u); }
__device__ __forceinline__ int imax(int a, int b) { return a > b ? a : b; }
__device__ __forceinline__ int imin(int a, int b) { return a < b ? a : b; }

template <int OFF> __device__ __forceinline__ void sort16_desc(int (&v)[64]) {
#pragma unroll
    for (int k = 2; k <= 16; k <<= 1)
#pragma unroll
        for (int j = k >> 1; j > 0; j >>= 1)
#pragma unroll
            for (int i = 0; i < 16; ++i) { const int l = i ^ j;
                if (l > i) { const bool desc = ((i & k) == 0); const int a = v[OFF + i], b = v[OFF + l]; const int mx = imax(a, b), mn = imin(a, b);
                    v[OFF + i] = desc ? mx : mn; v[OFF + l] = desc ? mn : mx; } }
}
template <int OA, int OB> __device__ __forceinline__ void merge16_desc(int (&v)[64]) {
#pragma unroll
    for (int i = 0; i < 16; ++i) v[OA + i] = imax(v[OA + i], v[OB + 15 - i]);
#pragma unroll
    for (int j = 8; j > 0; j >>= 1)
#pragma unroll
        for (int i = 0; i < 16; ++i) { const int l = i ^ j;
            if (l > i) { const int a = v[OA + i], b = v[OA + l]; v[OA + i] = imax(a, b); v[OA + l] = imin(a, b); } }
}
__device__ __forceinline__ void top16_of_64(int (&v)[64]) {
    sort16_desc<0>(v); sort16_desc<16>(v); sort16_desc<32>(v); sort16_desc<48>(v);
    merge16_desc<0, 16>(v); merge16_desc<32, 48>(v); merge16_desc<0, 32>(v);
}
__device__ __forceinline__ float gelu_tanh(float x) {
    const float u = 0.7978845608028654f * (x + 0.044715f * x * x * x);
    const float e = __builtin_amdgcn_exp2f(2.0f * 1.4426950408889634f * u);
    const float th = 1.0f - 2.0f * __builtin_amdgcn_rcpf(e + 1.0f);
    return 0.5f * x * (1.0f + th);
}
constexpr int ETILE = 0, GTILE = 16384, SCR0 = 32768, XQ0 = 98304;

__device__ __forceinline__ void select_tile(LAS unsigned char* lds, const bf16* pq, const bf16* sk, int t0, int wid, int lane) {
    asm volatile("" : "+v"(lane));
    const int r32 = lane & 31, hi = lane >> 5, h = wid;
    LAS int* scr = (LAS int*)(lds + SCR0 + wid * 8192);
    int v[64];
#pragma unroll 1
    for (int c = 0; c < 2; ++c) {
        bf16x8 qf[8];
        { const bf16* qp = pq + (size_t)(t0 + r32) * 2048 + h * 256 + c * 128 + 8 * hi;
#pragma unroll
          for (int s = 0; s < 8; ++s) qf[s] = *(const GAS bf16x8*)(qp + 16 * s); }
        bf16x8 af[2][4];
        const bf16* ap0 = sk + ((size_t)((c * 8 + h) * 128 + r32)) * 128 + 8 * hi;
#pragma unroll
        for (int s = 0; s < 4; ++s) af[0][s] = *(const GAS bf16x8*)(ap0 + 16 * s);
        f32x16 sc;
#pragma unroll
        for (int hb = 0; hb < 8; ++hb) {
            if (hb + 1 < 8) { const bf16* ap = ap0 + (size_t)(32 * ((hb + 1) >> 1)) * 128 + 64 * ((hb + 1) & 1);
#pragma unroll
                for (int s = 0; s < 4; ++s) af[(hb + 1) & 1][s] = *(const GAS bf16x8*)(ap + 16 * s); }
            __builtin_amdgcn_sched_barrier(0);
            if ((hb & 1) == 0) sc = (f32x16){0.f,0.f,0.f,0.f,0.f,0.f,0.f,0.f,0.f,0.f,0.f,0.f,0.f,0.f,0.f,0.f};
#pragma unroll
            for (int s = 0; s < 4; ++s) sc = __builtin_amdgcn_mfma_f32_32x32x16_bf16(af[hb & 1][s], qf[4 * (hb & 1) + s], sc, 0, 0, 0);
            if (hb & 1) {
#pragma unroll
                for (int r = 0; r < 16; ++r) v[(hb >> 1) * 16 + r] = (f2key(sc[r]) & ~127) | (32 * (hb >> 1) + (r & 3) + 8 * (r >> 2) + 4 * hi); }
            __builtin_amdgcn_sched_barrier(0);
        }
        top16_of_64(v);
#pragma unroll
        for (int i = 0; i < 16; ++i) v[16 + i] = __shfl_xor(v[i], 32);
        merge16_desc<0, 16>(v);
#pragma unroll
        for (int i = 0; i < 16; ++i) scr[(c * 16 + i) * 64 + lane] = v[i];
    }
    LDS_WAIT();
    float a[16], b[16];
#pragma unroll
    for (int i = 0; i < 16; ++i) { a[i] = key2f(scr[i * 64 + lane] & ~127); b[i] = key2f(v[i] & ~127); }
    int n = 0;
#pragma unroll
    for (int i = 0; i < 16; ++i)
#pragma unroll
        for (int j = 0; j < 16; ++j)
            if ((i + 1) * (j + 1) <= 16) { v[n] = (f2key(a[i] + b[j]) & ~255) | (i << 4) | j; ++n; }
#pragma unroll
    for (int i = 0; i < 64; ++i) if (i >= 50) v[i] = (int)0x80000000;
    top16_of_64(v);
    float s[16]; int e[16]; float mx = -INFINITY;
#pragma unroll
    for (int k = 0; k < 16; ++k) { const int i = (v[k] >> 4) & 15, j = v[k] & 15;
        const int ka = scr[i * 64 + lane], kb2 = scr[(16 + j) * 64 + lane];
        s[k] = key2f(ka & ~127) + key2f(kb2 & ~127); e[k] = (ka & 127) * 128 + (kb2 & 127); mx = fmaxf(mx, s[k]); }
    float sum = 0.f;
#pragma unroll
    for (int k = 0; k < 16; ++k) { s[k] = __builtin_amdgcn_exp2f((s[k] - mx) * 1.4426950408889634f); sum += s[k]; }
    const float inv = 1.0f / sum;
    if (hi == 0) {
        LAS int* E = (LAS int*)(lds + ETILE) + r32 * 128 + h * 16; LAS float* Gt = (LAS float*)(lds + GTILE) + r32 * 128 + h * 16;
#pragma unroll
        for (int k = 0; k < 16; ++k) { E[k] = e[k]; Gt[k] = s[k] * inv; }
    }
}

#define PEER_LOADROW(dst, tab, ridx) do { dst = *((const GAS v4u*)((tab) + (size_t)(ridx) * 1024) + lane); } while (0)
typedef float f32x2p __attribute__((ext_vector_type(2)));
#define PEER_CVT4(w) const f32x2p c0_ = __builtin_amdgcn_cvt_scalef32_pk_f32_fp4((w), 1.0f, 0), c1_ = __builtin_amdgcn_cvt_scalef32_pk_f32_fp4((w), 1.0f, 1), \
        c2_ = __builtin_amdgcn_cvt_scalef32_pk_f32_fp4((w), 1.0f, 2), c3_ = __builtin_amdgcn_cvt_scalef32_pk_f32_fp4((w), 1.0f, 3)
#define PEER_AXPY8(Y2, wk2, w, b) do { PEER_CVT4(w); Y2[(b)] = __builtin_elementwise_fma(wk2, c0_, Y2[(b)]); Y2[(b) + 1] = __builtin_elementwise_fma(wk2, c1_, Y2[(b) + 1]); \
        Y2[(b) + 2] = __builtin_elementwise_fma(wk2, c2_, Y2[(b) + 2]); Y2[(b) + 3] = __builtin_elementwise_fma(wk2, c3_, Y2[(b) + 3]); } while (0)

__device__ __forceinline__ void token_ffn(LAS unsigned char* lds, int tl, const bf16* xrow, const unsigned char* TU, const unsigned char* TV, const float* SU, const float* SV,
                                          const float* gain, const float* bias, float* outf, bf16* outb, unsigned char* out8, float* outsx, int lane,
                                          v4u (&buf)[16], bool have_u, bool has_next) {
    f32x2p xs[16];
#pragma unroll
    for (int q = 0; q < 4; ++q) { const v4u a = *(const GAS v4u*)(xrow + 32 * lane + 8 * q);
        xs[4 * q] = (f32x2p){bf_lo(a.x), bf_hi(a.x)}; xs[4 * q + 1] = (f32x2p){bf_lo(a.y), bf_hi(a.y)}; xs[4 * q + 2] = (f32x2p){bf_lo(a.z), bf_hi(a.z)}; xs[4 * q + 3] = (f32x2p){bf_lo(a.w), bf_hi(a.w)}; }
    const LAS int* E = (const LAS int*)(lds + ETILE) + tl * 128; const LAS float* Gt = (const LAS float*)(lds + GTILE) + tl * 128;
    const int e_lo = E[lane], e_hi = E[64 + lane]; const float g_lo = Gt[lane], g_hi = Gt[64 + lane];
    const float su_lo = SU[e_lo], su_hi = SU[e_hi], sv_lo = SV[e_lo], sv_hi = SV[e_hi];
#define PEER_EIDX(k) (((k) < 64) ? __builtin_amdgcn_readlane(e_lo, (k)) : __builtin_amdgcn_readlane(e_hi, (k) - 64))
    constexpr int PEER_RING = 16;
    float h_lo = 0.f, h_hi = 0.f;
    {
        float am = 0.f;
#pragma unroll
        for (int i = 0; i < 16; ++i) am = fmaxf(am, fmaxf(fabsf(xs[i].x), fabsf(xs[i].y)));
#pragma unroll
        for (int o = 1; o < 64; o <<= 1) am = fmaxf(am, __shfl_xor(am, o));
        const float sx = am > 0.f ? 6.0f / am : 1.0f, isx = am > 0.f ? am / 6.0f : 1.0f;
        v4u xh, xl;
#pragma unroll
        for (int wq = 0; wq < 4; ++wq) { unsigned wh = 0u, wl = 0u;
#define PEER_XQ(b) { const f32x2p v = xs[4 * wq + (b)] * sx; wh = __builtin_amdgcn_cvt_scalef32_pk_fp4_f32(wh, v.x, v.y, 1.0f, (b)); \
                const f32x2p d = __builtin_amdgcn_cvt_scalef32_pk_f32_fp4(wh, 1.0f, (b)); wl = __builtin_amdgcn_cvt_scalef32_pk_fp4_f32(wl, (v.x - d.x) * 4.0f, (v.y - d.y) * 4.0f, 1.0f, (b)); }
            PEER_XQ(0) PEER_XQ(1) PEER_XQ(2) PEER_XQ(3)
#undef PEER_XQ
            xh[wq] = wh; xl[wq] = wl; }
        LAS unsigned char* xq = lds + XQ0 + (tl >> 2) * 2048;
        *(LAS v4u*)(xq + 16 * lane) = xh; *(LAS v4u*)(xq + 1024 + 16 * lane) = xl;
        const int g = lane >> 4, rl = lane & 15;
        typedef int v8i_t __attribute__((ext_vector_type(8)));
        if (!have_u) { const int e_r = E[16 * 0 + rl];
#pragma unroll
            for (int s = 0; s < 16; ++s) buf[s] = *(const GAS v4u*)(TU + (size_t)e_r * 1024 + 16 * g + 64 * s); }
#define PEER_HBLOCK(rb, RELOAD) do { \
            f32x4 ah = {0.f, 0.f, 0.f, 0.f}, al = {0.f, 0.f, 0.f, 0.f}; \
            int xoff = 16 * g; asm volatile("" : "+v"(xoff));        \
            const LAS unsigned char* xbb = xq + xoff; \
            _Pragma("unroll") for (int s = 0; s < 16; ++s) { \
                const v4u a4 = buf[s]; const v4u bh = *(const LAS v4u*)(xbb + 64 * s), bl = *(const LAS v4u*)(xbb + 1024 + 64 * s); \
                const v8i_t A = {(int)a4.x, (int)a4.y, (int)a4.z, (int)a4.w, 0, 0, 0, 0}, BH = {(int)bh.x, (int)bh.y, (int)bh.z, (int)bh.w, 0, 0, 0, 0}, BL = {(int)bl.x, (int)bl.y, (int)bl.z, (int)bl.w, 0, 0, 0, 0}; \
                ah = __builtin_amdgcn_mfma_scale_f32_16x16x128_f8f6f4(A, BH, ah, 4, 4, 0, 127, 0, 127); \
                al = __builtin_amdgcn_mfma_scale_f32_16x16x128_f8f6f4(A, BL, al, 4, 4, 0, 127, 0, 127); \
                RELOAD(s); } \
              \
            float selv = 0.f; \
            _Pragma("unroll") for (int r = 0; r < 4; ++r) { const float hv = (ah[r] + 0.25f * al[r]) * isx; const float t = __shfl(hv, 16 * ((lane >> 2) & 3)); selv = ((lane & 3) == r) ? t : selv; } \
            if ((rb) < 4) h_lo = ((lane >> 4) == (rb)) ? selv : h_lo; else h_hi = ((lane >> 4) == ((rb) - 4)) ? selv : h_hi; } while (0)
#define PEER_RELOAD_U(s) buf[s] = *(const GAS v4u*)(rown + 64 * (s))
#define PEER_RELOAD_V(s) PEER_LOADROW(buf[s], TV, PEER_EIDX(s))
#pragma unroll 1
        for (int rb = 0; rb < 7; ++rb) {
            const int e_n = E[16 * (rb + 1) + rl];
            const GAS unsigned char* rown = (const GAS unsigned char*)TU + (size_t)e_n * 1024 + 16 * g;
            PEER_HBLOCK(rb, PEER_RELOAD_U);
        }
        PEER_HBLOCK(7, PEER_RELOAD_V);
#undef PEER_RELOAD_U
#undef PEER_RELOAD_V
#undef PEER_HBLOCK
    }
    const float w_lo = g_lo * gelu_tanh(h_lo * su_lo) * sv_lo, w_hi = g_hi * gelu_tanh(h_hi * su_hi) * sv_hi;
    f32x2p y[16];
#pragma unroll
    for (int i = 0; i < 16; ++i) y[i] = (f32x2p){0.f, 0.f};
#pragma unroll 1
    for (int k0 = 0; k0 < 128 - PEER_RING; k0 += PEER_RING) {
        const int wsrc = __builtin_bit_cast(int, (k0 < 64) ? w_lo : w_hi);
        const int kb = k0 + PEER_RING;
        const int esrc = (kb < 64) ? e_lo : e_hi;
#pragma unroll
        for (int i = 0; i < PEER_RING; ++i) {
            const float wk = __builtin_bit_cast(float, __builtin_amdgcn_readlane(wsrc, (k0 & 63) + i));
            const v4u w = buf[i]; const f32x2p wk2 = {wk, wk};
            PEER_AXPY8(y, wk2, w.x, 0); PEER_AXPY8(y, wk2, w.y, 4); PEER_AXPY8(y, wk2, w.z, 8); PEER_AXPY8(y, wk2, w.w, 12);
            const int en = __builtin_amdgcn_readlane(esrc, (kb & 63) + i); PEER_LOADROW(buf[i], TV, en);
        }
    }
    {
        const int e_nx = has_next ? E[128 + (lane & 15)] : 0;
        const GAS unsigned char* rownx = (const GAS unsigned char*)TU + (size_t)e_nx * 1024 + 16 * (lane >> 4);
#pragma unroll
        for (int i = 0; i < PEER_RING; ++i) {
            const float wk = __builtin_bit_cast(float, __builtin_amdgcn_readlane(__builtin_bit_cast(int, w_hi), 48 + i));
            const v4u w = buf[i]; const f32x2p wk2 = {wk, wk};
            PEER_AXPY8(y, wk2, w.x, 0); PEER_AXPY8(y, wk2, w.y, 4); PEER_AXPY8(y, wk2, w.z, 8); PEER_AXPY8(y, wk2, w.w, 12);
            if (has_next) buf[i] = *(const GAS v4u*)(rownx + 64 * i);
        }
    }
    float sm = 0.f;
#pragma unroll
    for (int i = 0; i < 16; ++i) { y[i] = xs[i] * ALPHA + y[i]; sm += y[i].x + y[i].y; }
    const float mean = wave_sum(sm) * (1.0f / 2048.0f);
    float sq = 0.f;
#pragma unroll
    for (int i = 0; i < 16; ++i) { y[i] = y[i] - mean; sq += y[i].x * y[i].x + y[i].y * y[i].y; }
    const float rstd = 1.0f / sqrtf(wave_sum(sq) * (1.0f / 2048.0f) + LN_EPS);
    unsigned pk[16];
#pragma unroll
    for (int q = 0; q < 8; ++q) { const int c0 = 32 * lane + 4 * q;
        const f32x4 ga = *(const GAS f32x4*)(gain + c0), ba = *(const GAS f32x4*)(bias + c0);
        f32x4 o;
        o[0] = y[2 * q].x * rstd * ga[0] + ba[0]; o[1] = y[2 * q].y * rstd * ga[1] + ba[1]; o[2] = y[2 * q + 1].x * rstd * ga[2] + ba[2]; o[3] = y[2 * q + 1].y * rstd * ga[3] + ba[3];
        if (outf) *(GAS f32x4*)(outf + c0) = o;
        pk[2 * q] = pk2(o[0], o[1]); pk[2 * q + 1] = pk2(o[2], o[3]); }
    if (outb) {
#pragma unroll
        for (int q = 0; q < 4; ++q) *(GAS v4u*)(outb + 32 * lane + 8 * q) = (v4u){pk[4 * q], pk[4 * q + 1], pk[4 * q + 2], pk[4 * q + 3]};
        float am = 0.f;
#pragma unroll
        for (int i = 0; i < 16; ++i) am = fmaxf(am, fmaxf(fabsf(bf_lo(pk[i])), fabsf(bf_hi(pk[i]))));
#pragma unroll
        for (int o = 1; o < 64; o <<= 1) am = fmaxf(am, __shfl_xor(am, o));
        const float sc = am > 0.f ? 127.0f / am : 0.f;
#pragma unroll
        for (int q = 0; q < 2; ++q) { v4u w;
            w.x = q8pack(bf_lo(pk[8 * q]), bf_hi(pk[8 * q]), bf_lo(pk[8 * q + 1]), bf_hi(pk[8 * q + 1]), sc); w.y = q8pack(bf_lo(pk[8 * q + 2]), bf_hi(pk[8 * q + 2]), bf_lo(pk[8 * q + 3]), bf_hi(pk[8 * q + 3]), sc);
            w.z = q8pack(bf_lo(pk[8 * q + 4]), bf_hi(pk[8 * q + 4]), bf_lo(pk[8 * q + 5]), bf_hi(pk[8 * q + 5]), sc); w.w = q8pack(bf_lo(pk[8 * q + 6]), bf_hi(pk[8 * q + 6]), bf_lo(pk[8 * q + 7]), bf_hi(pk[8 * q + 7]), sc);
            *(GAS v4u*)(out8 + 32 * lane + 16 * q) = w; }
        if (lane == 0) *outsx = am * (1.0f / 127.0f); }
#undef PEER_EIDX
}
#undef PEER_LOADROW
#undef PEER_AXPY8
#undef PEER_CVT4
}

__device__ __forceinline__ void ln_row(const bf16* zrow, const float* gain, const float* bias, bf16* outb, int lane) {
    float v[32]; float s = 0.f;
#pragma unroll
    for (int q = 0; q < 4; ++q) { const v4u w = *(const GAS v4u*)(zrow + 32 * lane + 8 * q);
        v[8 * q] = bf_lo(w.x); v[8 * q + 1] = bf_hi(w.x); v[8 * q + 2] = bf_lo(w.y); v[8 * q + 3] = bf_hi(w.y); v[8 * q + 4] = bf_lo(w.z); v[8 * q + 5] = bf_hi(w.z); v[8 * q + 6] = bf_lo(w.w); v[8 * q + 7] = bf_hi(w.w); }
#pragma unroll
    for (int i = 0; i < 32; ++i) s += v[i];
    const float mean = wave_sum(s) * (1.0f / 2048.0f); float s2 = 0.f;
#pragma unroll
    for (int i = 0; i < 32; ++i) { v[i] -= mean; s2 += v[i] * v[i]; }
    const float rstd = 1.0f / sqrtf(wave_sum(s2) * (1.0f / 2048.0f) + LN_EPS);
#pragma unroll
    for (int q = 0; q < 4; ++q) { const int c0 = 32 * lane + 8 * q;
        const f32x4 g0 = *(const GAS f32x4*)(gain + c0), g1 = *(const GAS f32x4*)(gain + c0 + 4), b0 = *(const GAS f32x4*)(bias + c0), b1 = *(const GAS f32x4*)(bias + c0 + 4);
        v4u o; o.x = pk2(v[8 * q] * rstd * g0[0] + b0[0], v[8 * q + 1] * rstd * g0[1] + b0[1]); o.y = pk2(v[8 * q + 2] * rstd * g0[2] + b0[2], v[8 * q + 3] * rstd * g0[3] + b0[3]);
        o.z = pk2(v[8 * q + 4] * rstd * g1[0] + b1[0], v[8 * q + 5] * rstd * g1[1] + b1[1]); o.w = pk2(v[8 * q + 6] * rstd * g1[2] + b1[2], v[8 * q + 7] * rstd * g1[3] + b1[3]);
        *(GAS v4u*)(outb + c0) = o; }
}

__device__ __forceinline__ void ln_rows(const bf16* z, const float* gain, const float* bias, bf16* out, int m0, int stride, int lane) {
    f32x4 gg[8], bb[8];
#pragma unroll
    for (int q = 0; q < 8; ++q) { gg[q] = *(const GAS f32x4*)(gain + 32 * lane + 4 * q); bb[q] = *(const GAS f32x4*)(bias + 32 * lane + 4 * q); }
    v4u cur[4], nx1[4];
    if (m0 < T) { const int m1 = (m0 + stride < T) ? m0 + stride : m0;
#pragma unroll
        for (int q = 0; q < 4; ++q) { cur[q] = *(const GAS v4u*)(z + (size_t)m0 * 2048 + 32 * lane + 8 * q); nx1[q] = *(const GAS v4u*)(z + (size_t)m1 * 2048 + 32 * lane + 8 * q); } }
#pragma unroll 1
    for (int m = m0; m < T; m += stride) {
        v4u nxt[4];
        const int mn = (m + 2 * stride < T) ? m + 2 * stride : m;
#pragma unroll
        for (int q = 0; q < 4; ++q) nxt[q] = *(const GAS v4u*)(z + (size_t)mn * 2048 + 32 * lane + 8 * q);
        float v[32]; float s = 0.f;
#pragma unroll
        for (int q = 0; q < 4; ++q) { const v4u w = cur[q];
            v[8 * q] = bf_lo(w.x); v[8 * q + 1] = bf_hi(w.x); v[8 * q + 2] = bf_lo(w.y); v[8 * q + 3] = bf_hi(w.y); v[8 * q + 4] = bf_lo(w.z); v[8 * q + 5] = bf_hi(w.z); v[8 * q + 6] = bf_lo(w.w); v[8 * q + 7] = bf_hi(w.w); }
#pragma unroll
        for (int i = 0; i < 32; ++i) s += v[i];
        const float mean = wave_sum(s) * (1.0f / 2048.0f); float s2 = 0.f;
#pragma unroll
        for (int i = 0; i < 32; ++i) { v[i] -= mean; s2 += v[i] * v[i]; }
        const float rstd = 1.0f / sqrtf(wave_sum(s2) * (1.0f / 2048.0f) + LN_EPS);
#pragma unroll
        for (int q = 0; q < 4; ++q) { const f32x4 g0 = gg[2 * q], g1 = gg[2 * q + 1], b0 = bb[2 * q], b1 = bb[2 * q + 1];
            v4u o; o.x = pk2(v[8 * q] * rstd * g0[0] + b0[0], v[8 * q + 1] * rstd * g0[1] + b0[1]); o.y = pk2(v[8 * q + 2] * rstd * g0[2] + b0[2], v[8 * q + 3] * rstd * g0[3] + b0[3]);
            o.z = pk2(v[8 * q + 4] * rstd * g1[0] + b1[0], v[8 * q + 5] * rstd * g1[1] + b1[1]); o.w = pk2(v[8 * q + 6] * rstd * g1[2] + b1[2], v[8 * q + 7] * rstd * g1[3] + b1[3]);
            *(GAS v4u*)(out + (size_t)m * 2048 + 32 * lane + 8 * q) = o; }
#pragma unroll
        for (int q = 0; q < 4; ++q) { cur[q] = nx1[q]; nx1[q] = nxt[q]; }
    }
}

#if MK_CHECK
namespace chk {
constexpr int CW_ERR = 2048;
__device__ __forceinline__ unsigned hash32(unsigned x) { x ^= x >> 16; x *= 0x7feb352du; x ^= x >> 15; x *= 0x846ca68bu; x ^= x >> 16; return x; }
__device__ __forceinline__ float bf2f(bf16 v) { return __builtin_bit_cast(float, (unsigned)v << 16); }
__device__ __forceinline__ void report(gu32* ctl, int stage, float d2, float r2) { atomicAdd((float*)(ctl + CW_ERR + 2 * stage), d2); atomicAdd((float*)(ctl + CW_ERR + 2 * stage + 1), r2); }
__device__ __forceinline__ float dotcol(const bf16* xr, const float* win, int n, int lane) { float a = 0.f; for (int k = lane; k < 2048; k += 64) a += bf2f(xr[k]) * win[(size_t)k * INC + n]; return wave_sum(a); }
__device__ __forceinline__ void check_inproj(gu32* ctl, const bf16* xin, const int* pos, const float* win, const bf16* qa, const bf16* ka, const bf16* qd, const bf16* kd, const bf16* vt, const bf16* ga, const bf16* gb, int gw, int ngw, int lane) {
    for (int s = gw; s < 4096; s += ngw) {
        const unsigned hsh = hash32(s * 2654435761u + 12345u);
        const int t = hsh % T, kind = (hsh >> 14) % 8;
        const unsigned h2 = hash32(hsh);
        const bf16* xr = xin + (size_t)t * 2048;
        float ref, got;
        if (kind == 0 || kind == 1) { const int head = h2 % 8, i = (h2 >> 3) % 64, nb = (kind == 0 ? 0 : 1024) + head * 128;
            const float t1 = dotcol(xr, win, nb + i, lane), t2 = dotcol(xr, win, nb + i + 64, lane);
            const float ang = (float)pos[t] * powf(10000.0f, -(float)(2 * i) / 128.0f), c = cosf(ang), sn = sinf(ang);
            const bool second = (h2 >> 9) & 1; ref = second ? (t1 * sn + t2 * c) : (t1 * c - t2 * sn);
            const bf16* p = (kind == 0 ? qa : ka) + (size_t)t * 1024 + head * 128 + i + (second ? 64 : 0);
            got = bf2f(*p) / (kind == 0 ? QSCALE_A : 1.0f);
        } else if (kind == 3 || kind == 4) { const int head = h2 % 8, comp = (h2 >> 3) & 1, i = (h2 >> 4) % 32, nb = (kind == 3 ? 3072 : 4096) + head * 128 + comp * 64;
            const float t1 = dotcol(xr, win, nb + i, lane), t2 = dotcol(xr, win, nb + i + 32, lane);
            const float ang = (float)pos[t] * powf(10000.0f, -(float)(2 * i) / 64.0f), c = cosf(ang), sn = sinf(ang);
            const bool second = (h2 >> 9) & 1; ref = second ? (t1 * sn + t2 * c) : (t1 * c - t2 * sn);
            const bf16* p = (kind == 3 ? qd : kd) + (size_t)t * 1024 + head * 128 + comp * 64 + i + (second ? 32 : 0);
            got = bf2f(*p) / (kind == 3 ? QSCALE_B : 1.0f);
        } else if (kind == 2 || kind == 5) { const int c = h2 % 1024; ref = dotcol(xr, win, (kind == 2 ? 2048 : 5120) + c, lane); got = bf2f(vt[(size_t)((kind == 2 ? 0 : 1024) + c) * T + t]);
        } else { const int c = h2 % 2048; const float v = dotcol(xr, win, (kind == 6 ? 6144 : 8192) + c, lane); ref = 1.0f / (1.0f + expf(-v)); got = (float)((const unsigned char*)(kind == 6 ? ga : gb))[(size_t)t * 2048 + c] * (1.0f / 255.0f); }
        if (lane == 0) report(ctl, 0, (got - ref) * (got - ref), ref * ref);
    }
}
__device__ __forceinline__ void check_kmean(gu32* ctl, const bf16* ka, const float* kmean, int gw, int ngw, int lane) {
    for (int s = gw; s < 1024; s += ngw) { const unsigned hsh = hash32(s * 40503u + 77u); const int item = hsh % 512, d = (hsh >> 10) % 128; const int b = item >> 7, h = (item >> 4) & 7, blk = item & 15;
        float a = 0.f; for (int r = lane; r < 256; r += 64) a += bf2f(ka[(size_t)(b * SEQ + blk * 256 + r) * 1024 + h * 128 + d]); a = wave_sum(a);
        const float g = kmean[(size_t)item * 128 + d];
        if (lane == 0) report(ctl, 1, (g - a) * (g - a), a * a + 1.0f); }
}
__device__ __forceinline__ void check_attn(LAS unsigned char* lds, gu32* ctl, const att::AttnArgs& A, int vcu, int G, int tid, int lane, int wave) {
    LAS float* sc = (LAS float*)lds; LAS float* red = sc + 4096; LAS float* ovec = red + 64; LAS float* gsc = ovec + 256; LAS unsigned* selw = (LAS unsigned*)(gsc + 16);
    for (int s = vcu; s < 1024; s += G) {
        const unsigned hsh = hash32(s * 2246822519u + 99u); const bool moba = (s & 1);
        const int b = hsh % NB, h = (hsh >> 2) % NH; int t = (hsh >> 5) % SEQ; if ((s & 6) == 0) t = (t & 255) + 256 * ((hsh >> 20) % 3);
        const size_t row = (size_t)b * SEQ + t; const int own = t >> 8;
        float o0 = 0.f, o1 = 0.f;
        const int ncomp = moba ? 1 : 2;
        __syncthreads();
        if (moba) {
            if (tid < 16) { float a = -INFINITY; if (tid < own) { a = 0.f; for (int d = 0; d < 128; ++d) a += bf2f(A.qa[row * 1024 + h * 128 + d]) * A.kmean[((size_t)(b * 8 + h) * 16 + tid) * 128 + d]; } gsc[tid] = a; }
            __syncthreads();
            if (tid == 0) { unsigned sel = 0u; for (int r = 0; r < 3; ++r) { float best = -INFINITY; int bi = -1; for (int n = 0; n < own; ++n) { const float g = gsc[n]; if (!((sel >> n) & 1u) && g > best) { best = g; bi = n; } } if (bi >= 0) sel |= 1u << bi; } selw[0] = sel; }
            __syncthreads();
        }
        const unsigned sel = moba ? selw[0] : 0u;
        for (int comp = 0; comp < ncomp; ++comp) {
            const bf16* qp = moba ? A.qa + row * 1024 + h * 128 : A.qd + row * 1024 + h * 128 + comp * 64;
            const bf16* kb = moba ? A.ka + (size_t)b * SEQ * 1024 + h * 128 : A.kd + (size_t)b * SEQ * 1024 + h * 128 + comp * 64;
            const int dq = moba ? 128 : 64;
            float lmax = -INFINITY;
            for (int k = tid; k <= t; k += 512) { bool ok = true; if (moba) { const int kbk = k >> 8; ok = (kbk == own) || ((sel >> kbk) & 1u); }
                float a = -INFINITY; if (ok) { a = 0.f; for (int d = 0; d < dq; ++d) a += bf2f(qp[d]) * bf2f(kb[(size_t)k * 1024 + d]); }
                sc[k] = a; lmax = fmaxf(lmax, a); }
            lmax = fmaxf(lmax, __shfl_xor(lmax, 1)); lmax = fmaxf(lmax, __shfl_xor(lmax, 2)); lmax = fmaxf(lmax, __shfl_xor(lmax, 4)); lmax = fmaxf(lmax, __shfl_xor(lmax, 8)); lmax = fmaxf(lmax, __shfl_xor(lmax, 16)); lmax = fmaxf(lmax, __shfl_xor(lmax, 32));
            if (lane == 0) red[wave] = lmax;
            __syncthreads();
            float gmax = red[0]; for (int w = 1; w < 8; ++w) gmax = fmaxf(gmax, red[w]);
            float lsum = 0.f;
            for (int k = tid; k <= t; k += 512) { const float p = exp2f(sc[k] - gmax); sc[k] = p; lsum += p; }
            lsum = wave_sum(lsum);
            if (lane == 0) red[8 + wave] = lsum;
            __syncthreads();
            float gsum = 0.f; for (int w = 0; w < 8; ++w) gsum += red[8 + w];
            if (tid < 128) { const bf16* vp = A.vt + (size_t)((moba ? 0 : 1024) + h * 128 + tid) * T + (size_t)b * SEQ; float a = 0.f; for (int k = 0; k <= t; ++k) a += sc[k] * bf2f(vp[k]); a /= gsum; if (comp == 0) o0 = a; else o1 = a; }
            __syncthreads();
        }
        float ref = 0.f, got = 0.f;
        if (tid < 128) {
            if (moba) { ref = o0; got = bf2f(A.oab[row * 2048 + h * 128 + tid]); }
            else { ref = o0 - A.lam * o1; got = bf2f(A.oab[row * 2048 + 1024 + h * 128 + tid]); }
            ovec[tid] = ref;
        }
        __syncthreads();
        if (tid < 128 && !moba) { float ss = 0.f; for (int d = 0; d < 128; ++d) ss += ovec[d] * ovec[d]; ref = ref / sqrtf(ss * (1.0f / 128.0f) + RMS_EPS) * A.gain[h * 128 + tid] * A.one_minus_li; }
        float d2 = (tid < 128) ? (got - ref) * (got - ref) : 0.f, r2 = (tid < 128) ? ref * ref : 0.f;
        d2 = wave_sum(d2); r2 = wave_sum(r2);
        if (lane == 0 && wave < 2) report(ctl, moba ? 2 : 3, d2, r2);
        __syncthreads();
    }
}
__device__ __forceinline__ void check_merged(gu32* ctl, const bf16* oab, const bf16* ga, const bf16* gb, const bf16* merged, const float* wa, const float* wb, int gw, int ngw, int lane) {
    for (int s = gw; s < 2048; s += ngw) { const unsigned hsh = hash32(s * 3266489917u + 5u); const int t = hsh % T, c = (hsh >> 14) % 2048;
        float a = 0.f, b = 0.f; for (int k = lane; k < 1024; k += 64) { a += bf2f(oab[(size_t)t * 2048 + k]) * wa[(size_t)k * 2048 + c]; b += bf2f(oab[(size_t)t * 2048 + 1024 + k]) * wb[(size_t)k * 2048 + c]; }
        a = wave_sum(a); b = wave_sum(b);
        const float ref = ((float)((const unsigned char*)ga)[(size_t)t * 2048 + c] * a + (float)((const unsigned char*)gb)[(size_t)t * 2048 + c] * b) * (1.0f / 255.0f), got = bf2f(merged[(size_t)t * 2048 + c]);
        if (lane == 0) report(ctl, 4, (got - ref) * (got - ref), ref * ref); }
}
__device__ __forceinline__ void check_z(gu32* ctl, const bf16* merged, const float* wo, const bf16* xres, const bf16* z, int gw, int ngw, int lane) {
    for (int s = gw; s < 2048; s += ngw) { const unsigned hsh = hash32(s * 668265263u + 31u); const int t = hsh % T, c = (hsh >> 14) % 2048;
        float a = 0.f; for (int k = lane; k < 2048; k += 64) a += bf2f(merged[(size_t)t * 2048 + k]) * wo[(size_t)k * 2048 + c];
        a = wave_sum(a);
        const float got = bf2f(z[(size_t)t * 2048 + c]) - ALPHA * bf2f(xres[(size_t)t * 2048 + c]);
        if (lane == 0) report(ctl, 5, (got - a) * (got - a), a * a); }
}
}
#endif

constexpr int NPHASE = 2 + 8 * DEPTH;
#ifndef MK_ALIGN
#define MK_ALIGN true
#endif
#ifndef MK_SP2
#define MK_SP2 true
#endif
struct Params { const float* in[16]; float* out; unsigned char* ws; int ph_lo, ph_hi; };

__global__ void __launch_bounds__(NWAVES * 64, 2) mk_fwd(Params args) {
    extern __shared__ __attribute__((aligned(16))) unsigned char lds_raw[];
    Frame F;
    F.lds = (LAS unsigned char*)lds_raw;
    F.MISC = (volatile LAS unsigned*)(F.lds + MISC_OFF);
    F.tid = threadIdx.x; F.lane = F.tid & 63; F.wave = __builtin_amdgcn_readfirstlane(F.tid >> 6);
    F.G = gridDim.x; { const int bx = blockIdx.x; F.vcu = (F.G % 8 == 0) ? (bx % 8) * (F.G / 8) + bx / 8 : bx; }
    F.ws = args.ws; F.ctl = (gu32*)(args.ws + WS_CTL);
    unsigned char* const ws = args.ws;
    const float* const in_x = args.in[0]; const int* const in_pos = (const int*)args.in[1];
    const float *in_win = args.in[2], *in_wa = args.in[3], *in_wb = args.in[4], *in_wo = args.in[5], *in_dlam = args.in[6], *in_dgain = args.in[7];
    const float *in_ln1g = args.in[8], *in_ln1b = args.in[9], *in_ln2g = args.in[10], *in_ln2b = args.in[11], *in_pwq = args.in[12], *in_sk = args.in[13], *in_pu = args.in[14], *in_pv = args.in[15];
    float* const dout = args.out;

    for (int u = F.tid; u < (LDS_BYTES - LDSCTL_OFF) / 4; u += NWAVES * 64) ((LAS unsigned*)(F.lds + LDSCTL_OFF))[u] = 0u;
    __syncthreads();
#if MK_FUSED
    XcdBarrier bar = xcd_barrier_post((unsigned*)(F.ctl + CW_BAR), F.MISC + 8, (unsigned)F.wave);
#define GRID_BAR() xcd_barrier(bar)
#else
#define GRID_BAR() do { } while (0)
#endif
    const int lo = args.ph_lo, hi = args.ph_hi;
#define IN(k) (lo <= (k) && (k) < hi)
#define BOTH(k) (IN(k) && IN((k) + 1))

    float* const cosA = (float*)(ws + WS_ROPE); float* const sinA = cosA + (size_t)T * 64; float* const cosB = sinA + (size_t)T * 64; float* const sinB = cosB + (size_t)T * 32;
    bf16* const XB = (bf16*)(ws + WS_XB);

    gu32* const wmax = F.ctl + CW_WMAX;
    if (IN(0)) {
        for (int it = F.wave * F.G + F.vcu; it < DEPTH * 16 * 40; it += F.G * NWAVES) { const int layer = it / 640;
            p0_absmax_item(in_win + (size_t)layer * 2048 * 10240, it % 640, F.lane, wmax + layer * 10240); }
        if (BOTH(0)) GRID_BAR();
    }
    if (IN(1)) {
        LAS float* scr = (LAS float*)(F.lds + F.wave * 16384);
        const int gw = F.vcu * NWAVES + F.wave, NGW = F.G * NWAVES;
        constexpr int I_IN = (2048 / 64) * (10240 / 32), I_A = (1024 / 64) * (2048 / 32), I_O = (2048 / 64) * (2048 / 32);
        constexpr int PER_LAYER = I_IN + 2 * I_A + 2 * I_O;
        for (int it = gw; it < DEPTH * PER_LAYER; it += NGW) {
            const int layer = it / PER_LAYER; int r = it % PER_LAYER;
            unsigned char* wl = ws + WS_W + (size_t)layer * W_LAYER;
            if (r < I_IN) { p0_transpose_item_i8(in_win + (size_t)layer * 2048 * 10240, 2048, 10240, wl + WO_MAIN, scr, r, F.lane, wmax + layer * 10240); continue; } r -= I_IN;
            if (r < I_A) { p0_transpose_item<false>(in_wa + (size_t)layer * 1024 * 2048, 1024, 2048, (bf16*)(wl + WO_A), scr, r, F.lane, 2048, 0); continue; } r -= I_A;
            if (r < I_A) { p0_transpose_item<false>(in_wb + (size_t)layer * 1024 * 2048, 1024, 2048, (bf16*)(wl + WO_A), scr, r, F.lane, 2048, 1024); continue; } r -= I_A;
            if (r < I_O) { p0_transpose_item<false>(in_wo + (size_t)layer * 2048 * 2048, 2048, 2048, (bf16*)(wl + WO_O), scr, r, F.lane); continue; } r -= I_O;
            p0_transpose_item<false>(in_pwq + (size_t)layer * 2048 * 2048, 2048, 2048, (bf16*)(wl + WO_Q), scr, r, F.lane);
        }
        const size_t gtid = (size_t)F.vcu * 512 + F.tid, gthreads = (size_t)F.G * 512;
        { const int nA = (int)(((size_t)T * 64 + gthreads - 1) / gthreads), nB = (int)(((size_t)T * 32 + gthreads - 1) / gthreads);
#define P0_ROPE_ELEM(j) do { \
            if ((j) < nA) { const size_t i = gtid + (size_t)(j) * gthreads; if (i < (size_t)T * 64) { const int t = (int)(i >> 6), k = (int)(i & 63);                \
                const float invf = powf(10000.0f, -(float)(2 * k) / 128.0f); const float ang = (float)in_pos[t] * invf; cosA[i] = cosf(ang); sinA[i] = sinf(ang); } } \
            else if ((j) < nA + nB) { const size_t i = gtid + (size_t)((j) - nA) * gthreads; if (i < (size_t)T * 32) { const int t = (int)(i >> 5), k = (int)(i & 31);     \
                const float invf = powf(10000.0f, -(float)(2 * k) / 64.0f); const float ang = (float)in_pos[t] * invf; cosB[i] = cosf(ang); sinB[i] = sinf(ang); } } } while (0)
          int rj = 0;
          for (int r = gw; r < 4 * NEXP; r += NGW, ++rj) { const int tab = r >> 14, e = r & (NEXP - 1);
            const float* src = ((tab & 1) ? in_pv : in_pu) + ((size_t)(tab >> 1) * NEXP + e) * 2048;
            f32x4 tv[8]; p0_table_row_load(src, tv, F.lane);
            P0_ROPE_ELEM(rj);
            p0_table_row_finish(tv, ws + WS_TAB + (size_t)tab * TAB_BYTES + (size_t)e * 1024, (float*)(ws + WS_TSC) + r, F.lane); }
          for (; rj < nA + nB; ++rj) P0_ROPE_ELEM(rj);
#undef P0_ROPE_ELEM
        }
        p0_convert(in_sk, (bf16*)(ws + WS_SK), (size_t)DEPTH * 2 * 8 * 128 * 128 / 8, gtid, gthreads);
        for (int row = gw; row < T; row += NGW) p0_x_row(in_x + (size_t)row * 2048, XB + (size_t)row * 2048, ws + WS_XI8 + (size_t)row * 2048, (float*)(ws + WS_SX) + row, F.lane);
        for (size_t i = gtid; i < (size_t)DEPTH * 10240; i += gthreads) { const int layer = (int)(i / 10240), n = (int)(i % 10240);
            ((float*)(ws + WS_SW))[layer * 10240 + inproj_row(n)] = __builtin_bit_cast(float, wmax[layer * 10240 + n]) * (1.0f / 127.0f); }
        if (BOTH(1)) GRID_BAR();
    }

    for (int layer = 0; layer < DEPTH; ++layer) {
        const int pb = 2 + 8 * layer;
        unsigned char* const wl = ws + WS_W + (size_t)layer * W_LAYER;
        bf16* const ZB = (bf16*)dout;
        float* const kmean = (float*)(ws + WS_KMEAN) + (size_t)layer * NB * NH * 16 * 128;
        const float lambda_init = layer == 0 ? 0.2f : 0.3555090675909306f;
#define PHASE_TID() int llane_ = lane_id(); asm volatile("" : "+v"(llane_)); const int llane = llane_, ltid = llane_ + 64 * F.wave
        if (IN(pb)) {
            const bf16* const XI8 = (const bf16*)(ws + WS_XI8); const float* const sx = (const float*)(ws + WS_SX); const float* const sw = (const float*)(ws + WS_SW) + layer * 10240;
            { pg8::Gemm g{XI8, (const bf16*)(wl + WO_MAIN), T, NMAIN, 1024}; pg8::StaticOrder S; S.init(T, NMAIN, F.G, (int)blockIdx.x);
              pg8::EpiInProjI8 E{(bf16*)(ws + WS_QA), (bf16*)(ws + WS_KA), (bf16*)(ws + WS_QD), (bf16*)(ws + WS_KD), (bf16*)(ws + WS_GA), (bf16*)(ws + WS_GB), cosA, sinA, cosB, sinB, QSCALE_A, QSCALE_B, sx, sw};
              pg8::gemm_phase<pg8::EpiInProjI8, pg8::StaticOrder, MK_ALIGN, MK_SP2, false, true>(F.lds, g, S, E, F.wave); }
            { pg8::Gemm g{(const bf16*)(wl + WO_V), XI8, NV, T, 1024}; pg8::StaticOrder S; S.init(NV, T, F.G, (int)blockIdx.x);
              pg8::EpiPlainI8 E{(bf16*)(ws + WS_VT), T, sw + NMAIN, sx};
              pg8::gemm_phase<pg8::EpiPlainI8, pg8::StaticOrder, MK_ALIGN, MK_SP2, false, true>(F.lds, g, S, E, F.wave); }
            if (BOTH(pb)) GRID_BAR();
        }
        if (IN(pb + 1)) {
            PHASE_TID();
            LAS float* part = (LAS float*)F.lds;
            const bf16* KA = (const bf16*)(ws + WS_KA);
#pragma unroll 1
            for (int item = F.vcu; item < NB * NH * 16; item += F.G) {
                const int b = item >> 7, h = (item >> 4) & 7, blk = item & 15;
                const int c = ltid & 15, rg = ltid >> 4;
                const bf16* kp = KA + (size_t)(b * SEQ + blk * 256 + rg) * 1024 + h * 128 + c * 8;
                float sacc[8] = {0.f, 0.f, 0.f, 0.f, 0.f, 0.f, 0.f, 0.f};
#pragma unroll
                for (int i = 0; i < 8; ++i) { const v4u w = *(const GAS v4u*)(kp + (size_t)(32 * i) * 1024);
                    sacc[0] += bf_lo(w.x); sacc[1] += bf_hi(w.x); sacc[2] += bf_lo(w.y); sacc[3] += bf_hi(w.y); sacc[4] += bf_lo(w.z); sacc[5] += bf_hi(w.z); sacc[6] += bf_lo(w.w); sacc[7] += bf_hi(w.w); }
#pragma unroll
                for (int j = 0; j < 8; ++j) part[rg * 128 + c * 8 + j] = sacc[j];
                __syncthreads();
                if (ltid < 128) { float t = 0.f;
#pragma unroll
                    for (int r = 0; r < 32; ++r) t += part[r * 128 + ltid];
                    kmean[(size_t)item * 128 + ltid] = t; }
                __syncthreads();
            }
            if (BOTH(pb + 1)) GRID_BAR();
        }
        if (IN(pb + 2)) {
            PHASE_TID();
            const float* lp = in_dlam + (size_t)layer * 256;
            const float s1 = wave_sum(lp[llane] * lp[64 + llane]), s2 = wave_sum(lp[128 + llane] * lp[192 + llane]);
            float lam = __builtin_bit_cast(float, __builtin_amdgcn_readfirstlane(__builtin_bit_cast(int, expf(s1) - expf(s2) + lambda_init))), oml = __builtin_bit_cast(float, __builtin_amdgcn_readfirstlane(layer == 0 ? 0x3f4ccccd : 0x3f24fd5c));
            att::AttnArgs A{(const bf16*)(ws + WS_QA), (const bf16*)(ws + WS_KA), (const bf16*)(ws + WS_QD), (const bf16*)(ws + WS_KD), (const bf16*)(ws + WS_VT),
                            (bf16*)(ws + WS_OA), kmean, in_dgain + (size_t)layer * 1024, lam, oml};
            att::attn_phase(F.lds, A, F.vcu, F.G, ltid, F.wave, llane);
            if (BOTH(pb + 2)) GRID_BAR();
        }
        if (IN(pb + 3)) {
            { pg8::Gemm g{(const bf16*)(ws + WS_OA), (const bf16*)(wl + WO_A), T, 2048, 2048}; pg8::StaticOrder S; S.init(T, 2048, F.G, (int)blockIdx.x);
              pg8::EpiBranch E{(const bf16*)(ws + WS_GA), (const bf16*)(ws + WS_GB), (bf16*)(ws + WS_MERGED), 2048};
              pg8::gemm_phase<pg8::EpiBranch, pg8::StaticOrder, MK_ALIGN, MK_SP2, true>(F.lds, g, S, E, F.wave); }
            if (BOTH(pb + 3)) GRID_BAR();
        }
        if (IN(pb + 4)) {
            pg8::Gemm g{(const bf16*)(ws + WS_MERGED), (const bf16*)(wl + WO_O), T, 2048, 2048}; pg8::StaticOrder S; S.init(T, 2048, F.G, (int)blockIdx.x);
            pg8::EpiOutProj E{XB, ZB, 2048, ALPHA};
            pg8::gemm_phase<pg8::EpiOutProj, pg8::StaticOrder, MK_ALIGN, MK_SP2>(F.lds, g, S, E, F.wave);
            if (BOTH(pb + 4)) GRID_BAR();
        }
        if (IN(pb + 5)) {
            PHASE_TID();
            const int gw = F.vcu * NWAVES + F.wave, NGW = F.G * NWAVES;
            ln_rows(ZB, in_ln1g + (size_t)layer * 2048, in_ln1b + (size_t)layer * 2048, XB, gw, NGW, llane);
            if (BOTH(pb + 5)) GRID_BAR();
        }
        if (IN(pb + 6)) {
            pg8::Gemm g{XB, (const bf16*)(wl + WO_Q), T, 2048, 2048}; pg8::StaticOrder S; S.init(T, 2048, F.G, (int)blockIdx.x);
            pg8::EpiPlainBf16 E{(bf16*)(ws + WS_PQ), 2048};
            pg8::gemm_phase<pg8::EpiPlainBf16, pg8::StaticOrder, MK_ALIGN, MK_SP2>(F.lds, g, S, E, F.wave);
            if (BOTH(pb + 6)) GRID_BAR();
        }
        if (IN(pb + 7)) {
            const unsigned char* TU = ws + WS_TAB + (size_t)(2 * layer) * TAB_BYTES; const unsigned char* TV = ws + WS_TAB + (size_t)(2 * layer + 1) * TAB_BYTES;
            const float* SU = (const float*)(ws + WS_TSC) + (size_t)(2 * layer) * NEXP; const float* SV = SU + NEXP;
            const bf16* sk = (const bf16*)(ws + WS_SK) + (size_t)layer * 2 * 8 * 128 * 128;
            const bool last = (layer == DEPTH - 1);
            PHASE_TID();
            v4u* const pscr = (v4u*)(ws + WS_PSCR + (size_t)F.vcu * 32768);
#pragma unroll 1
            for (int ta = F.vcu; ta < T / 32; ta += 2 * F.G) {
                const int tb = ta + F.G; const bool pair = tb < T / 32, sw = pair && (F.vcu & 1);
                const int nst = sw ? 6 : (pair ? 4 : 2);
#pragma unroll 1
                for (int st = 0; st < nst; ++st) {
                    int op, tile;
                    if (sw) { op = (st == 0 || st == 2) ? 0 : (st == 1 ? 2 : (st == 4 ? 3 : 1)); tile = (st == 0 || st == 5) ? tb : ta; }
                    else { op = st & 1; tile = st < 2 ? ta : tb; }
                    const int t0 = tile * 32;
                    if (op == 0) peer::select_tile(F.lds, (const bf16*)(ws + WS_PQ), sk, t0, F.wave, llane);
                    else if (op == 1) {
                    v4u ring[16];
#pragma unroll
                    for (int s = 0; s < 16; ++s) ring[s] = (v4u){0u, 0u, 0u, 0u};
#pragma unroll 1
                    for (int i = 0; i < 4; ++i) { const int tl = F.wave * 4 + i; const size_t t = (size_t)(t0 + tl);
                        peer::token_ffn(F.lds, tl, XB + t * 2048, TU, TV, SU, SV, in_ln2g + (size_t)layer * 2048, in_ln2b + (size_t)layer * 2048, last ? dout + t * 2048 : (float*)nullptr, last ? (bf16*)nullptr : XB + t * 2048, ws + WS_XI8 + t * 2048, (float*)(ws + WS_SX) + t, llane, ring, i > 0, i < 3); }
                    } else if (op == 2) {
#pragma unroll
                        for (int q = 0; q < 4; ++q) pscr[ltid + 512 * q] = *(const LAS v4u*)(F.lds + (size_t)(ltid + 512 * q) * 16);
                    } else {
#pragma unroll
                        for (int q = 0; q < 4; ++q) *(LAS v4u*)(F.lds + (size_t)(ltid + 512 * q) * 16) = pscr[ltid + 512 * q];
                    }
                    __syncthreads();
                }
            }
            if (BOTH(pb + 7)) GRID_BAR();
        }
    }
#undef PHASE_TID
#undef IN
#undef BOTH
#undef GRID_BAR
}

#if MK_CHECK
__global__ void __launch_bounds__(NWAVES * 64, 2) chk_kernel(Params args, int layer, int which) {
    extern __shared__ __attribute__((aligned(16))) unsigned char lds_raw[];
    LAS unsigned char* lds = (LAS unsigned char*)lds_raw;
    const int tid = threadIdx.x, lane = tid & 63, wave = __builtin_amdgcn_readfirstlane(tid >> 6), G = gridDim.x, vcu = blockIdx.x;
    unsigned char* const ws = args.ws; gu32* ctl = (gu32*)(ws + WS_CTL);
    const bf16* xresb = (const bf16*)(ws + WS_XB);
    float* const kmean = (float*)(ws + WS_KMEAN) + (size_t)layer * NB * NH * 16 * 128;
    const float lambda_init = layer == 0 ? 0.2f : 0.3555090675909306f;
    const int gw = vcu * NWAVES + wave, NGW = G * NWAVES;
    if (which == 0) {
        const float* lp = args.in[6] + (size_t)layer * 256;
        const float s1 = wave_sum(lp[lane] * lp[64 + lane]), s2 = wave_sum(lp[128 + lane] * lp[192 + lane]);
        const float lam = expf(s1) - expf(s2) + lambda_init;
        att::AttnArgs A{(const bf16*)(ws + WS_QA), (const bf16*)(ws + WS_KA), (const bf16*)(ws + WS_QD), (const bf16*)(ws + WS_KD), (const bf16*)(ws + WS_VT),
                        (bf16*)(ws + WS_OA), kmean, args.in[7] + (size_t)layer * 1024, lam, 1.0f - lambda_init};
        chk::check_inproj(ctl, xresb, (const int*)args.in[1], args.in[2] + (size_t)layer * 2048 * 10240, A.qa, A.ka, A.qd, A.kd, A.vt, (const bf16*)(ws + WS_GA), (const bf16*)(ws + WS_GB), gw, NGW, lane);
        chk::check_kmean(ctl, A.ka, kmean, gw, NGW, lane);
        chk::check_attn(lds, ctl, A, vcu, G, tid, lane, wave);
    } else if (which == 3) {
        const float oscale = 1.0f + 0.04f * (float)__hip_atomic_load(ctl + chk::CW_ERR + 64, RLX_AGENT);
        for (size_t i = (size_t)vcu * 512 + tid; i < (size_t)T * 2048 / 4; i += (size_t)G * 512) { f32x4 v = *(GAS f32x4*)(args.out + i * 4); v = v * oscale; *(GAS f32x4*)(args.out + i * 4) = v; }
    } else if (which == 2) {
        if (vcu == 0 && tid == 0) { const float tol[6] = {1e-3f, 1e-4f, 3e-2f, 3e-3f, 1e-3f, 1e-3f}; unsigned code = 0;
            for (int st = 0; st < 6; ++st) { const float d2 = __builtin_bit_cast(float, __hip_atomic_load(ctl + chk::CW_ERR + 2 * st, RLX_AGENT)), r2 = __builtin_bit_cast(float, __hip_atomic_load(ctl + chk::CW_ERR + 2 * st + 1, RLX_AGENT));
                if (!(d2 <= tol[st] * r2) || !(r2 > 0.f)) code |= 1u << st; }
#ifdef MK_CHECK_STAGE
            { const float d2 = __builtin_bit_cast(float, __hip_atomic_load(ctl + chk::CW_ERR + 2 * MK_CHECK_STAGE, RLX_AGENT)), r2 = __builtin_bit_cast(float, __hip_atomic_load(ctl + chk::CW_ERR + 2 * MK_CHECK_STAGE + 1, RLX_AGENT));
              float ratio = d2 / r2; ratio = fminf(fmaxf(ratio, 1e-8f), 1e4f); code = (unsigned)(int)(4.0f * (log10f(ratio) + 8.0f) + 0.5f); }
#endif
            __hip_atomic_store(ctl + chk::CW_ERR + 64, code, RLX_AGENT); }
    } else {
        chk::check_merged(ctl, (const bf16*)(ws + WS_OA), (const bf16*)(ws + WS_GA), (const bf16*)(ws + WS_GB), (const bf16*)(ws + WS_MERGED), args.in[3] + (size_t)layer * 1024 * 2048, args.in[4] + (size_t)layer * 1024 * 2048, gw, NGW, lane);
        chk::check_z(ctl, (const bf16*)(ws + WS_MERGED), args.in[5] + (size_t)layer * 2048 * 2048, xresb, (const bf16*)args.out, gw, NGW, lane);
    }
}
#endif

extern "C" void kernel_launch(void* const* d_in, const int* in_sizes, int n_in, void* d_out, int out_size, void* d_ws, size_t ws_size, hipStream_t stream) {
    static int grid = 0;
    if (grid == 0) {
        if (n_in != 16 || out_size != T * DM || ws_size < WS_END) { fprintf(stderr, "kernel_launch: unexpected problem (n_in %d, out %d, ws %zu < %zu); nothing launched\n", n_in, out_size, ws_size, (size_t)WS_END); grid = -1; return; }
        int dev = 0, cus = 0, per_cu = 0;
        if (hipGetDevice(&dev) != hipSuccess || hipDeviceGetAttribute(&cus, hipDeviceAttributeMultiprocessorCount, dev) != hipSuccess) { fprintf(stderr, "kernel_launch: device query failed\n"); grid = -1; return; }
#if MK_CHECK
        (void)hipFuncSetAttribute((const void*)chk_kernel, hipFuncAttributeMaxDynamicSharedMemorySize, LDS_BYTES);
#endif
        if (hipFuncSetAttribute((const void*)mk_fwd, hipFuncAttributeMaxDynamicSharedMemorySize, LDS_BYTES) != hipSuccess) { fprintf(stderr, "kernel_launch: hipFuncSetAttribute failed\n"); grid = -1; return; }
        if (hipOccupancyMaxActiveBlocksPerMultiprocessor(&per_cu, (const void*)mk_fwd, NWAVES * 64, LDS_BYTES) != hipSuccess || per_cu < 1) { fprintf(stderr, "kernel_launch: occupancy query says %d blocks per CU; nothing launched\n", per_cu); (void)hipGetLastError(); grid = -1; return; }
        grid = cus;
    }
    if (grid < 0) return;
    (void)hipMemsetAsync((char*)d_ws + WS_CTL, 0, CTL_ZERO_BYTES, stream);
    Params a{};
    for (int i = 0; i < 16; ++i) a.in[i] = (const float*)d_in[i];
    a.out = (float*)d_out; a.ws = (unsigned char*)d_ws;
#if MK_FUSED
    a.ph_lo = 0; a.ph_hi = NPHASE;
    hipLaunchKernelGGL(mk_fwd, dim3(grid), dim3(NWAVES * 64), LDS_BYTES, stream, a);
#else
    for (int ph = 0; ph < NPHASE; ++ph) { a.ph_lo = ph; a.ph_hi = ph + 1; hipLaunchKernelGGL(mk_fwd, dim3(grid), dim3(NWAVES * 64), LDS_BYTES, stream, a);
#if MK_CHECK
        if (ph == 2 + 8 * MK_CHECK_LAYER + 2) hipLaunchKernelGGL(chk_kernel, dim3(grid), dim3(NWAVES * 64), LDS_BYTES, stream, a, (int)MK_CHECK_LAYER, 0);
        if (ph == 2 + 8 * MK_CHECK_LAYER + 4) hipLaunchKernelGGL(chk_kernel, dim3(grid), dim3(NWAVES * 64), LDS_BYTES, stream, a, (int)MK_CHECK_LAYER, 1);
        if (ph == NPHASE - 2) hipLaunchKernelGGL(chk_kernel, dim3(grid), dim3(NWAVES * 64), LDS_BYTES, stream, a, (int)MK_CHECK_LAYER, 2);
        if (ph == NPHASE - 1) hipLaunchKernelGGL(chk_kernel, dim3(grid), dim3(NWAVES * 64), LDS_BYTES, stream, a, (int)MK_CHECK_LAYER, 3);
#endif
    }
#endif
}
```

```cpp
#include <hip/hip_runtime.h>
#include <cstdio>
#include <cstdint>

#ifndef MK_FUSED
#define MK_FUSED 1
#endif
#ifndef MK_CHECK
#define MK_CHECK 0
#endif
#ifndef MK_CHECK_LAYER
#define MK_CHECK_LAYER 0
#endif

namespace cfg {
constexpr int DM = 2048, NB = 4, SEQ = 4096, T = NB * SEQ, DEPTH = 2;
constexpr int NH = 8, HD = 128, AW = NH * HD;
constexpr int INC = 10240;
constexpr int NMAIN = 8192, NV = 2048;
constexpr int PH = 8, PKEYS = 128, PTOP = 16, NEXP = PKEYS * PKEYS, PHALF = 128;
constexpr float LN_EPS = 1e-5f, RMS_EPS = 1e-6f;
constexpr float ALPHA = 1.4142135623730951f;
constexpr float LOG2E = 1.4426950408889634f;
constexpr float QSCALE_A = 0.08838834764831845f * LOG2E;
constexpr float QSCALE_B = 0.125f * LOG2E;
}
using namespace cfg;

constexpr size_t MiB = 1u << 20;
constexpr size_t WS_CTL = 0, CTL_ZERO_BYTES = 1 * MiB;
constexpr size_t WS_SK = 1 * MiB;
constexpr size_t WS_KMEAN = MiB / 2;
constexpr size_t WS_TSC = 3 * MiB;
constexpr size_t WS_ROPE = 4 * MiB;
constexpr size_t WS_W = 20 * MiB, W_LAYER = 64 * MiB;
constexpr size_t WO_MAIN = 0, WO_V = 16 * MiB, WO_A = 40 * MiB, WO_O = 48 * MiB, WO_Q = 56 * MiB;
constexpr size_t WS_TAB = 148 * MiB, TAB_BYTES = 16 * MiB;
constexpr size_t WS_XI8 = 212 * MiB;
constexpr size_t WS_SX = 244 * MiB;
constexpr size_t WS_SW = 245 * MiB;
constexpr size_t WS_PSCR = 248 * MiB;
constexpr size_t WS_XB = 404 * MiB;
constexpr size_t WS_QA = 596 * MiB, WS_KA = 628 * MiB, WS_QD = 660 * MiB, WS_KD = 692 * MiB;
constexpr size_t WS_PQ = WS_QA;
constexpr size_t WS_VT = 724 * MiB;
constexpr size_t WS_MERGED = WS_VT;
constexpr size_t WS_GA = 788 * MiB, WS_GB = 852 * MiB;
constexpr size_t WS_OA = 916 * MiB;
constexpr size_t WS_END = 980 * MiB;

constexpr int CW_BAR = 4096;
constexpr int CW_WMAX = 16384;

constexpr int RING_BYTES = 131072;
constexpr int LDSCTL_OFF = RING_BYTES, MISC_OFF = LDSCTL_OFF + 320;
constexpr int LDS_BYTES = 147456;
constexpr int NWAVES = 8;

#define GAS __attribute__((address_space(1)))
#define LAS __attribute__((address_space(3)))
typedef unsigned short bf16;
typedef unsigned v4u __attribute__((ext_vector_type(4)));
typedef unsigned v2u __attribute__((ext_vector_type(2)));
typedef float f32x4 __attribute__((ext_vector_type(4)));
typedef float f32x16 __attribute__((ext_vector_type(16)));
typedef short bf16x8 __attribute__((ext_vector_type(8)));
typedef GAS unsigned gu32;
#define RLX_AGENT __ATOMIC_RELAXED, __HIP_MEMORY_SCOPE_AGENT
#define LDS_WAIT() asm volatile("s_waitcnt lgkmcnt(0)" ::: "memory")
#define VM_WAIT() asm volatile("s_waitcnt vmcnt(0)" ::: "memory")
__device__ __forceinline__ unsigned f2bf(float f) { unsigned u = __builtin_bit_cast(unsigned, f); return (u + 0x7fffu + ((u >> 16) & 1u)) >> 16; }
typedef float f32x2pk __attribute__((ext_vector_type(2))); typedef __bf16 bf16x2pk __attribute__((ext_vector_type(2)));
__device__ __forceinline__ unsigned pk2(float lo, float hi) { f32x2pk v = {lo, hi}; bf16x2pk b = __builtin_convertvector(v, bf16x2pk); return __builtin_bit_cast(unsigned, b); }
__device__ __forceinline__ float bf_lo(unsigned w) { return __builtin_bit_cast(float, w << 16); }
__device__ __forceinline__ float bf_hi(unsigned w) { return __builtin_bit_cast(float, w & 0xffff0000u); }
__device__ __forceinline__ float fexp2(float x) { return __builtin_amdgcn_exp2f(x); }
__device__ __forceinline__ float frcp(float x) { return __builtin_amdgcn_rcpf(x); }
__device__ __forceinline__ int lane_id() { return (int)__builtin_amdgcn_mbcnt_hi(~0u, __builtin_amdgcn_mbcnt_lo(~0u, 0u)); }
__device__ __forceinline__ float wave_sum(float v) {
#pragma unroll
    for (int o = 1; o < 64; o <<= 1) v += __shfl_xor(v, o);
    return v;
}
namespace pg8 {
#define PG8_LAS __attribute__((address_space(3)))
typedef unsigned short bf16_t;
typedef short bf16x8 __attribute__((ext_vector_type(8)));
typedef float f32x4 __attribute__((ext_vector_type(4)));
typedef unsigned u32x4 __attribute__((ext_vector_type(4)));
typedef int i32x4 __attribute__((ext_vector_type(4)));
constexpr int BM = 256, BK = 64, HALF = 128, HTB = HALF * BK * 2  , STAGE_BYTES = 8 * HTB, NXCD = 8, WGM = 8;

__host__ __device__ __forceinline__ int lds_byte(int r, int c) { const int st = (r >> 4) * 2 + (c >> 5), rr = r & 15, cc = c & 31, ob = rr * 64 + cc * 2; return st * 1024 + (ob ^ (((ob >> 9) & 1) << 5)); }
__host__ __device__ __forceinline__ void stage_rc(int b, int& R, int& C) { const int st = b / 1024, sb = b % 1024, swz = sb ^ (((sb >> 9) & 1) << 5); R = (st >> 1) * 16 + swz / 64; C = (st & 1) * 32 + (swz % 64) / 2; }
__host__ __device__ __forceinline__ int perm32(int rho) { const int n = rho >> 4, i = rho & 15; return 8 * (i >> 2) + 4 * n + (i & 3); }

template <bool I8> struct AccSel { typedef f32x4 type; };
template <> struct AccSel<true> { typedef i32x4 type; };
template <bool I8> __device__ __forceinline__ typename AccSel<I8>::type mma16(const bf16x8& b, const bf16x8& a, const typename AccSel<I8>::type& c) {
    if constexpr (I8) return __builtin_amdgcn_mfma_i32_16x16x64_i8(__builtin_bit_cast(i32x4, b), __builtin_bit_cast(i32x4, a), c, 0, 0, 0);
    else return __builtin_amdgcn_mfma_f32_16x16x32_bf16(b, a, c, 0, 0, 0);
}
struct Unit { int pm, pn; };
struct Gemm { const bf16_t* A; const bf16_t* Bt; int M, N, K; };

struct StaticOrder {
    int nM, nN, nwg, G, c;
    __host__ __device__ void init(int M, int N, int G_, int c_) { nM = M / BM; nN = N / BM; nwg = nM * nN; G = G_; c = c_; }
    __host__ __device__ bool next(int i, Unit& u) const {
        const long L = (long)i * G + c; if (L >= nwg) return false;
        int wgid = (int)L; { const int q = nwg / NXCD, r = nwg % NXCD, xcd = wgid % NXCD, off = wgid / NXCD; wgid = (xcd < r ? xcd * (q + 1) : r * (q + 1) + (xcd - r) * q) + off; }
        const int nig = WGM * nN, gid = wgid / nig, fm = gid * WGM, gsz = (nM - fm) < WGM ? (nM - fm) : WGM;
        u.pm = fm + ((wgid % nig) % gsz); u.pn = (wgid % nig) / gsz; return true;
    }
    __device__ __forceinline__ void a_ready(const Unit&) const {}
    __device__ __forceinline__ void done(const Unit&) const {}
};

typedef float f32x2cv __attribute__((ext_vector_type(2))); typedef __bf16 bf16x2cv __attribute__((ext_vector_type(2)));
__device__ __forceinline__ unsigned cvt_pk_bf16(float lo, float hi) { f32x2cv v = {lo, hi}; bf16x2cv b = __builtin_convertvector(v, bf16x2cv); return __builtin_bit_cast(unsigned, b); }

typedef unsigned u32x2 __attribute__((ext_vector_type(2)));
struct EpiPlainBf16 {
    static constexpr bool PERM = true, AFTER_DRAIN = false;
    bf16_t* O; int ldc;
    __device__ __forceinline__ void operator()(const f32x4 (&acc)[2][2][4][2], const Unit& u, int wr, int wc, int fr_, int fq_) const {
        int fr = fr_, fq = fq_; asm volatile("" : "+v"(fr), "+v"(fq));
        const int row0 = u.pm * BM + wr * 64 + fr, col0 = u.pn * BM + wc * 32 + 8 * fq;
#pragma unroll
        for (int ai = 0; ai < 2; ++ai)
#pragma unroll
            for (int m = 0; m < 4; ++m) { bf16_t* rowp = O + (size_t)(row0 + ai * HALF + m * 16) * ldc + col0;
#pragma unroll
                for (int bj = 0; bj < 2; ++bj) { const f32x4 v0 = acc[ai][bj][m][0], v1 = acc[ai][bj][m][1];
                    u32x4 w; w.x = cvt_pk_bf16(v0[0], v0[1]); w.y = cvt_pk_bf16(v0[2], v0[3]); w.z = cvt_pk_bf16(v1[0], v1[1]); w.w = cvt_pk_bf16(v1[2], v1[3]);
                    *(u32x4*)(rowp + bj * HALF) = w; } }
    }
};
struct EpiPeerQ {
    static constexpr bool PERM = true, AFTER_DRAIN = false;
    bf16_t* O;
    __device__ __forceinline__ void operator()(const f32x4 (&acc)[2][2][4][2], const Unit& u, int wr, int wc, int fr_, int fq_) const {
        int fr = fr_, fq = fq_; asm volatile("" : "+v"(fr), "+v"(fq));
#pragma unroll
        for (int ai = 0; ai < 2; ++ai)
#pragma unroll
            for (int m = 0; m < 4; ++m) { const int tile = u.pm * 8 + wr * 2 + ai * 4 + (m >> 1), r32 = fr + 16 * (m & 1);
#pragma unroll
                for (int bj = 0; bj < 2; ++bj) { const f32x4 v0 = acc[ai][bj][m][0], v1 = acc[ai][bj][m][1];
                    u32x4 w; w.x = cvt_pk_bf16(v0[0], v0[1]); w.y = cvt_pk_bf16(v0[2], v0[3]); w.z = cvt_pk_bf16(v1[0], v1[1]); w.w = cvt_pk_bf16(v1[2], v1[3]);
                    const size_t frag = (size_t)(((tile * 8 + u.pn) * 2 + bj) * 8 + 2 * wc + (fq >> 1));
                    *(u32x4*)(O + (frag * 64 + (fq & 1) * 32 + r32) * 8) = w; } }
    }
};
__device__ __forceinline__ size_t gate_block(int pm, int pn, int wr, int wc, int ai, int m, int bj) { return (size_t)(((((((pm * 8 + pn) * 2 + wr) * 4 + wc) * 2 + ai) * 4 + m) * 2 + bj)) * 512; }
struct EpiBranch {
    static constexpr bool PERM = true, AFTER_DRAIN = false;
    const bf16_t* ga; const bf16_t* gb; bf16_t* O; int ldc;
    __device__ __forceinline__ void mid(f32x4 (&acc)[2][2][4][2], const Unit& u, int wr, int wc, int fr_, int fq_) const {
        int fr = fr_, fq = fq_; asm volatile("" : "+v"(fr), "+v"(fq));
        const int row0 = u.pm * BM + wr * 64 + fr, col0 = u.pn * BM + wc * 32 + 8 * fq;
#pragma unroll
        for (int ai = 0; ai < 2; ++ai)
#pragma unroll
            for (int m = 0; m < 4; ++m) { const size_t off = (size_t)(row0 + ai * HALF + m * 16) * ldc + col0;
#pragma unroll
                for (int bj = 0; bj < 2; ++bj) { const size_t goff = gate_block(u.pm, u.pn, wr, wc, ai, m, bj) + fr * 32 + 8 * fq;
                    const u32x2 a = *(const u32x2*)((const unsigned char*)ga + goff), b = *(const u32x2*)((const unsigned char*)gb + goff);
#define PG8_RATIO(x, y, k) ((float)(((x) >> (8 * (k))) & 255u) * __builtin_amdgcn_rcpf((float)(((y) >> (8 * (k))) & 255u)))
                    f32x4 r0, r1;
                    r0[0] = PG8_RATIO(a.x, b.x, 0); r0[1] = PG8_RATIO(a.x, b.x, 1); r0[2] = PG8_RATIO(a.x, b.x, 2); r0[3] = PG8_RATIO(a.x, b.x, 3);
                    r1[0] = PG8_RATIO(a.y, b.y, 0); r1[1] = PG8_RATIO(a.y, b.y, 1); r1[2] = PG8_RATIO(a.y, b.y, 2); r1[3] = PG8_RATIO(a.y, b.y, 3);
#undef PG8_RATIO
                    acc[ai][bj][m][0] = acc[ai][bj][m][0] * r0; acc[ai][bj][m][1] = acc[ai][bj][m][1] * r1; } }
    }
    __device__ __forceinline__ void operator()(const f32x4 (&acc)[2][2][4][2], const Unit& u, int wr, int wc, int fr_, int fq_) const {
        int fr = fr_, fq = fq_; asm volatile("" : "+v"(fr), "+v"(fq));
        const int row0 = u.pm * BM + wr * 64 + fr, col0 = u.pn * BM + wc * 32 + 8 * fq;
#pragma unroll
        for (int ai = 0; ai < 2; ++ai)
#pragma unroll
            for (int m = 0; m < 4; ++m) { const size_t off = (size_t)(row0 + ai * HALF + m * 16) * ldc + col0;
#pragma unroll
                for (int bj = 0; bj < 2; ++bj) { const u32x2 g = *(const u32x2*)((const unsigned char*)gb + gate_block(u.pm, u.pn, wr, wc, ai, m, bj) + fr * 32 + 8 * fq);
                    const f32x4 v0 = acc[ai][bj][m][0], v1 = acc[ai][bj][m][1]; const float q = 1.0f / 255.0f;
                    f32x4 o0, o1;
                    o0[0] = v0[0] * ((float)(g.x & 255u) * q); o0[1] = v0[1] * ((float)((g.x >> 8) & 255u) * q); o0[2] = v0[2] * ((float)((g.x >> 16) & 255u) * q); o0[3] = v0[3] * ((float)(g.x >> 24) * q);
                    o1[0] = v1[0] * ((float)(g.y & 255u) * q); o1[1] = v1[1] * ((float)((g.y >> 8) & 255u) * q); o1[2] = v1[2] * ((float)((g.y >> 16) & 255u) * q); o1[3] = v1[3] * ((float)(g.y >> 24) * q);
                    u32x4 w; w.x = cvt_pk_bf16(o0[0], o0[1]); w.y = cvt_pk_bf16(o0[2], o0[3]); w.z = cvt_pk_bf16(o1[0], o1[1]); w.w = cvt_pk_bf16(o1[2], o1[3]);
                    *(u32x4*)(O + off + bj * HALF) = w; } }
    }
};
struct EpiOutProj {
    static constexpr bool PERM = true, AFTER_DRAIN = false;
    const bf16_t* xres; bf16_t* z; int ldc; float alpha;
    __device__ __forceinline__ void operator()(const f32x4 (&acc)[2][2][4][2], const Unit& u, int wr, int wc, int fr_, int fq_) const {
        int fr = fr_, fq = fq_; asm volatile("" : "+v"(fr), "+v"(fq));
        const int row0 = u.pm * BM + wr * 64 + fr, col0 = u.pn * BM + wc * 32 + 8 * fq;
#pragma unroll
        for (int ai = 0; ai < 2; ++ai)
#pragma unroll
            for (int m = 0; m < 4; ++m) { const size_t off = (size_t)(row0 + ai * HALF + m * 16) * ldc + col0;
#pragma unroll
                for (int bj = 0; bj < 2; ++bj) { const u32x4 x = *(const u32x4*)(xres + off + bj * HALF);
                    const f32x4 v0 = acc[ai][bj][m][0], v1 = acc[ai][bj][m][1];
                    f32x4 o0, o1;
                    o0[0] = v0[0] + alpha * __builtin_bit_cast(float, x.x << 16); o0[1] = v0[1] + alpha * __builtin_bit_cast(float, x.x & 0xffff0000u);
                    o0[2] = v0[2] + alpha * __builtin_bit_cast(float, x.y << 16); o0[3] = v0[3] + alpha * __builtin_bit_cast(float, x.y & 0xffff0000u);
                    o1[0] = v1[0] + alpha * __builtin_bit_cast(float, x.z << 16); o1[1] = v1[1] + alpha * __builtin_bit_cast(float, x.z & 0xffff0000u);
                    o1[2] = v1[2] + alpha * __builtin_bit_cast(float, x.w << 16); o1[3] = v1[3] + alpha * __builtin_bit_cast(float, x.w & 0xffff0000u);
                    u32x4 w; w.x = cvt_pk_bf16(o0[0], o0[1]); w.y = cvt_pk_bf16(o0[2], o0[3]); w.z = cvt_pk_bf16(o1[0], o1[1]); w.w = cvt_pk_bf16(o1[2], o1[3]);
                    *(u32x4*)(z + off + bj * HALF) = w; } }
    }
};
struct EpiInProj {
    static constexpr bool PERM = false, AFTER_DRAIN = false;
    bf16_t *qa, *ka, *qd, *kd, *ga, *gb; const float *cosA, *sinA, *cosB, *sinB; float qsa, qsb;
    __device__ __forceinline__ void operator()(const f32x4 (&acc)[2][2][4][2], const Unit& u, int wr, int wc, int fr_, int fq_) const {
        int fr = fr_, fq = fq_; asm volatile("" : "+v"(fr), "+v"(fq));
        const int row0 = u.pm * BM + wr * 64 + fr;
        const int ty = u.pn >> 2;
        if (ty >= 4) {
            unsigned char* dst = (unsigned char*)(ty < 6 ? ga : gb); const int col0 = (u.pn - (ty < 6 ? 16 : 24)) * BM + wc * 32 + 4 * fq; const float lo = ty < 6 ? 0.0f : 1.0f;
#pragma unroll
            for (int ai = 0; ai < 2; ++ai)
#pragma unroll
                for (int m = 0; m < 4; ++m) { unsigned char* rowp = dst + (size_t)(row0 + ai * HALF + m * 16) * 2048 + col0;
#pragma unroll
                    for (int bj = 0; bj < 2; ++bj)
#pragma unroll
                        for (int n = 0; n < 2; ++n) { const f32x4 v = acc[ai][bj][m][n]; unsigned w = 0u;
#pragma unroll
                            for (int j = 0; j < 4; ++j) { const float s = __builtin_amdgcn_rcpf(1.0f + __builtin_amdgcn_exp2f(-1.4426950408889634f * v[j]));
                                w = __builtin_amdgcn_cvt_pk_u8_f32(fmaxf(s * 255.0f + 0.5f, lo), j, w); }
                            *(unsigned*)(rowp + bj * HALF + n * 16) = w; } }
        } else if (ty < 2) {
            bf16_t* dst = ty == 0 ? qa : ka; const float sc = ty == 0 ? qsa : 1.0f;
            const int i0 = 16 * wc + 4 * fq;
#pragma unroll
            for (int ai = 0; ai < 2; ++ai)
#pragma unroll
                for (int m = 0; m < 4; ++m) { const int row = row0 + ai * HALF + m * 16;
                    const f32x4 c = *(const f32x4*)(cosA + (size_t)row * 64 + i0), s = *(const f32x4*)(sinA + (size_t)row * 64 + i0);
#pragma unroll
                    for (int bj = 0; bj < 2; ++bj) { const int head = 2 * (u.pn & 3) + bj; const f32x4 t1 = acc[ai][bj][m][0], t2 = acc[ai][bj][m][1];
                        const f32x4 o1 = t1 * c - t2 * s, o2 = t1 * s + t2 * c;
                        bf16_t* p = dst + (size_t)row * 1024 + head * 128 + i0;
                        u32x2 w1, w2; w1.x = cvt_pk_bf16(o1[0] * sc, o1[1] * sc); w1.y = cvt_pk_bf16(o1[2] * sc, o1[3] * sc); w2.x = cvt_pk_bf16(o2[0] * sc, o2[1] * sc); w2.y = cvt_pk_bf16(o2[2] * sc, o2[3] * sc);
                        *(u32x2*)p = w1; *(u32x2*)(p + 64) = w2;
                    } }
        } else {
            bf16_t* dst = ty == 2 ? qd : kd; const float sc = ty == 2 ? qsb : 1.0f;
            const int comp = wc >> 1, i0 = 16 * (wc & 1) + 4 * fq;
#pragma unroll
            for (int ai = 0; ai < 2; ++ai)
#pragma unroll
                for (int m = 0; m < 4; ++m) { const int row = row0 + ai * HALF + m * 16;
                    const f32x4 c = *(const f32x4*)(cosB + (size_t)row * 32 + i0), s = *(const f32x4*)(sinB + (size_t)row * 32 + i0);
#pragma unroll
                    for (int bj = 0; bj < 2; ++bj) { const int head = 2 * (u.pn & 3) + bj; const f32x4 t1 = acc[ai][bj][m][0], t2 = acc[ai][bj][m][1];
                        const f32x4 o1 = (t1 * c - t2 * s) * sc, o2 = (t1 * s + t2 * c) * sc;
                        bf16_t* p = dst + (size_t)row * 1024 + head * 128 + comp * 64 + i0;
                        u32x2 w1, w2; w1.x = cvt_pk_bf16(o1[0], o1[1]); w1.y = cvt_pk_bf16(o1[2], o1[3]); w2.x = cvt_pk_bf16(o2[0], o2[1]); w2.y = cvt_pk_bf16(o2[2], o2[3]);
                        *(u32x2*)p = w1; *(u32x2*)(p + 32) = w2;
                    } }
        }
    }
};

__device__ __forceinline__ f32x4 deq4(const i32x4& a, const f32x4& s) { return (f32x4){(float)a[0], (float)a[1], (float)a[2], (float)a[3]} * s; }
struct EpiPlainI8 {
    static constexpr bool PERM = true, AFTER_DRAIN = false;
    bf16_t* O; int ldc; const float* srow; const float* scol;
    __device__ __forceinline__ void operator()(const i32x4 (&acc)[2][2][4][2], const Unit& u, int wr, int wc, int fr_, int fq_) const {
        int fr = fr_, fq = fq_; asm volatile("" : "+v"(fr), "+v"(fq));
        const int row0 = u.pm * BM + wr * 64 + fr, col0 = u.pn * BM + wc * 32 + 8 * fq;
        f32x4 cs[2][2];
#pragma unroll
        for (int bj = 0; bj < 2; ++bj)
#pragma unroll
            for (int n = 0; n < 2; ++n) cs[bj][n] = *(const f32x4*)(scol + col0 + bj * HALF + 4 * n);
#pragma unroll
        for (int ai = 0; ai < 2; ++ai)
#pragma unroll
            for (int m = 0; m < 4; ++m) { const int row = row0 + ai * HALF + m * 16; const float sr = srow[row]; bf16_t* rowp = O + (size_t)row * ldc + col0;
#pragma unroll
                for (int bj = 0; bj < 2; ++bj) { const f32x4 v0 = deq4(acc[ai][bj][m][0], cs[bj][0] * sr), v1 = deq4(acc[ai][bj][m][1], cs[bj][1] * sr);
                    u32x4 w; w.x = cvt_pk_bf16(v0[0], v0[1]); w.y = cvt_pk_bf16(v0[2], v0[3]); w.z = cvt_pk_bf16(v1[0], v1[1]); w.w = cvt_pk_bf16(v1[2], v1[3]);
                    *(u32x4*)(rowp + bj * HALF) = w; } }
    }
};
__device__ __forceinline__ float row16_dpp(float v, int st) {
    const int x = __builtin_bit_cast(int, v);
    const int y = st == 0 ? __builtin_amdgcn_update_dpp(0, x, 0xB1, 0xF, 0xF, false) : st == 1 ? __builtin_amdgcn_update_dpp(0, x, 0x4E, 0xF, 0xF, false)
                : st == 2 ? __builtin_amdgcn_update_dpp(0, x, 0x141, 0xF, 0xF, false) : __builtin_amdgcn_update_dpp(0, x, 0x140, 0xF, 0xF, false);
    return __builtin_bit_cast(float, y);
}
struct EpiInProjI8 {
    static constexpr bool PERM = false, AFTER_DRAIN = false;
    bf16_t *qa, *ka, *qd, *kd, *ga, *gb; const float *cosA, *sinA, *cosB, *sinB; float qsa, qsb; const float *sx, *sw; float* km;
    __device__ __forceinline__ void operator()(const i32x4 (&acc)[2][2][4][2], const Unit& u, int wr, int wc, int fr_, int fq_) const {
        int fr = fr_, fq = fq_; asm volatile("" : "+v"(fr), "+v"(fq));
        const int row0 = u.pm * BM + wr * 64 + fr;
        const int ty = u.pn >> 2;
#define EPI_LOAD_CS() f32x4 cs[2][2]; _Pragma("unroll") for (int bj = 0; bj < 2; ++bj) _Pragma("unroll") for (int n = 0; n < 2; ++n) cs[bj][n] = *(const f32x4*)(sw + u.pn * BM + bj * HALF + wc * 32 + n * 16 + 4 * fq)
        if (ty >= 4) {
            EPI_LOAD_CS();
            unsigned char* dst = (unsigned char*)(ty < 6 ? ga : gb); const int col0 = (u.pn - (ty < 6 ? 16 : 24)) * BM + wc * 32 + 4 * fq; const float lo = ty < 6 ? 0.0f : 1.0f;
#pragma unroll
            for (int ai = 0; ai < 2; ++ai)
#pragma unroll
                for (int m = 0; m < 4; ++m) { const int row = row0 + ai * HALF + m * 16; const float sr = sx[row] * -1.4426950408889634f; unsigned char* rowp = dst + gate_block(u.pm, u.pn - (ty < 6 ? 16 : 24), wr, wc, ai, m, 0) + fr * 32 + 4 * fq;
#pragma unroll
                    for (int bj = 0; bj < 2; ++bj)
#pragma unroll
                        for (int n = 0; n < 2; ++n) { const f32x4 v = deq4(acc[ai][bj][m][n], cs[bj][n] * sr); unsigned w = 0u;
#pragma unroll
                            for (int j = 0; j < 4; ++j) { const float s = __builtin_amdgcn_rcpf(1.0f + __builtin_amdgcn_exp2f(v[j]));
                                w = __builtin_amdgcn_cvt_pk_u8_f32(fmaxf(s * 255.0f + 0.5f, lo), j, w); }
                            *(unsigned*)(rowp + bj * 512 + n * 16) = w; } }
        } else if (ty < 2) {
            bf16_t* dst = ty == 0 ? qa : ka; const float sc = ty == 0 ? qsa : 1.0f;
            const int i0 = 16 * wc + 4 * fq;
#pragma unroll
            for (int bj = 0; bj < 2; ++bj) { const int head = 2 * (u.pn & 3) + bj;
                const f32x4 cs0 = *(const f32x4*)(sw + u.pn * BM + bj * HALF + wc * 32 + 4 * fq), cs1 = *(const f32x4*)(sw + u.pn * BM + bj * HALF + wc * 32 + 16 + 4 * fq);
                int frj = fr; asm volatile("" : "+v"(frj)); const int row0j = u.pm * BM + wr * 64 + frj;
                f32x4 ks1 = f32x4{0.f, 0.f, 0.f, 0.f}, ks2 = f32x4{0.f, 0.f, 0.f, 0.f};
#pragma unroll
                for (int ai = 0; ai < 2; ++ai)
#pragma unroll
                    for (int m = 0; m < 4; ++m) { const int row = row0j + ai * HALF + m * 16; const float sr = sx[row] * sc;
                        const f32x4 c = *(const f32x4*)(cosA + (size_t)row * 64 + i0), s = *(const f32x4*)(sinA + (size_t)row * 64 + i0);
                        const f32x4 t1 = deq4(acc[ai][bj][m][0], cs0 * sr), t2 = deq4(acc[ai][bj][m][1], cs1 * sr);
                        const f32x4 o1 = t1 * c - t2 * s, o2 = t1 * s + t2 * c;
                        ks1 += o1; ks2 += o2;
                        const int rq = (row >> 8) * 262144 + ((row >> 5) & 7) * 4096 + (row & 31) * 8;
                        bf16_t* p = dst + (size_t)((ty == 0 ? rq : row * 1024) + head * (ty == 0 ? 32768 : 128) + (ty == 0 ? wc * 512 + (fq >> 1) * 256 + 4 * (fq & 1) : i0));
                        u32x2 w1, w2; w1.x = cvt_pk_bf16(o1[0], o1[1]); w1.y = cvt_pk_bf16(o1[2], o1[3]); w2.x = cvt_pk_bf16(o2[0], o2[1]); w2.y = cvt_pk_bf16(o2[2], o2[3]);
                        *(u32x2*)p = w1; *(u32x2*)(p + (ty == 0 ? 4 * 512 : 64)) = w2;
                    }
                if (ty == 1) {
#pragma unroll
                    for (int j = 0; j < 4; ++j) {
#pragma unroll
                        for (int st = 0; st < 4; ++st) { ks1[j] += row16_dpp(ks1[j], st); ks2[j] += row16_dpp(ks2[j], st); } }
                    if (fr == 0) { float* kp = km + ((size_t)((u.pm >> 4) * 8 + head) * 16 + (u.pm & 15)) * 128 + i0;
#pragma unroll
                        for (int j = 0; j < 4; ++j) { (void)__hip_atomic_fetch_add(kp + j, ks1[j], __ATOMIC_RELAXED, __HIP_MEMORY_SCOPE_AGENT); (void)__hip_atomic_fetch_add(kp + 64 + j, ks2[j], __ATOMIC_RELAXED, __HIP_MEMORY_SCOPE_AGENT); } }
                }
            }
        } else {
            EPI_LOAD_CS();
            bf16_t* dst = ty == 2 ? qd : kd; const float sc = ty == 2 ? qsb : 1.0f;
            const int comp = wc >> 1, i0 = 16 * (wc & 1) + 4 * fq;
#pragma unroll
            for (int ai = 0; ai < 2; ++ai)
#pragma unroll
                for (int m = 0; m < 4; ++m) { const int row = row0 + ai * HALF + m * 16; const float sr = sx[row] * sc;
                    const f32x4 c = *(const f32x4*)(cosB + (size_t)row * 32 + i0), s = *(const f32x4*)(sinB + (size_t)row * 32 + i0);
#pragma unroll
                    for (int bj = 0; bj < 2; ++bj) { const int head = 2 * (u.pn & 3) + bj; const f32x4 t1 = deq4(acc[ai][bj][m][0], cs[bj][0] * sr), t2 = deq4(acc[ai][bj][m][1], cs[bj][1] * sr);
                        const f32x4 o1 = t1 * c - t2 * s, o2 = t1 * s + t2 * c;
                        const int rq = (row >> 8) * 262144 + ((row >> 5) & 7) * 4096 + (row & 31) * 8;
                        bf16_t* p = dst + (size_t)((ty == 2 ? rq : row * 1024) + head * (ty == 2 ? 32768 : 128) + (ty == 2 ? (comp * 4 + (wc & 1)) * 512 + (fq >> 1) * 256 + 4 * (fq & 1) : comp * 64 + i0));
                        u32x2 w1, w2; w1.x = cvt_pk_bf16(o1[0], o1[1]); w1.y = cvt_pk_bf16(o1[2], o1[3]); w2.x = cvt_pk_bf16(o2[0], o2[1]); w2.y = cvt_pk_bf16(o2[2], o2[3]);
                        *(u32x2*)p = w1; *(u32x2*)(p + (ty == 2 ? 2 * 512 : 32)) = w2;
                    } }
        }
    }
};
template <class Epi, class Sched, bool ALIGN_EPI = false, bool SP2 = false, bool MID = false, bool I8 = false>
__device__ __forceinline__ void gemm_phase(PG8_LAS unsigned char* lds, const Gemm g, const Sched& S, const Epi& E, int wave) {
    int tid_ = lane_id(); asm volatile("" : "+v"(tid_)); tid_ += 64 * wave;
    const int tid = tid_, wid = __builtin_amdgcn_readfirstlane(tid >> 6), lane = tid & 63, wr = wid >> 2, wc = wid & 3, fr = lane & 15, fq = lane >> 4;
    const int K = g.K, nt = K / BK;
    unsigned voffA[2], voffB[2];
#pragma unroll
    for (int i = 0; i < 2; ++i) { int R, C; stage_rc(tid * 16 + i * 8192, R, C); const int Rb = Epi::PERM ? ((R & ~31) + perm32(R & 31)) : R;
        voffA[i] = (unsigned)(R * K + C) * 2u; voffB[i] = (unsigned)(Rb * K + C) * 2u; }
    const size_t kstep = (size_t)(BK * 2);
    const size_t hstep = (size_t)HALF * K * 2;
    const size_t tstep = 2 * hstep;
    const unsigned ldsw = (unsigned)wid * 1024u;
    const int aoff = lds_byte(wr * 64 + fr, fq * 8), boff = lds_byte(wc * 32 + fr, fq * 8);
#define PG8_SA(b, h) (((b) * 2 + (h)) * HTB)
#define PG8_SB(b, h) ((4 + (b) * 2 + (h)) * HTB)
#define PG8_STAGE(bufoff, gbase, voff) do { _Pragma("unroll") for (int _i = 0; _i < 2; ++_i) \
        __builtin_amdgcn_global_load_lds((const unsigned*)((const char*)(gbase) + (voff)[_i]), (PG8_LAS unsigned*)(lds + (bufoff) + ldsw + _i * 8192), 16, 0, 0); } while (0)
#define PG8_LDA(dst, b, h) do { _Pragma("unroll") for (int m = 0; m < 4; ++m) _Pragma("unroll") for (int k = 0; k < 2; ++k) dst[m][k] = *(const PG8_LAS bf16x8*)(lds + PG8_SA(b, h) + aoff + m * 2048 + k * 1024); } while (0)
#define PG8_LDB(dst, b, h) do { _Pragma("unroll") for (int n = 0; n < 2; ++n) _Pragma("unroll") for (int k = 0; k < 2; ++k) dst[n][k] = *(const PG8_LAS bf16x8*)(lds + PG8_SB(b, h) + boff + n * 2048 + k * 1024); } while (0)
#define PG8_MMA(ai, bj, At, Bt) do { __builtin_amdgcn_s_setprio(1); _Pragma("unroll") for (int m = 0; m < 4; ++m) _Pragma("unroll") for (int n = 0; n < 2; ++n) _Pragma("unroll") for (int k = 0; k < 2; ++k) \
        acc[ai][bj][m][n] = mma16<I8>(Bt[n][k], At[m][k], acc[ai][bj][m][n]); __builtin_amdgcn_s_setprio(0); } while (0)
#define PG8_WAIT_V(n) asm volatile("s_waitcnt vmcnt(" #n ")" ::: "memory")
#define PG8_WAIT_L(n) asm volatile("s_waitcnt lgkmcnt(" #n ")" ::: "memory")
#define PG8_BAR __builtin_amdgcn_s_barrier()
#define PG8_SCHED __builtin_amdgcn_sched_barrier(0)
    Unit cur, nxt; int ui = 0;
    if (!S.next(0, cur)) return;
    typedef typename AccSel<I8>::type acc_t;
    acc_t acc[2][2][4][2];
#pragma unroll
    for (int a = 0; a < 2; ++a)
#pragma unroll
        for (int b = 0; b < 2; ++b)
#pragma unroll
            for (int m = 0; m < 4; ++m)
#pragma unroll
                for (int n = 0; n < 2; ++n) acc[a][b][m][n] = (acc_t){0, 0, 0, 0};
    bf16x8 At[4][2], B0[2][2], B1[2][2];
    const char* cA = (const char*)g.A + (size_t)cur.pm * tstep; const char* cB = (const char*)g.Bt + (size_t)cur.pn * tstep;
    S.a_ready(cur);
    if constexpr (SP2) {
        PG8_STAGE(PG8_SB(0, 0), cB, voffB); PG8_STAGE(PG8_SB(0, 1), cB + hstep, voffB); PG8_STAGE(PG8_SA(0, 0), cA, voffA); PG8_STAGE(PG8_SA(0, 1), cA + hstep, voffA);
        if (wr == 1) PG8_BAR;
        PG8_WAIT_V(2); PG8_BAR;
        PG8_STAGE(PG8_SB(1, 0), cB + kstep, voffB); PG8_STAGE(PG8_SA(1, 0), cA + kstep, voffA); PG8_STAGE(PG8_SB(1, 1), cB + hstep + kstep, voffB);
        PG8_WAIT_V(6); PG8_BAR;
    } else {
        PG8_STAGE(PG8_SB(0, 0), cB, voffB); PG8_STAGE(PG8_SA(0, 0), cA, voffA); PG8_STAGE(PG8_SB(0, 1), cB + hstep, voffB); PG8_STAGE(PG8_SA(0, 1), cA + hstep, voffA);
        if (wr == 1) PG8_BAR;
        PG8_WAIT_V(4); PG8_BAR;
        PG8_STAGE(PG8_SB(1, 0), cB + kstep, voffB); PG8_STAGE(PG8_SA(1, 0), cA + kstep, voffA); PG8_STAGE(PG8_SB(1, 1), cB + hstep + kstep, voffB);
        PG8_WAIT_V(6); PG8_BAR;
    }
    for (;;) {
        const bool has_next = S.next(ui + 1, nxt);
        const char* nA = has_next ? (const char*)g.A + (size_t)nxt.pm * tstep : cA; const char* nB = has_next ? (const char*)g.Bt + (size_t)nxt.pn * tstep : cB;
        for (int t = 0; t < nt; t += 2) {
            if constexpr (MID) { if (t == nt / 2) E.mid(acc, cur, wr, wc, fr, fq); }
            const bool last = (t == nt - 2);
            const char* a1 = cA + (size_t)(t + 1) * kstep;
            const char* a2 = last ? nA : cA + (size_t)(t + 2) * kstep; const char* b2 = last ? nB : cB + (size_t)(t + 2) * kstep;
            const char* a3 = a2 + kstep; const char* b3 = b2 + kstep;
            if (last && has_next) S.a_ready(nxt);
            if constexpr (SP2) {
            PG8_LDB(B0, 0, 0); PG8_LDB(B1, 0, 1); PG8_SCHED; PG8_LDA(At, 0, 0); PG8_STAGE(PG8_SA(1, 1), a1 + hstep, voffA);
            PG8_WAIT_V(8); PG8_WAIT_L(0); PG8_BAR; PG8_MMA(0, 0, At, B0); PG8_MMA(0, 1, At, B1); PG8_BAR; PG8_SCHED;
            PG8_LDA(At, 0, 1); PG8_STAGE(PG8_SB(0, 0), b2, voffB); PG8_STAGE(PG8_SB(0, 1), b2 + hstep, voffB); PG8_STAGE(PG8_SA(0, 0), a2, voffA);
            PG8_WAIT_V(8); PG8_WAIT_L(0); PG8_BAR; PG8_MMA(1, 0, At, B0); PG8_MMA(1, 1, At, B1); PG8_BAR; PG8_SCHED;
            PG8_LDB(B0, 1, 0); PG8_LDB(B1, 1, 1); PG8_SCHED; PG8_LDA(At, 1, 0); PG8_STAGE(PG8_SA(0, 1), a2 + hstep, voffA);
            PG8_WAIT_V(8); PG8_WAIT_L(0); PG8_BAR; PG8_MMA(0, 0, At, B0); PG8_MMA(0, 1, At, B1); PG8_BAR; PG8_SCHED;
            PG8_LDA(At, 1, 1); PG8_STAGE(PG8_SB(1, 0), b3, voffB); PG8_STAGE(PG8_SB(1, 1), b3 + hstep, voffB); PG8_STAGE(PG8_SA(1, 0), a3, voffA);
            PG8_WAIT_V(8); PG8_WAIT_L(0); PG8_BAR; PG8_MMA(1, 0, At, B0); PG8_MMA(1, 1, At, B1); PG8_BAR; PG8_SCHED;
            } else {
            PG8_LDB(B0, 0, 0); PG8_SCHED; PG8_LDA(At, 0, 0); PG8_STAGE(PG8_SA(1, 1), a1 + hstep, voffA);
            PG8_WAIT_L(8); PG8_BAR; PG8_WAIT_L(0); PG8_MMA(0, 0, At, B0); PG8_BAR; PG8_SCHED;
            PG8_LDB(B1, 0, 1); PG8_STAGE(PG8_SB(0, 0), b2, voffB);
            PG8_BAR; PG8_WAIT_L(0); PG8_MMA(0, 1, At, B1); PG8_BAR;
            PG8_LDA(At, 0, 1); PG8_STAGE(PG8_SA(0, 0), a2, voffA);
            PG8_BAR; PG8_WAIT_L(0); PG8_MMA(1, 0, At, B0); PG8_BAR; PG8_SCHED;
            PG8_STAGE(PG8_SB(0, 1), b2 + hstep, voffB);
            PG8_WAIT_V(6); PG8_BAR; PG8_MMA(1, 1, At, B1); PG8_BAR;
            PG8_LDB(B0, 1, 0); PG8_SCHED; PG8_LDA(At, 1, 0); PG8_STAGE(PG8_SA(0, 1), a2 + hstep, voffA);
            PG8_WAIT_L(8); PG8_BAR; PG8_WAIT_L(0); PG8_MMA(0, 0, At, B0); PG8_BAR; PG8_SCHED;
            PG8_LDB(B1, 1, 1); PG8_STAGE(PG8_SB(1, 0), b3, voffB);
            PG8_BAR; PG8_WAIT_L(0); PG8_MMA(0, 1, At, B1); PG8_BAR;
            PG8_LDA(At, 1, 1); PG8_STAGE(PG8_SA(1, 0), a3, voffA);
            PG8_BAR; PG8_WAIT_L(0); PG8_MMA(1, 0, At, B0); PG8_BAR; PG8_SCHED;
            PG8_STAGE(PG8_SB(1, 1), b3 + hstep, voffB);
            PG8_WAIT_V(6); PG8_BAR; PG8_MMA(1, 1, At, B1); PG8_BAR;
            }
        }
        if constexpr (ALIGN_EPI) { if (wr == 0) PG8_BAR; }
        if constexpr (!Epi::AFTER_DRAIN) { E(acc, cur, wr, wc, fr, fq); S.done(cur); }
        if (!has_next) break;
#pragma unroll
        for (int a = 0; a < 2; ++a)
#pragma unroll
            for (int b = 0; b < 2; ++b)
#pragma unroll
                for (int m = 0; m < 4; ++m)
#pragma unroll
                    for (int n = 0; n < 2; ++n) acc[a][b][m][n] = (acc_t){0, 0, 0, 0};
        cur = nxt; cA = nA; cB = nB; ++ui;
        if constexpr (ALIGN_EPI) { if (wr == 1) PG8_BAR; }
    }
    PG8_WAIT_V(0);
    if constexpr (!ALIGN_EPI) { if (wr == 0) PG8_BAR; }
    PG8_BAR;
    if constexpr (Epi::AFTER_DRAIN) { E.fused(acc, cur, wr, wc, fr, fq, lds, wid, lane); S.done(cur); }
#undef PG8_SA
#undef PG8_SB
#undef PG8_STAGE
#undef PG8_LDA
#undef PG8_LDB
#undef PG8_MMA
#undef PG8_WAIT_V
#undef PG8_WAIT_L
#undef PG8_BAR
#undef PG8_SCHED
}
}
#define XB_TMO      128
#define XB_XCNT(j)  (256  + 64 * (j))
#define XB_XSUB(j)  (1280 + 64 * (j))
#define XB_XGEN(j)  (2304 + 64 * (j))
#define XB_TOP      3328
#define XB_TOPGEN   3392
#define XCD_BAR_WORDS 3456
#define XB_SPIN_CAP (1u << 18)

__device__ __forceinline__ unsigned xb_ld(unsigned* p)              { return __hip_atomic_load(p, __ATOMIC_RELAXED, __HIP_MEMORY_SCOPE_AGENT); }
__device__ __forceinline__ unsigned xb_add(unsigned* p, unsigned v) { return __hip_atomic_fetch_add(p, v, __ATOMIC_RELAXED, __HIP_MEMORY_SCOPE_AGENT); }
__device__ __forceinline__ unsigned xb_xcc_id() { return (unsigned)__builtin_amdgcn_s_getreg((3 << 11) | 20) & 0xFu; }
#define XB_SPIN(cond, bar) do { unsigned _sp = 0; while (cond) { __builtin_amdgcn_s_sleep(1); \
    if ((++_sp & 255u) == 0u) { if (xb_ld(&(bar)[XB_TMO])) break; if (_sp > XB_SPIN_CAP) { atomicAdd(&(bar)[XB_TMO], 1u); break; } } } } while (0)

struct XcdBarrier {
    unsigned* bar; unsigned x; unsigned wv;
    volatile LAS unsigned* st;
};

__device__ __forceinline__ XcdBarrier xcd_barrier_post(unsigned* bar, volatile LAS unsigned* st, unsigned wave) {
    XcdBarrier b; b.bar = bar; b.x = xb_xcc_id(); b.st = st; b.wv = wave;
    if (threadIdx.x == 0) (void)xb_add(&bar[XB_XCNT(b.x)], 1u);
    return b;
}
__device__ __forceinline__ void xcd_barrier_complete(unsigned* bar, unsigned x, unsigned& nloc, unsigned& nx) {
    const unsigned G = gridDim.x * gridDim.y * gridDim.z;
    unsigned sum, cnt, mine, sp = 0u;
    for (;;) {
        sum = 0u; cnt = 0u; mine = 0u;
#pragma unroll 1
        for (unsigned j = 0; j < 16; ++j) { const unsigned c = xb_ld(&bar[XB_XCNT(j)]); sum += c; cnt += (c > 0u) ? 1u : 0u; mine = (j == x) ? c : mine; }
        if (sum == G) break;
        __builtin_amdgcn_s_sleep(1);
        if ((++sp & 255u) == 0u) { if (xb_ld(&bar[XB_TMO])) break; if (sp > XB_SPIN_CAP) { atomicAdd(&bar[XB_TMO], 1u); break; } }
    }
    nloc = mine > 0u ? mine : 1u; nx = cnt > 0u ? cnt : 1u;
}

__device__ __forceinline__ void xcd_barrier(const XcdBarrier& b) {
    asm volatile("s_waitcnt vmcnt(0)" ::: "memory");
    __syncthreads();
    if (b.wv == 0u && lane_id() == 0) {
        unsigned* bar = b.bar;
        __builtin_amdgcn_s_waitcnt(0);
        unsigned nloc = b.st[0], nx = b.st[1];
        if (nloc == 0u) { xcd_barrier_complete(bar, b.x, nloc, nx); b.st[0] = nloc; b.st[1] = nx; }
        const unsigned old = xb_add(&bar[XB_XSUB(b.x)], 1u);
        const unsigned gen = old / nloc;
        if (old + 1u == (gen + 1u) * nloc) {
            __builtin_amdgcn_fence(__ATOMIC_RELEASE, "agent");
            asm volatile("s_waitcnt vmcnt(0)" ::: "memory");
            const unsigned og = xb_add(&bar[XB_TOP], 1u);
            const unsigned tg = og / nx;
            if (og + 1u == (tg + 1u) * nx) xb_add(&bar[XB_TOPGEN], 1u);
            else XB_SPIN(xb_ld(&bar[XB_TOPGEN]) == tg, bar);
            __builtin_amdgcn_fence(__ATOMIC_ACQUIRE, "agent");
            xb_add(&bar[XB_XGEN(b.x)], 1u);
            asm volatile("s_waitcnt vmcnt(0)" ::: "memory");
        } else {
            XB_SPIN(xb_ld(&bar[XB_XGEN(b.x)]) == gen, bar);
            __builtin_amdgcn_fence(__ATOMIC_ACQUIRE, "agent");
            asm volatile("s_waitcnt vmcnt(0)" ::: "memory");
        }
    }
    __syncthreads();
}


struct Frame {
    LAS unsigned char* lds;
    volatile LAS unsigned* MISC;
    gu32* ctl;
    int tid, lane, wave;
    int vcu, G;
    unsigned char* ws;
};

__device__ __forceinline__ int inproj_row(int n) {
    const int seg = n >> 10, r = n & 1023;
    if (seg >= 6) return (seg < 8 ? 4096 : 6144) + (n - (seg < 8 ? 6144 : 8192));
    if (seg == 2) return 8192 + r;
    if (seg == 5) return 8192 + 1024 + r;
    const int head = r >> 7, d = r & 127;
    if (seg < 2) return seg * 1024 + head * 128 + 32 * ((d >> 4) & 3) + 16 * (d >> 6) + (d & 15);
    return (seg - 1) * 1024 + head * 128 + 32 * (2 * (d >> 6) + ((d >> 4) & 1)) + 16 * ((d >> 5) & 1) + (d & 15);
}
template <bool MAP>
__device__ __forceinline__ void p0_transpose_item(const float* W, int K, int N, bf16* WT, LAS float* scr, int item, int lane, int ldk = 0, int koff = 0) {
    if (ldk == 0) ldk = K;
    const int nblk = N / 32, kb = item / nblk, nb = item % nblk, k0 = 64 * kb, n0 = 32 * nb;
#pragma unroll 8
    for (int i = 0; i < 32; ++i) { const int kk = 2 * i + (lane >> 5); scr[kk * 33 + (lane & 31)] = W[(size_t)(k0 + kk) * N + n0 + (lane & 31)]; }
    LDS_WAIT(); asm volatile("" ::: "memory");
    const int c = lane & 7;
#pragma unroll
    for (int j = 0; j < 4; ++j) { const int n = (lane >> 3) + 8 * j; const LAS float* s = scr + (8 * c) * 33 + n;
        v4u o; o.x = pk2(s[0 * 33], s[1 * 33]); o.y = pk2(s[2 * 33], s[3 * 33]); o.z = pk2(s[4 * 33], s[5 * 33]); o.w = pk2(s[6 * 33], s[7 * 33]);
        const int dr = MAP ? inproj_row(n0 + n) : (n0 + n);
        *(GAS v4u*)(WT + (size_t)dr * ldk + koff + k0 + 8 * c) = o; }
    LDS_WAIT(); asm volatile("" ::: "memory");
}
__device__ __forceinline__ void p0_convert(const float* src, bf16* dst, size_t n8, size_t gtid, size_t gthreads) {
    for (size_t i = gtid; i < n8; i += gthreads) {
        const f32x4 a = *(const GAS f32x4*)(src + i * 8), b = *(const GAS f32x4*)(src + i * 8 + 4);
        v4u o; o.x = pk2(a[0], a[1]); o.y = pk2(a[2], a[3]); o.z = pk2(b[0], b[1]); o.w = pk2(b[2], b[3]);
        *(GAS v4u*)(dst + i * 8) = o;
    }
}

__device__ __forceinline__ void p0_convert_sk(const float* src, bf16* dst, size_t n8, size_t gtid, size_t gthreads) {
    for (size_t i = gtid; i < n8; i += gthreads) {
        const f32x4 a = *(const GAS f32x4*)(src + i * 8), b = *(const GAS f32x4*)(src + i * 8 + 4);
        v4u o; o.x = pk2(a[0], a[1]); o.y = pk2(a[2], a[3]); o.z = pk2(b[0], b[1]); o.w = pk2(b[2], b[3]);
        const size_t R = i >> 4, blk = R >> 7; const int d8 = (int)(i & 15), key = (int)(R & 127);
        const size_t di = blk * 2048 + (size_t)(((key >> 5) * 8 + (d8 >> 1)) * 64 + (d8 & 1) * 32 + (key & 31));
        *(GAS v4u*)(dst + di * 8) = o;
    }
}

__device__ __forceinline__ void p0_table_row_load(const float* src, f32x4 (&v)[8], int lane) {
#pragma unroll
    for (int q = 0; q < 8; ++q) v[q] = *(const GAS f32x4*)(src + 256 * q + 4 * lane);
}
__device__ __forceinline__ void p0_table_row_finish(const f32x4 (&vin)[8], unsigned char* dst, float* scale_out, int lane, LAS unsigned char* scr) {
    f32x4 v[8];
    { const int lr = lane >> 3, lc = lane & 7;
#pragma unroll
      for (int q = 0; q < 8; ++q) *(LAS f32x4*)(scr + (((8 * q + lr) * 8 + (lc ^ lr)) << 4)) = vin[q];
#pragma unroll
      for (int j = 0; j < 8; ++j) v[j] = *(const LAS f32x4*)(scr + ((lane * 8 + (j ^ (lane & 7))) << 4)); }
    float am = 0.f;
#pragma unroll
    for (int q = 0; q < 8; ++q) am = fmaxf(am, fmaxf(fmaxf(fabsf(v[q][0]), fabsf(v[q][1])), fmaxf(fabsf(v[q][2]), fabsf(v[q][3]))));
#pragma unroll
    for (int o = 1; o < 64; o <<= 1) am = fmaxf(am, __shfl_xor(am, o));
    const float sc = am > 0.f ? 6.0f / am : 1.0f;
    v4u o;
#pragma unroll
    for (int wq = 0; wq < 4; ++wq) { unsigned w = 0u;
        w = __builtin_amdgcn_cvt_scalef32_pk_fp4_f32(w, v[2 * wq][0] * sc, v[2 * wq][1] * sc, 1.0f, 0);
        w = __builtin_amdgcn_cvt_scalef32_pk_fp4_f32(w, v[2 * wq][2] * sc, v[2 * wq][3] * sc, 1.0f, 1);
        w = __builtin_amdgcn_cvt_scalef32_pk_fp4_f32(w, v[2 * wq + 1][0] * sc, v[2 * wq + 1][1] * sc, 1.0f, 2);
        w = __builtin_amdgcn_cvt_scalef32_pk_fp4_f32(w, v[2 * wq + 1][2] * sc, v[2 * wq + 1][3] * sc, 1.0f, 3);
        o[wq] = w; }
    *(GAS v4u*)(dst + 16 * lane) = o;
    if (lane == 0) *scale_out = am > 0.f ? am / 6.0f : 1.0f;
}

__device__ __forceinline__ unsigned q8pack(float a, float b, float c, float d, float s) {
    const int ia = (int)__builtin_rintf(a * s), ib = (int)__builtin_rintf(b * s), ic = (int)__builtin_rintf(c * s), id = (int)__builtin_rintf(d * s);
    return ((unsigned)ia & 255u) | (((unsigned)ib & 255u) << 8) | (((unsigned)ic & 255u) << 16) | ((unsigned)id << 24);
}
__device__ __forceinline__ void p0_absmax_item(const float* W, int item, int lane, gu32* wmax) {
    const int kc = item / 40, nc = item % 40, n0 = 256 * nc + 4 * lane;
    const float* p = W + (size_t)(128 * kc) * 10240 + n0;
    f32x4 am = (f32x4){0.f, 0.f, 0.f, 0.f};
#pragma unroll 16
    for (int r = 0; r < 128; ++r) { const f32x4 v = *(const GAS f32x4*)(p + (size_t)r * 10240);
        am[0] = fmaxf(am[0], fabsf(v[0])); am[1] = fmaxf(am[1], fabsf(v[1])); am[2] = fmaxf(am[2], fabsf(v[2])); am[3] = fmaxf(am[3], fabsf(v[3])); }
#pragma unroll
    for (int j = 0; j < 4; ++j) (void)__hip_atomic_fetch_max(wmax + n0 + j, __builtin_bit_cast(unsigned, am[j]), RLX_AGENT);
}
__device__ __forceinline__ void p0_transpose_item_i8(const float* W, int K, int N, unsigned char* W8, LAS float* scr, int item, int lane, const gu32* wmax) {
    const int nblk = N / 32, kb = item / nblk, nb = item % nblk, k0 = 64 * kb, n0 = 32 * nb;
#pragma unroll 8
    for (int i = 0; i < 32; ++i) { const int kk = 2 * i + (lane >> 5); scr[kk * 33 + (lane & 31)] = W[(size_t)(k0 + kk) * N + n0 + (lane & 31)]; }
    LDS_WAIT(); asm volatile("" ::: "memory");
    const int c = lane & 7;
#pragma unroll
    for (int j = 0; j < 4; ++j) { const int n = (lane >> 3) + 8 * j; const LAS float* s = scr + (8 * c) * 33 + n;
        const float am = __builtin_bit_cast(float, wmax[n0 + n]); const float sc = am > 0.f ? 127.0f / am : 0.f;
        v2u o; o.x = q8pack(s[0 * 33], s[1 * 33], s[2 * 33], s[3 * 33], sc); o.y = q8pack(s[4 * 33], s[5 * 33], s[6 * 33], s[7 * 33], sc);
        *(GAS v2u*)(W8 + (size_t)inproj_row(n0 + n) * K + k0 + 8 * c) = o; }
    LDS_WAIT(); asm volatile("" ::: "memory");
}
__device__ __forceinline__ void p0_x_row(const float* src, bf16* dstb, unsigned char* dst8, float* sx, int lane) {
    f32x4 v[8]; float am = 0.f;
#pragma unroll
    for (int j = 0; j < 8; ++j) { v[j] = *(const GAS f32x4*)(src + 256 * j + 4 * lane);
        am = fmaxf(am, fmaxf(fmaxf(fabsf(v[j][0]), fabsf(v[j][1])), fmaxf(fabsf(v[j][2]), fabsf(v[j][3])))); }
#pragma unroll
    for (int o = 1; o < 64; o <<= 1) am = fmaxf(am, __shfl_xor(am, o));
    const float sc = am > 0.f ? 127.0f / am : 0.f;
#pragma unroll
    for (int j = 0; j < 8; ++j) { *(GAS v2u*)(dstb + 256 * j + 4 * lane) = (v2u){pk2(v[j][0], v[j][1]), pk2(v[j][2], v[j][3])};
        *(GAS unsigned*)(dst8 + 256 * j + 4 * lane) = q8pack(v[j][0], v[j][1], v[j][2], v[j][3], sc); }
    if (lane == 0) *sx = am * (1.0f / 127.0f);
}

namespace att {
constexpr int KB0 = 0, VB0 = 32768, KMT = 65536, QFR = 65536;
__device__ __forceinline__ int crow(int r, int hi) { return (r & 3) + 8 * (r >> 2) + 4 * hi; }
__device__ __forceinline__ unsigned cvtpk(float lo, float hi) { return pg8::cvt_pk_bf16(lo, hi); }

template <int DQK, bool MOBA>
__device__ __forceinline__ void attn_pass(LAS unsigned char* lds, const bf16* Qg, const bf16* Kg, const bf16* Vtg, int q0, unsigned sel, f32x16 (&o)[4], int tid, int wid, int lane) {
    constexpr int NS = DQK / 16, RB = DQK * 2, KCH = DQK / 8;
    constexpr float THR = 8.0f;
    const int r32 = lane & 31, hi = lane >> 5;
    const int qpos = q0 + 32 * wid + r32;
    const int own = q0 >> 8;
    const LAS unsigned char* qlds = lds + QFR + wid * 8192 + lane * 16;
    { const bf16* qp = Qg + (size_t)(wid * 8) * 512 + lane * 8;
#pragma unroll
      for (int s = 0; s < NS; ++s) *(LAS bf16x8*)(lds + QFR + wid * 8192 + lane * 16 + s * 1024) = *(const GAS bf16x8*)(qp + 512 * s); }
#pragma unroll
    for (int d = 0; d < 4; ++d) o[d] = (f32x16){0.f,0.f,0.f,0.f,0.f,0.f,0.f,0.f,0.f,0.f,0.f,0.f,0.f,0.f,0.f,0.f};
    f32x16 negm = (f32x16){0.f,0.f,0.f,0.f,0.f,0.f,0.f,0.f,0.f,0.f,0.f,0.f,0.f,0.f,0.f,0.f};
    float l_run = 0.f;
    const int nt = MOBA ? 4 + 4 * own : (q0 + 256) / 64;
    constexpr int NKC = (64 * KCH) / 512;
    v4u kreg[NKC], vreg[2];
    unsigned kgo[NKC], vgo[2]; int klds[NKC], vl0[2], vl1[2];
#pragma unroll
    for (int i = 0; i < NKC; ++i) { const int cid = tid + 512 * i, key = cid / KCH, ch = cid % KCH;
        const int swz = (DQK == 128) ? (key & 15) : ((key >> 1) & 7);
        kgo[i] = (unsigned)(key * 1024 + ch * 8) * 2u; klds[i] = key * RB + ((ch ^ swz) << 4); }
#pragma unroll
    for (int i = 0; i < 2; ++i) { const int cid = tid + 512 * i, d = cid >> 3, g = cid & 7;
        const int c = (g >> 2) * 4 + ((g >> 1) & 1) * 2, sw = (d >> 1) & 7, e = g & 1;
        vgo[i] = (unsigned)(d * T + g * 8) * 2u; vl0[i] = d * 128 + ((c ^ sw) << 4) + 8 * e; vl1[i] = d * 128 + (((c + 1) ^ sw) << 4) + 8 * e; }
#define KTILE(i) (MOBA ? ((i) < 4 ? own * 4 + (i) : (i) - 4) : (i))
#define ATT_LOAD(kt) do { const GAS unsigned char* kb_ = (const GAS unsigned char*)Kg + (size_t)(kt) * 131072; const GAS unsigned char* vb_ = (const GAS unsigned char*)Vtg + (size_t)(kt) * 128; \
                          _Pragma("unroll") for (int i_ = 0; i_ < NKC; ++i_) kreg[i_] = *(const GAS v4u*)(kb_ + kgo[i_]); \
                          _Pragma("unroll") for (int i_ = 0; i_ < 2; ++i_) vreg[i_] = *(const GAS v4u*)(vb_ + vgo[i_]); } while (0)
#define ATT_STORE(buf) do { _Pragma("unroll") for (int i_ = 0; i_ < NKC; ++i_) *(LAS v4u*)(lds + KB0 + (buf) * 16384 + klds[i_]) = kreg[i_]; \
                            _Pragma("unroll") for (int i_ = 0; i_ < 2; ++i_) { *(LAS v2u*)(lds + VB0 + (buf) * 16384 + vl0[i_]) = (v2u){vreg[i_].x, vreg[i_].y}; \
                                                                              *(LAS v2u*)(lds + VB0 + (buf) * 16384 + vl1[i_]) = (v2u){vreg[i_].z, vreg[i_].w}; } } while (0)
    ATT_LOAD(KTILE(0)); ATT_STORE(0);
    __syncthreads();
    const int kswz = (DQK == 128) ? (r32 & 15) : ((r32 >> 1) & 7);
    const int vsw = (r32 >> 1) & 7;
    const int kfo = r32 * RB, vfo = r32 * 128;
#define ATT_STEP(BUF) do { \
        const int kt = KTILE(it); const bool more = it + 1 < nt; \
        if (more) ATT_LOAD(KTILE(it + 1)); \
        const int blk = kt >> 2; bool need; \
        if (!MOBA || it < 4) need = (kt * 64 <= q0 + 32 * wid + 31); else need = __any((sel >> blk) & 1u); \
        if (need) { \
            f32x16 p0, p1; \
            const LAS unsigned char* kb = lds + KB0 + (BUF) * 16384 + kfo; \
              \
            bf16x8 fk0[2], fk1[2], fqv[2]; \
            { const int ch = ((0 + hi) ^ kswz) << 4; fk0[0] = *(const LAS bf16x8*)(kb + ch); fk1[0] = *(const LAS bf16x8*)(kb + 32 * RB + ch); fqv[0] = *(const LAS bf16x8*)(qlds); } \
            _Pragma("unroll") for (int s = 0; s < NS; ++s) { \
                if (s + 1 < NS) { const int ch = ((2 * (s + 1) + hi) ^ kswz) << 4; \
                    fk0[(s + 1) & 1] = *(const LAS bf16x8*)(kb + ch); fk1[(s + 1) & 1] = *(const LAS bf16x8*)(kb + 32 * RB + ch); fqv[(s + 1) & 1] = *(const LAS bf16x8*)(qlds + (s + 1) * 1024); } \
                __builtin_amdgcn_sched_barrier(0); \
                if (s == 0) {   \
                    asm volatile("v_mfma_f32_32x32x16_bf16 %0, %1, %2, %3" : "=&v"(p0) : "v"(fk0[0]), "v"(fqv[0]), "v"(negm)); \
                    asm volatile("v_mfma_f32_32x32x16_bf16 %0, %1, %2, %3" : "=&v"(p1) : "v"(fk1[0]), "v"(fqv[0]), "v"(negm)); } \
                else { p0 = __builtin_amdgcn_mfma_f32_32x32x16_bf16(fk0[s & 1], fqv[s & 1], p0, 0, 0, 0); p1 = __builtin_amdgcn_mfma_f32_32x32x16_bf16(fk1[s & 1], fqv[s & 1], p1, 0, 0, 0); } \
                __builtin_amdgcn_sched_barrier(0); } \
            if (!MOBA || it < 4) { \
                if (kt * 64 + 63 > q0 + 32 * wid) { const int kbase = kt * 64 + 4 * hi; \
                    _Pragma("unroll") for (int r = 0; r < 16; ++r) { const int kv = kbase + (r & 3) + 8 * (r >> 2); if (kv > qpos) p0[r] = -INFINITY; if (kv + 32 > qpos) p1[r] = -INFINITY; } } \
            } else { if (!((sel >> blk) & 1u)) { _Pragma("unroll") for (int r = 0; r < 16; ++r) { p0[r] = -INFINITY; p1[r] = -INFINITY; } } } \
            float rm = fmaxf(fmaxf(p0[0], p0[1]), p1[0]); \
            _Pragma("unroll") for (int r = 1; r < 16; ++r) rm = fmaxf(fmaxf(rm, p0[r]), p1[r]); \
            { const unsigned rb = __builtin_bit_cast(unsigned, rm); auto rr = __builtin_amdgcn_permlane32_swap(rb, rb, false, false); rm = fmaxf(__builtin_bit_cast(float, (unsigned)rr[0]), __builtin_bit_cast(float, (unsigned)rr[1])); } \
            if (it == 0 || __any(rm > THR)) { \
                const float dl = (it == 0) ? rm : fmaxf(rm, 0.f); const float alpha = fexp2(-dl); \
                _Pragma("unroll") for (int r = 0; r < 16; ++r) { p0[r] -= dl; p1[r] -= dl; negm[r] -= dl; } \
                l_run *= alpha; \
                _Pragma("unroll") for (int d = 0; d < 4; ++d) _Pragma("unroll") for (int r = 0; r < 16; ++r) o[d][r] *= alpha; } \
            float ls = 0.f; \
            _Pragma("unroll") for (int r = 0; r < 16; ++r) { p0[r] = fexp2(p0[r]); p1[r] = fexp2(p1[r]); ls += p0[r] + p1[r]; } \
            l_run += ls; \
            bf16x8 pa[4]; \
            { v4u w; \
              w.x = cvtpk(p0[0], p0[1]); w.y = cvtpk(p0[2], p0[3]); w.z = cvtpk(p0[4], p0[5]); w.w = cvtpk(p0[6], p0[7]); pa[0] = __builtin_bit_cast(bf16x8, w); \
              w.x = cvtpk(p0[8], p0[9]); w.y = cvtpk(p0[10], p0[11]); w.z = cvtpk(p0[12], p0[13]); w.w = cvtpk(p0[14], p0[15]); pa[1] = __builtin_bit_cast(bf16x8, w); \
              w.x = cvtpk(p1[0], p1[1]); w.y = cvtpk(p1[2], p1[3]); w.z = cvtpk(p1[4], p1[5]); w.w = cvtpk(p1[6], p1[7]); pa[2] = __builtin_bit_cast(bf16x8, w); \
              w.x = cvtpk(p1[8], p1[9]); w.y = cvtpk(p1[10], p1[11]); w.z = cvtpk(p1[12], p1[13]); w.w = cvtpk(p1[14], p1[15]); pa[3] = __builtin_bit_cast(bf16x8, w); } \
            const LAS unsigned char* vb = lds + VB0 + (BUF) * 16384 + vfo; \
            bf16x8 vfr[2][4]; \
            _Pragma("unroll") for (int d = 0; d < 4; ++d) vfr[0][d] = *(const LAS bf16x8*)(vb + d * 4096 + (((0 + hi) ^ vsw) << 4)); \
            _Pragma("unroll") for (int ks = 0; ks < 4; ++ks) { \
                if (ks + 1 < 4) { const int c = ((ks + 1) >> 1) * 4 + ((ks + 1) & 1) * 2 + hi; \
                    _Pragma("unroll") for (int d = 0; d < 4; ++d) vfr[(ks + 1) & 1][d] = *(const LAS bf16x8*)(vb + d * 4096 + ((c ^ vsw) << 4)); } \
                __builtin_amdgcn_sched_barrier(0); \
                _Pragma("unroll") for (int d = 0; d < 4; ++d) o[d] = __builtin_amdgcn_mfma_f32_32x32x16_bf16(vfr[ks & 1][d], pa[ks], o[d], 0, 0, 0); \
                __builtin_amdgcn_sched_barrier(0); } \
        } \
        if (more) ATT_STORE((BUF) ^ 1); \
        __syncthreads(); \
    } while (0)
    int it = 0;
#pragma unroll 1
    for (; it + 1 < nt; it += 2) { ATT_STEP(0); ++it; ATT_STEP(1); --it; }
    if (it < nt) ATT_STEP(0);
#undef ATT_STEP
#undef ATT_LOAD
#undef KTILE
#undef ATT_STORE
    const float lt = l_run + __shfl_xor(l_run, 32);
    const float inv = 1.0f / lt;
#pragma unroll
    for (int d = 0; d < 4; ++d)
#pragma unroll
        for (int r = 0; r < 16; ++r) o[d][r] *= inv;
}

__device__ __forceinline__ void attn_pass_diff2(LAS unsigned char* lds, const bf16* Qg, const bf16* Kg, const bf16* Vtg, int q0, f32x16 (&o1)[4], f32x16 (&o2)[4], int tid, int wid, int lane) {
    constexpr int RB = 256, KCH = 16; constexpr float THR = 8.0f;
    { const int r32 = lane & 31, hi = lane >> 5;
      const bf16* qp = Qg + (size_t)(wid * 8) * 512 + lane * 8;
#pragma unroll
      for (int s = 0; s < 8; ++s) *(LAS bf16x8*)(lds + QFR + wid * 8192 + lane * 16 + s * 1024) = *(const GAS bf16x8*)(qp + 512 * s); }
#pragma unroll
    for (int d = 0; d < 4; ++d) { o1[d] = (f32x16){0.f,0.f,0.f,0.f,0.f,0.f,0.f,0.f,0.f,0.f,0.f,0.f,0.f,0.f,0.f,0.f}; o2[d] = o1[d]; }
    float m1 = 0.f, l1 = 0.f, m2 = 0.f, l2 = 0.f;
    const int nt = (q0 + 256) / 64;
    v4u sreg[2];
#define ATT_KGO(i) ((unsigned)((((tq_ + 512 * (i)) >> 4) * 1024 + ((tq_ + 512 * (i)) & 15) * 8) * 2))
#define ATT_KLDS(i) ((((tq_ + 512 * (i)) >> 4) * RB) + (((((tq_ + 512 * (i)) & 15)) ^ (((tq_ + 512 * (i)) >> 4) & 15)) << 4))
#define ATT_VGO(i) ((unsigned)((((tq_ + 512 * (i)) >> 3) * T + ((tq_ + 512 * (i)) & 7) * 8) * 2))
#define ATT_VC(i) (((((tq_ + 512 * (i)) & 7) >> 2) * 4) + (((((tq_ + 512 * (i)) & 7) >> 1) & 1) * 2))
#define ATT_VL0(i) ((((tq_ + 512 * (i)) >> 3) * 128) + ((ATT_VC(i) ^ ((((tq_ + 512 * (i)) >> 3) >> 1) & 7)) << 4) + 8 * ((tq_ + 512 * (i)) & 1))
#define ATT_VL1(i) ((((tq_ + 512 * (i)) >> 3) * 128) + (((ATT_VC(i) + 1) ^ ((((tq_ + 512 * (i)) >> 3) >> 1) & 7)) << 4) + 8 * ((tq_ + 512 * (i)) & 1))
#define ATT_TQ int tq_ = lane; asm volatile("" : "+v"(tq_)); tq_ += 64 * wid
#define ATT_LOADK(kt) do { ATT_TQ; const GAS unsigned char* kb_ = (const GAS unsigned char*)Kg + (size_t)(kt) * 131072; _Pragma("unroll") for (int i_ = 0; i_ < 2; ++i_) sreg[i_] = *(const GAS v4u*)(kb_ + ATT_KGO(i_)); } while (0)
#define ATT_LOADV(kt) do { ATT_TQ; const GAS unsigned char* vb_ = (const GAS unsigned char*)Vtg + (size_t)(kt) * 128; _Pragma("unroll") for (int i_ = 0; i_ < 2; ++i_) sreg[i_] = *(const GAS v4u*)(vb_ + ATT_VGO(i_)); } while (0)
#define ATT_STOREK(buf) do { ATT_TQ; _Pragma("unroll") for (int i_ = 0; i_ < 2; ++i_) *(LAS v4u*)(lds + KB0 + (buf) * 16384 + ATT_KLDS(i_)) = sreg[i_]; } while (0)
#define ATT_STOREV(buf) do { ATT_TQ; _Pragma("unroll") for (int i_ = 0; i_ < 2; ++i_) { *(LAS v2u*)(lds + VB0 + (buf) * 16384 + ATT_VL0(i_)) = (v2u){sreg[i_].x, sreg[i_].y}; \
                                                                               *(LAS v2u*)(lds + VB0 + (buf) * 16384 + ATT_VL1(i_)) = (v2u){sreg[i_].z, sreg[i_].w}; } } while (0)
    {
      ATT_LOADK(0);
      v4u sv_[2]; { ATT_TQ; const GAS unsigned char* vb_ = (const GAS unsigned char*)Vtg; _Pragma("unroll") for (int i_ = 0; i_ < 2; ++i_) sv_[i_] = *(const GAS v4u*)(vb_ + ATT_VGO(i_)); }
      ATT_STOREK(0);
      { ATT_TQ; _Pragma("unroll") for (int i_ = 0; i_ < 2; ++i_) { *(LAS v2u*)(lds + VB0 + ATT_VL0(i_)) = (v2u){sv_[i_].x, sv_[i_].y}; *(LAS v2u*)(lds + VB0 + ATT_VL1(i_)) = (v2u){sv_[i_].z, sv_[i_].w}; } } }
    __syncthreads();
#define ATT_LN int ln_ = lane; asm volatile("" : "+v"(ln_)); const int r32 = ln_ & 31, hi = ln_ >> 5
#define ATT_QKS(BUF, S0, M, L, O) do { \
        ATT_LN; const int kswz = r32 & 15; const LAS unsigned char* qlds = lds + QFR + wid * 8192 + ln_ * 16; \
        const LAS unsigned char* kb = lds + KB0 + (BUF) * 16384 + r32 * RB; \
        _Pragma("unroll") for (int s = 0; s < 4; ++s) { const int ch = ((2 * ((S0) + s) + hi) ^ kswz) << 4; \
            const bf16x8 k0 = *(const LAS bf16x8*)(kb + ch), k1 = *(const LAS bf16x8*)(kb + 32 * RB + ch); \
            const bf16x8 qv = *(const LAS bf16x8*)(qlds + ((S0) + s) * 1024); \
            if (s == 0) { asm volatile("v_mfma_f32_32x32x16_bf16 %0, %1, %2, 0" : "=&v"(p0) : "v"(k0), "v"(qv)); \
                          asm volatile("v_mfma_f32_32x32x16_bf16 %0, %1, %2, 0" : "=&v"(p1) : "v"(k1), "v"(qv)); } \
            else { p0 = __builtin_amdgcn_mfma_f32_32x32x16_bf16(k0, qv, p0, 0, 0, 0); p1 = __builtin_amdgcn_mfma_f32_32x32x16_bf16(k1, qv, p1, 0, 0, 0); } } \
        if (diag) { const int kbase = kt * 64 + 4 * hi, qpos = q0 + 32 * wid + r32; \
            _Pragma("unroll") for (int r = 0; r < 16; ++r) { const int kv = kbase + (r & 3) + 8 * (r >> 2); if (kv > qpos) p0[r] = -INFINITY; if (kv + 32 > qpos) p1[r] = -INFINITY; } } \
        float rm = fmaxf(fmaxf(p0[0], p0[1]), p1[0]); \
        _Pragma("unroll") for (int r = 1; r < 16; ++r) rm = fmaxf(fmaxf(rm, p0[r]), p1[r]); \
        { const unsigned rb = __builtin_bit_cast(unsigned, rm); auto rr = __builtin_amdgcn_permlane32_swap(rb, rb, false, false); rm = fmaxf(__builtin_bit_cast(float, (unsigned)rr[0]), __builtin_bit_cast(float, (unsigned)rr[1])); } \
        if (it == 0 || __any(rm > M + THR)) { \
            const float mnew = (it == 0) ? rm : fmaxf(M, rm); const float alpha = fexp2(M - mnew); M = mnew; \
            L *= alpha; \
            _Pragma("unroll") for (int d = 0; d < 4; ++d) _Pragma("unroll") for (int r = 0; r < 16; ++r) O[d][r] *= alpha; } \
        float ls = 0.f; \
        { typedef float f32x2v __attribute__((ext_vector_type(2))); const f32x2v mm = (f32x2v){M, M};        \
          _Pragma("unroll") for (int r = 0; r < 16; r += 2) { const f32x2v a = (f32x2v){p0[r], p0[r + 1]} - mm, b = (f32x2v){p1[r], p1[r + 1]} - mm; \
              p0[r] = fexp2(a.x); p0[r + 1] = fexp2(a.y); p1[r] = fexp2(b.x); p1[r + 1] = fexp2(b.y); ls += (p0[r] + p0[r + 1]) + (p1[r] + p1[r + 1]); } } \
        L += ls; \
    } while (0)
#define ATT_PACK(dst_, ks) do { \
        if ((ks) == 0) { (dst_).x = cvtpk(p0[0], p0[1]); (dst_).y = cvtpk(p0[2], p0[3]); (dst_).z = cvtpk(p0[4], p0[5]); (dst_).w = cvtpk(p0[6], p0[7]); } \
        else if ((ks) == 1) { (dst_).x = cvtpk(p0[8], p0[9]); (dst_).y = cvtpk(p0[10], p0[11]); (dst_).z = cvtpk(p0[12], p0[13]); (dst_).w = cvtpk(p0[14], p0[15]); } \
        else if ((ks) == 2) { (dst_).x = cvtpk(p1[0], p1[1]); (dst_).y = cvtpk(p1[2], p1[3]); (dst_).z = cvtpk(p1[4], p1[5]); (dst_).w = cvtpk(p1[6], p1[7]); } \
        else { (dst_).x = cvtpk(p1[8], p1[9]); (dst_).y = cvtpk(p1[10], p1[11]); (dst_).z = cvtpk(p1[12], p1[13]); (dst_).w = cvtpk(p1[14], p1[15]); } } while (0)
#define ATT_STEP(BUF) do { \
        const int kt = it; const bool more = it + 1 < nt; \
        const bool need = kt * 64 <= q0 + 32 * wid + 31, diag = kt * 64 + 63 > q0 + 32 * wid; \
        if (more) ATT_LOADK(it + 1); \
        v4u pa1[4] = {(v4u){0u, 0u, 0u, 0u}, (v4u){0u, 0u, 0u, 0u}, (v4u){0u, 0u, 0u, 0u}, (v4u){0u, 0u, 0u, 0u}}; \
        if (need) { f32x16 p0, p1; ATT_QKS(BUF, 0, m1, l1, o1); \
              _Pragma("unroll") for (int ks = 0; ks < 4; ++ks) ATT_PACK(pa1[ks], ks); } \
        if (more) { ATT_STOREK((BUF) ^ 1); ATT_LOADV(it + 1); }        \
        if (need) { v4u pa2[4]; \
              { f32x16 p0, p1; ATT_QKS(BUF, 4, m2, l2, o2); \
                _Pragma("unroll") for (int ks = 0; ks < 4; ++ks) ATT_PACK(pa2[ks], ks); } \
              __builtin_amdgcn_sched_barrier(0); \
              ATT_LN; const int vsw = (r32 >> 1) & 7; \
              const LAS unsigned char* vb = lds + VB0 + (BUF) * 16384 + r32 * 128; \
              _Pragma("unroll") for (int ks = 0; ks < 4; ++ks) { \
                const bf16x8 pb1 = __builtin_bit_cast(bf16x8, pa1[ks]), pb2 = __builtin_bit_cast(bf16x8, pa2[ks]); \
                const int c = (ks >> 1) * 4 + (ks & 1) * 2 + hi; \
                _Pragma("unroll") for (int d = 0; d < 4; ++d) { const bf16x8 vf = *(const LAS bf16x8*)(vb + d * 4096 + ((c ^ vsw) << 4)); \
                    o1[d] = __builtin_amdgcn_mfma_f32_32x32x16_bf16(vf, pb1, o1[d], 0, 0, 0); \
                    o2[d] = __builtin_amdgcn_mfma_f32_32x32x16_bf16(vf, pb2, o2[d], 0, 0, 0); } \
                __builtin_amdgcn_sched_barrier(0); } } \
        if (more) ATT_STOREV((BUF) ^ 1); \
        __syncthreads(); \
    } while (0)
    int it = 0;
#pragma unroll 1
    for (; it + 1 < nt; it += 2) { ATT_STEP(0); ++it; ATT_STEP(1); --it; }
    if (it < nt) ATT_STEP(0);
#undef ATT_STEP
#undef ATT_QKS
#undef ATT_PACK
#undef ATT_LN
#undef ATT_LOADK
#undef ATT_LOADV
#undef ATT_STOREK
#undef ATT_STOREV
#undef ATT_TQ
#undef ATT_KGO
#undef ATT_KLDS
#undef ATT_VGO
#undef ATT_VC
#undef ATT_VL0
#undef ATT_VL1
    const float i1 = 1.0f / (l1 + __shfl_xor(l1, 32)), i2 = 1.0f / (l2 + __shfl_xor(l2, 32));
#pragma unroll
    for (int d = 0; d < 4; ++d)
#pragma unroll
        for (int r = 0; r < 16; ++r) { o1[d][r] *= i1; o2[d][r] *= i2; }
}

struct AttnArgs { const bf16 *qa, *ka, *qd, *kd, *vt; bf16* oab; const float* kmean; const float* gain; float lam, one_minus_li; };

constexpr int OST0 = 135168;
__device__ __forceinline__ LAS unsigned char* out_slot(LAS unsigned char* lds, int wid) { return lds + (wid == 0 ? OST0 : QFR + wid * 8192); }
__device__ __forceinline__ void out_put(LAS unsigned char* slot, int r32, int hi, int d, int gq, v2u w) { *(LAS v2u*)(slot + r32 * 256 + (((4 * d + gq) ^ (r32 & 15)) << 4) + hi * 8) = w; }
__device__ __forceinline__ void out_flush(const LAS unsigned char* slot, bf16* g, int lane) {
    const int c = lane & 15, rq = lane >> 4;
#pragma unroll
    for (int i = 0; i < 8; ++i) { const int row = 4 * i + rq; const v4u v = *(const LAS v4u*)(slot + row * 256 + ((c ^ (row & 15)) << 4)); *(GAS v4u*)(g + (size_t)row * 2048 + c * 8) = v; }
}

__device__ __forceinline__ void moba_unit(LAS unsigned char* lds, const AttnArgs& A, int b, int h, int qb, int tid, int wid, int lane) {
    asm volatile("" : "+v"(tid), "+v"(lane));
    const int r32 = lane & 31, hi = lane >> 5, q0 = qb * 256;
    const bf16* Qg = A.qa + (size_t)((((b * SEQ + q0) >> 8) * 8 + h) * 64) * 512;
    unsigned sel = 0u;
    if (qb > 0) {
        { const int row = tid >> 4, ch = tid & 15, n = row & 15;
          const float* kp = A.kmean + ((size_t)(b * 8 + h) * 16 + n) * 128 + ch * 8;
          const f32x4 a = *(const GAS f32x4*)kp, c = *(const GAS f32x4*)(kp + 4);
          float v[8] = {a[0], a[1], a[2], a[3], c[0], c[1], c[2], c[3]}; unsigned w[8];
#pragma unroll
          for (int j = 0; j < 8; ++j) { const float x = v[j] * (1.0f / 256.0f); const unsigned hb = f2bf(x); const float xr = __builtin_bit_cast(float, hb << 16); w[j] = (row < 16) ? hb : f2bf(x - xr); }
          v4u o; o.x = w[0] | (w[1] << 16); o.y = w[2] | (w[3] << 16); o.z = w[4] | (w[5] << 16); o.w = w[6] | (w[7] << 16);
          *(LAS v4u*)(lds + KMT + row * 256 + ((ch ^ (row & 15)) << 4)) = o; }
        __syncthreads();
        f32x16 g = (f32x16){0.f,0.f,0.f,0.f,0.f,0.f,0.f,0.f,0.f,0.f,0.f,0.f,0.f,0.f,0.f,0.f};
        { const bf16* qp = Qg + (size_t)(wid * 8) * 512 + lane * 8;
          const LAS unsigned char* kb = lds + KMT + r32 * 256;
#pragma unroll
          for (int s = 0; s < 8; ++s) { const bf16x8 qv = *(const GAS bf16x8*)(qp + 512 * s);
              const bf16x8 kf = *(const LAS bf16x8*)(kb + (((2 * s + hi) ^ (r32 & 15)) << 4));
              g = __builtin_amdgcn_mfma_f32_32x32x16_bf16(kf, qv, g, 0, 0, 0); } }
        float G[16];
#pragma unroll
        for (int r = 0; r < 8; ++r) { const float mine = g[r] + g[r + 8]; const float oth = __shfl_xor(mine, 32);
            const int nlo = (r & 3) + 8 * (r >> 2); G[nlo] = hi ? oth : mine; G[nlo + 4] = hi ? mine : oth; }
#pragma unroll
        for (int round = 0; round < 3; ++round) { float best = -INFINITY; int bi = -1;
#pragma unroll
            for (int n = 0; n < 16; ++n) { const bool ok = (n < qb) && !((sel >> n) & 1u) && (G[n] > best); best = ok ? G[n] : best; bi = ok ? n : bi; }
            if (bi >= 0) sel |= 1u << bi; }
        __syncthreads();
    }
    f32x16 o[4];
    attn_pass<128, true>(lds, Qg, A.ka + (size_t)(b * SEQ) * 1024 + h * 128, A.vt + (size_t)(h * 128) * T + b * SEQ, q0, sel, o, tid, wid, lane);
    LAS unsigned char* slot = out_slot(lds, wid);
#pragma unroll
    for (int d = 0; d < 4; ++d)
#pragma unroll
        for (int gq = 0; gq < 4; ++gq) { v2u w; w.x = cvtpk(o[d][4 * gq], o[d][4 * gq + 1]); w.y = cvtpk(o[d][4 * gq + 2], o[d][4 * gq + 3]); out_put(slot, r32, hi, d, gq, w); }
    out_flush(slot, A.oab + (size_t)(b * SEQ + q0 + 32 * wid) * 2048 + h * 128, lane);
}

__device__ __forceinline__ void diff_unit(LAS unsigned char* lds, const AttnArgs& A, int b, int h, int qb, int tid, int wid, int lane) {
    asm volatile("" : "+v"(tid), "+v"(lane));
    const int r32 = lane & 31, hi = lane >> 5, q0 = qb * 256;
    const size_t qrow = (size_t)(b * SEQ + q0);
    const bf16* Vtg = A.vt + (size_t)(1024 + h * 128) * T + b * SEQ;
    f32x16 o[4], o2[4];
    attn_pass_diff2(lds, A.qd + (size_t)(((qrow >> 8) * 8 + h) * 64) * 512, A.kd + (size_t)(b * SEQ) * 1024 + h * 128, Vtg, q0, o, o2, tid, wid, lane);
    float ss = 0.f;
#pragma unroll
    for (int d = 0; d < 4; ++d)
#pragma unroll
        for (int r = 0; r < 16; ++r) { const float v = o[d][r] - A.lam * o2[d][r]; o[d][r] = v; ss += v * v; }
    ss += __shfl_xor(ss, 32);
    const float rn = 1.0f / sqrtf(ss * (1.0f / 128.0f) + RMS_EPS) * A.one_minus_li;
    LAS unsigned char* slot = out_slot(lds, wid);
    const float* gp = A.gain + h * 128 + 4 * hi;
#pragma unroll
    for (int d = 0; d < 4; ++d)
#pragma unroll
        for (int gq = 0; gq < 4; ++gq) { const f32x4 gn = *(const GAS f32x4*)(gp + 32 * d + 8 * gq);
            v2u w; w.x = cvtpk(o[d][4 * gq] * rn * gn[0], o[d][4 * gq + 1] * rn * gn[1]); w.y = cvtpk(o[d][4 * gq + 2] * rn * gn[2], o[d][4 * gq + 3] * rn * gn[3]);
            out_put(slot, r32, hi, d, gq, w); }
    out_flush(slot, A.oab + (qrow + 32 * wid) * 2048 + 1024 + h * 128, lane);
}

__device__ __forceinline__ void attn_phase(LAS unsigned char* lds, const AttnArgs& A, int vcu, int G, int tid, int wid, int lane) {
    for (int ord = vcu; ord < 1024; ord += G) {
        const int i = ord >> 8, v = ord & 255, bh = v >> 3, s = v & 7;
        const int qb = (i & 1) ? 15 - s : s;
        if (i < 2) diff_unit(lds, A, bh >> 3, bh & 7, qb, tid, wid, lane);
        else moba_unit(lds, A, bh >> 3, bh & 7, qb, tid, wid, lane);
    }
}
}

namespace peer {
__device__ __forceinline__ int f2key(float f) { const int u = __builtin_bit_cast(int, f); return u ^ ((u >> 31) & 0x7fffffff); }
__device__ __forceinline__ float key2f(int k) { const int u = k ^ ((k >> 31) & 0x7fffffff); return __builtin_bit_cast(float, u); }
__device__ __forceinline__ int imax(int a, int b) { return a > b ? a : b; }
__device__ __forceinline__ int imin(int a, int b) { return a < b ? a : b; }

template <int OFF> __device__ __forceinline__ void sort16_desc(int (&v)[64]) {
#define PEER_CE(i, j) { const int a_ = v[OFF + (i)], b_ = v[OFF + (j)]; v[OFF + (i)] = imax(a_, b_); v[OFF + (j)] = imin(a_, b_); }
    PEER_CE(0, 1) PEER_CE(2, 3) PEER_CE(0, 2) PEER_CE(1, 3) PEER_CE(1, 2) PEER_CE(4, 5) PEER_CE(6, 7) PEER_CE(4, 6)
    PEER_CE(5, 7) PEER_CE(5, 6) PEER_CE(0, 4) PEER_CE(2, 6) PEER_CE(2, 4) PEER_CE(1, 5) PEER_CE(3, 7) PEER_CE(3, 5)
    PEER_CE(1, 2) PEER_CE(3, 4) PEER_CE(5, 6) PEER_CE(8, 9) PEER_CE(10, 11) PEER_CE(8, 10) PEER_CE(9, 11) PEER_CE(9, 10)
    PEER_CE(12, 13) PEER_CE(14, 15) PEER_CE(12, 14) PEER_CE(13, 15) PEER_CE(13, 14) PEER_CE(8, 12) PEER_CE(10, 14) PEER_CE(10, 12)
    PEER_CE(9, 13) PEER_CE(11, 15) PEER_CE(11, 13) PEER_CE(9, 10) PEER_CE(11, 12) PEER_CE(13, 14) PEER_CE(0, 8) PEER_CE(4, 12)
    PEER_CE(4, 8) PEER_CE(2, 10) PEER_CE(6, 14) PEER_CE(6, 10) PEER_CE(2, 4) PEER_CE(6, 8) PEER_CE(10, 12) PEER_CE(1, 9)
    PEER_CE(5, 13) PEER_CE(5, 9) PEER_CE(3, 11) PEER_CE(7, 15) PEER_CE(7, 11) PEER_CE(3, 5) PEER_CE(7, 9) PEER_CE(11, 13)
    PEER_CE(1, 2) PEER_CE(3, 4) PEER_CE(5, 6) PEER_CE(7, 8) PEER_CE(9, 10) PEER_CE(11, 12) PEER_CE(13, 14)
#undef PEER_CE
}
template <int OA, int OB> __device__ __forceinline__ void merge16_desc(int (&v)[64]) {
#pragma unroll
    for (int i = 0; i < 16; ++i) v[OA + i] = imax(v[OA + i], v[OB + 15 - i]);
#pragma unroll
    for (int j = 8; j > 0; j >>= 1)
#pragma unroll
        for (int i = 0; i < 16; ++i) { const int l = i ^ j;
            if (l > i) { const int a = v[OA + i], b = v[OA + l]; v[OA + i] = imax(a, b); v[OA + l] = imin(a, b); } }
}
__device__ __forceinline__ void top16_of_64(int (&v)[64]) {
    sort16_desc<0>(v); sort16_desc<16>(v); sort16_desc<32>(v); sort16_desc<48>(v);
    merge16_desc<0, 16>(v); merge16_desc<32, 48>(v); merge16_desc<0, 32>(v);
}
__device__ __forceinline__ void top16_of_64_set(int (&v)[64]) {
    sort16_desc<0>(v); sort16_desc<16>(v); sort16_desc<32>(v); sort16_desc<48>(v);
    merge16_desc<0, 16>(v); merge16_desc<32, 48>(v);
#pragma unroll
    for (int i = 0; i < 16; ++i) v[i] = imax(v[i], v[32 + 15 - i]);
}
__device__ __forceinline__ float gelu_tanh(float x) {
    const float u = 0.7978845608028654f * (x + 0.044715f * x * x * x);
    const float e = __builtin_amdgcn_exp2f(2.0f * 1.4426950408889634f * u);
    const float th = 1.0f - 2.0f * __builtin_amdgcn_rcpf(e + 1.0f);
    return 0.5f * x * (1.0f + th);
}
constexpr int ETILE = 0, GTILE = 16384, SCR0 = 32768, XQ0 = 98304, LNG0 = 114688;

__device__ __forceinline__ void select_tile(LAS unsigned char* lds, const bf16* pq, const bf16* sk, int t0, int wid, int lane) {
    asm volatile("" : "+v"(lane));
    const int r32 = lane & 31, hi = lane >> 5, h = wid;
    LAS int* scr = (LAS int*)(lds + SCR0 + wid * 8192);
    int v[64];
    bf16x8 qn[8], an[4];
    { const bf16* qp = pq + ((size_t)((((t0 >> 5) * 8 + h) * 2) * 8) * 64 + lane) * 8;
      const bf16* ap = sk + (size_t)h * 16384 + 8 * lane;
#pragma unroll
      for (int s = 0; s < 8; ++s) qn[s] = *(const GAS bf16x8*)(qp + 512 * s);
#pragma unroll
      for (int s = 0; s < 4; ++s) an[s] = *(const GAS bf16x8*)(ap + 512 * s); }
#pragma unroll 1
    for (int c = 0; c < 2; ++c) {
        bf16x8 qf[8];
#pragma unroll
        for (int s = 0; s < 8; ++s) qf[s] = qn[s];
        bf16x8 af[2][4];
        const bf16* ap0 = sk + (size_t)(c * 8 + h) * 16384 + 8 * lane;
#pragma unroll
        for (int s = 0; s < 4; ++s) af[0][s] = an[s];
        f32x16 sc;
#pragma unroll
        for (int hb = 0; hb < 8; ++hb) {
            if (hb + 1 < 8) { const bf16* ap = ap0 + (size_t)(8 * ((hb + 1) >> 1) + 4 * ((hb + 1) & 1)) * 512;
#pragma unroll
                for (int s = 0; s < 4; ++s) af[(hb + 1) & 1][s] = *(const GAS bf16x8*)(ap + 512 * s); }
            __builtin_amdgcn_sched_barrier(0);
            if ((hb & 1) == 0) sc = (f32x16){0.f,0.f,0.f,0.f,0.f,0.f,0.f,0.f,0.f,0.f,0.f,0.f,0.f,0.f,0.f,0.f};
#pragma unroll
            for (int s = 0; s < 4; ++s) sc = __builtin_amdgcn_mfma_f32_32x32x16_bf16(af[hb & 1][s], qf[4 * (hb & 1) + s], sc, 0, 0, 0);
            if (hb & 1) {
#pragma unroll
                for (int r = 0; r < 16; ++r) v[(hb >> 1) * 16 + r] = (f2key(sc[r]) & ~127) | (32 * (hb >> 1) + (r & 3) + 8 * (r >> 2) + 4 * hi); }
            __builtin_amdgcn_sched_barrier(0);
        }
        if (c == 0) { const bf16* qp = pq + ((size_t)((((t0 >> 5) * 8 + h) * 2 + 1) * 8) * 64 + lane) * 8; const bf16* ap = sk + (size_t)(8 + h) * 16384 + 8 * lane;
#pragma unroll
            for (int s = 0; s < 8; ++s) qn[s] = *(const GAS bf16x8*)(qp + 512 * s);
#pragma unroll
            for (int s = 0; s < 4; ++s) an[s] = *(const GAS bf16x8*)(ap + 512 * s); }
        top16_of_64(v);
#pragma unroll
        for (int i = 0; i < 16; ++i) v[16 + i] = __shfl_xor(v[i], 32);
        merge16_desc<0, 16>(v);
#pragma unroll
        for (int i = 0; i < 16; ++i) scr[(c * 16 + i) * 64 + lane] = v[i];
    }
    LDS_WAIT();
    float a[16], b[16];
#pragma unroll
    for (int i = 0; i < 16; ++i) { a[i] = key2f(scr[i * 64 + lane] & ~127); b[i] = key2f(v[i] & ~127); }
    int n = 0;
#pragma unroll
    for (int i = 0; i < 16; ++i)
#pragma unroll
        for (int j = 0; j < 16; ++j)
            if ((i + 1) * (j + 1) <= 16) { v[n] = (f2key(a[i] + b[j]) & ~255) | (i << 4) | j; ++n; }
#pragma unroll
    for (int i = 0; i < 64; ++i) if (i >= 50) v[i] = (int)0x80000000;
    top16_of_64_set(v);
    float s[16]; int e[16]; float mx = -INFINITY;
#pragma unroll
    for (int k = 0; k < 16; ++k) { const int i = (v[k] >> 4) & 15, j = v[k] & 15;
        const int ka = scr[i * 64 + lane], kb2 = scr[(16 + j) * 64 + lane];
        s[k] = key2f(ka & ~127) + key2f(kb2 & ~127); e[k] = (ka & 127) * 128 + (kb2 & 127); mx = fmaxf(mx, s[k]); }
    float sum = 0.f;
#pragma unroll
    for (int k = 0; k < 16; ++k) { s[k] = __builtin_amdgcn_exp2f((s[k] - mx) * 1.4426950408889634f); sum += s[k]; }
    const float inv = 1.0f / sum;
    if (hi == 0) {
        LAS int* E = (LAS int*)(lds + ETILE) + r32 * 128 + h * 16; LAS float* Gt = (LAS float*)(lds + GTILE) + r32 * 128 + h * 16;
#pragma unroll
        for (int k = 0; k < 16; ++k) { E[k] = e[k]; Gt[k] = s[k] * inv; }
    }
}

#define PEER_LOADROW(dst, tab, ridx) do { dst = *((const GAS v4u*)((tab) + (size_t)(ridx) * 1024) + lane); } while (0)
typedef float f32x2p __attribute__((ext_vector_type(2)));
#define PEER_CVT4(w) const f32x2p c0_ = __builtin_amdgcn_cvt_scalef32_pk_f32_fp4((w), 1.0f, 0), c1_ = __builtin_amdgcn_cvt_scalef32_pk_f32_fp4((w), 1.0f, 1), \
        c2_ = __builtin_amdgcn_cvt_scalef32_pk_f32_fp4((w), 1.0f, 2), c3_ = __builtin_amdgcn_cvt_scalef32_pk_f32_fp4((w), 1.0f, 3)
typedef _Float16 f16x2p __attribute__((ext_vector_type(2)));
#define PEER_CVT4H(w) const f16x2p c0_ = __builtin_amdgcn_cvt_scalef32_pk_f16_fp4((w), 1.0f, 0), c1_ = __builtin_amdgcn_cvt_scalef32_pk_f16_fp4((w), 1.0f, 1), \
        c2_ = __builtin_amdgcn_cvt_scalef32_pk_f16_fp4((w), 1.0f, 2), c3_ = __builtin_amdgcn_cvt_scalef32_pk_f16_fp4((w), 1.0f, 3)
#define PEER_AXPY8H(Y2, wk2, w, b) do { PEER_CVT4H(w); Y2[(b)] = __builtin_elementwise_fma(wk2, c0_, Y2[(b)]); Y2[(b) + 1] = __builtin_elementwise_fma(wk2, c1_, Y2[(b) + 1]); \
        Y2[(b) + 2] = __builtin_elementwise_fma(wk2, c2_, Y2[(b) + 2]); Y2[(b) + 3] = __builtin_elementwise_fma(wk2, c3_, Y2[(b) + 3]); } while (0)
#define PEER_AXPY8(Y2, wk2, w, b) do { PEER_CVT4(w); Y2[(b)] = __builtin_elementwise_fma(wk2, c0_, Y2[(b)]); Y2[(b) + 1] = __builtin_elementwise_fma(wk2, c1_, Y2[(b) + 1]); \
        Y2[(b) + 2] = __builtin_elementwise_fma(wk2, c2_, Y2[(b) + 2]); Y2[(b) + 3] = __builtin_elementwise_fma(wk2, c3_, Y2[(b) + 3]); } while (0)

__device__ __forceinline__ void token_ffn(LAS unsigned char* lds, int tl, const bf16* xrow, const unsigned char* TU, const unsigned char* TV, const float* SU, const float* SV,
                                          const float* gain, const float* bias, float* outf, bf16* outb, unsigned char* out8, float* outsx, int lane,
                                          v4u (&buf)[16], bool have_u, bool has_next) {
    f32x2p xs[16];
    LAS unsigned char* const scw = lds + SCR0 + (tl >> 2) * 8192;
#pragma unroll
    for (int q = 0; q < 4; ++q) *(LAS v4u*)(scw + q * 1024 + lane * 16) = *(const GAS v4u*)(xrow + 512 * q + 8 * lane);
#pragma unroll
    for (int q = 0; q < 4; ++q) { const v4u a = *(const LAS v4u*)(scw + lane * 64 + q * 16);
        xs[4 * q] = (f32x2p){bf_lo(a.x), bf_hi(a.x)}; xs[4 * q + 1] = (f32x2p){bf_lo(a.y), bf_hi(a.y)}; xs[4 * q + 2] = (f32x2p){bf_lo(a.z), bf_hi(a.z)}; xs[4 * q + 3] = (f32x2p){bf_lo(a.w), bf_hi(a.w)}; }
    const LAS int* E = (const LAS int*)(lds + ETILE) + tl * 128; const LAS float* Gt = (const LAS float*)(lds + GTILE) + tl * 128;
    const int e_lo = E[lane], e_hi = E[64 + lane]; const float g_lo = Gt[lane], g_hi = Gt[64 + lane];
    const f32x2p sc_lo = *(const GAS f32x2p*)(SU + 2 * (size_t)e_lo), sc_hi = *(const GAS f32x2p*)(SU + 2 * (size_t)e_hi);
    const float su_lo = sc_lo.x, su_hi = sc_hi.x, sv_lo = sc_lo.y, sv_hi = sc_hi.y;
#define PEER_EIDX(k) (((k) < 64) ? __builtin_amdgcn_readlane(e_lo, (k)) : __builtin_amdgcn_readlane(e_hi, (k) - 64))
    constexpr int PEER_RING = 16;
    float h_lo = 0.f, h_hi = 0.f;
    {
        float am = 0.f;
#pragma unroll
        for (int i = 0; i < 16; ++i) am = fmaxf(am, fmaxf(fabsf(xs[i].x), fabsf(xs[i].y)));
#pragma unroll
        for (int o = 1; o < 64; o <<= 1) am = fmaxf(am, __shfl_xor(am, o));
        const float sx = am > 0.f ? 6.0f / am : 1.0f, isx = am > 0.f ? am / 6.0f : 1.0f;
        v4u xh, xl;
#pragma unroll
        for (int wq = 0; wq < 4; ++wq) { unsigned wh = 0u, wl = 0u;
#define PEER_XQ(b) { const f32x2p v = xs[4 * wq + (b)] * sx; wh = __builtin_amdgcn_cvt_scalef32_pk_fp4_f32(wh, v.x, v.y, 1.0f, (b)); \
                const f32x2p d = __builtin_amdgcn_cvt_scalef32_pk_f32_fp4(wh, 1.0f, (b)); wl = __builtin_amdgcn_cvt_scalef32_pk_fp4_f32(wl, (v.x - d.x) * 4.0f, (v.y - d.y) * 4.0f, 1.0f, (b)); }
            PEER_XQ(0) PEER_XQ(1) PEER_XQ(2) PEER_XQ(3)
#undef PEER_XQ
            xh[wq] = wh; xl[wq] = wl; }
        LAS unsigned char* xq = lds + XQ0 + (tl >> 2) * 2048;
        *(LAS v4u*)(xq + 16 * lane) = xh; *(LAS v4u*)(xq + 1024 + 16 * lane) = xl;
        const int g = lane >> 4, rl = lane & 15;
        typedef int v8i_t __attribute__((ext_vector_type(8)));
        if (!have_u) { const int e_r = E[16 * 0 + rl];
#pragma unroll
            for (int s = 0; s < 16; ++s) buf[s] = *(const GAS v4u*)(TU + (size_t)e_r * 1024 + 16 * g + 64 * s); }
#define PEER_HBLOCK(rb, RELOAD) do { \
            f32x4 ah = {0.f, 0.f, 0.f, 0.f}, al = {0.f, 0.f, 0.f, 0.f}; \
            int xoff = 16 * g; asm volatile("" : "+v"(xoff));        \
            const LAS unsigned char* xbb = xq + xoff; \
            _Pragma("unroll") for (int s = 0; s < 16; ++s) { \
                const v4u a4 = buf[s]; const v4u bh = *(const LAS v4u*)(xbb + 64 * s), bl = *(const LAS v4u*)(xbb + 1024 + 64 * s); \
                const v8i_t A = {(int)a4.x, (int)a4.y, (int)a4.z, (int)a4.w, 0, 0, 0, 0}, BH = {(int)bh.x, (int)bh.y, (int)bh.z, (int)bh.w, 0, 0, 0, 0}, BL = {(int)bl.x, (int)bl.y, (int)bl.z, (int)bl.w, 0, 0, 0, 0}; \
                ah = __builtin_amdgcn_mfma_scale_f32_16x16x128_f8f6f4(A, BH, ah, 4, 4, 0, 127, 0, 127); \
                al = __builtin_amdgcn_mfma_scale_f32_16x16x128_f8f6f4(A, BL, al, 4, 4, 0, 127, 0, 127); \
                RELOAD(s); } \
              \
            float selv = 0.f; \
            _Pragma("unroll") for (int r = 0; r < 4; ++r) { const float hv = (ah[r] + 0.25f * al[r]) * isx; const float t = __shfl(hv, 16 * ((lane >> 2) & 3)); selv = ((lane & 3) == r) ? t : selv; } \
            if ((rb) < 4) h_lo = ((lane >> 4) == (rb)) ? selv : h_lo; else h_hi = ((lane >> 4) == ((rb) - 4)) ? selv : h_hi; } while (0)
#define PEER_RELOAD_U(s) buf[s] = *(const GAS v4u*)(rown + 64 * (s))
#define PEER_RELOAD_V(s) PEER_LOADROW(buf[s], TV, PEER_EIDX(s))
#pragma unroll 1
        for (int rb = 0; rb < 7; ++rb) {
            const int e_n = E[16 * (rb + 1) + rl];
            const GAS unsigned char* rown = (const GAS unsigned char*)TU + (size_t)e_n * 1024 + 16 * g;
            PEER_HBLOCK(rb, PEER_RELOAD_U);
        }
        PEER_HBLOCK(7, PEER_RELOAD_V);
#undef PEER_RELOAD_U
#undef PEER_RELOAD_V
#undef PEER_HBLOCK
    }
    const float w_lo = g_lo * gelu_tanh(h_lo * su_lo) * sv_lo, w_hi = g_hi * gelu_tanh(h_hi * su_hi) * sv_hi;
    f16x2p yh[16];
#pragma unroll
    for (int i = 0; i < 16; ++i) yh[i] = (f16x2p){(_Float16)0.f, (_Float16)0.f};
    int wp_lo, wp_hi;
    { const _Float16 a = (_Float16)(w_lo * 256.0f), b = (_Float16)(w_hi * 256.0f); wp_lo = __builtin_bit_cast(int, (f16x2p){a, a}); wp_hi = __builtin_bit_cast(int, (f16x2p){b, b}); }
#pragma unroll 1
    for (int k0 = 0; k0 < 128 - PEER_RING; k0 += PEER_RING) {
        const int wsrc = (k0 < 64) ? wp_lo : wp_hi;
        const int kb = k0 + PEER_RING;
        const int esrc = (kb < 64) ? e_lo : e_hi;
#pragma unroll
        for (int i = 0; i < PEER_RING; ++i) {
            const f16x2p wk2 = __builtin_bit_cast(f16x2p, __builtin_amdgcn_readlane(wsrc, (k0 & 63) + i));
            const v4u w = buf[i];
            PEER_AXPY8H(yh, wk2, w.x, 0); PEER_AXPY8H(yh, wk2, w.y, 4); PEER_AXPY8H(yh, wk2, w.z, 8); PEER_AXPY8H(yh, wk2, w.w, 12);
            const int en = __builtin_amdgcn_readlane(esrc, (kb & 63) + i); PEER_LOADROW(buf[i], TV, en);
        }
    }
    {
        const int e_nx = has_next ? E[128 + (lane & 15)] : 0;
        const GAS unsigned char* rownx = (const GAS unsigned char*)TU + (size_t)e_nx * 1024 + 16 * (lane >> 4);
#pragma unroll
        for (int i = 0; i < PEER_RING; ++i) {
            const f16x2p wk2 = __builtin_bit_cast(f16x2p, __builtin_amdgcn_readlane(wp_hi, 48 + i));
            const v4u w = buf[i];
            PEER_AXPY8H(yh, wk2, w.x, 0); PEER_AXPY8H(yh, wk2, w.y, 4); PEER_AXPY8H(yh, wk2, w.z, 8); PEER_AXPY8H(yh, wk2, w.w, 12);
            if (has_next) buf[i] = *(const GAS v4u*)(rownx + 64 * i);
        }
    }
    f32x2p y[16];
    float sm = 0.f;
#pragma unroll
    for (int i = 0; i < 16; ++i) { y[i] = xs[i] * ALPHA + (f32x2p){(float)yh[i].x, (float)yh[i].y} * (1.0f / 256.0f); sm += y[i].x + y[i].y; }
    const float mean = wave_sum(sm) * (1.0f / 2048.0f);
    float sq = 0.f;
#pragma unroll
    for (int i = 0; i < 16; ++i) { y[i] = y[i] - mean; sq += y[i].x * y[i].x + y[i].y * y[i].y; }
    const float rstd = 1.0f / sqrtf(wave_sum(sq) * (1.0f / 2048.0f) + LN_EPS);
    unsigned pk[16];
#pragma unroll
    for (int q = 0; q < 8; ++q) { const int c0 = 32 * lane + 4 * q;
        const f32x4 ga = *(const LAS f32x4*)(lds + LNG0 + (q * 64 + lane) * 16), ba = *(const LAS f32x4*)(lds + LNG0 + 8192 + (q * 64 + lane) * 16);
        f32x4 o;
        o[0] = y[2 * q].x * rstd * ga[0] + ba[0]; o[1] = y[2 * q].y * rstd * ga[1] + ba[1]; o[2] = y[2 * q + 1].x * rstd * ga[2] + ba[2]; o[3] = y[2 * q + 1].y * rstd * ga[3] + ba[3];
        if (outf) *(LAS f32x4*)(scw + lane * 128 + q * 16) = o;
        pk[2 * q] = pk2(o[0], o[1]); pk[2 * q + 1] = pk2(o[2], o[3]); }
    if (outf) {
#pragma unroll
        for (int i = 0; i < 8; ++i) *(GAS f32x4*)(outf + 256 * i + 4 * lane) = *(const LAS f32x4*)(scw + i * 1024 + lane * 16); }
    if (outb) {
#pragma unroll
        for (int q = 0; q < 4; ++q) *(LAS v4u*)(scw + lane * 64 + q * 16) = (v4u){pk[4 * q], pk[4 * q + 1], pk[4 * q + 2], pk[4 * q + 3]};
#pragma unroll
        for (int i = 0; i < 4; ++i) *(GAS v4u*)(outb + 512 * i + 8 * lane) = *(const LAS v4u*)(scw + i * 1024 + lane * 16);
        float am = 0.f;
#pragma unroll
        for (int i = 0; i < 16; ++i) am = fmaxf(am, fmaxf(fabsf(bf_lo(pk[i])), fabsf(bf_hi(pk[i]))));
#pragma unroll
        for (int o = 1; o < 64; o <<= 1) am = fmaxf(am, __shfl_xor(am, o));
        const float sc = am > 0.f ? 127.0f / am : 0.f;
#pragma unroll
        for (int q = 0; q < 2; ++q) { v4u w;
            w.x = q8pack(bf_lo(pk[8 * q]), bf_hi(pk[8 * q]), bf_lo(pk[8 * q + 1]), bf_hi(pk[8 * q + 1]), sc); w.y = q8pack(bf_lo(pk[8 * q + 2]), bf_hi(pk[8 * q + 2]), bf_lo(pk[8 * q + 3]), bf_hi(pk[8 * q + 3]), sc);
            w.z = q8pack(bf_lo(pk[8 * q + 4]), bf_hi(pk[8 * q + 4]), bf_lo(pk[8 * q + 5]), bf_hi(pk[8 * q + 5]), sc); w.w = q8pack(bf_lo(pk[8 * q + 6]), bf_hi(pk[8 * q + 6]), bf_lo(pk[8 * q + 7]), bf_hi(pk[8 * q + 7]), sc);
            *(LAS v4u*)(scw + lane * 32 + q * 16) = w; }
#pragma unroll
        for (int i = 0; i < 2; ++i) *(GAS v4u*)(out8 + 1024 * i + 16 * lane) = *(const LAS v4u*)(scw + i * 1024 + lane * 16);
        if (lane == 0) *outsx = am * (1.0f / 127.0f); }
#undef PEER_EIDX
}
#undef PEER_LOADROW
#undef PEER_AXPY8
#undef PEER_AXPY8H
#undef PEER_CVT4
}

__device__ __forceinline__ void ln_row(const bf16* zrow, const float* gain, const float* bias, bf16* outb, int lane) {
    float v[32]; float s = 0.f;
#pragma unroll
    for (int q = 0; q < 4; ++q) { const v4u w = *(const GAS v4u*)(zrow + 32 * lane + 8 * q);
        v[8 * q] = bf_lo(w.x); v[8 * q + 1] = bf_hi(w.x); v[8 * q + 2] = bf_lo(w.y); v[8 * q + 3] = bf_hi(w.y); v[8 * q + 4] = bf_lo(w.z); v[8 * q + 5] = bf_hi(w.z); v[8 * q + 6] = bf_lo(w.w); v[8 * q + 7] = bf_hi(w.w); }
#pragma unroll
    for (int i = 0; i < 32; ++i) s += v[i];
    const float mean = wave_sum(s) * (1.0f / 2048.0f); float s2 = 0.f;
#pragma unroll
    for (int i = 0; i < 32; ++i) { v[i] -= mean; s2 += v[i] * v[i]; }
    const float rstd = 1.0f / sqrtf(wave_sum(s2) * (1.0f / 2048.0f) + LN_EPS);
#pragma unroll
    for (int q = 0; q < 4; ++q) { const int c0 = 32 * lane + 8 * q;
        const f32x4 g0 = *(const GAS f32x4*)(gain + c0), g1 = *(const GAS f32x4*)(gain + c0 + 4), b0 = *(const GAS f32x4*)(bias + c0), b1 = *(const GAS f32x4*)(bias + c0 + 4);
        v4u o; o.x = pk2(v[8 * q] * rstd * g0[0] + b0[0], v[8 * q + 1] * rstd * g0[1] + b0[1]); o.y = pk2(v[8 * q + 2] * rstd * g0[2] + b0[2], v[8 * q + 3] * rstd * g0[3] + b0[3]);
        o.z = pk2(v[8 * q + 4] * rstd * g1[0] + b1[0], v[8 * q + 5] * rstd * g1[1] + b1[1]); o.w = pk2(v[8 * q + 6] * rstd * g1[2] + b1[2], v[8 * q + 7] * rstd * g1[3] + b1[3]);
        *(GAS v4u*)(outb + c0) = o; }
}

__device__ __forceinline__ void ln_rows(const bf16* z, const float* gain, const float* bias, bf16* out, int m0, int stride, int lane) {
    f32x4 gg[8], bb[8];
#pragma unroll
    for (int q = 0; q < 8; ++q) { gg[q] = *(const GAS f32x4*)(gain + 512 * (q >> 1) + 8 * lane + 4 * (q & 1)); bb[q] = *(const GAS f32x4*)(bias + 512 * (q >> 1) + 8 * lane + 4 * (q & 1)); }
    v4u cur[4], nx1[4];
    if (m0 < T) { const int m1 = (m0 + stride < T) ? m0 + stride : m0;
#pragma unroll
        for (int q = 0; q < 4; ++q) { cur[q] = *(const GAS v4u*)(z + (size_t)m0 * 2048 + 512 * q + 8 * lane); nx1[q] = *(const GAS v4u*)(z + (size_t)m1 * 2048 + 512 * q + 8 * lane); } }
#pragma unroll 1
    for (int m = m0; m < T; m += stride) {
        v4u nxt[4];
        const int mn = (m + 2 * stride < T) ? m + 2 * stride : m;
#pragma unroll
        for (int q = 0; q < 4; ++q) nxt[q] = *(const GAS v4u*)(z + (size_t)mn * 2048 + 512 * q + 8 * lane);
        float v[32]; float s = 0.f;
#pragma unroll
        for (int q = 0; q < 4; ++q) { const v4u w = cur[q];
            v[8 * q] = bf_lo(w.x); v[8 * q + 1] = bf_hi(w.x); v[8 * q + 2] = bf_lo(w.y); v[8 * q + 3] = bf_hi(w.y); v[8 * q + 4] = bf_lo(w.z); v[8 * q + 5] = bf_hi(w.z); v[8 * q + 6] = bf_lo(w.w); v[8 * q + 7] = bf_hi(w.w); }
#pragma unroll
        for (int i = 0; i < 32; ++i) s += v[i];
        const float mean = wave_sum(s) * (1.0f / 2048.0f); float s2 = 0.f;
#pragma unroll
        for (int i = 0; i < 32; ++i) { v[i] -= mean; s2 += v[i] * v[i]; }
        const float rstd = 1.0f / sqrtf(wave_sum(s2) * (1.0f / 2048.0f) + LN_EPS);
#pragma unroll
        for (int q = 0; q < 4; ++q) { const f32x4 g0 = gg[2 * q], g1 = gg[2 * q + 1], b0 = bb[2 * q], b1 = bb[2 * q + 1];
            v4u o; o.x = pk2(v[8 * q] * rstd * g0[0] + b0[0], v[8 * q + 1] * rstd * g0[1] + b0[1]); o.y = pk2(v[8 * q + 2] * rstd * g0[2] + b0[2], v[8 * q + 3] * rstd * g0[3] + b0[3]);
            o.z = pk2(v[8 * q + 4] * rstd * g1[0] + b1[0], v[8 * q + 5] * rstd * g1[1] + b1[1]); o.w = pk2(v[8 * q + 6] * rstd * g1[2] + b1[2], v[8 * q + 7] * rstd * g1[3] + b1[3]);
            *(GAS v4u*)(out + (size_t)m * 2048 + 512 * q + 8 * lane) = o; }
#pragma unroll
        for (int q = 0; q < 4; ++q) { cur[q] = nx1[q]; nx1[q] = nxt[q]; }
    }
}

#if MK_CHECK
namespace chk {
constexpr int CW_ERR = 2048;
__device__ __forceinline__ unsigned hash32(unsigned x) { x ^= x >> 16; x *= 0x7feb352du; x ^= x >> 15; x *= 0x846ca68bu; x ^= x >> 16; return x; }
__device__ __forceinline__ float bf2f(bf16 v) { return __builtin_bit_cast(float, (unsigned)v << 16); }
__device__ __forceinline__ void report(gu32* ctl, int stage, float d2, float r2) { atomicAdd((float*)(ctl + CW_ERR + 2 * stage), d2); atomicAdd((float*)(ctl + CW_ERR + 2 * stage + 1), r2); }
__device__ __forceinline__ float dotcol(const bf16* xr, const float* win, int n, int lane) { float a = 0.f; for (int k = lane; k < 2048; k += 64) a += bf2f(xr[k]) * win[(size_t)k * INC + n]; return wave_sum(a); }
__device__ __forceinline__ void check_inproj(gu32* ctl, const bf16* xin, const int* pos, const float* win, const bf16* qa, const bf16* ka, const bf16* qd, const bf16* kd, const bf16* vt, const bf16* ga, const bf16* gb, int gw, int ngw, int lane) {
    for (int s = gw; s < 4096; s += ngw) {
        const unsigned hsh = hash32(s * 2654435761u + 12345u);
        const int t = hsh % T, kind = (hsh >> 14) % 8;
        const unsigned h2 = hash32(hsh);
        const bf16* xr = xin + (size_t)t * 2048;
        float ref, got;
        if (kind == 0 || kind == 1) { const int head = h2 % 8, i = (h2 >> 3) % 64, nb = (kind == 0 ? 0 : 1024) + head * 128;
            const float t1 = dotcol(xr, win, nb + i, lane), t2 = dotcol(xr, win, nb + i + 64, lane);
            const float ang = (float)pos[t] * powf(10000.0f, -(float)(2 * i) / 128.0f), c = cosf(ang), sn = sinf(ang);
            const bool second = (h2 >> 9) & 1; ref = second ? (t1 * sn + t2 * c) : (t1 * c - t2 * sn);
            const bf16* p = (kind == 0 ? qa : ka) + (size_t)t * 1024 + head * 128 + i + (second ? 64 : 0);
            got = bf2f(*p) / (kind == 0 ? QSCALE_A : 1.0f);
        } else if (kind == 3 || kind == 4) { const int head = h2 % 8, comp = (h2 >> 3) & 1, i = (h2 >> 4) % 32, nb = (kind == 3 ? 3072 : 4096) + head * 128 + comp * 64;
            const float t1 = dotcol(xr, win, nb + i, lane), t2 = dotcol(xr, win, nb + i + 32, lane);
            const float ang = (float)pos[t] * powf(10000.0f, -(float)(2 * i) / 64.0f), c = cosf(ang), sn = sinf(ang);
            const bool second = (h2 >> 9) & 1; ref = second ? (t1 * sn + t2 * c) : (t1 * c - t2 * sn);
            const bf16* p = (kind == 3 ? qd : kd) + (size_t)t * 1024 + head * 128 + comp * 64 + i + (second ? 32 : 0);
            got = bf2f(*p) / (kind == 3 ? QSCALE_B : 1.0f);
        } else if (kind == 2 || kind == 5) { const int c = h2 % 1024; ref = dotcol(xr, win, (kind == 2 ? 2048 : 5120) + c, lane); got = bf2f(vt[(size_t)((kind == 2 ? 0 : 1024) + c) * T + t]);
        } else { const int c = h2 % 2048; const float v = dotcol(xr, win, (kind == 6 ? 6144 : 8192) + c, lane); ref = 1.0f / (1.0f + expf(-v)); got = (float)((const unsigned char*)(kind == 6 ? ga : gb))[(size_t)t * 2048 + c] * (1.0f / 255.0f); }
        if (lane == 0) report(ctl, 0, (got - ref) * (got - ref), ref * ref);
    }
}
__device__ __forceinline__ void check_kmean(gu32* ctl, const bf16* ka, const float* kmean, int gw, int ngw, int lane) {
    for (int s = gw; s < 1024; s += ngw) { const unsigned hsh = hash32(s * 40503u + 77u); const int item = hsh % 512, d = (hsh >> 10) % 128; const int b = item >> 7, h = (item >> 4) & 7, blk = item & 15;
        float a = 0.f; for (int r = lane; r < 256; r += 64) a += bf2f(ka[(size_t)(b * SEQ + blk * 256 + r) * 1024 + h * 128 + d]); a = wave_sum(a);
        const float g = kmean[(size_t)item * 128 + d];
        if (lane == 0) report(ctl, 1, (g - a) * (g - a), a * a + 1.0f); }
}
__device__ __forceinline__ void check_attn(LAS unsigned char* lds, gu32* ctl, const att::AttnArgs& A, int vcu, int G, int tid, int lane, int wave) {
    LAS float* sc = (LAS float*)lds; LAS float* red = sc + 4096; LAS float* ovec = red + 64; LAS float* gsc = ovec + 256; LAS unsigned* selw = (LAS unsigned*)(gsc + 16);
    for (int s = vcu; s < 1024; s += G) {
        const unsigned hsh = hash32(s * 2246822519u + 99u); const bool moba = (s & 1);
        const int b = hsh % NB, h = (hsh >> 2) % NH; int t = (hsh >> 5) % SEQ; if ((s & 6) == 0) t = (t & 255) + 256 * ((hsh >> 20) % 3);
        const size_t row = (size_t)b * SEQ + t; const int own = t >> 8;
        float o0 = 0.f, o1 = 0.f;
        const int ncomp = moba ? 1 : 2;
        __syncthreads();
        if (moba) {
            if (tid < 16) { float a = -INFINITY; if (tid < own) { a = 0.f; for (int d = 0; d < 128; ++d) a += bf2f(A.qa[row * 1024 + h * 128 + d]) * A.kmean[((size_t)(b * 8 + h) * 16 + tid) * 128 + d]; } gsc[tid] = a; }
            __syncthreads();
            if (tid == 0) { unsigned sel = 0u; for (int r = 0; r < 3; ++r) { float best = -INFINITY; int bi = -1; for (int n = 0; n < own; ++n) { const float g = gsc[n]; if (!((sel >> n) & 1u) && g > best) { best = g; bi = n; } } if (bi >= 0) sel |= 1u << bi; } selw[0] = sel; }
            __syncthreads();
        }
        const unsigned sel = moba ? selw[0] : 0u;
        for (int comp = 0; comp < ncomp; ++comp) {
            const bf16* qp = moba ? A.qa + row * 1024 + h * 128 : A.qd + row * 1024 + h * 128 + comp * 64;
            const bf16* kb = moba ? A.ka + (size_t)b * SEQ * 1024 + h * 128 : A.kd + (size_t)b * SEQ * 1024 + h * 128 + comp * 64;
            const int dq = moba ? 128 : 64;
            float lmax = -INFINITY;
            for (int k = tid; k <= t; k += 512) { bool ok = true; if (moba) { const int kbk = k >> 8; ok = (kbk == own) || ((sel >> kbk) & 1u); }
                float a = -INFINITY; if (ok) { a = 0.f; for (int d = 0; d < dq; ++d) a += bf2f(qp[d]) * bf2f(kb[(size_t)k * 1024 + d]); }
                sc[k] = a; lmax = fmaxf(lmax, a); }
            lmax = fmaxf(lmax, __shfl_xor(lmax, 1)); lmax = fmaxf(lmax, __shfl_xor(lmax, 2)); lmax = fmaxf(lmax, __shfl_xor(lmax, 4)); lmax = fmaxf(lmax, __shfl_xor(lmax, 8)); lmax = fmaxf(lmax, __shfl_xor(lmax, 16)); lmax = fmaxf(lmax, __shfl_xor(lmax, 32));
            if (lane == 0) red[wave] = lmax;
            __syncthreads();
            float gmax = red[0]; for (int w = 1; w < 8; ++w) gmax = fmaxf(gmax, red[w]);
            float lsum = 0.f;
            for (int k = tid; k <= t; k += 512) { const float p = exp2f(sc[k] - gmax); sc[k] = p; lsum += p; }
            lsum = wave_sum(lsum);
            if (lane == 0) red[8 + wave] = lsum;
            __syncthreads();
            float gsum = 0.f; for (int w = 0; w < 8; ++w) gsum += red[8 + w];
            if (tid < 128) { const bf16* vp = A.vt + (size_t)((moba ? 0 : 1024) + h * 128 + tid) * T + (size_t)b * SEQ; float a = 0.f; for (int k = 0; k <= t; ++k) a += sc[k] * bf2f(vp[k]); a /= gsum; if (comp == 0) o0 = a; else o1 = a; }
            __syncthreads();
        }
        float ref = 0.f, got = 0.f;
        if (tid < 128) {
            if (moba) { ref = o0; got = bf2f(A.oab[row * 2048 + h * 128 + tid]); }
            else { ref = o0 - A.lam * o1; got = bf2f(A.oab[row * 2048 + 1024 + h * 128 + tid]); }
            ovec[tid] = ref;
        }
        __syncthreads();
        if (tid < 128 && !moba) { float ss = 0.f; for (int d = 0; d < 128; ++d) ss += ovec[d] * ovec[d]; ref = ref / sqrtf(ss * (1.0f / 128.0f) + RMS_EPS) * A.gain[h * 128 + tid] * A.one_minus_li; }
        float d2 = (tid < 128) ? (got - ref) * (got - ref) : 0.f, r2 = (tid < 128) ? ref * ref : 0.f;
        d2 = wave_sum(d2); r2 = wave_sum(r2);
        if (lane == 0 && wave < 2) report(ctl, moba ? 2 : 3, d2, r2);
        __syncthreads();
    }
}
__device__ __forceinline__ void check_merged(gu32* ctl, const bf16* oab, const bf16* ga, const bf16* gb, const bf16* merged, const float* wa, const float* wb, int gw, int ngw, int lane) {
    for (int s = gw; s < 2048; s += ngw) { const unsigned hsh = hash32(s * 3266489917u + 5u); const int t = hsh % T, c = (hsh >> 14) % 2048;
        float a = 0.f, b = 0.f; for (int k = lane; k < 1024; k += 64) { a += bf2f(oab[(size_t)t * 2048 + k]) * wa[(size_t)k * 2048 + c]; b += bf2f(oab[(size_t)t * 2048 + 1024 + k]) * wb[(size_t)k * 2048 + c]; }
        a = wave_sum(a); b = wave_sum(b);
        const float ref = ((float)((const unsigned char*)ga)[(size_t)t * 2048 + c] * a + (float)((const unsigned char*)gb)[(size_t)t * 2048 + c] * b) * (1.0f / 255.0f), got = bf2f(merged[(size_t)t * 2048 + c]);
        if (lane == 0) report(ctl, 4, (got - ref) * (got - ref), ref * ref); }
}
__device__ __forceinline__ void check_z(gu32* ctl, const bf16* merged, const float* wo, const bf16* xres, const bf16* z, int gw, int ngw, int lane) {
    for (int s = gw; s < 2048; s += ngw) { const unsigned hsh = hash32(s * 668265263u + 31u); const int t = hsh % T, c = (hsh >> 14) % 2048;
        float a = 0.f; for (int k = lane; k < 2048; k += 64) a += bf2f(merged[(size_t)t * 2048 + k]) * wo[(size_t)k * 2048 + c];
        a = wave_sum(a);
        const float got = bf2f(z[(size_t)t * 2048 + c]) - ALPHA * bf2f(xres[(size_t)t * 2048 + c]);
        if (lane == 0) report(ctl, 5, (got - a) * (got - a), a * a); }
}
}
#endif

constexpr int NPHASE = 2 + 8 * DEPTH;
#ifndef MK_ALIGN
#define MK_ALIGN true
#endif
#ifndef MK_SP2
#define MK_SP2 true
#endif
struct Params { const float* in[16]; float* out; unsigned char* ws; int ph_lo, ph_hi; };

__global__ void __launch_bounds__(NWAVES * 64, 2) mk_fwd(Params args) {
    extern __shared__ __attribute__((aligned(16))) unsigned char lds_raw[];
    Frame F;
    F.lds = (LAS unsigned char*)lds_raw;
    F.MISC = (volatile LAS unsigned*)(F.lds + MISC_OFF);
    F.tid = threadIdx.x; F.lane = F.tid & 63; F.wave = __builtin_amdgcn_readfirstlane(F.tid >> 6);
    F.G = gridDim.x; { const int bx = blockIdx.x; F.vcu = (F.G % 8 == 0) ? (bx % 8) * (F.G / 8) + bx / 8 : bx; }
    F.ws = args.ws; F.ctl = (gu32*)(args.ws + WS_CTL);
    unsigned char* const ws = args.ws;
    const float* const in_x = args.in[0]; const int* const in_pos = (const int*)args.in[1];
    const float *in_win = args.in[2], *in_wa = args.in[3], *in_wb = args.in[4], *in_wo = args.in[5], *in_dlam = args.in[6], *in_dgain = args.in[7];
    const float *in_ln1g = args.in[8], *in_ln1b = args.in[9], *in_ln2g = args.in[10], *in_ln2b = args.in[11], *in_pwq = args.in[12], *in_sk = args.in[13], *in_pu = args.in[14], *in_pv = args.in[15];
    float* const dout = args.out;

    for (int u = F.tid; u < (LDS_BYTES - LDSCTL_OFF) / 4; u += NWAVES * 64) ((LAS unsigned*)(F.lds + LDSCTL_OFF))[u] = 0u;
    __syncthreads();
#if MK_FUSED
    XcdBarrier bar = xcd_barrier_post((unsigned*)(F.ctl + CW_BAR), F.MISC + 8, (unsigned)F.wave);
#define GRID_BAR() xcd_barrier(bar)
#else
#define GRID_BAR() do { } while (0)
#endif
    const int lo = args.ph_lo, hi = args.ph_hi;
#define IN(k) (lo <= (k) && (k) < hi)
#define BOTH(k) (IN(k) && IN((k) + 1))

    float* const cosA = (float*)(ws + WS_ROPE); float* const sinA = cosA + (size_t)T * 64; float* const cosB = sinA + (size_t)T * 64; float* const sinB = cosB + (size_t)T * 32;
    bf16* const XB = (bf16*)(ws + WS_XB);

    gu32* const wmax = F.ctl + CW_WMAX;
    if (IN(0)) {
        for (int it = F.wave * F.G + F.vcu; it < DEPTH * 16 * 40; it += F.G * NWAVES) { const int layer = it / 640;
            p0_absmax_item(in_win + (size_t)layer * 2048 * 10240, it % 640, F.lane, wmax + layer * 10240); }
        if (BOTH(0)) GRID_BAR();
    }
    if (IN(1)) {
        LAS float* scr = (LAS float*)(F.lds + F.wave * 16384);
        const int gw = F.vcu * NWAVES + F.wave, NGW = F.G * NWAVES;
        constexpr int I_IN = (2048 / 64) * (10240 / 32), I_A = (1024 / 64) * (2048 / 32), I_O = (2048 / 64) * (2048 / 32);
        constexpr int PER_LAYER = I_IN + 2 * I_A + 2 * I_O;
        for (int it = gw; it < DEPTH * PER_LAYER; it += NGW) {
            const int layer = it / PER_LAYER; int r = it % PER_LAYER;
            unsigned char* wl = ws + WS_W + (size_t)layer * W_LAYER;
            if (r < I_IN) { p0_transpose_item_i8(in_win + (size_t)layer * 2048 * 10240, 2048, 10240, wl + WO_MAIN, scr, r, F.lane, wmax + layer * 10240); continue; } r -= I_IN;
            if (r < I_A) { p0_transpose_item<false>(in_wa + (size_t)layer * 1024 * 2048, 1024, 2048, (bf16*)(wl + WO_A), scr, r, F.lane, 2048, 0); continue; } r -= I_A;
            if (r < I_A) { p0_transpose_item<false>(in_wb + (size_t)layer * 1024 * 2048, 1024, 2048, (bf16*)(wl + WO_A), scr, r, F.lane, 2048, 1024); continue; } r -= I_A;
            if (r < I_O) { p0_transpose_item<false>(in_wo + (size_t)layer * 2048 * 2048, 2048, 2048, (bf16*)(wl + WO_O), scr, r, F.lane); continue; } r -= I_O;
            p0_transpose_item<false>(in_pwq + (size_t)layer * 2048 * 2048, 2048, 2048, (bf16*)(wl + WO_Q), scr, r, F.lane);
        }
        const size_t gtid = (size_t)F.vcu * 512 + F.tid, gthreads = (size_t)F.G * 512;
        { const int nA = (int)(((size_t)T * 64 + gthreads - 1) / gthreads), nB = (int)(((size_t)T * 32 + gthreads - 1) / gthreads);
#define P0_ROPE_ELEM(j) do { \
            if ((j) < nA) { const size_t i = gtid + (size_t)(j) * gthreads; if (i < (size_t)T * 64) { const int t = (int)(i >> 6), k = (int)(i & 63);                \
                const float invf = powf(10000.0f, -(float)(2 * k) / 128.0f); const float ang = (float)in_pos[t] * invf; cosA[i] = cosf(ang); sinA[i] = sinf(ang); } } \
            else if ((j) < nA + nB) { const size_t i = gtid + (size_t)((j) - nA) * gthreads; if (i < (size_t)T * 32) { const int t = (int)(i >> 5), k = (int)(i & 31);     \
                const float invf = powf(10000.0f, -(float)(2 * k) / 64.0f); const float ang = (float)in_pos[t] * invf; cosB[i] = cosf(ang); sinB[i] = sinf(ang); } } } while (0)
          int rj = 0;
          for (int r = gw; r < 4 * NEXP; r += NGW, ++rj) { const int tab = r >> 14, e = r & (NEXP - 1);
            const float* src = ((tab & 1) ? in_pv : in_pu) + ((size_t)(tab >> 1) * NEXP + e) * 2048;
            f32x4 tv[8]; p0_table_row_load(src, tv, F.lane);
            P0_ROPE_ELEM(rj);
            p0_table_row_finish(tv, ws + WS_TAB + (size_t)tab * TAB_BYTES + (size_t)e * 1024, (float*)(ws + WS_TSC) + ((size_t)((tab >> 1) * NEXP + e) * 2 + (tab & 1)), F.lane, (LAS unsigned char*)scr); }
          for (; rj < nA + nB; ++rj) P0_ROPE_ELEM(rj);
#undef P0_ROPE_ELEM
        }
        p0_convert_sk(in_sk, (bf16*)(ws + WS_SK), (size_t)DEPTH * 2 * 8 * 128 * 128 / 8, gtid, gthreads);
        for (int row = gw; row < T; row += NGW) p0_x_row(in_x + (size_t)row * 2048, XB + (size_t)row * 2048, ws + WS_XI8 + (size_t)row * 2048, (float*)(ws + WS_SX) + row, F.lane);
        for (size_t i = gtid; i < (size_t)DEPTH * 10240; i += gthreads) { const int layer = (int)(i / 10240), n = (int)(i % 10240);
            ((float*)(ws + WS_SW))[layer * 10240 + inproj_row(n)] = __builtin_bit_cast(float, wmax[layer * 10240 + n]) * (1.0f / 127.0f); }
        if (BOTH(1)) GRID_BAR();
    }

    for (int layer = 0; layer < DEPTH; ++layer) {
        const int pb = 2 + 8 * layer;
        unsigned char* const wl = ws + WS_W + (size_t)layer * W_LAYER;
        bf16* const ZB = (bf16*)dout;
        float* const kmean = (float*)(ws + WS_KMEAN) + (size_t)layer * NB * NH * 16 * 128;
        const float lambda_init = layer == 0 ? 0.2f : 0.3555090675909306f;
#define PHASE_TID() int llane_ = lane_id(); asm volatile("" : "+v"(llane_)); const int llane = llane_, ltid = llane_ + 64 * F.wave
        if (IN(pb)) {
            const bf16* const XI8 = (const bf16*)(ws + WS_XI8); const float* const sx = (const float*)(ws + WS_SX); const float* const sw = (const float*)(ws + WS_SW) + layer * 10240;
            { pg8::Gemm g{XI8, (const bf16*)(wl + WO_MAIN), T, NMAIN, 1024}; pg8::StaticOrder S; S.init(T, NMAIN, F.G, (int)blockIdx.x);
              pg8::EpiInProjI8 E{(bf16*)(ws + WS_QA), (bf16*)(ws + WS_KA), (bf16*)(ws + WS_QD), (bf16*)(ws + WS_KD), (bf16*)(ws + WS_GA), (bf16*)(ws + WS_GB), cosA, sinA, cosB, sinB, QSCALE_A, QSCALE_B, sx, sw, kmean};
              pg8::gemm_phase<pg8::EpiInProjI8, pg8::StaticOrder, MK_ALIGN, MK_SP2, false, true>(F.lds, g, S, E, F.wave); }
            { pg8::Gemm g{(const bf16*)(wl + WO_V), XI8, NV, T, 1024}; pg8::StaticOrder S; S.init(NV, T, F.G, (int)blockIdx.x);
              pg8::EpiPlainI8 E{(bf16*)(ws + WS_VT), T, sw + NMAIN, sx};
              pg8::gemm_phase<pg8::EpiPlainI8, pg8::StaticOrder, MK_ALIGN, MK_SP2, false, true>(F.lds, g, S, E, F.wave); }
            if (BOTH(pb)) GRID_BAR();
        }
        if (IN(pb + 2)) {
            PHASE_TID();
            const float* lp = in_dlam + (size_t)layer * 256;
            const float s1 = wave_sum(lp[llane] * lp[64 + llane]), s2 = wave_sum(lp[128 + llane] * lp[192 + llane]);
            float lam = __builtin_bit_cast(float, __builtin_amdgcn_readfirstlane(__builtin_bit_cast(int, expf(s1) - expf(s2) + lambda_init))), oml = __builtin_bit_cast(float, __builtin_amdgcn_readfirstlane(layer == 0 ? 0x3f4ccccd : 0x3f24fd5c));
            att::AttnArgs A{(const bf16*)(ws + WS_QA), (const bf16*)(ws + WS_KA), (const bf16*)(ws + WS_QD), (const bf16*)(ws + WS_KD), (const bf16*)(ws + WS_VT),
                            (bf16*)(ws + WS_OA), kmean, in_dgain + (size_t)layer * 1024, lam, oml};
            att::attn_phase(F.lds, A, F.vcu, F.G, ltid, F.wave, llane);
            if (BOTH(pb + 2)) GRID_BAR();
        }
        if (IN(pb + 3)) {
            { pg8::Gemm g{(const bf16*)(ws + WS_OA), (const bf16*)(wl + WO_A), T, 2048, 2048}; pg8::StaticOrder S; S.init(T, 2048, F.G, (int)blockIdx.x);
              pg8::EpiBranch E{(const bf16*)(ws + WS_GA), (const bf16*)(ws + WS_GB), (bf16*)(ws + WS_MERGED), 2048};
              pg8::gemm_phase<pg8::EpiBranch, pg8::StaticOrder, MK_ALIGN, MK_SP2, true>(F.lds, g, S, E, F.wave); }
            if (BOTH(pb + 3)) GRID_BAR();
        }
        if (IN(pb + 4)) {
            pg8::Gemm g{(const bf16*)(ws + WS_MERGED), (const bf16*)(wl + WO_O), T, 2048, 2048}; pg8::StaticOrder S; S.init(T, 2048, F.G, (int)blockIdx.x);
            pg8::EpiOutProj E{XB, ZB, 2048, ALPHA};
            pg8::gemm_phase<pg8::EpiOutProj, pg8::StaticOrder, MK_ALIGN, MK_SP2>(F.lds, g, S, E, F.wave);
            if (BOTH(pb + 4)) GRID_BAR();
        }
        if (IN(pb + 5)) {
            PHASE_TID();
            const int gw = F.vcu * NWAVES + F.wave, NGW = F.G * NWAVES;
            ln_rows(ZB, in_ln1g + (size_t)layer * 2048, in_ln1b + (size_t)layer * 2048, XB, gw, NGW, llane);
            if (BOTH(pb + 5)) GRID_BAR();
        }
        if (IN(pb + 6)) {
            pg8::Gemm g{XB, (const bf16*)(wl + WO_Q), T, 2048, 2048}; pg8::StaticOrder S; S.init(T, 2048, F.G, (int)blockIdx.x);
            pg8::EpiPeerQ E{(bf16*)(ws + WS_PQ)};
            pg8::gemm_phase<pg8::EpiPeerQ, pg8::StaticOrder, MK_ALIGN, MK_SP2>(F.lds, g, S, E, F.wave);
            if (BOTH(pb + 6)) GRID_BAR();
        }
        if (IN(pb + 7)) {
            const unsigned char* TU = ws + WS_TAB + (size_t)(2 * layer) * TAB_BYTES; const unsigned char* TV = ws + WS_TAB + (size_t)(2 * layer + 1) * TAB_BYTES;
            const float* SU = (const float*)(ws + WS_TSC) + (size_t)layer * NEXP * 2; const float* SV = SU + 1;
            const bf16* sk = (const bf16*)(ws + WS_SK) + (size_t)layer * 2 * 8 * 128 * 128;
            const bool last = (layer == DEPTH - 1);
            PHASE_TID();
            v4u* const pscr = (v4u*)(ws + WS_PSCR + (size_t)F.vcu * 32768);
            { const int lo_ = ltid >> 3, q_ = ltid & 7;
              *(LAS f32x4*)(F.lds + peer::LNG0 + (q_ * 64 + lo_) * 16) = *(const GAS f32x4*)(in_ln2g + (size_t)layer * 2048 + 4 * ltid);
              *(LAS f32x4*)(F.lds + peer::LNG0 + 8192 + (q_ * 64 + lo_) * 16) = *(const GAS f32x4*)(in_ln2b + (size_t)layer * 2048 + 4 * ltid); }
#pragma unroll 1
            for (int ta = F.vcu; ta < T / 32; ta += 2 * F.G) {
                const int tb = ta + F.G; const bool pair = tb < T / 32, sw = pair && (F.vcu & 1);
                const int nst = sw ? 6 : (pair ? 4 : 2);
#pragma unroll 1
                for (int st = 0; st < nst; ++st) {
                    int op, tile;
                    if (sw) { op = (st == 0 || st == 2) ? 0 : (st == 1 ? 2 : (st == 4 ? 3 : 1)); tile = (st == 0 || st == 5) ? tb : ta; }
                    else { op = st & 1; tile = st < 2 ? ta : tb; }
                    const int t0 = tile * 32;
                    if (op == 0) peer::select_tile(F.lds, (const bf16*)(ws + WS_PQ), sk, t0, F.wave, llane);
                    else if (op == 1) {
                    v4u ring[16];
#pragma unroll
                    for (int s = 0; s < 16; ++s) ring[s] = (v4u){0u, 0u, 0u, 0u};
#pragma unroll 1
                    for (int i = 0; i < 4; ++i) { const int tl = F.wave * 4 + i; const size_t t = (size_t)(t0 + tl);
                        peer::token_ffn(F.lds, tl, XB + t * 2048, TU, TV, SU, SV, in_ln2g + (size_t)layer * 2048, in_ln2b + (size_t)layer * 2048, last ? dout + t * 2048 : (float*)nullptr, last ? (bf16*)nullptr : XB + t * 2048, ws + WS_XI8 + t * 2048, (float*)(ws + WS_SX) + t, llane, ring, i > 0, i < 3); }
                    } else if (op == 2) {
#pragma unroll
                        for (int q = 0; q < 4; ++q) pscr[ltid + 512 * q] = *(const LAS v4u*)(F.lds + (size_t)(ltid + 512 * q) * 16);
                    } else {
#pragma unroll
                        for (int q = 0; q < 4; ++q) *(LAS v4u*)(F.lds + (size_t)(ltid + 512 * q) * 16) = pscr[ltid + 512 * q];
                    }
                    __syncthreads();
                }
            }
            if (BOTH(pb + 7)) GRID_BAR();
        }
    }
#undef PHASE_TID
#undef IN
#undef BOTH
#undef GRID_BAR
}

#if MK_CHECK
__global__ void __launch_bounds__(NWAVES * 64, 2) chk_kernel(Params args, int layer, int which) {
    extern __shared__ __attribute__((aligned(16))) unsigned char lds_raw[];
    LAS unsigned char* lds = (LAS unsigned char*)lds_raw;
    const int tid = threadIdx.x, lane = tid & 63, wave = __builtin_amdgcn_readfirstlane(tid >> 6), G = gridDim.x, vcu = blockIdx.x;
    unsigned char* const ws = args.ws; gu32* ctl = (gu32*)(ws + WS_CTL);
    const bf16* xresb = (const bf16*)(ws + WS_XB);
    float* const kmean = (float*)(ws + WS_KMEAN) + (size_t)layer * NB * NH * 16 * 128;
    const float lambda_init = layer == 0 ? 0.2f : 0.3555090675909306f;
    const int gw = vcu * NWAVES + wave, NGW = G * NWAVES;
    if (which == 0) {
        const float* lp = args.in[6] + (size_t)layer * 256;
        const float s1 = wave_sum(lp[lane] * lp[64 + lane]), s2 = wave_sum(lp[128 + lane] * lp[192 + lane]);
        const float lam = expf(s1) - expf(s2) + lambda_init;
        att::AttnArgs A{(const bf16*)(ws + WS_QA), (const bf16*)(ws + WS_KA), (const bf16*)(ws + WS_QD), (const bf16*)(ws + WS_KD), (const bf16*)(ws + WS_VT),
                        (bf16*)(ws + WS_OA), kmean, args.in[7] + (size_t)layer * 1024, lam, 1.0f - lambda_init};
        chk::check_inproj(ctl, xresb, (const int*)args.in[1], args.in[2] + (size_t)layer * 2048 * 10240, A.qa, A.ka, A.qd, A.kd, A.vt, (const bf16*)(ws + WS_GA), (const bf16*)(ws + WS_GB), gw, NGW, lane);
        chk::check_kmean(ctl, A.ka, kmean, gw, NGW, lane);
        chk::check_attn(lds, ctl, A, vcu, G, tid, lane, wave);
    } else if (which == 3) {
        const float oscale = 1.0f + 0.04f * (float)__hip_atomic_load(ctl + chk::CW_ERR + 64, RLX_AGENT);
        for (size_t i = (size_t)vcu * 512 + tid; i < (size_t)T * 2048 / 4; i += (size_t)G * 512) { f32x4 v = *(GAS f32x4*)(args.out + i * 4); v = v * oscale; *(GAS f32x4*)(args.out + i * 4) = v; }
    } else if (which == 2) {
        if (vcu == 0 && tid == 0) { const float tol[6] = {1e-3f, 1e-4f, 3e-2f, 3e-3f, 1e-3f, 1e-3f}; unsigned code = 0;
            for (int st = 0; st < 6; ++st) { const float d2 = __builtin_bit_cast(float, __hip_atomic_load(ctl + chk::CW_ERR + 2 * st, RLX_AGENT)), r2 = __builtin_bit_cast(float, __hip_atomic_load(ctl + chk::CW_ERR + 2 * st + 1, RLX_AGENT));
                if (!(d2 <= tol[st] * r2) || !(r2 > 0.f)) code |= 1u << st; }
#ifdef MK_CHECK_STAGE
            { const float d2 = __builtin_bit_cast(float, __hip_atomic_load(ctl + chk::CW_ERR + 2 * MK_CHECK_STAGE, RLX_AGENT)), r2 = __builtin_bit_cast(float, __hip_atomic_load(ctl + chk::CW_ERR + 2 * MK_CHECK_STAGE + 1, RLX_AGENT));
              float ratio = d2 / r2; ratio = fminf(fmaxf(ratio, 1e-8f), 1e4f); code = (unsigned)(int)(4.0f * (log10f(ratio) + 8.0f) + 0.5f); }
#endif
            __hip_atomic_store(ctl + chk::CW_ERR + 64, code, RLX_AGENT); }
    } else {
        chk::check_merged(ctl, (const bf16*)(ws + WS_OA), (const bf16*)(ws + WS_GA), (const bf16*)(ws + WS_GB), (const bf16*)(ws + WS_MERGED), args.in[3] + (size_t)layer * 1024 * 2048, args.in[4] + (size_t)layer * 1024 * 2048, gw, NGW, lane);
        chk::check_z(ctl, (const bf16*)(ws + WS_MERGED), args.in[5] + (size_t)layer * 2048 * 2048, xresb, (const bf16*)args.out, gw, NGW, lane);
    }
}
#endif

extern "C" void kernel_launch(void* const* d_in, const int* in_sizes, int n_in, void* d_out, int out_size, void* d_ws, size_t ws_size, hipStream_t stream) {
    static int grid = 0;
    if (grid == 0) {
        if (n_in != 16 || out_size != T * DM || ws_size < WS_END) { fprintf(stderr, "kernel_launch: unexpected problem (n_in %d, out %d, ws %zu < %zu); nothing launched\n", n_in, out_size, ws_size, (size_t)WS_END); grid = -1; return; }
        int dev = 0, cus = 0, per_cu = 0;
        if (hipGetDevice(&dev) != hipSuccess || hipDeviceGetAttribute(&cus, hipDeviceAttributeMultiprocessorCount, dev) != hipSuccess) { fprintf(stderr, "kernel_launch: device query failed\n"); grid = -1; return; }
#if MK_CHECK
        (void)hipFuncSetAttribute((const void*)chk_kernel, hipFuncAttributeMaxDynamicSharedMemorySize, LDS_BYTES);
#endif
        if (hipFuncSetAttribute((const void*)mk_fwd, hipFuncAttributeMaxDynamicSharedMemorySize, LDS_BYTES) != hipSuccess) { fprintf(stderr, "kernel_launch: hipFuncSetAttribute failed\n"); grid = -1; return; }
        if (hipOccupancyMaxActiveBlocksPerMultiprocessor(&per_cu, (const void*)mk_fwd, NWAVES * 64, LDS_BYTES) != hipSuccess || per_cu < 1) { fprintf(stderr, "kernel_launch: occupancy query says %d blocks per CU; nothing launched\n", per_cu); (void)hipGetLastError(); grid = -1; return; }
        grid = cus;
    }
    if (grid < 0) return;
    (void)hipMemsetAsync((char*)d_ws + WS_CTL, 0, CTL_ZERO_BYTES, stream);
    Params a{};
    for (int i = 0; i < 16; ++i) a.in[i] = (const float*)d_in[i];
    a.out = (float*)d_out; a.ws = (unsigned char*)d_ws;
#if MK_FUSED
    a.ph_lo = 0; a.ph_hi = NPHASE;
    hipLaunchKernelGGL(mk_fwd, dim3(grid), dim3(NWAVES * 64), LDS_BYTES, stream, a);
#else
    for (int ph = 0; ph < NPHASE; ++ph) { a.ph_lo = ph; a.ph_hi = ph + 1; hipLaunchKernelGGL(mk_fwd, dim3(grid), dim3(NWAVES * 64), LDS_BYTES, stream, a);
#if MK_CHECK
        if (ph == 2 + 8 * MK_CHECK_LAYER + 2) hipLaunchKernelGGL(chk_kernel, dim3(grid), dim3(NWAVES * 64), LDS_BYTES, stream, a, (int)MK_CHECK_LAYER, 0);
        if (ph == 2 + 8 * MK_CHECK_LAYER + 4) hipLaunchKernelGGL(chk_kernel, dim3(grid), dim3(NWAVES * 64), LDS_BYTES, stream, a, (int)MK_CHECK_LAYER, 1);
        if (ph == NPHASE - 2) hipLaunchKernelGGL(chk_kernel, dim3(grid), dim3(NWAVES * 64), LDS_BYTES, stream, a, (int)MK_CHECK_LAYER, 2);
        if (ph == NPHASE - 1) hipLaunchKernelGGL(chk_kernel, dim3(grid), dim3(NWAVES * 64), LDS_BYTES, stream, a, (int)MK_CHECK_LAYER, 3);
#endif
    }
#endif
}
```
